# Optimizing an MI355X kernel written in HIP

```python
import jax, jax.numpy as jnp
from jax import lax
import numpy as np

D_MODEL = 2048
BATCH = 4
SEQ = 2048
DEPTH = 1

D_MIX = D_MODEL
NSA_WIDTH = D_MIX // 2
POOL_WIDTH = D_MIX - NSA_WIDTH
HEAD_DIM = 128
N_HEADS = NSA_WIDTH // HEAD_DIM
N_KV = 2
GQA = N_HEADS // N_KV
KV_WIDTH = N_KV * HEAD_DIM
N_GATES = 3 * N_HEADS
ROT_DIM = HEAD_DIM // 4
ROPE_THETA = 500000.0
CMP_LEN = 32
CMP_STRIDE = 16
CMP_HIDDEN = 2 * HEAD_DIM
SEL_LEN = 64
SEL_TOPK = 16
N_LOCAL = 2
WINDOW = 512
WIN_QBLOCK = 128
SEL_QBLOCK = 64
POOL_SIZES = (2, 4, 8, 16)
N_POOL_GROUPS = 4
POOL_GROUP = POOL_WIDTH // N_POOL_GROUPS
N_EXPERT_GROUPS = 4
EXPERTS_PER_GROUP = 8
N_EXPERTS = N_EXPERT_GROUPS * EXPERTS_PER_GROUP
TOP_K_INNER = 2
D_FF_EXPERT = D_MODEL // 4
MOE_BLOCK = 128
EPS = 1e-6
NEG = -1e30
BIG = 1e30
IN_WIDTH = NSA_WIDTH + 6 * KV_WIDTH + N_GATES + POOL_WIDTH

kernel_name = "hymba_nsa_pool_hmoe_layer"


def rmsnorm(x, g):
    xf = x.astype(jnp.float32)
    y = xf * lax.rsqrt(jnp.mean(xf * xf, axis=-1, keepdims=True) + EPS)
    return (y * g.astype(jnp.float32)).astype(x.dtype)


def rope_tables(positions, dtype):
    inv_freq = ROPE_THETA ** (-jnp.arange(0, ROT_DIM, 2, dtype=jnp.float32) / ROT_DIM)
    ang = positions.astype(jnp.float32)[..., None] * inv_freq
    return jnp.cos(ang)[:, None].astype(dtype), jnp.sin(ang)[:, None].astype(dtype)


def apply_partial_rope(x, cos, sin):
    xr, xp = x[..., :ROT_DIM], x[..., ROT_DIM:]
    x1, x2 = xr[..., : ROT_DIM // 2], xr[..., ROT_DIM // 2:]
    rot = jnp.concatenate([x1 * cos - x2 * sin, x2 * cos + x1 * sin], axis=-1)
    return jnp.concatenate([rot, xp], axis=-1)


def gather_blocks(blocks, idx):
    return jax.vmap(jax.vmap(lambda b_, i_: b_[i_]))(blocks, idx)


def cmp_to_sel_weights(n_cmp, n_sel):
    cs = jnp.arange(n_cmp)[:, None] * CMP_STRIDE
    ss = jnp.arange(n_sel)[None, :] * SEL_LEN
    ov = jnp.clip(jnp.minimum(cs + CMP_LEN, ss + SEL_LEN) - jnp.maximum(cs, ss), 0)
    return ov.astype(jnp.float32) / CMP_LEN


def nsa_mixer(q, kc, vc, ks, vs, kw, vw, gates, positions,
              pe_k, w_ck1, w_ck2, pe_v, w_cv1, w_cv2):
    B, S = q.shape[0], q.shape[1]
    scale = HEAD_DIM ** -0.5
    def heads(t, n):
        return t.reshape(B, S, n, HEAD_DIM).transpose(0, 2, 1, 3)
    q = heads(q, N_HEADS)
    kc, vc, ks, vs, kw, vw = [heads(t, N_KV) for t in (kc, vc, ks, vs, kw, vw)]
    cos, sin = rope_tables(positions, q.dtype)
    q_rope = apply_partial_rope(q, cos, sin)
    ks = apply_partial_rope(ks, cos, sin)
    kw = apply_partial_rope(kw, cos, sin)
    qg = q.reshape(B, N_KV, GQA, S, HEAD_DIM)
    qrg = q_rope.reshape(B, N_KV, GQA, S, HEAD_DIM)
    t_idx = jnp.arange(S)

    n_cmp = (S - CMP_LEN) // CMP_STRIDE + 1
    cmp_tok = jnp.arange(n_cmp)[:, None] * CMP_STRIDE + jnp.arange(CMP_LEN)[None, :]
    def compress(t, pe, w1, w2):
        blk = (t[:, :, cmp_tok] + pe).reshape(B, N_KV, n_cmp, CMP_LEN * HEAD_DIM)
        return jax.nn.gelu(blk @ w1) @ w2
    k_cmp = compress(kc, pe_k, w_ck1, w_ck2)
    v_cmp = compress(vc, pe_v, w_cv1, w_cv2)
    cmp_end = jnp.arange(n_cmp) * CMP_STRIDE + CMP_LEN - 1
    cmp_ok = cmp_end[None, :] <= t_idx[:, None]
    s_cmp = jnp.einsum('bgrsd,bgnd->bgrsn', qg, k_cmp).astype(jnp.float32) * scale
    s_cmp = jnp.where(cmp_ok, s_cmp, NEG)
    p_cmp = jnp.where(cmp_ok, jax.nn.softmax(s_cmp, axis=-1), 0.0)
    o_cmp = jnp.einsum('bgrsn,bgnd->bgrsd', p_cmp.astype(v_cmp.dtype), v_cmp)

    n_sel = S // SEL_LEN
    imp = jnp.einsum('bgrsn,nj->bgsj', p_cmp, cmp_to_sel_weights(n_cmp, n_sel))
    blk_j = jnp.arange(n_sel)[None, :]
    cur = (t_idx // SEL_LEN)[:, None]
    sel_ok = blk_j * SEL_LEN <= t_idx[:, None]
    forced = (blk_j == 0) | ((cur - blk_j >= 0) & (cur - blk_j < N_LOCAL))
    imp = jnp.where(sel_ok & forced, BIG, jnp.where(sel_ok, imp, -BIG))
    k_top = min(SEL_TOPK, n_sel)
    top_val, top_idx = lax.top_k(imp, k_top)
    top_ok = top_val >= 0.0
    ks_blocks = ks.reshape(B, N_KV, n_sel, SEL_LEN, HEAD_DIM)
    vs_blocks = vs.reshape(B, N_KV, n_sel, SEL_LEN, HEAD_DIM)
    nq = S // SEL_QBLOCK
    q_chunks = jnp.moveaxis(qrg.reshape(B, N_KV, GQA, nq, SEL_QBLOCK, HEAD_DIM), 3, 0)
    i_chunks = jnp.moveaxis(top_idx.reshape(B, N_KV, nq, SEL_QBLOCK, k_top), 2, 0)
    ok_chunks = jnp.moveaxis(top_ok.reshape(B, N_KV, nq, SEL_QBLOCK, k_top), 2, 0)
    t_chunks = t_idx.reshape(nq, SEL_QBLOCK)
    def sel_block(args):
        qb, ib, okb, tb = args
        flat = ib.reshape(B, N_KV, SEL_QBLOCK * k_top)
        kb = gather_blocks(ks_blocks, flat).reshape(B, N_KV, SEL_QBLOCK, k_top * SEL_LEN, HEAD_DIM)
        vb = gather_blocks(vs_blocks, flat).reshape(B, N_KV, SEL_QBLOCK, k_top * SEL_LEN, HEAD_DIM)
        kpos = (ib[..., None] * SEL_LEN + jnp.arange(SEL_LEN)).reshape(B, N_KV, SEL_QBLOCK, k_top * SEL_LEN)
        ok = jnp.repeat(okb, SEL_LEN, axis=-1) & (kpos <= tb[:, None])
        s = jnp.einsum('bgrqd,bgqld->bgrql', qb, kb).astype(jnp.float32) * scale
        s = jnp.where(ok[:, :, None], s, NEG)
        p = jax.nn.softmax(s, axis=-1).astype(vb.dtype)
        return jnp.einsum('bgrql,bgqld->bgrqd', p, vb)
    o_sel = lax.map(sel_block, (q_chunks, i_chunks, ok_chunks, t_chunks))
    o_sel = jnp.moveaxis(o_sel, 0, 3).reshape(B, N_KV, GQA, S, HEAD_DIM)

    nwb = S // WIN_QBLOCK
    kw_pad = jnp.pad(kw, ((0, 0), (0, 0), (WINDOW, 0), (0, 0)))
    vw_pad = jnp.pad(vw, ((0, 0), (0, 0), (WINDOW, 0), (0, 0)))
    win_idx = jnp.arange(nwb)[:, None] * WIN_QBLOCK + jnp.arange(WIN_QBLOCK + WINDOW)[None, :]
    kwb = kw_pad[:, :, win_idx]
    vwb = vw_pad[:, :, win_idx]
    kpos = (win_idx - WINDOW)[:, None, :]
    qpos = t_idx.reshape(nwb, WIN_QBLOCK)[:, :, None]
    w_ok = (kpos <= qpos) & (kpos > qpos - WINDOW) & (kpos >= 0)
    qw = qrg.reshape(B, N_KV, GQA, nwb, WIN_QBLOCK, HEAD_DIM)
    s_w = jnp.einsum('bgrnqd,bgnkd->bgrnqk', qw, kwb).astype(jnp.float32) * scale
    s_w = jnp.where(w_ok, s_w, NEG)
    p_w = jax.nn.softmax(s_w, axis=-1).astype(vwb.dtype)
    o_win = jnp.einsum('bgrnqk,bgnkd->bgrnqd', p_w, vwb).reshape(B, N_KV, GQA, S, HEAD_DIM)

    g = jax.nn.sigmoid(gates.reshape(B, S, N_HEADS, 3).transpose(0, 2, 1, 3))
    g = g.reshape(B, N_KV, GQA, S, 3)
    o = g[..., 0:1] * o_cmp + g[..., 1:2] * o_sel + g[..., 2:3] * o_win
    return o.reshape(B, N_HEADS, S, HEAD_DIM).transpose(0, 2, 1, 3).reshape(B, S, NSA_WIDTH)


def pool_mixer(u, w_pool, b_pool, pool_scale):
    B, S, C = u.shape
    uf = u.astype(jnp.float32)
    c0 = jnp.pad(jnp.cumsum(uf, axis=1), ((0, 0), (1, 0), (0, 0)))
    t1 = jnp.arange(1, S + 1, dtype=jnp.float32)[:, None]
    outs = []
    for gi, w in enumerate(POOL_SIZES):
        sl = slice(gi * POOL_GROUP, (gi + 1) * POOL_GROUP)
        cg = c0[:, :, sl]
        prev = jnp.pad(cg[:, : S + 1 - w], ((0, 0), (w - 1, 0), (0, 0)))
        mean = (cg[:, 1:] - prev) / jnp.minimum(t1, float(w))
        outs.append(mean - uf[:, :, sl])
    d = jnp.stack(outs, axis=2).astype(u.dtype)
    y = jnp.einsum('bsgc,gcd->bsgd', d, w_pool).reshape(B, S, C) + b_pool
    return y * pool_scale


def hier_moe(h, w_rg, b_rg, w_re, b_re, w_gate, w_up, w_down):
    B, S, D = h.shape
    N = B * S
    hf = h.reshape(N, D)
    rows = jnp.arange(N)
    lg = (hf @ w_rg).astype(jnp.float32) + b_rg.astype(jnp.float32)
    pg = jax.nn.softmax(lg, axis=-1)
    g_sel = jnp.argmax(lg, axis=-1)
    p_g = pg[rows, g_sel]
    le = jnp.einsum('nd,gde->nge', hf, w_re).astype(jnp.float32) + b_re.astype(jnp.float32)
    pe = jax.nn.softmax(le[rows, g_sel], axis=-1)
    top_p, top_e = lax.top_k(pe, TOP_K_INNER)
    gate = p_g[:, None] * top_p / jnp.sum(top_p, axis=-1, keepdims=True)
    expert = g_sel[:, None] * EXPERTS_PER_GROUP + top_e
    na = N * TOP_K_INNER
    e_flat = expert.reshape(na)
    tok_flat = jnp.repeat(rows, TOP_K_INNER)
    g_flat = gate.reshape(na)
    order = jnp.argsort(e_flat)
    e_s, tok_s, g_s = e_flat[order], tok_flat[order], g_flat[order]
    counts = jnp.bincount(e_flat, length=N_EXPERTS)
    starts = jnp.cumsum(counts) - counts
    pcounts = (counts + MOE_BLOCK - 1) // MOE_BLOCK * MOE_BLOCK
    pends = jnp.cumsum(pcounts)
    pstarts = pends - pcounts
    dest = pstarts[e_s] + jnp.arange(na) - starts[e_s]
    n_blocks = (na + N_EXPERTS * (MOE_BLOCK - 1) + MOE_BLOCK - 1) // MOE_BLOCK
    cap = n_blocks * MOE_BLOCK
    buf_tok = jnp.full((cap,), N, dtype=jnp.int32).at[dest].set(tok_s.astype(jnp.int32))
    buf_gate = jnp.zeros((cap,), jnp.float32).at[dest].set(g_s)
    blk_expert = jnp.minimum(jnp.searchsorted(pends, jnp.arange(n_blocks) * MOE_BLOCK, side='right'),
                             N_EXPERTS - 1)
    h_pad = jnp.concatenate([hf, jnp.zeros((1, D), hf.dtype)], axis=0)
    def run_block(args):
        tk, gt, e = args
        xb = h_pad[tk]
        y = (jax.nn.silu(xb @ w_gate[e]) * (xb @ w_up[e])) @ w_down[e]
        return y * gt[:, None].astype(y.dtype)
    ys = lax.map(run_block, (buf_tok.reshape(n_blocks, MOE_BLOCK),
                             buf_gate.reshape(n_blocks, MOE_BLOCK), blk_expert))
    out = jnp.zeros((N + 1, D), h.dtype).at[buf_tok].add(ys.reshape(cap, D))[:N]
    return out.reshape(B, S, D)


def setup_inputs(seed: int = 0) -> dict:
    key = jax.random.key(seed)
    ks = jax.random.split(key, 24)
    f32 = jnp.float32
    def nrm(k, shape, fan_in):
        return jax.random.normal(k, shape, f32) * (fan_in ** -0.5)
    def gain(k, shape):
        return 1.0 + 0.1 * jax.random.normal(k, shape, f32)
    L = DEPTH
    return {
        "x": jax.random.normal(ks[0], (BATCH, SEQ, D_MODEL), f32),
        "positions": (jnp.arange(SEQ, dtype=jnp.int32)[None, :]
                      + jax.random.randint(ks[1], (BATCH, 1), 0, 1024, dtype=jnp.int32)),
        "ln_mix": gain(ks[2], (L, D_MODEL)),
        "w_in": nrm(ks[3], (L, D_MODEL, IN_WIDTH), D_MODEL),
        "pe_cmp_k": 0.1 * jax.random.normal(ks[4], (L, CMP_LEN, HEAD_DIM), f32),
        "w_cmp_k1": nrm(ks[5], (L, CMP_LEN * HEAD_DIM, CMP_HIDDEN), CMP_LEN * HEAD_DIM),
        "w_cmp_k2": nrm(ks[6], (L, CMP_HIDDEN, HEAD_DIM), CMP_HIDDEN),
        "pe_cmp_v": 0.1 * jax.random.normal(ks[7], (L, CMP_LEN, HEAD_DIM), f32),
        "w_cmp_v1": nrm(ks[8], (L, CMP_LEN * HEAD_DIM, CMP_HIDDEN), CMP_LEN * HEAD_DIM),
        "w_cmp_v2": nrm(ks[9], (L, CMP_HIDDEN, HEAD_DIM), CMP_HIDDEN),
        "w_pool": nrm(ks[10], (L, N_POOL_GROUPS, POOL_GROUP, POOL_GROUP), POOL_GROUP),
        "b_pool": 0.01 * jax.random.normal(ks[11], (L, POOL_WIDTH), f32),
        "pool_scale": gain(ks[12], (L, POOL_WIDTH)),
        "gn_nsa": gain(ks[13], (L, NSA_WIDTH)),
        "gn_pool": gain(ks[14], (L, POOL_WIDTH)),
        "w_out": nrm(ks[15], (L, D_MIX, D_MODEL), D_MIX),
        "ln_moe": gain(ks[16], (L, D_MODEL)),
        "w_router_group": nrm(ks[17], (L, D_MODEL, N_EXPERT_GROUPS), D_MODEL),
        "b_router_group": 0.01 * jax.random.normal(ks[18], (L, N_EXPERT_GROUPS), f32),
        "w_router_expert": nrm(ks[19], (L, N_EXPERT_GROUPS, D_MODEL, EXPERTS_PER_GROUP), D_MODEL),
        "b_router_expert": 0.01 * jax.random.normal(ks[20], (L, N_EXPERT_GROUPS, EXPERTS_PER_GROUP), f32),
        "w_gate": nrm(ks[21], (L, N_EXPERTS, D_MODEL, D_FF_EXPERT), D_MODEL),
        "w_up": nrm(ks[22], (L, N_EXPERTS, D_MODEL, D_FF_EXPERT), D_MODEL),
        "w_down": nrm(ks[23], (L, N_EXPERTS, D_FF_EXPERT, D_MODEL), D_FF_EXPERT),
        "ln_final": gain(jax.random.fold_in(key, 99), (D_MODEL,)),
    }


def reference(x, positions, ln_mix, w_in, pe_cmp_k, w_cmp_k1, w_cmp_k2, pe_cmp_v, w_cmp_v1,
              w_cmp_v2, w_pool, b_pool, pool_scale, gn_nsa, gn_pool, w_out, ln_moe,
              w_router_group, b_router_group, w_router_expert, b_router_expert,
              w_gate, w_up, w_down, ln_final):
    sizes = (NSA_WIDTH, KV_WIDTH, KV_WIDTH, KV_WIDTH, KV_WIDTH, KV_WIDTH, KV_WIDTH, N_GATES, POOL_WIDTH)
    cuts, acc = [], 0
    for s_ in sizes[:-1]:
        acc += s_
        cuts.append(acc)
    for l in range(DEPTH):
        h = rmsnorm(x, ln_mix[l])
        proj = h @ w_in[l]
        q, kc, vc, ksel, vsel, kwin, vwin, gates, u = jnp.split(proj, cuts, axis=-1)
        o_nsa = nsa_mixer(q, kc, vc, ksel, vsel, kwin, vwin, gates, positions,
                          pe_cmp_k[l], w_cmp_k1[l], w_cmp_k2[l],
                          pe_cmp_v[l], w_cmp_v1[l], w_cmp_v2[l])
        o_pool = pool_mixer(u, w_pool[l], b_pool[l], pool_scale[l])
        mix = jnp.concatenate([rmsnorm(o_nsa, gn_nsa[l]), rmsnorm(o_pool, gn_pool[l])], axis=-1)
        x = x + mix @ w_out[l]
        h2 = rmsnorm(x, ln_moe[l])
        x = x + hier_moe(h2, w_router_group[l], b_router_group[l], w_router_expert[l],
                         b_router_expert[l], w_gate[l], w_up[l], w_down[l])
    return rmsnorm(x, ln_final)
```

```cpp
#include <hip/hip_runtime.h>
#include <cstdio>
#include <cstdint>

#ifndef N_LAUNCHES
#define N_LAUNCHES 1
#endif

#define XB_TMO      128
#define XB_XCNT(j)  (256  + 64 * (j))
#define XB_XSUB(j)  (1280 + 64 * (j))
#define XB_XGEN(j)  (2304 + 64 * (j))
#define XB_TOP      3328
#define XB_TOPGEN   3392
#define XCD_BAR_WORDS 3456
#define XB_SPIN_CAP (1u << 21)
#define LAS __attribute__((address_space(3)))

__device__ __forceinline__ unsigned xb_ld(unsigned* p)              { return __hip_atomic_load(p, __ATOMIC_RELAXED, __HIP_MEMORY_SCOPE_AGENT); }
__device__ __forceinline__ unsigned xb_add(unsigned* p, unsigned v) { return __hip_atomic_fetch_add(p, v, __ATOMIC_RELAXED, __HIP_MEMORY_SCOPE_AGENT); }
__device__ __forceinline__ unsigned xb_xcc_id() { return (unsigned)__builtin_amdgcn_s_getreg((3 << 11) | 20) & 0xFu; }
#define XB_SPIN(cond, bar) do { unsigned _sp = 0; while (cond) { __builtin_amdgcn_s_sleep(1); \
    if ((++_sp & 255u) == 0u) { if (xb_ld(&(bar)[XB_TMO])) break; if (_sp > XB_SPIN_CAP) { atomicAdd(&(bar)[XB_TMO], 1u); break; } } } } while (0)

struct XcdBarrier { unsigned* bar; unsigned x; volatile LAS unsigned* st; };

__device__ __forceinline__ XcdBarrier xcd_barrier_post(unsigned* bar, volatile LAS unsigned* st) {
    XcdBarrier b; b.bar = bar; b.x = xb_xcc_id(); b.st = st;
    if (threadIdx.x == 0) (void)xb_add(&bar[XB_XCNT(b.x)], 1u);
    return b;
}
__device__ __forceinline__ void xcd_barrier_complete(unsigned* bar, unsigned x, unsigned& nloc, unsigned& nx) {
    const unsigned G = gridDim.x * gridDim.y * gridDim.z;
    unsigned sum, cnt, mine, sp = 0u;
    for (;;) {
        sum = 0u; cnt = 0u; mine = 0u;
#pragma unroll
        for (unsigned j = 0; j < 16; ++j) { const unsigned c = xb_ld(&bar[XB_XCNT(j)]); sum += c; cnt += (c > 0u) ? 1u : 0u; mine = (j == x) ? c : mine; }
        if (sum == G) break;
        __builtin_amdgcn_s_sleep(1);
        if ((++sp & 255u) == 0u) { if (xb_ld(&bar[XB_TMO])) break; if (sp > XB_SPIN_CAP) { atomicAdd(&bar[XB_TMO], 1u); break; } }
    }
    nloc = mine > 0u ? mine : 1u; nx = cnt > 0u ? cnt : 1u;
}
__device__ __forceinline__ void xcd_barrier(const XcdBarrier& b) {
    asm volatile("s_waitcnt vmcnt(0)" ::: "memory");
    __syncthreads();
    if (threadIdx.x == 0) {
        unsigned* bar = b.bar;
        __builtin_amdgcn_s_waitcnt(0);
        unsigned nloc = b.st[0], nx = b.st[1];
        if (nloc == 0u) { xcd_barrier_complete(bar, b.x, nloc, nx); b.st[0] = nloc; b.st[1] = nx; }
        const unsigned old = xb_add(&bar[XB_XSUB(b.x)], 1u);
        const unsigned gen = old / nloc;
        if (old + 1u == (gen + 1u) * nloc) {
            __builtin_amdgcn_fence(__ATOMIC_RELEASE, "agent");
            asm volatile("s_waitcnt vmcnt(0)" ::: "memory");
            const unsigned og = xb_add(&bar[XB_TOP], 1u);
            const unsigned tg = og / nx;
            if (og + 1u == (tg + 1u) * nx) xb_add(&bar[XB_TOPGEN], 1u);
            else XB_SPIN(xb_ld(&bar[XB_TOPGEN]) == tg, bar);
            __builtin_amdgcn_fence(__ATOMIC_ACQUIRE, "agent");
            xb_add(&bar[XB_XGEN(b.x)], 1u);
            asm volatile("s_waitcnt vmcnt(0)" ::: "memory");
        } else {
            XB_SPIN(xb_ld(&bar[XB_XGEN(b.x)]) == gen, bar);
            __builtin_amdgcn_fence(__ATOMIC_ACQUIRE, "agent");
            asm volatile("s_waitcnt vmcnt(0)" ::: "memory");
        }
    }
    __syncthreads();
}

typedef unsigned short bf16_t;
constexpr int NB = 4, SEQ = 2048, DM = 2048, NT = NB * SEQ;
constexpr int NH = 8, NG = 2, HD = 128, INW = 3608, INWP = 3840;
constexpr int NCMP = 127, NSEL = 32, NEXP = 32, FF = 512;
constexpr float EPS = 1e-6f;
constexpr float SCALE = 0.08838834764831845f;
constexpr int NTHREADS = 512, NWAVES = 8;
constexpr int LDS_BYTES = 147456;
constexpr int YROWS = 24576;

enum { I_X = 0, I_POS, I_LNMIX, I_WIN, I_PEK, I_WK1, I_WK2, I_PEV, I_WV1, I_WV2, I_WPOOL, I_BPOOL, I_PSCALE, I_GNNSA, I_GNPOOL, I_WOUT, I_LNMOE,
       I_WRG, I_BRG, I_WRE, I_BRE, I_WGATE, I_WUP, I_WDOWN, I_LNFINAL, N_IN };

constexpr size_t MB = 1024 * 1024;
constexpr size_t WS_CTL   = 0;
constexpr size_t CTL_ZERO_BYTES = 32768;
constexpr int    CW_CNT   = 4096;
constexpr size_t WS_RSTD1 = 1 * MB;
constexpr size_t WS_RSTD2 = 1 * MB + 65536;
constexpr size_t WS_BIAS1 = 1 * MB + 131072;
constexpr size_t WS_AROW  = 1 * MB + 262144;
constexpr size_t WS_ROPEC = 2 * MB;
constexpr size_t WS_ROPES = 2 * MB + 524288;
constexpr size_t WS_GATES = 3 * MB;
constexpr size_t WS_TOKL  = 4 * MB;
constexpr size_t WS_GATEL = 5 * MB;
constexpr size_t WS_HID   = 6 * MB;
constexpr size_t WS_CMPKV = 8 * MB;
constexpr size_t WS_WINT  = 9 * MB;
constexpr size_t WS_WOUTT = 24 * MB;
constexpr size_t WS_W1T   = 32 * MB;
constexpr size_t WS_W2T   = 160 * MB;
constexpr size_t WS_CMPW  = 224 * MB;
constexpr size_t WS_XB    = 230 * MB;
constexpr size_t WS_QN    = 262 * MB;
constexpr size_t WS_QR    = 278 * MB;
constexpr size_t WS_KV    = 294 * MB;
constexpr size_t WS_U     = 319 * MB;
constexpr size_t WS_Y     = 230 * MB;
constexpr size_t WS_OWIN  = 351 * MB;
constexpr size_t WS_ONSA  = 367 * MB;
constexpr size_t WS_X1B   = 351 * MB;
constexpr size_t WS_OPOOL = 383 * MB;
constexpr size_t WS_ACT   = 383 * MB;
constexpr size_t WS_MIX   = 415 * MB;
constexpr size_t WS_END   = 447 * MB;

__device__ __forceinline__ bf16_t f2bf(float f) { unsigned u = __float_as_uint(f); u += 0x7FFFu + ((u >> 16) & 1u); return (bf16_t)(u >> 16); }
__device__ __forceinline__ float bf2f(bf16_t b) { return __uint_as_float(((unsigned)b) << 16); }
__device__ __forceinline__ float wave_sum(float v) {
#pragma unroll
    for (int o = 32; o >= 1; o >>= 1) v += __shfl_xor(v, o);
    return v;
}
__device__ __forceinline__ float wave_max(float v) {
#pragma unroll
    for (int o = 32; o >= 1; o >>= 1) v = fmaxf(v, __shfl_xor(v, o));
    return v;
}

struct Args { const float* in[N_IN]; float* out; unsigned char* ws; int ph_lo, ph_hi; };

struct Frame {
    const float* in[N_IN]; float* out; unsigned char* ws;
    float* lds;
    int tid, lane, wave, G, bid;
};

template <int NACC, bool B_KFAST, class FA, class FB, class FE>
__device__ __forceinline__ void ngemm_tile(const Frame& F, int K, FA fa, FB fb, FE fe) {
    float* As = F.lds;
    float* Bs = F.lds + 1024;
    const int tid = F.tid, ty = tid >> 4, tx = tid & 15;
    float acc[NACC][2][4];
#pragma unroll
    for (int w = 0; w < NACC; ++w)
#pragma unroll
        for (int i = 0; i < 2; ++i)
#pragma unroll
            for (int j = 0; j < 4; ++j) acc[w][i][j] = 0.f;
    for (int k0 = 0; k0 < K; k0 += 16) {
#pragma unroll
        for (int i = 0; i < 2; ++i) { const int idx = tid + 512 * i, m = idx >> 4, kk = idx & 15; As[kk * 64 + m] = fa(m, k0 + kk); }
#pragma unroll
        for (int w = 0; w < NACC; ++w)
#pragma unroll
            for (int i = 0; i < 2; ++i) { const int idx = tid + 512 * i; int kk, n; if (B_KFAST) { n = idx >> 4; kk = idx & 15; } else { kk = idx >> 6; n = idx & 63; }
                Bs[w * 1024 + kk * 64 + n] = fb(w, k0 + kk, n); }
        __syncthreads();
#pragma unroll
        for (int kk = 0; kk < 16; ++kk) {
            const float a0 = As[kk * 64 + 2 * ty], a1 = As[kk * 64 + 2 * ty + 1];
#pragma unroll
            for (int w = 0; w < NACC; ++w) {
                const float4 b = *(const float4*)&Bs[w * 1024 + kk * 64 + 4 * tx];
                acc[w][0][0] += a0 * b.x; acc[w][0][1] += a0 * b.y; acc[w][0][2] += a0 * b.z; acc[w][0][3] += a0 * b.w;
                acc[w][1][0] += a1 * b.x; acc[w][1][1] += a1 * b.y; acc[w][1][2] += a1 * b.z; acc[w][1][3] += a1 * b.w;
            }
        }
        __syncthreads();
    }
#pragma unroll
    for (int i = 0; i < 2; ++i)
#pragma unroll
        for (int j = 0; j < 4; ++j) fe(2 * ty + i, 4 * tx + j, acc[0][i][j], acc[NACC - 1][i][j]);
}

template <class KR>
__device__ __forceinline__ void nattn(const float* qv, float* sc, int nkeys, KR keyrow, const bf16_t* Kb, const bf16_t* Vb, int lane, float& o0, float& o1, float& inv_sum) {
    float mx = -3.0e38f;
    for (int i = lane; i < nkeys; i += 64) {
        const int kr = keyrow(i);
        float s = -3.0e38f;
        if (kr >= 0) {
            const bf16_t* kp = Kb + (size_t)kr * HD;
            float a = 0.f;
#pragma unroll 8
            for (int d = 0; d < HD; d += 2) { const unsigned w = *(const unsigned*)(kp + d); a += qv[d] * __uint_as_float(w << 16) + qv[d + 1] * __uint_as_float(w & 0xFFFF0000u); }
            s = a * SCALE;
        }
        sc[i] = s; mx = fmaxf(mx, s);
    }
    mx = wave_max(mx);
    if (mx < -1.0e38f) { o0 = 0.f; o1 = 0.f; inv_sum = 0.f; for (int i = lane; i < nkeys; i += 64) sc[i] = 0.f; return; }
    float sum = 0.f;
    for (int i = lane; i < nkeys; i += 64) { const float s = sc[i]; const float e = (s < -1.0e38f) ? 0.f : __expf(s - mx); sc[i] = e; sum += e; }
    sum = wave_sum(sum);
    inv_sum = 1.f / sum;
    float a0 = 0.f, a1 = 0.f;
    for (int i = 0; i < nkeys; ++i) {
        const float p = sc[i];
        if (p != 0.f) { const int kr = keyrow(i); const bf16_t* vp = Vb + (size_t)kr * HD; a0 += p * bf2f(vp[lane]); a1 += p * bf2f(vp[lane + 64]); }
    }
    o0 = a0 * inv_sum; o1 = a1 * inv_sum;
}

__device__ __forceinline__ float gelu_tanh(float x) { const float u = 0.7978845608028654f * (x + 0.044715f * x * x * x); return 0.5f * x * (1.f + tanhf(u)); }

__device__ __forceinline__ void p0_prologue(const Frame& F) {
    const float* x = F.in[I_X];
    bf16_t* xb = (bf16_t*)(F.ws + WS_XB); float* rstd1 = (float*)(F.ws + WS_RSTD1);
    const int gw = F.bid * NWAVES + F.wave, nw = F.G * NWAVES, lane = F.lane;
    for (int r = gw; r < NT; r += nw) {
        float4 v[8]; float ss = 0.f;
#pragma unroll
        for (int i = 0; i < 8; ++i) { v[i] = *(const float4*)(x + (size_t)r * DM + i * 256 + lane * 4); ss += v[i].x * v[i].x + v[i].y * v[i].y + v[i].z * v[i].z + v[i].w * v[i].w; }
        ss = wave_sum(ss);
        if (lane == 0) rstd1[r] = rsqrtf(ss * (1.f / DM) + EPS);
#pragma unroll
        for (int i = 0; i < 8; ++i) { uint2 w; w.x = f2bf(v[i].x) | ((unsigned)f2bf(v[i].y) << 16); w.y = f2bf(v[i].z) | ((unsigned)f2bf(v[i].w) << 16);
            *(uint2*)(xb + (size_t)r * DM + i * 256 + lane * 4) = w; }
    }
    {
        const float* w_in = F.in[I_WIN]; const float* ln = F.in[I_LNMIX]; bf16_t* wt = (bf16_t*)(F.ws + WS_WINT);
        const size_t total = (size_t)INWP * DM, nth = (size_t)F.G * NTHREADS;
        for (size_t idx = (size_t)F.bid * NTHREADS + F.tid; idx < total; idx += nth) {
            const int n = (int)(idx >> 11), k = (int)(idx & 2047);
            int src = -1;
            if (n < 2560) src = n; else if (n < 3584) src = 2584 + (n - 2560); else if (n < 3608) src = 2560 + (n - 3584);
            wt[idx] = src >= 0 ? f2bf(ln[k] * w_in[(size_t)k * INW + src]) : (bf16_t)0;
        }
    }
    {
        const int* pos = (const int*)F.in[I_POS]; float* rc = (float*)(F.ws + WS_ROPEC); float* rs = (float*)(F.ws + WS_ROPES);
        for (int idx = F.bid * NTHREADS + F.tid; idx < NB * SEQ * 16; idx += F.G * NTHREADS) {
            const int i = idx & 15, bs = idx >> 4;
            const float inv = exp2f(-(float)i * (1.f / 16.f) * 18.931568569324174f);
            const float ang = (float)pos[bs] * inv;
            rc[idx] = cosf(ang); rs[idx] = sinf(ang);
        }
    }
    for (int it = F.bid; it < 8; it += F.G) {
        const int kv = it >> 2, jb = it & 3;
        const float* pe = F.in[kv ? I_PEV : I_PEK]; const float* w1 = F.in[kv ? I_WV1 : I_WK1];
        const int mg = F.tid >> 6, j = jb * 64 + (F.tid & 63);
        float a = 0.f;
        for (int m = mg; m < 4096; m += 8) a += pe[m] * w1[(size_t)m * 256 + j];
        __syncthreads();
        F.lds[F.tid] = a;
        __syncthreads();
        if (F.tid < 64) { float s = 0.f; for (int q = 0; q < 8; ++q) s += F.lds[q * 64 + F.tid]; ((float*)(F.ws + WS_BIAS1))[kv * 256 + j] = s; }
        __syncthreads();
    }
}

__device__ __forceinline__ void p1_proj(const Frame& F) {
    const bf16_t* xb = (const bf16_t*)(F.ws + WS_XB); const bf16_t* wt = (const bf16_t*)(F.ws + WS_WINT); const float* rstd1 = (const float*)(F.ws + WS_RSTD1);
    bf16_t* qn = (bf16_t*)(F.ws + WS_QN); bf16_t* kv = (bf16_t*)(F.ws + WS_KV); float* u = (float*)(F.ws + WS_U); float* gates = (float*)(F.ws + WS_GATES);
    const int ntn = (INW + 63) / 64, ntiles = (NT / 64) * ntn;
    for (int t = F.bid; t < ntiles; t += F.G) {
        const int m0 = (t / ntn) * 64, n0 = (t % ntn) * 64;
        ngemm_tile<1, true>(F, DM,
            [&](int m, int k) { return bf2f(xb[(size_t)(m0 + m) * DM + k]); },
            [&](int, int k, int n) { return bf2f(wt[(size_t)(n0 + n) * DM + k]); },
            [&](int m, int n, float acc, float) {
                const int row = m0 + m, nn = n0 + n; const float v = acc * rstd1[row]; const int b = row >> 11, s = row & 2047;
                if (nn < 1024) { const int h = nn >> 7, d = nn & 127; qn[(((size_t)b * NH + h) * SEQ + s) * HD + d] = f2bf(v); }
                else if (nn < 2560) { const int c = nn - 1024, which = c >> 8, g = (c >> 7) & 1, d = c & 127; kv[(size_t)which * (4 * MB / 2) + (((size_t)b * NG + g) * SEQ + s) * HD + d] = f2bf(v); }
                else if (nn < 3584) u[(size_t)row * 1024 + (nn - 2560)] = v;
                else if (nn < 3608) gates[(size_t)row * 24 + (nn - 3584)] = v;
            });
    }
}

__device__ __forceinline__ void p2_rope(const Frame& F) {
    const bf16_t* qn = (const bf16_t*)(F.ws + WS_QN); bf16_t* qr = (bf16_t*)(F.ws + WS_QR); bf16_t* kv = (bf16_t*)(F.ws + WS_KV);
    const float* rc = (const float*)(F.ws + WS_ROPEC); const float* rs = (const float*)(F.ws + WS_ROPES);
    const size_t nth = (size_t)F.G * NTHREADS, gt = (size_t)F.bid * NTHREADS + F.tid;
    for (size_t idx = gt; idx < (size_t)NB * NH * SEQ * HD; idx += nth) {
        const int d = (int)(idx & 127); const size_t rowi = idx >> 7; const int s = (int)(rowi & 2047); const int b = (int)(rowi >> 14);
        float o;
        if (d < 32) { const int i = d & 15; const float c = rc[(b * SEQ + s) * 16 + i], sn = rs[(b * SEQ + s) * 16 + i];
            const float x1 = bf2f(qn[rowi * HD + i]), x2 = bf2f(qn[rowi * HD + 16 + i]);
            o = (d < 16) ? (x1 * c - x2 * sn) : (x2 * c + x1 * sn); }
        else o = bf2f(qn[idx]);
        qr[idx] = f2bf(o);
    }
    for (size_t idx = gt; idx < (size_t)2 * NB * NG * SEQ * 16; idx += nth) {
        const int i = (int)(idx & 15); size_t r = idx >> 4; const int w = (int)(r / ((size_t)NB * NG * SEQ)); r -= (size_t)w * NB * NG * SEQ;
        const int s = (int)(r & 2047), b = (int)(r >> 12);
        bf16_t* p = kv + (size_t)(w ? 4 : 2) * (4 * MB / 2) + r * HD;
        const float c = rc[(b * SEQ + s) * 16 + i], sn = rs[(b * SEQ + s) * 16 + i];
        const float x1 = bf2f(p[i]), x2 = bf2f(p[16 + i]);
        p[i] = f2bf(x1 * c - x2 * sn); p[16 + i] = f2bf(x2 * c + x1 * sn);
    }
}

__device__ __forceinline__ void p3_mid(const Frame& F) {
    const bf16_t* kv = (const bf16_t*)(F.ws + WS_KV);
    {
        float* hid = (float*)(F.ws + WS_HID); const float* bias1 = (const float*)(F.ws + WS_BIAS1);
        for (int t = F.bid; t < 2 * 16 * 4; t += F.G) {
            const int kvi = t >> 6, m0 = ((t >> 2) & 15) * 64, n0 = (t & 3) * 64;
            const bf16_t* A = kv + (size_t)kvi * (4 * MB / 2); const float* w1 = F.in[kvi ? I_WV1 : I_WK1];
            ngemm_tile<1, false>(F, 4096,
                [&](int m, int k) { return bf2f(A[(size_t)(m0 + m) * 2048 + k]); },
                [&](int, int k, int n) { return w1[(size_t)k * 256 + n0 + n]; },
                [&](int m, int n, float acc, float) { hid[((size_t)kvi * 1024 + m0 + m) * 256 + n0 + n] = gelu_tanh(acc + bias1[kvi * 256 + n0 + n]); });
        }
    }
    {
        const bf16_t* qr = (const bf16_t*)(F.ws + WS_QR); bf16_t* owin = (bf16_t*)(F.ws + WS_OWIN);
        float* qv = F.lds + 4096 + F.wave * 128; float* sc = F.lds + 4096 + 1024 + F.wave * 1024;
        const int gw = F.bid * NWAVES + F.wave, nw = F.G * NWAVES, lane = F.lane;
        for (int it = gw; it < NB * NH * SEQ; it += nw) {
            const int t = it & 2047, h = (it >> 11) & 7, b = it >> 14, g = h >> 2;
            const bf16_t* qp = qr + (((size_t)b * NH + h) * SEQ + t) * HD;
            qv[lane] = bf2f(qp[lane]); qv[lane + 64] = bf2f(qp[lane + 64]);
            const bf16_t* Kb = kv + (size_t)4 * (4 * MB / 2) + ((size_t)b * NG + g) * SEQ * HD;
            const bf16_t* Vb = kv + (size_t)5 * (4 * MB / 2) + ((size_t)b * NG + g) * SEQ * HD;
            const int lo = t - 511 > 0 ? t - 511 : 0, nk = t - lo + 1;
            float o0, o1, inv;
            nattn(qv, sc, nk, [&](int i) { return lo + i; }, Kb, Vb, lane, o0, o1, inv);
            bf16_t* op = owin + ((size_t)b * SEQ + t) * 1024 + h * HD;
            op[lane] = f2bf(o0); op[lane + 64] = f2bf(o1);
        }
    }
    __syncthreads();
    {
        const float* u = (const float*)(F.ws + WS_U); float* opool = (float*)(F.ws + WS_OPOOL);
        const float* wp = F.in[I_WPOOL]; const float* bp = F.in[I_BPOOL]; const float* ps = F.in[I_PSCALE];
        for (int t = F.bid; t < 128 * 4 * 4; t += F.G) {
            const int m0 = (t >> 4) * 64, gi = (t >> 2) & 3, n0 = (t & 3) * 64, w = 2 << gi;
            ngemm_tile<1, false>(F, 256,
                [&](int m, int k) { const int row = m0 + m, s = row & 2047, c = gi * 256 + k; const int cnt = (s + 1 < w) ? s + 1 : w; float sum = 0.f;
                    for (int q = 0; q < cnt; ++q) sum += u[(size_t)(row - q) * 1024 + c];
                    return sum / (float)cnt - u[(size_t)row * 1024 + c]; },
                [&](int, int k, int n) { return wp[((size_t)gi * 256 + k) * 256 + n0 + n]; },
                [&](int m, int n, float acc, float) { const int c = gi * 256 + n0 + n; opool[(size_t)(m0 + m) * 1024 + c] = (acc + bp[c]) * ps[c]; });
        }
    }
}

__device__ __forceinline__ void p4_cmp2(const Frame& F) {
    const float* hid = (const float*)(F.ws + WS_HID); bf16_t* ckv = (bf16_t*)(F.ws + WS_CMPKV);
    for (int t = F.bid; t < 2 * 16 * 2; t += F.G) {
        const int kvi = t >> 5, m0 = ((t >> 1) & 15) * 64, n0 = (t & 1) * 64;
        const float* w2 = F.in[kvi ? I_WV2 : I_WK2];
        ngemm_tile<1, false>(F, 256,
            [&](int m, int k) { return hid[((size_t)kvi * 1024 + m0 + m) * 256 + k]; },
            [&](int, int k, int n) { return w2[(size_t)k * 128 + n0 + n]; },
            [&](int m, int n, float acc, float) { const int R = m0 + m; ckv[((size_t)kvi * 1024 + R) * 128 + n0 + n] = ((R & 127) == 127) ? (bf16_t)0 : f2bf(acc); });
    }
}

__device__ __forceinline__ void p5_nsa(const Frame& F) {
    const bf16_t* qn = (const bf16_t*)(F.ws + WS_QN); const bf16_t* qr = (const bf16_t*)(F.ws + WS_QR); const bf16_t* kv = (const bf16_t*)(F.ws + WS_KV);
    const bf16_t* ckv = (const bf16_t*)(F.ws + WS_CMPKV); const bf16_t* owin = (const bf16_t*)(F.ws + WS_OWIN); bf16_t* onsa = (bf16_t*)(F.ws + WS_ONSA);
    const float* gates = (const float*)(F.ws + WS_GATES);
    float* qv = F.lds + 4096 + F.wave * 128; float* sc = F.lds + 4096 + 1024 + F.wave * 1024; float* pc = F.lds + 4096 + 1024 + 8192 + F.wave * 512;
    int* blk = (int*)(F.lds + 4096 + 1024 + 8192 + 4096) + F.wave * 16;
    const int gw = F.bid * NWAVES + F.wave, nw = F.G * NWAVES, lane = F.lane;
    for (int it = gw; it < NB * NG * SEQ; it += nw) {
        const int t = it & 2047, g = (it >> 11) & 1, b = it >> 12, tok = b * SEQ + t;
        const int nvalid = t >= 31 ? (((t - 31) >> 4) + 1 > NCMP ? NCMP : ((t - 31) >> 4) + 1) : 0;
        const bf16_t* Kc = ckv + ((size_t)b * NG + g) * 128 * HD; const bf16_t* Vc = ckv + (size_t)1024 * HD + ((size_t)b * NG + g) * 128 * HD;
        float oc[4][2];
        for (int r = 0; r < 4; ++r) {
            const int h = g * 4 + r; const bf16_t* qp = qn + (((size_t)b * NH + h) * SEQ + t) * HD;
            qv[lane] = bf2f(qp[lane]); qv[lane + 64] = bf2f(qp[lane + 64]);
            float inv;
            nattn(qv, sc, nvalid, [&](int i) { return i; }, Kc, Vc, lane, oc[r][0], oc[r][1], inv);
            pc[r * 128 + lane] = lane < nvalid ? sc[lane] * inv : 0.f;
            pc[r * 128 + lane + 64] = (lane + 64) < nvalid ? sc[lane + 64] * inv : 0.f;
        }
        float val = -3.0e38f;
        if (lane < 32) {
            const int j = lane; float imp = 0.f;
            for (int r = 0; r < 4; ++r) {
                const float* p = pc + r * 128;
                float a = 0.f;
                if (4 * j - 1 >= 0) a += 0.5f * p[4 * j - 1];
                a += p[4 * j] + p[4 * j + 1] + p[4 * j + 2];
                if (4 * j + 3 < NCMP) a += 0.5f * p[4 * j + 3];
                imp += a;
            }
            const int cur = t >> 6; const bool ok = (64 * j <= t), forced = (j == 0) || (cur - j >= 0 && cur - j < 2);
            val = (ok && forced) ? 1.0e30f : (ok ? imp : -1.0e30f);
        }
        unsigned selmask = 0u;
        for (int round = 0; round < 16; ++round) {
            const float m = wave_max(val);
            const unsigned long long cand = __ballot(val == m);
            const int idx = __ffsll((long long)cand) - 1;
            if (m >= 0.f) selmask |= 1u << idx;
            if (lane == idx) val = -3.0e38f;
        }
        int nsel = 0;
        for (int j = 0; j < 32; ++j) if (selmask & (1u << j)) { if (lane == 0) blk[nsel] = j; ++nsel; }
        const bf16_t* Ks = kv + (size_t)2 * (4 * MB / 2) + ((size_t)b * NG + g) * SEQ * HD;
        const bf16_t* Vs = kv + (size_t)3 * (4 * MB / 2) + ((size_t)b * NG + g) * SEQ * HD;
        for (int r = 0; r < 4; ++r) {
            const int h = g * 4 + r; const bf16_t* qp = qr + (((size_t)b * NH + h) * SEQ + t) * HD;
            qv[lane] = bf2f(qp[lane]); qv[lane + 64] = bf2f(qp[lane + 64]);
            float o0, o1, inv;
            nattn(qv, sc, nsel * 64, [&](int i) { const int kp = blk[i >> 6] * 64 + (i & 63); return kp <= t ? kp : -1; }, Ks, Vs, lane, o0, o1, inv);
            const float* gp = gates + (size_t)tok * 24 + h * 3;
            const float g0 = 1.f / (1.f + __expf(-gp[0])), g1 = 1.f / (1.f + __expf(-gp[1])), g2 = 1.f / (1.f + __expf(-gp[2]));
            const bf16_t* wp = owin + (size_t)tok * 1024 + h * HD; bf16_t* op = onsa + (size_t)tok * 1024 + h * HD;
            op[lane] = f2bf(g0 * oc[r][0] + g1 * o0 + g2 * bf2f(wp[lane]));
            op[lane + 64] = f2bf(g0 * oc[r][1] + g1 * o1 + g2 * bf2f(wp[lane + 64]));
        }
    }
}

__device__ __forceinline__ void p6_mix(const Frame& F) {
    const bf16_t* onsa = (const bf16_t*)(F.ws + WS_ONSA); const float* opool = (const float*)(F.ws + WS_OPOOL); bf16_t* mix = (bf16_t*)(F.ws + WS_MIX);
    const float* gn = F.in[I_GNNSA]; const float* gp = F.in[I_GNPOOL];
    const int gw = F.bid * NWAVES + F.wave, nw = F.G * NWAVES, lane = F.lane;
    for (int r = gw; r < NT; r += nw) {
        float a[16], p[16]; float sa = 0.f, sp = 0.f;
#pragma unroll
        for (int i = 0; i < 16; ++i) { a[i] = bf2f(onsa[(size_t)r * 1024 + i * 64 + lane]); p[i] = opool[(size_t)r * 1024 + i * 64 + lane]; sa += a[i] * a[i]; sp += p[i] * p[i]; }
        sa = wave_sum(sa); sp = wave_sum(sp);
        const float ra = rsqrtf(sa * (1.f / 1024.f) + EPS), rp = rsqrtf(sp * (1.f / 1024.f) + EPS);
#pragma unroll
        for (int i = 0; i < 16; ++i) { const int c = i * 64 + lane; mix[(size_t)r * DM + c] = f2bf(a[i] * ra * gn[c]); mix[(size_t)r * DM + 1024 + c] = f2bf(p[i] * rp * gp[c]); }
    }
}

__device__ __forceinline__ void p7_out(const Frame& F) {
    const bf16_t* mix = (const bf16_t*)(F.ws + WS_MIX); const float* wo = F.in[I_WOUT]; const float* x = F.in[I_X]; bf16_t* x1b = (bf16_t*)(F.ws + WS_X1B);
    for (int t = F.bid; t < 128 * 32; t += F.G) {
        const int m0 = (t >> 5) * 64, n0 = (t & 31) * 64;
        ngemm_tile<1, false>(F, DM,
            [&](int m, int k) { return bf2f(mix[(size_t)(m0 + m) * DM + k]); },
            [&](int, int k, int n) { return wo[(size_t)k * DM + n0 + n]; },
            [&](int m, int n, float acc, float) { const size_t o = (size_t)(m0 + m) * DM + n0 + n; const float v = x[o] + acc; F.out[o] = v; x1b[o] = f2bf(v); });
    }
}

__device__ __forceinline__ void p8_router(const Frame& F) {
    const float* lnm = F.in[I_LNMOE]; const float* wrg = F.in[I_WRG]; const float* brg = F.in[I_BRG]; const float* wre = F.in[I_WRE]; const float* bre = F.in[I_BRE];
    float* rstd2 = (float*)(F.ws + WS_RSTD2); int* arow = (int*)(F.ws + WS_AROW); int* tokl = (int*)(F.ws + WS_TOKL); float* gatel = (float*)(F.ws + WS_GATEL);
    unsigned* cnt = (unsigned*)(F.ws + WS_CTL) + CW_CNT;
    const int gw = F.bid * NWAVES + F.wave, nw = F.G * NWAVES, lane = F.lane;
    for (int r = gw; r < NT; r += nw) {
        float h[32]; float ss = 0.f;
#pragma unroll
        for (int i = 0; i < 8; ++i) { const float4 v = *(const float4*)(F.out + (size_t)r * DM + i * 256 + lane * 4); h[4 * i] = v.x; h[4 * i + 1] = v.y; h[4 * i + 2] = v.z; h[4 * i + 3] = v.w;
            ss += v.x * v.x + v.y * v.y + v.z * v.z + v.w * v.w; }
        ss = wave_sum(ss);
        const float rs = rsqrtf(ss * (1.f / DM) + EPS);
        float lg[4] = {0.f, 0.f, 0.f, 0.f};
#pragma unroll
        for (int i = 0; i < 8; ++i)
#pragma unroll
            for (int c = 0; c < 4; ++c) { const int k = i * 256 + lane * 4 + c; h[4 * i + c] *= rs * lnm[k]; const float4 w = *(const float4*)(wrg + (size_t)k * 4);
                lg[0] += h[4 * i + c] * w.x; lg[1] += h[4 * i + c] * w.y; lg[2] += h[4 * i + c] * w.z; lg[3] += h[4 * i + c] * w.w; }
#pragma unroll
        for (int j = 0; j < 4; ++j) lg[j] = wave_sum(lg[j]) + brg[j];
        int gs = 0; float gm = lg[0];
#pragma unroll
        for (int j = 1; j < 4; ++j) if (lg[j] > gm) { gm = lg[j]; gs = j; }
        float den = 0.f;
#pragma unroll
        for (int j = 0; j < 4; ++j) den += __expf(lg[j] - gm);
        const float pg = 1.f / den;
        float le[8] = {0.f, 0.f, 0.f, 0.f, 0.f, 0.f, 0.f, 0.f};
#pragma unroll
        for (int i = 0; i < 8; ++i)
#pragma unroll
            for (int c = 0; c < 4; ++c) { const int k = i * 256 + lane * 4 + c; const float* w = wre + ((size_t)gs * DM + k) * 8; const float4 w0 = *(const float4*)w, w1 = *(const float4*)(w + 4);
                const float hv = h[4 * i + c];
                le[0] += hv * w0.x; le[1] += hv * w0.y; le[2] += hv * w0.z; le[3] += hv * w0.w; le[4] += hv * w1.x; le[5] += hv * w1.y; le[6] += hv * w1.z; le[7] += hv * w1.w; }
#pragma unroll
        for (int j = 0; j < 8; ++j) le[j] = wave_sum(le[j]) + bre[gs * 8 + j];
        int e0 = 0; float m0 = le[0];
#pragma unroll
        for (int j = 1; j < 8; ++j) if (le[j] > m0) { m0 = le[j]; e0 = j; }
        int e1 = -1; float m1 = -3.0e38f;
#pragma unroll
        for (int j = 0; j < 8; ++j) if (j != e0 && le[j] > m1) { m1 = le[j]; e1 = j; }
        const float p1 = __expf(m1 - m0);
        const float gate0 = pg / (1.f + p1), gate1 = pg * p1 / (1.f + p1);
        if (lane == 0) {
            rstd2[r] = rs;
            const int ea = gs * 8 + e0, eb = gs * 8 + e1;
            const unsigned sa = atomicAdd(&cnt[64 * ea], 1u), sb = atomicAdd(&cnt[64 * eb], 1u);
            tokl[ea * 8192 + sa] = r; gatel[ea * 8192 + sa] = gate0; tokl[eb * 8192 + sb] = r; gatel[eb * 8192 + sb] = gate1;
            arow[2 * r] = ea * 8192 + (int)sa; arow[2 * r + 1] = eb * 8192 + (int)sb;
        }
    }
}

__device__ __forceinline__ void moe_counts(const Frame& F, int* cnts  , int* pst  ) {
    const unsigned* cnt = (const unsigned*)(F.ws + WS_CTL) + CW_CNT;
    __syncthreads();
    if (F.tid < 32) cnts[F.tid] = (int)__hip_atomic_load(&cnt[64 * F.tid], __ATOMIC_RELAXED, __HIP_MEMORY_SCOPE_AGENT);
    __syncthreads();
    if (F.tid == 0) { int a = 0; for (int e = 0; e < 32; ++e) { pst[e] = a; a += (cnts[e] + 255) & ~255; } pst[32] = a; }
    __syncthreads();
}

__device__ __forceinline__ void p9_moe1(const Frame& F) {
    int* cnts = (int*)(F.lds + 3072); int* pst = cnts + 32; int* tks = pst + 40;
    moe_counts(F, cnts, pst);
    const bf16_t* x1b = (const bf16_t*)(F.ws + WS_X1B); const float* lnm = F.in[I_LNMOE]; const float* wg = F.in[I_WGATE]; const float* wu = F.in[I_WUP];
    const float* rstd2 = (const float*)(F.ws + WS_RSTD2); const int* tokl = (const int*)(F.ws + WS_TOKL); bf16_t* act = (bf16_t*)(F.ws + WS_ACT);
    int base = 0;
    for (int e = 0; e < NEXP; ++e) {
        const int ce = cnts[e], nmt = (ce + 63) >> 6, ntile = nmt * 8;
        int first = (F.bid - base % F.G + F.G) % F.G;
        for (int i = first; i < ntile; i += F.G) {
            const int mt = i >> 3, n0 = (i & 7) * 64;
            __syncthreads();
            if (F.tid < 64) { const int slot = mt * 64 + F.tid; tks[F.tid] = slot < ce ? tokl[e * 8192 + slot] : -1; }
            __syncthreads();
            ngemm_tile<2, false>(F, DM,
                [&](int m, int k) { const int tk = tks[m]; return tk >= 0 ? bf2f(x1b[(size_t)tk * DM + k]) : 0.f; },
                [&](int w, int k, int n) { return lnm[k] * (w ? wu : wg)[((size_t)e * DM + k) * FF + n0 + n]; },
                [&](int m, int n, float ag, float au) { const int tk = tks[m]; if (tk >= 0) { const float rs = rstd2[tk]; const float vg = ag * rs, vu = au * rs;
                    act[(size_t)(pst[e] + mt * 64 + m) * FF + n0 + n] = f2bf(vg / (1.f + __expf(-vg)) * vu); } });
        }
        base += ntile;
    }
}

__device__ __forceinline__ void p10_moe2(const Frame& F) {
    int* cnts = (int*)(F.lds + 3072); int* pst = cnts + 32;
    moe_counts(F, cnts, pst);
    const bf16_t* act = (const bf16_t*)(F.ws + WS_ACT); const float* wd = F.in[I_WDOWN]; const float* gatel = (const float*)(F.ws + WS_GATEL); bf16_t* y = (bf16_t*)(F.ws + WS_Y);
    int base = 0;
    for (int e = 0; e < NEXP; ++e) {
        const int ce = cnts[e], nmt = (ce + 63) >> 6, ntile = nmt * 32;
        int first = (F.bid - base % F.G + F.G) % F.G;
        for (int i = first; i < ntile; i += F.G) {
            const int mt = i >> 5, n0 = (i & 31) * 64;
            ngemm_tile<1, false>(F, FF,
                [&](int m, int k) { const int slot = mt * 64 + m; return slot < ce ? bf2f(act[(size_t)(pst[e] + slot) * FF + k]) : 0.f; },
                [&](int, int k, int n) { return wd[((size_t)e * FF + k) * DM + n0 + n]; },
                [&](int m, int n, float acc, float) { const int slot = mt * 64 + m; if (slot < ce) y[(size_t)(pst[e] + slot) * DM + n0 + n] = f2bf(acc * gatel[e * 8192 + slot]); });
        }
        base += ntile;
    }
}

__device__ __forceinline__ void p11_final(const Frame& F) {
    int* cnts = (int*)(F.lds + 3072); int* pst = cnts + 32;
    moe_counts(F, cnts, pst);
    const bf16_t* y = (const bf16_t*)(F.ws + WS_Y); const int* arow = (const int*)(F.ws + WS_AROW); const float* lnf = F.in[I_LNFINAL];
    const int gw = F.bid * NWAVES + F.wave, nw = F.G * NWAVES, lane = F.lane;
    for (int r = gw; r < NT; r += nw) {
        const int a0 = arow[2 * r], a1 = arow[2 * r + 1];
        const size_t r0 = (size_t)(pst[a0 >> 13] + (a0 & 8191)), r1 = (size_t)(pst[a1 >> 13] + (a1 & 8191));
        float v[32]; float ss = 0.f;
#pragma unroll
        for (int i = 0; i < 8; ++i) { const int c = i * 256 + lane * 4; const float4 xv = *(const float4*)(F.out + (size_t)r * DM + c);
            const uint2 ya = *(const uint2*)(y + r0 * DM + c), yb = *(const uint2*)(y + r1 * DM + c);
            v[4 * i]     = xv.x + __uint_as_float(ya.x << 16) + __uint_as_float(yb.x << 16);
            v[4 * i + 1] = xv.y + __uint_as_float(ya.x & 0xFFFF0000u) + __uint_as_float(yb.x & 0xFFFF0000u);
            v[4 * i + 2] = xv.z + __uint_as_float(ya.y << 16) + __uint_as_float(yb.y << 16);
            v[4 * i + 3] = xv.w + __uint_as_float(ya.y & 0xFFFF0000u) + __uint_as_float(yb.y & 0xFFFF0000u);
            ss += v[4 * i] * v[4 * i] + v[4 * i + 1] * v[4 * i + 1] + v[4 * i + 2] * v[4 * i + 2] + v[4 * i + 3] * v[4 * i + 3]; }
        ss = wave_sum(ss);
        const float rs = rsqrtf(ss * (1.f / DM) + EPS);
#pragma unroll
        for (int i = 0; i < 8; ++i) { const int c = i * 256 + lane * 4; const float4 g = *(const float4*)(lnf + c);
            float4 o; o.x = v[4 * i] * rs * g.x; o.y = v[4 * i + 1] * rs * g.y; o.z = v[4 * i + 2] * rs * g.z; o.w = v[4 * i + 3] * rs * g.w;
            *(float4*)(F.out + (size_t)r * DM + c) = o; }
    }
}

constexpr int NPHASE = 12;
__global__ void __launch_bounds__(NTHREADS, 2) fwd(Args args) {
    extern __shared__ __attribute__((aligned(16))) unsigned char lds_raw[];
    Frame F;
#pragma unroll
    for (int i = 0; i < N_IN; ++i) F.in[i] = args.in[i];
    F.out = args.out; F.ws = args.ws;
    F.lds = (float*)(lds_raw + 16);
    F.tid = threadIdx.x; F.lane = F.tid & 63; F.wave = __builtin_amdgcn_readfirstlane(F.tid >> 6); F.G = gridDim.x; F.bid = blockIdx.x;
    if (F.tid < 4) ((LAS unsigned*)lds_raw)[F.tid] = 0u;
    __syncthreads();
    XcdBarrier bar; bar.bar = (unsigned*)(F.ws + WS_CTL); bar.x = 0; bar.st = nullptr;
    if (N_LAUNCHES == 1) bar = xcd_barrier_post((unsigned*)(F.ws + WS_CTL), (volatile LAS unsigned*)lds_raw);
    const int lo = args.ph_lo, hi = args.ph_hi;
#define IN(k) (lo <= (k) && (k) < hi)
#define SEAM(k) do { if (IN(k) && IN((k) + 1)) xcd_barrier(bar); } while (0)
    if (IN(0)) p0_prologue(F);
    SEAM(0);
    if (IN(1)) p1_proj(F);
    SEAM(1);
    if (IN(2)) p2_rope(F);
    SEAM(2);
    if (IN(3)) p3_mid(F);
    SEAM(3);
    if (IN(4)) p4_cmp2(F);
    SEAM(4);
    if (IN(5)) p5_nsa(F);
    SEAM(5);
    if (IN(6)) p6_mix(F);
    SEAM(6);
    if (IN(7)) p7_out(F);
    SEAM(7);
    if (IN(8)) p8_router(F);
    SEAM(8);
    if (IN(9)) p9_moe1(F);
    SEAM(9);
    if (IN(10)) p10_moe2(F);
    SEAM(10);
    if (IN(11)) p11_final(F);
#undef IN
#undef SEAM
}

extern "C" void kernel_launch(void* const* d_in, const int* in_sizes, int n_in, void* d_out, int out_size, void* d_ws, size_t ws_size, hipStream_t stream) {
    static int grid = 0;
    if (grid == 0) {
        if (n_in != N_IN || out_size != NT * DM || ws_size < WS_END) { fprintf(stderr, "kernel_launch: unexpected shapes: n_in %d out %d ws %zu (need %zu)\n", n_in, out_size, ws_size, (size_t)WS_END); grid = -1; return; }
        int dev = 0, cus = 0, per_cu = 0;
        if (hipGetDevice(&dev) != hipSuccess || hipDeviceGetAttribute(&cus, hipDeviceAttributeMultiprocessorCount, dev) != hipSuccess) { grid = -1; return; }
        if (hipFuncSetAttribute((const void*)fwd, hipFuncAttributeMaxDynamicSharedMemorySize, LDS_BYTES) != hipSuccess) { fprintf(stderr, "kernel_launch: hipFuncSetAttribute failed\n"); grid = -1; return; }
        if (hipOccupancyMaxActiveBlocksPerMultiprocessor(&per_cu, (const void*)fwd, NTHREADS, LDS_BYTES) != hipSuccess || per_cu < 1) { fprintf(stderr, "kernel_launch: occupancy query says %d\n", per_cu); }
        (void)hipGetLastError();
        grid = cus;
    }
    if (grid < 0) return;
    (void)in_sizes;
    hipMemsetAsync((char*)d_ws + WS_CTL, 0, CTL_ZERO_BYTES, stream);
    Args a{};
    for (int i = 0; i < N_IN; ++i) a.in[i] = (const float*)d_in[i];
    a.out = (float*)d_out; a.ws = (unsigned char*)d_ws;
    if (N_LAUNCHES == 1) { a.ph_lo = 0; a.ph_hi = NPHASE; hipLaunchKernelGGL(fwd, dim3(grid), dim3(NTHREADS), LDS_BYTES, stream, a); }
    else { for (int p = 0; p < NPHASE; ++p) { a.ph_lo = p; a.ph_hi = p + 1; hipLaunchKernelGGL(fwd, dim3(grid), dim3(NTHREADS), LDS_BYTES, stream, a); } }
}
```

```cpp
#include <hip/hip_runtime.h>
#include <cstdio>
#include <cstdint>

#ifndef N_LAUNCHES
#define N_LAUNCHES 1
#endif

#define XB_TMO      128
#define XB_XCNT(j)  (256  + 64 * (j))
#define XB_XSUB(j)  (1280 + 64 * (j))
#define XB_XGEN(j)  (2304 + 64 * (j))
#define XB_TOP      3328
#define XB_TOPGEN   3392
#define XCD_BAR_WORDS 3456
#define XB_SPIN_CAP (1u << 21)
#define LAS __attribute__((address_space(3)))

__device__ __forceinline__ unsigned xb_ld(unsigned* p)              { return __hip_atomic_load(p, __ATOMIC_RELAXED, __HIP_MEMORY_SCOPE_AGENT); }
__device__ __forceinline__ unsigned xb_add(unsigned* p, unsigned v) { return __hip_atomic_fetch_add(p, v, __ATOMIC_RELAXED, __HIP_MEMORY_SCOPE_AGENT); }
__device__ __forceinline__ unsigned xb_xcc_id() { return (unsigned)__builtin_amdgcn_s_getreg((3 << 11) | 20) & 0xFu; }
#define XB_SPIN(cond, bar) do { unsigned _sp = 0; while (cond) { __builtin_amdgcn_s_sleep(1); \
    if ((++_sp & 255u) == 0u) { if (xb_ld(&(bar)[XB_TMO])) break; if (_sp > XB_SPIN_CAP) { atomicAdd(&(bar)[XB_TMO], 1u); break; } } } } while (0)

struct XcdBarrier { unsigned* bar; unsigned x; volatile LAS unsigned* st; };

__device__ __forceinline__ XcdBarrier xcd_barrier_post(unsigned* bar, volatile LAS unsigned* st) {
    XcdBarrier b; b.bar = bar; b.x = xb_xcc_id(); b.st = st;
    if (threadIdx.x == 0) (void)xb_add(&bar[XB_XCNT(b.x)], 1u);
    return b;
}
__device__ __forceinline__ void xcd_barrier_complete(unsigned* bar, unsigned x, unsigned& nloc, unsigned& nx) {
    const unsigned G = gridDim.x * gridDim.y * gridDim.z;
    unsigned sum, cnt, mine, sp = 0u;
    for (;;) {
        sum = 0u; cnt = 0u; mine = 0u;
#pragma unroll
        for (unsigned j = 0; j < 16; ++j) { const unsigned c = xb_ld(&bar[XB_XCNT(j)]); sum += c; cnt += (c > 0u) ? 1u : 0u; mine = (j == x) ? c : mine; }
        if (sum == G) break;
        __builtin_amdgcn_s_sleep(1);
        if ((++sp & 255u) == 0u) { if (xb_ld(&bar[XB_TMO])) break; if (sp > XB_SPIN_CAP) { atomicAdd(&bar[XB_TMO], 1u); break; } }
    }
    nloc = mine > 0u ? mine : 1u; nx = cnt > 0u ? cnt : 1u;
}
__device__ __forceinline__ void xcd_barrier(const XcdBarrier& b) {
    asm volatile("s_waitcnt vmcnt(0)" ::: "memory");
    __syncthreads();
    if (threadIdx.x == 0) {
        unsigned* bar = b.bar;
        __builtin_amdgcn_s_waitcnt(0);
        unsigned nloc = b.st[0], nx = b.st[1];
        if (nloc == 0u) { xcd_barrier_complete(bar, b.x, nloc, nx); b.st[0] = nloc; b.st[1] = nx; }
        const unsigned old = xb_add(&bar[XB_XSUB(b.x)], 1u);
        const unsigned gen = old / nloc;
        if (old + 1u == (gen + 1u) * nloc) {
            __builtin_amdgcn_fence(__ATOMIC_RELEASE, "agent");
            asm volatile("s_waitcnt vmcnt(0)" ::: "memory");
            const unsigned og = xb_add(&bar[XB_TOP], 1u);
            const unsigned tg = og / nx;
            if (og + 1u == (tg + 1u) * nx) xb_add(&bar[XB_TOPGEN], 1u);
            else XB_SPIN(xb_ld(&bar[XB_TOPGEN]) == tg, bar);
            __builtin_amdgcn_fence(__ATOMIC_ACQUIRE, "agent");
            xb_add(&bar[XB_XGEN(b.x)], 1u);
            asm volatile("s_waitcnt vmcnt(0)" ::: "memory");
        } else {
            XB_SPIN(xb_ld(&bar[XB_XGEN(b.x)]) == gen, bar);
            __builtin_amdgcn_fence(__ATOMIC_ACQUIRE, "agent");
            asm volatile("s_waitcnt vmcnt(0)" ::: "memory");
        }
    }
    __syncthreads();
}

typedef unsigned short bf16_t;
constexpr int NB = 4, SEQ = 2048, DM = 2048, NT = NB * SEQ;
constexpr int NH = 8, NG = 2, HD = 128, INW = 3608, INWP = 3840;
constexpr int NCMP = 127, NSEL = 32, NEXP = 32, FF = 512;
constexpr float EPS = 1e-6f;
constexpr float SCALE = 0.08838834764831845f;
constexpr int NTHREADS = 512, NWAVES = 8;
constexpr int LDS_BYTES = 147456;
constexpr int YROWS = 24576;

enum { I_X = 0, I_POS, I_LNMIX, I_WIN, I_PEK, I_WK1, I_WK2, I_PEV, I_WV1, I_WV2, I_WPOOL, I_BPOOL, I_PSCALE, I_GNNSA, I_GNPOOL, I_WOUT, I_LNMOE,
       I_WRG, I_BRG, I_WRE, I_BRE, I_WGATE, I_WUP, I_WDOWN, I_LNFINAL, N_IN };

constexpr size_t MB = 1024 * 1024;
constexpr size_t WS_CTL   = 0;
constexpr size_t CTL_ZERO_BYTES = 32768;
constexpr int    CW_CNT   = 4096;
constexpr size_t WS_RSTD1 = 1 * MB;
constexpr size_t WS_RSTD2 = 1 * MB + 65536;
constexpr size_t WS_BIAS1 = 1 * MB + 131072;
constexpr size_t WS_AROW  = 1 * MB + 262144;
constexpr size_t WS_ROPEC = 2 * MB;
constexpr size_t WS_ROPES = 2 * MB + 524288;
constexpr size_t WS_GATES = 3 * MB;
constexpr size_t WS_TOKL  = 4 * MB;
constexpr size_t WS_GATEL = 5 * MB;
constexpr size_t WS_HID   = 6 * MB;
constexpr size_t WS_CMPKV = 8 * MB;
constexpr size_t WS_WINT  = 9 * MB;
constexpr size_t WS_WOUTT = 24 * MB;
constexpr size_t WS_W1T   = 32 * MB;
constexpr size_t WS_W2T   = 160 * MB;
constexpr size_t WS_CMPW  = 224 * MB;
constexpr size_t WS_XB    = 230 * MB;
constexpr size_t WS_QN    = 262 * MB;
constexpr size_t WS_QR    = 278 * MB;
constexpr size_t WS_KV    = 294 * MB;
constexpr size_t WS_U     = 319 * MB;
constexpr size_t WS_Y     = 230 * MB;
constexpr size_t WS_OWIN  = 351 * MB;
constexpr size_t WS_OCMP  = 367 * MB;
constexpr size_t WS_OSEL  = 319 * MB;
constexpr size_t WS_ML    = 6 * MB;
constexpr size_t WS_X1B   = 351 * MB;
constexpr size_t WS_OPOOL = 383 * MB;
constexpr size_t WS_ACT   = 383 * MB;
constexpr size_t WS_MIX   = 415 * MB;
constexpr size_t WS_END   = 447 * MB;

__device__ __forceinline__ bf16_t f2bf(float f) { unsigned u = __float_as_uint(f); u += 0x7FFFu + ((u >> 16) & 1u); return (bf16_t)(u >> 16); }
__device__ __forceinline__ float bf2f(bf16_t b) { return __uint_as_float(((unsigned)b) << 16); }
__device__ __forceinline__ float wave_sum(float v) {
#pragma unroll
    for (int o = 32; o >= 1; o >>= 1) v += __shfl_xor(v, o);
    return v;
}
__device__ __forceinline__ float wave_max(float v) {
#pragma unroll
    for (int o = 32; o >= 1; o >>= 1) v = fmaxf(v, __shfl_xor(v, o));
    return v;
}

struct Args { const float* in[N_IN]; float* out; unsigned char* ws; int ph_lo, ph_hi; };

struct Frame {
    const float* in[N_IN]; float* out; unsigned char* ws;
    float* lds;
    int tid, lane, wave, G, bid;
};

template <int NACC, bool B_KFAST, class FA, class FB, class FE>
__device__ __forceinline__ void ngemm_tile(const Frame& F, int K, FA fa, FB fb, FE fe) {
    float* As = F.lds;
    float* Bs = F.lds + 1024;
    const int tid = F.tid, ty = tid >> 4, tx = tid & 15;
    float acc[NACC][2][4];
#pragma unroll
    for (int w = 0; w < NACC; ++w)
#pragma unroll
        for (int i = 0; i < 2; ++i)
#pragma unroll
            for (int j = 0; j < 4; ++j) acc[w][i][j] = 0.f;
    for (int k0 = 0; k0 < K; k0 += 16) {
#pragma unroll
        for (int i = 0; i < 2; ++i) { const int idx = tid + 512 * i, m = idx >> 4, kk = idx & 15; As[kk * 64 + m] = fa(m, k0 + kk); }
#pragma unroll
        for (int w = 0; w < NACC; ++w)
#pragma unroll
            for (int i = 0; i < 2; ++i) { const int idx = tid + 512 * i; int kk, n; if (B_KFAST) { n = idx >> 4; kk = idx & 15; } else { kk = idx >> 6; n = idx & 63; }
                Bs[w * 1024 + kk * 64 + n] = fb(w, k0 + kk, n); }
        __syncthreads();
#pragma unroll
        for (int kk = 0; kk < 16; ++kk) {
            const float a0 = As[kk * 64 + 2 * ty], a1 = As[kk * 64 + 2 * ty + 1];
#pragma unroll
            for (int w = 0; w < NACC; ++w) {
                const float4 b = *(const float4*)&Bs[w * 1024 + kk * 64 + 4 * tx];
                acc[w][0][0] += a0 * b.x; acc[w][0][1] += a0 * b.y; acc[w][0][2] += a0 * b.z; acc[w][0][3] += a0 * b.w;
                acc[w][1][0] += a1 * b.x; acc[w][1][1] += a1 * b.y; acc[w][1][2] += a1 * b.z; acc[w][1][3] += a1 * b.w;
            }
        }
        __syncthreads();
    }
#pragma unroll
    for (int i = 0; i < 2; ++i)
#pragma unroll
        for (int j = 0; j < 4; ++j) fe(2 * ty + i, 4 * tx + j, acc[0][i][j], acc[NACC - 1][i][j]);
}

template <class KR>
__device__ __forceinline__ void nattn(const float* qv, float* sc, int nkeys, KR keyrow, const bf16_t* Kb, const bf16_t* Vb, int lane, float& o0, float& o1, float& inv_sum) {
    float mx = -3.0e38f;
    for (int i = lane; i < nkeys; i += 64) {
        const int kr = keyrow(i);
        float s = -3.0e38f;
        if (kr >= 0) {
            const bf16_t* kp = Kb + (size_t)kr * HD;
            float a = 0.f;
#pragma unroll 8
            for (int d = 0; d < HD; d += 2) { const unsigned w = *(const unsigned*)(kp + d); a += qv[d] * __uint_as_float(w << 16) + qv[d + 1] * __uint_as_float(w & 0xFFFF0000u); }
            s = a * SCALE;
        }
        sc[i] = s; mx = fmaxf(mx, s);
    }
    mx = wave_max(mx);
    if (mx < -1.0e38f) { o0 = 0.f; o1 = 0.f; inv_sum = 0.f; for (int i = lane; i < nkeys; i += 64) sc[i] = 0.f; return; }
    float sum = 0.f;
    for (int i = lane; i < nkeys; i += 64) { const float s = sc[i]; const float e = (s < -1.0e38f) ? 0.f : __expf(s - mx); sc[i] = e; sum += e; }
    sum = wave_sum(sum);
    inv_sum = 1.f / sum;
    float a0 = 0.f, a1 = 0.f;
    for (int i = 0; i < nkeys; ++i) {
        const float p = sc[i];
        if (p != 0.f) { const int kr = keyrow(i); const bf16_t* vp = Vb + (size_t)kr * HD; a0 += p * bf2f(vp[lane]); a1 += p * bf2f(vp[lane + 64]); }
    }
    o0 = a0 * inv_sum; o1 = a1 * inv_sum;
}

__device__ __forceinline__ float gelu_tanh(float x) { const float u = 0.7978845608028654f * (x + 0.044715f * x * x * x); return 0.5f * x * (1.f + tanhf(u)); }


namespace pg8 {
typedef short bf16x8 __attribute__((ext_vector_type(8)));
typedef float f32x4 __attribute__((ext_vector_type(4)));
typedef unsigned u32x4 __attribute__((ext_vector_type(4)));
constexpr int BM = 256, BK = 64, HALF = 128, HTB = HALF * BK * 2, STAGE_BYTES = 8 * HTB, NXCD = 8, WGM = 8;
__device__ __forceinline__ int lds_byte(int r, int c) { const int st = (r >> 4) * 2 + (c >> 5), rr = r & 15, cc = c & 31, ob = rr * 64 + cc * 2; return st * 1024 + (ob ^ (((ob >> 9) & 1) << 5)); }
__device__ __forceinline__ void stage_rc(int b, int& R, int& C) { const int st = b / 1024, sb = b % 1024, swz = sb ^ (((sb >> 9) & 1) << 5); R = (st >> 1) * 16 + swz / 64; C = (st & 1) * 32 + (swz % 64) / 2; }
struct Unit { int pm, pn, e, li; };
__device__ __forceinline__ unsigned cvt_pk_bf16(float lo, float hi) { unsigned r; asm volatile("v_cvt_pk_bf16_f32 %0, %1, %2" : "=v"(r) : "v"(lo), "v"(hi)); return r; }

struct DenseOrder {
    const char* A; const char* Bt; int lda, ldb; int nM, nN, nwg, G, c;
    __device__ void init(const void* A_, const void* Bt_, int lda_, int ldb_, int M, int N, int G_, int c_) { A = (const char*)A_; Bt = (const char*)Bt_; lda = lda_; ldb = ldb_; nM = M / BM; nN = N / BM; nwg = nM * nN; G = G_; c = c_; }
    __device__ __forceinline__ bool next(int i, Unit& u) const {
        const long L = (long)i * G + c; if (L >= nwg) return false;
        int wgid = (int)L; { const int q = nwg / NXCD, r = nwg % NXCD, xcd = wgid % NXCD, off = wgid / NXCD; wgid = (xcd < r ? xcd * (q + 1) : r * (q + 1) + (xcd - r) * q) + off; }
        const int nig = WGM * nN, gid = wgid / nig, fm = gid * WGM, gsz = (nM - fm) < WGM ? (nM - fm) : WGM;
        u.pm = fm + ((wgid % nig) % gsz); u.pn = (wgid % nig) / gsz; u.e = 0; u.li = i; return true;
    }
    __device__ __forceinline__ const char* a_base(const Unit& u) const { return A + (size_t)u.pm * BM * lda * 2; }
    __device__ __forceinline__ const char* b_base(const Unit& u) const { return Bt + (size_t)u.pn * BM * ldb * 2; }
    __device__ __forceinline__ unsigned a_row_off(const Unit&, int r) const { return (unsigned)r * (unsigned)lda * 2u; }
};

template <class Epi, class Sched, bool GATHER>
__device__ __forceinline__ void gemm_phase(LAS unsigned char* lds, const int K, const int lda, const int ldb, const Sched& S, const Epi& E) {
    const int tid = threadIdx.x, wid = __builtin_amdgcn_readfirstlane(tid >> 6), lane = tid & 63, wr = wid >> 2, wc = wid & 3, fr = lane & 15, fq = lane >> 4;
    const int nt = K / BK;
    int sR[2], sC[2];
#pragma unroll
    for (int i = 0; i < 2; ++i) stage_rc(tid * 16 + i * 8192, sR[i], sC[i]);
    unsigned voffB[2], voffA[2][2], nvoffA[2][2];
#pragma unroll
    for (int i = 0; i < 2; ++i) voffB[i] = (unsigned)(sR[i] * ldb + sC[i]) * 2u;
    const size_t kstep = (size_t)(BK * 2);
    const size_t hstepB = (size_t)HALF * ldb * 2;
    const unsigned ldsw = (unsigned)wid * 1024u;
    const int aoff = lds_byte(wr * 64 + fr, fq * 8), boff = lds_byte(wc * 32 + fr, fq * 8);
#define PG8_SA(b, h) (((b) * 2 + (h)) * HTB)
#define PG8_SB(b, h) ((4 + (b) * 2 + (h)) * HTB)
#define PG8_STAGE(bufoff, gbase, voff) do { _Pragma("unroll") for (int _i = 0; _i < 2; ++_i) \
        __builtin_amdgcn_global_load_lds((const unsigned*)((const char*)(gbase) + (voff)[_i]), (LAS unsigned*)(lds + (bufoff) + ldsw + _i * 8192), 16, 0, 0); } while (0)
#define PG8_LDA(dst, b, h) do { _Pragma("unroll") for (int m = 0; m < 4; ++m) _Pragma("unroll") for (int k = 0; k < 2; ++k) dst[m][k] = *(const LAS bf16x8*)(lds + PG8_SA(b, h) + aoff + m * 2048 + k * 1024); } while (0)
#define PG8_LDB(dst, b, h) do { _Pragma("unroll") for (int n = 0; n < 2; ++n) _Pragma("unroll") for (int k = 0; k < 2; ++k) dst[n][k] = *(const LAS bf16x8*)(lds + PG8_SB(b, h) + boff + n * 2048 + k * 1024); } while (0)
#define PG8_MMA(ai, bj, At, Bt) do { __builtin_amdgcn_s_setprio(1); _Pragma("unroll") for (int m = 0; m < 4; ++m) _Pragma("unroll") for (int n = 0; n < 2; ++n) _Pragma("unroll") for (int k = 0; k < 2; ++k) \
        acc[ai][bj][m][n] = __builtin_amdgcn_mfma_f32_16x16x32_bf16(Bt[n][k], At[m][k], acc[ai][bj][m][n], 0, 0, 0); __builtin_amdgcn_s_setprio(0); } while (0)
#define PG8_WAIT_V(n) asm volatile("s_waitcnt vmcnt(" #n ")" ::: "memory")
#define PG8_WAIT_L(n) asm volatile("s_waitcnt lgkmcnt(" #n ")" ::: "memory")
#define PG8_BAR __builtin_amdgcn_s_barrier()
#define PG8_SCHED __builtin_amdgcn_sched_barrier(0)
#define PG8_AOFFS(dst, u) do { _Pragma("unroll") for (int _h = 0; _h < 2; ++_h) _Pragma("unroll") for (int _i = 0; _i < 2; ++_i) dst[_h][_i] = S.a_row_off(u, _h * HALF + sR[_i]) + (unsigned)sC[_i] * 2u; } while (0)
    Unit cur, nxt; int ui = 0;
    if (!S.next(0, cur)) return;
    f32x4 acc[2][2][4][2];
#pragma unroll
    for (int a = 0; a < 2; ++a)
#pragma unroll
        for (int b = 0; b < 2; ++b)
#pragma unroll
            for (int m = 0; m < 4; ++m)
#pragma unroll
                for (int n = 0; n < 2; ++n) acc[a][b][m][n] = (f32x4){0.f, 0.f, 0.f, 0.f};
    bf16x8 At[4][2], B0[2][2], B1[2][2];
    const char* cA = S.a_base(cur); const char* cB = S.b_base(cur);
    PG8_AOFFS(voffA, cur);
    PG8_STAGE(PG8_SB(0, 0), cB, voffB); PG8_STAGE(PG8_SA(0, 0), cA, voffA[0]); PG8_STAGE(PG8_SB(0, 1), cB + hstepB, voffB); PG8_STAGE(PG8_SA(0, 1), cA, voffA[1]);
    if (wr == 1) PG8_BAR;
    PG8_WAIT_V(4); PG8_BAR;
    PG8_STAGE(PG8_SB(1, 0), cB + kstep, voffB); PG8_STAGE(PG8_SA(1, 0), cA + kstep, voffA[0]); PG8_STAGE(PG8_SB(1, 1), cB + hstepB + kstep, voffB);
    PG8_WAIT_V(6); PG8_BAR;
    for (;;) {
        const bool has_next = S.next(ui + 1, nxt);
        const char* nA = has_next ? S.a_base(nxt) : cA; const char* nB = has_next ? S.b_base(nxt) : cB;
        if (GATHER) { if (has_next) { PG8_AOFFS(nvoffA, nxt); } else {
#pragma unroll
            for (int _h = 0; _h < 2; ++_h)
#pragma unroll
                for (int _i = 0; _i < 2; ++_i) nvoffA[_h][_i] = voffA[_h][_i]; } }
        for (int t = 0; t < nt; t += 2) {
            const bool last = (t == nt - 2);
            const char* a1 = cA + (size_t)(t + 1) * kstep;
            const char* a2 = last ? nA : cA + (size_t)(t + 2) * kstep; const char* b2 = last ? nB : cB + (size_t)(t + 2) * kstep;
            const char* a3 = a2 + kstep; const char* b3 = b2 + kstep;
            unsigned vA2[2][2];
#pragma unroll
            for (int _h = 0; _h < 2; ++_h)
#pragma unroll
                for (int _i = 0; _i < 2; ++_i) vA2[_h][_i] = (GATHER && last) ? nvoffA[_h][_i] : voffA[_h][_i];
            PG8_LDB(B0, 0, 0); PG8_SCHED; PG8_LDA(At, 0, 0); PG8_STAGE(PG8_SA(1, 1), a1, voffA[1]);
            PG8_WAIT_L(8); PG8_BAR; PG8_WAIT_L(0); PG8_MMA(0, 0, At, B0); PG8_BAR; PG8_SCHED;
            PG8_LDB(B1, 0, 1); PG8_STAGE(PG8_SB(0, 0), b2, voffB);
            PG8_BAR; PG8_WAIT_L(0); PG8_MMA(0, 1, At, B1); PG8_BAR;
            PG8_LDA(At, 0, 1); PG8_STAGE(PG8_SA(0, 0), a2, vA2[0]);
            PG8_BAR; PG8_WAIT_L(0); PG8_MMA(1, 0, At, B0); PG8_BAR; PG8_SCHED;
            PG8_STAGE(PG8_SB(0, 1), b2 + hstepB, voffB);
            PG8_WAIT_V(6); PG8_BAR; PG8_MMA(1, 1, At, B1); PG8_BAR;
            PG8_LDB(B0, 1, 0); PG8_SCHED; PG8_LDA(At, 1, 0); PG8_STAGE(PG8_SA(0, 1), a2, vA2[1]);
            PG8_WAIT_L(8); PG8_BAR; PG8_WAIT_L(0); PG8_MMA(0, 0, At, B0); PG8_BAR; PG8_SCHED;
            PG8_LDB(B1, 1, 1); PG8_STAGE(PG8_SB(1, 0), b3, voffB);
            PG8_BAR; PG8_WAIT_L(0); PG8_MMA(0, 1, At, B1); PG8_BAR;
            PG8_LDA(At, 1, 1); PG8_STAGE(PG8_SA(1, 0), a3, vA2[0]);
            PG8_BAR; PG8_WAIT_L(0); PG8_MMA(1, 0, At, B0); PG8_BAR; PG8_SCHED;
            PG8_STAGE(PG8_SB(1, 1), b3 + hstepB, voffB);
            PG8_WAIT_V(6); PG8_BAR; PG8_MMA(1, 1, At, B1); PG8_BAR;
        }
        E(acc, cur, wr, wc, fr, fq);
        if (!has_next) break;
#pragma unroll
        for (int a = 0; a < 2; ++a)
#pragma unroll
            for (int b = 0; b < 2; ++b)
#pragma unroll
                for (int m = 0; m < 4; ++m)
#pragma unroll
                    for (int n = 0; n < 2; ++n) acc[a][b][m][n] = (f32x4){0.f, 0.f, 0.f, 0.f};
        cur = nxt; cA = nA; cB = nB; ++ui;
        if (GATHER) {
#pragma unroll
            for (int _h = 0; _h < 2; ++_h)
#pragma unroll
                for (int _i = 0; _i < 2; ++_i) voffA[_h][_i] = nvoffA[_h][_i]; }
    }
    PG8_WAIT_V(0);
    if (wr == 0) PG8_BAR;
    PG8_BAR;
#undef PG8_SA
#undef PG8_SB
#undef PG8_STAGE
#undef PG8_LDA
#undef PG8_LDB
#undef PG8_MMA
#undef PG8_WAIT_V
#undef PG8_WAIT_L
#undef PG8_BAR
#undef PG8_SCHED
#undef PG8_AOFFS
}
}

__device__ __forceinline__ void transpose_tile(const Frame& F, const float* src, int lds_, bf16_t* dstrow0, int ldd, int k0, int n0, const float* kscale) {
    float* T = F.lds;
    const int tid = F.tid, kk = tid >> 4, n4 = (tid & 15) * 4;
#pragma unroll
    for (int i = 0; i < 2; ++i) { const int k = kk + 32 * i; float4 v = *(const float4*)(src + (size_t)(k0 + k) * lds_ + n0 + n4); const float sc = kscale ? kscale[k0 + k] : 1.f;
        T[(n4 + 0) * 65 + k] = v.x * sc; T[(n4 + 1) * 65 + k] = v.y * sc; T[(n4 + 2) * 65 + k] = v.z * sc; T[(n4 + 3) * 65 + k] = v.w * sc; }
    __syncthreads();
    { const int n = tid >> 3, k8 = (tid & 7) * 8; const float* t = T + n * 65 + k8;
      pg8::u32x4 w; w.x = pg8::cvt_pk_bf16(t[0], t[1]); w.y = pg8::cvt_pk_bf16(t[2], t[3]); w.z = pg8::cvt_pk_bf16(t[4], t[5]); w.w = pg8::cvt_pk_bf16(t[6], t[7]);
      *(pg8::u32x4*)(dstrow0 + (size_t)n * ldd + k0 + k8) = w; }
    __syncthreads();
}


namespace att {
typedef short bf16x8 __attribute__((ext_vector_type(8)));
typedef short s16x4 __attribute__((ext_vector_type(4)));
typedef float f32x16 __attribute__((ext_vector_type(16)));
typedef float f32x4 __attribute__((ext_vector_type(4)));
typedef unsigned u32x4 __attribute__((ext_vector_type(4)));
constexpr int SHM = 16384;
constexpr int L_V = 0, L_K = 2 * SHM, L_WS = 4 * SHM, L_PART = L_WS + 8 * 64 * 4, L_SELM = L_PART + 4 * 64 * 33 * 4, L_VALS = L_SELM + 256, L_ITEM = L_VALS + 8 * 64 * 4, L_END = L_ITEM + 16;
constexpr float C2 = 1.4426950408889634f * SCALE;
#define KSWZ(row, colB) ((row) * 256 + ((colB) ^ (((row) & 7) << 4)))
#define SBAR() __builtin_amdgcn_sched_barrier(0)
__device__ __forceinline__ int v_st(int k, int c) { const int kk = (k & ~0xC) | ((k & 4) << 1) | ((k & 8) >> 1); return ((kk >> 3) * 4 + (c >> 5)) * 512 + ((kk & 7) * 32 + (c & 31)) * 2; }
__device__ __forceinline__ int v_rd_base(int lane) { return ((lane & 3) << 3) | (((lane >> 2) & 3) << 6) | (((lane >> 4) & 1) << 5) | (((lane >> 5) & 1) << 8); }
constexpr int v_rd_off(int d0, int ks, int half) { return d0 * 512 + ks * 4096 + half * 2048; }
__device__ __forceinline__ int crow(int r, int hi) { return (r & 3) + 8 * (r >> 2) + 4 * hi; }
__device__ __forceinline__ unsigned cvtpk(float lo, float hi) { unsigned r; asm volatile("v_cvt_pk_bf16_f32 %0, %1, %2" : "=v"(r) : "v"(lo), "v"(hi)); return r; }
__device__ __forceinline__ float swap_max(float v) { auto rr = __builtin_amdgcn_permlane32_swap(__float_as_uint(v), __float_as_uint(v), false, false); return fmaxf(__uint_as_float(rr[0]), __uint_as_float(rr[1])); }
__device__ __forceinline__ float swap_sum(float v) { auto rr = __builtin_amdgcn_permlane32_swap(__float_as_uint(v), __float_as_uint(v), false, false); return __uint_as_float(rr[0]) + __uint_as_float(rr[1]); }

struct WV { int tid, wid, lane, r32, hi, vb0; unsigned ksrc[2], vsrc[2]; char* lds; LAS unsigned char* ldsL; };
__device__ __forceinline__ void wv_src_init(WV& w) {
#pragma unroll
    for (int i = 0; i < 2; ++i) {
        const int L = (w.wid * 2 + i) * 1024 + w.lane * 16;
        { const int row = L >> 8, colB = (L & 255) ^ ((row & 7) << 4); w.ksrc[i] = (unsigned)(row * 256 + colB); }
        { const int sub = L >> 9, kkhi = sub >> 2, cblk = sub & 3, within = L & 511, kklo = within >> 6, cc = (within >> 1) & 31;
          const int kk = kkhi * 8 + kklo, k = (kk & ~0xC) | ((kk & 4) << 1) | ((kk & 8) >> 1), c = cblk * 32 + cc; w.vsrc[i] = (unsigned)(k * 256 + c * 2); }
    }
}
__device__ __forceinline__ void dma_tile(const WV& w, const bf16_t* Kt, const bf16_t* Vt, int buf) {
    int ln = w.lane; asm volatile("" : "+v"(ln));
#pragma unroll
    for (int i = 0; i < 2; ++i) {
        const int L = (w.wid * 2 + i) * 1024 + ln * 16;
        const int row = L >> 8, colB = (L & 255) ^ ((row & 7) << 4); const unsigned ksrc = (unsigned)(row * 256 + colB);
        const int sub = L >> 9, kkhi = sub >> 2, cblk = sub & 3, within = L & 511, kklo = within >> 6, cc = (within >> 1) & 31;
        const int kk = kkhi * 8 + kklo, k = (kk & ~0xC) | ((kk & 4) << 1) | ((kk & 8) >> 1), c = cblk * 32 + cc; const unsigned vsrc = (unsigned)(k * 256 + c * 2);
        __builtin_amdgcn_global_load_lds((const unsigned*)((const char*)Vt + vsrc), (LAS unsigned*)(w.ldsL + L_V + buf * SHM + (w.wid * 2 + i) * 1024), 16, 0, 0);
        __builtin_amdgcn_global_load_lds((const unsigned*)((const char*)Kt + ksrc), (LAS unsigned*)(w.ldsL + L_K + buf * SHM + (w.wid * 2 + i) * 1024), 16, 0, 0);
    }
}
__device__ __forceinline__ void qkt(const WV& w, int buf, const bf16x8 (&qr)[8], f32x16& p0, f32x16& p1) {
    p0 = f32x16{}; p1 = f32x16{};
    const char* kb[4];
#pragma unroll
    for (int dd = 0; dd < 4; ++dd) kb[dd] = w.lds + L_K + buf * SHM + KSWZ(w.r32, (dd * 16 + w.hi * 8) * 2);
#pragma unroll
    for (int d0 = 0; d0 < 8; ++d0) { const char* a = kb[d0 & 3] + (d0 >> 2) * 128;
        const bf16x8 b0 = *reinterpret_cast<const bf16x8*>(a); const bf16x8 b1 = *reinterpret_cast<const bf16x8*>(a + 32 * 256);
        p0 = __builtin_amdgcn_mfma_f32_32x32x16_bf16(b0, qr[d0], p0, 0, 0, 0);
        p1 = __builtin_amdgcn_mfma_f32_32x32x16_bf16(b1, qr[d0], p1, 0, 0, 0);
        if (d0 == 3) SBAR(); }
}
__device__ __forceinline__ void pack_p(const f32x16& p0, const f32x16& p1, bf16x8& pa0, bf16x8& pa1, bf16x8& pa2, bf16x8& pa3) {
#define PK4(P, B_, OUT) do { unsigned a0 = cvtpk(P[B_+0], P[B_+1]), a1 = cvtpk(P[B_+2], P[B_+3]); unsigned b0 = cvtpk(P[B_+4], P[B_+5]), b1 = cvtpk(P[B_+6], P[B_+7]); \
        auto r0 = __builtin_amdgcn_permlane32_swap(a0, b0, false, false); auto r1 = __builtin_amdgcn_permlane32_swap(a1, b1, false, false); \
        u32x4 w_ = {r0[0], r1[0], r0[1], r1[1]}; OUT = *reinterpret_cast<bf16x8*>(&w_); } while (0)
    PK4(p0, 0, pa0); PK4(p0, 8, pa1); PK4(p1, 0, pa2); PK4(p1, 8, pa3);
#undef PK4
}
template <int VB>
__device__ __forceinline__ void pv_tile(f32x16* o, int vb0, bf16x8 pa0, bf16x8 pa1, bf16x8 pa2, bf16x8 pa3) {
#define TRRD(dst, off) asm volatile("ds_read_b64_tr_b16 %0, %1 offset:%2" : "=&v"(dst) : "v"(vb0), "i"(off) : "memory")
#define PV_D0(d0) do { s16x4 l0, l1, l2, l3, h0, h1, h2, h3; constexpr int b_ = L_V + VB * SHM + v_rd_off(d0, 0, 0); \
        TRRD(l0, b_); TRRD(h0, b_ + 2048); TRRD(l1, b_ + 4096); TRRD(h1, b_ + 6144); TRRD(l2, b_ + 8192); TRRD(h2, b_ + 10240); TRRD(l3, b_ + 12288); TRRD(h3, b_ + 14336); \
        asm volatile("s_waitcnt lgkmcnt(0)" ::: "memory"); SBAR(); \
        o[d0] = __builtin_amdgcn_mfma_f32_32x32x16_bf16(pa0, (bf16x8){l0[0], l0[1], l0[2], l0[3], h0[0], h0[1], h0[2], h0[3]}, o[d0], 0, 0, 0); \
        o[d0] = __builtin_amdgcn_mfma_f32_32x32x16_bf16(pa1, (bf16x8){l1[0], l1[1], l1[2], l1[3], h1[0], h1[1], h1[2], h1[3]}, o[d0], 0, 0, 0); \
        o[d0] = __builtin_amdgcn_mfma_f32_32x32x16_bf16(pa2, (bf16x8){l2[0], l2[1], l2[2], l2[3], h2[0], h2[1], h2[2], h2[3]}, o[d0], 0, 0, 0); \
        o[d0] = __builtin_amdgcn_mfma_f32_32x32x16_bf16(pa3, (bf16x8){l3[0], l3[1], l3[2], l3[3], h3[0], h3[1], h3[2], h3[3]}, o[d0], 0, 0, 0); } while (0)
    PV_D0(0); PV_D0(1); PV_D0(2); PV_D0(3);
#undef PV_D0
#undef TRRD
}
__device__ __forceinline__ void store_o(const WV& w, const f32x16* o, const float* tab, bf16_t* outp) {
    bf16_t* lp = outp + (size_t)w.hi * 4096 + w.r32;
#pragma unroll
    for (int r = 0; r < 16; ++r) { const int q = crow(r, w.hi); const float sc = tab[q];
        bf16_t* p = lp; asm volatile("" : "+v"(p));
        p += ((r & 3) + 8 * (r >> 2)) * 1024;
#pragma unroll
        for (int d0 = 0; d0 < 4; ++d0) { const float v = o[d0][r] * sc; const float vn = __shfl_xor(v, 1);
            if ((w.r32 & 1) == 0) *(__attribute__((address_space(1))) unsigned*)(p + d0 * 32) = cvtpk(v, vn); } }
}

template <int MODE>
__device__ __forceinline__ void flash_pass(const WV& w, const bf16_t* Kp, const bf16_t* Vp, int j_lo, int j_hi, const bf16x8 (&qr)[8], int tpos, int tw0, unsigned selmask,
                                           f32x16 (&o)[4], float& m_reg, float& l_reg) {
    float* al_l = (float*)(w.lds + L_WS) + w.wid * 64;
    dma_tile(w, Kp + (size_t)j_lo * 64 * HD, Vp + (size_t)j_lo * 64 * HD, 0);
    int buf = 0;
    for (int j = j_lo; j < j_hi; ++j) {
        asm volatile("s_waitcnt vmcnt(0)" ::: "memory");
        __syncthreads();
        if (j + 1 < j_hi) dma_tile(w, Kp + (size_t)(j + 1) * 64 * HD, Vp + (size_t)(j + 1) * 64 * HD, buf ^ 1);
        f32x16 p0, p1;
        if (buf == 0) qkt(w, 0, qr, p0, p1); else qkt(w, 1, qr, p0, p1);
        const int kb = j * 64;
        { const float NEG = -__builtin_inff();
          const bool need = (kb + 63 > tw0) || (MODE == 1 && kb <= tw0 + 31 - 512);
          if (need) { const int dq = tpos - kb - 4 * w.hi; const unsigned W = (MODE == 1) ? 512u : 0x7fffffffu;
#pragma unroll
              for (int r = 0; r < 16; ++r) { const int c = (r & 3) + 8 * (r >> 2); if ((unsigned)(dq - c) >= W) p0[r] = NEG; if ((unsigned)(dq - c - 32) >= W) p1[r] = NEG; } }
          if (MODE == 0) { const bool sel = (selmask >> j) & 1u;
              if (!__all(sel)) {
#pragma unroll
                  for (int r = 0; r < 16; ++r) { p0[r] = sel ? p0[r] : NEG; p1[r] = sel ? p1[r] : NEG; } } }
        }
        float pmax = p0[0];
#pragma unroll
        for (int r = 1; r < 16; ++r) pmax = fmaxf(pmax, p0[r]);
#pragma unroll
        for (int r = 0; r < 16; ++r) pmax = fmaxf(pmax, p1[r]);
        pmax = swap_max(pmax);
        const float mn = fmaxf(m_reg, pmax);
        const float alpha = __builtin_amdgcn_exp2f((m_reg - mn) * C2);
        m_reg = mn;
        const float mnL = -mn * C2;
        float ps = 0.f;
#pragma unroll
        for (int r = 0; r < 16; ++r) { p0[r] = __builtin_amdgcn_exp2f(fmaf(p0[r], C2, mnL)); ps += p0[r]; }
#pragma unroll
        for (int r = 0; r < 16; ++r) { p1[r] = __builtin_amdgcn_exp2f(fmaf(p1[r], C2, mnL)); ps += p1[r]; }
        ps = swap_sum(ps);
        l_reg = l_reg * alpha + ps;
        if (__any(alpha < 1.f)) {
            if (w.hi == 0) al_l[w.r32] = alpha;
            asm volatile("s_waitcnt lgkmcnt(0)" ::: "memory");
#pragma unroll
            for (int r = 0; r < 16; ++r) { const float a = al_l[crow(r, w.hi)];
#pragma unroll
                for (int d = 0; d < 4; ++d) o[d][r] *= a; }
        }
        bf16x8 pa0, pa1, pa2, pa3;
        pack_p(p0, p1, pa0, pa1, pa2, pa3);
        if (buf == 0) pv_tile<0>(o, w.vb0, pa0, pa1, pa2, pa3); else pv_tile<1>(o, w.vb0, pa0, pa1, pa2, pa3);
        buf ^= 1;
    }
    __syncthreads();
}
}

__device__ const unsigned char ATT_ITEMS[80] = {15, 30, 31, 63, 14, 28, 29, 61, 62, 13, 26, 27, 59, 60, 12, 24, 25, 57, 58, 11, 22, 23, 55, 56, 10, 20, 21, 53, 54, 9, 18, 19, 51, 52, 8, 16, 17, 49, 50, 7, 48, 6, 5,
    72, 73, 74, 75, 76, 77, 78, 79, 80, 81, 82, 83, 84, 85, 86, 87, 88, 89, 90, 91, 92, 93, 94, 95, 4, 71, 3, 70, 2, 69, 1, 68, 0, 67, 66, 65, 64};
constexpr int CW_QUEUE = 6144;

__device__ __forceinline__ void p_attn(const Frame& F, unsigned char* lds_raw) {
    using namespace att;
    WV w; w.tid = F.tid; w.wid = F.wave; w.lane = F.lane; w.r32 = F.lane & 31; w.hi = F.lane >> 5;
    w.lds = (char*)lds_raw + 1024; w.ldsL = (LAS unsigned char*)lds_raw + 1024;
    w.vb0 = (int)(uintptr_t)(w.lds) + v_rd_base(w.lane);
    const bf16_t* qn = (const bf16_t*)(F.ws + WS_QN); const bf16_t* qrp = (const bf16_t*)(F.ws + WS_QR); const bf16_t* kv = (const bf16_t*)(F.ws + WS_KV);
    const bf16_t* ckv = (const bf16_t*)(F.ws + WS_CMPKV);
    bf16_t* ocmp = (bf16_t*)(F.ws + WS_OCMP); bf16_t* owin = (bf16_t*)(F.ws + WS_OWIN); bf16_t* osel = (bf16_t*)(F.ws + WS_OSEL); float* ml = (float*)(F.ws + WS_ML);
    unsigned* qctr = (unsigned*)(F.ws + WS_CTL) + CW_QUEUE;
    float* wsf = (float*)(w.lds + L_WS) + w.wid * 64;
    float* part = (float*)(w.lds + L_PART); unsigned* selm = (unsigned*)(w.lds + L_SELM); float* vals = (float*)(w.lds + L_VALS) + w.wid * 64; volatile int* itemw = (volatile int*)(w.lds + L_ITEM);
    const int hr = w.wid >> 1, th = w.wid & 1;
    for (;;) {
        __syncthreads();
        if (F.tid == 0) itemw[0] = (int)atomicAdd(qctr, 1u);
        __syncthreads();
        const int item = itemw[0];
        if (item >= 640) break;
        const int ent = ATT_ITEMS[item >> 3], bg = item & 7, type = ent >> 5, qb = ent & 31, b = bg >> 1, g = bg & 1, h = 4 * g + hr;
        const int t0 = qb * 64 + th * 32, tpos = t0 + w.r32, tok0 = b * SEQ + t0;
        const size_t qoff = (((size_t)b * NH + h) * SEQ + t0 + w.r32) * HD + w.hi * 8;
        const size_t kvoff = ((size_t)b * NG + g) * SEQ * HD;
        bf16x8 qr[8];
        f32x16 o[4];
#ifndef ATT_NO_WIN
        if (type == 2) {
#pragma unroll
            for (int d0 = 0; d0 < 8; ++d0) qr[d0] = *(const bf16x8*)(qrp + qoff + d0 * 16);
#pragma unroll
            for (int d = 0; d < 4; ++d) o[d] = f32x16{};
            float m_reg = -1e30f, l_reg = 0.f;
            flash_pass<1>(w, kv + (size_t)4 * (4 * MB / 2) + kvoff, kv + (size_t)5 * (4 * MB / 2) + kvoff, qb >= 8 ? qb - 8 : 0, qb + 1, qr, tpos, t0, 0u, o, m_reg, l_reg);
            if (w.hi == 0) wsf[w.r32] = 1.f / l_reg;
            asm volatile("s_waitcnt lgkmcnt(0)" ::: "memory");
            store_o(w, o, wsf, owin + (size_t)tok0 * 1024 + h * HD);
            continue;
        }
#endif
#ifndef ATT_NO_CMP
        {
#pragma unroll
            for (int d0 = 0; d0 < 8; ++d0) qr[d0] = *(const bf16x8*)(qn + qoff + d0 * 16);
            const bf16_t* Kc = ckv + (size_t)bg * 128 * HD; const bf16_t* Vc = ckv + (size_t)1024 * HD + (size_t)bg * 128 * HD;
            dma_tile(w, Kc, Vc, 0); dma_tile(w, Kc + 64 * HD, Vc + 64 * HD, 1);
            asm volatile("s_waitcnt vmcnt(0)" ::: "memory");
            __syncthreads();
            f32x16 pA0, pA1, pB0, pB1;
            qkt(w, 0, qr, pA0, pA1); qkt(w, 1, qr, pB0, pB1);
            const int nmax = tpos >= 31 ? ((tpos - 31) >> 4) : -1;
            const float NEG = -__builtin_inff();
            float pmax = NEG;
#pragma unroll
            for (int r = 0; r < 16; ++r) { const int n = crow(r, w.hi);
                pA0[r] = (n <= nmax) ? pA0[r] : NEG; pA1[r] = (n + 32 <= nmax) ? pA1[r] : NEG; pB0[r] = (n + 64 <= nmax) ? pB0[r] : NEG; pB1[r] = (n + 96 <= nmax) ? pB1[r] : NEG;
                pmax = fmaxf(fmaxf(pmax, pA0[r]), fmaxf(pA1[r], fmaxf(pB0[r], pB1[r]))); }
            pmax = swap_max(pmax);
            const float mm = (pmax == NEG) ? 0.f : pmax;
            const float mnL = -mm * C2;
            float ps = 0.f;
#pragma unroll
            for (int r = 0; r < 16; ++r) { pA0[r] = __builtin_amdgcn_exp2f(fmaf(pA0[r], C2, mnL)); pA1[r] = __builtin_amdgcn_exp2f(fmaf(pA1[r], C2, mnL));
                pB0[r] = __builtin_amdgcn_exp2f(fmaf(pB0[r], C2, mnL)); pB1[r] = __builtin_amdgcn_exp2f(fmaf(pB1[r], C2, mnL)); ps += (pA0[r] + pA1[r]) + (pB0[r] + pB1[r]); }
            ps = swap_sum(ps);
            const float inv = ps > 0.f ? 1.f / ps : 0.f;
#pragma unroll
            for (int r = 0; r < 16; ++r) { pA0[r] *= inv; pA1[r] *= inv; pB0[r] *= inv; pB1[r] *= inv; }
            {
                float av[16], bv[16];
#pragma unroll
                for (int gq = 0; gq < 4; ++gq) {
                    av[gq]      = pA0[4 * gq] + pA0[4 * gq + 1] + pA0[4 * gq + 2] + 0.5f * pA0[4 * gq + 3]; bv[gq]      = 0.5f * pA0[4 * gq + 3];
                    av[4 + gq]  = pA1[4 * gq] + pA1[4 * gq + 1] + pA1[4 * gq + 2] + 0.5f * pA1[4 * gq + 3]; bv[4 + gq]  = 0.5f * pA1[4 * gq + 3];
                    av[8 + gq]  = pB0[4 * gq] + pB0[4 * gq + 1] + pB0[4 * gq + 2] + 0.5f * pB0[4 * gq + 3]; bv[8 + gq]  = 0.5f * pB0[4 * gq + 3];
                    av[12 + gq] = pB1[4 * gq] + pB1[4 * gq + 1] + pB1[4 * gq + 2] + 0.5f * pB1[4 * gq + 3]; bv[12 + gq] = 0.5f * pB1[4 * gq + 3];
                }
                float* prow = part + ((size_t)hr * 64 + th * 32 + w.r32) * 33;
#pragma unroll
                for (int idx = 0; idx < 16; ++idx) {
                    const float bo = __shfl_xor(bv[idx], 32);
                    const float bprev = (idx > 0) ? __shfl_xor(bv[idx > 0 ? idx - 1 : 0], 32) : 0.f;
                    const float inc = w.hi ? bo : bprev;
                    prow[2 * idx + w.hi] = av[idx] + inc;
                }
            }
            if (type == 0) {
                bf16x8 pa0, pa1, pa2, pa3;
#pragma unroll
                for (int d = 0; d < 4; ++d) o[d] = f32x16{};
                pack_p(pA0, pA1, pa0, pa1, pa2, pa3); pv_tile<0>(o, w.vb0, pa0, pa1, pa2, pa3);
                pack_p(pB0, pB1, pa0, pa1, pa2, pa3); pv_tile<1>(o, w.vb0, pa0, pa1, pa2, pa3);
                if (w.hi == 0) wsf[w.r32] = 1.f;
                asm volatile("s_waitcnt lgkmcnt(0)" ::: "memory");
                store_o(w, o, wsf, ocmp + (size_t)tok0 * 1024 + h * HD);
            }
            __syncthreads();
#pragma unroll 1
            for (int ps2 = 0; ps2 < 4; ++ps2) {
                int ln = w.lane; asm volatile("" : "+v"(ln));
                const int j = ln & 31, hi2 = ln >> 5;
                const int tk = 8 * w.wid + 2 * ps2 + hi2, t = qb * 64 + tk, cur = qb;
                float imp = 0.f;
#pragma unroll
                for (int r = 0; r < 4; ++r) imp += part[((size_t)r * 64 + tk) * 33 + j];
                const bool ok = (64 * j <= t), forced = (j == 0) || (cur - j >= 0 && cur - j < 2);
                const float val = (ok && forced) ? 1.0e30f : (ok ? imp : -1.0e30f);
                vals[ln] = val;
                asm volatile("s_waitcnt lgkmcnt(0)" ::: "memory");
                int rank = 0;
#pragma unroll
                for (int jj = 0; jj < 32; ++jj) { const float o2 = vals[hi2 * 32 + jj]; rank += (o2 > val || (o2 == val && jj < j)) ? 1 : 0; }
                const unsigned long long bal = __ballot(rank < 16 && val >= 0.f);
                if (w.lane == 0) { selm[8 * w.wid + 2 * ps2] = (unsigned)bal; selm[8 * w.wid + 2 * ps2 + 1] = (unsigned)(bal >> 32); }
            }
            __syncthreads();
        }
#endif
#ifndef ATT_NO_SEL
        {
            const unsigned sm = selm[th * 32 + w.r32];
            const int ntile = qb + 1, hsplit = (ntile + 1) >> 1;
            const int ja = (qb >= 16 && type == 1) ? hsplit : 0, jb = (qb >= 16 && type == 0) ? hsplit : ntile;
#pragma unroll
            for (int d0 = 0; d0 < 8; ++d0) qr[d0] = *(const bf16x8*)(qrp + qoff + d0 * 16);
#pragma unroll
            for (int d = 0; d < 4; ++d) o[d] = f32x16{};
            float m_reg = -1e30f, l_reg = 0.f;
            flash_pass<0>(w, kv + (size_t)2 * (4 * MB / 2) + kvoff, kv + (size_t)3 * (4 * MB / 2) + kvoff, ja, jb, qr, tpos, t0, sm, o, m_reg, l_reg);
            if (w.hi == 0) { wsf[w.r32] = l_reg > 0.f ? 1.f / l_reg : 0.f; float* mp = ml + (((size_t)type * NT + tok0 + w.r32) * NH + h) * 2; mp[0] = m_reg; mp[1] = l_reg; }
            asm volatile("s_waitcnt lgkmcnt(0)" ::: "memory");
            store_o(w, o, wsf, osel + (size_t)type * NT * 1024 + (size_t)tok0 * 1024 + h * HD);
        }
#endif
    }
}

__device__ __forceinline__ void p0_prologue(const Frame& F) {
    const float* x = F.in[I_X];
    bf16_t* xb = (bf16_t*)(F.ws + WS_XB); float* rstd1 = (float*)(F.ws + WS_RSTD1);
    const int gw = F.bid * NWAVES + F.wave, nw = F.G * NWAVES, lane = F.lane;
    for (int r = gw; r < NT; r += nw) {
        float4 v[8]; float ss = 0.f;
#pragma unroll
        for (int i = 0; i < 8; ++i) { v[i] = *(const float4*)(x + (size_t)r * DM + i * 256 + lane * 4); ss += v[i].x * v[i].x + v[i].y * v[i].y + v[i].z * v[i].z + v[i].w * v[i].w; }
        ss = wave_sum(ss);
        if (lane == 0) rstd1[r] = rsqrtf(ss * (1.f / DM) + EPS);
#pragma unroll
        for (int i = 0; i < 8; ++i) { uint2 w; w.x = f2bf(v[i].x) | ((unsigned)f2bf(v[i].y) << 16); w.y = f2bf(v[i].z) | ((unsigned)f2bf(v[i].w) << 16);
            *(uint2*)(xb + (size_t)r * DM + i * 256 + lane * 4) = w; }
    }
    {
        const float* w_in = F.in[I_WIN]; const float* ln = F.in[I_LNMIX]; bf16_t* wt = (bf16_t*)(F.ws + WS_WINT);
        const size_t total = (size_t)INWP * DM, nth = (size_t)F.G * NTHREADS;
        for (size_t idx = (size_t)F.bid * NTHREADS + F.tid; idx < total; idx += nth) {
            const int n = (int)(idx >> 11), k = (int)(idx & 2047);
            int src = -1;
            if (n < 2560) src = n; else if (n < 3584) src = 2584 + (n - 2560); else if (n < 3608) src = 2560 + (n - 3584);
            wt[idx] = src >= 0 ? f2bf(ln[k] * w_in[(size_t)k * INW + src]) : (bf16_t)0;
        }
    }
    for (int t = F.bid; t < 32 * 32; t += F.G) { const int k0 = (t >> 5) * 64, n0 = (t & 31) * 64;
        transpose_tile(F, F.in[I_WOUT], DM, (bf16_t*)(F.ws + WS_WOUTT) + (size_t)n0 * DM, DM, k0, n0, nullptr); }
    for (int t = F.bid; t < 32 * 2 * 256; t += F.G) { const int e = t >> 9, up = (t >> 8) & 1, k0 = ((t >> 3) & 31) * 64, n0 = (t & 7) * 64;
        transpose_tile(F, (up ? F.in[I_WUP] : F.in[I_WGATE]) + (size_t)e * DM * FF, FF, (bf16_t*)(F.ws + WS_W1T) + ((size_t)e * 1024 + (n0 >> 7) * 256 + (n0 & 127) + up * 128) * DM, DM, k0, n0, F.in[I_LNMOE]); }
    for (int t = F.bid; t < 32 * 256; t += F.G) { const int e = t >> 8, k0 = ((t >> 5) & 7) * 64, n0 = (t & 31) * 64;
        transpose_tile(F, F.in[I_WDOWN] + (size_t)e * FF * DM, DM, (bf16_t*)(F.ws + WS_W2T) + ((size_t)e * 2048 + n0) * FF, FF, k0, n0, nullptr); }
    {
        const int* pos = (const int*)F.in[I_POS]; float* rc = (float*)(F.ws + WS_ROPEC); float* rs = (float*)(F.ws + WS_ROPES);
        for (int idx = F.bid * NTHREADS + F.tid; idx < NB * SEQ * 16; idx += F.G * NTHREADS) {
            const int i = idx & 15, bs = idx >> 4;
            const float inv = exp2f(-(float)i * (1.f / 16.f) * 18.931568569324174f);
            const float ang = (float)pos[bs] * inv;
            rc[idx] = cosf(ang); rs[idx] = sinf(ang);
        }
    }
    for (int it = F.bid; it < 8; it += F.G) {
        const int kv = it >> 2, jb = it & 3;
        const float* pe = (kv ? F.in[I_PEV] : F.in[I_PEK]); const float* w1 = (kv ? F.in[I_WV1] : F.in[I_WK1]);
        const int mg = F.tid >> 6, j = jb * 64 + (F.tid & 63);
        float a = 0.f;
        for (int m = mg; m < 4096; m += 8) a += pe[m] * w1[(size_t)m * 256 + j];
        __syncthreads();
        F.lds[F.tid] = a;
        __syncthreads();
        if (F.tid < 64) { float s = 0.f; for (int q = 0; q < 8; ++q) s += F.lds[q * 64 + F.tid]; ((float*)(F.ws + WS_BIAS1))[kv * 256 + j] = s; }
        __syncthreads();
    }
}

struct EpiProj {
    const float* rstd1; const float* rc; const float* rs; bf16_t* qn; bf16_t* qr; bf16_t* kv; float* u; float* gates;
    __device__ __forceinline__ void operator()(const pg8::f32x4 (&acc)[2][2][4][2], const pg8::Unit& un, int wr, int wc, int fr, int fq) const {
        const int pn = un.pn;
#pragma unroll
        for (int ai = 0; ai < 2; ++ai)
#pragma unroll
            for (int m = 0; m < 4; ++m) {
                const int row = un.pm * 256 + ai * 128 + wr * 64 + m * 16 + fr; const float r1 = rstd1[row]; const int b = row >> 11, s = row & 2047;
                if (pn < 10) {
                    const bool ropeu = (pn < 4) || pn == 6 || pn == 8;
                    pg8::f32x4 c4 = {1.f, 1.f, 1.f, 1.f}, s4 = {0.f, 0.f, 0.f, 0.f};
                    if (ropeu && wc == 0) { c4 = *(const pg8::f32x4*)(rc + (size_t)row * 16 + 4 * fq); s4 = *(const pg8::f32x4*)(rs + (size_t)row * 16 + 4 * fq); }
#pragma unroll
                    for (int bj = 0; bj < 2; ++bj) {
                        const pg8::f32x4 v0 = acc[ai][bj][m][0] * r1, v1 = acc[ai][bj][m][1] * r1;
                        const int d0 = 32 * wc + 4 * fq;
                        pg8::f32x4 o0 = v0, o1 = v1;
                        if (ropeu && wc == 0) { o0 = v0 * c4 - v1 * s4; o1 = v1 * c4 + v0 * s4; }
                        uint2 w0, w1; w0.x = pg8::cvt_pk_bf16(o0[0], o0[1]); w0.y = pg8::cvt_pk_bf16(o0[2], o0[3]); w1.x = pg8::cvt_pk_bf16(o1[0], o1[1]); w1.y = pg8::cvt_pk_bf16(o1[2], o1[3]);
                        if (pn < 4) {
                            const size_t o = (((size_t)b * NH + 2 * pn + bj) * SEQ + s) * HD + d0;
                            uint2 n0, n1; n0.x = pg8::cvt_pk_bf16(v0[0], v0[1]); n0.y = pg8::cvt_pk_bf16(v0[2], v0[3]); n1.x = pg8::cvt_pk_bf16(v1[0], v1[1]); n1.y = pg8::cvt_pk_bf16(v1[2], v1[3]);
                            *(uint2*)(qn + o) = n0; *(uint2*)(qn + o + 16) = n1; *(uint2*)(qr + o) = w0; *(uint2*)(qr + o + 16) = w1;
                        } else {
                            const size_t o = (size_t)(pn - 4) * (4 * MB / 2) + (((size_t)b * NG + bj) * SEQ + s) * HD + d0;
                            *(uint2*)(kv + o) = w0; *(uint2*)(kv + o + 16) = w1;
                        }
                    }
                } else if (pn < 14) {
#pragma unroll
                    for (int bj = 0; bj < 2; ++bj)
#pragma unroll
                        for (int n = 0; n < 2; ++n) *(pg8::f32x4*)(u + (size_t)row * 1024 + (pn - 10) * 256 + bj * 128 + wc * 32 + n * 16 + 4 * fq) = acc[ai][bj][m][n] * r1;
                } else {
                    if (wc == 0) { *(pg8::f32x4*)(gates + (size_t)row * 24 + 4 * fq) = acc[ai][0][m][0] * r1; if (fq < 2) *(pg8::f32x4*)(gates + (size_t)row * 24 + 16 + 4 * fq) = acc[ai][0][m][1] * r1; }
                }
            }
    }
};

__device__ __forceinline__ void p1_proj(const Frame& F, LAS unsigned char* stage) {
    pg8::DenseOrder S; S.init(F.ws + WS_XB, F.ws + WS_WINT, DM, DM, NT, INWP, F.G, F.bid);
    EpiProj E{(const float*)(F.ws + WS_RSTD1), (const float*)(F.ws + WS_ROPEC), (const float*)(F.ws + WS_ROPES), (bf16_t*)(F.ws + WS_QN), (bf16_t*)(F.ws + WS_QR), (bf16_t*)(F.ws + WS_KV),
              (float*)(F.ws + WS_U), (float*)(F.ws + WS_GATES)};
    pg8::gemm_phase<EpiProj, pg8::DenseOrder, false>(stage, DM, DM, DM, S, E);
}

__device__ __forceinline__ void p3_mid(const Frame& F) {
    const bf16_t* kv = (const bf16_t*)(F.ws + WS_KV);
    {
        float* hid = (float*)(F.ws + WS_HID); const float* bias1 = (const float*)(F.ws + WS_BIAS1);
        for (int t = F.bid; t < 2 * 16 * 4; t += F.G) {
            const int kvi = t >> 6, m0 = ((t >> 2) & 15) * 64, n0 = (t & 3) * 64;
            const bf16_t* A = kv + (size_t)kvi * (4 * MB / 2); const float* w1 = (kvi ? F.in[I_WV1] : F.in[I_WK1]);
            ngemm_tile<1, false>(F, 4096,
                [&](int m, int k) { return bf2f(A[(size_t)(m0 + m) * 2048 + k]); },
                [&](int, int k, int n) { return w1[(size_t)k * 256 + n0 + n]; },
                [&](int m, int n, float acc, float) { hid[((size_t)kvi * 1024 + m0 + m) * 256 + n0 + n] = gelu_tanh(acc + bias1[kvi * 256 + n0 + n]); });
        }
    }
    __syncthreads();
    {
        const float* u = (const float*)(F.ws + WS_U); float* opool = (float*)(F.ws + WS_OPOOL);
        const float* wp = F.in[I_WPOOL]; const float* bp = F.in[I_BPOOL]; const float* ps = F.in[I_PSCALE];
        for (int t = F.bid; t < 128 * 4 * 4; t += F.G) {
            const int m0 = (t >> 4) * 64, gi = (t >> 2) & 3, n0 = (t & 3) * 64, w = 2 << gi;
            ngemm_tile<1, false>(F, 256,
                [&](int m, int k) { const int row = m0 + m, s = row & 2047, c = gi * 256 + k; const int cnt = (s + 1 < w) ? s + 1 : w; float sum = 0.f;
                    for (int q = 0; q < cnt; ++q) sum += u[(size_t)(row - q) * 1024 + c];
                    return sum / (float)cnt - u[(size_t)row * 1024 + c]; },
                [&](int, int k, int n) { return wp[((size_t)gi * 256 + k) * 256 + n0 + n]; },
                [&](int m, int n, float acc, float) { const int c = gi * 256 + n0 + n; opool[(size_t)(m0 + m) * 1024 + c] = (acc + bp[c]) * ps[c]; });
        }
    }
}

__device__ __forceinline__ void p4_cmp2(const Frame& F) {
    const float* hid = (const float*)(F.ws + WS_HID); bf16_t* ckv = (bf16_t*)(F.ws + WS_CMPKV);
    for (int t = F.bid; t < 2 * 16 * 2; t += F.G) {
        const int kvi = t >> 5, m0 = ((t >> 1) & 15) * 64, n0 = (t & 1) * 64;
        const float* w2 = (kvi ? F.in[I_WV2] : F.in[I_WK2]);
        ngemm_tile<1, false>(F, 256,
            [&](int m, int k) { return hid[((size_t)kvi * 1024 + m0 + m) * 256 + k]; },
            [&](int, int k, int n) { return w2[(size_t)k * 128 + n0 + n]; },
            [&](int m, int n, float acc, float) { const int R = m0 + m; ckv[((size_t)kvi * 1024 + R) * 128 + n0 + n] = ((R & 127) == 127) ? (bf16_t)0 : f2bf(acc); });
    }
}

__device__ __forceinline__ void p6_mix(const Frame& F) {
    const bf16_t* ocmp = (const bf16_t*)(F.ws + WS_OCMP); const bf16_t* owin = (const bf16_t*)(F.ws + WS_OWIN); const bf16_t* osel = (const bf16_t*)(F.ws + WS_OSEL);
    const float* ml = (const float*)(F.ws + WS_ML); const float* gates = (const float*)(F.ws + WS_GATES);
    const float* opool = (const float*)(F.ws + WS_OPOOL); bf16_t* mix = (bf16_t*)(F.ws + WS_MIX);
    const float* gn = F.in[I_GNNSA]; const float* gp = F.in[I_GNPOOL];
    const int gw = F.bid * NWAVES + F.wave, nw = F.G * NWAVES, lane = F.lane;
    for (int r = gw; r < NT; r += nw) {
        const bool split = ((r & 2047) >> 6) >= 16;
        float a[16], p[16]; float sa = 0.f, sp = 0.f;
#pragma unroll
        for (int i = 0; i < 16; ++i) {
            const int h = i >> 1; const size_t o = (size_t)r * 1024 + i * 64 + lane;
            const float* gq = gates + (size_t)r * 24 + h * 3;
            const float g0 = 1.f / (1.f + __expf(-gq[0])), g1 = 1.f / (1.f + __expf(-gq[1])), g2 = 1.f / (1.f + __expf(-gq[2]));
            float os = bf2f(osel[o]);
            if (split) {
                const float* m0p = ml + ((size_t)r * NH + h) * 2; const float* m1p = ml + (((size_t)NT + r) * NH + h) * 2;
                const float m0 = m0p[0], l0 = m0p[1], m1 = m1p[0], l1 = m1p[1], M = fmaxf(m0, m1);
                const float a0 = l0 * exp2f((m0 - M) * att::C2), a1 = l1 * exp2f((m1 - M) * att::C2);
                os = (a0 * os + a1 * bf2f(osel[(size_t)NT * 1024 + o])) / (a0 + a1);
            }
            a[i] = g0 * bf2f(ocmp[o]) + g1 * os + g2 * bf2f(owin[o]);
            p[i] = opool[o]; sa += a[i] * a[i]; sp += p[i] * p[i];
        }
        sa = wave_sum(sa); sp = wave_sum(sp);
        const float ra = rsqrtf(sa * (1.f / 1024.f) + EPS), rp = rsqrtf(sp * (1.f / 1024.f) + EPS);
#pragma unroll
        for (int i = 0; i < 16; ++i) { const int c = i * 64 + lane; mix[(size_t)r * DM + c] = f2bf(a[i] * ra * gn[c]); mix[(size_t)r * DM + 1024 + c] = f2bf(p[i] * rp * gp[c]); }
    }
}

struct EpiOut {
    const float* x; float* out; bf16_t* x1b;
    __device__ __forceinline__ void operator()(const pg8::f32x4 (&acc)[2][2][4][2], const pg8::Unit& un, int wr, int wc, int fr, int fq) const {
#pragma unroll
        for (int ai = 0; ai < 2; ++ai)
#pragma unroll
            for (int m = 0; m < 4; ++m) {
                const int row = un.pm * 256 + ai * 128 + wr * 64 + m * 16 + fr;
#pragma unroll
                for (int bj = 0; bj < 2; ++bj)
#pragma unroll
                    for (int n = 0; n < 2; ++n) {
                        const size_t o = (size_t)row * DM + un.pn * 256 + bj * 128 + wc * 32 + n * 16 + 4 * fq;
                        const pg8::f32x4 v = acc[ai][bj][m][n] + *(const pg8::f32x4*)(x + o);
                        *(pg8::f32x4*)(out + o) = v;
                        uint2 w; w.x = pg8::cvt_pk_bf16(v[0], v[1]); w.y = pg8::cvt_pk_bf16(v[2], v[3]); *(uint2*)(x1b + o) = w;
                    }
            }
    }
};
__device__ __forceinline__ void p7_out(const Frame& F, LAS unsigned char* stage) {
    pg8::DenseOrder S; S.init(F.ws + WS_MIX, F.ws + WS_WOUTT, DM, DM, NT, DM, F.G, F.bid);
    EpiOut E{F.in[I_X], F.out, (bf16_t*)(F.ws + WS_X1B)};
    pg8::gemm_phase<EpiOut, pg8::DenseOrder, false>(stage, DM, DM, DM, S, E);
}

__device__ __forceinline__ void p8_router(const Frame& F) {
    const float* lnm = F.in[I_LNMOE]; const float* wrg = F.in[I_WRG]; const float* brg = F.in[I_BRG]; const float* wre = F.in[I_WRE]; const float* bre = F.in[I_BRE];
    float* rstd2 = (float*)(F.ws + WS_RSTD2); int* arow = (int*)(F.ws + WS_AROW); int* tokl = (int*)(F.ws + WS_TOKL); float* gatel = (float*)(F.ws + WS_GATEL);
    unsigned* cnt = (unsigned*)(F.ws + WS_CTL) + CW_CNT;
    const int gw = F.bid * NWAVES + F.wave, nw = F.G * NWAVES, lane = F.lane;
    for (int r = gw; r < NT; r += nw) {
        float h[32]; float ss = 0.f;
#pragma unroll
        for (int i = 0; i < 8; ++i) { const float4 v = *(const float4*)(F.out + (size_t)r * DM + i * 256 + lane * 4); h[4 * i] = v.x; h[4 * i + 1] = v.y; h[4 * i + 2] = v.z; h[4 * i + 3] = v.w;
            ss += v.x * v.x + v.y * v.y + v.z * v.z + v.w * v.w; }
        ss = wave_sum(ss);
        const float rs = rsqrtf(ss * (1.f / DM) + EPS);
        float lg[4] = {0.f, 0.f, 0.f, 0.f};
#pragma unroll
        for (int i = 0; i < 8; ++i)
#pragma unroll
            for (int c = 0; c < 4; ++c) { const int k = i * 256 + lane * 4 + c; h[4 * i + c] *= rs * lnm[k]; const float4 w = *(const float4*)(wrg + (size_t)k * 4);
                lg[0] += h[4 * i + c] * w.x; lg[1] += h[4 * i + c] * w.y; lg[2] += h[4 * i + c] * w.z; lg[3] += h[4 * i + c] * w.w; }
#pragma unroll
        for (int j = 0; j < 4; ++j) lg[j] = wave_sum(lg[j]) + brg[j];
        int gs = 0; float gm = lg[0];
#pragma unroll
        for (int j = 1; j < 4; ++j) if (lg[j] > gm) { gm = lg[j]; gs = j; }
        float den = 0.f;
#pragma unroll
        for (int j = 0; j < 4; ++j) den += __expf(lg[j] - gm);
        const float pg = 1.f / den;
        float le[8] = {0.f, 0.f, 0.f, 0.f, 0.f, 0.f, 0.f, 0.f};
#pragma unroll
        for (int i = 0; i < 8; ++i)
#pragma unroll
            for (int c = 0; c < 4; ++c) { const int k = i * 256 + lane * 4 + c; const float* w = wre + ((size_t)gs * DM + k) * 8; const float4 w0 = *(const float4*)w, w1 = *(const float4*)(w + 4);
                const float hv = h[4 * i + c];
                le[0] += hv * w0.x; le[1] += hv * w0.y; le[2] += hv * w0.z; le[3] += hv * w0.w; le[4] += hv * w1.x; le[5] += hv * w1.y; le[6] += hv * w1.z; le[7] += hv * w1.w; }
#pragma unroll
        for (int j = 0; j < 8; ++j) le[j] = wave_sum(le[j]) + bre[gs * 8 + j];
        int e0 = 0; float m0 = le[0];
#pragma unroll
        for (int j = 1; j < 8; ++j) if (le[j] > m0) { m0 = le[j]; e0 = j; }
        int e1 = -1; float m1 = -3.0e38f;
#pragma unroll
        for (int j = 0; j < 8; ++j) if (j != e0 && le[j] > m1) { m1 = le[j]; e1 = j; }
        const float p1 = __expf(m1 - m0);
        const float gate0 = pg / (1.f + p1), gate1 = pg * p1 / (1.f + p1);
        if (lane == 0) {
            rstd2[r] = rs;
            const int ea = gs * 8 + e0, eb = gs * 8 + e1;
            const unsigned sa = atomicAdd(&cnt[64 * ea], 1u), sb = atomicAdd(&cnt[64 * eb], 1u);
            tokl[ea * 8192 + sa] = r; gatel[ea * 8192 + sa] = gate0; tokl[eb * 8192 + sb] = r; gatel[eb * 8192 + sb] = gate1;
            arow[2 * r] = ea * 8192 + (int)sa; arow[2 * r + 1] = eb * 8192 + (int)sb;
        }
    }
}

__device__ __forceinline__ void moe_counts(const Frame& F, int* cnts  , int* pst  ) {
    const unsigned* cnt = (const unsigned*)(F.ws + WS_CTL) + CW_CNT;
    __syncthreads();
    if (F.tid < 32) cnts[F.tid] = (int)__hip_atomic_load(&cnt[64 * F.tid], __ATOMIC_RELAXED, __HIP_MEMORY_SCOPE_AGENT);
    __syncthreads();
    if (F.tid == 0) { int a = 0; for (int e = 0; e < 32; ++e) { pst[e] = a; a += (cnts[e] + 255) & ~255; } pst[32] = a; }
    __syncthreads();
}

constexpr int MOE_TAB_OFF = 1024 + 131072;
struct MoeTabs { int* cnts; int* pst; int* ust; int* rowtok; };
__device__ __forceinline__ MoeTabs moe_tabs(unsigned char* lds_raw) { MoeTabs T; T.cnts = (int*)(lds_raw + MOE_TAB_OFF); T.pst = T.cnts + 32; T.ust = T.pst + 40; T.rowtok = T.ust + 40; return T; }
template <int NTN> __device__ __forceinline__ void moe_units(const Frame& F, const MoeTabs& T) {
    moe_counts(F, T.cnts, T.pst);
    if (F.tid == 0) { int a = 0; for (int e = 0; e < 32; ++e) { T.ust[e] = a; a += ((T.cnts[e] + 255) >> 8) * NTN; } T.ust[32] = a; }
    __syncthreads();
}
template <int NTN, int LOGN> struct MoeOrder {
    const char* A; const char* Bt; const int* pst; const int* ust; const int* rowtok; int G, c, lda, ldb, brows;
    __device__ __forceinline__ bool next(int i, pg8::Unit& u) const {
        const int L = i * G + c; if (L >= ust[32]) return false;
        int e = 0; while (ust[e + 1] <= L) ++e;
        const int w = L - ust[e]; u.e = e; u.pm = w >> LOGN; u.pn = w & (NTN - 1); u.li = i; return true;
    }
    __device__ __forceinline__ const char* b_base(const pg8::Unit& u) const { return Bt + ((size_t)u.e * brows + (size_t)u.pn * 256) * ldb * 2; }
    __device__ __forceinline__ const char* a_base(const pg8::Unit& u) const { return rowtok ? A : A + (size_t)(pst[u.e] + u.pm * 256) * lda * 2; }
    __device__ __forceinline__ unsigned a_row_off(const pg8::Unit& u, int r) const {
        if (rowtok) { const int tk = rowtok[u.li * 256 + r]; return (unsigned)(tk < 0 ? 0 : tk) * (unsigned)lda * 2u; }
        return (unsigned)r * (unsigned)lda * 2u;
    }
};
struct EpiMoe1 {
    const int* cnts; const int* pst; const int* rowtok; const float* rstd2; bf16_t* act;
    __device__ __forceinline__ void operator()(const pg8::f32x4 (&acc)[2][2][4][2], const pg8::Unit& un, int wr, int wc, int fr, int fq) const {
#pragma unroll
        for (int ai = 0; ai < 2; ++ai)
#pragma unroll
            for (int m = 0; m < 4; ++m) {
                const int r = ai * 128 + wr * 64 + m * 16 + fr; const int tk = rowtok[un.li * 256 + r];
                if (tk >= 0) {
                    const float rs = rstd2[tk];
                    bf16_t* dst = act + (size_t)(pst[un.e] + un.pm * 256 + r) * FF + un.pn * 128 + wc * 32 + 4 * fq;
#pragma unroll
                    for (int n = 0; n < 2; ++n) {
                        const pg8::f32x4 vg = acc[ai][0][m][n] * rs, vu = acc[ai][1][m][n] * rs; float o[4];
#pragma unroll
                        for (int j = 0; j < 4; ++j) o[j] = vg[j] / (1.f + __expf(-vg[j])) * vu[j];
                        uint2 w; w.x = pg8::cvt_pk_bf16(o[0], o[1]); w.y = pg8::cvt_pk_bf16(o[2], o[3]); *(uint2*)(dst + 16 * n) = w;
                    }
                }
            }
    }
};
struct EpiMoe2 {
    const int* cnts; const int* pst; const float* gatel; bf16_t* y;
    __device__ __forceinline__ void operator()(const pg8::f32x4 (&acc)[2][2][4][2], const pg8::Unit& un, int wr, int wc, int fr, int fq) const {
#pragma unroll
        for (int ai = 0; ai < 2; ++ai)
#pragma unroll
            for (int m = 0; m < 4; ++m) {
                const int slot = un.pm * 256 + ai * 128 + wr * 64 + m * 16 + fr;
                if (slot < cnts[un.e]) {
                    const float gt = gatel[un.e * 8192 + slot];
                    bf16_t* dst = y + (size_t)(pst[un.e] + slot) * DM + un.pn * 256 + wc * 32 + 4 * fq;
#pragma unroll
                    for (int bj = 0; bj < 2; ++bj)
#pragma unroll
                        for (int n = 0; n < 2; ++n) { const pg8::f32x4 v = acc[ai][bj][m][n] * gt; uint2 w; w.x = pg8::cvt_pk_bf16(v[0], v[1]); w.y = pg8::cvt_pk_bf16(v[2], v[3]); *(uint2*)(dst + bj * 128 + n * 16) = w; }
                }
            }
    }
};

__device__ __forceinline__ void p9_moe1(const Frame& F, unsigned char* lds_raw, LAS unsigned char* stage) {
    const MoeTabs T = moe_tabs(lds_raw);
    moe_units<4>(F, T);
    MoeOrder<4, 2> S{(const char*)(F.ws + WS_X1B), (const char*)(F.ws + WS_W1T), T.pst, T.ust, T.rowtok, F.G, F.bid, DM, DM, 1024};
    { const int* tokl = (const int*)(F.ws + WS_TOKL); pg8::Unit u;
      for (int i = 0; i < 4 && S.next(i, u); ++i) { if (F.tid < 256) { const int slot = u.pm * 256 + F.tid; T.rowtok[i * 256 + F.tid] = slot < T.cnts[u.e] ? tokl[u.e * 8192 + slot] : -1; } } }
    asm volatile("s_waitcnt vmcnt(0) lgkmcnt(0)" ::: "memory");
    __syncthreads();
    EpiMoe1 E{T.cnts, T.pst, T.rowtok, (const float*)(F.ws + WS_RSTD2), (bf16_t*)(F.ws + WS_ACT)};
    pg8::gemm_phase<EpiMoe1, MoeOrder<4, 2>, true>(stage, DM, DM, DM, S, E);
}

__device__ __forceinline__ void p10_moe2(const Frame& F, unsigned char* lds_raw, LAS unsigned char* stage) {
    const MoeTabs T = moe_tabs(lds_raw);
    moe_units<8>(F, T);
    MoeOrder<8, 3> S{(const char*)(F.ws + WS_ACT), (const char*)(F.ws + WS_W2T), T.pst, T.ust, nullptr, F.G, F.bid, FF, FF, 2048};
    EpiMoe2 E{T.cnts, T.pst, (const float*)(F.ws + WS_GATEL), (bf16_t*)(F.ws + WS_Y)};
    pg8::gemm_phase<EpiMoe2, MoeOrder<8, 3>, false>(stage, FF, FF, FF, S, E);
}

__device__ __forceinline__ void p11_final(const Frame& F) {
    int* cnts = (int*)(F.lds + 3072); int* pst = cnts + 32;
    moe_counts(F, cnts, pst);
    const bf16_t* y = (const bf16_t*)(F.ws + WS_Y); const int* arow = (const int*)(F.ws + WS_AROW); const float* lnf = F.in[I_LNFINAL];
    const int gw = F.bid * NWAVES + F.wave, nw = F.G * NWAVES, lane = F.lane;
    for (int r = gw; r < NT; r += nw) {
        const int a0 = arow[2 * r], a1 = arow[2 * r + 1];
        const size_t r0 = (size_t)(pst[a0 >> 13] + (a0 & 8191)), r1 = (size_t)(pst[a1 >> 13] + (a1 & 8191));
        float v[32]; float ss = 0.f;
#pragma unroll
        for (int i = 0; i < 8; ++i) { const int c = i * 256 + lane * 4; const float4 xv = *(const float4*)(F.out + (size_t)r * DM + c);
            const uint2 ya = *(const uint2*)(y + r0 * DM + c), yb = *(const uint2*)(y + r1 * DM + c);
            v[4 * i]     = xv.x + __uint_as_float(ya.x << 16) + __uint_as_float(yb.x << 16);
            v[4 * i + 1] = xv.y + __uint_as_float(ya.x & 0xFFFF0000u) + __uint_as_float(yb.x & 0xFFFF0000u);
            v[4 * i + 2] = xv.z + __uint_as_float(ya.y << 16) + __uint_as_float(yb.y << 16);
            v[4 * i + 3] = xv.w + __uint_as_float(ya.y & 0xFFFF0000u) + __uint_as_float(yb.y & 0xFFFF0000u);
            ss += v[4 * i] * v[4 * i] + v[4 * i + 1] * v[4 * i + 1] + v[4 * i + 2] * v[4 * i + 2] + v[4 * i + 3] * v[4 * i + 3]; }
        ss = wave_sum(ss);
        const float rs = rsqrtf(ss * (1.f / DM) + EPS);
#pragma unroll
        for (int i = 0; i < 8; ++i) { const int c = i * 256 + lane * 4; const float4 g = *(const float4*)(lnf + c);
            float4 o; o.x = v[4 * i] * rs * g.x; o.y = v[4 * i + 1] * rs * g.y; o.z = v[4 * i + 2] * rs * g.z; o.w = v[4 * i + 3] * rs * g.w;
            *(float4*)(F.out + (size_t)r * DM + c) = o; }
    }
}

constexpr int NPHASE = 11;
__global__ void __launch_bounds__(NTHREADS, 2) fwd(Args args) {
    extern __shared__ __attribute__((aligned(16))) unsigned char lds_raw[];
    Frame F;
#pragma unroll
    for (int i = 0; i < N_IN; ++i) F.in[i] = args.in[i];
    F.out = args.out; F.ws = args.ws;
    F.lds = (float*)(lds_raw + 16);
    F.tid = threadIdx.x; F.lane = F.tid & 63; F.wave = __builtin_amdgcn_readfirstlane(F.tid >> 6); F.G = gridDim.x; F.bid = blockIdx.x;
    if (F.tid < 4) ((LAS unsigned*)lds_raw)[F.tid] = 0u;
    __syncthreads();
    XcdBarrier bar; bar.bar = (unsigned*)(F.ws + WS_CTL); bar.x = 0; bar.st = nullptr;
    if (N_LAUNCHES == 1) bar = xcd_barrier_post((unsigned*)(F.ws + WS_CTL), (volatile LAS unsigned*)lds_raw);
    const int lo = args.ph_lo, hi = args.ph_hi;
#ifndef ONLY_PHASE
#define ONLY_PHASE -1
#endif
#define IN(k) (lo <= (k) && (k) < hi && (ONLY_PHASE < 0 || ONLY_PHASE == (k)))
#define SEAM(k) do { if (IN(k) && IN((k) + 1)) xcd_barrier(bar); } while (0)
    LAS unsigned char* stage = (LAS unsigned char*)lds_raw + 1024;
    if (IN(0)) p0_prologue(F);
    SEAM(0);
    if (IN(1)) p1_proj(F, stage);
    SEAM(1);
    if (IN(2)) p3_mid(F);
    SEAM(2);
    if (IN(3)) p4_cmp2(F);
    SEAM(3);
    if (IN(4)) p_attn(F, lds_raw);
    SEAM(4);
    if (IN(5)) p6_mix(F);
    SEAM(5);
    if (IN(6)) p7_out(F, stage);
    SEAM(6);
    if (IN(7)) p8_router(F);
    SEAM(7);
    if (IN(8)) p9_moe1(F, lds_raw, stage);
    SEAM(8);
    if (IN(9)) p10_moe2(F, lds_raw, stage);
    SEAM(9);
    if (IN(10)) p11_final(F);
#undef IN
#undef SEAM
}

extern "C" void kernel_launch(void* const* d_in, const int* in_sizes, int n_in, void* d_out, int out_size, void* d_ws, size_t ws_size, hipStream_t stream) {
    static int grid = 0;
    if (grid == 0) {
        if (n_in != N_IN || out_size != NT * DM || ws_size < WS_END) { fprintf(stderr, "kernel_launch: unexpected shapes: n_in %d out %d ws %zu (need %zu)\n", n_in, out_size, ws_size, (size_t)WS_END); grid = -1; return; }
        int dev = 0, cus = 0, per_cu = 0;
        if (hipGetDevice(&dev) != hipSuccess || hipDeviceGetAttribute(&cus, hipDeviceAttributeMultiprocessorCount, dev) != hipSuccess) { grid = -1; return; }
        if (hipFuncSetAttribute((const void*)fwd, hipFuncAttributeMaxDynamicSharedMemorySize, LDS_BYTES) != hipSuccess) { fprintf(stderr, "kernel_launch: hipFuncSetAttribute failed\n"); grid = -1; return; }
        if (hipOccupancyMaxActiveBlocksPerMultiprocessor(&per_cu, (const void*)fwd, NTHREADS, LDS_BYTES) != hipSuccess || per_cu < 1) { fprintf(stderr, "kernel_launch: occupancy query says %d\n", per_cu); }
        (void)hipGetLastError();
        grid = cus;
    }
    if (grid < 0) return;
    (void)in_sizes;
    (void)hipMemsetAsync((char*)d_ws + WS_CTL, 0, CTL_ZERO_BYTES, stream);
    Args a{};
    for (int i = 0; i < N_IN; ++i) a.in[i] = (const float*)d_in[i];
    a.out = (float*)d_out; a.ws = (unsigned char*)d_ws;
    if (N_LAUNCHES == 1) { a.ph_lo = 0; a.ph_hi = NPHASE; hipLaunchKernelGGL(fwd, dim3(grid), dim3(NTHREADS), LDS_BYTES, stream, a); }
    else { for (int p = 0; p < NPHASE; ++p) { a.ph_lo = p; a.ph_hi = p + 1; hipLaunchKernelGGL(fwd, dim3(grid), dim3(NTHREADS), LDS_BYTES, stream, a); } }
}
```

```cpp
#include <hip/hip_runtime.h>
#include <cstdio>
#include <cstdint>

#ifndef N_LAUNCHES
#define N_LAUNCHES 1
#endif

#define XB_TMO      128
#define XB_XCNT(j)  (256  + 64 * (j))
#define XB_XSUB(j)  (1280 + 64 * (j))
#define XB_XGEN(j)  (2304 + 64 * (j))
#define XB_TOP      3328
#define XB_TOPGEN   3392
#define XCD_BAR_WORDS 3456
#define XB_SPIN_CAP (1u << 21)
#define LAS __attribute__((address_space(3)))

__device__ __forceinline__ unsigned xb_ld(unsigned* p)              { return __hip_atomic_load(p, __ATOMIC_RELAXED, __HIP_MEMORY_SCOPE_AGENT); }
__device__ __forceinline__ unsigned xb_add(unsigned* p, unsigned v) { return __hip_atomic_fetch_add(p, v, __ATOMIC_RELAXED, __HIP_MEMORY_SCOPE_AGENT); }
__device__ __forceinline__ unsigned xb_xcc_id() { return (unsigned)__builtin_amdgcn_s_getreg((3 << 11) | 20) & 0xFu; }
#define XB_SPIN(cond, bar) do { unsigned _sp = 0; while (cond) { __builtin_amdgcn_s_sleep(1); \
    if ((++_sp & 255u) == 0u) { if (xb_ld(&(bar)[XB_TMO])) break; if (_sp > XB_SPIN_CAP) { atomicAdd(&(bar)[XB_TMO], 1u); break; } } } } while (0)

struct XcdBarrier { unsigned* bar; unsigned x; volatile LAS unsigned* st; };

__device__ __forceinline__ XcdBarrier xcd_barrier_post(unsigned* bar, volatile LAS unsigned* st) {
    XcdBarrier b; b.bar = bar; b.x = xb_xcc_id(); b.st = st;
    if (threadIdx.x == 0) (void)xb_add(&bar[XB_XCNT(b.x)], 1u);
    return b;
}
__device__ __forceinline__ void xcd_barrier_complete(unsigned* bar, unsigned x, unsigned& nloc, unsigned& nx) {
    const unsigned G = gridDim.x * gridDim.y * gridDim.z;
    unsigned sum, cnt, mine, sp = 0u;
    for (;;) {
        sum = 0u; cnt = 0u; mine = 0u;
#pragma unroll
        for (unsigned j = 0; j < 16; ++j) { const unsigned c = xb_ld(&bar[XB_XCNT(j)]); sum += c; cnt += (c > 0u) ? 1u : 0u; mine = (j == x) ? c : mine; }
        if (sum == G) break;
        __builtin_amdgcn_s_sleep(1);
        if ((++sp & 255u) == 0u) { if (xb_ld(&bar[XB_TMO])) break; if (sp > XB_SPIN_CAP) { atomicAdd(&bar[XB_TMO], 1u); break; } }
    }
    nloc = mine > 0u ? mine : 1u; nx = cnt > 0u ? cnt : 1u;
}
__device__ __forceinline__ void xcd_barrier(const XcdBarrier& b) {
    asm volatile("s_waitcnt vmcnt(0)" ::: "memory");
    __syncthreads();
    if (threadIdx.x == 0) {
        unsigned* bar = b.bar;
        __builtin_amdgcn_s_waitcnt(0);
        unsigned nloc = b.st[0], nx = b.st[1];
        if (nloc == 0u) { xcd_barrier_complete(bar, b.x, nloc, nx); b.st[0] = nloc; b.st[1] = nx; }
        const unsigned old = xb_add(&bar[XB_XSUB(b.x)], 1u);
        const unsigned gen = old / nloc;
        if (old + 1u == (gen + 1u) * nloc) {
            __builtin_amdgcn_fence(__ATOMIC_RELEASE, "agent");
            asm volatile("s_waitcnt vmcnt(0)" ::: "memory");
            const unsigned og = xb_add(&bar[XB_TOP], 1u);
            const unsigned tg = og / nx;
            if (og + 1u == (tg + 1u) * nx) xb_add(&bar[XB_TOPGEN], 1u);
            else XB_SPIN(xb_ld(&bar[XB_TOPGEN]) == tg, bar);
            __builtin_amdgcn_fence(__ATOMIC_ACQUIRE, "agent");
            xb_add(&bar[XB_XGEN(b.x)], 1u);
            asm volatile("s_waitcnt vmcnt(0)" ::: "memory");
        } else {
            XB_SPIN(xb_ld(&bar[XB_XGEN(b.x)]) == gen, bar);
            __builtin_amdgcn_fence(__ATOMIC_ACQUIRE, "agent");
            asm volatile("s_waitcnt vmcnt(0)" ::: "memory");
        }
    }
    __syncthreads();
}

typedef unsigned short bf16_t;
constexpr int NB = 4, SEQ = 2048, DM = 2048, NT = NB * SEQ;
constexpr int NH = 8, NG = 2, HD = 128, INW = 3608, INWP = 3840;
constexpr int NCMP = 127, NSEL = 32, NEXP = 32, FF = 512;
constexpr float EPS = 1e-6f;
constexpr float SCALE = 0.08838834764831845f;
constexpr int NTHREADS = 512, NWAVES = 8;
constexpr int LDS_BYTES = 147456;
constexpr int YROWS = 24576;

enum { I_X = 0, I_POS, I_LNMIX, I_WIN, I_PEK, I_WK1, I_WK2, I_PEV, I_WV1, I_WV2, I_WPOOL, I_BPOOL, I_PSCALE, I_GNNSA, I_GNPOOL, I_WOUT, I_LNMOE,
       I_WRG, I_BRG, I_WRE, I_BRE, I_WGATE, I_WUP, I_WDOWN, I_LNFINAL, N_IN };

constexpr size_t MB = 1024 * 1024;
constexpr size_t WS_CTL   = 0;
constexpr size_t CTL_ZERO_BYTES = 32768;
constexpr int    CW_CNT   = 4096;
constexpr size_t WS_RSTD1 = 1 * MB;
constexpr size_t WS_RSTD2 = 1 * MB + 65536;
constexpr size_t WS_BIAS1 = 1 * MB + 131072;
constexpr size_t WS_AROW  = 1 * MB + 262144;
constexpr size_t WS_ROPEC = 2 * MB;
constexpr size_t WS_ROPES = 2 * MB + 524288;
constexpr size_t WS_GATES = 3 * MB;
constexpr size_t WS_TOKL  = 4 * MB;
constexpr size_t WS_GATEL = 5 * MB;
constexpr size_t WS_HID   = 6 * MB;
constexpr size_t WS_CMPKV = 8 * MB;
constexpr size_t WS_WINT  = 9 * MB;
constexpr size_t WS_WOUTT = 24 * MB;
constexpr size_t WS_W1T   = 32 * MB;
constexpr size_t WS_W2T   = 160 * MB;
constexpr size_t WS_CMPW  = 224 * MB;
constexpr size_t WS_POOLW = 228 * MB;
constexpr size_t WS_POOLB = 228 * MB + 524288;
constexpr size_t WS_CPART = 447 * MB;
constexpr size_t WS_DBUF  = 463 * MB;
constexpr size_t WS_XB    = 230 * MB;
constexpr size_t WS_QN    = 262 * MB;
constexpr size_t WS_QR    = 278 * MB;
constexpr size_t WS_KV    = 294 * MB;
constexpr size_t WS_U     = 319 * MB;
constexpr size_t WS_Y     = 230 * MB;
constexpr size_t WS_OWIN  = 351 * MB;
constexpr size_t WS_OCMP  = 367 * MB;
constexpr size_t WS_OSEL  = 319 * MB;
constexpr size_t WS_ML    = 6 * MB;
constexpr size_t WS_X1B   = 351 * MB;
constexpr size_t WS_OPOOL = 383 * MB;
constexpr size_t WS_ACT   = 383 * MB;
constexpr size_t WS_MIX   = 415 * MB;
constexpr size_t WS_END   = 479 * MB;

__device__ __forceinline__ bf16_t f2bf(float f) { unsigned u = __float_as_uint(f); u += 0x7FFFu + ((u >> 16) & 1u); return (bf16_t)(u >> 16); }
__device__ __forceinline__ float bf2f(bf16_t b) { return __uint_as_float(((unsigned)b) << 16); }
__device__ __forceinline__ float wave_sum(float v) {
#pragma unroll
    for (int o = 32; o >= 1; o >>= 1) v += __shfl_xor(v, o);
    return v;
}
__device__ __forceinline__ float wave_max(float v) {
#pragma unroll
    for (int o = 32; o >= 1; o >>= 1) v = fmaxf(v, __shfl_xor(v, o));
    return v;
}

struct Args { const float* in[N_IN]; float* out; unsigned char* ws; int ph_lo, ph_hi; };

struct Frame {
    const float* in[N_IN]; float* out; unsigned char* ws;
    float* lds;
    int tid, lane, wave, G, bid;
};

template <int NACC, bool B_KFAST, class FA, class FB, class FE>
__device__ __forceinline__ void ngemm_tile(const Frame& F, int K, FA fa, FB fb, FE fe) {
    float* As = F.lds;
    float* Bs = F.lds + 1024;
    const int tid = F.tid, ty = tid >> 4, tx = tid & 15;
    float acc[NACC][2][4];
#pragma unroll
    for (int w = 0; w < NACC; ++w)
#pragma unroll
        for (int i = 0; i < 2; ++i)
#pragma unroll
            for (int j = 0; j < 4; ++j) acc[w][i][j] = 0.f;
    for (int k0 = 0; k0 < K; k0 += 16) {
#pragma unroll
        for (int i = 0; i < 2; ++i) { const int idx = tid + 512 * i, m = idx >> 4, kk = idx & 15; As[kk * 64 + m] = fa(m, k0 + kk); }
#pragma unroll
        for (int w = 0; w < NACC; ++w)
#pragma unroll
            for (int i = 0; i < 2; ++i) { const int idx = tid + 512 * i; int kk, n; if (B_KFAST) { n = idx >> 4; kk = idx & 15; } else { kk = idx >> 6; n = idx & 63; }
                Bs[w * 1024 + kk * 64 + n] = fb(w, k0 + kk, n); }
        __syncthreads();
#pragma unroll
        for (int kk = 0; kk < 16; ++kk) {
            const float a0 = As[kk * 64 + 2 * ty], a1 = As[kk * 64 + 2 * ty + 1];
#pragma unroll
            for (int w = 0; w < NACC; ++w) {
                const float4 b = *(const float4*)&Bs[w * 1024 + kk * 64 + 4 * tx];
                acc[w][0][0] += a0 * b.x; acc[w][0][1] += a0 * b.y; acc[w][0][2] += a0 * b.z; acc[w][0][3] += a0 * b.w;
                acc[w][1][0] += a1 * b.x; acc[w][1][1] += a1 * b.y; acc[w][1][2] += a1 * b.z; acc[w][1][3] += a1 * b.w;
            }
        }
        __syncthreads();
    }
#pragma unroll
    for (int i = 0; i < 2; ++i)
#pragma unroll
        for (int j = 0; j < 4; ++j) fe(2 * ty + i, 4 * tx + j, acc[0][i][j], acc[NACC - 1][i][j]);
}

template <class KR>
__device__ __forceinline__ void nattn(const float* qv, float* sc, int nkeys, KR keyrow, const bf16_t* Kb, const bf16_t* Vb, int lane, float& o0, float& o1, float& inv_sum) {
    float mx = -3.0e38f;
    for (int i = lane; i < nkeys; i += 64) {
        const int kr = keyrow(i);
        float s = -3.0e38f;
        if (kr >= 0) {
            const bf16_t* kp = Kb + (size_t)kr * HD;
            float a = 0.f;
#pragma unroll 8
            for (int d = 0; d < HD; d += 2) { const unsigned w = *(const unsigned*)(kp + d); a += qv[d] * __uint_as_float(w << 16) + qv[d + 1] * __uint_as_float(w & 0xFFFF0000u); }
            s = a * SCALE;
        }
        sc[i] = s; mx = fmaxf(mx, s);
    }
    mx = wave_max(mx);
    if (mx < -1.0e38f) { o0 = 0.f; o1 = 0.f; inv_sum = 0.f; for (int i = lane; i < nkeys; i += 64) sc[i] = 0.f; return; }
    float sum = 0.f;
    for (int i = lane; i < nkeys; i += 64) { const float s = sc[i]; const float e = (s < -1.0e38f) ? 0.f : __expf(s - mx); sc[i] = e; sum += e; }
    sum = wave_sum(sum);
    inv_sum = 1.f / sum;
    float a0 = 0.f, a1 = 0.f;
    for (int i = 0; i < nkeys; ++i) {
        const float p = sc[i];
        if (p != 0.f) { const int kr = keyrow(i); const bf16_t* vp = Vb + (size_t)kr * HD; a0 += p * bf2f(vp[lane]); a1 += p * bf2f(vp[lane + 64]); }
    }
    o0 = a0 * inv_sum; o1 = a1 * inv_sum;
}

__device__ __forceinline__ float gelu_tanh(float x) { const float u = 0.7978845608028654f * (x + 0.044715f * x * x * x); return 0.5f * x * (1.f + tanhf(u)); }


namespace pg8 {
typedef short bf16x8 __attribute__((ext_vector_type(8)));
typedef float f32x4 __attribute__((ext_vector_type(4)));
typedef unsigned u32x4 __attribute__((ext_vector_type(4)));
constexpr int BM = 256, BK = 64, HALF = 128, HTB = HALF * BK * 2, STAGE_BYTES = 8 * HTB, NXCD = 8, WGM = 8;
__device__ __forceinline__ int lds_byte(int r, int c) { const int st = (r >> 4) * 2 + (c >> 5), rr = r & 15, cc = c & 31, ob = rr * 64 + cc * 2; return st * 1024 + (ob ^ (((ob >> 9) & 1) << 5)); }
__device__ __forceinline__ void stage_rc(int b, int& R, int& C) { const int st = b / 1024, sb = b % 1024, swz = sb ^ (((sb >> 9) & 1) << 5); R = (st >> 1) * 16 + swz / 64; C = (st & 1) * 32 + (swz % 64) / 2; }
struct Unit { int pm, pn, e, li; };
__device__ __forceinline__ unsigned cvt_pk_bf16(float lo, float hi) { unsigned r; asm volatile("v_cvt_pk_bf16_f32 %0, %1, %2" : "=v"(r) : "v"(lo), "v"(hi)); return r; }

struct DenseOrder {
    const char* A; const char* Bt; int lda, ldb; int nM, nN, nwg, G, c;
    __device__ void init(const void* A_, const void* Bt_, int lda_, int ldb_, int M, int N, int G_, int c_) { A = (const char*)A_; Bt = (const char*)Bt_; lda = lda_; ldb = ldb_; nM = M / BM; nN = N / BM; nwg = nM * nN; G = G_; c = c_; }
    __device__ __forceinline__ bool next(int i, Unit& u) const {
        const long L = (long)i * G + c; if (L >= nwg) return false;
        int wgid = (int)L; { const int q = nwg / NXCD, r = nwg % NXCD, xcd = wgid % NXCD, off = wgid / NXCD; wgid = (xcd < r ? xcd * (q + 1) : r * (q + 1) + (xcd - r) * q) + off; }
        const int nig = WGM * nN, gid = wgid / nig, fm = gid * WGM, gsz = (nM - fm) < WGM ? (nM - fm) : WGM;
        u.pm = fm + ((wgid % nig) % gsz); u.pn = (wgid % nig) / gsz; u.e = 0; u.li = i; return true;
    }
    __device__ __forceinline__ const char* a_base(const Unit& u) const { return A + (size_t)u.pm * BM * lda * 2; }
    __device__ __forceinline__ const char* b_base(const Unit& u) const { return Bt + (size_t)u.pn * BM * ldb * 2; }
    __device__ __forceinline__ unsigned a_row_off(const Unit&, int r) const { return (unsigned)r * (unsigned)lda * 2u; }
};

template <class Epi, class Sched, bool GATHER>
__device__ __forceinline__ void gemm_phase(LAS unsigned char* lds, const int K, const int lda, const int ldb, const Sched& S, const Epi& E) {
    const int tid = threadIdx.x, wid = __builtin_amdgcn_readfirstlane(tid >> 6), lane = tid & 63, wr = wid >> 2, wc = wid & 3, fr = lane & 15, fq = lane >> 4;
    const int nt = K / BK;
    int sR[2], sC[2];
#pragma unroll
    for (int i = 0; i < 2; ++i) stage_rc(tid * 16 + i * 8192, sR[i], sC[i]);
    unsigned voffB[2], voffA[2][2], nvoffA[2][2];
#pragma unroll
    for (int i = 0; i < 2; ++i) voffB[i] = (unsigned)(sR[i] * ldb + sC[i]) * 2u;
    const size_t kstep = (size_t)(BK * 2);
    const size_t hstepB = (size_t)HALF * ldb * 2;
    const unsigned ldsw = (unsigned)wid * 1024u;
    const int aoff = lds_byte(wr * 64 + fr, fq * 8), boff = lds_byte(wc * 32 + fr, fq * 8);
#define PG8_SA(b, h) (((b) * 2 + (h)) * HTB)
#define PG8_SB(b, h) ((4 + (b) * 2 + (h)) * HTB)
#define PG8_STAGE(bufoff, gbase, voff) do { _Pragma("unroll") for (int _i = 0; _i < 2; ++_i) \
        __builtin_amdgcn_global_load_lds((const unsigned*)((const char*)(gbase) + (voff)[_i]), (LAS unsigned*)(lds + (bufoff) + ldsw + _i * 8192), 16, 0, 0); } while (0)
#define PG8_LDA(dst, b, h) do { _Pragma("unroll") for (int m = 0; m < 4; ++m) _Pragma("unroll") for (int k = 0; k < 2; ++k) dst[m][k] = *(const LAS bf16x8*)(lds + PG8_SA(b, h) + aoff + m * 2048 + k * 1024); } while (0)
#define PG8_LDB(dst, b, h) do { _Pragma("unroll") for (int n = 0; n < 2; ++n) _Pragma("unroll") for (int k = 0; k < 2; ++k) dst[n][k] = *(const LAS bf16x8*)(lds + PG8_SB(b, h) + boff + n * 2048 + k * 1024); } while (0)
#define PG8_MMA(ai, bj, At, Bt) do { __builtin_amdgcn_s_setprio(1); _Pragma("unroll") for (int m = 0; m < 4; ++m) _Pragma("unroll") for (int n = 0; n < 2; ++n) _Pragma("unroll") for (int k = 0; k < 2; ++k) \
        acc[ai][bj][m][n] = __builtin_amdgcn_mfma_f32_16x16x32_bf16(Bt[n][k], At[m][k], acc[ai][bj][m][n], 0, 0, 0); __builtin_amdgcn_s_setprio(0); } while (0)
#define PG8_WAIT_V(n) asm volatile("s_waitcnt vmcnt(" #n ")" ::: "memory")
#define PG8_WAIT_L(n) asm volatile("s_waitcnt lgkmcnt(" #n ")" ::: "memory")
#define PG8_BAR __builtin_amdgcn_s_barrier()
#define PG8_SCHED __builtin_amdgcn_sched_barrier(0)
#define PG8_AOFFS(dst, u) do { _Pragma("unroll") for (int _h = 0; _h < 2; ++_h) _Pragma("unroll") for (int _i = 0; _i < 2; ++_i) dst[_h][_i] = S.a_row_off(u, _h * HALF + sR[_i]) + (unsigned)sC[_i] * 2u; } while (0)
    Unit cur, nxt; int ui = 0;
    if (!S.next(0, cur)) return;
    f32x4 acc[2][2][4][2];
#pragma unroll
    for (int a = 0; a < 2; ++a)
#pragma unroll
        for (int b = 0; b < 2; ++b)
#pragma unroll
            for (int m = 0; m < 4; ++m)
#pragma unroll
                for (int n = 0; n < 2; ++n) acc[a][b][m][n] = (f32x4){0.f, 0.f, 0.f, 0.f};
    bf16x8 At[4][2], B0[2][2], B1[2][2];
    const char* cA = S.a_base(cur); const char* cB = S.b_base(cur);
    PG8_AOFFS(voffA, cur);
    PG8_STAGE(PG8_SB(0, 0), cB, voffB); PG8_STAGE(PG8_SA(0, 0), cA, voffA[0]); PG8_STAGE(PG8_SB(0, 1), cB + hstepB, voffB); PG8_STAGE(PG8_SA(0, 1), cA, voffA[1]);
    if (wr == 1) PG8_BAR;
    PG8_WAIT_V(4); PG8_BAR;
    PG8_STAGE(PG8_SB(1, 0), cB + kstep, voffB); PG8_STAGE(PG8_SA(1, 0), cA + kstep, voffA[0]); PG8_STAGE(PG8_SB(1, 1), cB + hstepB + kstep, voffB);
    PG8_WAIT_V(6); PG8_BAR;
    for (;;) {
        const bool has_next = S.next(ui + 1, nxt);
        const char* nA = has_next ? S.a_base(nxt) : cA; const char* nB = has_next ? S.b_base(nxt) : cB;
        if (GATHER) { if (has_next) { PG8_AOFFS(nvoffA, nxt); } else {
#pragma unroll
            for (int _h = 0; _h < 2; ++_h)
#pragma unroll
                for (int _i = 0; _i < 2; ++_i) nvoffA[_h][_i] = voffA[_h][_i]; } }
        for (int t = 0; t < nt; t += 2) {
            const bool last = (t == nt - 2);
            const char* a1 = cA + (size_t)(t + 1) * kstep;
            const char* a2 = last ? nA : cA + (size_t)(t + 2) * kstep; const char* b2 = last ? nB : cB + (size_t)(t + 2) * kstep;
            const char* a3 = a2 + kstep; const char* b3 = b2 + kstep;
            unsigned vA2[2][2];
#pragma unroll
            for (int _h = 0; _h < 2; ++_h)
#pragma unroll
                for (int _i = 0; _i < 2; ++_i) vA2[_h][_i] = (GATHER && last) ? nvoffA[_h][_i] : voffA[_h][_i];
            PG8_LDB(B0, 0, 0); PG8_SCHED; PG8_LDA(At, 0, 0); PG8_STAGE(PG8_SA(1, 1), a1, voffA[1]);
            PG8_WAIT_L(8); PG8_BAR; PG8_WAIT_L(0); PG8_MMA(0, 0, At, B0); PG8_BAR; PG8_SCHED;
            PG8_LDB(B1, 0, 1); PG8_STAGE(PG8_SB(0, 0), b2, voffB);
            PG8_BAR; PG8_WAIT_L(0); PG8_MMA(0, 1, At, B1); PG8_BAR;
            PG8_LDA(At, 0, 1); PG8_STAGE(PG8_SA(0, 0), a2, vA2[0]);
            PG8_BAR; PG8_WAIT_L(0); PG8_MMA(1, 0, At, B0); PG8_BAR; PG8_SCHED;
            PG8_STAGE(PG8_SB(0, 1), b2 + hstepB, voffB);
            PG8_WAIT_V(6); PG8_BAR; PG8_MMA(1, 1, At, B1); PG8_BAR;
            PG8_LDB(B0, 1, 0); PG8_SCHED; PG8_LDA(At, 1, 0); PG8_STAGE(PG8_SA(0, 1), a2, vA2[1]);
            PG8_WAIT_L(8); PG8_BAR; PG8_WAIT_L(0); PG8_MMA(0, 0, At, B0); PG8_BAR; PG8_SCHED;
            PG8_LDB(B1, 1, 1); PG8_STAGE(PG8_SB(1, 0), b3, voffB);
            PG8_BAR; PG8_WAIT_L(0); PG8_MMA(0, 1, At, B1); PG8_BAR;
            PG8_LDA(At, 1, 1); PG8_STAGE(PG8_SA(1, 0), a3, vA2[0]);
            PG8_BAR; PG8_WAIT_L(0); PG8_MMA(1, 0, At, B0); PG8_BAR; PG8_SCHED;
            PG8_STAGE(PG8_SB(1, 1), b3 + hstepB, voffB);
            PG8_WAIT_V(6); PG8_BAR; PG8_MMA(1, 1, At, B1); PG8_BAR;
        }
        E(acc, cur, wr, wc, fr, fq);
        if (!has_next) break;
#pragma unroll
        for (int a = 0; a < 2; ++a)
#pragma unroll
            for (int b = 0; b < 2; ++b)
#pragma unroll
                for (int m = 0; m < 4; ++m)
#pragma unroll
                    for (int n = 0; n < 2; ++n) acc[a][b][m][n] = (f32x4){0.f, 0.f, 0.f, 0.f};
        cur = nxt; cA = nA; cB = nB; ++ui;
        if (GATHER) {
#pragma unroll
            for (int _h = 0; _h < 2; ++_h)
#pragma unroll
                for (int _i = 0; _i < 2; ++_i) voffA[_h][_i] = nvoffA[_h][_i]; }
    }
    PG8_WAIT_V(0);
    if (wr == 0) PG8_BAR;
    PG8_BAR;
#undef PG8_SA
#undef PG8_SB
#undef PG8_STAGE
#undef PG8_LDA
#undef PG8_LDB
#undef PG8_MMA
#undef PG8_WAIT_V
#undef PG8_WAIT_L
#undef PG8_BAR
#undef PG8_SCHED
#undef PG8_AOFFS
}
}

__device__ __forceinline__ void transpose_tile(const Frame& F, const float* src, int lds_, bf16_t* dstrow0, int ldd, int k0, int n0, const float* kscale) {
    float* T = F.lds;
    const int tid = F.tid, kk = tid >> 4, n4 = (tid & 15) * 4;
#pragma unroll
    for (int i = 0; i < 2; ++i) { const int k = kk + 32 * i; float4 v = *(const float4*)(src + (size_t)(k0 + k) * lds_ + n0 + n4); const float sc = kscale ? kscale[k0 + k] : 1.f;
        T[(n4 + 0) * 65 + k] = v.x * sc; T[(n4 + 1) * 65 + k] = v.y * sc; T[(n4 + 2) * 65 + k] = v.z * sc; T[(n4 + 3) * 65 + k] = v.w * sc; }
    __syncthreads();
    { const int n = tid >> 3, k8 = (tid & 7) * 8; const float* t = T + n * 65 + k8;
      pg8::u32x4 w; w.x = pg8::cvt_pk_bf16(t[0], t[1]); w.y = pg8::cvt_pk_bf16(t[2], t[3]); w.z = pg8::cvt_pk_bf16(t[4], t[5]); w.w = pg8::cvt_pk_bf16(t[6], t[7]);
      *(pg8::u32x4*)(dstrow0 + (size_t)n * ldd + k0 + k8) = w; }
    __syncthreads();
}


namespace att {
typedef short bf16x8 __attribute__((ext_vector_type(8)));
typedef short s16x4 __attribute__((ext_vector_type(4)));
typedef float f32x16 __attribute__((ext_vector_type(16)));
typedef float f32x4 __attribute__((ext_vector_type(4)));
typedef unsigned u32x4 __attribute__((ext_vector_type(4)));
constexpr int SHM = 16384;
constexpr int L_V = 0, L_K = 2 * SHM, L_WS = 4 * SHM, L_PART = L_WS + 8 * 64 * 4, L_SELM = L_PART + 4 * 64 * 33 * 4, L_VALS = L_SELM + 256, L_ITEM = L_VALS + 8 * 64 * 4, L_END = L_ITEM + 16;
constexpr float C2 = 1.4426950408889634f * SCALE;
#define KSWZ(row, colB) ((row) * 256 + ((colB) ^ (((row) & 7) << 4)))
#define SBAR() __builtin_amdgcn_sched_barrier(0)
__device__ __forceinline__ int v_st(int k, int c) { const int kk = (k & ~0xC) | ((k & 4) << 1) | ((k & 8) >> 1); return ((kk >> 3) * 4 + (c >> 5)) * 512 + ((kk & 7) * 32 + (c & 31)) * 2; }
__device__ __forceinline__ int v_rd_base(int lane) { return ((lane & 3) << 3) | (((lane >> 2) & 3) << 6) | (((lane >> 4) & 1) << 5) | (((lane >> 5) & 1) << 8); }
constexpr int v_rd_off(int d0, int ks, int half) { return d0 * 512 + ks * 4096 + half * 2048; }
__device__ __forceinline__ int crow(int r, int hi) { return (r & 3) + 8 * (r >> 2) + 4 * hi; }
__device__ __forceinline__ unsigned cvtpk(float lo, float hi) { unsigned r; asm volatile("v_cvt_pk_bf16_f32 %0, %1, %2" : "=v"(r) : "v"(lo), "v"(hi)); return r; }
__device__ __forceinline__ float swap_max(float v) { auto rr = __builtin_amdgcn_permlane32_swap(__float_as_uint(v), __float_as_uint(v), false, false); return fmaxf(__uint_as_float(rr[0]), __uint_as_float(rr[1])); }
__device__ __forceinline__ float swap_sum(float v) { auto rr = __builtin_amdgcn_permlane32_swap(__float_as_uint(v), __float_as_uint(v), false, false); return __uint_as_float(rr[0]) + __uint_as_float(rr[1]); }

struct WV { int tid, wid, lane, r32, hi, vb0; unsigned ksrc[2], vsrc[2]; char* lds; LAS unsigned char* ldsL; };
__device__ __forceinline__ void wv_src_init(WV& w) {
#pragma unroll
    for (int i = 0; i < 2; ++i) {
        const int L = (w.wid * 2 + i) * 1024 + w.lane * 16;
        { const int row = L >> 8, colB = (L & 255) ^ ((row & 7) << 4); w.ksrc[i] = (unsigned)(row * 256 + colB); }
        { const int sub = L >> 9, kkhi = sub >> 2, cblk = sub & 3, within = L & 511, kklo = within >> 6, cc = (within >> 1) & 31;
          const int kk = kkhi * 8 + kklo, k = (kk & ~0xC) | ((kk & 4) << 1) | ((kk & 8) >> 1), c = cblk * 32 + cc; w.vsrc[i] = (unsigned)(k * 256 + c * 2); }
    }
}
__device__ __forceinline__ void dma_tile(const WV& w, const bf16_t* Kt, const bf16_t* Vt, int buf) {
    int ln = w.lane; asm volatile("" : "+v"(ln));
#pragma unroll
    for (int i = 0; i < 2; ++i) {
        const int L = (w.wid * 2 + i) * 1024 + ln * 16;
        const int row = L >> 8, colB = (L & 255) ^ ((row & 7) << 4); const unsigned ksrc = (unsigned)(row * 256 + colB);
        const int sub = L >> 9, kkhi = sub >> 2, cblk = sub & 3, within = L & 511, kklo = within >> 6, cc = (within >> 1) & 31;
        const int kk = kkhi * 8 + kklo, k = (kk & ~0xC) | ((kk & 4) << 1) | ((kk & 8) >> 1), c = cblk * 32 + cc; const unsigned vsrc = (unsigned)(k * 256 + c * 2);
        __builtin_amdgcn_global_load_lds((const unsigned*)((const char*)Vt + vsrc), (LAS unsigned*)(w.ldsL + L_V + buf * SHM + (w.wid * 2 + i) * 1024), 16, 0, 0);
        __builtin_amdgcn_global_load_lds((const unsigned*)((const char*)Kt + ksrc), (LAS unsigned*)(w.ldsL + L_K + buf * SHM + (w.wid * 2 + i) * 1024), 16, 0, 0);
    }
}
__device__ __forceinline__ void qkt(const WV& w, int buf, const bf16x8 (&qr)[8], f32x16& p0, f32x16& p1) {
    p0 = f32x16{}; p1 = f32x16{};
    const char* kb[4];
#pragma unroll
    for (int dd = 0; dd < 4; ++dd) kb[dd] = w.lds + L_K + buf * SHM + KSWZ(w.r32, (dd * 16 + w.hi * 8) * 2);
#pragma unroll
    for (int d0 = 0; d0 < 8; ++d0) { const char* a = kb[d0 & 3] + (d0 >> 2) * 128;
        const bf16x8 b0 = *reinterpret_cast<const bf16x8*>(a); const bf16x8 b1 = *reinterpret_cast<const bf16x8*>(a + 32 * 256);
        p0 = __builtin_amdgcn_mfma_f32_32x32x16_bf16(b0, qr[d0], p0, 0, 0, 0);
        p1 = __builtin_amdgcn_mfma_f32_32x32x16_bf16(b1, qr[d0], p1, 0, 0, 0);
        if (d0 == 3) SBAR(); }
}
__device__ __forceinline__ void pack_p(const f32x16& p0, const f32x16& p1, bf16x8& pa0, bf16x8& pa1, bf16x8& pa2, bf16x8& pa3) {
#define PK4(P, B_, OUT) do { unsigned a0 = cvtpk(P[B_+0], P[B_+1]), a1 = cvtpk(P[B_+2], P[B_+3]); unsigned b0 = cvtpk(P[B_+4], P[B_+5]), b1 = cvtpk(P[B_+6], P[B_+7]); \
        auto r0 = __builtin_amdgcn_permlane32_swap(a0, b0, false, false); auto r1 = __builtin_amdgcn_permlane32_swap(a1, b1, false, false); \
        u32x4 w_ = {r0[0], r1[0], r0[1], r1[1]}; OUT = *reinterpret_cast<bf16x8*>(&w_); } while (0)
    PK4(p0, 0, pa0); PK4(p0, 8, pa1); PK4(p1, 0, pa2); PK4(p1, 8, pa3);
#undef PK4
}
template <int VB>
__device__ __forceinline__ void pv_tile(f32x16* o, int vb0, bf16x8 pa0, bf16x8 pa1, bf16x8 pa2, bf16x8 pa3) {
#define TRRD(dst, off) asm volatile("ds_read_b64_tr_b16 %0, %1 offset:%2" : "=&v"(dst) : "v"(vb0), "i"(off) : "memory")
#define PV_D0(d0) do { s16x4 l0, l1, l2, l3, h0, h1, h2, h3; constexpr int b_ = L_V + VB * SHM + v_rd_off(d0, 0, 0); \
        TRRD(l0, b_); TRRD(h0, b_ + 2048); TRRD(l1, b_ + 4096); TRRD(h1, b_ + 6144); TRRD(l2, b_ + 8192); TRRD(h2, b_ + 10240); TRRD(l3, b_ + 12288); TRRD(h3, b_ + 14336); \
        asm volatile("s_waitcnt lgkmcnt(0)" ::: "memory"); SBAR(); \
        o[d0] = __builtin_amdgcn_mfma_f32_32x32x16_bf16(pa0, (bf16x8){l0[0], l0[1], l0[2], l0[3], h0[0], h0[1], h0[2], h0[3]}, o[d0], 0, 0, 0); \
        o[d0] = __builtin_amdgcn_mfma_f32_32x32x16_bf16(pa1, (bf16x8){l1[0], l1[1], l1[2], l1[3], h1[0], h1[1], h1[2], h1[3]}, o[d0], 0, 0, 0); \
        o[d0] = __builtin_amdgcn_mfma_f32_32x32x16_bf16(pa2, (bf16x8){l2[0], l2[1], l2[2], l2[3], h2[0], h2[1], h2[2], h2[3]}, o[d0], 0, 0, 0); \
        o[d0] = __builtin_amdgcn_mfma_f32_32x32x16_bf16(pa3, (bf16x8){l3[0], l3[1], l3[2], l3[3], h3[0], h3[1], h3[2], h3[3]}, o[d0], 0, 0, 0); } while (0)
    PV_D0(0); PV_D0(1); PV_D0(2); PV_D0(3);
#undef PV_D0
#undef TRRD
}
__device__ __forceinline__ void store_o(const WV& w, const f32x16* o, const float* tab, bf16_t* outp) {
    bf16_t* lp = outp + (size_t)w.hi * 4096 + w.r32;
#pragma unroll
    for (int r = 0; r < 16; ++r) { const int q = crow(r, w.hi); const float sc = tab[q];
        bf16_t* p = lp; asm volatile("" : "+v"(p));
        p += ((r & 3) + 8 * (r >> 2)) * 1024;
#pragma unroll
        for (int d0 = 0; d0 < 4; ++d0) { const float v = o[d0][r] * sc; const float vn = __shfl_xor(v, 1);
            if ((w.r32 & 1) == 0) *(__attribute__((address_space(1))) unsigned*)(p + d0 * 32) = cvtpk(v, vn); } }
}

template <int MODE>
__device__ __forceinline__ void flash_pass(const WV& w, const bf16_t* Kp, const bf16_t* Vp, int j_lo, int j_hi, const bf16x8 (&qr)[8], int tpos, int tw0, unsigned selmask,
                                           f32x16 (&o)[4], float& m_reg, float& l_reg) {
    float* al_l = (float*)(w.lds + L_WS) + w.wid * 64;
    dma_tile(w, Kp + (size_t)j_lo * 64 * HD, Vp + (size_t)j_lo * 64 * HD, 0);
    int buf = 0;
    for (int j = j_lo; j < j_hi; ++j) {
        asm volatile("s_waitcnt vmcnt(0)" ::: "memory");
        __syncthreads();
        if (j + 1 < j_hi) dma_tile(w, Kp + (size_t)(j + 1) * 64 * HD, Vp + (size_t)(j + 1) * 64 * HD, buf ^ 1);
        f32x16 p0, p1;
        if (buf == 0) qkt(w, 0, qr, p0, p1); else qkt(w, 1, qr, p0, p1);
        const int kb = j * 64;
        { const float NEG = -__builtin_inff();
          const bool need = (kb + 63 > tw0) || (MODE == 1 && kb <= tw0 + 31 - 512);
          if (need) { const int dq = tpos - kb - 4 * w.hi; const unsigned W = (MODE == 1) ? 512u : 0x7fffffffu;
#pragma unroll
              for (int r = 0; r < 16; ++r) { const int c = (r & 3) + 8 * (r >> 2); if ((unsigned)(dq - c) >= W) p0[r] = NEG; if ((unsigned)(dq - c - 32) >= W) p1[r] = NEG; } }
          if (MODE == 0) { const bool sel = (selmask >> j) & 1u;
              if (!__all(sel)) {
#pragma unroll
                  for (int r = 0; r < 16; ++r) { p0[r] = sel ? p0[r] : NEG; p1[r] = sel ? p1[r] : NEG; } } }
        }
        float pmax = p0[0];
#pragma unroll
        for (int r = 1; r < 16; ++r) pmax = fmaxf(pmax, p0[r]);
#pragma unroll
        for (int r = 0; r < 16; ++r) pmax = fmaxf(pmax, p1[r]);
        pmax = swap_max(pmax);
        const float mn = fmaxf(m_reg, pmax);
        const float alpha = __builtin_amdgcn_exp2f((m_reg - mn) * C2);
        m_reg = mn;
        const float mnL = -mn * C2;
        float ps = 0.f;
#pragma unroll
        for (int r = 0; r < 16; ++r) { p0[r] = __builtin_amdgcn_exp2f(fmaf(p0[r], C2, mnL)); ps += p0[r]; }
#pragma unroll
        for (int r = 0; r < 16; ++r) { p1[r] = __builtin_amdgcn_exp2f(fmaf(p1[r], C2, mnL)); ps += p1[r]; }
        ps = swap_sum(ps);
        l_reg = l_reg * alpha + ps;
        if (__any(alpha < 1.f)) {
            if (w.hi == 0) al_l[w.r32] = alpha;
            asm volatile("s_waitcnt lgkmcnt(0)" ::: "memory");
#pragma unroll
            for (int r = 0; r < 16; ++r) { const float a = al_l[crow(r, w.hi)];
#pragma unroll
                for (int d = 0; d < 4; ++d) o[d][r] *= a; }
        }
        bf16x8 pa0, pa1, pa2, pa3;
        pack_p(p0, p1, pa0, pa1, pa2, pa3);
        if (buf == 0) pv_tile<0>(o, w.vb0, pa0, pa1, pa2, pa3); else pv_tile<1>(o, w.vb0, pa0, pa1, pa2, pa3);
        buf ^= 1;
    }
    __syncthreads();
}
}

__device__ const unsigned char ATT_ITEMS[80] = {15, 30, 31, 63, 14, 28, 29, 61, 62, 13, 26, 27, 59, 60, 12, 24, 25, 57, 58, 11, 22, 23, 55, 56, 10, 20, 21, 53, 54, 9, 18, 19, 51, 52, 8, 16, 17, 49, 50, 7, 48, 6, 5,
    72, 73, 74, 75, 76, 77, 78, 79, 80, 81, 82, 83, 84, 85, 86, 87, 88, 89, 90, 91, 92, 93, 94, 95, 4, 71, 3, 70, 2, 69, 1, 68, 0, 67, 66, 65, 64};
constexpr int CW_QUEUE = 6144;

__device__ __forceinline__ void p_attn(const Frame& F, unsigned char* lds_raw) {
    using namespace att;
    WV w; w.tid = F.tid; w.wid = F.wave; w.lane = F.lane; w.r32 = F.lane & 31; w.hi = F.lane >> 5;
    w.lds = (char*)lds_raw + 1024; w.ldsL = (LAS unsigned char*)lds_raw + 1024;
    w.vb0 = (int)(uintptr_t)(w.lds) + v_rd_base(w.lane);
    const bf16_t* qn = (const bf16_t*)(F.ws + WS_QN); const bf16_t* qrp = (const bf16_t*)(F.ws + WS_QR); const bf16_t* kv = (const bf16_t*)(F.ws + WS_KV);
    const bf16_t* ckv = (const bf16_t*)(F.ws + WS_CMPKV);
    bf16_t* ocmp = (bf16_t*)(F.ws + WS_OCMP); bf16_t* owin = (bf16_t*)(F.ws + WS_OWIN); bf16_t* osel = (bf16_t*)(F.ws + WS_OSEL); float* ml = (float*)(F.ws + WS_ML);
    unsigned* qctr = (unsigned*)(F.ws + WS_CTL) + CW_QUEUE;
    float* wsf = (float*)(w.lds + L_WS) + w.wid * 64;
    float* part = (float*)(w.lds + L_PART); unsigned* selm = (unsigned*)(w.lds + L_SELM); float* vals = (float*)(w.lds + L_VALS) + w.wid * 64; volatile int* itemw = (volatile int*)(w.lds + L_ITEM);
    const int hr = w.wid >> 1, th = w.wid & 1;
    for (;;) {
        __syncthreads();
        if (F.tid == 0) itemw[0] = (int)atomicAdd(qctr, 1u);
        __syncthreads();
        const int item = itemw[0];
        if (item >= 640) break;
        const int ent = ATT_ITEMS[item >> 3], bg = item & 7, type = ent >> 5, qb = ent & 31, b = bg >> 1, g = bg & 1, h = 4 * g + hr;
        const int t0 = qb * 64 + th * 32, tpos = t0 + w.r32, tok0 = b * SEQ + t0;
        const size_t qoff = (((size_t)b * NH + h) * SEQ + t0 + w.r32) * HD + w.hi * 8;
        const size_t kvoff = ((size_t)b * NG + g) * SEQ * HD;
        bf16x8 qr[8];
        f32x16 o[4];
#ifndef ATT_NO_WIN
        if (type == 2) {
#pragma unroll
            for (int d0 = 0; d0 < 8; ++d0) qr[d0] = *(const bf16x8*)(qrp + qoff + d0 * 16);
#pragma unroll
            for (int d = 0; d < 4; ++d) o[d] = f32x16{};
            float m_reg = -1e30f, l_reg = 0.f;
            flash_pass<1>(w, kv + (size_t)4 * (4 * MB / 2) + kvoff, kv + (size_t)5 * (4 * MB / 2) + kvoff, qb >= 8 ? qb - 8 : 0, qb + 1, qr, tpos, t0, 0u, o, m_reg, l_reg);
            if (w.hi == 0) wsf[w.r32] = 1.f / l_reg;
            asm volatile("s_waitcnt lgkmcnt(0)" ::: "memory");
            store_o(w, o, wsf, owin + (size_t)tok0 * 1024 + h * HD);
            continue;
        }
#endif
#ifndef ATT_NO_CMP
        {
#pragma unroll
            for (int d0 = 0; d0 < 8; ++d0) qr[d0] = *(const bf16x8*)(qn + qoff + d0 * 16);
            const bf16_t* Kc = ckv + (size_t)bg * 128 * HD; const bf16_t* Vc = ckv + (size_t)1024 * HD + (size_t)bg * 128 * HD;
            dma_tile(w, Kc, Vc, 0); dma_tile(w, Kc + 64 * HD, Vc + 64 * HD, 1);
            asm volatile("s_waitcnt vmcnt(0)" ::: "memory");
            __syncthreads();
            f32x16 pA0, pA1, pB0, pB1;
            qkt(w, 0, qr, pA0, pA1); qkt(w, 1, qr, pB0, pB1);
            const int nmax = tpos >= 31 ? ((tpos - 31) >> 4) : -1;
            const float NEG = -__builtin_inff();
            float pmax = NEG;
#pragma unroll
            for (int r = 0; r < 16; ++r) { const int n = crow(r, w.hi);
                pA0[r] = (n <= nmax) ? pA0[r] : NEG; pA1[r] = (n + 32 <= nmax) ? pA1[r] : NEG; pB0[r] = (n + 64 <= nmax) ? pB0[r] : NEG; pB1[r] = (n + 96 <= nmax) ? pB1[r] : NEG;
                pmax = fmaxf(fmaxf(pmax, pA0[r]), fmaxf(pA1[r], fmaxf(pB0[r], pB1[r]))); }
            pmax = swap_max(pmax);
            const float mm = (pmax == NEG) ? 0.f : pmax;
            const float mnL = -mm * C2;
            float ps = 0.f;
#pragma unroll
            for (int r = 0; r < 16; ++r) { pA0[r] = __builtin_amdgcn_exp2f(fmaf(pA0[r], C2, mnL)); pA1[r] = __builtin_amdgcn_exp2f(fmaf(pA1[r], C2, mnL));
                pB0[r] = __builtin_amdgcn_exp2f(fmaf(pB0[r], C2, mnL)); pB1[r] = __builtin_amdgcn_exp2f(fmaf(pB1[r], C2, mnL)); ps += (pA0[r] + pA1[r]) + (pB0[r] + pB1[r]); }
            ps = swap_sum(ps);
            const float inv = ps > 0.f ? 1.f / ps : 0.f;
#pragma unroll
            for (int r = 0; r < 16; ++r) { pA0[r] *= inv; pA1[r] *= inv; pB0[r] *= inv; pB1[r] *= inv; }
            {
                float av[16], bv[16];
#pragma unroll
                for (int gq = 0; gq < 4; ++gq) {
                    av[gq]      = pA0[4 * gq] + pA0[4 * gq + 1] + pA0[4 * gq + 2] + 0.5f * pA0[4 * gq + 3]; bv[gq]      = 0.5f * pA0[4 * gq + 3];
                    av[4 + gq]  = pA1[4 * gq] + pA1[4 * gq + 1] + pA1[4 * gq + 2] + 0.5f * pA1[4 * gq + 3]; bv[4 + gq]  = 0.5f * pA1[4 * gq + 3];
                    av[8 + gq]  = pB0[4 * gq] + pB0[4 * gq + 1] + pB0[4 * gq + 2] + 0.5f * pB0[4 * gq + 3]; bv[8 + gq]  = 0.5f * pB0[4 * gq + 3];
                    av[12 + gq] = pB1[4 * gq] + pB1[4 * gq + 1] + pB1[4 * gq + 2] + 0.5f * pB1[4 * gq + 3]; bv[12 + gq] = 0.5f * pB1[4 * gq + 3];
                }
                float* prow = part + ((size_t)hr * 64 + th * 32 + w.r32) * 33;
#pragma unroll
                for (int idx = 0; idx < 16; ++idx) {
                    const float bo = __shfl_xor(bv[idx], 32);
                    const float bprev = (idx > 0) ? __shfl_xor(bv[idx > 0 ? idx - 1 : 0], 32) : 0.f;
                    const float inc = w.hi ? bo : bprev;
                    prow[2 * idx + w.hi] = av[idx] + inc;
                }
            }
            if (type == 0) {
                bf16x8 pa0, pa1, pa2, pa3;
#pragma unroll
                for (int d = 0; d < 4; ++d) o[d] = f32x16{};
                pack_p(pA0, pA1, pa0, pa1, pa2, pa3); pv_tile<0>(o, w.vb0, pa0, pa1, pa2, pa3);
                pack_p(pB0, pB1, pa0, pa1, pa2, pa3); pv_tile<1>(o, w.vb0, pa0, pa1, pa2, pa3);
                if (w.hi == 0) wsf[w.r32] = 1.f;
                asm volatile("s_waitcnt lgkmcnt(0)" ::: "memory");
                store_o(w, o, wsf, ocmp + (size_t)tok0 * 1024 + h * HD);
            }
            __syncthreads();
#pragma unroll 1
            for (int ps2 = 0; ps2 < 4; ++ps2) {
                int ln = w.lane; asm volatile("" : "+v"(ln));
                const int j = ln & 31, hi2 = ln >> 5;
                const int tk = 8 * w.wid + 2 * ps2 + hi2, t = qb * 64 + tk, cur = qb;
                float imp = 0.f;
#pragma unroll
                for (int r = 0; r < 4; ++r) imp += part[((size_t)r * 64 + tk) * 33 + j];
                const bool ok = (64 * j <= t), forced = (j == 0) || (cur - j >= 0 && cur - j < 2);
                const float val = (ok && forced) ? 1.0e30f : (ok ? imp : -1.0e30f);
                vals[ln] = val;
                asm volatile("s_waitcnt lgkmcnt(0)" ::: "memory");
                int rank = 0;
#pragma unroll
                for (int jj = 0; jj < 32; ++jj) { const float o2 = vals[hi2 * 32 + jj]; rank += (o2 > val || (o2 == val && jj < j)) ? 1 : 0; }
                const unsigned long long bal = __ballot(rank < 16 && val >= 0.f);
                if (w.lane == 0) { selm[8 * w.wid + 2 * ps2] = (unsigned)bal; selm[8 * w.wid + 2 * ps2 + 1] = (unsigned)(bal >> 32); }
            }
            __syncthreads();
        }
#endif
#ifndef ATT_NO_SEL
        {
            const unsigned sm = selm[th * 32 + w.r32];
            const int ntile = qb + 1, hsplit = (ntile + 1) >> 1;
            const int ja = (qb >= 16 && type == 1) ? hsplit : 0, jb = (qb >= 16 && type == 0) ? hsplit : ntile;
#pragma unroll
            for (int d0 = 0; d0 < 8; ++d0) qr[d0] = *(const bf16x8*)(qrp + qoff + d0 * 16);
#pragma unroll
            for (int d = 0; d < 4; ++d) o[d] = f32x16{};
            float m_reg = -1e30f, l_reg = 0.f;
            flash_pass<0>(w, kv + (size_t)2 * (4 * MB / 2) + kvoff, kv + (size_t)3 * (4 * MB / 2) + kvoff, ja, jb, qr, tpos, t0, sm, o, m_reg, l_reg);
            if (w.hi == 0) { wsf[w.r32] = l_reg > 0.f ? 1.f / l_reg : 0.f; float* mp = ml + (((size_t)type * NT + tok0 + w.r32) * NH + h) * 2; mp[0] = m_reg; mp[1] = l_reg; }
            asm volatile("s_waitcnt lgkmcnt(0)" ::: "memory");
            store_o(w, o, wsf, osel + (size_t)type * NT * 1024 + (size_t)tok0 * 1024 + h * HD);
        }
#endif
    }
}

struct CvtTile { const float* src; const float* ksc; bf16_t* dst0; int sld, ldd, mode; };
__device__ __forceinline__ CvtTile cvt_decode(const Frame& F, int t) {
    CvtTile c; c.ksc = nullptr; c.mode = 0;
    if (t < 4096) { const int e = t >> 7, mat = (t >> 6) & 1, kt = (t >> 1) & 31, nt = t & 1;
        c.src = (mat ? F.in[I_WUP] : F.in[I_WGATE]) + ((size_t)e * DM + kt * 64) * FF + nt * 256; c.sld = FF; c.ksc = F.in[I_LNMOE] + kt * 64;
        c.dst0 = (bf16_t*)(F.ws + WS_W1T) + ((size_t)e * 1024 + nt * 512 + mat * 128) * DM + kt * 64; c.ldd = DM; c.mode = 1; return c; }
    t -= 4096;
    if (t < 2048) { const int e = t >> 6, kt = (t >> 3) & 7, nt = t & 7;
        c.src = F.in[I_WDOWN] + ((size_t)e * FF + kt * 64) * DM + nt * 256; c.sld = DM;
        c.dst0 = (bf16_t*)(F.ws + WS_W2T) + ((size_t)e * 2048 + nt * 256) * FF + kt * 64; c.ldd = FF; return c; }
    t -= 2048;
    if (t < 256) { const int kt = t >> 3, nt = t & 7;
        c.src = F.in[I_WOUT] + (size_t)kt * 64 * DM + nt * 256; c.sld = DM; c.dst0 = (bf16_t*)(F.ws + WS_WOUTT) + (size_t)nt * 256 * DM + kt * 64; c.ldd = DM; return c; }
    t -= 256;
    if (t < 480) { const int kt = t / 15, nt = t % 15;
        c.src = F.in[I_WIN] + (size_t)kt * 64 * INW; c.sld = INW; c.ksc = F.in[I_LNMIX] + kt * 64;
        c.dst0 = (bf16_t*)(F.ws + WS_WINT) + (size_t)nt * 256 * DM + kt * 64; c.ldd = DM; c.mode = 2 + nt; return c; }
    t -= 480;
    { const int kv = t >> 6, kt = t & 63;
      c.src = (kv ? F.in[I_WV1] : F.in[I_WK1]) + (size_t)kt * 64 * 256; c.sld = 256; c.dst0 = (bf16_t*)(F.ws + WS_CMPW) + (size_t)kv * 256 * 4096 + kt * 64; c.ldd = 4096; return c; }
}
constexpr int N_CVT_TILES = 4096 + 2048 + 256 + 480 + 128;
__device__ __forceinline__ void cvt_load(const CvtTile& c, int nq, int kq, float4 (&v)[8]) {
    const float* p = c.src + 4 * nq; bool valid = true;
    if (c.mode >= 2) { const int n = (c.mode - 2) * 256 + 4 * nq; int sc = -1; if (n < 2560) sc = n; else if (n < 3584) sc = n + 24; else if (n < 3608) sc = n - 1024; valid = sc >= 0; p = c.src + (valid ? sc : 0); }
#pragma unroll
    for (int i = 0; i < 8; ++i) v[i] = valid ? *(const float4*)(p + (size_t)(kq * 8 + i) * c.sld) : make_float4(0.f, 0.f, 0.f, 0.f);
}

__device__ __forceinline__ void p0_prologue(const Frame& F) {
    const float* x = F.in[I_X];
    bf16_t* xb = (bf16_t*)(F.ws + WS_XB); float* rstd1 = (float*)(F.ws + WS_RSTD1);
    const int gw = F.bid * NWAVES + F.wave, nw = F.G * NWAVES, lane = F.lane;
    for (int r = gw; r < NT; r += nw) {
        float4 v[8]; float ss = 0.f;
#pragma unroll
        for (int i = 0; i < 8; ++i) { v[i] = *(const float4*)(x + (size_t)r * DM + i * 256 + lane * 4); ss += v[i].x * v[i].x + v[i].y * v[i].y + v[i].z * v[i].z + v[i].w * v[i].w; }
        ss = wave_sum(ss);
        if (lane == 0) rstd1[r] = rsqrtf(ss * (1.f / DM) + EPS);
#pragma unroll
        for (int i = 0; i < 8; ++i) { uint2 w; w.x = pg8::cvt_pk_bf16(v[i].x, v[i].y); w.y = pg8::cvt_pk_bf16(v[i].z, v[i].w);
            *(uint2*)(xb + (size_t)r * DM + i * 256 + lane * 4) = w; }
    }
    {
        float* T = F.lds;
        const int tid = F.tid, nq = tid & 63, kq = tid >> 6;
        int t = F.bid; float4 v[8]; CvtTile c;
        if (t < N_CVT_TILES) { c = cvt_decode(F, t); cvt_load(c, nq, kq, v); }
        while (t < N_CVT_TILES) {
            __syncthreads();
#pragma unroll
            for (int i = 0; i < 8; ++i) { const float s = c.ksc ? c.ksc[kq * 8 + i] : 1.f; float* tp = T + (kq * 8 + i) * 257 + 4 * nq; tp[0] = v[i].x * s; tp[1] = v[i].y * s; tp[2] = v[i].z * s; tp[3] = v[i].w * s; }
            __syncthreads();
            const CvtTile cc = c; const int tn = t + F.G;
            if (tn < N_CVT_TILES) { c = cvt_decode(F, tn); cvt_load(c, nq, kq, v); }
#pragma unroll
            for (int j = 0; j < 4; ++j) { const int id = tid + 512 * j, n = id >> 3, kc = id & 7; const float* tp = T + (kc * 8) * 257 + n;
                pg8::u32x4 w; w.x = pg8::cvt_pk_bf16(tp[0], tp[257]); w.y = pg8::cvt_pk_bf16(tp[2 * 257], tp[3 * 257]); w.z = pg8::cvt_pk_bf16(tp[4 * 257], tp[5 * 257]); w.w = pg8::cvt_pk_bf16(tp[6 * 257], tp[7 * 257]);
                const int rowi = (cc.mode == 1) ? ((n >> 7) * 256 + (n & 127)) : n;
                *(pg8::u32x4*)(cc.dst0 + (size_t)rowi * cc.ldd + kc * 8) = w; }
            t = tn;
        }
        __syncthreads();
    }
    {
        const float* wp = F.in[I_WPOOL]; const float* ps = F.in[I_PSCALE]; const float* bp = F.in[I_BPOOL]; bf16_t* wpt = (bf16_t*)(F.ws + WS_POOLW); float* pb = (float*)(F.ws + WS_POOLB);
        for (int idx = F.bid * NTHREADS + F.tid; idx < 4 * 256 * 256; idx += F.G * NTHREADS) { const int k = idx & 255, n = (idx >> 8) & 255, g = idx >> 16;
            wpt[idx] = f2bf(wp[((size_t)g * 256 + k) * 256 + n] * ps[g * 256 + n]); }
        for (int idx = F.bid * NTHREADS + F.tid; idx < 1024; idx += F.G * NTHREADS) pb[idx] = bp[idx] * ps[idx];
    }
    {
        const int* pos = (const int*)F.in[I_POS]; float* rc = (float*)(F.ws + WS_ROPEC); float* rs = (float*)(F.ws + WS_ROPES);
        for (int idx = F.bid * NTHREADS + F.tid; idx < NB * SEQ * 16; idx += F.G * NTHREADS) {
            const int i = idx & 15, bs = idx >> 4;
            const float inv = exp2f(-(float)i * (1.f / 16.f) * 18.931568569324174f);
            const float ang = (float)pos[bs] * inv;
            rc[idx] = cosf(ang); rs[idx] = sinf(ang);
        }
    }
    for (int it = F.bid; it < 8; it += F.G) {
        const int kv = it >> 2, jb = it & 3;
        const float* pe = (kv ? F.in[I_PEV] : F.in[I_PEK]); const float* w1 = (kv ? F.in[I_WV1] : F.in[I_WK1]);
        const int mg = F.tid >> 6, j = jb * 64 + (F.tid & 63);
        float a = 0.f;
        for (int m = mg; m < 4096; m += 8) a += pe[m] * w1[(size_t)m * 256 + j];
        __syncthreads();
        F.lds[F.tid] = a;
        __syncthreads();
        if (F.tid < 64) { float s = 0.f; for (int q = 0; q < 8; ++q) s += F.lds[q * 64 + F.tid]; ((float*)(F.ws + WS_BIAS1))[kv * 256 + j] = s; }
        __syncthreads();
    }
}

struct EpiProj {
    const float* rstd1; const float* rc; const float* rs; bf16_t* qn; bf16_t* qr; bf16_t* kv; float* u; float* gates;
    __device__ __forceinline__ void operator()(const pg8::f32x4 (&acc)[2][2][4][2], const pg8::Unit& un, int wr, int wc, int fr, int fq) const {
        const int pn = un.pn;
#pragma unroll
        for (int ai = 0; ai < 2; ++ai)
#pragma unroll
            for (int m = 0; m < 4; ++m) {
                const int row = un.pm * 256 + ai * 128 + wr * 64 + m * 16 + fr; const float r1 = rstd1[row]; const int b = row >> 11, s = row & 2047;
                if (pn < 10) {
                    const bool ropeu = (pn < 4) || pn == 6 || pn == 8;
                    pg8::f32x4 c4 = {1.f, 1.f, 1.f, 1.f}, s4 = {0.f, 0.f, 0.f, 0.f};
                    if (ropeu && wc == 0) { c4 = *(const pg8::f32x4*)(rc + (size_t)row * 16 + 4 * fq); s4 = *(const pg8::f32x4*)(rs + (size_t)row * 16 + 4 * fq); }
#pragma unroll
                    for (int bj = 0; bj < 2; ++bj) {
                        const pg8::f32x4 v0 = acc[ai][bj][m][0] * r1, v1 = acc[ai][bj][m][1] * r1;
                        const int d0 = 32 * wc + 4 * fq;
                        pg8::f32x4 o0 = v0, o1 = v1;
                        if (ropeu && wc == 0) { o0 = v0 * c4 - v1 * s4; o1 = v1 * c4 + v0 * s4; }
                        uint2 w0, w1; w0.x = pg8::cvt_pk_bf16(o0[0], o0[1]); w0.y = pg8::cvt_pk_bf16(o0[2], o0[3]); w1.x = pg8::cvt_pk_bf16(o1[0], o1[1]); w1.y = pg8::cvt_pk_bf16(o1[2], o1[3]);
                        if (pn < 4) {
                            const size_t o = (((size_t)b * NH + 2 * pn + bj) * SEQ + s) * HD + d0;
                            uint2 n0, n1; n0.x = pg8::cvt_pk_bf16(v0[0], v0[1]); n0.y = pg8::cvt_pk_bf16(v0[2], v0[3]); n1.x = pg8::cvt_pk_bf16(v1[0], v1[1]); n1.y = pg8::cvt_pk_bf16(v1[2], v1[3]);
                            *(uint2*)(qn + o) = n0; *(uint2*)(qn + o + 16) = n1; *(uint2*)(qr + o) = w0; *(uint2*)(qr + o + 16) = w1;
                        } else {
                            const size_t o = (size_t)(pn - 4) * (4 * MB / 2) + (((size_t)b * NG + bj) * SEQ + s) * HD + d0;
                            *(uint2*)(kv + o) = w0; *(uint2*)(kv + o + 16) = w1;
                        }
                    }
                } else if (pn < 14) {
#pragma unroll
                    for (int bj = 0; bj < 2; ++bj)
#pragma unroll
                        for (int n = 0; n < 2; ++n) *(pg8::f32x4*)(u + (size_t)row * 1024 + (pn - 10) * 256 + bj * 128 + wc * 32 + n * 16 + 4 * fq) = acc[ai][bj][m][n] * r1;
                } else {
                    if (wc == 0) { *(pg8::f32x4*)(gates + (size_t)row * 24 + 4 * fq) = acc[ai][0][m][0] * r1; if (fq < 2) *(pg8::f32x4*)(gates + (size_t)row * 24 + 16 + 4 * fq) = acc[ai][0][m][1] * r1; }
                }
            }
    }
};

__device__ __forceinline__ void p1_proj(const Frame& F, LAS unsigned char* stage) {
    pg8::DenseOrder S; S.init(F.ws + WS_XB, F.ws + WS_WINT, DM, DM, NT, INWP, F.G, F.bid);
    EpiProj E{(const float*)(F.ws + WS_RSTD1), (const float*)(F.ws + WS_ROPEC), (const float*)(F.ws + WS_ROPES), (bf16_t*)(F.ws + WS_QN), (bf16_t*)(F.ws + WS_QR), (bf16_t*)(F.ws + WS_KV),
              (float*)(F.ws + WS_U), (float*)(F.ws + WS_GATES)};
    pg8::gemm_phase<EpiProj, pg8::DenseOrder, false>(stage, DM, DM, DM, S, E);
}

struct CmpOrder {
    const char* kc; const char* w1t; int c;
    __device__ __forceinline__ bool next(int i, pg8::Unit& u) const { if (i > 0) return false; u.e = c >> 5; u.pm = (c >> 3) & 3; u.pn = c & 7; u.li = 0; return true; }
    __device__ __forceinline__ const char* a_base(const pg8::Unit& u) const { return kc + (size_t)u.e * 4 * MB + ((size_t)u.pm * 256 * 2048 + u.pn * 512) * 2; }
    __device__ __forceinline__ const char* b_base(const pg8::Unit& u) const { return w1t + ((size_t)u.e * 256 * 4096 + u.pn * 512) * 2; }
    __device__ __forceinline__ unsigned a_row_off(const pg8::Unit&, int r) const { return (unsigned)r * 4096u; }
};
struct EpiCmp {
    float* part;
    __device__ __forceinline__ void operator()(const pg8::f32x4 (&acc)[2][2][4][2], const pg8::Unit& un, int wr, int wc, int fr, int fq) const {
        float* base = part + (((size_t)un.pn * 2 + un.e) * 1024 + un.pm * 256) * 256;
#pragma unroll
        for (int ai = 0; ai < 2; ++ai)
#pragma unroll
            for (int m = 0; m < 4; ++m) { float* rowp = base + (size_t)(ai * 128 + wr * 64 + m * 16 + fr) * 256 + wc * 32 + 4 * fq;
#pragma unroll
                for (int bj = 0; bj < 2; ++bj)
#pragma unroll
                    for (int n = 0; n < 2; ++n) *(pg8::f32x4*)(rowp + bj * 128 + n * 16) = acc[ai][bj][m][n]; }
    }
};
struct PoolOrder {
    const char* d; const char* wpt; int c;
    __device__ __forceinline__ bool next(int i, pg8::Unit& u) const { if (i > 0) return false; u.pm = c >> 2; u.pn = 0; u.e = c & 3; u.li = 0; return true; }
    __device__ __forceinline__ const char* a_base(const pg8::Unit& u) const { return d + ((size_t)u.pm * 256 * 1024 + u.e * 256) * 2; }
    __device__ __forceinline__ const char* b_base(const pg8::Unit& u) const { return wpt + (size_t)u.e * 256 * 256 * 2; }
    __device__ __forceinline__ unsigned a_row_off(const pg8::Unit&, int r) const { return (unsigned)r * 2048u; }
};
struct EpiPool {
    const float* pb; float* opool;
    __device__ __forceinline__ void operator()(const pg8::f32x4 (&acc)[2][2][4][2], const pg8::Unit& un, int wr, int wc, int fr, int fq) const {
#pragma unroll
        for (int ai = 0; ai < 2; ++ai)
#pragma unroll
            for (int m = 0; m < 4; ++m) { const int row = un.pm * 256 + ai * 128 + wr * 64 + m * 16 + fr;
#pragma unroll
                for (int bj = 0; bj < 2; ++bj)
#pragma unroll
                    for (int n = 0; n < 2; ++n) { const int c = un.e * 256 + bj * 128 + wc * 32 + n * 16 + 4 * fq;
                        *(pg8::f32x4*)(opool + (size_t)row * 1024 + c) = acc[ai][bj][m][n] + *(const pg8::f32x4*)(pb + c); } }
    }
};
__device__ __forceinline__ void p3_mid(const Frame& F, LAS unsigned char* stage) {
    if (F.bid < 64) {
        CmpOrder S{(const char*)(F.ws + WS_KV), (const char*)(F.ws + WS_CMPW), F.bid};
        EpiCmp E{(float*)(F.ws + WS_CPART)};
        pg8::gemm_phase<EpiCmp, CmpOrder, false>(stage, 512, 2048, 4096, S, E);
    } else if (F.bid < 192) {
        const int c = F.bid - 64, pm = c >> 2, gi = c & 3, w = 2 << gi;
        const float* u = (const float*)(F.ws + WS_U); bf16_t* d = (bf16_t*)(F.ws + WS_DBUF);
        { const int cc = F.tid & 255, half = F.tid >> 8, col = gi * 256 + cc; const int r0 = pm * 256 + half * 128;
          float sum = 0.f;
          for (int q = 1; q < w; ++q) { const int rr = r0 - q; if ((rr & 2047) < (r0 & 2047) && rr >= (r0 & ~2047)) sum += u[(size_t)rr * 1024 + col]; }
          for (int i = 0; i < 128; ++i) { const int row = r0 + i, s = row & 2047; const float uv = u[(size_t)row * 1024 + col];
              sum += uv;
              const int cnt = (s + 1 < w) ? s + 1 : w;
              d[(size_t)row * 1024 + col] = f2bf(sum / (float)cnt - uv);
              if (s + 1 >= w) sum -= u[(size_t)(row - w + 1) * 1024 + col]; } }
        asm volatile("s_waitcnt vmcnt(0)" ::: "memory");
        __syncthreads();
        PoolOrder S{(const char*)(F.ws + WS_DBUF), (const char*)(F.ws + WS_POOLW), c};
        EpiPool E{(const float*)(F.ws + WS_POOLB), (float*)(F.ws + WS_OPOOL)};
        pg8::gemm_phase<EpiPool, PoolOrder, false>(stage, 256, 1024, 256, S, E);
    }
}

__device__ __forceinline__ void p4_cmp2(const Frame& F) {
    const float* part = (const float*)(F.ws + WS_CPART); const float* bias1 = (const float*)(F.ws + WS_BIAS1); bf16_t* ckv = (bf16_t*)(F.ws + WS_CMPKV);
    float* H = F.lds;
    for (int it = F.bid; it < 64; it += F.G) {
        const int kvi = it >> 5, r0 = (it & 31) * 32; const float* w2 = kvi ? F.in[I_WV2] : F.in[I_WK2];
        __syncthreads();
#pragma unroll
        for (int j = 0; j < 16; ++j) { const int idx = F.tid + 512 * j, r = idx >> 8, c = idx & 255; float s = bias1[kvi * 256 + c];
#pragma unroll
            for (int sp = 0; sp < 8; ++sp) s += part[(((size_t)sp * 2 + kvi) * 1024 + r0 + r) * 256 + c];
            H[r * 257 + c] = gelu_tanh(s); }
        __syncthreads();
        const int r = F.tid >> 4, c0 = (F.tid & 15) * 8;
        float acc[8] = {0.f, 0.f, 0.f, 0.f, 0.f, 0.f, 0.f, 0.f};
        for (int k = 0; k < 256; ++k) { const float hv = H[r * 257 + k]; const float4 wa = *(const float4*)(w2 + (size_t)k * 128 + c0), wb = *(const float4*)(w2 + (size_t)k * 128 + c0 + 4);
            acc[0] += hv * wa.x; acc[1] += hv * wa.y; acc[2] += hv * wa.z; acc[3] += hv * wa.w; acc[4] += hv * wb.x; acc[5] += hv * wb.y; acc[6] += hv * wb.z; acc[7] += hv * wb.w; }
        const int R = r0 + r; const bool pad = (R & 127) == 127;
        pg8::u32x4 w; w.x = pad ? 0u : pg8::cvt_pk_bf16(acc[0], acc[1]); w.y = pad ? 0u : pg8::cvt_pk_bf16(acc[2], acc[3]); w.z = pad ? 0u : pg8::cvt_pk_bf16(acc[4], acc[5]); w.w = pad ? 0u : pg8::cvt_pk_bf16(acc[6], acc[7]);
        *(pg8::u32x4*)(ckv + ((size_t)kvi * 1024 + R) * 128 + c0) = w;
    }
}

__device__ __forceinline__ void p6_mix(const Frame& F) {
    const bf16_t* ocmp = (const bf16_t*)(F.ws + WS_OCMP); const bf16_t* owin = (const bf16_t*)(F.ws + WS_OWIN); const bf16_t* osel = (const bf16_t*)(F.ws + WS_OSEL);
    const float* ml = (const float*)(F.ws + WS_ML); const float* gates = (const float*)(F.ws + WS_GATES);
    const float* opool = (const float*)(F.ws + WS_OPOOL); bf16_t* mix = (bf16_t*)(F.ws + WS_MIX);
    const float* gn = F.in[I_GNNSA]; const float* gp = F.in[I_GNPOOL];
    const int gw = F.bid * NWAVES + F.wave, nw = F.G * NWAVES, lane = F.lane;
    for (int r = gw; r < NT; r += nw) {
        const bool split = ((r & 2047) >> 6) >= 16;
        float a[16], p[16]; float sa = 0.f, sp = 0.f;
#pragma unroll
        for (int i = 0; i < 16; ++i) {
            const int h = i >> 1; const size_t o = (size_t)r * 1024 + i * 64 + lane;
            const float* gq = gates + (size_t)r * 24 + h * 3;
            const float g0 = 1.f / (1.f + __expf(-gq[0])), g1 = 1.f / (1.f + __expf(-gq[1])), g2 = 1.f / (1.f + __expf(-gq[2]));
            float os = bf2f(osel[o]);
            if (split) {
                const float* m0p = ml + ((size_t)r * NH + h) * 2; const float* m1p = ml + (((size_t)NT + r) * NH + h) * 2;
                const float m0 = m0p[0], l0 = m0p[1], m1 = m1p[0], l1 = m1p[1], M = fmaxf(m0, m1);
                const float a0 = l0 * exp2f((m0 - M) * att::C2), a1 = l1 * exp2f((m1 - M) * att::C2);
                os = (a0 * os + a1 * bf2f(osel[(size_t)NT * 1024 + o])) / (a0 + a1);
            }
            a[i] = g0 * bf2f(ocmp[o]) + g1 * os + g2 * bf2f(owin[o]);
            p[i] = opool[o]; sa += a[i] * a[i]; sp += p[i] * p[i];
        }
        sa = wave_sum(sa); sp = wave_sum(sp);
        const float ra = rsqrtf(sa * (1.f / 1024.f) + EPS), rp = rsqrtf(sp * (1.f / 1024.f) + EPS);
#pragma unroll
        for (int i = 0; i < 16; ++i) { const int c = i * 64 + lane; mix[(size_t)r * DM + c] = f2bf(a[i] * ra * gn[c]); mix[(size_t)r * DM + 1024 + c] = f2bf(p[i] * rp * gp[c]); }
    }
}

struct EpiOut {
    const float* x; float* out; bf16_t* x1b;
    __device__ __forceinline__ void operator()(const pg8::f32x4 (&acc)[2][2][4][2], const pg8::Unit& un, int wr, int wc, int fr, int fq) const {
#pragma unroll
        for (int ai = 0; ai < 2; ++ai)
#pragma unroll
            for (int m = 0; m < 4; ++m) {
                const int row = un.pm * 256 + ai * 128 + wr * 64 + m * 16 + fr;
#pragma unroll
                for (int bj = 0; bj < 2; ++bj)
#pragma unroll
                    for (int n = 0; n < 2; ++n) {
                        const size_t o = (size_t)row * DM + un.pn * 256 + bj * 128 + wc * 32 + n * 16 + 4 * fq;
                        const pg8::f32x4 v = acc[ai][bj][m][n] + *(const pg8::f32x4*)(x + o);
                        *(pg8::f32x4*)(out + o) = v;
                        uint2 w; w.x = pg8::cvt_pk_bf16(v[0], v[1]); w.y = pg8::cvt_pk_bf16(v[2], v[3]); *(uint2*)(x1b + o) = w;
                    }
            }
    }
};
__device__ __forceinline__ void p7_out(const Frame& F, LAS unsigned char* stage) {
    pg8::DenseOrder S; S.init(F.ws + WS_MIX, F.ws + WS_WOUTT, DM, DM, NT, DM, F.G, F.bid);
    EpiOut E{F.in[I_X], F.out, (bf16_t*)(F.ws + WS_X1B)};
    pg8::gemm_phase<EpiOut, pg8::DenseOrder, false>(stage, DM, DM, DM, S, E);
}

__device__ __forceinline__ void p8_router(const Frame& F) {
    const float* lnm = F.in[I_LNMOE]; const float* wrg = F.in[I_WRG]; const float* brg = F.in[I_BRG]; const float* wre = F.in[I_WRE]; const float* bre = F.in[I_BRE];
    float* rstd2 = (float*)(F.ws + WS_RSTD2); int* arow = (int*)(F.ws + WS_AROW); int* tokl = (int*)(F.ws + WS_TOKL); float* gatel = (float*)(F.ws + WS_GATEL);
    unsigned* cnt = (unsigned*)(F.ws + WS_CTL) + CW_CNT;
    const int gw = F.bid * NWAVES + F.wave, nw = F.G * NWAVES, lane = F.lane;
    for (int r = gw; r < NT; r += nw) {
        float h[32]; float ss = 0.f;
#pragma unroll
        for (int i = 0; i < 8; ++i) { const float4 v = *(const float4*)(F.out + (size_t)r * DM + i * 256 + lane * 4); h[4 * i] = v.x; h[4 * i + 1] = v.y; h[4 * i + 2] = v.z; h[4 * i + 3] = v.w;
            ss += v.x * v.x + v.y * v.y + v.z * v.z + v.w * v.w; }
        ss = wave_sum(ss);
        const float rs = rsqrtf(ss * (1.f / DM) + EPS);
        float lg[4] = {0.f, 0.f, 0.f, 0.f};
#pragma unroll
        for (int i = 0; i < 8; ++i)
#pragma unroll
            for (int c = 0; c < 4; ++c) { const int k = i * 256 + lane * 4 + c; h[4 * i + c] *= rs * lnm[k]; const float4 w = *(const float4*)(wrg + (size_t)k * 4);
                lg[0] += h[4 * i + c] * w.x; lg[1] += h[4 * i + c] * w.y; lg[2] += h[4 * i + c] * w.z; lg[3] += h[4 * i + c] * w.w; }
#pragma unroll
        for (int j = 0; j < 4; ++j) lg[j] = wave_sum(lg[j]) + brg[j];
        int gs = 0; float gm = lg[0];
#pragma unroll
        for (int j = 1; j < 4; ++j) if (lg[j] > gm) { gm = lg[j]; gs = j; }
        float den = 0.f;
#pragma unroll
        for (int j = 0; j < 4; ++j) den += __expf(lg[j] - gm);
        const float pg = 1.f / den;
        float le[8] = {0.f, 0.f, 0.f, 0.f, 0.f, 0.f, 0.f, 0.f};
#pragma unroll
        for (int i = 0; i < 8; ++i)
#pragma unroll
            for (int c = 0; c < 4; ++c) { const int k = i * 256 + lane * 4 + c; const float* w = wre + ((size_t)gs * DM + k) * 8; const float4 w0 = *(const float4*)w, w1 = *(const float4*)(w + 4);
                const float hv = h[4 * i + c];
                le[0] += hv * w0.x; le[1] += hv * w0.y; le[2] += hv * w0.z; le[3] += hv * w0.w; le[4] += hv * w1.x; le[5] += hv * w1.y; le[6] += hv * w1.z; le[7] += hv * w1.w; }
#pragma unroll
        for (int j = 0; j < 8; ++j) le[j] = wave_sum(le[j]) + bre[gs * 8 + j];
        int e0 = 0; float m0 = le[0];
#pragma unroll
        for (int j = 1; j < 8; ++j) if (le[j] > m0) { m0 = le[j]; e0 = j; }
        int e1 = -1; float m1 = -3.0e38f;
#pragma unroll
        for (int j = 0; j < 8; ++j) if (j != e0 && le[j] > m1) { m1 = le[j]; e1 = j; }
        const float p1 = __expf(m1 - m0);
        const float gate0 = pg / (1.f + p1), gate1 = pg * p1 / (1.f + p1);
        if (lane == 0) {
            rstd2[r] = rs;
            const int ea = gs * 8 + e0, eb = gs * 8 + e1;
            const unsigned sa = atomicAdd(&cnt[64 * ea], 1u), sb = atomicAdd(&cnt[64 * eb], 1u);
            tokl[ea * 8192 + sa] = r; gatel[ea * 8192 + sa] = gate0; tokl[eb * 8192 + sb] = r; gatel[eb * 8192 + sb] = gate1;
            arow[2 * r] = ea * 8192 + (int)sa; arow[2 * r + 1] = eb * 8192 + (int)sb;
        }
    }
}

__device__ __forceinline__ void moe_counts(const Frame& F, int* cnts  , int* pst  ) {
    const unsigned* cnt = (const unsigned*)(F.ws + WS_CTL) + CW_CNT;
    __syncthreads();
    if (F.tid < 32) cnts[F.tid] = (int)__hip_atomic_load(&cnt[64 * F.tid], __ATOMIC_RELAXED, __HIP_MEMORY_SCOPE_AGENT);
    __syncthreads();
    if (F.tid == 0) { int a = 0; for (int e = 0; e < 32; ++e) { pst[e] = a; a += (cnts[e] + 255) & ~255; } pst[32] = a; }
    __syncthreads();
}

constexpr int MOE_TAB_OFF = 1024 + 131072;
struct MoeTabs { int* cnts; int* pst; int* ust; int* rowtok; };
__device__ __forceinline__ MoeTabs moe_tabs(unsigned char* lds_raw) { MoeTabs T; T.cnts = (int*)(lds_raw + MOE_TAB_OFF); T.pst = T.cnts + 32; T.ust = T.pst + 40; T.rowtok = T.ust + 40; return T; }
template <int NTN> __device__ __forceinline__ void moe_units(const Frame& F, const MoeTabs& T) {
    moe_counts(F, T.cnts, T.pst);
    if (F.tid == 0) { int a = 0; for (int e = 0; e < 32; ++e) { T.ust[e] = a; a += ((T.cnts[e] + 255) >> 8) * NTN; } T.ust[32] = a; }
    __syncthreads();
}
template <int NTN, int LOGN> struct MoeOrder {
    const char* A; const char* Bt; const int* pst; const int* ust; const int* rowtok; int G, c, lda, ldb, brows;
    __device__ __forceinline__ bool next(int i, pg8::Unit& u) const {
        const int L = i * G + c; if (L >= ust[32]) return false;
        int e = 0; while (ust[e + 1] <= L) ++e;
        const int w = L - ust[e]; u.e = e; u.pm = w >> LOGN; u.pn = w & (NTN - 1); u.li = i; return true;
    }
    __device__ __forceinline__ const char* b_base(const pg8::Unit& u) const { return Bt + ((size_t)u.e * brows + (size_t)u.pn * 256) * ldb * 2; }
    __device__ __forceinline__ const char* a_base(const pg8::Unit& u) const { return rowtok ? A : A + (size_t)(pst[u.e] + u.pm * 256) * lda * 2; }
    __device__ __forceinline__ unsigned a_row_off(const pg8::Unit& u, int r) const {
        if (rowtok) { const int tk = rowtok[u.li * 256 + r]; return (unsigned)(tk < 0 ? 0 : tk) * (unsigned)lda * 2u; }
        return (unsigned)r * (unsigned)lda * 2u;
    }
};
struct EpiMoe1 {
    const int* cnts; const int* pst; const int* rowtok; const float* rstd2; bf16_t* act;
    __device__ __forceinline__ void operator()(const pg8::f32x4 (&acc)[2][2][4][2], const pg8::Unit& un, int wr, int wc, int fr, int fq) const {
#pragma unroll
        for (int ai = 0; ai < 2; ++ai)
#pragma unroll
            for (int m = 0; m < 4; ++m) {
                const int r = ai * 128 + wr * 64 + m * 16 + fr; const int tk = rowtok[un.li * 256 + r];
                if (tk >= 0) {
                    const float rs = rstd2[tk];
                    bf16_t* dst = act + (size_t)(pst[un.e] + un.pm * 256 + r) * FF + un.pn * 128 + wc * 32 + 4 * fq;
#pragma unroll
                    for (int n = 0; n < 2; ++n) {
                        const pg8::f32x4 vg = acc[ai][0][m][n] * rs, vu = acc[ai][1][m][n] * rs; float o[4];
#pragma unroll
                        for (int j = 0; j < 4; ++j) o[j] = vg[j] / (1.f + __expf(-vg[j])) * vu[j];
                        uint2 w; w.x = pg8::cvt_pk_bf16(o[0], o[1]); w.y = pg8::cvt_pk_bf16(o[2], o[3]); *(uint2*)(dst + 16 * n) = w;
                    }
                }
            }
    }
};
struct EpiMoe2 {
    const int* cnts; const int* pst; const float* gatel; bf16_t* y;
    __device__ __forceinline__ void operator()(const pg8::f32x4 (&acc)[2][2][4][2], const pg8::Unit& un, int wr, int wc, int fr, int fq) const {
#pragma unroll
        for (int ai = 0; ai < 2; ++ai)
#pragma unroll
            for (int m = 0; m < 4; ++m) {
                const int slot = un.pm * 256 + ai * 128 + wr * 64 + m * 16 + fr;
                if (slot < cnts[un.e]) {
                    const float gt = gatel[un.e * 8192 + slot];
                    bf16_t* dst = y + (size_t)(pst[un.e] + slot) * DM + un.pn * 256 + wc * 32 + 4 * fq;
#pragma unroll
                    for (int bj = 0; bj < 2; ++bj)
#pragma unroll
                        for (int n = 0; n < 2; ++n) { const pg8::f32x4 v = acc[ai][bj][m][n] * gt; uint2 w; w.x = pg8::cvt_pk_bf16(v[0], v[1]); w.y = pg8::cvt_pk_bf16(v[2], v[3]); *(uint2*)(dst + bj * 128 + n * 16) = w; }
                }
            }
    }
};

__device__ __forceinline__ void p9_moe1(const Frame& F, unsigned char* lds_raw, LAS unsigned char* stage) {
    const MoeTabs T = moe_tabs(lds_raw);
    moe_units<4>(F, T);
    MoeOrder<4, 2> S{(const char*)(F.ws + WS_X1B), (const char*)(F.ws + WS_W1T), T.pst, T.ust, T.rowtok, F.G, F.bid, DM, DM, 1024};
    { const int* tokl = (const int*)(F.ws + WS_TOKL); pg8::Unit u;
      for (int i = 0; i < 4 && S.next(i, u); ++i) { if (F.tid < 256) { const int slot = u.pm * 256 + F.tid; T.rowtok[i * 256 + F.tid] = slot < T.cnts[u.e] ? tokl[u.e * 8192 + slot] : -1; } } }
    asm volatile("s_waitcnt vmcnt(0) lgkmcnt(0)" ::: "memory");
    __syncthreads();
    EpiMoe1 E{T.cnts, T.pst, T.rowtok, (const float*)(F.ws + WS_RSTD2), (bf16_t*)(F.ws + WS_ACT)};
    pg8::gemm_phase<EpiMoe1, MoeOrder<4, 2>, true>(stage, DM, DM, DM, S, E);
}

__device__ __forceinline__ void p10_moe2(const Frame& F, unsigned char* lds_raw, LAS unsigned char* stage) {
    const MoeTabs T = moe_tabs(lds_raw);
    moe_units<8>(F, T);
    MoeOrder<8, 3> S{(const char*)(F.ws + WS_ACT), (const char*)(F.ws + WS_W2T), T.pst, T.ust, nullptr, F.G, F.bid, FF, FF, 2048};
    EpiMoe2 E{T.cnts, T.pst, (const float*)(F.ws + WS_GATEL), (bf16_t*)(F.ws + WS_Y)};
    pg8::gemm_phase<EpiMoe2, MoeOrder<8, 3>, false>(stage, FF, FF, FF, S, E);
}

__device__ __forceinline__ void p11_final(const Frame& F) {
    int* cnts = (int*)(F.lds + 3072); int* pst = cnts + 32;
    moe_counts(F, cnts, pst);
    const bf16_t* y = (const bf16_t*)(F.ws + WS_Y); const int* arow = (const int*)(F.ws + WS_AROW); const float* lnf = F.in[I_LNFINAL];
    const int gw = F.bid * NWAVES + F.wave, nw = F.G * NWAVES, lane = F.lane;
    for (int r = gw; r < NT; r += nw) {
        const int a0 = arow[2 * r], a1 = arow[2 * r + 1];
        const size_t r0 = (size_t)(pst[a0 >> 13] + (a0 & 8191)), r1 = (size_t)(pst[a1 >> 13] + (a1 & 8191));
        float v[32]; float ss = 0.f;
#pragma unroll
        for (int i = 0; i < 8; ++i) { const int c = i * 256 + lane * 4; const float4 xv = *(const float4*)(F.out + (size_t)r * DM + c);
            const uint2 ya = *(const uint2*)(y + r0 * DM + c), yb = *(const uint2*)(y + r1 * DM + c);
            v[4 * i]     = xv.x + __uint_as_float(ya.x << 16) + __uint_as_float(yb.x << 16);
            v[4 * i + 1] = xv.y + __uint_as_float(ya.x & 0xFFFF0000u) + __uint_as_float(yb.x & 0xFFFF0000u);
            v[4 * i + 2] = xv.z + __uint_as_float(ya.y << 16) + __uint_as_float(yb.y << 16);
            v[4 * i + 3] = xv.w + __uint_as_float(ya.y & 0xFFFF0000u) + __uint_as_float(yb.y & 0xFFFF0000u);
            ss += v[4 * i] * v[4 * i] + v[4 * i + 1] * v[4 * i + 1] + v[4 * i + 2] * v[4 * i + 2] + v[4 * i + 3] * v[4 * i + 3]; }
        ss = wave_sum(ss);
        const float rs = rsqrtf(ss * (1.f / DM) + EPS);
#pragma unroll
        for (int i = 0; i < 8; ++i) { const int c = i * 256 + lane * 4; const float4 g = *(const float4*)(lnf + c);
            float4 o; o.x = v[4 * i] * rs * g.x; o.y = v[4 * i + 1] * rs * g.y; o.z = v[4 * i + 2] * rs * g.z; o.w = v[4 * i + 3] * rs * g.w;
            *(float4*)(F.out + (size_t)r * DM + c) = o; }
    }
}

constexpr int NPHASE = 11;
__global__ void __launch_bounds__(NTHREADS, 2) fwd(Args args) {
    extern __shared__ __attribute__((aligned(16))) unsigned char lds_raw[];
    Frame F;
#pragma unroll
    for (int i = 0; i < N_IN; ++i) F.in[i] = args.in[i];
    F.out = args.out; F.ws = args.ws;
    F.lds = (float*)(lds_raw + 16);
    F.tid = threadIdx.x; F.lane = F.tid & 63; F.wave = __builtin_amdgcn_readfirstlane(F.tid >> 6); F.G = gridDim.x; F.bid = blockIdx.x;
    if (F.tid < 4) ((LAS unsigned*)lds_raw)[F.tid] = 0u;
    __syncthreads();
    XcdBarrier bar; bar.bar = (unsigned*)(F.ws + WS_CTL); bar.x = 0; bar.st = nullptr;
    if (N_LAUNCHES == 1) bar = xcd_barrier_post((unsigned*)(F.ws + WS_CTL), (volatile LAS unsigned*)lds_raw);
    const int lo = args.ph_lo, hi = args.ph_hi;
#ifndef ONLY_PHASE
#define ONLY_PHASE -1
#endif
#define IN(k) (lo <= (k) && (k) < hi && (ONLY_PHASE < 0 || ONLY_PHASE == (k)))
#define SEAM(k) do { if (IN(k) && IN((k) + 1)) xcd_barrier(bar); } while (0)
    LAS unsigned char* stage = (LAS unsigned char*)lds_raw + 1024;
    if (IN(0)) p0_prologue(F);
    SEAM(0);
    if (IN(1)) p1_proj(F, stage);
    SEAM(1);
    if (IN(2)) p3_mid(F, stage);
    SEAM(2);
    if (IN(3)) p4_cmp2(F);
    SEAM(3);
    if (IN(4)) p_attn(F, lds_raw);
    SEAM(4);
    if (IN(5)) p6_mix(F);
    SEAM(5);
    if (IN(6)) p7_out(F, stage);
    SEAM(6);
    if (IN(7)) p8_router(F);
    SEAM(7);
    if (IN(8)) p9_moe1(F, lds_raw, stage);
    SEAM(8);
    if (IN(9)) p10_moe2(F, lds_raw, stage);
    SEAM(9);
    if (IN(10)) p11_final(F);
#undef IN
#undef SEAM
}

extern "C" void kernel_launch(void* const* d_in, const int* in_sizes, int n_in, void* d_out, int out_size, void* d_ws, size_t ws_size, hipStream_t stream) {
    static int grid = 0;
    if (grid == 0) {
        if (n_in != N_IN || out_size != NT * DM || ws_size < WS_END) { fprintf(stderr, "kernel_launch: unexpected shapes: n_in %d out %d ws %zu (need %zu)\n", n_in, out_size, ws_size, (size_t)WS_END); grid = -1; return; }
        int dev = 0, cus = 0, per_cu = 0;
        if (hipGetDevice(&dev) != hipSuccess || hipDeviceGetAttribute(&cus, hipDeviceAttributeMultiprocessorCount, dev) != hipSuccess) { grid = -1; return; }
        if (hipFuncSetAttribute((const void*)fwd, hipFuncAttributeMaxDynamicSharedMemorySize, LDS_BYTES) != hipSuccess) { fprintf(stderr, "kernel_launch: hipFuncSetAttribute failed\n"); grid = -1; return; }
        if (hipOccupancyMaxActiveBlocksPerMultiprocessor(&per_cu, (const void*)fwd, NTHREADS, LDS_BYTES) != hipSuccess || per_cu < 1) { fprintf(stderr, "kernel_launch: occupancy query says %d\n", per_cu); }
        (void)hipGetLastError();
        grid = cus;
    }
    if (grid < 0) return;
    (void)in_sizes;
    (void)hipMemsetAsync((char*)d_ws + WS_CTL, 0, CTL_ZERO_BYTES, stream);
    Args a{};
    for (int i = 0; i < N_IN; ++i) a.in[i] = (const float*)d_in[i];
    a.out = (float*)d_out; a.ws = (unsigned char*)d_ws;
    if (N_LAUNCHES == 1) { a.ph_lo = 0; a.ph_hi = NPHASE; hipLaunchKernelGGL(fwd, dim3(grid), dim3(NTHREADS), LDS_BYTES, stream, a); }
    else { for (int p = 0; p < NPHASE; ++p) { a.ph_lo = p; a.ph_hi = p + 1; hipLaunchKernelGGL(fwd, dim3(grid), dim3(NTHREADS), LDS_BYTES, stream, a); } }
}
```

```cpp
#include <hip/hip_runtime.h>
#include <cstdio>
#include <cstdint>

#ifndef PROBE_REPEAT
#define PROBE_REPEAT -1
#endif
#ifndef N_LAUNCHES
#define N_LAUNCHES 1
#endif

#define XB_TMO      128
#define XB_XCNT(j)  (256  + 64 * (j))
#define XB_XSUB(j)  (1280 + 64 * (j))
#define XB_XGEN(j)  (2304 + 64 * (j))
#define XB_TOP      3328
#define XB_TOPGEN   3392
#define XCD_BAR_WORDS 3456
#define XB_SPIN_CAP (1u << 21)
#define LAS __attribute__((address_space(3)))

__device__ __forceinline__ unsigned xb_ld(unsigned* p)              { return __hip_atomic_load(p, __ATOMIC_RELAXED, __HIP_MEMORY_SCOPE_AGENT); }
__device__ __forceinline__ unsigned xb_add(unsigned* p, unsigned v) { return __hip_atomic_fetch_add(p, v, __ATOMIC_RELAXED, __HIP_MEMORY_SCOPE_AGENT); }
__device__ __forceinline__ unsigned xb_xcc_id() { return (unsigned)__builtin_amdgcn_s_getreg((3 << 11) | 20) & 0xFu; }
#define XB_SPIN(cond, bar) do { unsigned _sp = 0; while (cond) { __builtin_amdgcn_s_sleep(1); \
    if ((++_sp & 255u) == 0u) { if (xb_ld(&(bar)[XB_TMO])) break; if (_sp > XB_SPIN_CAP) { atomicAdd(&(bar)[XB_TMO], 1u); break; } } } } while (0)

struct XcdBarrier { unsigned* bar; unsigned x; volatile LAS unsigned* st; };

__device__ __forceinline__ XcdBarrier xcd_barrier_post(unsigned* bar, volatile LAS unsigned* st) {
    XcdBarrier b; b.bar = bar; b.x = xb_xcc_id(); b.st = st;
    if (threadIdx.x == 0) (void)xb_add(&bar[XB_XCNT(b.x)], 1u);
    return b;
}
__device__ __forceinline__ void xcd_barrier_complete(unsigned* bar, unsigned x, unsigned& nloc, unsigned& nx) {
    const unsigned G = gridDim.x * gridDim.y * gridDim.z;
    unsigned sum, cnt, mine, sp = 0u;
    for (;;) {
        sum = 0u; cnt = 0u; mine = 0u;
#pragma unroll
        for (unsigned j = 0; j < 16; ++j) { const unsigned c = xb_ld(&bar[XB_XCNT(j)]); sum += c; cnt += (c > 0u) ? 1u : 0u; mine = (j == x) ? c : mine; }
        if (sum == G) break;
        __builtin_amdgcn_s_sleep(1);
        if ((++sp & 255u) == 0u) { if (xb_ld(&bar[XB_TMO])) break; if (sp > XB_SPIN_CAP) { atomicAdd(&bar[XB_TMO], 1u); break; } }
    }
    nloc = mine > 0u ? mine : 1u; nx = cnt > 0u ? cnt : 1u;
}
__device__ __forceinline__ void xcd_barrier(const XcdBarrier& b) {
    asm volatile("s_waitcnt vmcnt(0)" ::: "memory");
    __syncthreads();
    if (threadIdx.x == 0) {
        unsigned* bar = b.bar;
        __builtin_amdgcn_s_waitcnt(0);
        unsigned nloc = b.st[0], nx = b.st[1];
        if (nloc == 0u) { xcd_barrier_complete(bar, b.x, nloc, nx); b.st[0] = nloc; b.st[1] = nx; }
        const unsigned old = xb_add(&bar[XB_XSUB(b.x)], 1u);
        const unsigned gen = old / nloc;
        if (old + 1u == (gen + 1u) * nloc) {
            __builtin_amdgcn_fence(__ATOMIC_RELEASE, "agent");
            asm volatile("s_waitcnt vmcnt(0)" ::: "memory");
            const unsigned og = xb_add(&bar[XB_TOP], 1u);
            const unsigned tg = og / nx;
            if (og + 1u == (tg + 1u) * nx) xb_add(&bar[XB_TOPGEN], 1u);
            else XB_SPIN(xb_ld(&bar[XB_TOPGEN]) == tg, bar);
            __builtin_amdgcn_fence(__ATOMIC_ACQUIRE, "agent");
            xb_add(&bar[XB_XGEN(b.x)], 1u);
            asm volatile("s_waitcnt vmcnt(0)" ::: "memory");
        } else {
            XB_SPIN(xb_ld(&bar[XB_XGEN(b.x)]) == gen, bar);
            __builtin_amdgcn_fence(__ATOMIC_ACQUIRE, "agent");
            asm volatile("s_waitcnt vmcnt(0)" ::: "memory");
        }
    }
    __syncthreads();
}

typedef unsigned short bf16_t;
constexpr int NB = 4, SEQ = 2048, DM = 2048, NT = NB * SEQ;
constexpr int NH = 8, NG = 2, HD = 128, INW = 3608, INWP = 3840;
constexpr int NCMP = 127, NSEL = 32, NEXP = 32, FF = 512;
constexpr float EPS = 1e-6f;
constexpr float SCALE = 0.08838834764831845f;
constexpr int NTHREADS = 512, NWAVES = 8;
constexpr int LDS_BYTES = 147456;
constexpr int YROWS = 24576;

enum { I_X = 0, I_POS, I_LNMIX, I_WIN, I_PEK, I_WK1, I_WK2, I_PEV, I_WV1, I_WV2, I_WPOOL, I_BPOOL, I_PSCALE, I_GNNSA, I_GNPOOL, I_WOUT, I_LNMOE,
       I_WRG, I_BRG, I_WRE, I_BRE, I_WGATE, I_WUP, I_WDOWN, I_LNFINAL, N_IN };

constexpr size_t MB = 1024 * 1024;
constexpr size_t WS_CTL   = 0;
constexpr size_t CTL_ZERO_BYTES = 32768;
constexpr int    CW_CNT   = 4096;
constexpr size_t WS_RSTD1 = 1 * MB;
constexpr size_t WS_RSTD2 = 1 * MB + 65536;
constexpr size_t WS_BIAS1 = 1 * MB + 131072;
constexpr size_t WS_AROW  = 1 * MB + 262144;
constexpr size_t WS_ROPEC = 2 * MB;
constexpr size_t WS_ROPES = 2 * MB + 524288;
constexpr size_t WS_GATES = 3 * MB;
constexpr size_t WS_TOKL  = 4 * MB;
constexpr size_t WS_GATEL = 5 * MB;
constexpr size_t WS_HID   = 6 * MB;
constexpr size_t WS_CMPKV = 8 * MB;
constexpr size_t WS_WINT  = 9 * MB;
constexpr size_t WS_WOUTT = 24 * MB;
constexpr size_t WS_W1T   = 32 * MB;
constexpr size_t WS_W2T   = 160 * MB;
constexpr size_t WS_CMPW  = 224 * MB;
constexpr size_t WS_POOLW = 228 * MB;
constexpr size_t WS_POOLB = 228 * MB + 524288;
constexpr size_t WS_CPART = 447 * MB;
constexpr size_t WS_DBUF  = 463 * MB;
constexpr size_t WS_XB    = 230 * MB;
constexpr size_t WS_QN    = 262 * MB;
constexpr size_t WS_QR    = 278 * MB;
constexpr size_t WS_KV    = 294 * MB;
constexpr size_t WS_U     = 319 * MB;
constexpr size_t WS_Y     = 230 * MB;
constexpr size_t WS_OWIN  = 351 * MB;
constexpr size_t WS_OCMP  = 367 * MB;
constexpr size_t WS_OSEL  = 319 * MB;
constexpr size_t WS_ML    = 6 * MB;
constexpr size_t WS_X1B   = 351 * MB;
constexpr size_t WS_OPOOL = 383 * MB;
constexpr size_t WS_ACT   = 383 * MB;
constexpr size_t WS_MIX   = 415 * MB;
constexpr size_t WS_END   = 479 * MB;

__device__ __forceinline__ bf16_t f2bf(float f) { unsigned u = __float_as_uint(f); u += 0x7FFFu + ((u >> 16) & 1u); return (bf16_t)(u >> 16); }
__device__ __forceinline__ float bf2f(bf16_t b) { return __uint_as_float(((unsigned)b) << 16); }
__device__ __forceinline__ float wave_sum(float v) {
#pragma unroll
    for (int o = 32; o >= 1; o >>= 1) v += __shfl_xor(v, o);
    return v;
}
__device__ __forceinline__ float wave_max(float v) {
#pragma unroll
    for (int o = 32; o >= 1; o >>= 1) v = fmaxf(v, __shfl_xor(v, o));
    return v;
}

struct Args { const float* in[N_IN]; float* out; unsigned char* ws; int ph_lo, ph_hi; };

struct Frame {
    const float* in[N_IN]; float* out; unsigned char* ws;
    float* lds;
    int tid, lane, wave, G, bid;
};

template <int NACC, bool B_KFAST, class FA, class FB, class FE>
__device__ __forceinline__ void ngemm_tile(const Frame& F, int K, FA fa, FB fb, FE fe) {
    float* As = F.lds;
    float* Bs = F.lds + 1024;
    const int tid = F.tid, ty = tid >> 4, tx = tid & 15;
    float acc[NACC][2][4];
#pragma unroll
    for (int w = 0; w < NACC; ++w)
#pragma unroll
        for (int i = 0; i < 2; ++i)
#pragma unroll
            for (int j = 0; j < 4; ++j) acc[w][i][j] = 0.f;
    for (int k0 = 0; k0 < K; k0 += 16) {
#pragma unroll
        for (int i = 0; i < 2; ++i) { const int idx = tid + 512 * i, m = idx >> 4, kk = idx & 15; As[kk * 64 + m] = fa(m, k0 + kk); }
#pragma unroll
        for (int w = 0; w < NACC; ++w)
#pragma unroll
            for (int i = 0; i < 2; ++i) { const int idx = tid + 512 * i; int kk, n; if (B_KFAST) { n = idx >> 4; kk = idx & 15; } else { kk = idx >> 6; n = idx & 63; }
                Bs[w * 1024 + kk * 64 + n] = fb(w, k0 + kk, n); }
        __syncthreads();
#pragma unroll
        for (int kk = 0; kk < 16; ++kk) {
            const float a0 = As[kk * 64 + 2 * ty], a1 = As[kk * 64 + 2 * ty + 1];
#pragma unroll
            for (int w = 0; w < NACC; ++w) {
                const float4 b = *(const float4*)&Bs[w * 1024 + kk * 64 + 4 * tx];
                acc[w][0][0] += a0 * b.x; acc[w][0][1] += a0 * b.y; acc[w][0][2] += a0 * b.z; acc[w][0][3] += a0 * b.w;
                acc[w][1][0] += a1 * b.x; acc[w][1][1] += a1 * b.y; acc[w][1][2] += a1 * b.z; acc[w][1][3] += a1 * b.w;
            }
        }
        __syncthreads();
    }
#pragma unroll
    for (int i = 0; i < 2; ++i)
#pragma unroll
        for (int j = 0; j < 4; ++j) fe(2 * ty + i, 4 * tx + j, acc[0][i][j], acc[NACC - 1][i][j]);
}

template <class KR>
__device__ __forceinline__ void nattn(const float* qv, float* sc, int nkeys, KR keyrow, const bf16_t* Kb, const bf16_t* Vb, int lane, float& o0, float& o1, float& inv_sum) {
    float mx = -3.0e38f;
    for (int i = lane; i < nkeys; i += 64) {
        const int kr = keyrow(i);
        float s = -3.0e38f;
        if (kr >= 0) {
            const bf16_t* kp = Kb + (size_t)kr * HD;
            float a = 0.f;
#pragma unroll 8
            for (int d = 0; d < HD; d += 2) { const unsigned w = *(const unsigned*)(kp + d); a += qv[d] * __uint_as_float(w << 16) + qv[d + 1] * __uint_as_float(w & 0xFFFF0000u); }
            s = a * SCALE;
        }
        sc[i] = s; mx = fmaxf(mx, s);
    }
    mx = wave_max(mx);
    if (mx < -1.0e38f) { o0 = 0.f; o1 = 0.f; inv_sum = 0.f; for (int i = lane; i < nkeys; i += 64) sc[i] = 0.f; return; }
    float sum = 0.f;
    for (int i = lane; i < nkeys; i += 64) { const float s = sc[i]; const float e = (s < -1.0e38f) ? 0.f : __expf(s - mx); sc[i] = e; sum += e; }
    sum = wave_sum(sum);
    inv_sum = 1.f / sum;
    float a0 = 0.f, a1 = 0.f;
    for (int i = 0; i < nkeys; ++i) {
        const float p = sc[i];
        if (p != 0.f) { const int kr = keyrow(i); const bf16_t* vp = Vb + (size_t)kr * HD; a0 += p * bf2f(vp[lane]); a1 += p * bf2f(vp[lane + 64]); }
    }
    o0 = a0 * inv_sum; o1 = a1 * inv_sum;
}

__device__ __forceinline__ float gelu_tanh(float x) { const float u = 0.7978845608028654f * (x + 0.044715f * x * x * x); return 0.5f * x * (1.f + tanhf(u)); }


namespace pg8 {
typedef short bf16x8 __attribute__((ext_vector_type(8)));
typedef float f32x4 __attribute__((ext_vector_type(4)));
typedef unsigned u32x4 __attribute__((ext_vector_type(4)));
constexpr int BM = 256, BK = 64, HALF = 128, HTB = HALF * BK * 2, STAGE_BYTES = 8 * HTB, NXCD = 8, WGM = 8;
__device__ __forceinline__ int lds_byte(int r, int c) { const int st = (r >> 4) * 2 + (c >> 5), rr = r & 15, cc = c & 31, ob = rr * 64 + cc * 2; return st * 1024 + (ob ^ (((ob >> 9) & 1) << 5)); }
__device__ __forceinline__ void stage_rc(int b, int& R, int& C) { const int st = b / 1024, sb = b % 1024, swz = sb ^ (((sb >> 9) & 1) << 5); R = (st >> 1) * 16 + swz / 64; C = (st & 1) * 32 + (swz % 64) / 2; }
struct Unit { int pm, pn, e, li; };
__device__ __forceinline__ unsigned cvt_pk_bf16(float lo, float hi) { unsigned r; asm volatile("v_cvt_pk_bf16_f32 %0, %1, %2" : "=v"(r) : "v"(lo), "v"(hi)); return r; }

struct DenseOrder {
    const char* A; const char* Bt; int lda, ldb; int nM, nN, nwg, G, c;
    __device__ void init(const void* A_, const void* Bt_, int lda_, int ldb_, int M, int N, int G_, int c_) { A = (const char*)A_; Bt = (const char*)Bt_; lda = lda_; ldb = ldb_; nM = M / BM; nN = N / BM; nwg = nM * nN; G = G_; c = c_; }
    __device__ __forceinline__ bool next(int i, Unit& u) const {
        const long L = (long)i * G + c; if (L >= nwg) return false;
        int wgid = (int)L; { const int q = nwg / NXCD, r = nwg % NXCD, xcd = wgid % NXCD, off = wgid / NXCD; wgid = (xcd < r ? xcd * (q + 1) : r * (q + 1) + (xcd - r) * q) + off; }
        const int nig = WGM * nN, gid = wgid / nig, fm = gid * WGM, gsz = (nM - fm) < WGM ? (nM - fm) : WGM;
        u.pm = fm + ((wgid % nig) % gsz); u.pn = (wgid % nig) / gsz; u.e = 0; u.li = i; return true;
    }
    __device__ __forceinline__ const char* a_base(const Unit& u) const { return A + (size_t)u.pm * BM * lda * 2; }
    __device__ __forceinline__ const char* b_base(const Unit& u) const { return Bt + (size_t)u.pn * BM * ldb * 2; }
    __device__ __forceinline__ unsigned a_row_off(const Unit&, int r) const { return (unsigned)r * (unsigned)lda * 2u; }
};

template <class Epi, class Sched, bool GATHER>
__device__ __forceinline__ void gemm_phase(LAS unsigned char* lds, const int K, const int lda, const int ldb, const Sched& S, const Epi& E) {
    const int tid = threadIdx.x, wid = __builtin_amdgcn_readfirstlane(tid >> 6), lane = tid & 63, wr = wid >> 2, wc = wid & 3, fr = lane & 15, fq = lane >> 4;
    const int nt = K / BK;
    int sR[2], sC[2];
#pragma unroll
    for (int i = 0; i < 2; ++i) stage_rc(tid * 16 + i * 8192, sR[i], sC[i]);
    unsigned voffB[2], voffA[2][2], nvoffA[2][2];
#pragma unroll
    for (int i = 0; i < 2; ++i) voffB[i] = (unsigned)(sR[i] * ldb + sC[i]) * 2u;
    const size_t kstep = (size_t)(BK * 2);
    const size_t hstepB = (size_t)HALF * ldb * 2;
    const unsigned ldsw = (unsigned)wid * 1024u;
    const int aoff = lds_byte(wr * 64 + fr, fq * 8), boff = lds_byte(wc * 32 + fr, fq * 8);
#define PG8_SA(b, h) (((b) * 2 + (h)) * HTB)
#define PG8_SB(b, h) ((4 + (b) * 2 + (h)) * HTB)
#define PG8_STAGE(bufoff, gbase, voff) do { _Pragma("unroll") for (int _i = 0; _i < 2; ++_i) \
        __builtin_amdgcn_global_load_lds((const unsigned*)((const char*)(gbase) + (voff)[_i]), (LAS unsigned*)(lds + (bufoff) + ldsw + _i * 8192), 16, 0, 0); } while (0)
#define PG8_LDA(dst, b, h) do { _Pragma("unroll") for (int m = 0; m < 4; ++m) _Pragma("unroll") for (int k = 0; k < 2; ++k) dst[m][k] = *(const LAS bf16x8*)(lds + PG8_SA(b, h) + aoff + m * 2048 + k * 1024); } while (0)
#define PG8_LDB(dst, b, h) do { _Pragma("unroll") for (int n = 0; n < 2; ++n) _Pragma("unroll") for (int k = 0; k < 2; ++k) dst[n][k] = *(const LAS bf16x8*)(lds + PG8_SB(b, h) + boff + n * 2048 + k * 1024); } while (0)
#define PG8_MMA(ai, bj, At, Bt) do { __builtin_amdgcn_s_setprio(1); _Pragma("unroll") for (int m = 0; m < 4; ++m) _Pragma("unroll") for (int n = 0; n < 2; ++n) _Pragma("unroll") for (int k = 0; k < 2; ++k) \
        acc[ai][bj][m][n] = __builtin_amdgcn_mfma_f32_16x16x32_bf16(Bt[n][k], At[m][k], acc[ai][bj][m][n], 0, 0, 0); __builtin_amdgcn_s_setprio(0); } while (0)
#define PG8_WAIT_V(n) asm volatile("s_waitcnt vmcnt(" #n ")" ::: "memory")
#define PG8_WAIT_L(n) asm volatile("s_waitcnt lgkmcnt(" #n ")" ::: "memory")
#define PG8_BAR __builtin_amdgcn_s_barrier()
#define PG8_SCHED __builtin_amdgcn_sched_barrier(0)
#define PG8_AOFFS(dst, u) do { _Pragma("unroll") for (int _h = 0; _h < 2; ++_h) _Pragma("unroll") for (int _i = 0; _i < 2; ++_i) dst[_h][_i] = S.a_row_off(u, _h * HALF + sR[_i]) + (unsigned)sC[_i] * 2u; } while (0)
    Unit cur, nxt; int ui = 0;
    if (!S.next(0, cur)) return;
    f32x4 acc[2][2][4][2];
#pragma unroll
    for (int a = 0; a < 2; ++a)
#pragma unroll
        for (int b = 0; b < 2; ++b)
#pragma unroll
            for (int m = 0; m < 4; ++m)
#pragma unroll
                for (int n = 0; n < 2; ++n) acc[a][b][m][n] = (f32x4){0.f, 0.f, 0.f, 0.f};
    bf16x8 At[4][2], B0[2][2], B1[2][2];
    const char* cA = S.a_base(cur); const char* cB = S.b_base(cur);
    PG8_AOFFS(voffA, cur);
    PG8_STAGE(PG8_SB(0, 0), cB, voffB); PG8_STAGE(PG8_SA(0, 0), cA, voffA[0]); PG8_STAGE(PG8_SB(0, 1), cB + hstepB, voffB); PG8_STAGE(PG8_SA(0, 1), cA, voffA[1]);
    if (wr == 1) PG8_BAR;
    PG8_WAIT_V(4); PG8_BAR;
    PG8_STAGE(PG8_SB(1, 0), cB + kstep, voffB); PG8_STAGE(PG8_SA(1, 0), cA + kstep, voffA[0]); PG8_STAGE(PG8_SB(1, 1), cB + hstepB + kstep, voffB);
    PG8_WAIT_V(6); PG8_BAR;
    for (;;) {
        const bool has_next = S.next(ui + 1, nxt);
        const char* nA = has_next ? S.a_base(nxt) : cA; const char* nB = has_next ? S.b_base(nxt) : cB;
        if (GATHER) { if (has_next) { PG8_AOFFS(nvoffA, nxt); } else {
#pragma unroll
            for (int _h = 0; _h < 2; ++_h)
#pragma unroll
                for (int _i = 0; _i < 2; ++_i) nvoffA[_h][_i] = voffA[_h][_i]; } }
        for (int t = 0; t < nt; t += 2) {
            const bool last = (t == nt - 2);
            const char* a1 = cA + (size_t)(t + 1) * kstep;
            const char* a2 = last ? nA : cA + (size_t)(t + 2) * kstep; const char* b2 = last ? nB : cB + (size_t)(t + 2) * kstep;
            const char* a3 = a2 + kstep; const char* b3 = b2 + kstep;
            unsigned vA2[2][2];
#pragma unroll
            for (int _h = 0; _h < 2; ++_h)
#pragma unroll
                for (int _i = 0; _i < 2; ++_i) vA2[_h][_i] = (GATHER && last) ? nvoffA[_h][_i] : voffA[_h][_i];
            PG8_LDB(B0, 0, 0); PG8_SCHED; PG8_LDA(At, 0, 0); PG8_STAGE(PG8_SA(1, 1), a1, voffA[1]);
            PG8_WAIT_L(8); PG8_BAR; PG8_WAIT_L(0); PG8_MMA(0, 0, At, B0); PG8_BAR; PG8_SCHED;
            PG8_LDB(B1, 0, 1); PG8_STAGE(PG8_SB(0, 0), b2, voffB);
            PG8_BAR; PG8_WAIT_L(0); PG8_MMA(0, 1, At, B1); PG8_BAR;
            PG8_LDA(At, 0, 1); PG8_STAGE(PG8_SA(0, 0), a2, vA2[0]);
            PG8_BAR; PG8_WAIT_L(0); PG8_MMA(1, 0, At, B0); PG8_BAR; PG8_SCHED;
            PG8_STAGE(PG8_SB(0, 1), b2 + hstepB, voffB);
            PG8_WAIT_V(6); PG8_BAR; PG8_MMA(1, 1, At, B1); PG8_BAR;
            PG8_LDB(B0, 1, 0); PG8_SCHED; PG8_LDA(At, 1, 0); PG8_STAGE(PG8_SA(0, 1), a2, vA2[1]);
            PG8_WAIT_L(8); PG8_BAR; PG8_WAIT_L(0); PG8_MMA(0, 0, At, B0); PG8_BAR; PG8_SCHED;
            PG8_LDB(B1, 1, 1); PG8_STAGE(PG8_SB(1, 0), b3, voffB);
            PG8_BAR; PG8_WAIT_L(0); PG8_MMA(0, 1, At, B1); PG8_BAR;
            PG8_LDA(At, 1, 1); PG8_STAGE(PG8_SA(1, 0), a3, vA2[0]);
            PG8_BAR; PG8_WAIT_L(0); PG8_MMA(1, 0, At, B0); PG8_BAR; PG8_SCHED;
            PG8_STAGE(PG8_SB(1, 1), b3 + hstepB, voffB);
            PG8_WAIT_V(6); PG8_BAR; PG8_MMA(1, 1, At, B1); PG8_BAR;
        }
        E(acc, cur, wr, wc, fr, fq);
        if (!has_next) break;
#pragma unroll
        for (int a = 0; a < 2; ++a)
#pragma unroll
            for (int b = 0; b < 2; ++b)
#pragma unroll
                for (int m = 0; m < 4; ++m)
#pragma unroll
                    for (int n = 0; n < 2; ++n) acc[a][b][m][n] = (f32x4){0.f, 0.f, 0.f, 0.f};
        cur = nxt; cA = nA; cB = nB; ++ui;
        if (GATHER) {
#pragma unroll
            for (int _h = 0; _h < 2; ++_h)
#pragma unroll
                for (int _i = 0; _i < 2; ++_i) voffA[_h][_i] = nvoffA[_h][_i]; }
    }
    PG8_WAIT_V(0);
    if (wr == 0) PG8_BAR;
    PG8_BAR;
#undef PG8_SA
#undef PG8_SB
#undef PG8_STAGE
#undef PG8_LDA
#undef PG8_LDB
#undef PG8_MMA
#undef PG8_WAIT_V
#undef PG8_WAIT_L
#undef PG8_BAR
#undef PG8_SCHED
#undef PG8_AOFFS
}
}

__device__ __forceinline__ void transpose_tile(const Frame& F, const float* src, int lds_, bf16_t* dstrow0, int ldd, int k0, int n0, const float* kscale) {
    float* T = F.lds;
    const int tid = F.tid, kk = tid >> 4, n4 = (tid & 15) * 4;
#pragma unroll
    for (int i = 0; i < 2; ++i) { const int k = kk + 32 * i; float4 v = *(const float4*)(src + (size_t)(k0 + k) * lds_ + n0 + n4); const float sc = kscale ? kscale[k0 + k] : 1.f;
        T[(n4 + 0) * 65 + k] = v.x * sc; T[(n4 + 1) * 65 + k] = v.y * sc; T[(n4 + 2) * 65 + k] = v.z * sc; T[(n4 + 3) * 65 + k] = v.w * sc; }
    __syncthreads();
    { const int n = tid >> 3, k8 = (tid & 7) * 8; const float* t = T + n * 65 + k8;
      pg8::u32x4 w; w.x = pg8::cvt_pk_bf16(t[0], t[1]); w.y = pg8::cvt_pk_bf16(t[2], t[3]); w.z = pg8::cvt_pk_bf16(t[4], t[5]); w.w = pg8::cvt_pk_bf16(t[6], t[7]);
      *(pg8::u32x4*)(dstrow0 + (size_t)n * ldd + k0 + k8) = w; }
    __syncthreads();
}


namespace att {
typedef short bf16x8 __attribute__((ext_vector_type(8)));
typedef short s16x4 __attribute__((ext_vector_type(4)));
typedef float f32x16 __attribute__((ext_vector_type(16)));
typedef float f32x4 __attribute__((ext_vector_type(4)));
typedef unsigned u32x4 __attribute__((ext_vector_type(4)));
constexpr int SHM = 16384;
constexpr int L_V = 0, L_K = 2 * SHM, L_WS = 4 * SHM, L_PART = L_WS + 8 * 64 * 4, L_SELM = L_PART + 4 * 64 * 33 * 4, L_VALS = L_SELM + 256, L_ITEM = L_VALS + 8 * 64 * 4, L_END = L_ITEM + 16;
constexpr float C2 = 1.4426950408889634f * SCALE;
#define KSWZ(row, colB) ((row) * 256 + ((colB) ^ (((row) & 7) << 4)))
#define SBAR() __builtin_amdgcn_sched_barrier(0)
__device__ __forceinline__ int v_st(int k, int c) { const int kk = (k & ~0xC) | ((k & 4) << 1) | ((k & 8) >> 1); return ((kk >> 3) * 4 + (c >> 5)) * 512 + ((kk & 7) * 32 + (c & 31)) * 2; }
__device__ __forceinline__ int v_rd_base(int lane) { return ((lane & 3) << 3) | (((lane >> 2) & 3) << 6) | (((lane >> 4) & 1) << 5) | (((lane >> 5) & 1) << 8); }
constexpr int v_rd_off(int d0, int ks, int half) { return d0 * 512 + ks * 4096 + half * 2048; }
__device__ __forceinline__ int crow(int r, int hi) { return (r & 3) + 8 * (r >> 2) + 4 * hi; }
__device__ __forceinline__ unsigned cvtpk(float lo, float hi) { unsigned r; asm volatile("v_cvt_pk_bf16_f32 %0, %1, %2" : "=v"(r) : "v"(lo), "v"(hi)); return r; }
__device__ __forceinline__ float swap_max(float v) { auto rr = __builtin_amdgcn_permlane32_swap(__float_as_uint(v), __float_as_uint(v), false, false); return fmaxf(__uint_as_float(rr[0]), __uint_as_float(rr[1])); }
__device__ __forceinline__ float swap_sum(float v) { auto rr = __builtin_amdgcn_permlane32_swap(__float_as_uint(v), __float_as_uint(v), false, false); return __uint_as_float(rr[0]) + __uint_as_float(rr[1]); }

struct WV { int tid, wid, lane, r32, hi, vb0; unsigned ksrc[2], vsrc[2]; char* lds; LAS unsigned char* ldsL; };
__device__ __forceinline__ void wv_src_init(WV& w) {
#pragma unroll
    for (int i = 0; i < 2; ++i) {
        const int L = (w.wid * 2 + i) * 1024 + w.lane * 16;
        { const int row = L >> 8, colB = (L & 255) ^ ((row & 7) << 4); w.ksrc[i] = (unsigned)(row * 256 + colB); }
        { const int sub = L >> 9, kkhi = sub >> 2, cblk = sub & 3, within = L & 511, kklo = within >> 6, cc = (within >> 1) & 31;
          const int kk = kkhi * 8 + kklo, k = (kk & ~0xC) | ((kk & 4) << 1) | ((kk & 8) >> 1), c = cblk * 32 + cc; w.vsrc[i] = (unsigned)(k * 256 + c * 2); }
    }
}
__device__ __forceinline__ void dma_tile(const WV& w, const bf16_t* Kt, const bf16_t* Vt, int buf) {
    int ln = w.lane; asm volatile("" : "+v"(ln));
#pragma unroll
    for (int i = 0; i < 2; ++i) {
        const int L = (w.wid * 2 + i) * 1024 + ln * 16;
        const int row = L >> 8, colB = (L & 255) ^ ((row & 7) << 4); const unsigned ksrc = (unsigned)(row * 256 + colB);
        const int sub = L >> 9, kkhi = sub >> 2, cblk = sub & 3, within = L & 511, kklo = within >> 6, cc = (within >> 1) & 31;
        const int kk = kkhi * 8 + kklo, k = (kk & ~0xC) | ((kk & 4) << 1) | ((kk & 8) >> 1), c = cblk * 32 + cc; const unsigned vsrc = (unsigned)(k * 256 + c * 2);
        __builtin_amdgcn_global_load_lds((const unsigned*)((const char*)Vt + vsrc), (LAS unsigned*)(w.ldsL + L_V + buf * SHM + (w.wid * 2 + i) * 1024), 16, 0, 0);
        __builtin_amdgcn_global_load_lds((const unsigned*)((const char*)Kt + ksrc), (LAS unsigned*)(w.ldsL + L_K + buf * SHM + (w.wid * 2 + i) * 1024), 16, 0, 0);
    }
}
__device__ __forceinline__ void qkt(const WV& w, int buf, const bf16x8 (&qr)[8], f32x16& p0, f32x16& p1) {
    p0 = f32x16{}; p1 = f32x16{};
    const char* kb[4];
#pragma unroll
    for (int dd = 0; dd < 4; ++dd) kb[dd] = w.lds + L_K + buf * SHM + KSWZ(w.r32, (dd * 16 + w.hi * 8) * 2);
#pragma unroll
    for (int d0 = 0; d0 < 8; ++d0) { const char* a = kb[d0 & 3] + (d0 >> 2) * 128;
        const bf16x8 b0 = *reinterpret_cast<const bf16x8*>(a); const bf16x8 b1 = *reinterpret_cast<const bf16x8*>(a + 32 * 256);
        p0 = __builtin_amdgcn_mfma_f32_32x32x16_bf16(b0, qr[d0], p0, 0, 0, 0);
        p1 = __builtin_amdgcn_mfma_f32_32x32x16_bf16(b1, qr[d0], p1, 0, 0, 0);
        if (d0 == 3) SBAR(); }
}
__device__ __forceinline__ void pack_p(const f32x16& p0, const f32x16& p1, bf16x8& pa0, bf16x8& pa1, bf16x8& pa2, bf16x8& pa3) {
#define PK4(P, B_, OUT) do { unsigned a0 = cvtpk(P[B_+0], P[B_+1]), a1 = cvtpk(P[B_+2], P[B_+3]); unsigned b0 = cvtpk(P[B_+4], P[B_+5]), b1 = cvtpk(P[B_+6], P[B_+7]); \
        auto r0 = __builtin_amdgcn_permlane32_swap(a0, b0, false, false); auto r1 = __builtin_amdgcn_permlane32_swap(a1, b1, false, false); \
        u32x4 w_ = {r0[0], r1[0], r0[1], r1[1]}; OUT = *reinterpret_cast<bf16x8*>(&w_); } while (0)
    PK4(p0, 0, pa0); PK4(p0, 8, pa1); PK4(p1, 0, pa2); PK4(p1, 8, pa3);
#undef PK4
}
template <int VB>
__device__ __forceinline__ void pv_tile(f32x16* o, int vb0, bf16x8 pa0, bf16x8 pa1, bf16x8 pa2, bf16x8 pa3) {
#define TRRD(dst, off) asm volatile("ds_read_b64_tr_b16 %0, %1 offset:%2" : "=&v"(dst) : "v"(vb0), "i"(off) : "memory")
#define PV_D0(d0) do { s16x4 l0, l1, l2, l3, h0, h1, h2, h3; constexpr int b_ = L_V + VB * SHM + v_rd_off(d0, 0, 0); \
        TRRD(l0, b_); TRRD(h0, b_ + 2048); TRRD(l1, b_ + 4096); TRRD(h1, b_ + 6144); TRRD(l2, b_ + 8192); TRRD(h2, b_ + 10240); TRRD(l3, b_ + 12288); TRRD(h3, b_ + 14336); \
        asm volatile("s_waitcnt lgkmcnt(0)" ::: "memory"); SBAR(); \
        o[d0] = __builtin_amdgcn_mfma_f32_32x32x16_bf16(pa0, (bf16x8){l0[0], l0[1], l0[2], l0[3], h0[0], h0[1], h0[2], h0[3]}, o[d0], 0, 0, 0); \
        o[d0] = __builtin_amdgcn_mfma_f32_32x32x16_bf16(pa1, (bf16x8){l1[0], l1[1], l1[2], l1[3], h1[0], h1[1], h1[2], h1[3]}, o[d0], 0, 0, 0); \
        o[d0] = __builtin_amdgcn_mfma_f32_32x32x16_bf16(pa2, (bf16x8){l2[0], l2[1], l2[2], l2[3], h2[0], h2[1], h2[2], h2[3]}, o[d0], 0, 0, 0); \
        o[d0] = __builtin_amdgcn_mfma_f32_32x32x16_bf16(pa3, (bf16x8){l3[0], l3[1], l3[2], l3[3], h3[0], h3[1], h3[2], h3[3]}, o[d0], 0, 0, 0); } while (0)
    PV_D0(0); PV_D0(1); PV_D0(2); PV_D0(3);
#undef PV_D0
#undef TRRD
}
__device__ __forceinline__ void store_o(const WV& w, const f32x16* o, const float* tab, bf16_t* outp) {
    bf16_t* lp = outp + (size_t)w.hi * 4096 + w.r32;
#pragma unroll
    for (int r = 0; r < 16; ++r) { const int q = crow(r, w.hi); const float sc = tab[q];
        bf16_t* p = lp; asm volatile("" : "+v"(p));
        p += ((r & 3) + 8 * (r >> 2)) * 1024;
#pragma unroll
        for (int d0 = 0; d0 < 4; ++d0) { const float v = o[d0][r] * sc; const float vn = __shfl_xor(v, 1);
            if ((w.r32 & 1) == 0) *(__attribute__((address_space(1))) unsigned*)(p + d0 * 32) = cvtpk(v, vn); } }
}

template <int MODE>
__device__ __forceinline__ void flash_pass(const WV& w, const bf16_t* Kp, const bf16_t* Vp, int j_lo, int j_hi, const bf16x8 (&qr)[8], int tpos, int tw0, unsigned selmask,
                                           f32x16 (&o)[4], float& m_reg, float& l_reg) {
    float* al_l = (float*)(w.lds + L_WS) + w.wid * 64;
    dma_tile(w, Kp + (size_t)j_lo * 64 * HD, Vp + (size_t)j_lo * 64 * HD, 0);
#define FSTEP(BUF, jj) do { const int jt = (jj);                                                                                  \
        asm volatile("s_waitcnt vmcnt(0)" ::: "memory");                                                                         \
        __syncthreads();                                                                                                         \
        if (jt + 1 < j_hi) dma_tile(w, Kp + (size_t)(jt + 1) * 64 * HD, Vp + (size_t)(jt + 1) * 64 * HD, (BUF) ^ 1);                 \
        f32x16 p0, p1;                                                                                                           \
        qkt(w, BUF, qr, p0, p1);                                                                                                 \
        const int kb = jt * 64;                                                                                                  \
        { const float NEG = -__builtin_inff();                                                                                   \
          const bool need = (kb + 63 > tw0) || (MODE == 1 && kb <= tw0 + 31 - 512);                                              \
          if (need) { const int dq = tpos - kb - 4 * w.hi; const unsigned W = (MODE == 1) ? 512u : 0x7fffffffu;                  \
              _Pragma("unroll") for (int r = 0; r < 16; ++r) { const int c = (r & 3) + 8 * (r >> 2); if ((unsigned)(dq - c) >= W) p0[r] = NEG; if ((unsigned)(dq - c - 32) >= W) p1[r] = NEG; } } \
          if (MODE == 0) { const bool sel = (selmask >> jt) & 1u;                                                                 \
              if (!__all(sel)) { _Pragma("unroll") for (int r = 0; r < 16; ++r) { p0[r] = sel ? p0[r] : NEG; p1[r] = sel ? p1[r] : NEG; } } } } \
        float pmax = p0[0];                                                                                                      \
        _Pragma("unroll") for (int r = 1; r < 16; ++r) pmax = fmaxf(pmax, p0[r]);                                                \
        _Pragma("unroll") for (int r = 0; r < 16; ++r) pmax = fmaxf(pmax, p1[r]);                                                \
        pmax = swap_max(pmax);                                                                                                   \
        const float mn = fmaxf(m_reg, pmax);                                                                                     \
        const float alpha = __builtin_amdgcn_exp2f((m_reg - mn) * C2);                                                           \
        m_reg = mn;                                                                                                              \
        const float mnL = -mn * C2;                                                                                              \
        float ps = 0.f;                                                                                                          \
        _Pragma("unroll") for (int r = 0; r < 16; ++r) { p0[r] = __builtin_amdgcn_exp2f(fmaf(p0[r], C2, mnL)); ps += p0[r]; }    \
        _Pragma("unroll") for (int r = 0; r < 16; ++r) { p1[r] = __builtin_amdgcn_exp2f(fmaf(p1[r], C2, mnL)); ps += p1[r]; }    \
        ps = swap_sum(ps);                                                                                                       \
        l_reg = l_reg * alpha + ps;                                                                                              \
        if (w.hi == 0) al_l[w.r32] = alpha;                                                                                      \
        asm volatile("s_waitcnt lgkmcnt(0)" ::: "memory");                                                                       \
        _Pragma("unroll") for (int r = 0; r < 16; ++r) { const float a = al_l[crow(r, w.hi)];                                    \
            _Pragma("unroll") for (int d = 0; d < 4; ++d) o[d][r] *= a; }                                                        \
        bf16x8 pa0, pa1, pa2, pa3;                                                                                               \
        pack_p(p0, p1, pa0, pa1, pa2, pa3);                                                                                      \
        pv_tile<BUF>(o, w.vb0, pa0, pa1, pa2, pa3);                                                                              \
    } while (0)
    int j = j_lo;
    for (; j + 1 < j_hi; j += 2) { FSTEP(0, j); FSTEP(1, j + 1); }
    if (j < j_hi) FSTEP(0, j);
#undef FSTEP
    __syncthreads();
}
}

__device__ const unsigned char ATT_ITEMS[80] = {15, 30, 31, 63, 14, 28, 29, 61, 62, 13, 26, 27, 59, 60, 12, 24, 25, 57, 58, 11, 22, 23, 55, 56, 10, 20, 21, 53, 54, 9, 18, 19, 51, 52, 8, 16, 17, 49, 50, 7, 48, 6, 5,
    72, 73, 74, 75, 76, 77, 78, 79, 80, 81, 82, 83, 84, 85, 86, 87, 88, 89, 90, 91, 92, 93, 94, 95, 4, 71, 3, 70, 2, 69, 1, 68, 0, 67, 66, 65, 64};
constexpr int CW_QUEUE = 6144;
constexpr int CW_CVTQ = 6144 + 256;

__device__ __forceinline__ void p_attn(const Frame& F, unsigned char* lds_raw, int rep) {
    using namespace att;
    WV w; w.tid = F.tid; w.wid = F.wave; w.lane = F.lane; w.r32 = F.lane & 31; w.hi = F.lane >> 5;
    w.lds = (char*)lds_raw + 1024; w.ldsL = (LAS unsigned char*)lds_raw + 1024;
    w.vb0 = (int)(uintptr_t)(w.lds) + v_rd_base(w.lane);
    const bf16_t* qn = (const bf16_t*)(F.ws + WS_QN); const bf16_t* qrp = (const bf16_t*)(F.ws + WS_QR); const bf16_t* kv = (const bf16_t*)(F.ws + WS_KV);
    const bf16_t* ckv = (const bf16_t*)(F.ws + WS_CMPKV);
    bf16_t* ocmp = (bf16_t*)(F.ws + WS_OCMP); bf16_t* owin = (bf16_t*)(F.ws + WS_OWIN); bf16_t* osel = (bf16_t*)(F.ws + WS_OSEL); float* ml = (float*)(F.ws + WS_ML);
    unsigned* qctr = (unsigned*)(F.ws + WS_CTL) + CW_QUEUE + 64 * rep;
    float* wsf = (float*)(w.lds + L_WS) + w.wid * 64;
    float* part = (float*)(w.lds + L_PART); unsigned* selm = (unsigned*)(w.lds + L_SELM); float* vals = (float*)(w.lds + L_VALS) + w.wid * 64; volatile int* itemw = (volatile int*)(w.lds + L_ITEM);
    const int hr = w.wid >> 1, th = w.wid & 1;
    for (;;) {
        __syncthreads();
        if (F.tid == 0) itemw[0] = (int)atomicAdd(qctr, 1u);
        __syncthreads();
        const int item = itemw[0];
        if (item >= 640) break;
        const int ent = ATT_ITEMS[item >> 3], bg = item & 7, type = ent >> 5, qb = ent & 31, b = bg >> 1, g = bg & 1, h = 4 * g + hr;
        const int t0 = qb * 64 + th * 32, tpos = t0 + w.r32, tok0 = b * SEQ + t0;
        const size_t qoff = (((size_t)b * NH + h) * SEQ + t0 + w.r32) * HD + w.hi * 8;
        const size_t kvoff = ((size_t)b * NG + g) * SEQ * HD;
        bf16x8 qr[8];
        f32x16 o[4];
#ifndef ATT_NO_WIN
        if (type == 2) {
#pragma unroll
            for (int d0 = 0; d0 < 8; ++d0) qr[d0] = *(const bf16x8*)(qrp + qoff + d0 * 16);
#pragma unroll
            for (int d = 0; d < 4; ++d) o[d] = f32x16{};
            float m_reg = -1e30f, l_reg = 0.f;
            flash_pass<1>(w, kv + (size_t)4 * (4 * MB / 2) + kvoff, kv + (size_t)5 * (4 * MB / 2) + kvoff, qb >= 8 ? qb - 8 : 0, qb + 1, qr, tpos, t0, 0u, o, m_reg, l_reg);
            if (w.hi == 0) wsf[w.r32] = 1.f / l_reg;
            asm volatile("s_waitcnt lgkmcnt(0)" ::: "memory");
            store_o(w, o, wsf, owin + (size_t)tok0 * 1024 + h * HD);
            continue;
        }
#endif
#ifndef ATT_NO_CMP
        {
#pragma unroll
            for (int d0 = 0; d0 < 8; ++d0) qr[d0] = *(const bf16x8*)(qn + qoff + d0 * 16);
            const bf16_t* Kc = ckv + (size_t)bg * 128 * HD; const bf16_t* Vc = ckv + (size_t)1024 * HD + (size_t)bg * 128 * HD;
            dma_tile(w, Kc, Vc, 0); dma_tile(w, Kc + 64 * HD, Vc + 64 * HD, 1);
            asm volatile("s_waitcnt vmcnt(0)" ::: "memory");
            __syncthreads();
            f32x16 pA0, pA1, pB0, pB1;
            qkt(w, 0, qr, pA0, pA1); qkt(w, 1, qr, pB0, pB1);
            const int nmax = tpos >= 31 ? ((tpos - 31) >> 4) : -1;
            const float NEG = -__builtin_inff();
            float pmax = NEG;
#pragma unroll
            for (int r = 0; r < 16; ++r) { const int n = crow(r, w.hi);
                pA0[r] = (n <= nmax) ? pA0[r] : NEG; pA1[r] = (n + 32 <= nmax) ? pA1[r] : NEG; pB0[r] = (n + 64 <= nmax) ? pB0[r] : NEG; pB1[r] = (n + 96 <= nmax) ? pB1[r] : NEG;
                pmax = fmaxf(fmaxf(pmax, pA0[r]), fmaxf(pA1[r], fmaxf(pB0[r], pB1[r]))); }
            pmax = swap_max(pmax);
            const float mm = (pmax == NEG) ? 0.f : pmax;
            const float mnL = -mm * C2;
            float ps = 0.f;
#pragma unroll
            for (int r = 0; r < 16; ++r) { pA0[r] = __builtin_amdgcn_exp2f(fmaf(pA0[r], C2, mnL)); pA1[r] = __builtin_amdgcn_exp2f(fmaf(pA1[r], C2, mnL));
                pB0[r] = __builtin_amdgcn_exp2f(fmaf(pB0[r], C2, mnL)); pB1[r] = __builtin_amdgcn_exp2f(fmaf(pB1[r], C2, mnL)); ps += (pA0[r] + pA1[r]) + (pB0[r] + pB1[r]); }
            ps = swap_sum(ps);
            const float inv = ps > 0.f ? 1.f / ps : 0.f;
#pragma unroll
            for (int r = 0; r < 16; ++r) { pA0[r] *= inv; pA1[r] *= inv; pB0[r] *= inv; pB1[r] *= inv; }
            {
                float av[16], bv[16];
#pragma unroll
                for (int gq = 0; gq < 4; ++gq) {
                    av[gq]      = pA0[4 * gq] + pA0[4 * gq + 1] + pA0[4 * gq + 2] + 0.5f * pA0[4 * gq + 3]; bv[gq]      = 0.5f * pA0[4 * gq + 3];
                    av[4 + gq]  = pA1[4 * gq] + pA1[4 * gq + 1] + pA1[4 * gq + 2] + 0.5f * pA1[4 * gq + 3]; bv[4 + gq]  = 0.5f * pA1[4 * gq + 3];
                    av[8 + gq]  = pB0[4 * gq] + pB0[4 * gq + 1] + pB0[4 * gq + 2] + 0.5f * pB0[4 * gq + 3]; bv[8 + gq]  = 0.5f * pB0[4 * gq + 3];
                    av[12 + gq] = pB1[4 * gq] + pB1[4 * gq + 1] + pB1[4 * gq + 2] + 0.5f * pB1[4 * gq + 3]; bv[12 + gq] = 0.5f * pB1[4 * gq + 3];
                }
                float* prow = part + ((size_t)hr * 64 + th * 32 + w.r32) * 33;
#pragma unroll
                for (int idx = 0; idx < 16; ++idx) {
                    const float bo = __shfl_xor(bv[idx], 32);
                    const float bprev = (idx > 0) ? __shfl_xor(bv[idx > 0 ? idx - 1 : 0], 32) : 0.f;
                    const float inc = w.hi ? bo : bprev;
                    prow[2 * idx + w.hi] = av[idx] + inc;
                }
            }
            if (type == 0) {
                bf16x8 pa0, pa1, pa2, pa3;
#pragma unroll
                for (int d = 0; d < 4; ++d) o[d] = f32x16{};
                pack_p(pA0, pA1, pa0, pa1, pa2, pa3); pv_tile<0>(o, w.vb0, pa0, pa1, pa2, pa3);
                pack_p(pB0, pB1, pa0, pa1, pa2, pa3); pv_tile<1>(o, w.vb0, pa0, pa1, pa2, pa3);
                if (w.hi == 0) wsf[w.r32] = 1.f;
                asm volatile("s_waitcnt lgkmcnt(0)" ::: "memory");
                store_o(w, o, wsf, ocmp + (size_t)tok0 * 1024 + h * HD);
            }
            __syncthreads();
#pragma unroll 1
            for (int ps2 = 0; ps2 < 4; ++ps2) {
                int ln = w.lane; asm volatile("" : "+v"(ln));
                const int j = ln & 31, hi2 = ln >> 5;
                const int tk = 8 * w.wid + 2 * ps2 + hi2, t = qb * 64 + tk, cur = qb;
                float imp = 0.f;
#pragma unroll
                for (int r = 0; r < 4; ++r) imp += part[((size_t)r * 64 + tk) * 33 + j];
                const bool ok = (64 * j <= t), forced = (j == 0) || (cur - j >= 0 && cur - j < 2);
                const float val = (ok && forced) ? 1.0e30f : (ok ? imp : -1.0e30f);
                vals[ln] = val;
                asm volatile("s_waitcnt lgkmcnt(0)" ::: "memory");
                int rank = 0;
#pragma unroll
                for (int jj = 0; jj < 32; ++jj) { const float o2 = vals[hi2 * 32 + jj]; rank += (o2 > val || (o2 == val && jj < j)) ? 1 : 0; }
                const unsigned long long bal = __ballot(rank < 16 && val >= 0.f);
                if (w.lane == 0) { selm[8 * w.wid + 2 * ps2] = (unsigned)bal; selm[8 * w.wid + 2 * ps2 + 1] = (unsigned)(bal >> 32); }
            }
            __syncthreads();
        }
#endif
#ifndef ATT_NO_SEL
        {
            const unsigned sm = selm[th * 32 + w.r32];
            const int ntile = qb + 1, hsplit = (ntile + 1) >> 1;
            const int ja = (qb >= 16 && type == 1) ? hsplit : 0, jb = (qb >= 16 && type == 0) ? hsplit : ntile;
#pragma unroll
            for (int d0 = 0; d0 < 8; ++d0) qr[d0] = *(const bf16x8*)(qrp + qoff + d0 * 16);
#pragma unroll
            for (int d = 0; d < 4; ++d) o[d] = f32x16{};
            float m_reg = -1e30f, l_reg = 0.f;
            flash_pass<0>(w, kv + (size_t)2 * (4 * MB / 2) + kvoff, kv + (size_t)3 * (4 * MB / 2) + kvoff, ja, jb, qr, tpos, t0, sm, o, m_reg, l_reg);
            if (w.hi == 0) { wsf[w.r32] = l_reg > 0.f ? 1.f / l_reg : 0.f; float* mp = ml + (((size_t)type * NT + tok0 + w.r32) * NH + h) * 2; mp[0] = m_reg; mp[1] = l_reg; }
            asm volatile("s_waitcnt lgkmcnt(0)" ::: "memory");
            store_o(w, o, wsf, osel + (size_t)type * NT * 1024 + (size_t)tok0 * 1024 + h * HD);
        }
#endif
    }
}

struct CvtTile { const float* src; const float* ksc; bf16_t* dst0; int sld, ldd, mode; };
__device__ __forceinline__ CvtTile cvt_decode(const Frame& F, int t) {
    CvtTile c; c.ksc = nullptr; c.mode = 0;
    if (t < 4096) { const int e = t >> 7, mat = (t >> 6) & 1, kt = (t >> 1) & 31, nt = t & 1;
        c.src = (mat ? F.in[I_WUP] : F.in[I_WGATE]) + ((size_t)e * DM + kt * 64) * FF + nt * 256; c.sld = FF; c.ksc = F.in[I_LNMOE] + kt * 64;
        c.dst0 = (bf16_t*)(F.ws + WS_W1T) + ((size_t)e * 1024 + nt * 512 + mat * 128) * DM + kt * 64; c.ldd = DM; c.mode = 1; return c; }
    t -= 4096;
    if (t < 2048) { const int e = t >> 6, kt = (t >> 3) & 7, nt = t & 7;
        c.src = F.in[I_WDOWN] + ((size_t)e * FF + kt * 64) * DM + nt * 256; c.sld = DM;
        c.dst0 = (bf16_t*)(F.ws + WS_W2T) + ((size_t)e * 2048 + nt * 256) * FF + kt * 64; c.ldd = FF; return c; }
    t -= 2048;
    if (t < 256) { const int kt = t >> 3, nt = t & 7;
        c.src = F.in[I_WOUT] + (size_t)kt * 64 * DM + nt * 256; c.sld = DM; c.dst0 = (bf16_t*)(F.ws + WS_WOUTT) + (size_t)nt * 256 * DM + kt * 64; c.ldd = DM; return c; }
    t -= 256;
    if (t < 480) { const int kt = t / 15, nt = t % 15;
        c.src = F.in[I_WIN] + (size_t)kt * 64 * INW; c.sld = INW; c.ksc = F.in[I_LNMIX] + kt * 64;
        c.dst0 = (bf16_t*)(F.ws + WS_WINT) + (size_t)nt * 256 * DM + kt * 64; c.ldd = DM; c.mode = 2 + nt; return c; }
    t -= 480;
    { const int kv = t >> 6, kt = t & 63;
      c.src = (kv ? F.in[I_WV1] : F.in[I_WK1]) + (size_t)kt * 64 * 256; c.sld = 256; c.dst0 = (bf16_t*)(F.ws + WS_CMPW) + (size_t)kv * 256 * 4096 + kt * 64; c.ldd = 4096; return c; }
}
constexpr int N_CVT_TILES = 4096 + 2048 + 256 + 480 + 128;
__device__ __forceinline__ void cvt_load(const CvtTile& c, int nq, int kq, float4 (&v)[8]) {
    const float* p = c.src + 4 * nq; bool valid = true;
    if (c.mode >= 2) { const int n = (c.mode - 2) * 256 + 4 * nq; int sc = -1; if (n < 2560) sc = n; else if (n < 3584) sc = n + 24; else if (n < 3608) sc = n - 1024; valid = sc >= 0; p = c.src + (valid ? sc : 0); }
#pragma unroll
    for (int i = 0; i < 8; ++i) v[i] = valid ? *(const float4*)(p + (size_t)(kq * 8 + i) * c.sld) : make_float4(0.f, 0.f, 0.f, 0.f);
}

__device__ __forceinline__ void cvt_stream(const Frame& F, int t_lo, int t_hi, unsigned* queue) {
    float* T = F.lds;
    volatile int* nxtw = (volatile int*)(F.lds + 64 * 257);
    const int tid = F.tid, nq = tid & 63, kq = tid >> 6;
    int t; float4 v[8]; CvtTile c;
    if (queue) { __syncthreads(); if (tid == 0) nxtw[0] = t_lo + (int)atomicAdd(queue, 1u); __syncthreads(); t = nxtw[0]; } else t = t_lo + F.bid;
    if (t < t_hi) { c = cvt_decode(F, t); cvt_load(c, nq, kq, v); }
    while (t < t_hi) {
        int tn_reg = 0;
        if (queue && tid == 0) tn_reg = t_lo + (int)atomicAdd(queue, 1u);
        __syncthreads();
#pragma unroll
        for (int i = 0; i < 8; ++i) { const float s = c.ksc ? c.ksc[kq * 8 + i] : 1.f; float* tp = T + (kq * 8 + i) * 257 + 4 * nq; tp[0] = v[i].x * s; tp[1] = v[i].y * s; tp[2] = v[i].z * s; tp[3] = v[i].w * s; }
        if (queue && tid == 0) nxtw[0] = tn_reg;
        __syncthreads();
        const CvtTile cc = c; const int tn = queue ? nxtw[0] : t + F.G;
        if (tn < t_hi) { c = cvt_decode(F, tn); cvt_load(c, nq, kq, v); }
#pragma unroll
        for (int j = 0; j < 4; ++j) { const int id = tid + 512 * j, n = id >> 3, kc = id & 7; const float* tp = T + (kc * 8) * 257 + n;
            pg8::u32x4 w; w.x = pg8::cvt_pk_bf16(tp[0], tp[257]); w.y = pg8::cvt_pk_bf16(tp[2 * 257], tp[3 * 257]); w.z = pg8::cvt_pk_bf16(tp[4 * 257], tp[5 * 257]); w.w = pg8::cvt_pk_bf16(tp[6 * 257], tp[7 * 257]);
            const int rowi = (cc.mode == 1) ? ((n >> 7) * 256 + (n & 127)) : n;
            *(pg8::u32x4*)(cc.dst0 + (size_t)rowi * cc.ldd + kc * 8) = w; }
        t = tn;
    }
    __syncthreads();
}

__device__ __forceinline__ void p0_prologue(const Frame& F) {
    const float* x = F.in[I_X];
    bf16_t* xb = (bf16_t*)(F.ws + WS_XB); float* rstd1 = (float*)(F.ws + WS_RSTD1);
    const int gw = F.bid * NWAVES + F.wave, nw = F.G * NWAVES, lane = F.lane;
    for (int r = gw; r < NT; r += nw) {
        float4 v[8]; float ss = 0.f;
#pragma unroll
        for (int i = 0; i < 8; ++i) { v[i] = *(const float4*)(x + (size_t)r * DM + i * 256 + lane * 4); ss += v[i].x * v[i].x + v[i].y * v[i].y + v[i].z * v[i].z + v[i].w * v[i].w; }
        ss = wave_sum(ss);
        if (lane == 0) rstd1[r] = rsqrtf(ss * (1.f / DM) + EPS);
#pragma unroll
        for (int i = 0; i < 8; ++i) { uint2 w; w.x = pg8::cvt_pk_bf16(v[i].x, v[i].y); w.y = pg8::cvt_pk_bf16(v[i].z, v[i].w);
            *(uint2*)(xb + (size_t)r * DM + i * 256 + lane * 4) = w; }
    }
    cvt_stream(F, 6400, N_CVT_TILES, nullptr);
    {
        const float* wp = F.in[I_WPOOL]; const float* ps = F.in[I_PSCALE]; const float* bp = F.in[I_BPOOL]; bf16_t* wpt = (bf16_t*)(F.ws + WS_POOLW); float* pb = (float*)(F.ws + WS_POOLB);
        for (int idx = F.bid * NTHREADS + F.tid; idx < 4 * 256 * 256; idx += F.G * NTHREADS) { const int k = idx & 255, n = (idx >> 8) & 255, g = idx >> 16;
            wpt[idx] = f2bf(wp[((size_t)g * 256 + k) * 256 + n] * ps[g * 256 + n]); }
        for (int idx = F.bid * NTHREADS + F.tid; idx < 1024; idx += F.G * NTHREADS) pb[idx] = bp[idx] * ps[idx];
    }
    {
        const int* pos = (const int*)F.in[I_POS]; float* rc = (float*)(F.ws + WS_ROPEC); float* rs = (float*)(F.ws + WS_ROPES);
        for (int idx = F.bid * NTHREADS + F.tid; idx < NB * SEQ * 16; idx += F.G * NTHREADS) {
            const int i = idx & 15, bs = idx >> 4;
            const float inv = exp2f(-(float)i * (1.f / 16.f) * 18.931568569324174f);
            const float ang = (float)pos[bs] * inv;
            rc[idx] = cosf(ang); rs[idx] = sinf(ang);
        }
    }
    for (int it = F.bid; it < 64; it += F.G) {
        const int kv = it >> 5, jb = (it >> 3) & 3, mc = it & 7;
        const float* pe = (kv ? F.in[I_PEV] : F.in[I_PEK]); const float* w1 = (kv ? F.in[I_WV1] : F.in[I_WK1]);
        const int mg = F.tid >> 6, j = jb * 64 + (F.tid & 63);
        float a = 0.f;
#pragma unroll 8
        for (int m = mc * 512 + mg; m < mc * 512 + 512; m += 8) a += pe[m] * w1[(size_t)m * 256 + j];
        __syncthreads();
        F.lds[F.tid] = a;
        __syncthreads();
        if (F.tid < 64) { float s = 0.f; for (int q = 0; q < 8; ++q) s += F.lds[q * 64 + F.tid]; ((float*)(F.ws + WS_BIAS1))[(mc * 2 + kv) * 256 + j] = s; }
        __syncthreads();
    }
}

struct EpiProj {
    const float* rstd1; const float* rc; const float* rs; bf16_t* qn; bf16_t* qr; bf16_t* kv; float* u; float* gates;
    __device__ __forceinline__ void operator()(const pg8::f32x4 (&acc)[2][2][4][2], const pg8::Unit& un, int wr, int wc, int fr, int fq) const {
        const int pn = un.pn;
#pragma unroll
        for (int ai = 0; ai < 2; ++ai)
#pragma unroll
            for (int m = 0; m < 4; ++m) {
                const int row = un.pm * 256 + ai * 128 + wr * 64 + m * 16 + fr; const float r1 = rstd1[row]; const int b = row >> 11, s = row & 2047;
                if (pn < 10) {
                    const bool ropeu = (pn < 4) || pn == 6 || pn == 8;
                    pg8::f32x4 c4 = {1.f, 1.f, 1.f, 1.f}, s4 = {0.f, 0.f, 0.f, 0.f};
                    if (ropeu && wc == 0) { c4 = *(const pg8::f32x4*)(rc + (size_t)row * 16 + 4 * fq); s4 = *(const pg8::f32x4*)(rs + (size_t)row * 16 + 4 * fq); }
#pragma unroll
                    for (int bj = 0; bj < 2; ++bj) {
                        const pg8::f32x4 v0 = acc[ai][bj][m][0] * r1, v1 = acc[ai][bj][m][1] * r1;
                        const int d0 = 32 * wc + 4 * fq;
                        pg8::f32x4 o0 = v0, o1 = v1;
                        if (ropeu && wc == 0) { o0 = v0 * c4 - v1 * s4; o1 = v1 * c4 + v0 * s4; }
                        uint2 w0, w1; w0.x = pg8::cvt_pk_bf16(o0[0], o0[1]); w0.y = pg8::cvt_pk_bf16(o0[2], o0[3]); w1.x = pg8::cvt_pk_bf16(o1[0], o1[1]); w1.y = pg8::cvt_pk_bf16(o1[2], o1[3]);
                        if (pn < 4) {
                            const size_t o = (((size_t)b * NH + 2 * pn + bj) * SEQ + s) * HD + d0;
                            uint2 n0, n1; n0.x = pg8::cvt_pk_bf16(v0[0], v0[1]); n0.y = pg8::cvt_pk_bf16(v0[2], v0[3]); n1.x = pg8::cvt_pk_bf16(v1[0], v1[1]); n1.y = pg8::cvt_pk_bf16(v1[2], v1[3]);
                            *(uint2*)(qn + o) = n0; *(uint2*)(qn + o + 16) = n1; *(uint2*)(qr + o) = w0; *(uint2*)(qr + o + 16) = w1;
                        } else {
                            const size_t o = (size_t)(pn - 4) * (4 * MB / 2) + (((size_t)b * NG + bj) * SEQ + s) * HD + d0;
                            *(uint2*)(kv + o) = w0; *(uint2*)(kv + o + 16) = w1;
                        }
                    }
                } else if (pn < 14) {
#pragma unroll
                    for (int bj = 0; bj < 2; ++bj)
#pragma unroll
                        for (int n = 0; n < 2; ++n) *(pg8::f32x4*)(u + (size_t)row * 1024 + (pn - 10) * 256 + bj * 128 + wc * 32 + n * 16 + 4 * fq) = acc[ai][bj][m][n] * r1;
                } else {
                    if (wc == 0) { *(pg8::f32x4*)(gates + (size_t)row * 24 + 4 * fq) = acc[ai][0][m][0] * r1; if (fq < 2) *(pg8::f32x4*)(gates + (size_t)row * 24 + 16 + 4 * fq) = acc[ai][0][m][1] * r1; }
                }
            }
    }
};

__device__ __forceinline__ void p1_proj(const Frame& F, LAS unsigned char* stage) {
    pg8::DenseOrder S; S.init(F.ws + WS_XB, F.ws + WS_WINT, DM, DM, NT, INWP, F.G, F.bid);
    EpiProj E{(const float*)(F.ws + WS_RSTD1), (const float*)(F.ws + WS_ROPEC), (const float*)(F.ws + WS_ROPES), (bf16_t*)(F.ws + WS_QN), (bf16_t*)(F.ws + WS_QR), (bf16_t*)(F.ws + WS_KV),
              (float*)(F.ws + WS_U), (float*)(F.ws + WS_GATES)};
    pg8::gemm_phase<EpiProj, pg8::DenseOrder, false>(stage, DM, DM, DM, S, E);
}

struct CmpOrder {
    const char* kc; const char* w1t; int c;
    __device__ __forceinline__ bool next(int i, pg8::Unit& u) const { if (i > 0) return false; u.e = c >> 5; u.pm = (c >> 3) & 3; u.pn = c & 7; u.li = 0; return true; }
    __device__ __forceinline__ const char* a_base(const pg8::Unit& u) const { return kc + (size_t)u.e * 4 * MB + ((size_t)u.pm * 256 * 2048 + u.pn * 512) * 2; }
    __device__ __forceinline__ const char* b_base(const pg8::Unit& u) const { return w1t + ((size_t)u.e * 256 * 4096 + u.pn * 512) * 2; }
    __device__ __forceinline__ unsigned a_row_off(const pg8::Unit&, int r) const { return (unsigned)r * 4096u; }
};
struct EpiCmp {
    float* part;
    __device__ __forceinline__ void operator()(const pg8::f32x4 (&acc)[2][2][4][2], const pg8::Unit& un, int wr, int wc, int fr, int fq) const {
        float* base = part + (((size_t)un.pn * 2 + un.e) * 1024 + un.pm * 256) * 256;
#pragma unroll
        for (int ai = 0; ai < 2; ++ai)
#pragma unroll
            for (int m = 0; m < 4; ++m) { float* rowp = base + (size_t)(ai * 128 + wr * 64 + m * 16 + fr) * 256 + wc * 32 + 4 * fq;
#pragma unroll
                for (int bj = 0; bj < 2; ++bj)
#pragma unroll
                    for (int n = 0; n < 2; ++n) *(pg8::f32x4*)(rowp + bj * 128 + n * 16) = acc[ai][bj][m][n]; }
    }
};
struct PoolOrder {
    const char* d; const char* wpt; int c;
    __device__ __forceinline__ bool next(int i, pg8::Unit& u) const { if (i > 0) return false; u.pm = c >> 2; u.pn = 0; u.e = c & 3; u.li = 0; return true; }
    __device__ __forceinline__ const char* a_base(const pg8::Unit& u) const { return d + ((size_t)u.pm * 256 * 1024 + u.e * 256) * 2; }
    __device__ __forceinline__ const char* b_base(const pg8::Unit& u) const { return wpt + (size_t)u.e * 256 * 256 * 2; }
    __device__ __forceinline__ unsigned a_row_off(const pg8::Unit&, int r) const { return (unsigned)r * 2048u; }
};
struct EpiPool {
    const float* pb; float* opool;
    __device__ __forceinline__ void operator()(const pg8::f32x4 (&acc)[2][2][4][2], const pg8::Unit& un, int wr, int wc, int fr, int fq) const {
#pragma unroll
        for (int ai = 0; ai < 2; ++ai)
#pragma unroll
            for (int m = 0; m < 4; ++m) { const int row = un.pm * 256 + ai * 128 + wr * 64 + m * 16 + fr;
#pragma unroll
                for (int bj = 0; bj < 2; ++bj)
#pragma unroll
                    for (int n = 0; n < 2; ++n) { const int c = un.e * 256 + bj * 128 + wc * 32 + n * 16 + 4 * fq;
                        *(pg8::f32x4*)(opool + (size_t)row * 1024 + c) = acc[ai][bj][m][n] + *(const pg8::f32x4*)(pb + c); } }
    }
};
__device__ __forceinline__ void p3_mid(const Frame& F, LAS unsigned char* stage) {
    if (F.bid < 64) {
        CmpOrder S{(const char*)(F.ws + WS_KV), (const char*)(F.ws + WS_CMPW), F.bid};
        EpiCmp E{(float*)(F.ws + WS_CPART)};
        pg8::gemm_phase<EpiCmp, CmpOrder, false>(stage, 512, 2048, 4096, S, E);
    } else if (F.bid < 192) {
        const int c = F.bid - 64, pm = c >> 2, gi = c & 3, w = 2 << gi;
        const float* u = (const float*)(F.ws + WS_U); bf16_t* d = (bf16_t*)(F.ws + WS_DBUF);
        for (int task = F.tid; task < 256 * 16; task += NTHREADS) {
            const int cc = task & 255, ch = task >> 8, col = gi * 256 + cc, r0 = pm * 256 + ch * 16, s0 = r0 & 2047;
            float uv[31];
#pragma unroll
            for (int q = 0; q < 31; ++q) { const int s = s0 - 15 + q; uv[q] = (s >= 0) ? u[(size_t)(r0 - 15 + q) * 1024 + col] : 0.f; }
#pragma unroll
            for (int i = 0; i < 16; ++i) { float sum = 0.f;
#pragma unroll
                for (int q = 0; q < 16; ++q) if (q < w) sum += uv[15 + i - q];
                const int s = s0 + i, cnt = (s + 1 < w) ? s + 1 : w;
                d[(size_t)(r0 + i) * 1024 + col] = f2bf(sum / (float)cnt - uv[15 + i]); }
        }
        asm volatile("s_waitcnt vmcnt(0)" ::: "memory");
        __syncthreads();
        PoolOrder S{(const char*)(F.ws + WS_DBUF), (const char*)(F.ws + WS_POOLW), c};
        EpiPool E{(const float*)(F.ws + WS_POOLB), (float*)(F.ws + WS_OPOOL)};
        pg8::gemm_phase<EpiPool, PoolOrder, false>(stage, 256, 1024, 256, S, E);
    }
    cvt_stream(F, 0, 6400, (unsigned*)(F.ws + WS_CTL) + CW_CVTQ);
}

__device__ __forceinline__ void p4_cmp2(const Frame& F) {
    const float* part = (const float*)(F.ws + WS_CPART); const float* bias1p = (const float*)(F.ws + WS_BIAS1); bf16_t* ckv = (bf16_t*)(F.ws + WS_CMPKV);
    float* H = F.lds;
    for (int it = F.bid; it < 128; it += F.G) {
        const int kvi = it >> 6, r0 = (it & 63) * 16; const float* w2 = kvi ? F.in[I_WV2] : F.in[I_WK2];
        __syncthreads();
#pragma unroll
        for (int j = 0; j < 2; ++j) { const int idx = F.tid + 512 * j, r = idx >> 6, c = (idx & 63) * 4;
            pg8::f32x4 s = {0.f, 0.f, 0.f, 0.f};
#pragma unroll
            for (int sp = 0; sp < 8; ++sp) s += *(const pg8::f32x4*)(part + (((size_t)sp * 2 + kvi) * 1024 + r0 + r) * 256 + c) + *(const pg8::f32x4*)(bias1p + (sp * 2 + kvi) * 256 + c);
            H[r * 260 + c] = gelu_tanh(s[0]); H[r * 260 + c + 1] = gelu_tanh(s[1]); H[r * 260 + c + 2] = gelu_tanh(s[2]); H[r * 260 + c + 3] = gelu_tanh(s[3]); }
        __syncthreads();
        const int r = F.tid >> 5, c0 = (F.tid & 31) * 4;
        pg8::f32x4 acc = {0.f, 0.f, 0.f, 0.f};
#pragma unroll 8
        for (int k = 0; k < 256; ++k) acc += *(const pg8::f32x4*)(w2 + (size_t)k * 128 + c0) * H[r * 260 + k];
        const int R = r0 + r; const bool pad = (R & 127) == 127;
        uint2 w; w.x = pad ? 0u : pg8::cvt_pk_bf16(acc[0], acc[1]); w.y = pad ? 0u : pg8::cvt_pk_bf16(acc[2], acc[3]);
        *(uint2*)(ckv + ((size_t)kvi * 1024 + R) * 128 + c0) = w;
    }
}

__device__ __forceinline__ void unpack8(const pg8::u32x4 w, float (&f)[8]) {
    f[0] = __uint_as_float(w.x << 16); f[1] = __uint_as_float(w.x & 0xFFFF0000u); f[2] = __uint_as_float(w.y << 16); f[3] = __uint_as_float(w.y & 0xFFFF0000u);
    f[4] = __uint_as_float(w.z << 16); f[5] = __uint_as_float(w.z & 0xFFFF0000u); f[6] = __uint_as_float(w.w << 16); f[7] = __uint_as_float(w.w & 0xFFFF0000u);
}
__device__ __forceinline__ void p6_mix(const Frame& F) {
    const bf16_t* ocmp = (const bf16_t*)(F.ws + WS_OCMP); const bf16_t* owin = (const bf16_t*)(F.ws + WS_OWIN); const bf16_t* osel = (const bf16_t*)(F.ws + WS_OSEL);
    const float* ml = (const float*)(F.ws + WS_ML); const float* gates = (const float*)(F.ws + WS_GATES);
    const float* opool = (const float*)(F.ws + WS_OPOOL); bf16_t* mix = (bf16_t*)(F.ws + WS_MIX);
    const float* gn = F.in[I_GNNSA]; const float* gp = F.in[I_GNPOOL];
    const int gw = F.bid * NWAVES + F.wave, nw = F.G * NWAVES, lane = F.lane, h = lane >> 3;
    for (int r = gw; r < NT; r += nw) {
        const bool split = ((r & 2047) >> 6) >= 16;
        const size_t o = (size_t)r * 1024 + lane * 16;
        const float* gq = gates + (size_t)r * 24 + h * 3;
        const float g0 = 1.f / (1.f + __expf(-gq[0])), g1 = 1.f / (1.f + __expf(-gq[1])), g2 = 1.f / (1.f + __expf(-gq[2]));
        float w0 = 1.f, w1 = 0.f;
        if (split) { const float* m0p = ml + ((size_t)r * NH + h) * 2; const float* m1p = ml + (((size_t)NT + r) * NH + h) * 2;
            const float m0 = m0p[0], l0 = m0p[1], m1 = m1p[0], l1 = m1p[1], M = fmaxf(m0, m1);
            const float a0 = l0 * exp2f((m0 - M) * att::C2), a1 = l1 * exp2f((m1 - M) * att::C2), inv = 1.f / (a0 + a1); w0 = a0 * inv; w1 = a1 * inv; }
        float a[16], p[16]; float sa = 0.f, sp = 0.f;
#pragma unroll
        for (int hf = 0; hf < 2; ++hf) {
            float c8[8], w8[8], s8[8], t8[8];
            unpack8(*(const pg8::u32x4*)(ocmp + o + hf * 8), c8); unpack8(*(const pg8::u32x4*)(owin + o + hf * 8), w8); unpack8(*(const pg8::u32x4*)(osel + o + hf * 8), s8);
            if (split) unpack8(*(const pg8::u32x4*)(osel + (size_t)NT * 1024 + o + hf * 8), t8);
#pragma unroll
            for (int j = 0; j < 8; ++j) { const float os = split ? (w0 * s8[j] + w1 * t8[j]) : s8[j]; a[hf * 8 + j] = g0 * c8[j] + g1 * os + g2 * w8[j]; sa += a[hf * 8 + j] * a[hf * 8 + j]; }
        }
#pragma unroll
        for (int q = 0; q < 4; ++q) { const pg8::f32x4 v = *(const pg8::f32x4*)(opool + o + q * 4); p[q * 4] = v[0]; p[q * 4 + 1] = v[1]; p[q * 4 + 2] = v[2]; p[q * 4 + 3] = v[3]; sp += v[0] * v[0] + v[1] * v[1] + v[2] * v[2] + v[3] * v[3]; }
        sa = wave_sum(sa); sp = wave_sum(sp);
        const float ra = rsqrtf(sa * (1.f / 1024.f) + EPS), rp = rsqrtf(sp * (1.f / 1024.f) + EPS);
        float ga[16], gb[16];
#pragma unroll
        for (int q = 0; q < 4; ++q) { const pg8::f32x4 v = *(const pg8::f32x4*)(gn + lane * 16 + q * 4), u = *(const pg8::f32x4*)(gp + lane * 16 + q * 4);
            ga[q * 4] = v[0]; ga[q * 4 + 1] = v[1]; ga[q * 4 + 2] = v[2]; ga[q * 4 + 3] = v[3]; gb[q * 4] = u[0]; gb[q * 4 + 1] = u[1]; gb[q * 4 + 2] = u[2]; gb[q * 4 + 3] = u[3]; }
#pragma unroll
        for (int hf = 0; hf < 2; ++hf) { pg8::u32x4 wa, wb;
            wa.x = pg8::cvt_pk_bf16(a[hf * 8] * ra * ga[hf * 8], a[hf * 8 + 1] * ra * ga[hf * 8 + 1]); wa.y = pg8::cvt_pk_bf16(a[hf * 8 + 2] * ra * ga[hf * 8 + 2], a[hf * 8 + 3] * ra * ga[hf * 8 + 3]);
            wa.z = pg8::cvt_pk_bf16(a[hf * 8 + 4] * ra * ga[hf * 8 + 4], a[hf * 8 + 5] * ra * ga[hf * 8 + 5]); wa.w = pg8::cvt_pk_bf16(a[hf * 8 + 6] * ra * ga[hf * 8 + 6], a[hf * 8 + 7] * ra * ga[hf * 8 + 7]);
            wb.x = pg8::cvt_pk_bf16(p[hf * 8] * rp * gb[hf * 8], p[hf * 8 + 1] * rp * gb[hf * 8 + 1]); wb.y = pg8::cvt_pk_bf16(p[hf * 8 + 2] * rp * gb[hf * 8 + 2], p[hf * 8 + 3] * rp * gb[hf * 8 + 3]);
            wb.z = pg8::cvt_pk_bf16(p[hf * 8 + 4] * rp * gb[hf * 8 + 4], p[hf * 8 + 5] * rp * gb[hf * 8 + 5]); wb.w = pg8::cvt_pk_bf16(p[hf * 8 + 6] * rp * gb[hf * 8 + 6], p[hf * 8 + 7] * rp * gb[hf * 8 + 7]);
            *(pg8::u32x4*)(mix + (size_t)r * DM + lane * 16 + hf * 8) = wa; *(pg8::u32x4*)(mix + (size_t)r * DM + 1024 + lane * 16 + hf * 8) = wb; }
    }
}

struct EpiOut {
    const float* x; float* out; bf16_t* x1b;
    __device__ __forceinline__ void operator()(const pg8::f32x4 (&acc)[2][2][4][2], const pg8::Unit& un, int wr, int wc, int fr, int fq) const {
#pragma unroll
        for (int ai = 0; ai < 2; ++ai)
#pragma unroll
            for (int m = 0; m < 4; ++m) {
                const int row = un.pm * 256 + ai * 128 + wr * 64 + m * 16 + fr;
#pragma unroll
                for (int bj = 0; bj < 2; ++bj)
#pragma unroll
                    for (int n = 0; n < 2; ++n) {
                        const size_t o = (size_t)row * DM + un.pn * 256 + bj * 128 + wc * 32 + n * 16 + 4 * fq;
                        const pg8::f32x4 v = acc[ai][bj][m][n] + *(const pg8::f32x4*)(x + o);
                        *(pg8::f32x4*)(out + o) = v;
                        uint2 w; w.x = pg8::cvt_pk_bf16(v[0], v[1]); w.y = pg8::cvt_pk_bf16(v[2], v[3]); *(uint2*)(x1b + o) = w;
                    }
            }
    }
};
__device__ __forceinline__ void p7_out(const Frame& F, LAS unsigned char* stage) {
    pg8::DenseOrder S; S.init(F.ws + WS_MIX, F.ws + WS_WOUTT, DM, DM, NT, DM, F.G, F.bid);
    EpiOut E{F.in[I_X], F.out, (bf16_t*)(F.ws + WS_X1B)};
    pg8::gemm_phase<EpiOut, pg8::DenseOrder, false>(stage, DM, DM, DM, S, E);
}

__device__ __forceinline__ void p8_router(const Frame& F) {
    const float* lnm = F.in[I_LNMOE]; const float* wrg = F.in[I_WRG]; const float* brg = F.in[I_BRG]; const float* wre = F.in[I_WRE]; const float* bre = F.in[I_BRE];
    float* rstd2 = (float*)(F.ws + WS_RSTD2); int* arow = (int*)(F.ws + WS_AROW); int* tokl = (int*)(F.ws + WS_TOKL); float* gatel = (float*)(F.ws + WS_GATEL);
    unsigned* cnt = (unsigned*)(F.ws + WS_CTL) + CW_CNT;
    const int gw = F.bid * NWAVES + F.wave, nw = F.G * NWAVES, lane = F.lane;
    for (int r = gw; r < NT; r += nw) {
        float h[32]; float ss = 0.f;
#pragma unroll
        for (int i = 0; i < 32; ++i) { h[i] = F.out[(size_t)r * DM + i * 64 + lane]; ss += h[i] * h[i]; }
        ss = wave_sum(ss);
        const float rs = rsqrtf(ss * (1.f / DM) + EPS);
        float lg[4] = {0.f, 0.f, 0.f, 0.f};
#pragma unroll
        for (int i = 0; i < 32; ++i) { const int k = i * 64 + lane; h[i] *= rs * lnm[k]; const float4 w = *(const float4*)(wrg + (size_t)k * 4);
            lg[0] += h[i] * w.x; lg[1] += h[i] * w.y; lg[2] += h[i] * w.z; lg[3] += h[i] * w.w; }
#pragma unroll
        for (int j = 0; j < 4; ++j) lg[j] = wave_sum(lg[j]) + brg[j];
        int gs = 0; float gm = lg[0];
#pragma unroll
        for (int j = 1; j < 4; ++j) if (lg[j] > gm) { gm = lg[j]; gs = j; }
        float den = 0.f;
#pragma unroll
        for (int j = 0; j < 4; ++j) den += __expf(lg[j] - gm);
        const float pg = 1.f / den;
        float le[8] = {0.f, 0.f, 0.f, 0.f, 0.f, 0.f, 0.f, 0.f};
#pragma unroll
        for (int i = 0; i < 32; ++i) { const int k = i * 64 + lane; const float* w = wre + ((size_t)gs * DM + k) * 8; const float4 w0 = *(const float4*)w, w1 = *(const float4*)(w + 4);
            const float hv = h[i];
            le[0] += hv * w0.x; le[1] += hv * w0.y; le[2] += hv * w0.z; le[3] += hv * w0.w; le[4] += hv * w1.x; le[5] += hv * w1.y; le[6] += hv * w1.z; le[7] += hv * w1.w; }
#pragma unroll
        for (int j = 0; j < 8; ++j) le[j] = wave_sum(le[j]) + bre[gs * 8 + j];
        int e0 = 0; float m0 = le[0];
#pragma unroll
        for (int j = 1; j < 8; ++j) if (le[j] > m0) { m0 = le[j]; e0 = j; }
        int e1 = -1; float m1 = -3.0e38f;
#pragma unroll
        for (int j = 0; j < 8; ++j) if (j != e0 && le[j] > m1) { m1 = le[j]; e1 = j; }
        const float p1 = __expf(m1 - m0);
        const float gate0 = pg / (1.f + p1), gate1 = pg * p1 / (1.f + p1);
        if (lane == 0) {
            rstd2[r] = rs;
            const int ea = gs * 8 + e0, eb = gs * 8 + e1;
            const unsigned sa = atomicAdd(&cnt[64 * ea], 1u), sb = atomicAdd(&cnt[64 * eb], 1u);
            tokl[ea * 8192 + sa] = r; gatel[ea * 8192 + sa] = gate0; tokl[eb * 8192 + sb] = r; gatel[eb * 8192 + sb] = gate1;
            arow[2 * r] = ea * 8192 + (int)sa; arow[2 * r + 1] = eb * 8192 + (int)sb;
        }
    }
}

__device__ __forceinline__ void moe_counts(const Frame& F, int* cnts  , int* pst  ) {
    const unsigned* cnt = (const unsigned*)(F.ws + WS_CTL) + CW_CNT;
    __syncthreads();
    if (F.tid < 32) cnts[F.tid] = (int)__hip_atomic_load(&cnt[64 * F.tid], __ATOMIC_RELAXED, __HIP_MEMORY_SCOPE_AGENT);
    __syncthreads();
    if (F.tid == 0) { int a = 0; for (int e = 0; e < 32; ++e) { pst[e] = a; a += (cnts[e] + 255) & ~255; } pst[32] = a; }
    __syncthreads();
}

constexpr int MOE_TAB_OFF = 1024 + 131072;
struct MoeTabs { int* cnts; int* pst; int* ust; int* rowtok; };
__device__ __forceinline__ MoeTabs moe_tabs(unsigned char* lds_raw) { MoeTabs T; T.cnts = (int*)(lds_raw + MOE_TAB_OFF); T.pst = T.cnts + 32; T.ust = T.pst + 40; T.rowtok = T.ust + 40; return T; }
template <int NTN> __device__ __forceinline__ void moe_units(const Frame& F, const MoeTabs& T) {
    moe_counts(F, T.cnts, T.pst);
    if (F.tid == 0) { int a = 0; for (int e = 0; e < 32; ++e) { T.ust[e] = a; a += ((T.cnts[e] + 255) >> 8) * NTN; } T.ust[32] = a; }
    __syncthreads();
}
template <int NTN, int LOGN> struct MoeOrder {
    const char* A; const char* Bt; const int* pst; const int* ust; const int* rowtok; int G, c, lda, ldb, brows;
    __device__ __forceinline__ bool next(int i, pg8::Unit& u) const {
        const int L = i * G + c; if (L >= ust[32]) return false;
        int e = 0; while (ust[e + 1] <= L) ++e;
        const int w = L - ust[e]; u.e = e; u.pm = w >> LOGN; u.pn = w & (NTN - 1); u.li = i; return true;
    }
    __device__ __forceinline__ const char* b_base(const pg8::Unit& u) const { return Bt + ((size_t)u.e * brows + (size_t)u.pn * 256) * ldb * 2; }
    __device__ __forceinline__ const char* a_base(const pg8::Unit& u) const { return rowtok ? A : A + (size_t)(pst[u.e] + u.pm * 256) * lda * 2; }
    __device__ __forceinline__ unsigned a_row_off(const pg8::Unit& u, int r) const {
        if (rowtok) { const int tk = rowtok[u.li * 256 + r]; return (unsigned)(tk < 0 ? 0 : tk) * (unsigned)lda * 2u; }
        return (unsigned)r * (unsigned)lda * 2u;
    }
};
struct EpiMoe1 {
    const int* cnts; const int* pst; const int* rowtok; const float* rstd2; bf16_t* act;
    __device__ __forceinline__ void operator()(const pg8::f32x4 (&acc)[2][2][4][2], const pg8::Unit& un, int wr, int wc, int fr, int fq) const {
#pragma unroll
        for (int ai = 0; ai < 2; ++ai)
#pragma unroll
            for (int m = 0; m < 4; ++m) {
                const int r = ai * 128 + wr * 64 + m * 16 + fr; const int tk = rowtok[un.li * 256 + r];
                if (tk >= 0) {
                    const float rs = rstd2[tk];
                    bf16_t* dst = act + (size_t)(pst[un.e] + un.pm * 256 + r) * FF + un.pn * 128 + wc * 32 + 4 * fq;
#pragma unroll
                    for (int n = 0; n < 2; ++n) {
                        const pg8::f32x4 vg = acc[ai][0][m][n] * rs, vu = acc[ai][1][m][n] * rs; float o[4];
#pragma unroll
                        for (int j = 0; j < 4; ++j) o[j] = vg[j] / (1.f + __expf(-vg[j])) * vu[j];
                        uint2 w; w.x = pg8::cvt_pk_bf16(o[0], o[1]); w.y = pg8::cvt_pk_bf16(o[2], o[3]); *(uint2*)(dst + 16 * n) = w;
                    }
                }
            }
    }
};
struct EpiMoe2 {
    const int* cnts; const int* pst; const float* gatel; bf16_t* y;
    __device__ __forceinline__ void operator()(const pg8::f32x4 (&acc)[2][2][4][2], const pg8::Unit& un, int wr, int wc, int fr, int fq) const {
#pragma unroll
        for (int ai = 0; ai < 2; ++ai)
#pragma unroll
            for (int m = 0; m < 4; ++m) {
                const int slot = un.pm * 256 + ai * 128 + wr * 64 + m * 16 + fr;
                if (slot < cnts[un.e]) {
                    const float gt = gatel[un.e * 8192 + slot];
                    bf16_t* dst = y + (size_t)(pst[un.e] + slot) * DM + un.pn * 256 + wc * 32 + 4 * fq;
#pragma unroll
                    for (int bj = 0; bj < 2; ++bj)
#pragma unroll
                        for (int n = 0; n < 2; ++n) { const pg8::f32x4 v = acc[ai][bj][m][n] * gt; uint2 w; w.x = pg8::cvt_pk_bf16(v[0], v[1]); w.y = pg8::cvt_pk_bf16(v[2], v[3]); *(uint2*)(dst + bj * 128 + n * 16) = w; }
                }
            }
    }
};

__device__ __forceinline__ void p9_moe1(const Frame& F, unsigned char* lds_raw, LAS unsigned char* stage) {
    const MoeTabs T = moe_tabs(lds_raw);
    moe_units<4>(F, T);
    MoeOrder<4, 2> S{(const char*)(F.ws + WS_X1B), (const char*)(F.ws + WS_W1T), T.pst, T.ust, T.rowtok, F.G, F.bid, DM, DM, 1024};
    { const int* tokl = (const int*)(F.ws + WS_TOKL); pg8::Unit u;
      for (int i = 0; i < 4 && S.next(i, u); ++i) { if (F.tid < 256) { const int slot = u.pm * 256 + F.tid; T.rowtok[i * 256 + F.tid] = slot < T.cnts[u.e] ? tokl[u.e * 8192 + slot] : -1; } } }
    asm volatile("s_waitcnt vmcnt(0) lgkmcnt(0)" ::: "memory");
    __syncthreads();
    EpiMoe1 E{T.cnts, T.pst, T.rowtok, (const float*)(F.ws + WS_RSTD2), (bf16_t*)(F.ws + WS_ACT)};
    pg8::gemm_phase<EpiMoe1, MoeOrder<4, 2>, true>(stage, DM, DM, DM, S, E);
}

__device__ __forceinline__ void p10_moe2(const Frame& F, unsigned char* lds_raw, LAS unsigned char* stage) {
    const MoeTabs T = moe_tabs(lds_raw);
    moe_units<8>(F, T);
    MoeOrder<8, 3> S{(const char*)(F.ws + WS_ACT), (const char*)(F.ws + WS_W2T), T.pst, T.ust, nullptr, F.G, F.bid, FF, FF, 2048};
    EpiMoe2 E{T.cnts, T.pst, (const float*)(F.ws + WS_GATEL), (bf16_t*)(F.ws + WS_Y)};
    pg8::gemm_phase<EpiMoe2, MoeOrder<8, 3>, false>(stage, FF, FF, FF, S, E);
}

__device__ __forceinline__ void p11_final(const Frame& F) {
    int* cnts = (int*)(F.lds + 3072); int* pst = cnts + 32;
    moe_counts(F, cnts, pst);
    const bf16_t* y = (const bf16_t*)(F.ws + WS_Y); const int* arow = (const int*)(F.ws + WS_AROW); const float* lnf = F.in[I_LNFINAL];
    const int gw = F.bid * NWAVES + F.wave, nw = F.G * NWAVES, lane = F.lane;
    for (int r = gw; r < NT; r += nw) {
        const int a0 = arow[2 * r], a1 = arow[2 * r + 1];
        const size_t r0 = (size_t)(pst[a0 >> 13] + (a0 & 8191)), r1 = (size_t)(pst[a1 >> 13] + (a1 & 8191));
        float v[32]; float ss = 0.f;
#pragma unroll
        for (int i = 0; i < 8; ++i) { const int c = i * 256 + lane * 4; const float4 xv = *(const float4*)(F.out + (size_t)r * DM + c);
            const uint2 ya = *(const uint2*)(y + r0 * DM + c), yb = *(const uint2*)(y + r1 * DM + c);
            v[4 * i]     = xv.x + __uint_as_float(ya.x << 16) + __uint_as_float(yb.x << 16);
            v[4 * i + 1] = xv.y + __uint_as_float(ya.x & 0xFFFF0000u) + __uint_as_float(yb.x & 0xFFFF0000u);
            v[4 * i + 2] = xv.z + __uint_as_float(ya.y << 16) + __uint_as_float(yb.y << 16);
            v[4 * i + 3] = xv.w + __uint_as_float(ya.y & 0xFFFF0000u) + __uint_as_float(yb.y & 0xFFFF0000u);
            ss += v[4 * i] * v[4 * i] + v[4 * i + 1] * v[4 * i + 1] + v[4 * i + 2] * v[4 * i + 2] + v[4 * i + 3] * v[4 * i + 3]; }
        ss = wave_sum(ss);
        const float rs = rsqrtf(ss * (1.f / DM) + EPS);
#pragma unroll
        for (int i = 0; i < 8; ++i) { const int c = i * 256 + lane * 4; const float4 g = *(const float4*)(lnf + c);
            float4 o; o.x = v[4 * i] * rs * g.x; o.y = v[4 * i + 1] * rs * g.y; o.z = v[4 * i + 2] * rs * g.z; o.w = v[4 * i + 3] * rs * g.w;
            *(float4*)(F.out + (size_t)r * DM + c) = o; }
    }
}

constexpr int NPHASE = 11;
__global__ void __launch_bounds__(NTHREADS, 2) fwd(Args args) {
    extern __shared__ __attribute__((aligned(16))) unsigned char lds_raw[];
    Frame F;
#pragma unroll
    for (int i = 0; i < N_IN; ++i) F.in[i] = args.in[i];
    F.out = args.out; F.ws = args.ws;
    F.lds = (float*)(lds_raw + 16);
    F.tid = threadIdx.x; F.lane = F.tid & 63; F.wave = __builtin_amdgcn_readfirstlane(F.tid >> 6); F.G = gridDim.x; F.bid = blockIdx.x;
    if (F.tid < 4) ((LAS unsigned*)lds_raw)[F.tid] = 0u;
    __syncthreads();
    XcdBarrier bar; bar.bar = (unsigned*)(F.ws + WS_CTL); bar.x = 0; bar.st = nullptr;
    if (N_LAUNCHES == 1) bar = xcd_barrier_post((unsigned*)(F.ws + WS_CTL), (volatile LAS unsigned*)lds_raw);
    const int lo = args.ph_lo, hi = args.ph_hi;
#ifndef ONLY_PHASE
#define ONLY_PHASE -1
#endif
#define IN(k) (lo <= (k) && (k) < hi && (ONLY_PHASE < 0 || ONLY_PHASE == (k)))
#define SEAM(k) do { if (IN(k) && IN((k) + 1)) xcd_barrier(bar); } while (0)
    LAS unsigned char* stage = (LAS unsigned char*)lds_raw + 1024;
#define RUN(k, ...) do { if (IN(k)) { __VA_ARGS__; if (PROBE_REPEAT == (k)) { xcd_barrier(bar); __VA_ARGS__; } } } while (0)
    RUN(0, p0_prologue(F));
    SEAM(0);
    RUN(1, p1_proj(F, stage));
    SEAM(1);
    RUN(2, p3_mid(F, stage));
    SEAM(2);
    RUN(3, p4_cmp2(F));
    SEAM(3);
    if (IN(4)) {
#pragma unroll 1
        for (int rep = 0; rep < (PROBE_REPEAT == 4 ? 2 : 1); ++rep) { if (rep) xcd_barrier(bar); p_attn(F, lds_raw, rep); } }
    SEAM(4);
    RUN(5, p6_mix(F));
    SEAM(5);
    RUN(6, p7_out(F, stage));
    SEAM(6);
    if (IN(7)) p8_router(F);
    SEAM(7);
    RUN(8, p9_moe1(F, lds_raw, stage));
    SEAM(8);
    RUN(9, p10_moe2(F, lds_raw, stage));
    SEAM(9);
    if (IN(10)) p11_final(F);
#undef RUN
#undef IN
#undef SEAM
}

extern "C" void kernel_launch(void* const* d_in, const int* in_sizes, int n_in, void* d_out, int out_size, void* d_ws, size_t ws_size, hipStream_t stream) {
    static int grid = 0;
    if (grid == 0) {
        if (n_in != N_IN || out_size != NT * DM || ws_size < WS_END) { fprintf(stderr, "kernel_launch: unexpected shapes: n_in %d out %d ws %zu (need %zu)\n", n_in, out_size, ws_size, (size_t)WS_END); grid = -1; return; }
        int dev = 0, cus = 0, per_cu = 0;
        if (hipGetDevice(&dev) != hipSuccess || hipDeviceGetAttribute(&cus, hipDeviceAttributeMultiprocessorCount, dev) != hipSuccess) { grid = -1; return; }
        if (hipFuncSetAttribute((const void*)fwd, hipFuncAttributeMaxDynamicSharedMemorySize, LDS_BYTES) != hipSuccess) { fprintf(stderr, "kernel_launch: hipFuncSetAttribute failed\n"); grid = -1; return; }
        if (hipOccupancyMaxActiveBlocksPerMultiprocessor(&per_cu, (const void*)fwd, NTHREADS, LDS_BYTES) != hipSuccess || per_cu < 1) { fprintf(stderr, "kernel_launch: occupancy query says %d\n", per_cu); }
        (void)hipGetLastError();
        grid = cus;
    }
    if (grid < 0) return;
    (void)in_sizes;
    (void)hipMemsetAsync((char*)d_ws + WS_CTL, 0, CTL_ZERO_BYTES, stream);
    Args a{};
    for (int i = 0; i < N_IN; ++i) a.in[i] = (const float*)d_in[i];
    a.out = (float*)d_out; a.ws = (unsigned char*)d_ws;
    if (N_LAUNCHES == 1) { a.ph_lo = 0; a.ph_hi = NPHASE; hipLaunchKernelGGL(fwd, dim3(grid), dim3(NTHREADS), LDS_BYTES, stream, a); }
    else { for (int p = 0; p < NPHASE; ++p) { a.ph_lo = p; a.ph_hi = p + 1; hipLaunchKernelGGL(fwd, dim3(grid), dim3(NTHREADS), LDS_BYTES, stream, a); } }
}
```

```cpp
#include <hip/hip_runtime.h>
#include <cstdio>
#include <cstdint>

#ifndef PROBE_REPEAT
#define PROBE_REPEAT -1
#endif
#ifndef N_LAUNCHES
#define N_LAUNCHES 1
#endif

#define XB_TMO      128
#define XB_XCNT(j)  (256  + 64 * (j))
#define XB_XSUB(j)  (1280 + 64 * (j))
#define XB_XGEN(j)  (2304 + 64 * (j))
#define XB_TOP      3328
#define XB_TOPGEN   3392
#define XCD_BAR_WORDS 3456
#define XB_SPIN_CAP (1u << 21)
#define LAS __attribute__((address_space(3)))

__device__ __forceinline__ unsigned xb_ld(unsigned* p)              { return __hip_atomic_load(p, __ATOMIC_RELAXED, __HIP_MEMORY_SCOPE_AGENT); }
__device__ __forceinline__ unsigned xb_add(unsigned* p, unsigned v) { return __hip_atomic_fetch_add(p, v, __ATOMIC_RELAXED, __HIP_MEMORY_SCOPE_AGENT); }
__device__ __forceinline__ unsigned xb_xcc_id() { return (unsigned)__builtin_amdgcn_s_getreg((3 << 11) | 20) & 0xFu; }
#define XB_SPIN(cond, bar) do { unsigned _sp = 0; while (cond) { __builtin_amdgcn_s_sleep(1); \
    if ((++_sp & 255u) == 0u) { if (xb_ld(&(bar)[XB_TMO])) break; if (_sp > XB_SPIN_CAP) { atomicAdd(&(bar)[XB_TMO], 1u); break; } } } } while (0)

struct XcdBarrier { unsigned* bar; unsigned x; volatile LAS unsigned* st; };

__device__ __forceinline__ XcdBarrier xcd_barrier_post(unsigned* bar, volatile LAS unsigned* st) {
    XcdBarrier b; b.bar = bar; b.x = xb_xcc_id(); b.st = st;
    if (threadIdx.x == 0) (void)xb_add(&bar[XB_XCNT(b.x)], 1u);
    return b;
}
__device__ __forceinline__ void xcd_barrier_complete(unsigned* bar, unsigned x, unsigned& nloc, unsigned& nx) {
    const unsigned G = gridDim.x * gridDim.y * gridDim.z;
    unsigned sum, cnt, mine, sp = 0u;
    for (;;) {
        sum = 0u; cnt = 0u; mine = 0u;
#pragma unroll
        for (unsigned j = 0; j < 16; ++j) { const unsigned c = xb_ld(&bar[XB_XCNT(j)]); sum += c; cnt += (c > 0u) ? 1u : 0u; mine = (j == x) ? c : mine; }
        if (sum == G) break;
        __builtin_amdgcn_s_sleep(1);
        if ((++sp & 255u) == 0u) { if (xb_ld(&bar[XB_TMO])) break; if (sp > XB_SPIN_CAP) { atomicAdd(&bar[XB_TMO], 1u); break; } }
    }
    nloc = mine > 0u ? mine : 1u; nx = cnt > 0u ? cnt : 1u;
}
__device__ __forceinline__ void xcd_barrier(const XcdBarrier& b) {
    asm volatile("s_waitcnt vmcnt(0)" ::: "memory");
    __syncthreads();
    if (threadIdx.x == 0) {
        unsigned* bar = b.bar;
        __builtin_amdgcn_s_waitcnt(0);
        unsigned nloc = b.st[0], nx = b.st[1];
        if (nloc == 0u) { xcd_barrier_complete(bar, b.x, nloc, nx); b.st[0] = nloc; b.st[1] = nx; }
        const unsigned old = xb_add(&bar[XB_XSUB(b.x)], 1u);
        const unsigned gen = old / nloc;
        if (old + 1u == (gen + 1u) * nloc) {
            __builtin_amdgcn_fence(__ATOMIC_RELEASE, "agent");
            asm volatile("s_waitcnt vmcnt(0)" ::: "memory");
            const unsigned og = xb_add(&bar[XB_TOP], 1u);
            const unsigned tg = og / nx;
            if (og + 1u == (tg + 1u) * nx) xb_add(&bar[XB_TOPGEN], 1u);
            else XB_SPIN(xb_ld(&bar[XB_TOPGEN]) == tg, bar);
            __builtin_amdgcn_fence(__ATOMIC_ACQUIRE, "agent");
            xb_add(&bar[XB_XGEN(b.x)], 1u);
            asm volatile("s_waitcnt vmcnt(0)" ::: "memory");
        } else {
            XB_SPIN(xb_ld(&bar[XB_XGEN(b.x)]) == gen, bar);
            __builtin_amdgcn_fence(__ATOMIC_ACQUIRE, "agent");
            asm volatile("s_waitcnt vmcnt(0)" ::: "memory");
        }
    }
    __syncthreads();
}

typedef unsigned short bf16_t;
constexpr int NB = 4, SEQ = 2048, DM = 2048, NT = NB * SEQ;
constexpr int NH = 8, NG = 2, HD = 128, INW = 3608, INWP = 3840;
constexpr int NCMP = 127, NSEL = 32, NEXP = 32, FF = 512;
constexpr float EPS = 1e-6f;
constexpr float SCALE = 0.08838834764831845f;
constexpr int NTHREADS = 512, NWAVES = 8;
constexpr int LDS_BYTES = 147456;
constexpr int YROWS = 24576;

enum { I_X = 0, I_POS, I_LNMIX, I_WIN, I_PEK, I_WK1, I_WK2, I_PEV, I_WV1, I_WV2, I_WPOOL, I_BPOOL, I_PSCALE, I_GNNSA, I_GNPOOL, I_WOUT, I_LNMOE,
       I_WRG, I_BRG, I_WRE, I_BRE, I_WGATE, I_WUP, I_WDOWN, I_LNFINAL, N_IN };

constexpr size_t MB = 1024 * 1024;
constexpr size_t WS_CTL   = 0;
constexpr size_t CTL_ZERO_BYTES = 65536;
constexpr int    CW_CNT   = 4096;
constexpr size_t WS_RSTD1 = 1 * MB;
constexpr size_t WS_RSTD2 = 1 * MB + 65536;
constexpr size_t WS_BIAS1 = 1 * MB + 131072;
constexpr size_t WS_AROW  = 1 * MB + 262144;
constexpr size_t WS_WR    = 1 * MB + 393216;
constexpr size_t WS_WG4   = 1 * MB + 655360;
constexpr size_t WS_ROPEC = 2 * MB;
constexpr size_t WS_ROPES = 2 * MB + 524288;
constexpr size_t WS_GATES = 3 * MB;
constexpr size_t WS_TOKL  = 4 * MB;
constexpr size_t WS_GATEL = 5 * MB;
constexpr size_t WS_HID   = 6 * MB;
constexpr size_t WS_CMPKV = 8 * MB;
constexpr size_t WS_WINT  = 9 * MB;
constexpr size_t WS_WOUTT = 24 * MB;
constexpr size_t WS_W1T   = 32 * MB;
constexpr size_t WS_W2T   = 160 * MB;
constexpr size_t WS_CMPW  = 224 * MB;
constexpr size_t WS_POOLW = 228 * MB;
constexpr size_t WS_POOLB = 228 * MB + 524288;
constexpr size_t WS_CPART = 447 * MB;
constexpr size_t WS_DBUF  = 463 * MB;
constexpr size_t WS_XB    = 230 * MB;
constexpr size_t WS_QN    = 262 * MB;
constexpr size_t WS_QR    = 278 * MB;
constexpr size_t WS_KV    = 294 * MB;
constexpr size_t WS_U     = 319 * MB;
constexpr size_t WS_Y     = 230 * MB;
constexpr size_t WS_OWIN  = 351 * MB;
constexpr size_t WS_OCMP  = 367 * MB;
constexpr size_t WS_OSEL  = 319 * MB;
constexpr size_t WS_ML    = 6 * MB;
constexpr size_t WS_X1B   = 351 * MB;
constexpr size_t WS_OPOOL = 383 * MB;
constexpr size_t WS_ACT   = 383 * MB;
constexpr size_t WS_MIX   = 415 * MB;
constexpr size_t WS_END   = 479 * MB;

__device__ __forceinline__ bf16_t f2bf(float f) { unsigned u = __float_as_uint(f); u += 0x7FFFu + ((u >> 16) & 1u); return (bf16_t)(u >> 16); }
__device__ __forceinline__ float bf2f(bf16_t b) { return __uint_as_float(((unsigned)b) << 16); }
__device__ __forceinline__ float wave_sum(float v) {
#pragma unroll
    for (int o = 32; o >= 1; o >>= 1) v += __shfl_xor(v, o);
    return v;
}
__device__ __forceinline__ float wave_max(float v) {
#pragma unroll
    for (int o = 32; o >= 1; o >>= 1) v = fmaxf(v, __shfl_xor(v, o));
    return v;
}

struct Args { const float* in[N_IN]; float* out; unsigned char* ws; int ph_lo, ph_hi; };

struct Frame {
    const float* in[N_IN]; float* out; unsigned char* ws;
    float* lds;
    int tid, lane, wave, G, bid;
};

template <int NACC, bool B_KFAST, class FA, class FB, class FE>
__device__ __forceinline__ void ngemm_tile(const Frame& F, int K, FA fa, FB fb, FE fe) {
    float* As = F.lds;
    float* Bs = F.lds + 1024;
    const int tid = F.tid, ty = tid >> 4, tx = tid & 15;
    float acc[NACC][2][4];
#pragma unroll
    for (int w = 0; w < NACC; ++w)
#pragma unroll
        for (int i = 0; i < 2; ++i)
#pragma unroll
            for (int j = 0; j < 4; ++j) acc[w][i][j] = 0.f;
    for (int k0 = 0; k0 < K; k0 += 16) {
#pragma unroll
        for (int i = 0; i < 2; ++i) { const int idx = tid + 512 * i, m = idx >> 4, kk = idx & 15; As[kk * 64 + m] = fa(m, k0 + kk); }
#pragma unroll
        for (int w = 0; w < NACC; ++w)
#pragma unroll
            for (int i = 0; i < 2; ++i) { const int idx = tid + 512 * i; int kk, n; if (B_KFAST) { n = idx >> 4; kk = idx & 15; } else { kk = idx >> 6; n = idx & 63; }
                Bs[w * 1024 + kk * 64 + n] = fb(w, k0 + kk, n); }
        __syncthreads();
#pragma unroll
        for (int kk = 0; kk < 16; ++kk) {
            const float a0 = As[kk * 64 + 2 * ty], a1 = As[kk * 64 + 2 * ty + 1];
#pragma unroll
            for (int w = 0; w < NACC; ++w) {
                const float4 b = *(const float4*)&Bs[w * 1024 + kk * 64 + 4 * tx];
                acc[w][0][0] += a0 * b.x; acc[w][0][1] += a0 * b.y; acc[w][0][2] += a0 * b.z; acc[w][0][3] += a0 * b.w;
                acc[w][1][0] += a1 * b.x; acc[w][1][1] += a1 * b.y; acc[w][1][2] += a1 * b.z; acc[w][1][3] += a1 * b.w;
            }
        }
        __syncthreads();
    }
#pragma unroll
    for (int i = 0; i < 2; ++i)
#pragma unroll
        for (int j = 0; j < 4; ++j) fe(2 * ty + i, 4 * tx + j, acc[0][i][j], acc[NACC - 1][i][j]);
}

template <class KR>
__device__ __forceinline__ void nattn(const float* qv, float* sc, int nkeys, KR keyrow, const bf16_t* Kb, const bf16_t* Vb, int lane, float& o0, float& o1, float& inv_sum) {
    float mx = -3.0e38f;
    for (int i = lane; i < nkeys; i += 64) {
        const int kr = keyrow(i);
        float s = -3.0e38f;
        if (kr >= 0) {
            const bf16_t* kp = Kb + (size_t)kr * HD;
            float a = 0.f;
#pragma unroll 8
            for (int d = 0; d < HD; d += 2) { const unsigned w = *(const unsigned*)(kp + d); a += qv[d] * __uint_as_float(w << 16) + qv[d + 1] * __uint_as_float(w & 0xFFFF0000u); }
            s = a * SCALE;
        }
        sc[i] = s; mx = fmaxf(mx, s);
    }
    mx = wave_max(mx);
    if (mx < -1.0e38f) { o0 = 0.f; o1 = 0.f; inv_sum = 0.f; for (int i = lane; i < nkeys; i += 64) sc[i] = 0.f; return; }
    float sum = 0.f;
    for (int i = lane; i < nkeys; i += 64) { const float s = sc[i]; const float e = (s < -1.0e38f) ? 0.f : __expf(s - mx); sc[i] = e; sum += e; }
    sum = wave_sum(sum);
    inv_sum = 1.f / sum;
    float a0 = 0.f, a1 = 0.f;
    for (int i = 0; i < nkeys; ++i) {
        const float p = sc[i];
        if (p != 0.f) { const int kr = keyrow(i); const bf16_t* vp = Vb + (size_t)kr * HD; a0 += p * bf2f(vp[lane]); a1 += p * bf2f(vp[lane + 64]); }
    }
    o0 = a0 * inv_sum; o1 = a1 * inv_sum;
}

__device__ __forceinline__ float gelu_tanh(float x) { const float u = 0.7978845608028654f * (x + 0.044715f * x * x * x); return 0.5f * x * (1.f + tanhf(u)); }


namespace pg8 {
typedef short bf16x8 __attribute__((ext_vector_type(8)));
typedef float f32x4 __attribute__((ext_vector_type(4)));
typedef unsigned u32x4 __attribute__((ext_vector_type(4)));
constexpr int BM = 256, BK = 64, HALF = 128, HTB = HALF * BK * 2, STAGE_BYTES = 8 * HTB, NXCD = 8, WGM = 8;
__device__ __forceinline__ int lds_byte(int r, int c) { const int st = (r >> 4) * 2 + (c >> 5), rr = r & 15, cc = c & 31, ob = rr * 64 + cc * 2; return st * 1024 + (ob ^ (((ob >> 9) & 1) << 5)); }
__device__ __forceinline__ void stage_rc(int b, int& R, int& C) { const int st = b / 1024, sb = b % 1024, swz = sb ^ (((sb >> 9) & 1) << 5); R = (st >> 1) * 16 + swz / 64; C = (st & 1) * 32 + (swz % 64) / 2; }
struct Unit { int pm, pn, e, li; };
__device__ __forceinline__ unsigned cvt_pk_bf16(float lo, float hi) { unsigned r; asm volatile("v_cvt_pk_bf16_f32 %0, %1, %2" : "=v"(r) : "v"(lo), "v"(hi)); return r; }

struct DenseOrder {
    const char* A; const char* Bt; int lda, ldb; int nM, nN, nwg, G, c;
    __device__ void init(const void* A_, const void* Bt_, int lda_, int ldb_, int M, int N, int G_, int c_) { A = (const char*)A_; Bt = (const char*)Bt_; lda = lda_; ldb = ldb_; nM = M / BM; nN = N / BM; nwg = nM * nN; G = G_; c = c_; }
    __device__ __forceinline__ bool next(int i, Unit& u) const {
        const long L = (long)i * G + c; if (L >= nwg) return false;
        int wgid = (int)L; { const int q = nwg / NXCD, r = nwg % NXCD, xcd = wgid % NXCD, off = wgid / NXCD; wgid = (xcd < r ? xcd * (q + 1) : r * (q + 1) + (xcd - r) * q) + off; }
        const int nig = WGM * nN, gid = wgid / nig, fm = gid * WGM, gsz = (nM - fm) < WGM ? (nM - fm) : WGM;
        u.pm = fm + ((wgid % nig) % gsz); u.pn = (wgid % nig) / gsz; u.e = 0; u.li = i; return true;
    }
    __device__ __forceinline__ const char* a_base(const Unit& u) const { return A + (size_t)u.pm * BM * lda * 2; }
    __device__ __forceinline__ const char* b_base(const Unit& u) const { return Bt + (size_t)u.pn * BM * ldb * 2; }
    __device__ __forceinline__ unsigned a_row_off(const Unit&, int r) const { return (unsigned)r * (unsigned)lda * 2u; }
};

template <class Epi, class Sched, bool GATHER>
__device__ __forceinline__ void gemm_phase(LAS unsigned char* lds, const int K, const int lda, const int ldb, const Sched& S, const Epi& E) {
    const int tid = threadIdx.x, wid = __builtin_amdgcn_readfirstlane(tid >> 6), lane = tid & 63, wr = wid >> 2, wc = wid & 3, fr = lane & 15, fq = lane >> 4;
    const int nt = K / BK;
    int sR[2], sC[2];
#pragma unroll
    for (int i = 0; i < 2; ++i) stage_rc(tid * 16 + i * 8192, sR[i], sC[i]);
    unsigned voffB[2], voffA[2][2], nvoffA[2][2];
#pragma unroll
    for (int i = 0; i < 2; ++i) voffB[i] = (unsigned)(sR[i] * ldb + sC[i]) * 2u;
    const size_t kstep = (size_t)(BK * 2);
    const size_t hstepB = (size_t)HALF * ldb * 2;
    const unsigned ldsw = (unsigned)wid * 1024u;
    const int aoff = lds_byte(wr * 64 + fr, fq * 8), boff = lds_byte(wc * 32 + fr, fq * 8);
#define PG8_SA(b, h) (((b) * 2 + (h)) * HTB)
#define PG8_SB(b, h) ((4 + (b) * 2 + (h)) * HTB)
#define PG8_STAGE(bufoff, gbase, voff) do { _Pragma("unroll") for (int _i = 0; _i < 2; ++_i) \
        __builtin_amdgcn_global_load_lds((const unsigned*)((const char*)(gbase) + (voff)[_i]), (LAS unsigned*)(lds + (bufoff) + ldsw + _i * 8192), 16, 0, 0); } while (0)
#define PG8_LDA(dst, b, h) do { _Pragma("unroll") for (int m = 0; m < 4; ++m) _Pragma("unroll") for (int k = 0; k < 2; ++k) dst[m][k] = *(const LAS bf16x8*)(lds + PG8_SA(b, h) + aoff + m * 2048 + k * 1024); } while (0)
#define PG8_LDB(dst, b, h) do { _Pragma("unroll") for (int n = 0; n < 2; ++n) _Pragma("unroll") for (int k = 0; k < 2; ++k) dst[n][k] = *(const LAS bf16x8*)(lds + PG8_SB(b, h) + boff + n * 2048 + k * 1024); } while (0)
#define PG8_MMA(ai, bj, At, Bt) do { __builtin_amdgcn_s_setprio(1); _Pragma("unroll") for (int m = 0; m < 4; ++m) _Pragma("unroll") for (int n = 0; n < 2; ++n) _Pragma("unroll") for (int k = 0; k < 2; ++k) \
        acc[ai][bj][m][n] = __builtin_amdgcn_mfma_f32_16x16x32_bf16(Bt[n][k], At[m][k], acc[ai][bj][m][n], 0, 0, 0); __builtin_amdgcn_s_setprio(0); } while (0)
#define PG8_WAIT_V(n) asm volatile("s_waitcnt vmcnt(" #n ")" ::: "memory")
#define PG8_WAIT_L(n) asm volatile("s_waitcnt lgkmcnt(" #n ")" ::: "memory")
#define PG8_BAR __builtin_amdgcn_s_barrier()
#define PG8_SCHED __builtin_amdgcn_sched_barrier(0)
#define PG8_AOFFS(dst, u) do { _Pragma("unroll") for (int _h = 0; _h < 2; ++_h) _Pragma("unroll") for (int _i = 0; _i < 2; ++_i) dst[_h][_i] = S.a_row_off(u, _h * HALF + sR[_i]) + (unsigned)sC[_i] * 2u; } while (0)
    Unit cur, nxt; int ui = 0;
    if (!S.next(0, cur)) return;
    f32x4 acc[2][2][4][2];
#pragma unroll
    for (int a = 0; a < 2; ++a)
#pragma unroll
        for (int b = 0; b < 2; ++b)
#pragma unroll
            for (int m = 0; m < 4; ++m)
#pragma unroll
                for (int n = 0; n < 2; ++n) acc[a][b][m][n] = (f32x4){0.f, 0.f, 0.f, 0.f};
    bf16x8 At[4][2], B0[2][2], B1[2][2];
    const char* cA = S.a_base(cur); const char* cB = S.b_base(cur);
    PG8_AOFFS(voffA, cur);
    PG8_STAGE(PG8_SB(0, 0), cB, voffB); PG8_STAGE(PG8_SA(0, 0), cA, voffA[0]); PG8_STAGE(PG8_SB(0, 1), cB + hstepB, voffB); PG8_STAGE(PG8_SA(0, 1), cA, voffA[1]);
    if (wr == 1) PG8_BAR;
    PG8_WAIT_V(4); PG8_BAR;
    PG8_STAGE(PG8_SB(1, 0), cB + kstep, voffB); PG8_STAGE(PG8_SA(1, 0), cA + kstep, voffA[0]); PG8_STAGE(PG8_SB(1, 1), cB + hstepB + kstep, voffB);
    PG8_WAIT_V(6); PG8_BAR;
    for (;;) {
        const bool has_next = S.next(ui + 1, nxt);
        const char* nA = has_next ? S.a_base(nxt) : cA; const char* nB = has_next ? S.b_base(nxt) : cB;
        if (GATHER) { if (has_next) { PG8_AOFFS(nvoffA, nxt); } else {
#pragma unroll
            for (int _h = 0; _h < 2; ++_h)
#pragma unroll
                for (int _i = 0; _i < 2; ++_i) nvoffA[_h][_i] = voffA[_h][_i]; } }
        for (int t = 0; t < nt; t += 2) {
            const bool last = (t == nt - 2);
            const char* a1 = cA + (size_t)(t + 1) * kstep;
            const char* a2 = last ? nA : cA + (size_t)(t + 2) * kstep; const char* b2 = last ? nB : cB + (size_t)(t + 2) * kstep;
            const char* a3 = a2 + kstep; const char* b3 = b2 + kstep;
            unsigned vA2[2][2];
#pragma unroll
            for (int _h = 0; _h < 2; ++_h)
#pragma unroll
                for (int _i = 0; _i < 2; ++_i) vA2[_h][_i] = (GATHER && last) ? nvoffA[_h][_i] : voffA[_h][_i];
            PG8_LDB(B0, 0, 0); PG8_SCHED; PG8_LDA(At, 0, 0); PG8_STAGE(PG8_SA(1, 1), a1, voffA[1]);
            PG8_WAIT_L(8); PG8_BAR; PG8_WAIT_L(0); PG8_MMA(0, 0, At, B0); PG8_BAR; PG8_SCHED;
            PG8_LDB(B1, 0, 1); PG8_STAGE(PG8_SB(0, 0), b2, voffB);
            PG8_BAR; PG8_WAIT_L(0); PG8_MMA(0, 1, At, B1); PG8_BAR;
            PG8_LDA(At, 0, 1); PG8_STAGE(PG8_SA(0, 0), a2, vA2[0]);
            PG8_BAR; PG8_WAIT_L(0); PG8_MMA(1, 0, At, B0); PG8_BAR; PG8_SCHED;
            PG8_STAGE(PG8_SB(0, 1), b2 + hstepB, voffB);
            PG8_WAIT_V(6); PG8_BAR; PG8_MMA(1, 1, At, B1); PG8_BAR;
            PG8_LDB(B0, 1, 0); PG8_SCHED; PG8_LDA(At, 1, 0); PG8_STAGE(PG8_SA(0, 1), a2, vA2[1]);
            PG8_WAIT_L(8); PG8_BAR; PG8_WAIT_L(0); PG8_MMA(0, 0, At, B0); PG8_BAR; PG8_SCHED;
            PG8_LDB(B1, 1, 1); PG8_STAGE(PG8_SB(1, 0), b3, voffB);
            PG8_BAR; PG8_WAIT_L(0); PG8_MMA(0, 1, At, B1); PG8_BAR;
            PG8_LDA(At, 1, 1); PG8_STAGE(PG8_SA(1, 0), a3, vA2[0]);
            PG8_BAR; PG8_WAIT_L(0); PG8_MMA(1, 0, At, B0); PG8_BAR; PG8_SCHED;
            PG8_STAGE(PG8_SB(1, 1), b3 + hstepB, voffB);
            PG8_WAIT_V(6); PG8_BAR; PG8_MMA(1, 1, At, B1); PG8_BAR;
        }
        E(acc, cur, wr, wc, fr, fq);
        if (!has_next) break;
#pragma unroll
        for (int a = 0; a < 2; ++a)
#pragma unroll
            for (int b = 0; b < 2; ++b)
#pragma unroll
                for (int m = 0; m < 4; ++m)
#pragma unroll
                    for (int n = 0; n < 2; ++n) acc[a][b][m][n] = (f32x4){0.f, 0.f, 0.f, 0.f};
        cur = nxt; cA = nA; cB = nB; ++ui;
        if (GATHER) {
#pragma unroll
            for (int _h = 0; _h < 2; ++_h)
#pragma unroll
                for (int _i = 0; _i < 2; ++_i) voffA[_h][_i] = nvoffA[_h][_i]; }
    }
    PG8_WAIT_V(0);
    if (wr == 0) PG8_BAR;
    PG8_BAR;
#undef PG8_SA
#undef PG8_SB
#undef PG8_STAGE
#undef PG8_LDA
#undef PG8_LDB
#undef PG8_MMA
#undef PG8_WAIT_V
#undef PG8_WAIT_L
#undef PG8_BAR
#undef PG8_SCHED
#undef PG8_AOFFS
}
}

__device__ __forceinline__ void transpose_tile(const Frame& F, const float* src, int lds_, bf16_t* dstrow0, int ldd, int k0, int n0, const float* kscale) {
    float* T = F.lds;
    const int tid = F.tid, kk = tid >> 4, n4 = (tid & 15) * 4;
#pragma unroll
    for (int i = 0; i < 2; ++i) { const int k = kk + 32 * i; float4 v = *(const float4*)(src + (size_t)(k0 + k) * lds_ + n0 + n4); const float sc = kscale ? kscale[k0 + k] : 1.f;
        T[(n4 + 0) * 65 + k] = v.x * sc; T[(n4 + 1) * 65 + k] = v.y * sc; T[(n4 + 2) * 65 + k] = v.z * sc; T[(n4 + 3) * 65 + k] = v.w * sc; }
    __syncthreads();
    { const int n = tid >> 3, k8 = (tid & 7) * 8; const float* t = T + n * 65 + k8;
      pg8::u32x4 w; w.x = pg8::cvt_pk_bf16(t[0], t[1]); w.y = pg8::cvt_pk_bf16(t[2], t[3]); w.z = pg8::cvt_pk_bf16(t[4], t[5]); w.w = pg8::cvt_pk_bf16(t[6], t[7]);
      *(pg8::u32x4*)(dstrow0 + (size_t)n * ldd + k0 + k8) = w; }
    __syncthreads();
}


namespace att {
typedef short bf16x8 __attribute__((ext_vector_type(8)));
typedef short s16x4 __attribute__((ext_vector_type(4)));
typedef float f32x16 __attribute__((ext_vector_type(16)));
typedef float f32x4 __attribute__((ext_vector_type(4)));
typedef unsigned u32x4 __attribute__((ext_vector_type(4)));
constexpr int SHM = 16384;
constexpr int L_V = 0, L_K = 2 * SHM, L_WS = 4 * SHM, L_PART = L_WS + 8 * 64 * 4, L_SELM = L_PART + 4 * 64 * 33 * 4, L_VALS = L_SELM + 256, L_ITEM = L_VALS + 8 * 64 * 4, L_END = L_ITEM + 16;
constexpr float C2 = 1.4426950408889634f * SCALE;
#define KSWZ(row, colB) ((row) * 256 + ((colB) ^ (((row) & 7) << 4)))
#define SBAR() __builtin_amdgcn_sched_barrier(0)
__device__ __forceinline__ int v_st(int k, int c) { const int kk = (k & ~0xC) | ((k & 4) << 1) | ((k & 8) >> 1); return ((kk >> 3) * 4 + (c >> 5)) * 512 + ((kk & 7) * 32 + (c & 31)) * 2; }
__device__ __forceinline__ int v_rd_base(int lane) { return ((lane & 3) << 3) | (((lane >> 2) & 3) << 6) | (((lane >> 4) & 1) << 5) | (((lane >> 5) & 1) << 8); }
constexpr int v_rd_off(int d0, int ks, int half) { return d0 * 512 + ks * 4096 + half * 2048; }
__device__ __forceinline__ int crow(int r, int hi) { return (r & 3) + 8 * (r >> 2) + 4 * hi; }
__device__ __forceinline__ unsigned cvtpk(float lo, float hi) { unsigned r; asm volatile("v_cvt_pk_bf16_f32 %0, %1, %2" : "=v"(r) : "v"(lo), "v"(hi)); return r; }
__device__ __forceinline__ float swap_max(float v) { auto rr = __builtin_amdgcn_permlane32_swap(__float_as_uint(v), __float_as_uint(v), false, false); return fmaxf(__uint_as_float(rr[0]), __uint_as_float(rr[1])); }
__device__ __forceinline__ float swap_sum(float v) { auto rr = __builtin_amdgcn_permlane32_swap(__float_as_uint(v), __float_as_uint(v), false, false); return __uint_as_float(rr[0]) + __uint_as_float(rr[1]); }

struct WV { int tid, wid, lane, r32, hi, vb0; unsigned ksrc[2], vsrc[2]; char* lds; LAS unsigned char* ldsL; };
__device__ __forceinline__ void wv_src_init(WV& w) {
#pragma unroll
    for (int i = 0; i < 2; ++i) {
        const int L = (w.wid * 2 + i) * 1024 + w.lane * 16;
        { const int row = L >> 8, colB = (L & 255) ^ ((row & 7) << 4); w.ksrc[i] = (unsigned)(row * 256 + colB); }
        { const int sub = L >> 9, kkhi = sub >> 2, cblk = sub & 3, within = L & 511, kklo = within >> 6, cc = (within >> 1) & 31;
          const int kk = kkhi * 8 + kklo, k = (kk & ~0xC) | ((kk & 4) << 1) | ((kk & 8) >> 1), c = cblk * 32 + cc; w.vsrc[i] = (unsigned)(k * 256 + c * 2); }
    }
}
__device__ __forceinline__ void dma_tile(const WV& w, const bf16_t* Kt, const bf16_t* Vt, int buf) {
    int ln = w.lane; asm volatile("" : "+v"(ln));
#pragma unroll
    for (int i = 0; i < 2; ++i) {
        const int L = (w.wid * 2 + i) * 1024 + ln * 16;
        const int row = L >> 8, colB = (L & 255) ^ ((row & 7) << 4); const unsigned ksrc = (unsigned)(row * 256 + colB);
        const int sub = L >> 9, kkhi = sub >> 2, cblk = sub & 3, within = L & 511, kklo = within >> 6, cc = (within >> 1) & 31;
        const int kk = kkhi * 8 + kklo, k = (kk & ~0xC) | ((kk & 4) << 1) | ((kk & 8) >> 1), c = cblk * 32 + cc; const unsigned vsrc = (unsigned)(k * 256 + c * 2);
        __builtin_amdgcn_global_load_lds((const unsigned*)((const char*)Vt + vsrc), (LAS unsigned*)(w.ldsL + L_V + buf * SHM + (w.wid * 2 + i) * 1024), 16, 0, 0);
        __builtin_amdgcn_global_load_lds((const unsigned*)((const char*)Kt + ksrc), (LAS unsigned*)(w.ldsL + L_K + buf * SHM + (w.wid * 2 + i) * 1024), 16, 0, 0);
    }
}
__device__ __forceinline__ void qkt(const WV& w, int buf, const bf16x8 (&qr)[8], f32x16& p0, f32x16& p1) {
    p0 = f32x16{}; p1 = f32x16{};
    const char* kb[4];
#pragma unroll
    for (int dd = 0; dd < 4; ++dd) kb[dd] = w.lds + L_K + buf * SHM + KSWZ(w.r32, (dd * 16 + w.hi * 8) * 2);
#pragma unroll
    for (int d0 = 0; d0 < 8; ++d0) { const char* a = kb[d0 & 3] + (d0 >> 2) * 128;
        const bf16x8 b0 = *reinterpret_cast<const bf16x8*>(a); const bf16x8 b1 = *reinterpret_cast<const bf16x8*>(a + 32 * 256);
        p0 = __builtin_amdgcn_mfma_f32_32x32x16_bf16(b0, qr[d0], p0, 0, 0, 0);
        p1 = __builtin_amdgcn_mfma_f32_32x32x16_bf16(b1, qr[d0], p1, 0, 0, 0);
        if (d0 == 3) SBAR(); }
}
__device__ __forceinline__ void pack_p(const f32x16& p0, const f32x16& p1, bf16x8& pa0, bf16x8& pa1, bf16x8& pa2, bf16x8& pa3) {
#define PK4(P, B_, OUT) do { unsigned a0 = cvtpk(P[B_+0], P[B_+1]), a1 = cvtpk(P[B_+2], P[B_+3]); unsigned b0 = cvtpk(P[B_+4], P[B_+5]), b1 = cvtpk(P[B_+6], P[B_+7]); \
        auto r0 = __builtin_amdgcn_permlane32_swap(a0, b0, false, false); auto r1 = __builtin_amdgcn_permlane32_swap(a1, b1, false, false); \
        u32x4 w_ = {r0[0], r1[0], r0[1], r1[1]}; OUT = *reinterpret_cast<bf16x8*>(&w_); } while (0)
    PK4(p0, 0, pa0); PK4(p0, 8, pa1); PK4(p1, 0, pa2); PK4(p1, 8, pa3);
#undef PK4
}
template <int VB>
__device__ __forceinline__ void pv_tile(f32x16* o, int vb0, bf16x8 pa0, bf16x8 pa1, bf16x8 pa2, bf16x8 pa3) {
#define TRRD(dst, off) asm volatile("ds_read_b64_tr_b16 %0, %1 offset:%2" : "=&v"(dst) : "v"(vb0), "i"(off) : "memory")
#define PV_D0(d0) do { s16x4 l0, l1, l2, l3, h0, h1, h2, h3; constexpr int b_ = L_V + VB * SHM + v_rd_off(d0, 0, 0); \
        TRRD(l0, b_); TRRD(h0, b_ + 2048); TRRD(l1, b_ + 4096); TRRD(h1, b_ + 6144); TRRD(l2, b_ + 8192); TRRD(h2, b_ + 10240); TRRD(l3, b_ + 12288); TRRD(h3, b_ + 14336); \
        asm volatile("s_waitcnt lgkmcnt(0)" ::: "memory"); SBAR(); \
        o[d0] = __builtin_amdgcn_mfma_f32_32x32x16_bf16(pa0, (bf16x8){l0[0], l0[1], l0[2], l0[3], h0[0], h0[1], h0[2], h0[3]}, o[d0], 0, 0, 0); \
        o[d0] = __builtin_amdgcn_mfma_f32_32x32x16_bf16(pa1, (bf16x8){l1[0], l1[1], l1[2], l1[3], h1[0], h1[1], h1[2], h1[3]}, o[d0], 0, 0, 0); \
        o[d0] = __builtin_amdgcn_mfma_f32_32x32x16_bf16(pa2, (bf16x8){l2[0], l2[1], l2[2], l2[3], h2[0], h2[1], h2[2], h2[3]}, o[d0], 0, 0, 0); \
        o[d0] = __builtin_amdgcn_mfma_f32_32x32x16_bf16(pa3, (bf16x8){l3[0], l3[1], l3[2], l3[3], h3[0], h3[1], h3[2], h3[3]}, o[d0], 0, 0, 0); } while (0)
    PV_D0(0); PV_D0(1); PV_D0(2); PV_D0(3);
#undef PV_D0
#undef TRRD
}
__device__ __forceinline__ void store_o(const WV& w, const f32x16* o, const float* tab, bf16_t* outp) {
    bf16_t* lp = outp + (size_t)w.hi * 4096 + w.r32;
#pragma unroll
    for (int r = 0; r < 16; ++r) { const int q = crow(r, w.hi); const float sc = tab[q];
        bf16_t* p = lp; asm volatile("" : "+v"(p));
        p += ((r & 3) + 8 * (r >> 2)) * 1024;
#pragma unroll
        for (int d0 = 0; d0 < 4; ++d0) { const float v = o[d0][r] * sc; const float vn = __shfl_xor(v, 1);
            if ((w.r32 & 1) == 0) *(__attribute__((address_space(1))) unsigned*)(p + d0 * 32) = cvtpk(v, vn); } }
}

template <int MODE>
__device__ __forceinline__ void flash_pass(const WV& w, const bf16_t* Kp, const bf16_t* Vp, int j_lo, int j_hi, const bf16x8 (&qr)[8], int tpos, int tw0, unsigned selmask,
                                           f32x16 (&o)[4], float& m_reg, float& l_reg) {
    float* al_l = (float*)(w.lds + L_WS) + w.wid * 64;
    dma_tile(w, Kp + (size_t)j_lo * 64 * HD, Vp + (size_t)j_lo * 64 * HD, 0);
#define FSTEP(BUF, jj) do { const int jt = (jj);                                                                                  \
        asm volatile("s_waitcnt vmcnt(0)" ::: "memory");                                                                         \
        __syncthreads();                                                                                                         \
        if (jt + 1 < j_hi) dma_tile(w, Kp + (size_t)(jt + 1) * 64 * HD, Vp + (size_t)(jt + 1) * 64 * HD, (BUF) ^ 1);                 \
        f32x16 p0, p1;                                                                                                           \
        qkt(w, BUF, qr, p0, p1);                                                                                                 \
        const int kb = jt * 64;                                                                                                  \
        { const float NEG = -__builtin_inff();                                                                                   \
          const bool need = (kb + 63 > tw0) || (MODE == 1 && kb <= tw0 + 31 - 512);                                              \
          if (need) { const int dq = tpos - kb - 4 * w.hi; const unsigned W = (MODE == 1) ? 512u : 0x7fffffffu;                  \
              _Pragma("unroll") for (int r = 0; r < 16; ++r) { const int c = (r & 3) + 8 * (r >> 2); if ((unsigned)(dq - c) >= W) p0[r] = NEG; if ((unsigned)(dq - c - 32) >= W) p1[r] = NEG; } } \
          if (MODE == 0) { const bool sel = (selmask >> jt) & 1u;                                                                 \
              if (!__all(sel)) { _Pragma("unroll") for (int r = 0; r < 16; ++r) { p0[r] = sel ? p0[r] : NEG; p1[r] = sel ? p1[r] : NEG; } } } } \
        float pmax = p0[0];                                                                                                      \
        _Pragma("unroll") for (int r = 1; r < 16; ++r) pmax = fmaxf(pmax, p0[r]);                                                \
        _Pragma("unroll") for (int r = 0; r < 16; ++r) pmax = fmaxf(pmax, p1[r]);                                                \
        pmax = swap_max(pmax);                                                                                                   \
        const float mn = fmaxf(m_reg, pmax);                                                                                     \
        const float alpha = __builtin_amdgcn_exp2f((m_reg - mn) * C2);                                                           \
        m_reg = mn;                                                                                                              \
        const float mnL = -mn * C2;                                                                                              \
        float ps = 0.f;                                                                                                          \
        _Pragma("unroll") for (int r = 0; r < 16; ++r) { p0[r] = __builtin_amdgcn_exp2f(fmaf(p0[r], C2, mnL)); ps += p0[r]; }    \
        _Pragma("unroll") for (int r = 0; r < 16; ++r) { p1[r] = __builtin_amdgcn_exp2f(fmaf(p1[r], C2, mnL)); ps += p1[r]; }    \
        ps = swap_sum(ps);                                                                                                       \
        l_reg = l_reg * alpha + ps;                                                                                              \
        if (w.hi == 0) al_l[w.r32] = alpha;                                                                                      \
        asm volatile("s_waitcnt lgkmcnt(0)" ::: "memory");                                                                       \
        _Pragma("unroll") for (int r = 0; r < 16; ++r) { const float a = al_l[crow(r, w.hi)];                                    \
            _Pragma("unroll") for (int d = 0; d < 4; ++d) o[d][r] *= a; }                                                        \
        bf16x8 pa0, pa1, pa2, pa3;                                                                                               \
        pack_p(p0, p1, pa0, pa1, pa2, pa3);                                                                                      \
        pv_tile<BUF>(o, w.vb0, pa0, pa1, pa2, pa3);                                                                              \
    } while (0)
    int j = j_lo;
    for (; j + 1 < j_hi; j += 2) { FSTEP(0, j); FSTEP(1, j + 1); }
    if (j < j_hi) FSTEP(0, j);
#undef FSTEP
    __syncthreads();
}
}

__device__ const unsigned char ATT_ITEMS[80] = {15, 30, 31, 63, 14, 28, 29, 61, 62, 13, 26, 27, 59, 60, 12, 24, 25, 57, 58, 11, 22, 23, 55, 56, 10, 20, 21, 53, 54, 9, 18, 19, 51, 52, 8, 16, 17, 49, 50, 7, 48, 6, 5,
    72, 73, 74, 75, 76, 77, 78, 79, 80, 81, 82, 83, 84, 85, 86, 87, 88, 89, 90, 91, 92, 93, 94, 95, 4, 71, 3, 70, 2, 69, 1, 68, 0, 67, 66, 65, 64};
constexpr int CW_QUEUE = 6144;
constexpr int CW_CVTQ = 6144 + 256;

__device__ __forceinline__ void p_attn(const Frame& F, unsigned char* lds_raw, int rep) {
    using namespace att;
    WV w; w.tid = F.tid; w.wid = F.wave; w.lane = F.lane; w.r32 = F.lane & 31; w.hi = F.lane >> 5;
    w.lds = (char*)lds_raw + 1024; w.ldsL = (LAS unsigned char*)lds_raw + 1024;
    w.vb0 = (int)(uintptr_t)(w.lds) + v_rd_base(w.lane);
    const bf16_t* qn = (const bf16_t*)(F.ws + WS_QN); const bf16_t* qrp = (const bf16_t*)(F.ws + WS_QR); const bf16_t* kv = (const bf16_t*)(F.ws + WS_KV);
    const bf16_t* ckv = (const bf16_t*)(F.ws + WS_CMPKV);
    bf16_t* ocmp = (bf16_t*)(F.ws + WS_OCMP); bf16_t* owin = (bf16_t*)(F.ws + WS_OWIN); bf16_t* osel = (bf16_t*)(F.ws + WS_OSEL); float* ml = (float*)(F.ws + WS_ML);
    unsigned* qctr = (unsigned*)(F.ws + WS_CTL) + CW_QUEUE + 64 * rep;
    float* wsf = (float*)(w.lds + L_WS) + w.wid * 64;
    float* part = (float*)(w.lds + L_PART); unsigned* selm = (unsigned*)(w.lds + L_SELM); float* vals = (float*)(w.lds + L_VALS) + w.wid * 64; volatile int* itemw = (volatile int*)(w.lds + L_ITEM);
    const int hr = w.wid >> 1, th = w.wid & 1;
    for (;;) {
        __syncthreads();
        if (F.tid == 0) itemw[0] = (int)atomicAdd(qctr, 1u);
        __syncthreads();
        const int item = itemw[0];
        if (item >= 640) break;
        const int ent = ATT_ITEMS[item >> 3], bg = item & 7, type = ent >> 5, qb = ent & 31, b = bg >> 1, g = bg & 1, h = 4 * g + hr;
        const int t0 = qb * 64 + th * 32, tpos = t0 + w.r32, tok0 = b * SEQ + t0;
        const size_t qoff = (((size_t)b * NH + h) * SEQ + t0 + w.r32) * HD + w.hi * 8;
        const size_t kvoff = ((size_t)b * NG + g) * SEQ * HD;
        bf16x8 qr[8];
        f32x16 o[4];
#ifndef ATT_NO_WIN
        if (type == 2) {
#pragma unroll
            for (int d0 = 0; d0 < 8; ++d0) qr[d0] = *(const bf16x8*)(qrp + qoff + d0 * 16);
#pragma unroll
            for (int d = 0; d < 4; ++d) o[d] = f32x16{};
            float m_reg = -1e30f, l_reg = 0.f;
            flash_pass<1>(w, kv + (size_t)4 * (4 * MB / 2) + kvoff, kv + (size_t)5 * (4 * MB / 2) + kvoff, qb >= 8 ? qb - 8 : 0, qb + 1, qr, tpos, t0, 0u, o, m_reg, l_reg);
            if (w.hi == 0) wsf[w.r32] = 1.f / l_reg;
            asm volatile("s_waitcnt lgkmcnt(0)" ::: "memory");
            store_o(w, o, wsf, owin + (size_t)tok0 * 1024 + h * HD);
            continue;
        }
#endif
#ifndef ATT_NO_CMP
        {
#pragma unroll
            for (int d0 = 0; d0 < 8; ++d0) qr[d0] = *(const bf16x8*)(qn + qoff + d0 * 16);
            const bf16_t* Kc = ckv + (size_t)bg * 128 * HD; const bf16_t* Vc = ckv + (size_t)1024 * HD + (size_t)bg * 128 * HD;
            dma_tile(w, Kc, Vc, 0); dma_tile(w, Kc + 64 * HD, Vc + 64 * HD, 1);
            asm volatile("s_waitcnt vmcnt(0)" ::: "memory");
            __syncthreads();
            f32x16 pA0, pA1, pB0, pB1;
            qkt(w, 0, qr, pA0, pA1); qkt(w, 1, qr, pB0, pB1);
            const int nmax = tpos >= 31 ? ((tpos - 31) >> 4) : -1;
            const float NEG = -__builtin_inff();
            float pmax = NEG;
#pragma unroll
            for (int r = 0; r < 16; ++r) { const int n = crow(r, w.hi);
                pA0[r] = (n <= nmax) ? pA0[r] : NEG; pA1[r] = (n + 32 <= nmax) ? pA1[r] : NEG; pB0[r] = (n + 64 <= nmax) ? pB0[r] : NEG; pB1[r] = (n + 96 <= nmax) ? pB1[r] : NEG;
                pmax = fmaxf(fmaxf(pmax, pA0[r]), fmaxf(pA1[r], fmaxf(pB0[r], pB1[r]))); }
            pmax = swap_max(pmax);
            const float mm = (pmax == NEG) ? 0.f : pmax;
            const float mnL = -mm * C2;
            float ps = 0.f;
#pragma unroll
            for (int r = 0; r < 16; ++r) { pA0[r] = __builtin_amdgcn_exp2f(fmaf(pA0[r], C2, mnL)); pA1[r] = __builtin_amdgcn_exp2f(fmaf(pA1[r], C2, mnL));
                pB0[r] = __builtin_amdgcn_exp2f(fmaf(pB0[r], C2, mnL)); pB1[r] = __builtin_amdgcn_exp2f(fmaf(pB1[r], C2, mnL)); ps += (pA0[r] + pA1[r]) + (pB0[r] + pB1[r]); }
            ps = swap_sum(ps);
            const float inv = ps > 0.f ? 1.f / ps : 0.f;
#pragma unroll
            for (int r = 0; r < 16; ++r) { pA0[r] *= inv; pA1[r] *= inv; pB0[r] *= inv; pB1[r] *= inv; }
            {
                float av[16], bv[16];
#pragma unroll
                for (int gq = 0; gq < 4; ++gq) {
                    av[gq]      = pA0[4 * gq] + pA0[4 * gq + 1] + pA0[4 * gq + 2] + 0.5f * pA0[4 * gq + 3]; bv[gq]      = 0.5f * pA0[4 * gq + 3];
                    av[4 + gq]  = pA1[4 * gq] + pA1[4 * gq + 1] + pA1[4 * gq + 2] + 0.5f * pA1[4 * gq + 3]; bv[4 + gq]  = 0.5f * pA1[4 * gq + 3];
                    av[8 + gq]  = pB0[4 * gq] + pB0[4 * gq + 1] + pB0[4 * gq + 2] + 0.5f * pB0[4 * gq + 3]; bv[8 + gq]  = 0.5f * pB0[4 * gq + 3];
                    av[12 + gq] = pB1[4 * gq] + pB1[4 * gq + 1] + pB1[4 * gq + 2] + 0.5f * pB1[4 * gq + 3]; bv[12 + gq] = 0.5f * pB1[4 * gq + 3];
                }
                float* prow = part + ((size_t)hr * 64 + th * 32 + w.r32) * 33;
#pragma unroll
                for (int idx = 0; idx < 16; ++idx) {
                    const float bo = __shfl_xor(bv[idx], 32);
                    const float bprev = (idx > 0) ? __shfl_xor(bv[idx > 0 ? idx - 1 : 0], 32) : 0.f;
                    const float inc = w.hi ? bo : bprev;
                    prow[2 * idx + w.hi] = av[idx] + inc;
                }
            }
            if (type == 0) {
                bf16x8 pa0, pa1, pa2, pa3;
#pragma unroll
                for (int d = 0; d < 4; ++d) o[d] = f32x16{};
                pack_p(pA0, pA1, pa0, pa1, pa2, pa3); pv_tile<0>(o, w.vb0, pa0, pa1, pa2, pa3);
                pack_p(pB0, pB1, pa0, pa1, pa2, pa3); pv_tile<1>(o, w.vb0, pa0, pa1, pa2, pa3);
                if (w.hi == 0) wsf[w.r32] = 1.f;
                asm volatile("s_waitcnt lgkmcnt(0)" ::: "memory");
                store_o(w, o, wsf, ocmp + (size_t)tok0 * 1024 + h * HD);
            }
            __syncthreads();
#pragma unroll 1
            for (int ps2 = 0; ps2 < 4; ++ps2) {
                int ln = w.lane; asm volatile("" : "+v"(ln));
                const int j = ln & 31, hi2 = ln >> 5;
                const int tk = 8 * w.wid + 2 * ps2 + hi2, t = qb * 64 + tk, cur = qb;
                float imp = 0.f;
#pragma unroll
                for (int r = 0; r < 4; ++r) imp += part[((size_t)r * 64 + tk) * 33 + j];
                const bool ok = (64 * j <= t), forced = (j == 0) || (cur - j >= 0 && cur - j < 2);
                const float val = (ok && forced) ? 1.0e30f : (ok ? imp : -1.0e30f);
                vals[ln] = val;
                asm volatile("s_waitcnt lgkmcnt(0)" ::: "memory");
                int rank = 0;
#pragma unroll
                for (int jj = 0; jj < 32; ++jj) { const float o2 = vals[hi2 * 32 + jj]; rank += (o2 > val || (o2 == val && jj < j)) ? 1 : 0; }
                const unsigned long long bal = __ballot(rank < 16 && val >= 0.f);
                if (w.lane == 0) { selm[8 * w.wid + 2 * ps2] = (unsigned)bal; selm[8 * w.wid + 2 * ps2 + 1] = (unsigned)(bal >> 32); }
            }
            __syncthreads();
        }
#endif
#ifndef ATT_NO_SEL
        {
            const unsigned sm = selm[th * 32 + w.r32];
            const int ntile = qb + 1, hsplit = (ntile + 1) >> 1;
            const int ja = (qb >= 16 && type == 1) ? hsplit : 0, jb = (qb >= 16 && type == 0) ? hsplit : ntile;
#pragma unroll
            for (int d0 = 0; d0 < 8; ++d0) qr[d0] = *(const bf16x8*)(qrp + qoff + d0 * 16);
#pragma unroll
            for (int d = 0; d < 4; ++d) o[d] = f32x16{};
            float m_reg = -1e30f, l_reg = 0.f;
            flash_pass<0>(w, kv + (size_t)2 * (4 * MB / 2) + kvoff, kv + (size_t)3 * (4 * MB / 2) + kvoff, ja, jb, qr, tpos, t0, sm, o, m_reg, l_reg);
            if (w.hi == 0) { wsf[w.r32] = l_reg > 0.f ? 1.f / l_reg : 0.f; float* mp = ml + (((size_t)type * NT + tok0 + w.r32) * NH + h) * 2; mp[0] = m_reg; mp[1] = l_reg; }
            asm volatile("s_waitcnt lgkmcnt(0)" ::: "memory");
            store_o(w, o, wsf, osel + (size_t)type * NT * 1024 + (size_t)tok0 * 1024 + h * HD);
        }
#endif
    }
}

struct CvtTile { const float* src; const float* ksc; bf16_t* dst0; int sld, ldd, mode; };
__device__ __forceinline__ CvtTile cvt_decode(const Frame& F, int t) {
    CvtTile c; c.ksc = nullptr; c.mode = 0;
    if (t < 4096) { const int e = t >> 7, mat = (t >> 6) & 1, kt = (t >> 1) & 31, nt = t & 1;
        c.src = (mat ? F.in[I_WUP] : F.in[I_WGATE]) + ((size_t)e * DM + kt * 64) * FF + nt * 256; c.sld = FF; c.ksc = F.in[I_LNMOE] + kt * 64;
        c.dst0 = (bf16_t*)(F.ws + WS_W1T) + ((size_t)e * 1024 + nt * 512 + mat * 128) * DM + kt * 64; c.ldd = DM; c.mode = 1; return c; }
    t -= 4096;
    if (t < 2048) { const int e = t >> 6, kt = (t >> 3) & 7, nt = t & 7;
        c.src = F.in[I_WDOWN] + ((size_t)e * FF + kt * 64) * DM + nt * 256; c.sld = DM;
        c.dst0 = (bf16_t*)(F.ws + WS_W2T) + ((size_t)e * 2048 + nt * 256) * FF + kt * 64; c.ldd = FF; return c; }
    t -= 2048;
    if (t < 256) { const int kt = t >> 3, nt = t & 7;
        c.src = F.in[I_WOUT] + (size_t)kt * 64 * DM + nt * 256; c.sld = DM; c.dst0 = (bf16_t*)(F.ws + WS_WOUTT) + (size_t)nt * 256 * DM + kt * 64; c.ldd = DM; return c; }
    t -= 256;
    if (t < 480) { const int kt = t / 15, nt = t % 15;
        c.src = F.in[I_WIN] + (size_t)kt * 64 * INW; c.sld = INW; c.ksc = F.in[I_LNMIX] + kt * 64;
        c.dst0 = (bf16_t*)(F.ws + WS_WINT) + (size_t)nt * 256 * DM + kt * 64; c.ldd = DM; c.mode = 2 + nt; return c; }
    t -= 480;
    { const int kv = t >> 6, kt = t & 63;
      c.src = (kv ? F.in[I_WV1] : F.in[I_WK1]) + (size_t)kt * 64 * 256; c.sld = 256; c.dst0 = (bf16_t*)(F.ws + WS_CMPW) + (size_t)kv * 256 * 4096 + kt * 64; c.ldd = 4096; return c; }
}
constexpr int N_CVT_TILES = 4096 + 2048 + 256 + 480 + 128;
__device__ __forceinline__ void cvt_load(const CvtTile& c, int nq, int kq, float4 (&v)[8]) {
    const float* p = c.src + 4 * nq; bool valid = true;
    if (c.mode >= 2) { const int n = (c.mode - 2) * 256 + 4 * nq; int sc = -1; if (n < 2560) sc = n; else if (n < 3584) sc = n + 24; else if (n < 3608) sc = n - 1024; valid = sc >= 0; p = c.src + (valid ? sc : 0); }
#pragma unroll
    for (int i = 0; i < 8; ++i) v[i] = valid ? *(const float4*)(p + (size_t)(kq * 8 + i) * c.sld) : make_float4(0.f, 0.f, 0.f, 0.f);
}

constexpr int CVT_RUN = 4;
__device__ __forceinline__ void cvt_stream(const Frame& F, int t_lo, int t_hi, unsigned* queue) {
    float* T = F.lds;
    volatile int* nxtw = (volatile int*)(F.lds + 64 * 257);
    const int tid = F.tid, nq = tid & 63, kq = tid >> 6;
    int tA, tB; float4 vA[8], vB[8]; CvtTile cA, cB;
    if (queue) { __syncthreads(); if (tid == 0) { nxtw[0] = t_lo + CVT_RUN * (int)atomicAdd(queue, 1u); nxtw[1] = t_lo + CVT_RUN * (int)atomicAdd(queue, 1u); } __syncthreads(); tA = nxtw[0]; tB = nxtw[1]; }
    else { tA = t_lo + F.bid; tB = tA + F.G; }
    if (tA < t_hi) { cA = cvt_decode(F, tA); cvt_load(cA, nq, kq, vA); }
    if (tB < t_hi) { cB = cvt_decode(F, tB); cvt_load(cB, nq, kq, vB); }
#define CVT_STEP(tX, cX, vX, slot) do {                                                                                                     \
        const bool pop = queue && (((tX) - t_lo) % CVT_RUN == CVT_RUN - 1);                 \
        int tn_reg = 0;                                                                                                                      \
        if (pop && tid == 0) tn_reg = t_lo + CVT_RUN * (int)atomicAdd(queue, 1u);                                                            \
        __syncthreads();                                                                                                                     \
        _Pragma("unroll") for (int i = 0; i < 8; ++i) { const float s = cX.ksc ? cX.ksc[kq * 8 + i] : 1.f; float* tp = T + (kq * 8 + i) * 257 + 4 * nq; \
            tp[0] = vX[i].x * s; tp[1] = vX[i].y * s; tp[2] = vX[i].z * s; tp[3] = vX[i].w * s; }                                           \
        if (pop && tid == 0) nxtw[slot] = tn_reg;                                                                                            \
        __syncthreads();                                                                                                                     \
        const CvtTile cc = cX; const int tn = queue ? (pop ? nxtw[slot] : tX + 1) : tX + 2 * F.G;                                            \
        if (tn < t_hi) { cX = cvt_decode(F, tn); cvt_load(cX, nq, kq, vX); }                                                                 \
        _Pragma("unroll") for (int j = 0; j < 4; ++j) { const int id = tid + 512 * j, n = id >> 3, kc = id & 7; const float* tp = T + (kc * 8) * 257 + n; \
            pg8::u32x4 w; w.x = pg8::cvt_pk_bf16(tp[0], tp[257]); w.y = pg8::cvt_pk_bf16(tp[2 * 257], tp[3 * 257]); w.z = pg8::cvt_pk_bf16(tp[4 * 257], tp[5 * 257]); w.w = pg8::cvt_pk_bf16(tp[6 * 257], tp[7 * 257]); \
            const int rowi = (cc.mode == 1) ? ((n >> 7) * 256 + (n & 127)) : n;                                                              \
            *(pg8::u32x4*)(cc.dst0 + (size_t)rowi * cc.ldd + kc * 8) = w; }                                                                  \
        tX = tn; } while (0)
    while (tA < t_hi) {
        CVT_STEP(tA, cA, vA, 0);
        if (tB >= t_hi) { const int t2 = tA; tA = tB; tB = t2; const CvtTile c2 = cA; cA = cB; cB = c2;
#pragma unroll
            for (int i = 0; i < 8; ++i) { const float4 x = vA[i]; vA[i] = vB[i]; vB[i] = x; }
            continue; }
        CVT_STEP(tB, cB, vB, 1);
    }
    while (tB < t_hi) CVT_STEP(tB, cB, vB, 1);
#undef CVT_STEP
    __syncthreads();
}

__device__ __forceinline__ void p0_prologue(const Frame& F) {
    const float* x = F.in[I_X];
    bf16_t* xb = (bf16_t*)(F.ws + WS_XB); float* rstd1 = (float*)(F.ws + WS_RSTD1);
    const int gw = F.bid * NWAVES + F.wave, nw = F.G * NWAVES, lane = F.lane;
    for (int r = gw; r < NT; r += nw) {
        float4 v[8]; float ss = 0.f;
#pragma unroll
        for (int i = 0; i < 8; ++i) { v[i] = *(const float4*)(x + (size_t)r * DM + i * 256 + lane * 4); ss += v[i].x * v[i].x + v[i].y * v[i].y + v[i].z * v[i].z + v[i].w * v[i].w; }
        ss = wave_sum(ss);
        if (lane == 0) rstd1[r] = rsqrtf(ss * (1.f / DM) + EPS);
#pragma unroll
        for (int i = 0; i < 8; ++i) { uint2 w; w.x = pg8::cvt_pk_bf16(v[i].x, v[i].y); w.y = pg8::cvt_pk_bf16(v[i].z, v[i].w);
            *(uint2*)(xb + (size_t)r * DM + i * 256 + lane * 4) = w; }
    }
    cvt_stream(F, 6400, N_CVT_TILES, nullptr);
    {
        const float* wp = F.in[I_WPOOL]; const float* ps = F.in[I_PSCALE]; const float* bp = F.in[I_BPOOL]; bf16_t* wpt = (bf16_t*)(F.ws + WS_POOLW); float* pb = (float*)(F.ws + WS_POOLB);
        for (int idx = F.bid * NTHREADS + F.tid; idx < 4 * 256 * 256; idx += F.G * NTHREADS) { const int k = idx & 255, n = (idx >> 8) & 255, g = idx >> 16;
            wpt[idx] = f2bf(wp[((size_t)g * 256 + k) * 256 + n] * ps[g * 256 + n]); }
        for (int idx = F.bid * NTHREADS + F.tid; idx < 1024; idx += F.G * NTHREADS) pb[idx] = bp[idx] * ps[idx];
    }
    {
        const float* lnm = F.in[I_LNMOE]; const float* wre = F.in[I_WRE]; const float* wrg = F.in[I_WRG]; float* WR = (float*)(F.ws + WS_WR); float* WG4 = (float*)(F.ws + WS_WG4);
        for (int idx = F.bid * NTHREADS + F.tid; idx < DM * 32; idx += F.G * NTHREADS) { const int k = idx >> 5, c = idx & 31; WR[idx] = lnm[k] * wre[((size_t)(c >> 3) * DM + k) * 8 + (c & 7)]; }
        for (int idx = F.bid * NTHREADS + F.tid; idx < DM * 4; idx += F.G * NTHREADS) WG4[idx] = lnm[idx >> 2] * wrg[idx];
    }
    {
        const int* pos = (const int*)F.in[I_POS]; float* rc = (float*)(F.ws + WS_ROPEC); float* rs = (float*)(F.ws + WS_ROPES);
        for (int idx = F.bid * NTHREADS + F.tid; idx < NB * SEQ * 16; idx += F.G * NTHREADS) {
            const int i = idx & 15, bs = idx >> 4;
            const float inv = exp2f(-(float)i * (1.f / 16.f) * 18.931568569324174f);
            const float ang = (float)pos[bs] * inv;
            rc[idx] = cosf(ang); rs[idx] = sinf(ang);
        }
    }
    for (int it = F.bid; it < 64; it += F.G) {
        const int kv = it >> 5, jb = (it >> 3) & 3, mc = it & 7;
        const float* pe = (kv ? F.in[I_PEV] : F.in[I_PEK]); const float* w1 = (kv ? F.in[I_WV1] : F.in[I_WK1]);
        const int mg = F.tid >> 6, j = jb * 64 + (F.tid & 63);
        float a = 0.f;
#pragma unroll 8
        for (int m = mc * 512 + mg; m < mc * 512 + 512; m += 8) a += pe[m] * w1[(size_t)m * 256 + j];
        __syncthreads();
        F.lds[F.tid] = a;
        __syncthreads();
        if (F.tid < 64) { float s = 0.f; for (int q = 0; q < 8; ++q) s += F.lds[q * 64 + F.tid]; ((float*)(F.ws + WS_BIAS1))[(mc * 2 + kv) * 256 + j] = s; }
        __syncthreads();
    }
}

struct EpiProj {
    const float* rstd1; const float* rc; const float* rs; bf16_t* qn; bf16_t* qr; bf16_t* kv; float* u; float* gates;
    __device__ __forceinline__ void operator()(const pg8::f32x4 (&acc)[2][2][4][2], const pg8::Unit& un, int wr, int wc, int fr, int fq) const {
        const int pn = un.pn;
#pragma unroll
        for (int ai = 0; ai < 2; ++ai)
#pragma unroll
            for (int m = 0; m < 4; ++m) {
                const int row = un.pm * 256 + ai * 128 + wr * 64 + m * 16 + fr; const float r1 = rstd1[row]; const int b = row >> 11, s = row & 2047;
                if (pn < 10) {
                    const bool ropeu = (pn < 4) || pn == 6 || pn == 8;
                    pg8::f32x4 c4 = {1.f, 1.f, 1.f, 1.f}, s4 = {0.f, 0.f, 0.f, 0.f};
                    if (ropeu && wc == 0) { c4 = *(const pg8::f32x4*)(rc + (size_t)row * 16 + 4 * fq); s4 = *(const pg8::f32x4*)(rs + (size_t)row * 16 + 4 * fq); }
#pragma unroll
                    for (int bj = 0; bj < 2; ++bj) {
                        const pg8::f32x4 v0 = acc[ai][bj][m][0] * r1, v1 = acc[ai][bj][m][1] * r1;
                        const int d0 = 32 * wc + 4 * fq;
                        pg8::f32x4 o0 = v0, o1 = v1;
                        if (ropeu && wc == 0) { o0 = v0 * c4 - v1 * s4; o1 = v1 * c4 + v0 * s4; }
                        uint2 w0, w1; w0.x = pg8::cvt_pk_bf16(o0[0], o0[1]); w0.y = pg8::cvt_pk_bf16(o0[2], o0[3]); w1.x = pg8::cvt_pk_bf16(o1[0], o1[1]); w1.y = pg8::cvt_pk_bf16(o1[2], o1[3]);
                        if (pn < 4) {
                            const size_t o = (((size_t)b * NH + 2 * pn + bj) * SEQ + s) * HD + d0;
                            uint2 n0, n1; n0.x = pg8::cvt_pk_bf16(v0[0], v0[1]); n0.y = pg8::cvt_pk_bf16(v0[2], v0[3]); n1.x = pg8::cvt_pk_bf16(v1[0], v1[1]); n1.y = pg8::cvt_pk_bf16(v1[2], v1[3]);
                            *(uint2*)(qn + o) = n0; *(uint2*)(qn + o + 16) = n1; *(uint2*)(qr + o) = w0; *(uint2*)(qr + o + 16) = w1;
                        } else {
                            const size_t o = (size_t)(pn - 4) * (4 * MB / 2) + (((size_t)b * NG + bj) * SEQ + s) * HD + d0;
                            *(uint2*)(kv + o) = w0; *(uint2*)(kv + o + 16) = w1;
                        }
                    }
                } else if (pn < 14) {
#pragma unroll
                    for (int bj = 0; bj < 2; ++bj)
#pragma unroll
                        for (int n = 0; n < 2; ++n) *(pg8::f32x4*)(u + (size_t)row * 1024 + (pn - 10) * 256 + bj * 128 + wc * 32 + n * 16 + 4 * fq) = acc[ai][bj][m][n] * r1;
                } else {
                    if (wc == 0) { *(pg8::f32x4*)(gates + (size_t)row * 24 + 4 * fq) = acc[ai][0][m][0] * r1; if (fq < 2) *(pg8::f32x4*)(gates + (size_t)row * 24 + 16 + 4 * fq) = acc[ai][0][m][1] * r1; }
                }
            }
    }
};

__device__ __forceinline__ void p1_proj(const Frame& F, LAS unsigned char* stage) {
    pg8::DenseOrder S; S.init(F.ws + WS_XB, F.ws + WS_WINT, DM, DM, NT, INWP, F.G, F.bid);
    EpiProj E{(const float*)(F.ws + WS_RSTD1), (const float*)(F.ws + WS_ROPEC), (const float*)(F.ws + WS_ROPES), (bf16_t*)(F.ws + WS_QN), (bf16_t*)(F.ws + WS_QR), (bf16_t*)(F.ws + WS_KV),
              (float*)(F.ws + WS_U), (float*)(F.ws + WS_GATES)};
    pg8::gemm_phase<EpiProj, pg8::DenseOrder, false>(stage, DM, DM, DM, S, E);
}

struct CmpOrder {
    const char* kc; const char* w1t; int c;
    __device__ __forceinline__ bool next(int i, pg8::Unit& u) const { if (i > 0) return false; u.e = c >> 5; u.pm = (c >> 3) & 3; u.pn = c & 7; u.li = 0; return true; }
    __device__ __forceinline__ const char* a_base(const pg8::Unit& u) const { return kc + (size_t)u.e * 4 * MB + ((size_t)u.pm * 256 * 2048 + u.pn * 512) * 2; }
    __device__ __forceinline__ const char* b_base(const pg8::Unit& u) const { return w1t + ((size_t)u.e * 256 * 4096 + u.pn * 512) * 2; }
    __device__ __forceinline__ unsigned a_row_off(const pg8::Unit&, int r) const { return (unsigned)r * 4096u; }
};
struct EpiCmp {
    float* part;
    __device__ __forceinline__ void operator()(const pg8::f32x4 (&acc)[2][2][4][2], const pg8::Unit& un, int wr, int wc, int fr, int fq) const {
        float* base = part + (((size_t)un.pn * 2 + un.e) * 1024 + un.pm * 256) * 256;
#pragma unroll
        for (int ai = 0; ai < 2; ++ai)
#pragma unroll
            for (int m = 0; m < 4; ++m) { float* rowp = base + (size_t)(ai * 128 + wr * 64 + m * 16 + fr) * 256 + wc * 32 + 4 * fq;
#pragma unroll
                for (int bj = 0; bj < 2; ++bj)
#pragma unroll
                    for (int n = 0; n < 2; ++n) *(pg8::f32x4*)(rowp + bj * 128 + n * 16) = acc[ai][bj][m][n]; }
    }
};
struct PoolOrder {
    const char* d; const char* wpt; int c;
    __device__ __forceinline__ bool next(int i, pg8::Unit& u) const { if (i > 0) return false; u.pm = c >> 2; u.pn = 0; u.e = c & 3; u.li = 0; return true; }
    __device__ __forceinline__ const char* a_base(const pg8::Unit& u) const { return d + ((size_t)u.pm * 256 * 1024 + u.e * 256) * 2; }
    __device__ __forceinline__ const char* b_base(const pg8::Unit& u) const { return wpt + (size_t)u.e * 256 * 256 * 2; }
    __device__ __forceinline__ unsigned a_row_off(const pg8::Unit&, int r) const { return (unsigned)r * 2048u; }
};
struct EpiPool {
    const float* pb; float* opool;
    __device__ __forceinline__ void operator()(const pg8::f32x4 (&acc)[2][2][4][2], const pg8::Unit& un, int wr, int wc, int fr, int fq) const {
#pragma unroll
        for (int ai = 0; ai < 2; ++ai)
#pragma unroll
            for (int m = 0; m < 4; ++m) { const int row = un.pm * 256 + ai * 128 + wr * 64 + m * 16 + fr;
#pragma unroll
                for (int bj = 0; bj < 2; ++bj)
#pragma unroll
                    for (int n = 0; n < 2; ++n) { const int c = un.e * 256 + bj * 128 + wc * 32 + n * 16 + 4 * fq;
                        *(pg8::f32x4*)(opool + (size_t)row * 1024 + c) = acc[ai][bj][m][n] + *(const pg8::f32x4*)(pb + c); } }
    }
};
__device__ __forceinline__ void p3_mid(const Frame& F, LAS unsigned char* stage, int rep) {
    if (F.bid < 64) {
        CmpOrder S{(const char*)(F.ws + WS_KV), (const char*)(F.ws + WS_CMPW), F.bid};
        EpiCmp E{(float*)(F.ws + WS_CPART)};
        pg8::gemm_phase<EpiCmp, CmpOrder, false>(stage, 512, 2048, 4096, S, E);
    } else if (F.bid < 192) {
        const int c = F.bid - 64, pm = c >> 2, gi = c & 3, w = 2 << gi;
        const float* u = (const float*)(F.ws + WS_U); bf16_t* d = (bf16_t*)(F.ws + WS_DBUF);
        for (int task = F.tid; task < 256 * 16; task += 2 * NTHREADS) {
            const int cc = task & 255, col = gi * 256 + cc;
            float uv[2][31];
#pragma unroll
            for (int tt = 0; tt < 2; ++tt) { const int ch = (task >> 8) + 2 * tt, r0 = pm * 256 + ch * 16, s0 = r0 & 2047;
#pragma unroll
                for (int q = 0; q < 31; ++q) { const int s = s0 - 15 + q; uv[tt][q] = (s >= 0) ? u[(size_t)(r0 - 15 + q) * 1024 + col] : 0.f; } }
#pragma unroll
            for (int tt = 0; tt < 2; ++tt) { const int ch = (task >> 8) + 2 * tt, r0 = pm * 256 + ch * 16, s0 = r0 & 2047;
#pragma unroll
                for (int i = 0; i < 16; ++i) { float sum = 0.f;
#pragma unroll
                    for (int q = 0; q < 16; ++q) if (q < w) sum += uv[tt][15 + i - q];
                    const int s = s0 + i, cnt = (s + 1 < w) ? s + 1 : w;
                    d[(size_t)(r0 + i) * 1024 + col] = f2bf(sum / (float)cnt - uv[tt][15 + i]); } }
        }
        asm volatile("s_waitcnt vmcnt(0)" ::: "memory");
        __syncthreads();
        PoolOrder S{(const char*)(F.ws + WS_DBUF), (const char*)(F.ws + WS_POOLW), c};
        EpiPool E{(const float*)(F.ws + WS_POOLB), (float*)(F.ws + WS_OPOOL)};
        pg8::gemm_phase<EpiPool, PoolOrder, false>(stage, 256, 1024, 256, S, E);
    }
    cvt_stream(F, 0, 6400, (unsigned*)(F.ws + WS_CTL) + CW_CVTQ + 64 * rep);
}

__device__ __forceinline__ void p4_cmp2(const Frame& F) {
    const float* part = (const float*)(F.ws + WS_CPART); const float* bias1p = (const float*)(F.ws + WS_BIAS1); bf16_t* ckv = (bf16_t*)(F.ws + WS_CMPKV);
    float* H = F.lds;
    for (int it = F.bid; it < 128; it += F.G) {
        const int kvi = it >> 6, r0 = (it & 63) * 16; const float* w2 = kvi ? F.in[I_WV2] : F.in[I_WK2];
        __syncthreads();
#pragma unroll
        for (int j = 0; j < 2; ++j) { const int idx = F.tid + 512 * j, r = idx >> 6, c = (idx & 63) * 4;
            pg8::f32x4 s = {0.f, 0.f, 0.f, 0.f};
#pragma unroll
            for (int sp = 0; sp < 8; ++sp) s += *(const pg8::f32x4*)(part + (((size_t)sp * 2 + kvi) * 1024 + r0 + r) * 256 + c) + *(const pg8::f32x4*)(bias1p + (sp * 2 + kvi) * 256 + c);
            H[r * 260 + c] = gelu_tanh(s[0]); H[r * 260 + c + 1] = gelu_tanh(s[1]); H[r * 260 + c + 2] = gelu_tanh(s[2]); H[r * 260 + c + 3] = gelu_tanh(s[3]); }
        __syncthreads();
        const int r = F.tid >> 5, c0 = (F.tid & 31) * 4;
        pg8::f32x4 acc = {0.f, 0.f, 0.f, 0.f};
#pragma unroll 8
        for (int k = 0; k < 256; ++k) acc += *(const pg8::f32x4*)(w2 + (size_t)k * 128 + c0) * H[r * 260 + k];
        const int R = r0 + r; const bool pad = (R & 127) == 127;
        uint2 w; w.x = pad ? 0u : pg8::cvt_pk_bf16(acc[0], acc[1]); w.y = pad ? 0u : pg8::cvt_pk_bf16(acc[2], acc[3]);
        *(uint2*)(ckv + ((size_t)kvi * 1024 + R) * 128 + c0) = w;
    }
}

__device__ __forceinline__ void unpack8(const pg8::u32x4 w, float (&f)[8]) {
    f[0] = __uint_as_float(w.x << 16); f[1] = __uint_as_float(w.x & 0xFFFF0000u); f[2] = __uint_as_float(w.y << 16); f[3] = __uint_as_float(w.y & 0xFFFF0000u);
    f[4] = __uint_as_float(w.z << 16); f[5] = __uint_as_float(w.z & 0xFFFF0000u); f[6] = __uint_as_float(w.w << 16); f[7] = __uint_as_float(w.w & 0xFFFF0000u);
}
__device__ __forceinline__ void p6_mix(const Frame& F) {
    const bf16_t* ocmp = (const bf16_t*)(F.ws + WS_OCMP); const bf16_t* owin = (const bf16_t*)(F.ws + WS_OWIN); const bf16_t* osel = (const bf16_t*)(F.ws + WS_OSEL);
    const float* ml = (const float*)(F.ws + WS_ML); const float* gates = (const float*)(F.ws + WS_GATES);
    const float* opool = (const float*)(F.ws + WS_OPOOL); bf16_t* mix = (bf16_t*)(F.ws + WS_MIX);
    const float* gn = F.in[I_GNNSA]; const float* gp = F.in[I_GNPOOL];
    const int gw = F.bid * NWAVES + F.wave, nw = F.G * NWAVES, lane = F.lane, h = lane >> 3;
    for (int r = gw; r < NT; r += nw) {
        const bool split = ((r & 2047) >> 6) >= 16;
        const size_t o = (size_t)r * 1024 + lane * 16;
        const float* gq = gates + (size_t)r * 24 + h * 3;
        const float g0 = 1.f / (1.f + __expf(-gq[0])), g1 = 1.f / (1.f + __expf(-gq[1])), g2 = 1.f / (1.f + __expf(-gq[2]));
        float w0 = 1.f, w1 = 0.f;
        if (split) { const float* m0p = ml + ((size_t)r * NH + h) * 2; const float* m1p = ml + (((size_t)NT + r) * NH + h) * 2;
            const float m0 = m0p[0], l0 = m0p[1], m1 = m1p[0], l1 = m1p[1], M = fmaxf(m0, m1);
            const float a0 = l0 * exp2f((m0 - M) * att::C2), a1 = l1 * exp2f((m1 - M) * att::C2), inv = 1.f / (a0 + a1); w0 = a0 * inv; w1 = a1 * inv; }
        float a[16], p[16]; float sa = 0.f, sp = 0.f;
#pragma unroll
        for (int hf = 0; hf < 2; ++hf) {
            float c8[8], w8[8], s8[8], t8[8];
            unpack8(*(const pg8::u32x4*)(ocmp + o + hf * 8), c8); unpack8(*(const pg8::u32x4*)(owin + o + hf * 8), w8); unpack8(*(const pg8::u32x4*)(osel + o + hf * 8), s8);
            if (split) unpack8(*(const pg8::u32x4*)(osel + (size_t)NT * 1024 + o + hf * 8), t8);
#pragma unroll
            for (int j = 0; j < 8; ++j) { const float os = split ? (w0 * s8[j] + w1 * t8[j]) : s8[j]; a[hf * 8 + j] = g0 * c8[j] + g1 * os + g2 * w8[j]; sa += a[hf * 8 + j] * a[hf * 8 + j]; }
        }
#pragma unroll
        for (int q = 0; q < 4; ++q) { const pg8::f32x4 v = *(const pg8::f32x4*)(opool + o + q * 4); p[q * 4] = v[0]; p[q * 4 + 1] = v[1]; p[q * 4 + 2] = v[2]; p[q * 4 + 3] = v[3]; sp += v[0] * v[0] + v[1] * v[1] + v[2] * v[2] + v[3] * v[3]; }
        sa = wave_sum(sa); sp = wave_sum(sp);
        const float ra = rsqrtf(sa * (1.f / 1024.f) + EPS), rp = rsqrtf(sp * (1.f / 1024.f) + EPS);
        float ga[16], gb[16];
#pragma unroll
        for (int q = 0; q < 4; ++q) { const pg8::f32x4 v = *(const pg8::f32x4*)(gn + lane * 16 + q * 4), u = *(const pg8::f32x4*)(gp + lane * 16 + q * 4);
            ga[q * 4] = v[0]; ga[q * 4 + 1] = v[1]; ga[q * 4 + 2] = v[2]; ga[q * 4 + 3] = v[3]; gb[q * 4] = u[0]; gb[q * 4 + 1] = u[1]; gb[q * 4 + 2] = u[2]; gb[q * 4 + 3] = u[3]; }
#pragma unroll
        for (int hf = 0; hf < 2; ++hf) { pg8::u32x4 wa, wb;
            wa.x = pg8::cvt_pk_bf16(a[hf * 8] * ra * ga[hf * 8], a[hf * 8 + 1] * ra * ga[hf * 8 + 1]); wa.y = pg8::cvt_pk_bf16(a[hf * 8 + 2] * ra * ga[hf * 8 + 2], a[hf * 8 + 3] * ra * ga[hf * 8 + 3]);
            wa.z = pg8::cvt_pk_bf16(a[hf * 8 + 4] * ra * ga[hf * 8 + 4], a[hf * 8 + 5] * ra * ga[hf * 8 + 5]); wa.w = pg8::cvt_pk_bf16(a[hf * 8 + 6] * ra * ga[hf * 8 + 6], a[hf * 8 + 7] * ra * ga[hf * 8 + 7]);
            wb.x = pg8::cvt_pk_bf16(p[hf * 8] * rp * gb[hf * 8], p[hf * 8 + 1] * rp * gb[hf * 8 + 1]); wb.y = pg8::cvt_pk_bf16(p[hf * 8 + 2] * rp * gb[hf * 8 + 2], p[hf * 8 + 3] * rp * gb[hf * 8 + 3]);
            wb.z = pg8::cvt_pk_bf16(p[hf * 8 + 4] * rp * gb[hf * 8 + 4], p[hf * 8 + 5] * rp * gb[hf * 8 + 5]); wb.w = pg8::cvt_pk_bf16(p[hf * 8 + 6] * rp * gb[hf * 8 + 6], p[hf * 8 + 7] * rp * gb[hf * 8 + 7]);
            *(pg8::u32x4*)(mix + (size_t)r * DM + lane * 16 + hf * 8) = wa; *(pg8::u32x4*)(mix + (size_t)r * DM + 1024 + lane * 16 + hf * 8) = wb; }
    }
}

struct EpiOut {
    const float* x; float* out; bf16_t* x1b;
    __device__ __forceinline__ void operator()(const pg8::f32x4 (&acc)[2][2][4][2], const pg8::Unit& un, int wr, int wc, int fr, int fq) const {
#pragma unroll
        for (int ai = 0; ai < 2; ++ai)
#pragma unroll
            for (int m = 0; m < 4; ++m) {
                const int row = un.pm * 256 + ai * 128 + wr * 64 + m * 16 + fr;
#pragma unroll
                for (int bj = 0; bj < 2; ++bj)
#pragma unroll
                    for (int n = 0; n < 2; ++n) {
                        const size_t o = (size_t)row * DM + un.pn * 256 + bj * 128 + wc * 32 + n * 16 + 4 * fq;
                        const pg8::f32x4 v = acc[ai][bj][m][n] + *(const pg8::f32x4*)(x + o);
                        *(pg8::f32x4*)(out + o) = v;
                        uint2 w; w.x = pg8::cvt_pk_bf16(v[0], v[1]); w.y = pg8::cvt_pk_bf16(v[2], v[3]); *(uint2*)(x1b + o) = w;
                    }
            }
    }
};
__device__ __forceinline__ void p7_out(const Frame& F, LAS unsigned char* stage) {
    pg8::DenseOrder S; S.init(F.ws + WS_MIX, F.ws + WS_WOUTT, DM, DM, NT, DM, F.G, F.bid);
    EpiOut E{F.in[I_X], F.out, (bf16_t*)(F.ws + WS_X1B)};
    pg8::gemm_phase<EpiOut, pg8::DenseOrder, false>(stage, DM, DM, DM, S, E);
}

__device__ __forceinline__ void p8_router(const Frame& F, int dummy) {
    typedef float f32x16 __attribute__((ext_vector_type(16)));
    const float* WR = (const float*)(F.ws + WS_WR); const float* WG4 = (const float*)(F.ws + WS_WG4); const float* brg = F.in[I_BRG]; const float* bre = F.in[I_BRE];
    float* rstd2 = (float*)(F.ws + (dummy ? WS_DBUF : WS_RSTD2)); int* arow = (int*)(F.ws + (dummy ? WS_DBUF + MB : WS_AROW)); int* tokl = (int*)(F.ws + (dummy ? WS_DBUF + 2 * MB : WS_TOKL)); float* gatel = (float*)(F.ws + (dummy ? WS_DBUF + 4 * MB : WS_GATEL));
    unsigned* cnt = (unsigned*)(F.ws + WS_CTL) + (dummy ? 8192 : CW_CNT);
    float* part = F.lds; float* ssp = part + 8 * 32 * 33; float* lgp = ssp + 256;
    const int lane = F.lane, row = lane & 31, half = lane >> 5, kbase = F.wave * 256;
    for (int it = F.bid; it < NT / 32; it += F.G) {
        const int tok0 = it * 32;
        const float* xp = F.out + (size_t)(tok0 + row) * DM + kbase + 4 * half;
        f32x16 acc = {0.f, 0.f, 0.f, 0.f, 0.f, 0.f, 0.f, 0.f, 0.f, 0.f, 0.f, 0.f, 0.f, 0.f, 0.f, 0.f};
        float ss = 0.f, lg0 = 0.f, lg1 = 0.f, lg2 = 0.f, lg3 = 0.f;
#pragma unroll 4
        for (int kb = 0; kb < 256; kb += 8) {
            const float4 xa = *(const float4*)(xp + kb);
            const int k0 = kbase + kb + 4 * half;
            ss += xa.x * xa.x + xa.y * xa.y + xa.z * xa.z + xa.w * xa.w;
            const float av[4] = {xa.x, xa.y, xa.z, xa.w};
#pragma unroll
            for (int j = 0; j < 4; ++j) {
                const float bv = WR[(size_t)(k0 + j) * 32 + row]; const float4 w4 = *(const float4*)(WG4 + (size_t)(k0 + j) * 4);
                acc = __builtin_amdgcn_mfma_f32_32x32x2f32(av[j], bv, acc, 0, 0, 0);
                lg0 += av[j] * w4.x; lg1 += av[j] * w4.y; lg2 += av[j] * w4.z; lg3 += av[j] * w4.w;
            }
        }
        ss += __shfl_xor(ss, 32); lg0 += __shfl_xor(lg0, 32); lg1 += __shfl_xor(lg1, 32); lg2 += __shfl_xor(lg2, 32); lg3 += __shfl_xor(lg3, 32);
        __syncthreads();
#pragma unroll
        for (int r = 0; r < 16; ++r) part[(F.wave * 32 + (r & 3) + 8 * (r >> 2) + 4 * half) * 33 + row] = acc[r];
        if (half == 0) { ssp[F.wave * 32 + row] = ss; float* q = lgp + (F.wave * 32 + row) * 4; q[0] = lg0; q[1] = lg1; q[2] = lg2; q[3] = lg3; }
        __syncthreads();
        if (F.wave == 0 && lane < 32) {
            const int t = lane, r = tok0 + t;
            float s2 = 0.f, lg[4] = {0.f, 0.f, 0.f, 0.f};
#pragma unroll
            for (int w = 0; w < 8; ++w) { s2 += ssp[w * 32 + t]; const float* q = lgp + (w * 32 + t) * 4; lg[0] += q[0]; lg[1] += q[1]; lg[2] += q[2]; lg[3] += q[3]; }
            const float rs = rsqrtf(s2 * (1.f / DM) + EPS);
#pragma unroll
            for (int j = 0; j < 4; ++j) lg[j] = lg[j] * rs + brg[j];
            int gs = 0; float gm = lg[0];
#pragma unroll
            for (int j = 1; j < 4; ++j) if (lg[j] > gm) { gm = lg[j]; gs = j; }
            float den = 0.f;
#pragma unroll
            for (int j = 0; j < 4; ++j) den += __expf(lg[j] - gm);
            const float pg = 1.f / den;
            float le[8];
#pragma unroll
            for (int j = 0; j < 8; ++j) { float s = 0.f;
#pragma unroll
                for (int w = 0; w < 8; ++w) s += part[(w * 32 + t) * 33 + gs * 8 + j];
                le[j] = s * rs + bre[gs * 8 + j]; }
            int e0 = 0; float m0 = le[0];
#pragma unroll
            for (int j = 1; j < 8; ++j) if (le[j] > m0) { m0 = le[j]; e0 = j; }
            int e1 = -1; float m1 = -3.0e38f;
#pragma unroll
            for (int j = 0; j < 8; ++j) if (j != e0 && le[j] > m1) { m1 = le[j]; e1 = j; }
            const float p1 = __expf(m1 - m0);
            const float gate0 = pg / (1.f + p1), gate1 = pg * p1 / (1.f + p1);
            rstd2[r] = rs;
            const int ea = gs * 8 + e0, eb = gs * 8 + e1;
            const unsigned sa = atomicAdd(&cnt[64 * ea], 1u), sb = atomicAdd(&cnt[64 * eb], 1u);
            tokl[ea * 8192 + sa] = r; gatel[ea * 8192 + sa] = gate0; tokl[eb * 8192 + sb] = r; gatel[eb * 8192 + sb] = gate1;
            arow[2 * r] = ea * 8192 + (int)sa; arow[2 * r + 1] = eb * 8192 + (int)sb;
        }
    }
}

__device__ __forceinline__ void moe_counts(const Frame& F, int* cnts  , int* pst  ) {
    const unsigned* cnt = (const unsigned*)(F.ws + WS_CTL) + CW_CNT;
    __syncthreads();
    if (F.tid < 32) cnts[F.tid] = (int)__hip_atomic_load(&cnt[64 * F.tid], __ATOMIC_RELAXED, __HIP_MEMORY_SCOPE_AGENT);
    __syncthreads();
    if (F.tid == 0) { int a = 0; for (int e = 0; e < 32; ++e) { pst[e] = a; a += (cnts[e] + 255) & ~255; } pst[32] = a; }
    __syncthreads();
}

constexpr int MOE_TAB_OFF = 1024 + 131072;
struct MoeTabs { int* cnts; int* pst; int* ust; int* rowtok; };
__device__ __forceinline__ MoeTabs moe_tabs(unsigned char* lds_raw) { MoeTabs T; T.cnts = (int*)(lds_raw + MOE_TAB_OFF); T.pst = T.cnts + 32; T.ust = T.pst + 40; T.rowtok = T.ust + 40; return T; }
template <int NTN> __device__ __forceinline__ void moe_units(const Frame& F, const MoeTabs& T) {
    moe_counts(F, T.cnts, T.pst);
    if (F.tid == 0) { int a = 0; for (int e = 0; e < 32; ++e) { T.ust[e] = a; a += ((T.cnts[e] + 255) >> 8) * NTN; } T.ust[32] = a; }
    __syncthreads();
}
template <int NTN, int LOGN> struct MoeOrder {
    const char* A; const char* Bt; const int* pst; const int* ust; const int* rowtok; int G, c, lda, ldb, brows;
    __device__ __forceinline__ bool next(int i, pg8::Unit& u) const {
        const int L = i * G + c; if (L >= ust[32]) return false;
        int e = 0; while (ust[e + 1] <= L) ++e;
        const int w = L - ust[e]; u.e = e; u.pm = w >> LOGN; u.pn = w & (NTN - 1); u.li = i; return true;
    }
    __device__ __forceinline__ const char* b_base(const pg8::Unit& u) const { return Bt + ((size_t)u.e * brows + (size_t)u.pn * 256) * ldb * 2; }
    __device__ __forceinline__ const char* a_base(const pg8::Unit& u) const { return rowtok ? A : A + (size_t)(pst[u.e] + u.pm * 256) * lda * 2; }
    __device__ __forceinline__ unsigned a_row_off(const pg8::Unit& u, int r) const {
        if (rowtok) { const int tk = rowtok[u.li * 256 + r]; return (unsigned)(tk < 0 ? 0 : tk) * (unsigned)lda * 2u; }
        return (unsigned)r * (unsigned)lda * 2u;
    }
};
struct EpiMoe1 {
    const int* cnts; const int* pst; const int* rowtok; const float* rstd2; bf16_t* act;
    __device__ __forceinline__ void operator()(const pg8::f32x4 (&acc)[2][2][4][2], const pg8::Unit& un, int wr, int wc, int fr, int fq) const {
#pragma unroll
        for (int ai = 0; ai < 2; ++ai)
#pragma unroll
            for (int m = 0; m < 4; ++m) {
                const int r = ai * 128 + wr * 64 + m * 16 + fr; const int tk = rowtok[un.li * 256 + r];
                if (tk >= 0) {
                    const float rs = rstd2[tk];
                    bf16_t* dst = act + (size_t)(pst[un.e] + un.pm * 256 + r) * FF + un.pn * 128 + wc * 32 + 4 * fq;
#pragma unroll
                    for (int n = 0; n < 2; ++n) {
                        const pg8::f32x4 vg = acc[ai][0][m][n] * rs, vu = acc[ai][1][m][n] * rs; float o[4];
#pragma unroll
                        for (int j = 0; j < 4; ++j) o[j] = vg[j] / (1.f + __expf(-vg[j])) * vu[j];
                        uint2 w; w.x = pg8::cvt_pk_bf16(o[0], o[1]); w.y = pg8::cvt_pk_bf16(o[2], o[3]); *(uint2*)(dst + 16 * n) = w;
                    }
                }
            }
    }
};
struct EpiMoe2 {
    const int* cnts; const int* pst; const float* gatel; bf16_t* y;
    __device__ __forceinline__ void operator()(const pg8::f32x4 (&acc)[2][2][4][2], const pg8::Unit& un, int wr, int wc, int fr, int fq) const {
#pragma unroll
        for (int ai = 0; ai < 2; ++ai)
#pragma unroll
            for (int m = 0; m < 4; ++m) {
                const int slot = un.pm * 256 + ai * 128 + wr * 64 + m * 16 + fr;
                if (slot < cnts[un.e]) {
                    const float gt = gatel[un.e * 8192 + slot];
                    bf16_t* dst = y + (size_t)(pst[un.e] + slot) * DM + un.pn * 256 + wc * 32 + 4 * fq;
#pragma unroll
                    for (int bj = 0; bj < 2; ++bj)
#pragma unroll
                        for (int n = 0; n < 2; ++n) { const pg8::f32x4 v = acc[ai][bj][m][n] * gt; uint2 w; w.x = pg8::cvt_pk_bf16(v[0], v[1]); w.y = pg8::cvt_pk_bf16(v[2], v[3]); *(uint2*)(dst + bj * 128 + n * 16) = w; }
                }
            }
    }
};

__device__ __forceinline__ void p9_moe1(const Frame& F, unsigned char* lds_raw, LAS unsigned char* stage) {
    const MoeTabs T = moe_tabs(lds_raw);
    moe_units<4>(F, T);
    MoeOrder<4, 2> S{(const char*)(F.ws + WS_X1B), (const char*)(F.ws + WS_W1T), T.pst, T.ust, T.rowtok, F.G, F.bid, DM, DM, 1024};
    { const int* tokl = (const int*)(F.ws + WS_TOKL); pg8::Unit u;
      for (int i = 0; i < 4 && S.next(i, u); ++i) { if (F.tid < 256) { const int slot = u.pm * 256 + F.tid; T.rowtok[i * 256 + F.tid] = slot < T.cnts[u.e] ? tokl[u.e * 8192 + slot] : -1; } } }
    asm volatile("s_waitcnt vmcnt(0) lgkmcnt(0)" ::: "memory");
    __syncthreads();
    EpiMoe1 E{T.cnts, T.pst, T.rowtok, (const float*)(F.ws + WS_RSTD2), (bf16_t*)(F.ws + WS_ACT)};
    pg8::gemm_phase<EpiMoe1, MoeOrder<4, 2>, true>(stage, DM, DM, DM, S, E);
}

__device__ __forceinline__ void p10_moe2(const Frame& F, unsigned char* lds_raw, LAS unsigned char* stage) {
    const MoeTabs T = moe_tabs(lds_raw);
    moe_units<8>(F, T);
    MoeOrder<8, 3> S{(const char*)(F.ws + WS_ACT), (const char*)(F.ws + WS_W2T), T.pst, T.ust, nullptr, F.G, F.bid, FF, FF, 2048};
    EpiMoe2 E{T.cnts, T.pst, (const float*)(F.ws + WS_GATEL), (bf16_t*)(F.ws + WS_Y)};
    pg8::gemm_phase<EpiMoe2, MoeOrder<8, 3>, false>(stage, FF, FF, FF, S, E);
}

__device__ __forceinline__ void p11_final(const Frame& F, int dummy) {
    int* cnts = (int*)(F.lds + 3072); int* pst = cnts + 32;
    moe_counts(F, cnts, pst);
    const bf16_t* y = (const bf16_t*)(F.ws + WS_Y); const int* arow = (const int*)(F.ws + WS_AROW); const float* lnf = F.in[I_LNFINAL];
    const int gw = F.bid * NWAVES + F.wave, nw = F.G * NWAVES, lane = F.lane;
    for (int r = gw; r < NT; r += nw) {
        const int a0 = arow[2 * r], a1 = arow[2 * r + 1];
        const size_t r0 = (size_t)(pst[a0 >> 13] + (a0 & 8191)), r1 = (size_t)(pst[a1 >> 13] + (a1 & 8191));
        float v[32]; float ss = 0.f;
#pragma unroll
        for (int i = 0; i < 8; ++i) { const int c = i * 256 + lane * 4; const float4 xv = *(const float4*)(F.out + (size_t)r * DM + c);
            const uint2 ya = *(const uint2*)(y + r0 * DM + c), yb = *(const uint2*)(y + r1 * DM + c);
            v[4 * i]     = xv.x + __uint_as_float(ya.x << 16) + __uint_as_float(yb.x << 16);
            v[4 * i + 1] = xv.y + __uint_as_float(ya.x & 0xFFFF0000u) + __uint_as_float(yb.x & 0xFFFF0000u);
            v[4 * i + 2] = xv.z + __uint_as_float(ya.y << 16) + __uint_as_float(yb.y << 16);
            v[4 * i + 3] = xv.w + __uint_as_float(ya.y & 0xFFFF0000u) + __uint_as_float(yb.y & 0xFFFF0000u);
            ss += v[4 * i] * v[4 * i] + v[4 * i + 1] * v[4 * i + 1] + v[4 * i + 2] * v[4 * i + 2] + v[4 * i + 3] * v[4 * i + 3]; }
        ss = wave_sum(ss);
        const float rs = rsqrtf(ss * (1.f / DM) + EPS);
#pragma unroll
        for (int i = 0; i < 8; ++i) { const int c = i * 256 + lane * 4; const float4 g = *(const float4*)(lnf + c);
            float4 o; o.x = v[4 * i] * rs * g.x; o.y = v[4 * i + 1] * rs * g.y; o.z = v[4 * i + 2] * rs * g.z; o.w = v[4 * i + 3] * rs * g.w;
            *(float4*)((dummy ? (float*)(F.ws + WS_W1T) : F.out) + (size_t)r * DM + c) = o; }
    }
}

constexpr int NPHASE = 11;
__global__ void __launch_bounds__(NTHREADS, 2) fwd(Args args) {
    extern __shared__ __attribute__((aligned(16))) unsigned char lds_raw[];
    Frame F;
#pragma unroll
    for (int i = 0; i < N_IN; ++i) F.in[i] = args.in[i];
    F.out = args.out; F.ws = args.ws;
    F.lds = (float*)(lds_raw + 16);
    F.tid = threadIdx.x; F.lane = F.tid & 63; F.wave = __builtin_amdgcn_readfirstlane(F.tid >> 6); F.G = gridDim.x; F.bid = blockIdx.x;
    if (F.tid < 4) ((LAS unsigned*)lds_raw)[F.tid] = 0u;
    __syncthreads();
    XcdBarrier bar; bar.bar = (unsigned*)(F.ws + WS_CTL); bar.x = 0; bar.st = nullptr;
    if (N_LAUNCHES == 1) bar = xcd_barrier_post((unsigned*)(F.ws + WS_CTL), (volatile LAS unsigned*)lds_raw);
    const int lo = args.ph_lo, hi = args.ph_hi;
#ifndef ONLY_PHASE
#define ONLY_PHASE -1
#endif
#define IN(k) (lo <= (k) && (k) < hi && (ONLY_PHASE < 0 || ONLY_PHASE == (k)))
#define SEAM(k) do { if (IN(k) && IN((k) + 1)) { xcd_barrier(bar); if (PROBE_REPEAT == 12) xcd_barrier(bar); } } while (0)
    LAS unsigned char* stage = (LAS unsigned char*)lds_raw + 1024;
#define RUN(k, ...) do { if (IN(k)) { __VA_ARGS__; if (PROBE_REPEAT == (k)) { xcd_barrier(bar); __VA_ARGS__; } } } while (0)
    RUN(0, p0_prologue(F));
    if (PROBE_REPEAT == 11 && IN(0)) { xcd_barrier(bar); cvt_stream(F, 0, 6400, nullptr); }
    SEAM(0);
    RUN(1, p1_proj(F, stage));
    SEAM(1);
    if (IN(2)) { p3_mid(F, stage, 0); if (PROBE_REPEAT == 2) { xcd_barrier(bar); p3_mid(F, stage, 1); } }
    SEAM(2);
    RUN(3, p4_cmp2(F));
    SEAM(3);
    if (IN(4)) {
#pragma unroll 1
        for (int rep = 0; rep < (PROBE_REPEAT == 4 ? 2 : 1); ++rep) { if (rep) xcd_barrier(bar); p_attn(F, lds_raw, rep); } }
    SEAM(4);
    RUN(5, p6_mix(F));
    SEAM(5);
    RUN(6, p7_out(F, stage));
    SEAM(6);
    if (IN(7)) { if (PROBE_REPEAT == 7) { p8_router(F, 1); xcd_barrier(bar); } p8_router(F, 0); }
    SEAM(7);
    RUN(8, p9_moe1(F, lds_raw, stage));
    SEAM(8);
    RUN(9, p10_moe2(F, lds_raw, stage));
    SEAM(9);
    if (IN(10)) { if (PROBE_REPEAT == 10) { p11_final(F, 1); xcd_barrier(bar); } p11_final(F, 0); }
#undef RUN
#undef IN
#undef SEAM
}

extern "C" void kernel_launch(void* const* d_in, const int* in_sizes, int n_in, void* d_out, int out_size, void* d_ws, size_t ws_size, hipStream_t stream) {
    static int grid = 0;
    if (grid == 0) {
        if (n_in != N_IN || out_size != NT * DM || ws_size < WS_END) { fprintf(stderr, "kernel_launch: unexpected shapes: n_in %d out %d ws %zu (need %zu)\n", n_in, out_size, ws_size, (size_t)WS_END); grid = -1; return; }
        int dev = 0, cus = 0, per_cu = 0;
        if (hipGetDevice(&dev) != hipSuccess || hipDeviceGetAttribute(&cus, hipDeviceAttributeMultiprocessorCount, dev) != hipSuccess) { grid = -1; return; }
        if (hipFuncSetAttribute((const void*)fwd, hipFuncAttributeMaxDynamicSharedMemorySize, LDS_BYTES) != hipSuccess) { fprintf(stderr, "kernel_launch: hipFuncSetAttribute failed\n"); grid = -1; return; }
        if (hipOccupancyMaxActiveBlocksPerMultiprocessor(&per_cu, (const void*)fwd, NTHREADS, LDS_BYTES) != hipSuccess || per_cu < 1) { fprintf(stderr, "kernel_launch: occupancy query says %d\n", per_cu); }
        (void)hipGetLastError();
        grid = cus;
    }
    if (grid < 0) return;
    (void)in_sizes;
    (void)hipMemsetAsync((char*)d_ws + WS_CTL, 0, CTL_ZERO_BYTES, stream);
    Args a{};
    for (int i = 0; i < N_IN; ++i) a.in[i] = (const float*)d_in[i];
    a.out = (float*)d_out; a.ws = (unsigned char*)d_ws;
    if (N_LAUNCHES == 1) { a.ph_lo = 0; a.ph_hi = NPHASE; hipLaunchKernelGGL(fwd, dim3(grid), dim3(NTHREADS), LDS_BYTES, stream, a); }
    else { for (int p = 0; p < NPHASE; ++p) { a.ph_lo = p; a.ph_hi = p + 1; hipLaunchKernelGGL(fwd, dim3(grid), dim3(NTHREADS), LDS_BYTES, stream, a); } }
}
```

```cpp
#include <hip/hip_runtime.h>
#include <cstdio>
#include <cstdint>

#ifndef PROBE_REPEAT
#define PROBE_REPEAT -1
#endif
#ifndef N_LAUNCHES
#define N_LAUNCHES 1
#endif

#define XB_TMO      128
#define XB_XCNT(j)  (256  + 64 * (j))
#define XB_XSUB(j)  (1280 + 64 * (j))
#define XB_XGEN(j)  (2304 + 64 * (j))
#define XB_TOP      3328
#define XB_TOPGEN   3392
#define XCD_BAR_WORDS 3456
#define XB_SPIN_CAP (1u << 21)
#define LAS __attribute__((address_space(3)))

__device__ __forceinline__ unsigned xb_ld(unsigned* p)              { return __hip_atomic_load(p, __ATOMIC_RELAXED, __HIP_MEMORY_SCOPE_AGENT); }
__device__ __forceinline__ unsigned xb_add(unsigned* p, unsigned v) { return __hip_atomic_fetch_add(p, v, __ATOMIC_RELAXED, __HIP_MEMORY_SCOPE_AGENT); }
__device__ __forceinline__ unsigned xb_xcc_id() { return (unsigned)__builtin_amdgcn_s_getreg((3 << 11) | 20) & 0xFu; }
#define XB_SPIN(cond, bar) do { unsigned _sp = 0; while (cond) { __builtin_amdgcn_s_sleep(1); \
    if ((++_sp & 255u) == 0u) { if (xb_ld(&(bar)[XB_TMO])) break; if (_sp > XB_SPIN_CAP) { atomicAdd(&(bar)[XB_TMO], 1u); break; } } } } while (0)

struct XcdBarrier { unsigned* bar; unsigned x; volatile LAS unsigned* st; };

__device__ __forceinline__ XcdBarrier xcd_barrier_post(unsigned* bar, volatile LAS unsigned* st) {
    XcdBarrier b; b.bar = bar; b.x = xb_xcc_id(); b.st = st;
    if (threadIdx.x == 0) (void)xb_add(&bar[XB_XCNT(b.x)], 1u);
    return b;
}
__device__ __forceinline__ void xcd_barrier_complete(unsigned* bar, unsigned x, unsigned& nloc, unsigned& nx) {
    const unsigned G = gridDim.x * gridDim.y * gridDim.z;
    unsigned sum, cnt, mine, sp = 0u;
    for (;;) {
        sum = 0u; cnt = 0u; mine = 0u;
#pragma unroll
        for (unsigned j = 0; j < 16; ++j) { const unsigned c = xb_ld(&bar[XB_XCNT(j)]); sum += c; cnt += (c > 0u) ? 1u : 0u; mine = (j == x) ? c : mine; }
        if (sum == G) break;
        __builtin_amdgcn_s_sleep(1);
        if ((++sp & 255u) == 0u) { if (xb_ld(&bar[XB_TMO])) break; if (sp > XB_SPIN_CAP) { atomicAdd(&bar[XB_TMO], 1u); break; } }
    }
    nloc = mine > 0u ? mine : 1u; nx = cnt > 0u ? cnt : 1u;
}
__device__ __forceinline__ void xcd_barrier(const XcdBarrier& b) {
    asm volatile("s_waitcnt vmcnt(0)" ::: "memory");
    __syncthreads();
    if (threadIdx.x == 0) {
        unsigned* bar = b.bar;
        __builtin_amdgcn_s_waitcnt(0);
        unsigned nloc = b.st[0], nx = b.st[1];
        if (nloc == 0u) { xcd_barrier_complete(bar, b.x, nloc, nx); b.st[0] = nloc; b.st[1] = nx; }
        const unsigned old = xb_add(&bar[XB_XSUB(b.x)], 1u);
        const unsigned gen = old / nloc;
        if (old + 1u == (gen + 1u) * nloc) {
            __builtin_amdgcn_fence(__ATOMIC_RELEASE, "agent");
            asm volatile("s_waitcnt vmcnt(0)" ::: "memory");
            const unsigned og = xb_add(&bar[XB_TOP], 1u);
            const unsigned tg = og / nx;
            if (og + 1u == (tg + 1u) * nx) xb_add(&bar[XB_TOPGEN], 1u);
            else XB_SPIN(xb_ld(&bar[XB_TOPGEN]) == tg, bar);
            __builtin_amdgcn_fence(__ATOMIC_ACQUIRE, "agent");
            xb_add(&bar[XB_XGEN(b.x)], 1u);
            asm volatile("s_waitcnt vmcnt(0)" ::: "memory");
        } else {
            XB_SPIN(xb_ld(&bar[XB_XGEN(b.x)]) == gen, bar);
            __builtin_amdgcn_fence(__ATOMIC_ACQUIRE, "agent");
            asm volatile("s_waitcnt vmcnt(0)" ::: "memory");
        }
    }
    __syncthreads();
}

typedef unsigned short bf16_t;
constexpr int NB = 4, SEQ = 2048, DM = 2048, NT = NB * SEQ;
constexpr int NH = 8, NG = 2, HD = 128, INW = 3608, INWP = 3840;
constexpr int NCMP = 127, NSEL = 32, NEXP = 32, FF = 512;
constexpr float EPS = 1e-6f;
constexpr float SCALE = 0.08838834764831845f;
constexpr int NTHREADS = 512, NWAVES = 8;
constexpr int LDS_BYTES = 147456;
constexpr int YROWS = 24576;

enum { I_X = 0, I_POS, I_LNMIX, I_WIN, I_PEK, I_WK1, I_WK2, I_PEV, I_WV1, I_WV2, I_WPOOL, I_BPOOL, I_PSCALE, I_GNNSA, I_GNPOOL, I_WOUT, I_LNMOE,
       I_WRG, I_BRG, I_WRE, I_BRE, I_WGATE, I_WUP, I_WDOWN, I_LNFINAL, N_IN };

constexpr size_t MB = 1024 * 1024;
constexpr size_t WS_CTL   = 0;
constexpr size_t CTL_ZERO_BYTES = 65536;
constexpr int    CW_CNT   = 4096;
constexpr size_t WS_RSTD1 = 1 * MB;
constexpr size_t WS_RSTD2 = 1 * MB + 65536;
constexpr size_t WS_BIAS1 = 1 * MB + 131072;
constexpr size_t WS_AROW  = 1 * MB + 262144;
constexpr size_t WS_WR    = 1 * MB + 393216;
constexpr size_t WS_WG4   = 1 * MB + 655360;
constexpr size_t WS_ROPEC = 2 * MB;
constexpr size_t WS_ROPES = 2 * MB + 524288;
constexpr size_t WS_GATES = 3 * MB;
constexpr size_t WS_TOKL  = 4 * MB;
constexpr size_t WS_GATEL = 5 * MB;
constexpr size_t WS_HID   = 6 * MB;
constexpr size_t WS_CMPKV = 8 * MB;
constexpr size_t WS_WINT  = 9 * MB;
constexpr size_t WS_WOUTT = 24 * MB;
constexpr size_t WS_W1T   = 32 * MB;
constexpr size_t WS_W2T   = 160 * MB;
constexpr size_t WS_CMPW  = 224 * MB;
constexpr size_t WS_POOLW = 228 * MB;
constexpr size_t WS_POOLB = 228 * MB + 524288;
constexpr size_t WS_CPART = 447 * MB;
constexpr size_t WS_DBUF  = 463 * MB;
constexpr size_t WS_XB    = 230 * MB;
constexpr size_t WS_QN    = 262 * MB;
constexpr size_t WS_QR    = 278 * MB;
constexpr size_t WS_KV    = 294 * MB;
constexpr size_t WS_U     = 319 * MB;
constexpr size_t WS_Y     = 230 * MB;
constexpr size_t WS_OWIN  = 351 * MB;
constexpr size_t WS_OCMP  = 367 * MB;
constexpr size_t WS_OSEL  = 319 * MB;
constexpr size_t WS_ML    = 6 * MB;
constexpr size_t WS_X1B   = 351 * MB;
constexpr size_t WS_OPOOL = 383 * MB;
constexpr size_t WS_ACT   = 383 * MB;
constexpr size_t WS_MIX   = 415 * MB;
constexpr size_t WS_END   = 479 * MB;

__device__ __forceinline__ bf16_t f2bf(float f) { unsigned u = __float_as_uint(f); u += 0x7FFFu + ((u >> 16) & 1u); return (bf16_t)(u >> 16); }
__device__ __forceinline__ float bf2f(bf16_t b) { return __uint_as_float(((unsigned)b) << 16); }
__device__ __forceinline__ float wave_sum(float v) {
#pragma unroll
    for (int o = 32; o >= 1; o >>= 1) v += __shfl_xor(v, o);
    return v;
}
__device__ __forceinline__ float wave_max(float v) {
#pragma unroll
    for (int o = 32; o >= 1; o >>= 1) v = fmaxf(v, __shfl_xor(v, o));
    return v;
}

struct Args { const float* in[N_IN]; float* out; unsigned char* ws; int ph_lo, ph_hi; };

struct Frame {
    const float* in[N_IN]; float* out; unsigned char* ws;
    float* lds;
    int tid, lane, wave, G, bid;
};

template <int NACC, bool B_KFAST, class FA, class FB, class FE>
__device__ __forceinline__ void ngemm_tile(const Frame& F, int K, FA fa, FB fb, FE fe) {
    float* As = F.lds;
    float* Bs = F.lds + 1024;
    const int tid = F.tid, ty = tid >> 4, tx = tid & 15;
    float acc[NACC][2][4];
#pragma unroll
    for (int w = 0; w < NACC; ++w)
#pragma unroll
        for (int i = 0; i < 2; ++i)
#pragma unroll
            for (int j = 0; j < 4; ++j) acc[w][i][j] = 0.f;
    for (int k0 = 0; k0 < K; k0 += 16) {
#pragma unroll
        for (int i = 0; i < 2; ++i) { const int idx = tid + 512 * i, m = idx >> 4, kk = idx & 15; As[kk * 64 + m] = fa(m, k0 + kk); }
#pragma unroll
        for (int w = 0; w < NACC; ++w)
#pragma unroll
            for (int i = 0; i < 2; ++i) { const int idx = tid + 512 * i; int kk, n; if (B_KFAST) { n = idx >> 4; kk = idx & 15; } else { kk = idx >> 6; n = idx & 63; }
                Bs[w * 1024 + kk * 64 + n] = fb(w, k0 + kk, n); }
        __syncthreads();
#pragma unroll
        for (int kk = 0; kk < 16; ++kk) {
            const float a0 = As[kk * 64 + 2 * ty], a1 = As[kk * 64 + 2 * ty + 1];
#pragma unroll
            for (int w = 0; w < NACC; ++w) {
                const float4 b = *(const float4*)&Bs[w * 1024 + kk * 64 + 4 * tx];
                acc[w][0][0] += a0 * b.x; acc[w][0][1] += a0 * b.y; acc[w][0][2] += a0 * b.z; acc[w][0][3] += a0 * b.w;
                acc[w][1][0] += a1 * b.x; acc[w][1][1] += a1 * b.y; acc[w][1][2] += a1 * b.z; acc[w][1][3] += a1 * b.w;
            }
        }
        __syncthreads();
    }
#pragma unroll
    for (int i = 0; i < 2; ++i)
#pragma unroll
        for (int j = 0; j < 4; ++j) fe(2 * ty + i, 4 * tx + j, acc[0][i][j], acc[NACC - 1][i][j]);
}

template <class KR>
__device__ __forceinline__ void nattn(const float* qv, float* sc, int nkeys, KR keyrow, const bf16_t* Kb, const bf16_t* Vb, int lane, float& o0, float& o1, float& inv_sum) {
    float mx = -3.0e38f;
    for (int i = lane; i < nkeys; i += 64) {
        const int kr = keyrow(i);
        float s = -3.0e38f;
        if (kr >= 0) {
            const bf16_t* kp = Kb + (size_t)kr * HD;
            float a = 0.f;
#pragma unroll 8
            for (int d = 0; d < HD; d += 2) { const unsigned w = *(const unsigned*)(kp + d); a += qv[d] * __uint_as_float(w << 16) + qv[d + 1] * __uint_as_float(w & 0xFFFF0000u); }
            s = a * SCALE;
        }
        sc[i] = s; mx = fmaxf(mx, s);
    }
    mx = wave_max(mx);
    if (mx < -1.0e38f) { o0 = 0.f; o1 = 0.f; inv_sum = 0.f; for (int i = lane; i < nkeys; i += 64) sc[i] = 0.f; return; }
    float sum = 0.f;
    for (int i = lane; i < nkeys; i += 64) { const float s = sc[i]; const float e = (s < -1.0e38f) ? 0.f : __expf(s - mx); sc[i] = e; sum += e; }
    sum = wave_sum(sum);
    inv_sum = 1.f / sum;
    float a0 = 0.f, a1 = 0.f;
    for (int i = 0; i < nkeys; ++i) {
        const float p = sc[i];
        if (p != 0.f) { const int kr = keyrow(i); const bf16_t* vp = Vb + (size_t)kr * HD; a0 += p * bf2f(vp[lane]); a1 += p * bf2f(vp[lane + 64]); }
    }
    o0 = a0 * inv_sum; o1 = a1 * inv_sum;
}

__device__ __forceinline__ float gelu_tanh(float x) { const float u = 0.7978845608028654f * (x + 0.044715f * x * x * x); return 0.5f * x * (1.f + tanhf(u)); }


namespace pg8 {
typedef short bf16x8 __attribute__((ext_vector_type(8)));
typedef float f32x4 __attribute__((ext_vector_type(4)));
typedef unsigned u32x4 __attribute__((ext_vector_type(4)));
constexpr int BM = 256, BK = 64, HALF = 128, HTB = HALF * BK * 2, STAGE_BYTES = 8 * HTB, NXCD = 8, WGM = 8;
__device__ __forceinline__ int lds_byte(int r, int c) { const int st = (r >> 4) * 2 + (c >> 5), rr = r & 15, cc = c & 31, ob = rr * 64 + cc * 2; return st * 1024 + (ob ^ (((ob >> 9) & 1) << 5)); }
__device__ __forceinline__ void stage_rc(int b, int& R, int& C) { const int st = b / 1024, sb = b % 1024, swz = sb ^ (((sb >> 9) & 1) << 5); R = (st >> 1) * 16 + swz / 64; C = (st & 1) * 32 + (swz % 64) / 2; }
struct Unit { int pm, pn, e, li; };
__device__ __forceinline__ unsigned cvt_pk_bf16(float lo, float hi) { unsigned r; asm volatile("v_cvt_pk_bf16_f32 %0, %1, %2" : "=v"(r) : "v"(lo), "v"(hi)); return r; }

struct DenseOrder {
    const char* A; const char* Bt; int lda, ldb; int nM, nN, nwg, G, c;
    __device__ void init(const void* A_, const void* Bt_, int lda_, int ldb_, int M, int N, int G_, int c_) { A = (const char*)A_; Bt = (const char*)Bt_; lda = lda_; ldb = ldb_; nM = M / BM; nN = N / BM; nwg = nM * nN; G = G_; c = c_; }
    __device__ __forceinline__ bool next(int i, Unit& u) const {
        const long L = (long)i * G + c; if (L >= nwg) return false;
        int wgid = (int)L; { const int q = nwg / NXCD, r = nwg % NXCD, xcd = wgid % NXCD, off = wgid / NXCD; wgid = (xcd < r ? xcd * (q + 1) : r * (q + 1) + (xcd - r) * q) + off; }
        const int nig = WGM * nN, gid = wgid / nig, fm = gid * WGM, gsz = (nM - fm) < WGM ? (nM - fm) : WGM;
        u.pm = fm + ((wgid % nig) % gsz); u.pn = (wgid % nig) / gsz; u.e = 0; u.li = i; return true;
    }
    __device__ __forceinline__ const char* a_base(const Unit& u) const { return A + (size_t)u.pm * BM * lda * 2; }
    __device__ __forceinline__ const char* b_base(const Unit& u) const { return Bt + (size_t)u.pn * BM * ldb * 2; }
    __device__ __forceinline__ unsigned a_row_off(const Unit&, int r) const { return (unsigned)r * (unsigned)lda * 2u; }
};

template <class Epi, class Sched, bool GATHER>
__device__ __forceinline__ void gemm_phase(LAS unsigned char* lds, const int K, const int lda, const int ldb, const Sched& S, const Epi& E) {
    const int tid = threadIdx.x, wid = __builtin_amdgcn_readfirstlane(tid >> 6), lane = tid & 63, wr = wid >> 2, wc = wid & 3, fr = lane & 15, fq = lane >> 4;
    const int nt = K / BK;
    int sR[2], sC[2];
#pragma unroll
    for (int i = 0; i < 2; ++i) stage_rc(tid * 16 + i * 8192, sR[i], sC[i]);
    unsigned voffB[2], voffA[2][2], nvoffA[2][2];
#pragma unroll
    for (int i = 0; i < 2; ++i) voffB[i] = (unsigned)(sR[i] * ldb + sC[i]) * 2u;
    const size_t kstep = (size_t)(BK * 2);
    const size_t hstepB = (size_t)HALF * ldb * 2;
    const unsigned ldsw = (unsigned)wid * 1024u;
    const int aoff = lds_byte(wr * 64 + fr, fq * 8), boff = lds_byte(wc * 32 + fr, fq * 8);
#define PG8_SA(b, h) (((b) * 2 + (h)) * HTB)
#define PG8_SB(b, h) ((4 + (b) * 2 + (h)) * HTB)
#define PG8_STAGE(bufoff, gbase, voff) do { _Pragma("unroll") for (int _i = 0; _i < 2; ++_i) \
        __builtin_amdgcn_global_load_lds((const unsigned*)((const char*)(gbase) + (voff)[_i]), (LAS unsigned*)(lds + (bufoff) + ldsw + _i * 8192), 16, 0, 0); } while (0)
#define PG8_LDA(dst, b, h) do { _Pragma("unroll") for (int m = 0; m < 4; ++m) _Pragma("unroll") for (int k = 0; k < 2; ++k) dst[m][k] = *(const LAS bf16x8*)(lds + PG8_SA(b, h) + aoff + m * 2048 + k * 1024); } while (0)
#define PG8_LDB(dst, b, h) do { _Pragma("unroll") for (int n = 0; n < 2; ++n) _Pragma("unroll") for (int k = 0; k < 2; ++k) dst[n][k] = *(const LAS bf16x8*)(lds + PG8_SB(b, h) + boff + n * 2048 + k * 1024); } while (0)
#define PG8_MMA(ai, bj, At, Bt) do { __builtin_amdgcn_s_setprio(1); _Pragma("unroll") for (int m = 0; m < 4; ++m) _Pragma("unroll") for (int n = 0; n < 2; ++n) _Pragma("unroll") for (int k = 0; k < 2; ++k) \
        acc[ai][bj][m][n] = __builtin_amdgcn_mfma_f32_16x16x32_bf16(Bt[n][k], At[m][k], acc[ai][bj][m][n], 0, 0, 0); __builtin_amdgcn_s_setprio(0); } while (0)
#define PG8_WAIT_V(n) asm volatile("s_waitcnt vmcnt(" #n ")" ::: "memory")
#define PG8_WAIT_L(n) asm volatile("s_waitcnt lgkmcnt(" #n ")" ::: "memory")
#define PG8_BAR __builtin_amdgcn_s_barrier()
#define PG8_SCHED __builtin_amdgcn_sched_barrier(0)
#define PG8_AOFFS(dst, u) do { _Pragma("unroll") for (int _h = 0; _h < 2; ++_h) _Pragma("unroll") for (int _i = 0; _i < 2; ++_i) dst[_h][_i] = S.a_row_off(u, _h * HALF + sR[_i]) + (unsigned)sC[_i] * 2u; } while (0)
    Unit cur, nxt; int ui = 0;
    if (!S.next(0, cur)) return;
    f32x4 acc[2][2][4][2];
#pragma unroll
    for (int a = 0; a < 2; ++a)
#pragma unroll
        for (int b = 0; b < 2; ++b)
#pragma unroll
            for (int m = 0; m < 4; ++m)
#pragma unroll
                for (int n = 0; n < 2; ++n) acc[a][b][m][n] = (f32x4){0.f, 0.f, 0.f, 0.f};
    bf16x8 At[4][2], B0[2][2], B1[2][2];
    const char* cA = S.a_base(cur); const char* cB = S.b_base(cur);
    PG8_AOFFS(voffA, cur);
    PG8_STAGE(PG8_SB(0, 0), cB, voffB); PG8_STAGE(PG8_SA(0, 0), cA, voffA[0]); PG8_STAGE(PG8_SB(0, 1), cB + hstepB, voffB); PG8_STAGE(PG8_SA(0, 1), cA, voffA[1]);
    if (wr == 1) PG8_BAR;
    PG8_WAIT_V(4); PG8_BAR;
    PG8_STAGE(PG8_SB(1, 0), cB + kstep, voffB); PG8_STAGE(PG8_SA(1, 0), cA + kstep, voffA[0]); PG8_STAGE(PG8_SB(1, 1), cB + hstepB + kstep, voffB);
    PG8_WAIT_V(6); PG8_BAR;
    for (;;) {
        const bool has_next = S.next(ui + 1, nxt);
        const char* nA = has_next ? S.a_base(nxt) : cA; const char* nB = has_next ? S.b_base(nxt) : cB;
        if (GATHER) { if (has_next) { PG8_AOFFS(nvoffA, nxt); } else {
#pragma unroll
            for (int _h = 0; _h < 2; ++_h)
#pragma unroll
                for (int _i = 0; _i < 2; ++_i) nvoffA[_h][_i] = voffA[_h][_i]; } }
        for (int t = 0; t < nt; t += 2) {
            const bool last = (t == nt - 2);
            const char* a1 = cA + (size_t)(t + 1) * kstep;
            const char* a2 = last ? nA : cA + (size_t)(t + 2) * kstep; const char* b2 = last ? nB : cB + (size_t)(t + 2) * kstep;
            const char* a3 = a2 + kstep; const char* b3 = b2 + kstep;
            unsigned vA2[2][2];
#pragma unroll
            for (int _h = 0; _h < 2; ++_h)
#pragma unroll
                for (int _i = 0; _i < 2; ++_i) vA2[_h][_i] = (GATHER && last) ? nvoffA[_h][_i] : voffA[_h][_i];
            PG8_LDB(B0, 0, 0); PG8_SCHED; PG8_LDA(At, 0, 0); PG8_STAGE(PG8_SA(1, 1), a1, voffA[1]);
            PG8_WAIT_L(8); PG8_BAR; PG8_WAIT_L(0); PG8_MMA(0, 0, At, B0); PG8_BAR; PG8_SCHED;
            PG8_LDB(B1, 0, 1); PG8_STAGE(PG8_SB(0, 0), b2, voffB);
            PG8_BAR; PG8_WAIT_L(0); PG8_MMA(0, 1, At, B1); PG8_BAR;
            PG8_LDA(At, 0, 1); PG8_STAGE(PG8_SA(0, 0), a2, vA2[0]);
            PG8_BAR; PG8_WAIT_L(0); PG8_MMA(1, 0, At, B0); PG8_BAR; PG8_SCHED;
            PG8_STAGE(PG8_SB(0, 1), b2 + hstepB, voffB);
            PG8_WAIT_V(6); PG8_BAR; PG8_MMA(1, 1, At, B1); PG8_BAR;
            PG8_LDB(B0, 1, 0); PG8_SCHED; PG8_LDA(At, 1, 0); PG8_STAGE(PG8_SA(0, 1), a2, vA2[1]);
            PG8_WAIT_L(8); PG8_BAR; PG8_WAIT_L(0); PG8_MMA(0, 0, At, B0); PG8_BAR; PG8_SCHED;
            PG8_LDB(B1, 1, 1); PG8_STAGE(PG8_SB(1, 0), b3, voffB);
            PG8_BAR; PG8_WAIT_L(0); PG8_MMA(0, 1, At, B1); PG8_BAR;
            PG8_LDA(At, 1, 1); PG8_STAGE(PG8_SA(1, 0), a3, vA2[0]);
            PG8_BAR; PG8_WAIT_L(0); PG8_MMA(1, 0, At, B0); PG8_BAR; PG8_SCHED;
            PG8_STAGE(PG8_SB(1, 1), b3 + hstepB, voffB);
            PG8_WAIT_V(6); PG8_BAR; PG8_MMA(1, 1, At, B1); PG8_BAR;
        }
        E(acc, cur, wr, wc, fr, fq);
        if (!has_next) break;
#pragma unroll
        for (int a = 0; a < 2; ++a)
#pragma unroll
            for (int b = 0; b < 2; ++b)
#pragma unroll
                for (int m = 0; m < 4; ++m)
#pragma unroll
                    for (int n = 0; n < 2; ++n) acc[a][b][m][n] = (f32x4){0.f, 0.f, 0.f, 0.f};
        cur = nxt; cA = nA; cB = nB; ++ui;
        if (GATHER) {
#pragma unroll
            for (int _h = 0; _h < 2; ++_h)
#pragma unroll
                for (int _i = 0; _i < 2; ++_i) voffA[_h][_i] = nvoffA[_h][_i]; }
    }
    PG8_WAIT_V(0);
    if (wr == 0) PG8_BAR;
    PG8_BAR;
#undef PG8_SA
#undef PG8_SB
#undef PG8_STAGE
#undef PG8_LDA
#undef PG8_LDB
#undef PG8_MMA
#undef PG8_WAIT_V
#undef PG8_WAIT_L
#undef PG8_BAR
#undef PG8_SCHED
#undef PG8_AOFFS
}
}


namespace g2 {
using pg8::bf16x8; using pg8::f32x4; using pg8::lds_byte; using pg8::cvt_pk_bf16;
typedef short s16x4 __attribute__((ext_vector_type(4)));
constexpr int A_BYTES = 32768, B_BYTES = 16384, STG = A_BYTES + B_BYTES;
struct Unit { int e, pm, pn, li; };
template <class Epi, class Sched>
__device__ __forceinline__ void gemm(LAS unsigned char* lds, const int K, const Sched& S, const Epi& E) {
#if defined(__HIP_DEVICE_COMPILE__)
    const int tid = threadIdx.x, wid = __builtin_amdgcn_readfirstlane(tid >> 6), lane = tid & 63, wr = wid >> 2, wc = wid & 3, fr = lane & 15, fq = lane >> 4;
    const int nt = K / 64;
    int awoff[4];
#pragma unroll
    for (int j = 0; j < 4; ++j) { const int id = tid + 512 * j, row = id >> 3, ch = id & 7; awoff[j] = (row >> 7) * 16384 + lds_byte(row & 127, ch * 8); }
    const int bkr = tid >> 5, bnq = tid & 31;
    int bwoff[4];
#pragma unroll
    for (int j = 0; j < 4; ++j) { const int kr = bkr + 16 * j, f = (kr & 3) | (((kr >> 3) & 1) << 2), c = bnq >> 2; bwoff[j] = A_BYTES + kr * 256 + ((c ^ f) * 32) + (bnq & 3) * 8; }
    const int aoff = lds_byte(wr * 64 + fr, fq * 8);
    int boff[2];
    { const int q = (lane >> 2) & 3, p = lane & 3, f = q | ((fq & 1) << 2);
#pragma unroll
      for (int n = 0; n < 2; ++n) boff[n] = A_BYTES + (8 * fq + q) * 256 + (((2 * wc + n) ^ f) * 32) + 8 * p; }
    const int ldsb = (int)(uintptr_t)lds;
    Unit u;
    for (int ui = 0; S.next(ui, u); ++ui) {
        const bf16_t* pa[4]; const float* pb;
#pragma unroll
        for (int j = 0; j < 4; ++j) { const int id = tid + 512 * j; pa[j] = S.a_row(u, id >> 3) + (id & 7) * 8; }
        pb = S.b_col(u, 4 * bnq) + (size_t)bkr * S.ldb;
        const size_t bstep = (size_t)16 * S.ldb;
        f32x4 acc[2][4][2];
#pragma unroll
        for (int a = 0; a < 2; ++a)
#pragma unroll
            for (int m = 0; m < 4; ++m)
#pragma unroll
                for (int n = 0; n < 2; ++n) acc[a][m][n] = (f32x4){0.f, 0.f, 0.f, 0.f};
        bf16x8 ra0[4], ra1[4]; f32x4 rb0[4], rb1[4];
#define G2_LOAD(RA, RB, t) do { _Pragma("unroll") for (int j = 0; j < 4; ++j) { RA[j] = *(const bf16x8*)(pa[j] + (size_t)(t) * 64); RB[j] = *(const f32x4*)(pb + (size_t)(t) * 64 * S.ldb + j * bstep); } } while (0)
#define G2_WRITE(st, RA, RB) do { _Pragma("unroll") for (int j = 0; j < 4; ++j) { *(LAS bf16x8*)(lds + (st) * STG + awoff[j]) = RA[j]; \
            uint2 w_; w_.x = cvt_pk_bf16(RB[j][0], RB[j][1]); w_.y = cvt_pk_bf16(RB[j][2], RB[j][3]); *(LAS uint2*)(lds + (st) * STG + bwoff[j]) = w_; } } while (0)
#define G2_TR(dst, n, imm) asm volatile("ds_read_b64_tr_b16 %0, %1 offset:%2" : "=&v"(dst) : "v"(ldsb + boff[n]), "i"(imm) : "memory")
#define G2_COMPUTE(st) do { \
        s16x4 b00l, b00h, b01l, b01h, b10l, b10h, b11l, b11h;        \
        G2_TR(b00l, 0, (st) * STG); G2_TR(b00h, 0, (st) * STG + 1024); G2_TR(b01l, 0, (st) * STG + 8192); G2_TR(b01h, 0, (st) * STG + 8192 + 1024); \
        G2_TR(b10l, 1, (st) * STG); G2_TR(b10h, 1, (st) * STG + 1024); G2_TR(b11l, 1, (st) * STG + 8192); G2_TR(b11h, 1, (st) * STG + 8192 + 1024); \
        bf16x8 At[2][4][2]; \
        _Pragma("unroll") for (int a = 0; a < 2; ++a) _Pragma("unroll") for (int m = 0; m < 4; ++m) _Pragma("unroll") for (int k = 0; k < 2; ++k) \
            At[a][m][k] = *(const LAS bf16x8*)(lds + (st) * STG + a * 16384 + aoff + m * 2048 + k * 1024); \
        asm volatile("s_waitcnt lgkmcnt(0)" ::: "memory"); __builtin_amdgcn_sched_barrier(0); \
        const bf16x8 B00 = {b00l[0], b00l[1], b00l[2], b00l[3], b00h[0], b00h[1], b00h[2], b00h[3]}, B01 = {b01l[0], b01l[1], b01l[2], b01l[3], b01h[0], b01h[1], b01h[2], b01h[3]}; \
        const bf16x8 B10 = {b10l[0], b10l[1], b10l[2], b10l[3], b10h[0], b10h[1], b10h[2], b10h[3]}, B11 = {b11l[0], b11l[1], b11l[2], b11l[3], b11h[0], b11h[1], b11h[2], b11h[3]}; \
        __builtin_amdgcn_s_setprio(1); \
        _Pragma("unroll") for (int a = 0; a < 2; ++a) _Pragma("unroll") for (int m = 0; m < 4; ++m) { \
            acc[a][m][0] = __builtin_amdgcn_mfma_f32_16x16x32_bf16(B00, At[a][m][0], acc[a][m][0], 0, 0, 0); acc[a][m][0] = __builtin_amdgcn_mfma_f32_16x16x32_bf16(B01, At[a][m][1], acc[a][m][0], 0, 0, 0); \
            acc[a][m][1] = __builtin_amdgcn_mfma_f32_16x16x32_bf16(B10, At[a][m][0], acc[a][m][1], 0, 0, 0); acc[a][m][1] = __builtin_amdgcn_mfma_f32_16x16x32_bf16(B11, At[a][m][1], acc[a][m][1], 0, 0, 0); } \
        __builtin_amdgcn_s_setprio(0); } while (0)
        G2_LOAD(ra0, rb0, 0); G2_LOAD(ra1, rb1, 1);
        __syncthreads();
        G2_WRITE(0, ra0, rb0);
        if (nt > 2) G2_LOAD(ra0, rb0, 2);
        __syncthreads();
        for (int t = 0; t < nt; t += 2) {
            G2_COMPUTE(0);
            G2_WRITE(1, ra1, rb1);
            if (t + 3 < nt) G2_LOAD(ra1, rb1, t + 3);
            __syncthreads();
            G2_COMPUTE(1);
            if (t + 2 < nt) { G2_WRITE(0, ra0, rb0); if (t + 4 < nt) G2_LOAD(ra0, rb0, t + 4); }
            __syncthreads();
        }
        E(acc, u, wr, wc, fr, fq);
#undef G2_LOAD
#undef G2_WRITE
#undef G2_TR
#undef G2_COMPUTE
    }
#endif
}
}

__device__ __forceinline__ void transpose_tile(const Frame& F, const float* src, int lds_, bf16_t* dstrow0, int ldd, int k0, int n0, const float* kscale) {
    float* T = F.lds;
    const int tid = F.tid, kk = tid >> 4, n4 = (tid & 15) * 4;
#pragma unroll
    for (int i = 0; i < 2; ++i) { const int k = kk + 32 * i; float4 v = *(const float4*)(src + (size_t)(k0 + k) * lds_ + n0 + n4); const float sc = kscale ? kscale[k0 + k] : 1.f;
        T[(n4 + 0) * 65 + k] = v.x * sc; T[(n4 + 1) * 65 + k] = v.y * sc; T[(n4 + 2) * 65 + k] = v.z * sc; T[(n4 + 3) * 65 + k] = v.w * sc; }
    __syncthreads();
    { const int n = tid >> 3, k8 = (tid & 7) * 8; const float* t = T + n * 65 + k8;
      pg8::u32x4 w; w.x = pg8::cvt_pk_bf16(t[0], t[1]); w.y = pg8::cvt_pk_bf16(t[2], t[3]); w.z = pg8::cvt_pk_bf16(t[4], t[5]); w.w = pg8::cvt_pk_bf16(t[6], t[7]);
      *(pg8::u32x4*)(dstrow0 + (size_t)n * ldd + k0 + k8) = w; }
    __syncthreads();
}


namespace att {
typedef short bf16x8 __attribute__((ext_vector_type(8)));
typedef short s16x4 __attribute__((ext_vector_type(4)));
typedef float f32x16 __attribute__((ext_vector_type(16)));
typedef float f32x4 __attribute__((ext_vector_type(4)));
typedef unsigned u32x4 __attribute__((ext_vector_type(4)));
constexpr int SHM = 16384;
constexpr int L_V = 0, L_K = 2 * SHM, L_WS = 4 * SHM, L_PART = L_WS + 8 * 64 * 4, L_SELM = L_PART + 4 * 64 * 33 * 4, L_VALS = L_SELM + 256, L_ITEM = L_VALS + 8 * 64 * 4, L_END = L_ITEM + 16;
constexpr float C2 = 1.4426950408889634f * SCALE;
#define KSWZ(row, colB) ((row) * 256 + ((colB) ^ (((row) & 7) << 4)))
#define SBAR() __builtin_amdgcn_sched_barrier(0)
__device__ __forceinline__ int v_st(int k, int c) { const int kk = (k & ~0xC) | ((k & 4) << 1) | ((k & 8) >> 1); return ((kk >> 3) * 4 + (c >> 5)) * 512 + ((kk & 7) * 32 + (c & 31)) * 2; }
__device__ __forceinline__ int v_rd_base(int lane) { return ((lane & 3) << 3) | (((lane >> 2) & 3) << 6) | (((lane >> 4) & 1) << 5) | (((lane >> 5) & 1) << 8); }
constexpr int v_rd_off(int d0, int ks, int half) { return d0 * 512 + ks * 4096 + half * 2048; }
__device__ __forceinline__ int crow(int r, int hi) { return (r & 3) + 8 * (r >> 2) + 4 * hi; }
__device__ __forceinline__ unsigned cvtpk(float lo, float hi) { unsigned r; asm volatile("v_cvt_pk_bf16_f32 %0, %1, %2" : "=v"(r) : "v"(lo), "v"(hi)); return r; }
__device__ __forceinline__ float swap_max(float v) { auto rr = __builtin_amdgcn_permlane32_swap(__float_as_uint(v), __float_as_uint(v), false, false); return fmaxf(__uint_as_float(rr[0]), __uint_as_float(rr[1])); }
__device__ __forceinline__ float swap_sum(float v) { auto rr = __builtin_amdgcn_permlane32_swap(__float_as_uint(v), __float_as_uint(v), false, false); return __uint_as_float(rr[0]) + __uint_as_float(rr[1]); }

struct WV { int tid, wid, lane, r32, hi, vb0; unsigned ksrc[2], vsrc[2]; char* lds; LAS unsigned char* ldsL; };
__device__ __forceinline__ void wv_src_init(WV& w) {
#pragma unroll
    for (int i = 0; i < 2; ++i) {
        const int L = (w.wid * 2 + i) * 1024 + w.lane * 16;
        { const int row = L >> 8, colB = (L & 255) ^ ((row & 7) << 4); w.ksrc[i] = (unsigned)(row * 256 + colB); }
        { const int sub = L >> 9, kkhi = sub >> 2, cblk = sub & 3, within = L & 511, kklo = within >> 6, cc = (within >> 1) & 31;
          const int kk = kkhi * 8 + kklo, k = (kk & ~0xC) | ((kk & 4) << 1) | ((kk & 8) >> 1), c = cblk * 32 + cc; w.vsrc[i] = (unsigned)(k * 256 + c * 2); }
    }
}
__device__ __forceinline__ void dma_tile(const WV& w, const bf16_t* Kt, const bf16_t* Vt, int buf) {
    int ln = w.lane; asm volatile("" : "+v"(ln));
#pragma unroll
    for (int i = 0; i < 2; ++i) {
        const int L = (w.wid * 2 + i) * 1024 + ln * 16;
        const int row = L >> 8, colB = (L & 255) ^ ((row & 7) << 4); const unsigned ksrc = (unsigned)(row * 256 + colB);
        const int sub = L >> 9, kkhi = sub >> 2, cblk = sub & 3, within = L & 511, kklo = within >> 6, cc = (within >> 1) & 31;
        const int kk = kkhi * 8 + kklo, k = (kk & ~0xC) | ((kk & 4) << 1) | ((kk & 8) >> 1), c = cblk * 32 + cc; const unsigned vsrc = (unsigned)(k * 256 + c * 2);
        __builtin_amdgcn_global_load_lds((const unsigned*)((const char*)Vt + vsrc), (LAS unsigned*)(w.ldsL + L_V + buf * SHM + (w.wid * 2 + i) * 1024), 16, 0, 0);
        __builtin_amdgcn_global_load_lds((const unsigned*)((const char*)Kt + ksrc), (LAS unsigned*)(w.ldsL + L_K + buf * SHM + (w.wid * 2 + i) * 1024), 16, 0, 0);
    }
}
__device__ __forceinline__ void qkt(const WV& w, int buf, const bf16x8 (&qr)[8], f32x16& p0, f32x16& p1) {
    p0 = f32x16{}; p1 = f32x16{};
    const char* kb[4];
#pragma unroll
    for (int dd = 0; dd < 4; ++dd) kb[dd] = w.lds + L_K + buf * SHM + KSWZ(w.r32, (dd * 16 + w.hi * 8) * 2);
#pragma unroll
    for (int d0 = 0; d0 < 8; ++d0) { const char* a = kb[d0 & 3] + (d0 >> 2) * 128;
        const bf16x8 b0 = *reinterpret_cast<const bf16x8*>(a); const bf16x8 b1 = *reinterpret_cast<const bf16x8*>(a + 32 * 256);
        p0 = __builtin_amdgcn_mfma_f32_32x32x16_bf16(b0, qr[d0], p0, 0, 0, 0);
        p1 = __builtin_amdgcn_mfma_f32_32x32x16_bf16(b1, qr[d0], p1, 0, 0, 0);
        if (d0 == 3) SBAR(); }
}
__device__ __forceinline__ void pack_p(const f32x16& p0, const f32x16& p1, bf16x8& pa0, bf16x8& pa1, bf16x8& pa2, bf16x8& pa3) {
#define PK4(P, B_, OUT) do { unsigned a0 = cvtpk(P[B_+0], P[B_+1]), a1 = cvtpk(P[B_+2], P[B_+3]); unsigned b0 = cvtpk(P[B_+4], P[B_+5]), b1 = cvtpk(P[B_+6], P[B_+7]); \
        auto r0 = __builtin_amdgcn_permlane32_swap(a0, b0, false, false); auto r1 = __builtin_amdgcn_permlane32_swap(a1, b1, false, false); \
        u32x4 w_ = {r0[0], r1[0], r0[1], r1[1]}; OUT = *reinterpret_cast<bf16x8*>(&w_); } while (0)
    PK4(p0, 0, pa0); PK4(p0, 8, pa1); PK4(p1, 0, pa2); PK4(p1, 8, pa3);
#undef PK4
}
template <int VB>
__device__ __forceinline__ void pv_tile(f32x16* o, int vb0, bf16x8 pa0, bf16x8 pa1, bf16x8 pa2, bf16x8 pa3) {
#define TRRD(dst, off) asm volatile("ds_read_b64_tr_b16 %0, %1 offset:%2" : "=&v"(dst) : "v"(vb0), "i"(off) : "memory")
#define PV_D0(d0) do { s16x4 l0, l1, l2, l3, h0, h1, h2, h3; constexpr int b_ = L_V + VB * SHM + v_rd_off(d0, 0, 0); \
        TRRD(l0, b_); TRRD(h0, b_ + 2048); TRRD(l1, b_ + 4096); TRRD(h1, b_ + 6144); TRRD(l2, b_ + 8192); TRRD(h2, b_ + 10240); TRRD(l3, b_ + 12288); TRRD(h3, b_ + 14336); \
        asm volatile("s_waitcnt lgkmcnt(0)" ::: "memory"); SBAR(); \
        o[d0] = __builtin_amdgcn_mfma_f32_32x32x16_bf16(pa0, (bf16x8){l0[0], l0[1], l0[2], l0[3], h0[0], h0[1], h0[2], h0[3]}, o[d0], 0, 0, 0); \
        o[d0] = __builtin_amdgcn_mfma_f32_32x32x16_bf16(pa1, (bf16x8){l1[0], l1[1], l1[2], l1[3], h1[0], h1[1], h1[2], h1[3]}, o[d0], 0, 0, 0); \
        o[d0] = __builtin_amdgcn_mfma_f32_32x32x16_bf16(pa2, (bf16x8){l2[0], l2[1], l2[2], l2[3], h2[0], h2[1], h2[2], h2[3]}, o[d0], 0, 0, 0); \
        o[d0] = __builtin_amdgcn_mfma_f32_32x32x16_bf16(pa3, (bf16x8){l3[0], l3[1], l3[2], l3[3], h3[0], h3[1], h3[2], h3[3]}, o[d0], 0, 0, 0); } while (0)
    PV_D0(0); PV_D0(1); PV_D0(2); PV_D0(3);
#undef PV_D0
#undef TRRD
}
__device__ __forceinline__ void store_o(const WV& w, const f32x16* o, const float* tab, bf16_t* outp) {
    bf16_t* lp = outp + (size_t)w.hi * 4096 + w.r32;
#pragma unroll
    for (int r = 0; r < 16; ++r) { const int q = crow(r, w.hi); const float sc = tab[q];
        bf16_t* p = lp; asm volatile("" : "+v"(p));
        p += ((r & 3) + 8 * (r >> 2)) * 1024;
#pragma unroll
        for (int d0 = 0; d0 < 4; ++d0) { const float v = o[d0][r] * sc; const float vn = __shfl_xor(v, 1);
            if ((w.r32 & 1) == 0) *(__attribute__((address_space(1))) unsigned*)(p + d0 * 32) = cvtpk(v, vn); } }
}

template <int MODE>
__device__ __forceinline__ void flash_pass(const WV& w, const bf16_t* Kp, const bf16_t* Vp, int j_lo, int j_hi, const bf16x8 (&qr)[8], int tpos, int tw0, unsigned selmask,
                                           f32x16 (&o)[4], float& m_reg, float& l_reg) {
    float* al_l = (float*)(w.lds + L_WS) + w.wid * 64;
    dma_tile(w, Kp + (size_t)j_lo * 64 * HD, Vp + (size_t)j_lo * 64 * HD, 0);
#define FSTEP(BUF, jj) do { const int jt = (jj);                                                                                  \
        asm volatile("s_waitcnt vmcnt(0)" ::: "memory");                                                                         \
        __syncthreads();                                                                                                         \
        if (jt + 1 < j_hi) dma_tile(w, Kp + (size_t)(jt + 1) * 64 * HD, Vp + (size_t)(jt + 1) * 64 * HD, (BUF) ^ 1);                 \
        f32x16 p0, p1;                                                                                                           \
        qkt(w, BUF, qr, p0, p1);                                                                                                 \
        const int kb = jt * 64;                                                                                                  \
        { const float NEG = -__builtin_inff();                                                                                   \
          const bool need = (kb + 63 > tw0) || (MODE == 1 && kb <= tw0 + 31 - 512);                                              \
          if (need) { const int dq = tpos - kb - 4 * w.hi; const unsigned W = (MODE == 1) ? 512u : 0x7fffffffu;                  \
              _Pragma("unroll") for (int r = 0; r < 16; ++r) { const int c = (r & 3) + 8 * (r >> 2); if ((unsigned)(dq - c) >= W) p0[r] = NEG; if ((unsigned)(dq - c - 32) >= W) p1[r] = NEG; } } \
          if (MODE == 0) { const bool sel = (selmask >> jt) & 1u;                                                                 \
              if (!__all(sel)) { _Pragma("unroll") for (int r = 0; r < 16; ++r) { p0[r] = sel ? p0[r] : NEG; p1[r] = sel ? p1[r] : NEG; } } } } \
        float pmax = p0[0];                                                                                                      \
        _Pragma("unroll") for (int r = 1; r < 16; ++r) pmax = fmaxf(pmax, p0[r]);                                                \
        _Pragma("unroll") for (int r = 0; r < 16; ++r) pmax = fmaxf(pmax, p1[r]);                                                \
        pmax = swap_max(pmax);                                                                                                   \
        const float mn = fmaxf(m_reg, pmax);                                                                                     \
        const float alpha = __builtin_amdgcn_exp2f((m_reg - mn) * C2);                                                           \
        m_reg = mn;                                                                                                              \
        const float mnL = -mn * C2;                                                                                              \
        float ps = 0.f;                                                                                                          \
        _Pragma("unroll") for (int r = 0; r < 16; ++r) { p0[r] = __builtin_amdgcn_exp2f(fmaf(p0[r], C2, mnL)); ps += p0[r]; }    \
        _Pragma("unroll") for (int r = 0; r < 16; ++r) { p1[r] = __builtin_amdgcn_exp2f(fmaf(p1[r], C2, mnL)); ps += p1[r]; }    \
        ps = swap_sum(ps);                                                                                                       \
        l_reg = l_reg * alpha + ps;                                                                                              \
        if (w.hi == 0) al_l[w.r32] = alpha;                                                                                      \
        asm volatile("s_waitcnt lgkmcnt(0)" ::: "memory");                                                                       \
        _Pragma("unroll") for (int r = 0; r < 16; ++r) { const float a = al_l[crow(r, w.hi)];                                    \
            _Pragma("unroll") for (int d = 0; d < 4; ++d) o[d][r] *= a; }                                                        \
        bf16x8 pa0, pa1, pa2, pa3;                                                                                               \
        pack_p(p0, p1, pa0, pa1, pa2, pa3);                                                                                      \
        pv_tile<BUF>(o, w.vb0, pa0, pa1, pa2, pa3);                                                                              \
    } while (0)
    int j = j_lo;
    for (; j + 1 < j_hi; j += 2) { FSTEP(0, j); FSTEP(1, j + 1); }
    if (j < j_hi) FSTEP(0, j);
#undef FSTEP
    __syncthreads();
}
}

__device__ const unsigned char ATT_ITEMS[80] = {15, 30, 31, 63, 14, 28, 29, 61, 62, 13, 26, 27, 59, 60, 12, 24, 25, 57, 58, 11, 22, 23, 55, 56, 10, 20, 21, 53, 54, 9, 18, 19, 51, 52, 8, 16, 17, 49, 50, 7, 48, 6, 5,
    72, 73, 74, 75, 76, 77, 78, 79, 80, 81, 82, 83, 84, 85, 86, 87, 88, 89, 90, 91, 92, 93, 94, 95, 4, 71, 3, 70, 2, 69, 1, 68, 0, 67, 66, 65, 64};
constexpr int CW_QUEUE = 6144;
constexpr int CW_CVTQ = 6144 + 256;

__device__ __forceinline__ void p_attn(const Frame& F, unsigned char* lds_raw, int rep) {
    using namespace att;
    WV w; w.tid = F.tid; w.wid = F.wave; w.lane = F.lane; w.r32 = F.lane & 31; w.hi = F.lane >> 5;
    w.lds = (char*)lds_raw + 1024; w.ldsL = (LAS unsigned char*)lds_raw + 1024;
    w.vb0 = (int)(uintptr_t)(w.lds) + v_rd_base(w.lane);
    const bf16_t* qn = (const bf16_t*)(F.ws + WS_QN); const bf16_t* qrp = (const bf16_t*)(F.ws + WS_QR); const bf16_t* kv = (const bf16_t*)(F.ws + WS_KV);
    const bf16_t* ckv = (const bf16_t*)(F.ws + WS_CMPKV);
    bf16_t* ocmp = (bf16_t*)(F.ws + WS_OCMP); bf16_t* owin = (bf16_t*)(F.ws + WS_OWIN); bf16_t* osel = (bf16_t*)(F.ws + WS_OSEL); float* ml = (float*)(F.ws + WS_ML);
    unsigned* qctr = (unsigned*)(F.ws + WS_CTL) + CW_QUEUE + 64 * rep;
    float* wsf = (float*)(w.lds + L_WS) + w.wid * 64;
    float* part = (float*)(w.lds + L_PART); unsigned* selm = (unsigned*)(w.lds + L_SELM); float* vals = (float*)(w.lds + L_VALS) + w.wid * 64; volatile int* itemw = (volatile int*)(w.lds + L_ITEM);
    const int hr = w.wid >> 1, th = w.wid & 1;
    for (;;) {
        __syncthreads();
        if (F.tid == 0) itemw[0] = (int)atomicAdd(qctr, 1u);
        __syncthreads();
        const int item = itemw[0];
        if (item >= 640) break;
        const int ent = ATT_ITEMS[item >> 3], bg = item & 7, type = ent >> 5, qb = ent & 31, b = bg >> 1, g = bg & 1, h = 4 * g + hr;
        const int t0 = qb * 64 + th * 32, tpos = t0 + w.r32, tok0 = b * SEQ + t0;
        const size_t qoff = (((size_t)b * NH + h) * SEQ + t0 + w.r32) * HD + w.hi * 8;
        const size_t kvoff = ((size_t)b * NG + g) * SEQ * HD;
        bf16x8 qr[8];
        f32x16 o[4];
#ifndef ATT_NO_WIN
        if (type == 2) {
#pragma unroll
            for (int d0 = 0; d0 < 8; ++d0) qr[d0] = *(const bf16x8*)(qrp + qoff + d0 * 16);
#pragma unroll
            for (int d = 0; d < 4; ++d) o[d] = f32x16{};
            float m_reg = -1e30f, l_reg = 0.f;
            flash_pass<1>(w, kv + (size_t)4 * (4 * MB / 2) + kvoff, kv + (size_t)5 * (4 * MB / 2) + kvoff, qb >= 8 ? qb - 8 : 0, qb + 1, qr, tpos, t0, 0u, o, m_reg, l_reg);
            if (w.hi == 0) wsf[w.r32] = 1.f / l_reg;
            asm volatile("s_waitcnt lgkmcnt(0)" ::: "memory");
            store_o(w, o, wsf, owin + (size_t)tok0 * 1024 + h * HD);
            continue;
        }
#endif
#ifndef ATT_NO_CMP
        {
#pragma unroll
            for (int d0 = 0; d0 < 8; ++d0) qr[d0] = *(const bf16x8*)(qn + qoff + d0 * 16);
            const bf16_t* Kc = ckv + (size_t)bg * 128 * HD; const bf16_t* Vc = ckv + (size_t)1024 * HD + (size_t)bg * 128 * HD;
            dma_tile(w, Kc, Vc, 0); dma_tile(w, Kc + 64 * HD, Vc + 64 * HD, 1);
            asm volatile("s_waitcnt vmcnt(0)" ::: "memory");
            __syncthreads();
            f32x16 pA0, pA1, pB0, pB1;
            qkt(w, 0, qr, pA0, pA1); qkt(w, 1, qr, pB0, pB1);
            const int nmax = tpos >= 31 ? ((tpos - 31) >> 4) : -1;
            const float NEG = -__builtin_inff();
            float pmax = NEG;
#pragma unroll
            for (int r = 0; r < 16; ++r) { const int n = crow(r, w.hi);
                pA0[r] = (n <= nmax) ? pA0[r] : NEG; pA1[r] = (n + 32 <= nmax) ? pA1[r] : NEG; pB0[r] = (n + 64 <= nmax) ? pB0[r] : NEG; pB1[r] = (n + 96 <= nmax) ? pB1[r] : NEG;
                pmax = fmaxf(fmaxf(pmax, pA0[r]), fmaxf(pA1[r], fmaxf(pB0[r], pB1[r]))); }
            pmax = swap_max(pmax);
            const float mm = (pmax == NEG) ? 0.f : pmax;
            const float mnL = -mm * C2;
            float ps = 0.f;
#pragma unroll
            for (int r = 0; r < 16; ++r) { pA0[r] = __builtin_amdgcn_exp2f(fmaf(pA0[r], C2, mnL)); pA1[r] = __builtin_amdgcn_exp2f(fmaf(pA1[r], C2, mnL));
                pB0[r] = __builtin_amdgcn_exp2f(fmaf(pB0[r], C2, mnL)); pB1[r] = __builtin_amdgcn_exp2f(fmaf(pB1[r], C2, mnL)); ps += (pA0[r] + pA1[r]) + (pB0[r] + pB1[r]); }
            ps = swap_sum(ps);
            const float inv = ps > 0.f ? 1.f / ps : 0.f;
#pragma unroll
            for (int r = 0; r < 16; ++r) { pA0[r] *= inv; pA1[r] *= inv; pB0[r] *= inv; pB1[r] *= inv; }
            {
                float av[16], bv[16];
#pragma unroll
                for (int gq = 0; gq < 4; ++gq) {
                    av[gq]      = pA0[4 * gq] + pA0[4 * gq + 1] + pA0[4 * gq + 2] + 0.5f * pA0[4 * gq + 3]; bv[gq]      = 0.5f * pA0[4 * gq + 3];
                    av[4 + gq]  = pA1[4 * gq] + pA1[4 * gq + 1] + pA1[4 * gq + 2] + 0.5f * pA1[4 * gq + 3]; bv[4 + gq]  = 0.5f * pA1[4 * gq + 3];
                    av[8 + gq]  = pB0[4 * gq] + pB0[4 * gq + 1] + pB0[4 * gq + 2] + 0.5f * pB0[4 * gq + 3]; bv[8 + gq]  = 0.5f * pB0[4 * gq + 3];
                    av[12 + gq] = pB1[4 * gq] + pB1[4 * gq + 1] + pB1[4 * gq + 2] + 0.5f * pB1[4 * gq + 3]; bv[12 + gq] = 0.5f * pB1[4 * gq + 3];
                }
                float* prow = part + ((size_t)hr * 64 + th * 32 + w.r32) * 33;
#pragma unroll
                for (int idx = 0; idx < 16; ++idx) {
                    const float bo = __shfl_xor(bv[idx], 32);
                    const float bprev = (idx > 0) ? __shfl_xor(bv[idx > 0 ? idx - 1 : 0], 32) : 0.f;
                    const float inc = w.hi ? bo : bprev;
                    prow[2 * idx + w.hi] = av[idx] + inc;
                }
            }
            if (type == 0) {
                bf16x8 pa0, pa1, pa2, pa3;
#pragma unroll
                for (int d = 0; d < 4; ++d) o[d] = f32x16{};
                pack_p(pA0, pA1, pa0, pa1, pa2, pa3); pv_tile<0>(o, w.vb0, pa0, pa1, pa2, pa3);
                pack_p(pB0, pB1, pa0, pa1, pa2, pa3); pv_tile<1>(o, w.vb0, pa0, pa1, pa2, pa3);
                if (w.hi == 0) wsf[w.r32] = 1.f;
                asm volatile("s_waitcnt lgkmcnt(0)" ::: "memory");
                store_o(w, o, wsf, ocmp + (size_t)tok0 * 1024 + h * HD);
            }
            __syncthreads();
#pragma unroll 1
            for (int ps2 = 0; ps2 < 4; ++ps2) {
                int ln = w.lane; asm volatile("" : "+v"(ln));
                const int j = ln & 31, hi2 = ln >> 5;
                const int tk = 8 * w.wid + 2 * ps2 + hi2, t = qb * 64 + tk, cur = qb;
                float imp = 0.f;
#pragma unroll
                for (int r = 0; r < 4; ++r) imp += part[((size_t)r * 64 + tk) * 33 + j];
                const bool ok = (64 * j <= t), forced = (j == 0) || (cur - j >= 0 && cur - j < 2);
                const float val = (ok && forced) ? 1.0e30f : (ok ? imp : -1.0e30f);
                vals[ln] = val;
                asm volatile("s_waitcnt lgkmcnt(0)" ::: "memory");
                int rank = 0;
#pragma unroll
                for (int jj = 0; jj < 32; ++jj) { const float o2 = vals[hi2 * 32 + jj]; rank += (o2 > val || (o2 == val && jj < j)) ? 1 : 0; }
                const unsigned long long bal = __ballot(rank < 16 && val >= 0.f);
                if (w.lane == 0) { selm[8 * w.wid + 2 * ps2] = (unsigned)bal; selm[8 * w.wid + 2 * ps2 + 1] = (unsigned)(bal >> 32); }
            }
            __syncthreads();
        }
#endif
#ifndef ATT_NO_SEL
        {
            const unsigned sm = selm[th * 32 + w.r32];
            const int ntile = qb + 1, hsplit = (ntile + 1) >> 1;
            const int ja = (qb >= 16 && type == 1) ? hsplit : 0, jb = (qb >= 16 && type == 0) ? hsplit : ntile;
#pragma unroll
            for (int d0 = 0; d0 < 8; ++d0) qr[d0] = *(const bf16x8*)(qrp + qoff + d0 * 16);
#pragma unroll
            for (int d = 0; d < 4; ++d) o[d] = f32x16{};
            float m_reg = -1e30f, l_reg = 0.f;
            flash_pass<0>(w, kv + (size_t)2 * (4 * MB / 2) + kvoff, kv + (size_t)3 * (4 * MB / 2) + kvoff, ja, jb, qr, tpos, t0, sm, o, m_reg, l_reg);
            if (w.hi == 0) { wsf[w.r32] = l_reg > 0.f ? 1.f / l_reg : 0.f; float* mp = ml + (((size_t)type * NT + tok0 + w.r32) * NH + h) * 2; mp[0] = m_reg; mp[1] = l_reg; }
            asm volatile("s_waitcnt lgkmcnt(0)" ::: "memory");
            store_o(w, o, wsf, osel + (size_t)type * NT * 1024 + (size_t)tok0 * 1024 + h * HD);
        }
#endif
    }
}

struct CvtTile { const float* src; const float* ksc; bf16_t* dst0; int sld, ldd, mode; };
__device__ __forceinline__ CvtTile cvt_decode(const Frame& F, int t) {
    CvtTile c; c.ksc = nullptr; c.mode = 0;
    if (t < 4096) { const int e = t >> 7, mat = (t >> 6) & 1, kt = (t >> 1) & 31, nt = t & 1;
        c.src = (mat ? F.in[I_WUP] : F.in[I_WGATE]) + ((size_t)e * DM + kt * 64) * FF + nt * 256; c.sld = FF; c.ksc = F.in[I_LNMOE] + kt * 64;
        c.dst0 = (bf16_t*)(F.ws + WS_W1T) + ((size_t)e * 1024 + nt * 512 + mat * 128) * DM + kt * 64; c.ldd = DM; c.mode = 1; return c; }
    t -= 4096;
    if (t < 2048) { const int e = t >> 6, kt = (t >> 3) & 7, nt = t & 7;
        c.src = F.in[I_WDOWN] + ((size_t)e * FF + kt * 64) * DM + nt * 256; c.sld = DM;
        c.dst0 = (bf16_t*)(F.ws + WS_W2T) + ((size_t)e * 2048 + nt * 256) * FF + kt * 64; c.ldd = FF; return c; }
    t -= 2048;
    if (t < 256) { const int kt = t >> 3, nt = t & 7;
        c.src = F.in[I_WOUT] + (size_t)kt * 64 * DM + nt * 256; c.sld = DM; c.dst0 = (bf16_t*)(F.ws + WS_WOUTT) + (size_t)nt * 256 * DM + kt * 64; c.ldd = DM; return c; }
    t -= 256;
    if (t < 480) { const int kt = t / 15, nt = t % 15;
        c.src = F.in[I_WIN] + (size_t)kt * 64 * INW; c.sld = INW; c.ksc = F.in[I_LNMIX] + kt * 64;
        c.dst0 = (bf16_t*)(F.ws + WS_WINT) + (size_t)nt * 256 * DM + kt * 64; c.ldd = DM; c.mode = 2 + nt; return c; }
    t -= 480;
    { const int kv = t >> 6, kt = t & 63;
      c.src = (kv ? F.in[I_WV1] : F.in[I_WK1]) + (size_t)kt * 64 * 256; c.sld = 256; c.dst0 = (bf16_t*)(F.ws + WS_CMPW) + (size_t)kv * 256 * 4096 + kt * 64; c.ldd = 4096; return c; }
}
constexpr int N_CVT_TILES = 4096 + 2048 + 256 + 480 + 128;
__device__ __forceinline__ void cvt_load(const CvtTile& c, int nq, int kq, float4 (&v)[8]) {
    const float* p = c.src + 4 * nq; bool valid = true;
    if (c.mode >= 2) { const int n = (c.mode - 2) * 256 + 4 * nq; int sc = -1; if (n < 2560) sc = n; else if (n < 3584) sc = n + 24; else if (n < 3608) sc = n - 1024; valid = sc >= 0; p = c.src + (valid ? sc : 0); }
#pragma unroll
    for (int i = 0; i < 8; ++i) v[i] = valid ? *(const float4*)(p + (size_t)(kq * 8 + i) * c.sld) : make_float4(0.f, 0.f, 0.f, 0.f);
}

constexpr int CVT_RUN = 4;
__device__ __forceinline__ void cvt_stream(const Frame& F, int t_lo, int t_hi, unsigned* queue) {
    float* T = F.lds;
    volatile int* nxtw = (volatile int*)(F.lds + 64 * 257);
    const int tid = F.tid, nq = tid & 63, kq = tid >> 6;
    int tA, tB; float4 vA[8], vB[8]; CvtTile cA, cB;
    if (queue) { __syncthreads(); if (tid == 0) { nxtw[0] = t_lo + CVT_RUN * (int)atomicAdd(queue, 1u); nxtw[1] = t_lo + CVT_RUN * (int)atomicAdd(queue, 1u); } __syncthreads(); tA = nxtw[0]; tB = nxtw[1]; }
    else { tA = t_lo + F.bid; tB = tA + F.G; }
    if (tA < t_hi) { cA = cvt_decode(F, tA); cvt_load(cA, nq, kq, vA); }
    if (tB < t_hi) { cB = cvt_decode(F, tB); cvt_load(cB, nq, kq, vB); }
#define CVT_STEP(tX, cX, vX, slot) do {                                                                                                     \
        const bool pop = queue && (((tX) - t_lo) % CVT_RUN == CVT_RUN - 1);                 \
        int tn_reg = 0;                                                                                                                      \
        if (pop && tid == 0) tn_reg = t_lo + CVT_RUN * (int)atomicAdd(queue, 1u);                                                            \
        __syncthreads();                                                                                                                     \
        _Pragma("unroll") for (int i = 0; i < 8; ++i) { const float s = cX.ksc ? cX.ksc[kq * 8 + i] : 1.f; float* tp = T + (kq * 8 + i) * 257 + 4 * nq; \
            tp[0] = vX[i].x * s; tp[1] = vX[i].y * s; tp[2] = vX[i].z * s; tp[3] = vX[i].w * s; }                                           \
        if (pop && tid == 0) nxtw[slot] = tn_reg;                                                                                            \
        __syncthreads();                                                                                                                     \
        const CvtTile cc = cX; const int tn = queue ? (pop ? nxtw[slot] : tX + 1) : tX + 2 * F.G;                                            \
        if (tn < t_hi) { cX = cvt_decode(F, tn); cvt_load(cX, nq, kq, vX); }                                                                 \
        _Pragma("unroll") for (int j = 0; j < 4; ++j) { const int id = tid + 512 * j, n = id >> 3, kc = id & 7; const float* tp = T + (kc * 8) * 257 + n; \
            pg8::u32x4 w; w.x = pg8::cvt_pk_bf16(tp[0], tp[257]); w.y = pg8::cvt_pk_bf16(tp[2 * 257], tp[3 * 257]); w.z = pg8::cvt_pk_bf16(tp[4 * 257], tp[5 * 257]); w.w = pg8::cvt_pk_bf16(tp[6 * 257], tp[7 * 257]); \
            const int rowi = (cc.mode == 1) ? ((n >> 7) * 256 + (n & 127)) : n;                                                              \
            *(pg8::u32x4*)(cc.dst0 + (size_t)rowi * cc.ldd + kc * 8) = w; }                                                                  \
        tX = tn; } while (0)
    while (tA < t_hi) {
        CVT_STEP(tA, cA, vA, 0);
        if (tB >= t_hi) { const int t2 = tA; tA = tB; tB = t2; const CvtTile c2 = cA; cA = cB; cB = c2;
#pragma unroll
            for (int i = 0; i < 8; ++i) { const float4 x = vA[i]; vA[i] = vB[i]; vB[i] = x; }
            continue; }
        CVT_STEP(tB, cB, vB, 1);
    }
    while (tB < t_hi) CVT_STEP(tB, cB, vB, 1);
#undef CVT_STEP
    __syncthreads();
}

__device__ __forceinline__ void p0_prologue(const Frame& F) {
    const float* x = F.in[I_X];
    bf16_t* xb = (bf16_t*)(F.ws + WS_XB); float* rstd1 = (float*)(F.ws + WS_RSTD1);
    const int gw = F.bid * NWAVES + F.wave, nw = F.G * NWAVES, lane = F.lane;
    for (int r = gw; r < NT; r += nw) {
        float4 v[8]; float ss = 0.f;
#pragma unroll
        for (int i = 0; i < 8; ++i) { v[i] = *(const float4*)(x + (size_t)r * DM + i * 256 + lane * 4); ss += v[i].x * v[i].x + v[i].y * v[i].y + v[i].z * v[i].z + v[i].w * v[i].w; }
        ss = wave_sum(ss);
        if (lane == 0) rstd1[r] = rsqrtf(ss * (1.f / DM) + EPS);
#pragma unroll
        for (int i = 0; i < 8; ++i) { uint2 w; w.x = pg8::cvt_pk_bf16(v[i].x, v[i].y); w.y = pg8::cvt_pk_bf16(v[i].z, v[i].w);
            *(uint2*)(xb + (size_t)r * DM + i * 256 + lane * 4) = w; }
    }
    cvt_stream(F, 6400, N_CVT_TILES, nullptr);
    {
        const float* wp = F.in[I_WPOOL]; const float* ps = F.in[I_PSCALE]; const float* bp = F.in[I_BPOOL]; bf16_t* wpt = (bf16_t*)(F.ws + WS_POOLW); float* pb = (float*)(F.ws + WS_POOLB);
        for (int idx = F.bid * NTHREADS + F.tid; idx < 4 * 256 * 256; idx += F.G * NTHREADS) { const int k = idx & 255, n = (idx >> 8) & 255, g = idx >> 16;
            wpt[idx] = f2bf(wp[((size_t)g * 256 + k) * 256 + n] * ps[g * 256 + n]); }
        for (int idx = F.bid * NTHREADS + F.tid; idx < 1024; idx += F.G * NTHREADS) pb[idx] = bp[idx] * ps[idx];
    }
    {
        const float* lnm = F.in[I_LNMOE]; const float* wre = F.in[I_WRE]; const float* wrg = F.in[I_WRG]; float* WR = (float*)(F.ws + WS_WR); float* WG4 = (float*)(F.ws + WS_WG4);
        for (int idx = F.bid * NTHREADS + F.tid; idx < DM * 32; idx += F.G * NTHREADS) { const int k = idx >> 5, c = idx & 31; WR[idx] = lnm[k] * wre[((size_t)(c >> 3) * DM + k) * 8 + (c & 7)]; }
        for (int idx = F.bid * NTHREADS + F.tid; idx < DM * 4; idx += F.G * NTHREADS) WG4[idx] = lnm[idx >> 2] * wrg[idx];
    }
    {
        const int* pos = (const int*)F.in[I_POS]; float* rc = (float*)(F.ws + WS_ROPEC); float* rs = (float*)(F.ws + WS_ROPES);
        for (int idx = F.bid * NTHREADS + F.tid; idx < NB * SEQ * 16; idx += F.G * NTHREADS) {
            const int i = idx & 15, bs = idx >> 4;
            const float inv = exp2f(-(float)i * (1.f / 16.f) * 18.931568569324174f);
            const float ang = (float)pos[bs] * inv;
            rc[idx] = cosf(ang); rs[idx] = sinf(ang);
        }
    }
    for (int it = F.bid; it < 64; it += F.G) {
        const int kv = it >> 5, jb = (it >> 3) & 3, mc = it & 7;
        const float* pe = (kv ? F.in[I_PEV] : F.in[I_PEK]); const float* w1 = (kv ? F.in[I_WV1] : F.in[I_WK1]);
        const int mg = F.tid >> 6, j = jb * 64 + (F.tid & 63);
        float a = 0.f;
#pragma unroll 8
        for (int m = mc * 512 + mg; m < mc * 512 + 512; m += 8) a += pe[m] * w1[(size_t)m * 256 + j];
        __syncthreads();
        F.lds[F.tid] = a;
        __syncthreads();
        if (F.tid < 64) { float s = 0.f; for (int q = 0; q < 8; ++q) s += F.lds[q * 64 + F.tid]; ((float*)(F.ws + WS_BIAS1))[(mc * 2 + kv) * 256 + j] = s; }
        __syncthreads();
    }
}

struct EpiProj {
    const float* rstd1; const float* rc; const float* rs; bf16_t* qn; bf16_t* qr; bf16_t* kv; float* u; float* gates;
    __device__ __forceinline__ void operator()(const pg8::f32x4 (&acc)[2][2][4][2], const pg8::Unit& un, int wr, int wc, int fr, int fq) const {
        const int pn = un.pn;
#pragma unroll
        for (int ai = 0; ai < 2; ++ai)
#pragma unroll
            for (int m = 0; m < 4; ++m) {
                const int row = un.pm * 256 + ai * 128 + wr * 64 + m * 16 + fr; const float r1 = rstd1[row]; const int b = row >> 11, s = row & 2047;
                if (pn < 10) {
                    const bool ropeu = (pn < 4) || pn == 6 || pn == 8;
                    pg8::f32x4 c4 = {1.f, 1.f, 1.f, 1.f}, s4 = {0.f, 0.f, 0.f, 0.f};
                    if (ropeu && wc == 0) { c4 = *(const pg8::f32x4*)(rc + (size_t)row * 16 + 4 * fq); s4 = *(const pg8::f32x4*)(rs + (size_t)row * 16 + 4 * fq); }
#pragma unroll
                    for (int bj = 0; bj < 2; ++bj) {
                        const pg8::f32x4 v0 = acc[ai][bj][m][0] * r1, v1 = acc[ai][bj][m][1] * r1;
                        const int d0 = 32 * wc + 4 * fq;
                        pg8::f32x4 o0 = v0, o1 = v1;
                        if (ropeu && wc == 0) { o0 = v0 * c4 - v1 * s4; o1 = v1 * c4 + v0 * s4; }
                        uint2 w0, w1; w0.x = pg8::cvt_pk_bf16(o0[0], o0[1]); w0.y = pg8::cvt_pk_bf16(o0[2], o0[3]); w1.x = pg8::cvt_pk_bf16(o1[0], o1[1]); w1.y = pg8::cvt_pk_bf16(o1[2], o1[3]);
                        if (pn < 4) {
                            const size_t o = (((size_t)b * NH + 2 * pn + bj) * SEQ + s) * HD + d0;
                            uint2 n0, n1; n0.x = pg8::cvt_pk_bf16(v0[0], v0[1]); n0.y = pg8::cvt_pk_bf16(v0[2], v0[3]); n1.x = pg8::cvt_pk_bf16(v1[0], v1[1]); n1.y = pg8::cvt_pk_bf16(v1[2], v1[3]);
                            *(uint2*)(qn + o) = n0; *(uint2*)(qn + o + 16) = n1; *(uint2*)(qr + o) = w0; *(uint2*)(qr + o + 16) = w1;
                        } else {
                            const size_t o = (size_t)(pn - 4) * (4 * MB / 2) + (((size_t)b * NG + bj) * SEQ + s) * HD + d0;
                            *(uint2*)(kv + o) = w0; *(uint2*)(kv + o + 16) = w1;
                        }
                    }
                } else if (pn < 14) {
#pragma unroll
                    for (int bj = 0; bj < 2; ++bj)
#pragma unroll
                        for (int n = 0; n < 2; ++n) *(pg8::f32x4*)(u + (size_t)row * 1024 + (pn - 10) * 256 + bj * 128 + wc * 32 + n * 16 + 4 * fq) = acc[ai][bj][m][n] * r1;
                } else {
                    if (wc == 0) { *(pg8::f32x4*)(gates + (size_t)row * 24 + 4 * fq) = acc[ai][0][m][0] * r1; if (fq < 2) *(pg8::f32x4*)(gates + (size_t)row * 24 + 16 + 4 * fq) = acc[ai][0][m][1] * r1; }
                }
            }
    }
};

__device__ __forceinline__ void p1_proj(const Frame& F, LAS unsigned char* stage) {
    pg8::DenseOrder S; S.init(F.ws + WS_XB, F.ws + WS_WINT, DM, DM, NT, INWP, F.G, F.bid);
    EpiProj E{(const float*)(F.ws + WS_RSTD1), (const float*)(F.ws + WS_ROPEC), (const float*)(F.ws + WS_ROPES), (bf16_t*)(F.ws + WS_QN), (bf16_t*)(F.ws + WS_QR), (bf16_t*)(F.ws + WS_KV),
              (float*)(F.ws + WS_U), (float*)(F.ws + WS_GATES)};
    pg8::gemm_phase<EpiProj, pg8::DenseOrder, false>(stage, DM, DM, DM, S, E);
}

struct CmpOrder {
    const char* kc; const char* w1t; int c;
    __device__ __forceinline__ bool next(int i, pg8::Unit& u) const { if (i > 0) return false; u.e = c >> 5; u.pm = (c >> 3) & 3; u.pn = c & 7; u.li = 0; return true; }
    __device__ __forceinline__ const char* a_base(const pg8::Unit& u) const { return kc + (size_t)u.e * 4 * MB + ((size_t)u.pm * 256 * 2048 + u.pn * 512) * 2; }
    __device__ __forceinline__ const char* b_base(const pg8::Unit& u) const { return w1t + ((size_t)u.e * 256 * 4096 + u.pn * 512) * 2; }
    __device__ __forceinline__ unsigned a_row_off(const pg8::Unit&, int r) const { return (unsigned)r * 4096u; }
};
struct EpiCmp {
    float* part;
    __device__ __forceinline__ void operator()(const pg8::f32x4 (&acc)[2][2][4][2], const pg8::Unit& un, int wr, int wc, int fr, int fq) const {
        float* base = part + (((size_t)un.pn * 2 + un.e) * 1024 + un.pm * 256) * 256;
#pragma unroll
        for (int ai = 0; ai < 2; ++ai)
#pragma unroll
            for (int m = 0; m < 4; ++m) { float* rowp = base + (size_t)(ai * 128 + wr * 64 + m * 16 + fr) * 256 + wc * 32 + 4 * fq;
#pragma unroll
                for (int bj = 0; bj < 2; ++bj)
#pragma unroll
                    for (int n = 0; n < 2; ++n) *(pg8::f32x4*)(rowp + bj * 128 + n * 16) = acc[ai][bj][m][n]; }
    }
};
struct PoolOrder {
    const char* d; const char* wpt; int c;
    __device__ __forceinline__ bool next(int i, pg8::Unit& u) const { if (i > 0) return false; u.pm = c >> 2; u.pn = 0; u.e = c & 3; u.li = 0; return true; }
    __device__ __forceinline__ const char* a_base(const pg8::Unit& u) const { return d + ((size_t)u.pm * 256 * 1024 + u.e * 256) * 2; }
    __device__ __forceinline__ const char* b_base(const pg8::Unit& u) const { return wpt + (size_t)u.e * 256 * 256 * 2; }
    __device__ __forceinline__ unsigned a_row_off(const pg8::Unit&, int r) const { return (unsigned)r * 2048u; }
};
struct EpiPool {
    const float* pb; float* opool;
    __device__ __forceinline__ void operator()(const pg8::f32x4 (&acc)[2][2][4][2], const pg8::Unit& un, int wr, int wc, int fr, int fq) const {
#pragma unroll
        for (int ai = 0; ai < 2; ++ai)
#pragma unroll
            for (int m = 0; m < 4; ++m) { const int row = un.pm * 256 + ai * 128 + wr * 64 + m * 16 + fr;
#pragma unroll
                for (int bj = 0; bj < 2; ++bj)
#pragma unroll
                    for (int n = 0; n < 2; ++n) { const int c = un.e * 256 + bj * 128 + wc * 32 + n * 16 + 4 * fq;
                        *(pg8::f32x4*)(opool + (size_t)row * 1024 + c) = acc[ai][bj][m][n] + *(const pg8::f32x4*)(pb + c); } }
    }
};
__device__ __forceinline__ void p3_mid(const Frame& F, LAS unsigned char* stage, int rep) {
    if (F.bid < 64) {
        CmpOrder S{(const char*)(F.ws + WS_KV), (const char*)(F.ws + WS_CMPW), F.bid};
        EpiCmp E{(float*)(F.ws + WS_CPART)};
        pg8::gemm_phase<EpiCmp, CmpOrder, false>(stage, 512, 2048, 4096, S, E);
    } else if (F.bid < 192) {
        const int c = F.bid - 64, pm = c >> 2, gi = c & 3, w = 2 << gi;
        const float* u = (const float*)(F.ws + WS_U); bf16_t* d = (bf16_t*)(F.ws + WS_DBUF);
        for (int task = F.tid; task < 256 * 16; task += 2 * NTHREADS) {
            const int cc = task & 255, col = gi * 256 + cc;
            float uv[2][31];
#pragma unroll
            for (int tt = 0; tt < 2; ++tt) { const int ch = (task >> 8) + 2 * tt, r0 = pm * 256 + ch * 16, s0 = r0 & 2047;
#pragma unroll
                for (int q = 0; q < 31; ++q) { const int s = s0 - 15 + q; uv[tt][q] = (s >= 0) ? u[(size_t)(r0 - 15 + q) * 1024 + col] : 0.f; } }
#pragma unroll
            for (int tt = 0; tt < 2; ++tt) { const int ch = (task >> 8) + 2 * tt, r0 = pm * 256 + ch * 16, s0 = r0 & 2047;
#pragma unroll
                for (int i = 0; i < 16; ++i) { float sum = 0.f;
#pragma unroll
                    for (int q = 0; q < 16; ++q) if (q < w) sum += uv[tt][15 + i - q];
                    const int s = s0 + i, cnt = (s + 1 < w) ? s + 1 : w;
                    d[(size_t)(r0 + i) * 1024 + col] = f2bf(sum / (float)cnt - uv[tt][15 + i]); } }
        }
        asm volatile("s_waitcnt vmcnt(0)" ::: "memory");
        __syncthreads();
        PoolOrder S{(const char*)(F.ws + WS_DBUF), (const char*)(F.ws + WS_POOLW), c};
        EpiPool E{(const float*)(F.ws + WS_POOLB), (float*)(F.ws + WS_OPOOL)};
        pg8::gemm_phase<EpiPool, PoolOrder, false>(stage, 256, 1024, 256, S, E);
    }
    cvt_stream(F, 6144, 6400, (unsigned*)(F.ws + WS_CTL) + CW_CVTQ + 64 * rep);
}

__device__ __forceinline__ void p4_cmp2(const Frame& F) {
    const float* part = (const float*)(F.ws + WS_CPART); const float* bias1p = (const float*)(F.ws + WS_BIAS1); bf16_t* ckv = (bf16_t*)(F.ws + WS_CMPKV);
    float* H = F.lds;
    for (int it = F.bid; it < 128; it += F.G) {
        const int kvi = it >> 6, r0 = (it & 63) * 16; const float* w2 = kvi ? F.in[I_WV2] : F.in[I_WK2];
        __syncthreads();
#pragma unroll
        for (int j = 0; j < 2; ++j) { const int idx = F.tid + 512 * j, r = idx >> 6, c = (idx & 63) * 4;
            pg8::f32x4 s = {0.f, 0.f, 0.f, 0.f};
#pragma unroll
            for (int sp = 0; sp < 8; ++sp) s += *(const pg8::f32x4*)(part + (((size_t)sp * 2 + kvi) * 1024 + r0 + r) * 256 + c) + *(const pg8::f32x4*)(bias1p + (sp * 2 + kvi) * 256 + c);
            H[r * 260 + c] = gelu_tanh(s[0]); H[r * 260 + c + 1] = gelu_tanh(s[1]); H[r * 260 + c + 2] = gelu_tanh(s[2]); H[r * 260 + c + 3] = gelu_tanh(s[3]); }
        __syncthreads();
        const int r = F.tid >> 5, c0 = (F.tid & 31) * 4;
        pg8::f32x4 acc = {0.f, 0.f, 0.f, 0.f};
#pragma unroll 8
        for (int k = 0; k < 256; ++k) acc += *(const pg8::f32x4*)(w2 + (size_t)k * 128 + c0) * H[r * 260 + k];
        const int R = r0 + r; const bool pad = (R & 127) == 127;
        uint2 w; w.x = pad ? 0u : pg8::cvt_pk_bf16(acc[0], acc[1]); w.y = pad ? 0u : pg8::cvt_pk_bf16(acc[2], acc[3]);
        *(uint2*)(ckv + ((size_t)kvi * 1024 + R) * 128 + c0) = w;
    }
}

__device__ __forceinline__ void unpack8(const pg8::u32x4 w, float (&f)[8]) {
    f[0] = __uint_as_float(w.x << 16); f[1] = __uint_as_float(w.x & 0xFFFF0000u); f[2] = __uint_as_float(w.y << 16); f[3] = __uint_as_float(w.y & 0xFFFF0000u);
    f[4] = __uint_as_float(w.z << 16); f[5] = __uint_as_float(w.z & 0xFFFF0000u); f[6] = __uint_as_float(w.w << 16); f[7] = __uint_as_float(w.w & 0xFFFF0000u);
}
__device__ __forceinline__ void p6_mix(const Frame& F) {
    const bf16_t* ocmp = (const bf16_t*)(F.ws + WS_OCMP); const bf16_t* owin = (const bf16_t*)(F.ws + WS_OWIN); const bf16_t* osel = (const bf16_t*)(F.ws + WS_OSEL);
    const float* ml = (const float*)(F.ws + WS_ML); const float* gates = (const float*)(F.ws + WS_GATES);
    const float* opool = (const float*)(F.ws + WS_OPOOL); bf16_t* mix = (bf16_t*)(F.ws + WS_MIX);
    const float* gn = F.in[I_GNNSA]; const float* gp = F.in[I_GNPOOL];
    const int gw = F.bid * NWAVES + F.wave, nw = F.G * NWAVES, lane = F.lane, h = lane >> 3;
    for (int r = gw; r < NT; r += nw) {
        const bool split = ((r & 2047) >> 6) >= 16;
        const size_t o = (size_t)r * 1024 + lane * 16;
        const float* gq = gates + (size_t)r * 24 + h * 3;
        const float g0 = 1.f / (1.f + __expf(-gq[0])), g1 = 1.f / (1.f + __expf(-gq[1])), g2 = 1.f / (1.f + __expf(-gq[2]));
        float w0 = 1.f, w1 = 0.f;
        if (split) { const float* m0p = ml + ((size_t)r * NH + h) * 2; const float* m1p = ml + (((size_t)NT + r) * NH + h) * 2;
            const float m0 = m0p[0], l0 = m0p[1], m1 = m1p[0], l1 = m1p[1], M = fmaxf(m0, m1);
            const float a0 = l0 * exp2f((m0 - M) * att::C2), a1 = l1 * exp2f((m1 - M) * att::C2), inv = 1.f / (a0 + a1); w0 = a0 * inv; w1 = a1 * inv; }
        float a[16], p[16]; float sa = 0.f, sp = 0.f;
#pragma unroll
        for (int hf = 0; hf < 2; ++hf) {
            float c8[8], w8[8], s8[8], t8[8];
            unpack8(*(const pg8::u32x4*)(ocmp + o + hf * 8), c8); unpack8(*(const pg8::u32x4*)(owin + o + hf * 8), w8); unpack8(*(const pg8::u32x4*)(osel + o + hf * 8), s8);
            if (split) unpack8(*(const pg8::u32x4*)(osel + (size_t)NT * 1024 + o + hf * 8), t8);
#pragma unroll
            for (int j = 0; j < 8; ++j) { const float os = split ? (w0 * s8[j] + w1 * t8[j]) : s8[j]; a[hf * 8 + j] = g0 * c8[j] + g1 * os + g2 * w8[j]; sa += a[hf * 8 + j] * a[hf * 8 + j]; }
        }
#pragma unroll
        for (int q = 0; q < 4; ++q) { const pg8::f32x4 v = *(const pg8::f32x4*)(opool + o + q * 4); p[q * 4] = v[0]; p[q * 4 + 1] = v[1]; p[q * 4 + 2] = v[2]; p[q * 4 + 3] = v[3]; sp += v[0] * v[0] + v[1] * v[1] + v[2] * v[2] + v[3] * v[3]; }
        sa = wave_sum(sa); sp = wave_sum(sp);
        const float ra = rsqrtf(sa * (1.f / 1024.f) + EPS), rp = rsqrtf(sp * (1.f / 1024.f) + EPS);
        float ga[16], gb[16];
#pragma unroll
        for (int q = 0; q < 4; ++q) { const pg8::f32x4 v = *(const pg8::f32x4*)(gn + lane * 16 + q * 4), u = *(const pg8::f32x4*)(gp + lane * 16 + q * 4);
            ga[q * 4] = v[0]; ga[q * 4 + 1] = v[1]; ga[q * 4 + 2] = v[2]; ga[q * 4 + 3] = v[3]; gb[q * 4] = u[0]; gb[q * 4 + 1] = u[1]; gb[q * 4 + 2] = u[2]; gb[q * 4 + 3] = u[3]; }
#pragma unroll
        for (int hf = 0; hf < 2; ++hf) { pg8::u32x4 wa, wb;
            wa.x = pg8::cvt_pk_bf16(a[hf * 8] * ra * ga[hf * 8], a[hf * 8 + 1] * ra * ga[hf * 8 + 1]); wa.y = pg8::cvt_pk_bf16(a[hf * 8 + 2] * ra * ga[hf * 8 + 2], a[hf * 8 + 3] * ra * ga[hf * 8 + 3]);
            wa.z = pg8::cvt_pk_bf16(a[hf * 8 + 4] * ra * ga[hf * 8 + 4], a[hf * 8 + 5] * ra * ga[hf * 8 + 5]); wa.w = pg8::cvt_pk_bf16(a[hf * 8 + 6] * ra * ga[hf * 8 + 6], a[hf * 8 + 7] * ra * ga[hf * 8 + 7]);
            wb.x = pg8::cvt_pk_bf16(p[hf * 8] * rp * gb[hf * 8], p[hf * 8 + 1] * rp * gb[hf * 8 + 1]); wb.y = pg8::cvt_pk_bf16(p[hf * 8 + 2] * rp * gb[hf * 8 + 2], p[hf * 8 + 3] * rp * gb[hf * 8 + 3]);
            wb.z = pg8::cvt_pk_bf16(p[hf * 8 + 4] * rp * gb[hf * 8 + 4], p[hf * 8 + 5] * rp * gb[hf * 8 + 5]); wb.w = pg8::cvt_pk_bf16(p[hf * 8 + 6] * rp * gb[hf * 8 + 6], p[hf * 8 + 7] * rp * gb[hf * 8 + 7]);
            *(pg8::u32x4*)(mix + (size_t)r * DM + lane * 16 + hf * 8) = wa; *(pg8::u32x4*)(mix + (size_t)r * DM + 1024 + lane * 16 + hf * 8) = wb; }
    }
}

struct EpiOut {
    const float* x; float* out; bf16_t* x1b; const float* lnm;
    __device__ __forceinline__ void operator()(const pg8::f32x4 (&acc)[2][2][4][2], const pg8::Unit& un, int wr, int wc, int fr, int fq) const {
#pragma unroll
        for (int ai = 0; ai < 2; ++ai)
#pragma unroll
            for (int m = 0; m < 4; ++m) {
                const int row = un.pm * 256 + ai * 128 + wr * 64 + m * 16 + fr;
#pragma unroll
                for (int bj = 0; bj < 2; ++bj)
#pragma unroll
                    for (int n = 0; n < 2; ++n) {
                        const size_t o = (size_t)row * DM + un.pn * 256 + bj * 128 + wc * 32 + n * 16 + 4 * fq;
                        const pg8::f32x4 v = acc[ai][bj][m][n] + *(const pg8::f32x4*)(x + o);
                        *(pg8::f32x4*)(out + o) = v;
                        const pg8::f32x4 g = *(const pg8::f32x4*)(lnm + un.pn * 256 + bj * 128 + wc * 32 + n * 16 + 4 * fq);
                        uint2 w; w.x = pg8::cvt_pk_bf16(v[0] * g[0], v[1] * g[1]); w.y = pg8::cvt_pk_bf16(v[2] * g[2], v[3] * g[3]); *(uint2*)(x1b + o) = w;
                    }
            }
    }
};
__device__ __forceinline__ void p7_out(const Frame& F, LAS unsigned char* stage) {
    pg8::DenseOrder S; S.init(F.ws + WS_MIX, F.ws + WS_WOUTT, DM, DM, NT, DM, F.G, F.bid);
    EpiOut E{F.in[I_X], F.out, (bf16_t*)(F.ws + WS_X1B), F.in[I_LNMOE]};
    pg8::gemm_phase<EpiOut, pg8::DenseOrder, false>(stage, DM, DM, DM, S, E);
}

__device__ __forceinline__ void p8_router(const Frame& F, int dummy) {
    typedef float f32x16 __attribute__((ext_vector_type(16)));
    const float* WR = (const float*)(F.ws + WS_WR); const float* WG4 = (const float*)(F.ws + WS_WG4); const float* brg = F.in[I_BRG]; const float* bre = F.in[I_BRE];
    float* rstd2 = (float*)(F.ws + (dummy ? WS_DBUF : WS_RSTD2)); int* arow = (int*)(F.ws + (dummy ? WS_DBUF + MB : WS_AROW)); int* tokl = (int*)(F.ws + (dummy ? WS_DBUF + 2 * MB : WS_TOKL)); float* gatel = (float*)(F.ws + (dummy ? WS_DBUF + 4 * MB : WS_GATEL));
    unsigned* cnt = (unsigned*)(F.ws + WS_CTL) + (dummy ? 8192 : CW_CNT);
    float* part = F.lds; float* ssp = part + 8 * 32 * 33; float* lgp = ssp + 256;
    const int lane = F.lane, row = lane & 31, half = lane >> 5, kbase = F.wave * 256;
    for (int it = F.bid; it < NT / 32; it += F.G) {
        const int tok0 = it * 32;
        const float* xp = F.out + (size_t)(tok0 + row) * DM + kbase + 4 * half;
        f32x16 acc = {0.f, 0.f, 0.f, 0.f, 0.f, 0.f, 0.f, 0.f, 0.f, 0.f, 0.f, 0.f, 0.f, 0.f, 0.f, 0.f};
        float ss = 0.f, lg0 = 0.f, lg1 = 0.f, lg2 = 0.f, lg3 = 0.f;
#pragma unroll 4
        for (int kb = 0; kb < 256; kb += 8) {
            const float4 xa = *(const float4*)(xp + kb);
            const int k0 = kbase + kb + 4 * half;
            ss += xa.x * xa.x + xa.y * xa.y + xa.z * xa.z + xa.w * xa.w;
            const float av[4] = {xa.x, xa.y, xa.z, xa.w};
#pragma unroll
            for (int j = 0; j < 4; ++j) {
                const float bv = WR[(size_t)(k0 + j) * 32 + row]; const float4 w4 = *(const float4*)(WG4 + (size_t)(k0 + j) * 4);
                acc = __builtin_amdgcn_mfma_f32_32x32x2f32(av[j], bv, acc, 0, 0, 0);
                lg0 += av[j] * w4.x; lg1 += av[j] * w4.y; lg2 += av[j] * w4.z; lg3 += av[j] * w4.w;
            }
        }
        ss += __shfl_xor(ss, 32); lg0 += __shfl_xor(lg0, 32); lg1 += __shfl_xor(lg1, 32); lg2 += __shfl_xor(lg2, 32); lg3 += __shfl_xor(lg3, 32);
        __syncthreads();
#pragma unroll
        for (int r = 0; r < 16; ++r) part[(F.wave * 32 + (r & 3) + 8 * (r >> 2) + 4 * half) * 33 + row] = acc[r];
        if (half == 0) { ssp[F.wave * 32 + row] = ss; float* q = lgp + (F.wave * 32 + row) * 4; q[0] = lg0; q[1] = lg1; q[2] = lg2; q[3] = lg3; }
        __syncthreads();
        if (F.wave == 0 && lane < 32) {
            const int t = lane, r = tok0 + t;
            float s2 = 0.f, lg[4] = {0.f, 0.f, 0.f, 0.f};
#pragma unroll
            for (int w = 0; w < 8; ++w) { s2 += ssp[w * 32 + t]; const float* q = lgp + (w * 32 + t) * 4; lg[0] += q[0]; lg[1] += q[1]; lg[2] += q[2]; lg[3] += q[3]; }
            const float rs = rsqrtf(s2 * (1.f / DM) + EPS);
#pragma unroll
            for (int j = 0; j < 4; ++j) lg[j] = lg[j] * rs + brg[j];
            int gs = 0; float gm = lg[0];
#pragma unroll
            for (int j = 1; j < 4; ++j) if (lg[j] > gm) { gm = lg[j]; gs = j; }
            float den = 0.f;
#pragma unroll
            for (int j = 0; j < 4; ++j) den += __expf(lg[j] - gm);
            const float pg = 1.f / den;
            float le[8];
#pragma unroll
            for (int j = 0; j < 8; ++j) { float s = 0.f;
#pragma unroll
                for (int w = 0; w < 8; ++w) s += part[(w * 32 + t) * 33 + gs * 8 + j];
                le[j] = s * rs + bre[gs * 8 + j]; }
            int e0 = 0; float m0 = le[0];
#pragma unroll
            for (int j = 1; j < 8; ++j) if (le[j] > m0) { m0 = le[j]; e0 = j; }
            int e1 = -1; float m1 = -3.0e38f;
#pragma unroll
            for (int j = 0; j < 8; ++j) if (j != e0 && le[j] > m1) { m1 = le[j]; e1 = j; }
            const float p1 = __expf(m1 - m0);
            const float gate0 = pg / (1.f + p1), gate1 = pg * p1 / (1.f + p1);
            rstd2[r] = rs;
            const int ea = gs * 8 + e0, eb = gs * 8 + e1;
            const unsigned sa = atomicAdd(&cnt[64 * ea], 1u), sb = atomicAdd(&cnt[64 * eb], 1u);
            tokl[ea * 8192 + sa] = r; gatel[ea * 8192 + sa] = gate0; tokl[eb * 8192 + sb] = r; gatel[eb * 8192 + sb] = gate1;
            arow[2 * r] = ea * 8192 + (int)sa; arow[2 * r + 1] = eb * 8192 + (int)sb;
        }
    }
}

__device__ __forceinline__ void moe_counts(const Frame& F, int* cnts  , int* pst  ) {
    const unsigned* cnt = (const unsigned*)(F.ws + WS_CTL) + CW_CNT;
    __syncthreads();
    if (F.tid < 32) cnts[F.tid] = (int)__hip_atomic_load(&cnt[64 * F.tid], __ATOMIC_RELAXED, __HIP_MEMORY_SCOPE_AGENT);
    __syncthreads();
    if (F.tid == 0) { int a = 0; for (int e = 0; e < 32; ++e) { pst[e] = a; a += (cnts[e] + 255) & ~255; } pst[32] = a; }
    __syncthreads();
}

constexpr int MOE_TAB_OFF = 1024 + 131072;
struct MoeTabs { int* cnts; int* pst; int* ust; int* rowtok; };
__device__ __forceinline__ MoeTabs moe_tabs(unsigned char* lds_raw) { MoeTabs T; T.cnts = (int*)(lds_raw + MOE_TAB_OFF); T.pst = T.cnts + 32; T.ust = T.pst + 40; T.rowtok = T.ust + 40; return T; }
template <int NTN> __device__ __forceinline__ void moe_units(const Frame& F, const MoeTabs& T) {
    moe_counts(F, T.cnts, T.pst);
    if (F.tid == 0) { int a = 0; for (int e = 0; e < 32; ++e) { T.ust[e] = a; a += ((T.cnts[e] + 255) >> 8) * NTN; } T.ust[32] = a; }
    __syncthreads();
}
template <int NTN> struct MoeOrder2 {
    const int* cnts; const int* pst; const int* ust; const int* rowtok; const bf16_t* A; const float* W0; const float* W1; int G, c, lda, ldb, gather;
    __device__ __forceinline__ bool next(int i, g2::Unit& u) const {
        const int L = i * G + c; if (L >= ust[32]) return false;
        int e = 0; while (ust[e + 1] <= L) ++e;
        const int w = L - ust[e], nmt = (cnts[e] + 255) >> 8; u.e = e; u.pn = w / nmt; u.pm = w - u.pn * nmt; u.li = i; return true;
    }
    __device__ __forceinline__ const bf16_t* a_row(const g2::Unit& u, int r) const {
        if (gather) { const int tk = rowtok[u.li * 256 + r]; return A + (size_t)(tk < 0 ? 0 : tk) * lda; }
        return A + (size_t)(pst[u.e] + u.pm * 256 + r) * lda;
    }
    __device__ __forceinline__ const float* b_col(const g2::Unit& u, int col) const {
        if (gather) { const int wcp = col >> 5, n = (col >> 4) & 1, i = col & 15; return (n ? W1 : W0) + (size_t)u.e * DM * FF + u.pn * 64 + 16 * wcp + i; }
        return W0 + (size_t)u.e * FF * DM + u.pn * 128 + col;
    }
};
struct EpiMoe1 {
    const int* pst; const int* rowtok; const float* rstd2; bf16_t* act;
    __device__ __forceinline__ void operator()(const pg8::f32x4 (&acc)[2][4][2], const g2::Unit& un, int wr, int wc, int fr, int fq) const {
#pragma unroll
        for (int ai = 0; ai < 2; ++ai)
#pragma unroll
            for (int m = 0; m < 4; ++m) {
                const int r = ai * 128 + wr * 64 + m * 16 + fr; const int tk = rowtok[un.li * 256 + r];
                if (tk >= 0) {
                    const float rs = rstd2[tk];
                    const pg8::f32x4 vg = acc[ai][m][0] * rs, vu = acc[ai][m][1] * rs; float o[4];
#pragma unroll
                    for (int j = 0; j < 4; ++j) o[j] = vg[j] / (1.f + __expf(-vg[j])) * vu[j];
                    uint2 w; w.x = pg8::cvt_pk_bf16(o[0], o[1]); w.y = pg8::cvt_pk_bf16(o[2], o[3]);
                    *(uint2*)(act + (size_t)(pst[un.e] + un.pm * 256 + r) * FF + un.pn * 64 + wc * 16 + 4 * fq) = w;
                }
            }
    }
};
struct EpiMoe2 {
    const int* cnts; const int* pst; const float* gatel; bf16_t* y;
    __device__ __forceinline__ void operator()(const pg8::f32x4 (&acc)[2][4][2], const g2::Unit& un, int wr, int wc, int fr, int fq) const {
#pragma unroll
        for (int ai = 0; ai < 2; ++ai)
#pragma unroll
            for (int m = 0; m < 4; ++m) {
                const int slot = un.pm * 256 + ai * 128 + wr * 64 + m * 16 + fr;
                if (slot < cnts[un.e]) {
                    const float gt = gatel[un.e * 8192 + slot];
                    bf16_t* dst = y + (size_t)(pst[un.e] + slot) * DM + un.pn * 128 + wc * 32 + 4 * fq;
#pragma unroll
                    for (int n = 0; n < 2; ++n) { const pg8::f32x4 v = acc[ai][m][n] * gt; uint2 w; w.x = pg8::cvt_pk_bf16(v[0], v[1]); w.y = pg8::cvt_pk_bf16(v[2], v[3]); *(uint2*)(dst + n * 16) = w; }
                }
            }
    }
};

__device__ __forceinline__ void p9_moe1(const Frame& F, unsigned char* lds_raw, LAS unsigned char* stage) {
    const MoeTabs T = moe_tabs(lds_raw);
    moe_units<8>(F, T);
    const int vc = (F.G % 8 == 0) ? (F.bid % 8) * (F.G / 8) + F.bid / 8 : F.bid;
    MoeOrder2<8> S{T.cnts, T.pst, T.ust, T.rowtok, (const bf16_t*)(F.ws + WS_X1B), F.in[I_WGATE], F.in[I_WUP], F.G, vc, DM, FF, 1};
    { const int* tokl = (const int*)(F.ws + WS_TOKL); g2::Unit u;
      for (int i = 0; i < 4 && S.next(i, u); ++i) { if (F.tid < 256) { const int slot = u.pm * 256 + F.tid; T.rowtok[i * 256 + F.tid] = slot < T.cnts[u.e] ? tokl[u.e * 8192 + slot] : -1; } } }
    asm volatile("s_waitcnt vmcnt(0) lgkmcnt(0)" ::: "memory");
    __syncthreads();
    EpiMoe1 E{T.pst, T.rowtok, (const float*)(F.ws + WS_RSTD2), (bf16_t*)(F.ws + WS_ACT)};
    g2::gemm<EpiMoe1, MoeOrder2<8>>(stage, DM, S, E);
}

__device__ __forceinline__ void p10_moe2(const Frame& F, unsigned char* lds_raw, LAS unsigned char* stage) {
    const MoeTabs T = moe_tabs(lds_raw);
    moe_units<16>(F, T);
    const int vc = (F.G % 8 == 0) ? (F.bid % 8) * (F.G / 8) + F.bid / 8 : F.bid;
    MoeOrder2<16> S{T.cnts, T.pst, T.ust, nullptr, (const bf16_t*)(F.ws + WS_ACT), F.in[I_WDOWN], nullptr, F.G, vc, FF, DM, 0};
    EpiMoe2 E{T.cnts, T.pst, (const float*)(F.ws + WS_GATEL), (bf16_t*)(F.ws + WS_Y)};
    g2::gemm<EpiMoe2, MoeOrder2<16>>(stage, FF, S, E);
}

__device__ __forceinline__ void p11_final(const Frame& F, int dummy) {
    int* cnts = (int*)(F.lds + 3072); int* pst = cnts + 32;
    moe_counts(F, cnts, pst);
    const bf16_t* y = (const bf16_t*)(F.ws + WS_Y); const int* arow = (const int*)(F.ws + WS_AROW); const float* lnf = F.in[I_LNFINAL];
    const int gw = F.bid * NWAVES + F.wave, nw = F.G * NWAVES, lane = F.lane;
    for (int r = gw; r < NT; r += nw) {
        const int a0 = arow[2 * r], a1 = arow[2 * r + 1];
        const size_t r0 = (size_t)(pst[a0 >> 13] + (a0 & 8191)), r1 = (size_t)(pst[a1 >> 13] + (a1 & 8191));
        float v[32]; float ss = 0.f;
#pragma unroll
        for (int i = 0; i < 8; ++i) { const int c = i * 256 + lane * 4; const float4 xv = *(const float4*)(F.out + (size_t)r * DM + c);
            const uint2 ya = *(const uint2*)(y + r0 * DM + c), yb = *(const uint2*)(y + r1 * DM + c);
            v[4 * i]     = xv.x + __uint_as_float(ya.x << 16) + __uint_as_float(yb.x << 16);
            v[4 * i + 1] = xv.y + __uint_as_float(ya.x & 0xFFFF0000u) + __uint_as_float(yb.x & 0xFFFF0000u);
            v[4 * i + 2] = xv.z + __uint_as_float(ya.y << 16) + __uint_as_float(yb.y << 16);
            v[4 * i + 3] = xv.w + __uint_as_float(ya.y & 0xFFFF0000u) + __uint_as_float(yb.y & 0xFFFF0000u);
            ss += v[4 * i] * v[4 * i] + v[4 * i + 1] * v[4 * i + 1] + v[4 * i + 2] * v[4 * i + 2] + v[4 * i + 3] * v[4 * i + 3]; }
        ss = wave_sum(ss);
        const float rs = rsqrtf(ss * (1.f / DM) + EPS);
#pragma unroll
        for (int i = 0; i < 8; ++i) { const int c = i * 256 + lane * 4; const float4 g = *(const float4*)(lnf + c);
            float4 o; o.x = v[4 * i] * rs * g.x; o.y = v[4 * i + 1] * rs * g.y; o.z = v[4 * i + 2] * rs * g.z; o.w = v[4 * i + 3] * rs * g.w;
            *(float4*)((dummy ? (float*)(F.ws + WS_W1T) : F.out) + (size_t)r * DM + c) = o; }
    }
}

constexpr int NPHASE = 11;
__global__ void __launch_bounds__(NTHREADS, 2) fwd(Args args) {
    extern __shared__ __attribute__((aligned(16))) unsigned char lds_raw[];
    Frame F;
#pragma unroll
    for (int i = 0; i < N_IN; ++i) F.in[i] = args.in[i];
    F.out = args.out; F.ws = args.ws;
    F.lds = (float*)(lds_raw + 16);
    F.tid = threadIdx.x; F.lane = F.tid & 63; F.wave = __builtin_amdgcn_readfirstlane(F.tid >> 6); F.G = gridDim.x; F.bid = blockIdx.x;
    if (F.tid < 4) ((LAS unsigned*)lds_raw)[F.tid] = 0u;
    __syncthreads();
    XcdBarrier bar; bar.bar = (unsigned*)(F.ws + WS_CTL); bar.x = 0; bar.st = nullptr;
    if (N_LAUNCHES == 1) bar = xcd_barrier_post((unsigned*)(F.ws + WS_CTL), (volatile LAS unsigned*)lds_raw);
    const int lo = args.ph_lo, hi = args.ph_hi;
#ifndef ONLY_PHASE
#define ONLY_PHASE -1
#endif
#define IN(k) (lo <= (k) && (k) < hi && (ONLY_PHASE < 0 || ONLY_PHASE == (k)))
#define SEAM(k) do { if (IN(k) && IN((k) + 1)) { xcd_barrier(bar); if (PROBE_REPEAT == 12) xcd_barrier(bar); } } while (0)
    LAS unsigned char* stage = (LAS unsigned char*)lds_raw + 1024;
#define RUN(k, ...) do { if (IN(k)) { __VA_ARGS__; if (PROBE_REPEAT == (k)) { xcd_barrier(bar); __VA_ARGS__; } } } while (0)
    RUN(0, p0_prologue(F));
    if (PROBE_REPEAT == 11 && IN(0)) { xcd_barrier(bar); cvt_stream(F, 0, 6400, nullptr); }
    SEAM(0);
    RUN(1, p1_proj(F, stage));
    SEAM(1);
    if (IN(2)) { p3_mid(F, stage, 0); if (PROBE_REPEAT == 2) { xcd_barrier(bar); p3_mid(F, stage, 1); } }
    SEAM(2);
    RUN(3, p4_cmp2(F));
    SEAM(3);
    if (IN(4)) {
#pragma unroll 1
        for (int rep = 0; rep < (PROBE_REPEAT == 4 ? 2 : 1); ++rep) { if (rep) xcd_barrier(bar); p_attn(F, lds_raw, rep); } }
    SEAM(4);
    RUN(5, p6_mix(F));
    SEAM(5);
    RUN(6, p7_out(F, stage));
    SEAM(6);
    if (IN(7)) { if (PROBE_REPEAT == 7) { p8_router(F, 1); xcd_barrier(bar); } p8_router(F, 0); }
    SEAM(7);
    RUN(8, p9_moe1(F, lds_raw, stage));
    SEAM(8);
    RUN(9, p10_moe2(F, lds_raw, stage));
    SEAM(9);
    if (IN(10)) { if (PROBE_REPEAT == 10) { p11_final(F, 1); xcd_barrier(bar); } p11_final(F, 0); }
#undef RUN
#undef IN
#undef SEAM
}

extern "C" void kernel_launch(void* const* d_in, const int* in_sizes, int n_in, void* d_out, int out_size, void* d_ws, size_t ws_size, hipStream_t stream) {
    static int grid = 0;
    if (grid == 0) {
        if (n_in != N_IN || out_size != NT * DM || ws_size < WS_END) { fprintf(stderr, "kernel_launch: unexpected shapes: n_in %d out %d ws %zu (need %zu)\n", n_in, out_size, ws_size, (size_t)WS_END); grid = -1; return; }
        int dev = 0, cus = 0, per_cu = 0;
        if (hipGetDevice(&dev) != hipSuccess || hipDeviceGetAttribute(&cus, hipDeviceAttributeMultiprocessorCount, dev) != hipSuccess) { grid = -1; return; }
        if (hipFuncSetAttribute((const void*)fwd, hipFuncAttributeMaxDynamicSharedMemorySize, LDS_BYTES) != hipSuccess) { fprintf(stderr, "kernel_launch: hipFuncSetAttribute failed\n"); grid = -1; return; }
        if (hipOccupancyMaxActiveBlocksPerMultiprocessor(&per_cu, (const void*)fwd, NTHREADS, LDS_BYTES) != hipSuccess || per_cu < 1) { fprintf(stderr, "kernel_launch: occupancy query says %d\n", per_cu); }
        (void)hipGetLastError();
        grid = cus;
    }
    if (grid < 0) return;
    (void)in_sizes;
    (void)hipMemsetAsync((char*)d_ws + WS_CTL, 0, CTL_ZERO_BYTES, stream);
    Args a{};
    for (int i = 0; i < N_IN; ++i) a.in[i] = (const float*)d_in[i];
    a.out = (float*)d_out; a.ws = (unsigned char*)d_ws;
    if (N_LAUNCHES == 1) { a.ph_lo = 0; a.ph_hi = NPHASE; hipLaunchKernelGGL(fwd, dim3(grid), dim3(NTHREADS), LDS_BYTES, stream, a); }
    else { for (int p = 0; p < NPHASE; ++p) { a.ph_lo = p; a.ph_hi = p + 1; hipLaunchKernelGGL(fwd, dim3(grid), dim3(NTHREADS), LDS_BYTES, stream, a); } }
}
```

```cpp
#include <hip/hip_runtime.h>
#include <cstdio>
#include <cstdint>

#ifndef PROBE_REPEAT
#define PROBE_REPEAT -1
#endif
#ifndef N_LAUNCHES
#define N_LAUNCHES 1
#endif

#define XB_TMO      128
#define XB_XCNT(j)  (256  + 64 * (j))
#define XB_XSUB(j)  (1280 + 64 * (j))
#define XB_XGEN(j)  (2304 + 64 * (j))
#define XB_TOP      3328
#define XB_TOPGEN   3392
#define XCD_BAR_WORDS 3456
#define XB_SPIN_CAP (1u << 21)
#define LAS __attribute__((address_space(3)))

__device__ __forceinline__ unsigned xb_ld(unsigned* p)              { return __hip_atomic_load(p, __ATOMIC_RELAXED, __HIP_MEMORY_SCOPE_AGENT); }
__device__ __forceinline__ unsigned xb_add(unsigned* p, unsigned v) { return __hip_atomic_fetch_add(p, v, __ATOMIC_RELAXED, __HIP_MEMORY_SCOPE_AGENT); }
__device__ __forceinline__ unsigned xb_xcc_id() { return (unsigned)__builtin_amdgcn_s_getreg((3 << 11) | 20) & 0xFu; }
#define XB_SPIN(cond, bar) do { unsigned _sp = 0; while (cond) { __builtin_amdgcn_s_sleep(1); \
    if ((++_sp & 255u) == 0u) { if (xb_ld(&(bar)[XB_TMO])) break; if (_sp > XB_SPIN_CAP) { atomicAdd(&(bar)[XB_TMO], 1u); break; } } } } while (0)

struct XcdBarrier { unsigned* bar; unsigned x; volatile LAS unsigned* st; };

__device__ __forceinline__ XcdBarrier xcd_barrier_post(unsigned* bar, volatile LAS unsigned* st) {
    XcdBarrier b; b.bar = bar; b.x = xb_xcc_id(); b.st = st;
    if (threadIdx.x == 0) (void)xb_add(&bar[XB_XCNT(b.x)], 1u);
    return b;
}
__device__ __forceinline__ void xcd_barrier_complete(unsigned* bar, unsigned x, unsigned& nloc, unsigned& nx) {
    const unsigned G = gridDim.x * gridDim.y * gridDim.z;
    unsigned sum, cnt, mine, sp = 0u;
    for (;;) {
        sum = 0u; cnt = 0u; mine = 0u;
#pragma unroll
        for (unsigned j = 0; j < 16; ++j) { const unsigned c = xb_ld(&bar[XB_XCNT(j)]); sum += c; cnt += (c > 0u) ? 1u : 0u; mine = (j == x) ? c : mine; }
        if (sum == G) break;
        __builtin_amdgcn_s_sleep(1);
        if ((++sp & 255u) == 0u) { if (xb_ld(&bar[XB_TMO])) break; if (sp > XB_SPIN_CAP) { atomicAdd(&bar[XB_TMO], 1u); break; } }
    }
    nloc = mine > 0u ? mine : 1u; nx = cnt > 0u ? cnt : 1u;
}
__device__ __forceinline__ void xcd_barrier(const XcdBarrier& b) {
    asm volatile("s_waitcnt vmcnt(0)" ::: "memory");
    __syncthreads();
    if (threadIdx.x == 0) {
        unsigned* bar = b.bar;
        __builtin_amdgcn_s_waitcnt(0);
        unsigned nloc = b.st[0], nx = b.st[1];
        if (nloc == 0u) { xcd_barrier_complete(bar, b.x, nloc, nx); b.st[0] = nloc; b.st[1] = nx; }
        const unsigned old = xb_add(&bar[XB_XSUB(b.x)], 1u);
        const unsigned gen = old / nloc;
        if (old + 1u == (gen + 1u) * nloc) {
            __builtin_amdgcn_fence(__ATOMIC_RELEASE, "agent");
            asm volatile("s_waitcnt vmcnt(0)" ::: "memory");
            const unsigned og = xb_add(&bar[XB_TOP], 1u);
            const unsigned tg = og / nx;
            if (og + 1u == (tg + 1u) * nx) xb_add(&bar[XB_TOPGEN], 1u);
            else XB_SPIN(xb_ld(&bar[XB_TOPGEN]) == tg, bar);
            __builtin_amdgcn_fence(__ATOMIC_ACQUIRE, "agent");
            xb_add(&bar[XB_XGEN(b.x)], 1u);
            asm volatile("s_waitcnt vmcnt(0)" ::: "memory");
        } else {
            XB_SPIN(xb_ld(&bar[XB_XGEN(b.x)]) == gen, bar);
            __builtin_amdgcn_fence(__ATOMIC_ACQUIRE, "agent");
            asm volatile("s_waitcnt vmcnt(0)" ::: "memory");
        }
    }
    __syncthreads();
}

typedef unsigned short bf16_t;
constexpr int NB = 4, SEQ = 2048, DM = 2048, NT = NB * SEQ;
constexpr int NH = 8, NG = 2, HD = 128, INW = 3608, INWP = 3840;
constexpr int NCMP = 127, NSEL = 32, NEXP = 32, FF = 512;
constexpr float EPS = 1e-6f;
constexpr float SCALE = 0.08838834764831845f;
constexpr int NTHREADS = 512, NWAVES = 8;
constexpr int LDS_BYTES = 147456;
constexpr int YROWS = 24576;

enum { I_X = 0, I_POS, I_LNMIX, I_WIN, I_PEK, I_WK1, I_WK2, I_PEV, I_WV1, I_WV2, I_WPOOL, I_BPOOL, I_PSCALE, I_GNNSA, I_GNPOOL, I_WOUT, I_LNMOE,
       I_WRG, I_BRG, I_WRE, I_BRE, I_WGATE, I_WUP, I_WDOWN, I_LNFINAL, N_IN };

constexpr size_t MB = 1024 * 1024;
constexpr size_t WS_CTL   = 0;
constexpr size_t CTL_ZERO_BYTES = 65536;
constexpr int    CW_CNT   = 4096;
constexpr size_t WS_RSTD1 = 1 * MB;
constexpr size_t WS_RSTD2 = 1 * MB + 65536;
constexpr size_t WS_BIAS1 = 1 * MB + 131072;
constexpr size_t WS_AROW  = 1 * MB + 262144;
constexpr size_t WS_WR    = 1 * MB + 393216;
constexpr size_t WS_WG4   = 1 * MB + 655360;
constexpr size_t WS_ROPEC = 2 * MB;
constexpr size_t WS_ROPES = 2 * MB + 524288;
constexpr size_t WS_GATES = 3 * MB;
constexpr size_t WS_TOKL  = 4 * MB;
constexpr size_t WS_GATEL = 5 * MB;
constexpr size_t WS_HID   = 6 * MB;
constexpr size_t WS_CMPKV = 8 * MB;
constexpr size_t WS_WINT  = 9 * MB;
constexpr size_t WS_WOUTT = 24 * MB;
constexpr size_t WS_W1T   = 32 * MB;
constexpr size_t WS_W2T   = 160 * MB;
constexpr size_t WS_CMPW  = 224 * MB;
constexpr size_t WS_POOLW = 228 * MB;
constexpr size_t WS_POOLB = 228 * MB + 524288;
constexpr size_t WS_CPART = 447 * MB;
constexpr size_t WS_DBUF  = 463 * MB;
constexpr size_t WS_XB    = 230 * MB;
constexpr size_t WS_QN    = 262 * MB;
constexpr size_t WS_QR    = 278 * MB;
constexpr size_t WS_KV    = 294 * MB;
constexpr size_t WS_U     = 319 * MB;
constexpr size_t WS_Y     = 230 * MB;
constexpr size_t WS_OWIN  = 351 * MB;
constexpr size_t WS_OCMP  = 367 * MB;
constexpr size_t WS_OSEL  = 319 * MB;
constexpr size_t WS_ML    = 6 * MB;
constexpr size_t WS_X1B   = 351 * MB;
constexpr size_t WS_OPOOL = 383 * MB;
constexpr size_t WS_ACT   = 383 * MB;
constexpr size_t WS_MIX   = 415 * MB;
constexpr size_t WS_END   = 479 * MB;

__device__ __forceinline__ bf16_t f2bf(float f) { unsigned u = __float_as_uint(f); u += 0x7FFFu + ((u >> 16) & 1u); return (bf16_t)(u >> 16); }
__device__ __forceinline__ float bf2f(bf16_t b) { return __uint_as_float(((unsigned)b) << 16); }
__device__ __forceinline__ float wave_sum(float v) {
#pragma unroll
    for (int o = 32; o >= 1; o >>= 1) v += __shfl_xor(v, o);
    return v;
}
__device__ __forceinline__ float wave_max(float v) {
#pragma unroll
    for (int o = 32; o >= 1; o >>= 1) v = fmaxf(v, __shfl_xor(v, o));
    return v;
}

struct Args { const float* in[N_IN]; float* out; unsigned char* ws; int ph_lo, ph_hi; };

struct Frame {
    const float* in[N_IN]; float* out; unsigned char* ws;
    float* lds;
    int tid, lane, wave, G, bid;
};

template <int NACC, bool B_KFAST, class FA, class FB, class FE>
__device__ __forceinline__ void ngemm_tile(const Frame& F, int K, FA fa, FB fb, FE fe) {
    float* As = F.lds;
    float* Bs = F.lds + 1024;
    const int tid = F.tid, ty = tid >> 4, tx = tid & 15;
    float acc[NACC][2][4];
#pragma unroll
    for (int w = 0; w < NACC; ++w)
#pragma unroll
        for (int i = 0; i < 2; ++i)
#pragma unroll
            for (int j = 0; j < 4; ++j) acc[w][i][j] = 0.f;
    for (int k0 = 0; k0 < K; k0 += 16) {
#pragma unroll
        for (int i = 0; i < 2; ++i) { const int idx = tid + 512 * i, m = idx >> 4, kk = idx & 15; As[kk * 64 + m] = fa(m, k0 + kk); }
#pragma unroll
        for (int w = 0; w < NACC; ++w)
#pragma unroll
            for (int i = 0; i < 2; ++i) { const int idx = tid + 512 * i; int kk, n; if (B_KFAST) { n = idx >> 4; kk = idx & 15; } else { kk = idx >> 6; n = idx & 63; }
                Bs[w * 1024 + kk * 64 + n] = fb(w, k0 + kk, n); }
        __syncthreads();
#pragma unroll
        for (int kk = 0; kk < 16; ++kk) {
            const float a0 = As[kk * 64 + 2 * ty], a1 = As[kk * 64 + 2 * ty + 1];
#pragma unroll
            for (int w = 0; w < NACC; ++w) {
                const float4 b = *(const float4*)&Bs[w * 1024 + kk * 64 + 4 * tx];
                acc[w][0][0] += a0 * b.x; acc[w][0][1] += a0 * b.y; acc[w][0][2] += a0 * b.z; acc[w][0][3] += a0 * b.w;
                acc[w][1][0] += a1 * b.x; acc[w][1][1] += a1 * b.y; acc[w][1][2] += a1 * b.z; acc[w][1][3] += a1 * b.w;
            }
        }
        __syncthreads();
    }
#pragma unroll
    for (int i = 0; i < 2; ++i)
#pragma unroll
        for (int j = 0; j < 4; ++j) fe(2 * ty + i, 4 * tx + j, acc[0][i][j], acc[NACC - 1][i][j]);
}

template <class KR>
__device__ __forceinline__ void nattn(const float* qv, float* sc, int nkeys, KR keyrow, const bf16_t* Kb, const bf16_t* Vb, int lane, float& o0, float& o1, float& inv_sum) {
    float mx = -3.0e38f;
    for (int i = lane; i < nkeys; i += 64) {
        const int kr = keyrow(i);
        float s = -3.0e38f;
        if (kr >= 0) {
            const bf16_t* kp = Kb + (size_t)kr * HD;
            float a = 0.f;
#pragma unroll 8
            for (int d = 0; d < HD; d += 2) { const unsigned w = *(const unsigned*)(kp + d); a += qv[d] * __uint_as_float(w << 16) + qv[d + 1] * __uint_as_float(w & 0xFFFF0000u); }
            s = a * SCALE;
        }
        sc[i] = s; mx = fmaxf(mx, s);
    }
    mx = wave_max(mx);
    if (mx < -1.0e38f) { o0 = 0.f; o1 = 0.f; inv_sum = 0.f; for (int i = lane; i < nkeys; i += 64) sc[i] = 0.f; return; }
    float sum = 0.f;
    for (int i = lane; i < nkeys; i += 64) { const float s = sc[i]; const float e = (s < -1.0e38f) ? 0.f : __expf(s - mx); sc[i] = e; sum += e; }
    sum = wave_sum(sum);
    inv_sum = 1.f / sum;
    float a0 = 0.f, a1 = 0.f;
    for (int i = 0; i < nkeys; ++i) {
        const float p = sc[i];
        if (p != 0.f) { const int kr = keyrow(i); const bf16_t* vp = Vb + (size_t)kr * HD; a0 += p * bf2f(vp[lane]); a1 += p * bf2f(vp[lane + 64]); }
    }
    o0 = a0 * inv_sum; o1 = a1 * inv_sum;
}

__device__ __forceinline__ float gelu_tanh(float x) { const float u = 0.7978845608028654f * (x + 0.044715f * x * x * x); return 0.5f * x * (1.f + tanhf(u)); }


namespace pg8 {
typedef short bf16x8 __attribute__((ext_vector_type(8)));
typedef float f32x4 __attribute__((ext_vector_type(4)));
typedef unsigned u32x4 __attribute__((ext_vector_type(4)));
constexpr int BM = 256, BK = 64, HALF = 128, HTB = HALF * BK * 2, STAGE_BYTES = 8 * HTB, NXCD = 8, WGM = 8;
__device__ __forceinline__ int lds_byte(int r, int c) { const int st = (r >> 4) * 2 + (c >> 5), rr = r & 15, cc = c & 31, ob = rr * 64 + cc * 2; return st * 1024 + (ob ^ (((ob >> 9) & 1) << 5)); }
__device__ __forceinline__ void stage_rc(int b, int& R, int& C) { const int st = b / 1024, sb = b % 1024, swz = sb ^ (((sb >> 9) & 1) << 5); R = (st >> 1) * 16 + swz / 64; C = (st & 1) * 32 + (swz % 64) / 2; }
struct Unit { int pm, pn, e, li; };
__device__ __forceinline__ unsigned cvt_pk_bf16(float lo, float hi) { unsigned r; asm volatile("v_cvt_pk_bf16_f32 %0, %1, %2" : "=v"(r) : "v"(lo), "v"(hi)); return r; }

struct DenseOrder {
    const char* A; const char* Bt; int lda, ldb; int nM, nN, nwg, G, c;
    __device__ void init(const void* A_, const void* Bt_, int lda_, int ldb_, int M, int N, int G_, int c_) { A = (const char*)A_; Bt = (const char*)Bt_; lda = lda_; ldb = ldb_; nM = M / BM; nN = N / BM; nwg = nM * nN; G = G_; c = c_; }
    __device__ __forceinline__ bool next(int i, Unit& u) const {
        const long L = (long)i * G + c; if (L >= nwg) return false;
        int wgid = (int)L; { const int q = nwg / NXCD, r = nwg % NXCD, xcd = wgid % NXCD, off = wgid / NXCD; wgid = (xcd < r ? xcd * (q + 1) : r * (q + 1) + (xcd - r) * q) + off; }
        const int nig = WGM * nN, gid = wgid / nig, fm = gid * WGM, gsz = (nM - fm) < WGM ? (nM - fm) : WGM;
        u.pm = fm + ((wgid % nig) % gsz); u.pn = (wgid % nig) / gsz; u.e = 0; u.li = i; return true;
    }
    __device__ __forceinline__ const char* a_base(const Unit& u) const { return A + (size_t)u.pm * BM * lda * 2; }
    __device__ __forceinline__ const char* b_base(const Unit& u) const { return Bt + (size_t)u.pn * BM * ldb * 2; }
    __device__ __forceinline__ unsigned a_row_off(const Unit&, int r) const { return (unsigned)r * (unsigned)lda * 2u; }
};

template <class Epi, class Sched, bool GATHER>
__device__ __forceinline__ void gemm_phase(LAS unsigned char* lds, const int K, const int lda, const int ldb, const Sched& S, const Epi& E) {
    const int tid = threadIdx.x, wid = __builtin_amdgcn_readfirstlane(tid >> 6), lane = tid & 63, wr = wid >> 2, wc = wid & 3, fr = lane & 15, fq = lane >> 4;
    const int nt = K / BK;
    int sR[2], sC[2];
#pragma unroll
    for (int i = 0; i < 2; ++i) stage_rc(tid * 16 + i * 8192, sR[i], sC[i]);
    unsigned voffB[2], voffA[2][2], nvoffA[2][2];
#pragma unroll
    for (int i = 0; i < 2; ++i) voffB[i] = (unsigned)(sR[i] * ldb + sC[i]) * 2u;
    const size_t kstep = (size_t)(BK * 2);
    const size_t hstepB = (size_t)HALF * ldb * 2;
    const unsigned ldsw = (unsigned)wid * 1024u;
    const int aoff = lds_byte(wr * 64 + fr, fq * 8), boff = lds_byte(wc * 32 + fr, fq * 8);
#define PG8_SA(b, h) (((b) * 2 + (h)) * HTB)
#define PG8_SB(b, h) ((4 + (b) * 2 + (h)) * HTB)
#define PG8_STAGE(bufoff, gbase, voff) do { _Pragma("unroll") for (int _i = 0; _i < 2; ++_i) \
        __builtin_amdgcn_global_load_lds((const unsigned*)((const char*)(gbase) + (voff)[_i]), (LAS unsigned*)(lds + (bufoff) + ldsw + _i * 8192), 16, 0, 0); } while (0)
#define PG8_LDA(dst, b, h) do { _Pragma("unroll") for (int m = 0; m < 4; ++m) _Pragma("unroll") for (int k = 0; k < 2; ++k) dst[m][k] = *(const LAS bf16x8*)(lds + PG8_SA(b, h) + aoff + m * 2048 + k * 1024); } while (0)
#define PG8_LDB(dst, b, h) do { _Pragma("unroll") for (int n = 0; n < 2; ++n) _Pragma("unroll") for (int k = 0; k < 2; ++k) dst[n][k] = *(const LAS bf16x8*)(lds + PG8_SB(b, h) + boff + n * 2048 + k * 1024); } while (0)
#define PG8_MMA(ai, bj, At, Bt) do { __builtin_amdgcn_s_setprio(1); _Pragma("unroll") for (int m = 0; m < 4; ++m) _Pragma("unroll") for (int n = 0; n < 2; ++n) _Pragma("unroll") for (int k = 0; k < 2; ++k) \
        acc[ai][bj][m][n] = __builtin_amdgcn_mfma_f32_16x16x32_bf16(Bt[n][k], At[m][k], acc[ai][bj][m][n], 0, 0, 0); __builtin_amdgcn_s_setprio(0); } while (0)
#define PG8_WAIT_V(n) asm volatile("s_waitcnt vmcnt(" #n ")" ::: "memory")
#define PG8_WAIT_L(n) asm volatile("s_waitcnt lgkmcnt(" #n ")" ::: "memory")
#define PG8_BAR __builtin_amdgcn_s_barrier()
#define PG8_SCHED __builtin_amdgcn_sched_barrier(0)
#define PG8_AOFFS(dst, u) do { _Pragma("unroll") for (int _h = 0; _h < 2; ++_h) _Pragma("unroll") for (int _i = 0; _i < 2; ++_i) dst[_h][_i] = S.a_row_off(u, _h * HALF + sR[_i]) + (unsigned)sC[_i] * 2u; } while (0)
    Unit cur, nxt; int ui = 0;
    if (!S.next(0, cur)) return;
    f32x4 acc[2][2][4][2];
#pragma unroll
    for (int a = 0; a < 2; ++a)
#pragma unroll
        for (int b = 0; b < 2; ++b)
#pragma unroll
            for (int m = 0; m < 4; ++m)
#pragma unroll
                for (int n = 0; n < 2; ++n) acc[a][b][m][n] = (f32x4){0.f, 0.f, 0.f, 0.f};
    bf16x8 At[4][2], B0[2][2], B1[2][2];
    const char* cA = S.a_base(cur); const char* cB = S.b_base(cur);
    PG8_AOFFS(voffA, cur);
    PG8_STAGE(PG8_SB(0, 0), cB, voffB); PG8_STAGE(PG8_SA(0, 0), cA, voffA[0]); PG8_STAGE(PG8_SB(0, 1), cB + hstepB, voffB); PG8_STAGE(PG8_SA(0, 1), cA, voffA[1]);
    if (wr == 1) PG8_BAR;
    PG8_WAIT_V(4); PG8_BAR;
    PG8_STAGE(PG8_SB(1, 0), cB + kstep, voffB); PG8_STAGE(PG8_SA(1, 0), cA + kstep, voffA[0]); PG8_STAGE(PG8_SB(1, 1), cB + hstepB + kstep, voffB);
    PG8_WAIT_V(6); PG8_BAR;
    for (;;) {
        const bool has_next = S.next(ui + 1, nxt);
        const char* nA = has_next ? S.a_base(nxt) : cA; const char* nB = has_next ? S.b_base(nxt) : cB;
        if (GATHER) { if (has_next) { PG8_AOFFS(nvoffA, nxt); } else {
#pragma unroll
            for (int _h = 0; _h < 2; ++_h)
#pragma unroll
                for (int _i = 0; _i < 2; ++_i) nvoffA[_h][_i] = voffA[_h][_i]; } }
        for (int t = 0; t < nt; t += 2) {
            const bool last = (t == nt - 2);
            const char* a1 = cA + (size_t)(t + 1) * kstep;
            const char* a2 = last ? nA : cA + (size_t)(t + 2) * kstep; const char* b2 = last ? nB : cB + (size_t)(t + 2) * kstep;
            const char* a3 = a2 + kstep; const char* b3 = b2 + kstep;
            unsigned vA2[2][2];
#pragma unroll
            for (int _h = 0; _h < 2; ++_h)
#pragma unroll
                for (int _i = 0; _i < 2; ++_i) vA2[_h][_i] = (GATHER && last) ? nvoffA[_h][_i] : voffA[_h][_i];
            PG8_LDB(B0, 0, 0); PG8_SCHED; PG8_LDA(At, 0, 0); PG8_STAGE(PG8_SA(1, 1), a1, voffA[1]);
            PG8_WAIT_L(8); PG8_BAR; PG8_WAIT_L(0); PG8_MMA(0, 0, At, B0); PG8_BAR; PG8_SCHED;
            PG8_LDB(B1, 0, 1); PG8_STAGE(PG8_SB(0, 0), b2, voffB);
            PG8_BAR; PG8_WAIT_L(0); PG8_MMA(0, 1, At, B1); PG8_BAR;
            PG8_LDA(At, 0, 1); PG8_STAGE(PG8_SA(0, 0), a2, vA2[0]);
            PG8_BAR; PG8_WAIT_L(0); PG8_MMA(1, 0, At, B0); PG8_BAR; PG8_SCHED;
            PG8_STAGE(PG8_SB(0, 1), b2 + hstepB, voffB);
            PG8_WAIT_V(6); PG8_BAR; PG8_MMA(1, 1, At, B1); PG8_BAR;
            PG8_LDB(B0, 1, 0); PG8_SCHED; PG8_LDA(At, 1, 0); PG8_STAGE(PG8_SA(0, 1), a2, vA2[1]);
            PG8_WAIT_L(8); PG8_BAR; PG8_WAIT_L(0); PG8_MMA(0, 0, At, B0); PG8_BAR; PG8_SCHED;
            PG8_LDB(B1, 1, 1); PG8_STAGE(PG8_SB(1, 0), b3, voffB);
            PG8_BAR; PG8_WAIT_L(0); PG8_MMA(0, 1, At, B1); PG8_BAR;
            PG8_LDA(At, 1, 1); PG8_STAGE(PG8_SA(1, 0), a3, vA2[0]);
            PG8_BAR; PG8_WAIT_L(0); PG8_MMA(1, 0, At, B0); PG8_BAR; PG8_SCHED;
            PG8_STAGE(PG8_SB(1, 1), b3 + hstepB, voffB);
            PG8_WAIT_V(6); PG8_BAR; PG8_MMA(1, 1, At, B1); PG8_BAR;
        }
        E(acc, cur, wr, wc, fr, fq);
        if (!has_next) break;
#pragma unroll
        for (int a = 0; a < 2; ++a)
#pragma unroll
            for (int b = 0; b < 2; ++b)
#pragma unroll
                for (int m = 0; m < 4; ++m)
#pragma unroll
                    for (int n = 0; n < 2; ++n) acc[a][b][m][n] = (f32x4){0.f, 0.f, 0.f, 0.f};
        cur = nxt; cA = nA; cB = nB; ++ui;
        if (GATHER) {
#pragma unroll
            for (int _h = 0; _h < 2; ++_h)
#pragma unroll
                for (int _i = 0; _i < 2; ++_i) voffA[_h][_i] = nvoffA[_h][_i]; }
    }
    PG8_WAIT_V(0);
    if (wr == 0) PG8_BAR;
    PG8_BAR;
#undef PG8_SA
#undef PG8_SB
#undef PG8_STAGE
#undef PG8_LDA
#undef PG8_LDB
#undef PG8_MMA
#undef PG8_WAIT_V
#undef PG8_WAIT_L
#undef PG8_BAR
#undef PG8_SCHED
#undef PG8_AOFFS
}
}


namespace g2 {
using pg8::bf16x8; using pg8::f32x4; using pg8::lds_byte; using pg8::cvt_pk_bf16;
typedef short s16x4 __attribute__((ext_vector_type(4)));
constexpr int A_BYTES = 32768, B_BYTES = 16384, STG = A_BYTES + B_BYTES;
struct Unit { int e, pm, pn, li; };
template <int NT_, class Epi, class Sched>
__device__ __forceinline__ void gemm(LAS unsigned char* lds, const Sched& S, const Epi& E) {
#if defined(__HIP_DEVICE_COMPILE__)
    const int tid = threadIdx.x, wid = __builtin_amdgcn_readfirstlane(tid >> 6), lane = tid & 63, wr = wid >> 2, wc = wid & 3, fr = lane & 15, fq = lane >> 4;
    constexpr int nt = NT_;
    int awoff[4];
#pragma unroll
    for (int j = 0; j < 4; ++j) { const int id = tid + 512 * j, row = id >> 3, ch = id & 7; awoff[j] = (row >> 7) * 16384 + lds_byte(row & 127, ch * 8); }
    const int bkr = tid >> 5, bnq = tid & 31;
    int bwoff[4];
#pragma unroll
    for (int j = 0; j < 4; ++j) { const int kr = bkr + 16 * j, f = (kr & 3) | (((kr >> 3) & 1) << 2), c = bnq >> 2; bwoff[j] = A_BYTES + kr * 256 + ((c ^ f) * 32) + (bnq & 3) * 8; }
    const int aoff = lds_byte(wr * 64 + fr, fq * 8);
    int boff[2];
    { const int q = (lane >> 2) & 3, p = lane & 3, f = q | ((fq & 1) << 2);
#pragma unroll
      for (int n = 0; n < 2; ++n) boff[n] = A_BYTES + (8 * fq + q) * 256 + (((2 * wc + n) ^ f) * 32) + 8 * p; }
    const int ldsb = (int)(uintptr_t)lds;
    Unit u;
    for (int ui = 0; S.next(ui, u); ++ui) {
        const bf16_t* pa[4]; const float* pb;
#pragma unroll
        for (int j = 0; j < 4; ++j) { const int id = tid + 512 * j; pa[j] = S.a_row(u, id >> 3) + (id & 7) * 8; }
        pb = S.b_col(u, 4 * bnq) + (size_t)bkr * S.ldb;
        const size_t bstep = (size_t)16 * S.ldb;
        f32x4 acc[2][4][2];
#pragma unroll
        for (int a = 0; a < 2; ++a)
#pragma unroll
            for (int m = 0; m < 4; ++m)
#pragma unroll
                for (int n = 0; n < 2; ++n) acc[a][m][n] = (f32x4){0.f, 0.f, 0.f, 0.f};
        bf16x8 ra[2][4]; f32x4 rb[3][4];
#define G2_LOADA(RA, t) do { _Pragma("unroll") for (int j = 0; j < 4; ++j) RA[j] = *(const bf16x8*)(pa[j] + (size_t)(t) * 64); } while (0)
#define G2_LOADB(RB, t) do { _Pragma("unroll") for (int j = 0; j < 4; ++j) RB[j] = *(const f32x4*)(pb + (size_t)(t) * 64 * S.ldb + j * bstep); } while (0)
#define G2_WRITE_A(st, RA, j) do { *(LAS bf16x8*)(lds + (st) * STG + awoff[j]) = RA[j]; } while (0)
#define G2_WRITE_B(st, RB, j) do { uint2 w_; w_.x = cvt_pk_bf16(RB[j][0], RB[j][1]); w_.y = cvt_pk_bf16(RB[j][2], RB[j][3]); *(LAS uint2*)(lds + (st) * STG + bwoff[j]) = w_; } while (0)
#define G2_TR(dst, n, imm) asm volatile("ds_read_b64_tr_b16 %0, %1 offset:%2" : "=&v"(dst) : "v"(ldsb + boff[n]), "i"(imm) : "memory")
#define G2_COMPUTE(st, DOW, WA, WB) do { \
        s16x4 b00l, b00h, b01l, b01h, b10l, b10h, b11l, b11h;        \
        G2_TR(b00l, 0, (st) * STG); G2_TR(b00h, 0, (st) * STG + 1024); G2_TR(b01l, 0, (st) * STG + 8192); G2_TR(b01h, 0, (st) * STG + 8192 + 1024); \
        G2_TR(b10l, 1, (st) * STG); G2_TR(b10h, 1, (st) * STG + 1024); G2_TR(b11l, 1, (st) * STG + 8192); G2_TR(b11h, 1, (st) * STG + 8192 + 1024); \
        bf16x8 At[4][2]; \
        _Pragma("unroll") for (int m = 0; m < 4; ++m) _Pragma("unroll") for (int k = 0; k < 2; ++k) At[m][k] = *(const LAS bf16x8*)(lds + (st) * STG + aoff + m * 2048 + k * 1024); \
        asm volatile("s_waitcnt lgkmcnt(0)" ::: "memory"); __builtin_amdgcn_sched_barrier(0); \
        const bf16x8 B00 = {b00l[0], b00l[1], b00l[2], b00l[3], b00h[0], b00h[1], b00h[2], b00h[3]}, B01 = {b01l[0], b01l[1], b01l[2], b01l[3], b01h[0], b01h[1], b01h[2], b01h[3]}; \
        const bf16x8 B10 = {b10l[0], b10l[1], b10l[2], b10l[3], b10h[0], b10h[1], b10h[2], b10h[3]}, B11 = {b11l[0], b11l[1], b11l[2], b11l[3], b11h[0], b11h[1], b11h[2], b11h[3]}; \
        _Pragma("unroll") for (int a = 0; a < 2; ++a) { \
            _Pragma("unroll") for (int m = 0; m < 4; ++m) { \
                __builtin_amdgcn_s_setprio(1); \
                acc[a][m][0] = __builtin_amdgcn_mfma_f32_16x16x32_bf16(B00, At[m][0], acc[a][m][0], 0, 0, 0); acc[a][m][0] = __builtin_amdgcn_mfma_f32_16x16x32_bf16(B01, At[m][1], acc[a][m][0], 0, 0, 0); \
                acc[a][m][1] = __builtin_amdgcn_mfma_f32_16x16x32_bf16(B10, At[m][0], acc[a][m][1], 0, 0, 0); acc[a][m][1] = __builtin_amdgcn_mfma_f32_16x16x32_bf16(B11, At[m][1], acc[a][m][1], 0, 0, 0); \
                __builtin_amdgcn_s_setprio(0); \
                if (DOW) { if (a == 0) G2_WRITE_A((st) ^ 1, WA, m); else G2_WRITE_B((st) ^ 1, WB, m); __builtin_amdgcn_sched_barrier(0); } } \
            if (a == 0) { __builtin_amdgcn_sched_barrier(0); \
                _Pragma("unroll") for (int m = 0; m < 4; ++m) _Pragma("unroll") for (int k = 0; k < 2; ++k) At[m][k] = *(const LAS bf16x8*)(lds + (st) * STG + 16384 + aoff + m * 2048 + k * 1024); \
                asm volatile("s_waitcnt lgkmcnt(0)" ::: "memory"); __builtin_amdgcn_sched_barrier(0); } } } while (0)
        G2_LOADA(ra[0], 0); G2_LOADB(rb[0], 0); G2_LOADA(ra[1], 1); G2_LOADB(rb[1], 1); if (nt > 2) G2_LOADB(rb[2], 2);
        __syncthreads();
#pragma unroll
        for (int j = 0; j < 4; ++j) { G2_WRITE_A(0, ra[0], j); G2_WRITE_B(0, rb[0], j); }
        if (nt > 2) G2_LOADA(ra[0], 2);
        if (nt > 3) G2_LOADB(rb[0], 3);
        __syncthreads();
#pragma unroll
        for (int t = 0; t < nt; ++t) {
            if (t + 1 < nt) {
                if ((t & 1) == 0) G2_COMPUTE(0, true, ra[(t + 1) & 1], rb[(t + 1) % 3]); else G2_COMPUTE(1, true, ra[(t + 1) & 1], rb[(t + 1) % 3]);
                if (t + 3 < nt) G2_LOADA(ra[(t + 1) & 1], t + 3);
                if (t + 4 < nt) G2_LOADB(rb[(t + 1) % 3], t + 4);
            } else {
                if ((t & 1) == 0) G2_COMPUTE(0, false, ra[0], rb[0]); else G2_COMPUTE(1, false, ra[0], rb[0]);
            }
            __syncthreads();
        }
        E(acc, u, wr, wc, fr, fq);
#undef G2_LOADA
#undef G2_LOADB
#undef G2_WRITE_A
#undef G2_WRITE_B
#undef G2_TR
#undef G2_COMPUTE
    }
#endif
}
}

__device__ __forceinline__ void transpose_tile(const Frame& F, const float* src, int lds_, bf16_t* dstrow0, int ldd, int k0, int n0, const float* kscale) {
    float* T = F.lds;
    const int tid = F.tid, kk = tid >> 4, n4 = (tid & 15) * 4;
#pragma unroll
    for (int i = 0; i < 2; ++i) { const int k = kk + 32 * i; float4 v = *(const float4*)(src + (size_t)(k0 + k) * lds_ + n0 + n4); const float sc = kscale ? kscale[k0 + k] : 1.f;
        T[(n4 + 0) * 65 + k] = v.x * sc; T[(n4 + 1) * 65 + k] = v.y * sc; T[(n4 + 2) * 65 + k] = v.z * sc; T[(n4 + 3) * 65 + k] = v.w * sc; }
    __syncthreads();
    { const int n = tid >> 3, k8 = (tid & 7) * 8; const float* t = T + n * 65 + k8;
      pg8::u32x4 w; w.x = pg8::cvt_pk_bf16(t[0], t[1]); w.y = pg8::cvt_pk_bf16(t[2], t[3]); w.z = pg8::cvt_pk_bf16(t[4], t[5]); w.w = pg8::cvt_pk_bf16(t[6], t[7]);
      *(pg8::u32x4*)(dstrow0 + (size_t)n * ldd + k0 + k8) = w; }
    __syncthreads();
}


namespace att {
typedef short bf16x8 __attribute__((ext_vector_type(8)));
typedef short s16x4 __attribute__((ext_vector_type(4)));
typedef float f32x16 __attribute__((ext_vector_type(16)));
typedef float f32x4 __attribute__((ext_vector_type(4)));
typedef unsigned u32x4 __attribute__((ext_vector_type(4)));
constexpr int SHM = 16384;
constexpr int NBUF = 3;
constexpr int L_K = 0, L_V = NBUF * SHM, L_WS = 2 * NBUF * SHM, L_PART = L_WS + 8 * 64 * 4, L_SELM = L_PART + 4 * 64 * 33 * 4, L_VALS = L_SELM + 256, L_ITEM = L_VALS + 8 * 64 * 4, L_END = L_ITEM + 16;
constexpr float C2 = 1.4426950408889634f * SCALE;
#define KSWZ(row, colB) ((row) * 256 + ((colB) ^ (((row) & 7) << 4)))
#define SBAR() __builtin_amdgcn_sched_barrier(0)
__device__ __forceinline__ int v_st(int k, int c) { const int kk = (k & ~0xC) | ((k & 4) << 1) | ((k & 8) >> 1); return ((kk >> 3) * 4 + (c >> 5)) * 512 + ((kk & 7) * 32 + (c & 31)) * 2; }
__device__ __forceinline__ int v_rd_base(int lane) { return ((lane & 3) << 3) | (((lane >> 2) & 3) << 6) | (((lane >> 4) & 1) << 5) | (((lane >> 5) & 1) << 8); }
constexpr int v_rd_off(int d0, int ks, int half) { return d0 * 512 + ks * 4096 + half * 2048; }
__device__ __forceinline__ int crow(int r, int hi) { return (r & 3) + 8 * (r >> 2) + 4 * hi; }
__device__ __forceinline__ unsigned cvtpk(float lo, float hi) { unsigned r; asm volatile("v_cvt_pk_bf16_f32 %0, %1, %2" : "=v"(r) : "v"(lo), "v"(hi)); return r; }
__device__ __forceinline__ float swap_max(float v) { auto rr = __builtin_amdgcn_permlane32_swap(__float_as_uint(v), __float_as_uint(v), false, false); return fmaxf(__uint_as_float(rr[0]), __uint_as_float(rr[1])); }
__device__ __forceinline__ float swap_sum(float v) { auto rr = __builtin_amdgcn_permlane32_swap(__float_as_uint(v), __float_as_uint(v), false, false); return __uint_as_float(rr[0]) + __uint_as_float(rr[1]); }

struct WV { int tid, wid, lane, r32, hi, vb0; unsigned ksrc[2], vsrc[2]; char* lds; LAS unsigned char* ldsL; };
__device__ __forceinline__ void wv_src_init(WV& w) {
#pragma unroll
    for (int i = 0; i < 2; ++i) {
        const int L = (w.wid * 2 + i) * 1024 + w.lane * 16;
        { const int row = L >> 8, colB = (L & 255) ^ ((row & 7) << 4); w.ksrc[i] = (unsigned)(row * 256 + colB); }
        { const int sub = L >> 9, kkhi = sub >> 2, cblk = sub & 3, within = L & 511, kklo = within >> 6, cc = (within >> 1) & 31;
          const int kk = kkhi * 8 + kklo, k = (kk & ~0xC) | ((kk & 4) << 1) | ((kk & 8) >> 1), c = cblk * 32 + cc; w.vsrc[i] = (unsigned)(k * 256 + c * 2); }
    }
}
__device__ __forceinline__ void dma_tile(const WV& w, const bf16_t* Kt, const bf16_t* Vt, int buf) {
    int ln = w.lane; asm volatile("" : "+v"(ln));
#pragma unroll
    for (int i = 0; i < 2; ++i) {
        const int L = (w.wid * 2 + i) * 1024 + ln * 16;
        const int row = L >> 8, colB = (L & 255) ^ ((row & 7) << 4); const unsigned ksrc = (unsigned)(row * 256 + colB);
        const int sub = L >> 9, kkhi = sub >> 2, cblk = sub & 3, within = L & 511, kklo = within >> 6, cc = (within >> 1) & 31;
        const int kk = kkhi * 8 + kklo, k = (kk & ~0xC) | ((kk & 4) << 1) | ((kk & 8) >> 1), c = cblk * 32 + cc; const unsigned vsrc = (unsigned)(k * 256 + c * 2);
        __builtin_amdgcn_global_load_lds((const unsigned*)((const char*)Vt + vsrc), (LAS unsigned*)(w.ldsL + L_V + buf * SHM + (w.wid * 2 + i) * 1024), 16, 0, 0);
        __builtin_amdgcn_global_load_lds((const unsigned*)((const char*)Kt + ksrc), (LAS unsigned*)(w.ldsL + L_K + buf * SHM + (w.wid * 2 + i) * 1024), 16, 0, 0);
    }
}
template <int BUF>
__device__ __forceinline__ void qkt(const WV& w, const bf16x8 (&qr)[8], f32x16& p0, f32x16& p1) {
    p0 = f32x16{}; p1 = f32x16{};
    const LAS char* kb[4];
#pragma unroll
    for (int dd = 0; dd < 4; ++dd) kb[dd] = (const LAS char*)w.ldsL + L_K + KSWZ(w.r32, (dd * 16 + w.hi * 8) * 2);
#pragma unroll
    for (int d0 = 0; d0 < 8; ++d0) { const LAS char* a = kb[d0 & 3] + BUF * SHM + (d0 >> 2) * 128;
        const bf16x8 b0 = *reinterpret_cast<const LAS bf16x8*>(a); const bf16x8 b1 = *reinterpret_cast<const LAS bf16x8*>(a + 32 * 256);
        p0 = __builtin_amdgcn_mfma_f32_32x32x16_bf16(b0, qr[d0], p0, 0, 0, 0);
        p1 = __builtin_amdgcn_mfma_f32_32x32x16_bf16(b1, qr[d0], p1, 0, 0, 0);
        if (d0 == 3) SBAR(); }
}
__device__ __forceinline__ void pack_p(const f32x16& p0, const f32x16& p1, bf16x8& pa0, bf16x8& pa1, bf16x8& pa2, bf16x8& pa3) {
#define PK4(P, B_, OUT) do { unsigned a0 = cvtpk(P[B_+0], P[B_+1]), a1 = cvtpk(P[B_+2], P[B_+3]); unsigned b0 = cvtpk(P[B_+4], P[B_+5]), b1 = cvtpk(P[B_+6], P[B_+7]); \
        auto r0 = __builtin_amdgcn_permlane32_swap(a0, b0, false, false); auto r1 = __builtin_amdgcn_permlane32_swap(a1, b1, false, false); \
        u32x4 w_ = {r0[0], r1[0], r0[1], r1[1]}; OUT = *reinterpret_cast<bf16x8*>(&w_); } while (0)
    PK4(p0, 0, pa0); PK4(p0, 8, pa1); PK4(p1, 0, pa2); PK4(p1, 8, pa3);
#undef PK4
}
template <int VB>
__device__ __forceinline__ void pv_tile(f32x16* o, int vb0, bf16x8 pa0, bf16x8 pa1, bf16x8 pa2, bf16x8 pa3) {
#define TRRD(dst, off) asm volatile("ds_read_b64_tr_b16 %0, %1 offset:%2" : "=&v"(dst) : "v"(vb0), "i"(off) : "memory")
#define PV_D0(d0) do { s16x4 l0, l1, l2, l3, h0, h1, h2, h3; constexpr int b_ = VB * SHM + v_rd_off(d0, 0, 0); \
        TRRD(l0, b_); TRRD(h0, b_ + 2048); TRRD(l1, b_ + 4096); TRRD(h1, b_ + 6144); TRRD(l2, b_ + 8192); TRRD(h2, b_ + 10240); TRRD(l3, b_ + 12288); TRRD(h3, b_ + 14336); \
        asm volatile("s_waitcnt lgkmcnt(0)" ::: "memory"); SBAR(); \
        o[d0] = __builtin_amdgcn_mfma_f32_32x32x16_bf16(pa0, (bf16x8){l0[0], l0[1], l0[2], l0[3], h0[0], h0[1], h0[2], h0[3]}, o[d0], 0, 0, 0); \
        o[d0] = __builtin_amdgcn_mfma_f32_32x32x16_bf16(pa1, (bf16x8){l1[0], l1[1], l1[2], l1[3], h1[0], h1[1], h1[2], h1[3]}, o[d0], 0, 0, 0); \
        o[d0] = __builtin_amdgcn_mfma_f32_32x32x16_bf16(pa2, (bf16x8){l2[0], l2[1], l2[2], l2[3], h2[0], h2[1], h2[2], h2[3]}, o[d0], 0, 0, 0); \
        o[d0] = __builtin_amdgcn_mfma_f32_32x32x16_bf16(pa3, (bf16x8){l3[0], l3[1], l3[2], l3[3], h3[0], h3[1], h3[2], h3[3]}, o[d0], 0, 0, 0); } while (0)
    PV_D0(0); PV_D0(1); PV_D0(2); PV_D0(3);
#undef PV_D0
#undef TRRD
}
__device__ __forceinline__ void store_o(const WV& w, const f32x16* o, const float* tab, bf16_t* outp) {
    bf16_t* lp = outp + (size_t)w.hi * 4096 + w.r32;
#pragma unroll
    for (int r = 0; r < 16; ++r) { const int q = crow(r, w.hi); const float sc = tab[q];
        bf16_t* p = lp; asm volatile("" : "+v"(p));
        p += ((r & 3) + 8 * (r >> 2)) * 1024;
#pragma unroll
        for (int d0 = 0; d0 < 4; ++d0) { const float v = o[d0][r] * sc; const float vn = __shfl_xor(v, 1);
            if ((w.r32 & 1) == 0) *(__attribute__((address_space(1))) unsigned*)(p + d0 * 32) = cvtpk(v, vn); } }
}

template <int MODE>
__device__ __forceinline__ void flash_pass(const WV& w, const bf16_t* Kp, const bf16_t* Vp, int j_lo, int j_hi, const bf16x8 (&qr)[8], int tpos, int tw0, unsigned selmask,
                                           f32x16 (&o)[4], float& m_reg, float& l_reg) {
    float* al_l = (float*)(w.lds + L_WS) + w.wid * 64;
    dma_tile(w, Kp + (size_t)j_lo * 64 * HD, Vp + (size_t)j_lo * 64 * HD, 0);
    if (j_lo + 1 < j_hi) dma_tile(w, Kp + (size_t)(j_lo + 1) * 64 * HD, Vp + (size_t)(j_lo + 1) * 64 * HD, 1);
#define FSTEP(BUF, jj) do { const int jt = (jj);                                                                                  \
        if (jt + 1 < j_hi) asm volatile("s_waitcnt vmcnt(4)" ::: "memory"); else asm volatile("s_waitcnt vmcnt(0)" ::: "memory");   \
        asm volatile("s_waitcnt lgkmcnt(0)" ::: "memory"); __builtin_amdgcn_s_barrier(); asm volatile("" ::: "memory");          \
        if (jt + 2 < j_hi) dma_tile(w, Kp + (size_t)(jt + 2) * 64 * HD, Vp + (size_t)(jt + 2) * 64 * HD, ((BUF) + 2) % 3);         \
        f32x16 p0, p1;                                                                                                           \
        qkt<BUF>(w, qr, p0, p1);                                                                                                 \
        const int kb = jt * 64;                                                                                                  \
        { const float NEG = -__builtin_inff();                                                                                   \
          const bool need = (kb + 63 > tw0) || (MODE == 1 && kb <= tw0 + 31 - 512);                                              \
          if (need) { const int dq = tpos - kb - 4 * w.hi; const unsigned W = (MODE == 1) ? 512u : 0x7fffffffu;                  \
              _Pragma("unroll") for (int r = 0; r < 16; ++r) { const int c = (r & 3) + 8 * (r >> 2); if ((unsigned)(dq - c) >= W) p0[r] = NEG; if ((unsigned)(dq - c - 32) >= W) p1[r] = NEG; } } \
          if (MODE == 0) { const bool sel = (selmask >> jt) & 1u;                                                                \
              if (!__all(sel)) { _Pragma("unroll") for (int r = 0; r < 16; ++r) { p0[r] = sel ? p0[r] : NEG; p1[r] = sel ? p1[r] : NEG; } } } } \
        float pmax = p0[0];                                                                                                      \
        _Pragma("unroll") for (int r = 1; r < 16; ++r) pmax = fmaxf(pmax, p0[r]);                                                \
        _Pragma("unroll") for (int r = 0; r < 16; ++r) pmax = fmaxf(pmax, p1[r]);                                                \
        pmax = swap_max(pmax);                                                                                                   \
        const float mn = fmaxf(m_reg, pmax);                                                                                     \
        const float alpha = __builtin_amdgcn_exp2f((m_reg - mn) * C2);                                                           \
        m_reg = mn;                                                                                                              \
        const float mnL = -mn * C2;                                                                                              \
        float ps = 0.f;                                                                                                          \
        _Pragma("unroll") for (int r = 0; r < 16; ++r) { p0[r] = __builtin_amdgcn_exp2f(fmaf(p0[r], C2, mnL)); ps += p0[r]; }    \
        _Pragma("unroll") for (int r = 0; r < 16; ++r) { p1[r] = __builtin_amdgcn_exp2f(fmaf(p1[r], C2, mnL)); ps += p1[r]; }    \
        ps = swap_sum(ps);                                                                                                       \
        l_reg = l_reg * alpha + ps;                                                                                              \
        if (w.hi == 0) al_l[w.r32] = alpha;                                                                                      \
        asm volatile("s_waitcnt lgkmcnt(0)" ::: "memory");                                                                       \
        _Pragma("unroll") for (int r = 0; r < 16; ++r) { const float a = al_l[crow(r, w.hi)];                                    \
            _Pragma("unroll") for (int d = 0; d < 4; ++d) o[d][r] *= a; }                                                        \
        bf16x8 pa0, pa1, pa2, pa3;                                                                                               \
        pack_p(p0, p1, pa0, pa1, pa2, pa3);                                                                                      \
        pv_tile<BUF>(o, w.vb0, pa0, pa1, pa2, pa3);                                                                              \
    } while (0)
    int j = j_lo;
    for (; j + 2 < j_hi; j += 3) { FSTEP(0, j); FSTEP(1, j + 1); FSTEP(2, j + 2); }
    if (j < j_hi) { FSTEP(0, j); if (j + 1 < j_hi) FSTEP(1, j + 1); }
#undef FSTEP
    __syncthreads();
}
}

__device__ const unsigned char ATT_ITEMS[80] = {15, 30, 31, 63, 14, 28, 29, 61, 62, 13, 26, 27, 59, 60, 12, 24, 25, 57, 58, 11, 22, 23, 55, 56, 10, 20, 21, 53, 54, 9, 18, 19, 51, 52, 8, 16, 17, 49, 50, 7, 48, 6, 5,
    72, 73, 74, 75, 76, 77, 78, 79, 80, 81, 82, 83, 84, 85, 86, 87, 88, 89, 90, 91, 92, 93, 94, 95, 4, 71, 3, 70, 2, 69, 1, 68, 0, 67, 66, 65, 64};
constexpr int CW_QUEUE = 6144;
constexpr int CW_CVTQ = 6144 + 256;

__device__ __forceinline__ void p_attn(const Frame& F, unsigned char* lds_raw, int rep) {
    using namespace att;
    WV w;
#define WV_INIT() do { int ln_ = F.lane; asm volatile("" : "+v"(ln_)); w.tid = F.wave * 64 + ln_; w.wid = F.wave; w.lane = ln_; w.r32 = ln_ & 31; w.hi = ln_ >> 5; \
        w.lds = (char*)lds_raw + 1024; w.ldsL = (LAS unsigned char*)lds_raw + 1024; w.vb0 = (int)(uintptr_t)(w.lds) + att::L_V + v_rd_base(ln_); } while (0)
    WV_INIT();
    const bf16_t* qn = (const bf16_t*)(F.ws + WS_QN); const bf16_t* qrp = (const bf16_t*)(F.ws + WS_QR); const bf16_t* kv = (const bf16_t*)(F.ws + WS_KV);
    const bf16_t* ckv = (const bf16_t*)(F.ws + WS_CMPKV);
    bf16_t* ocmp = (bf16_t*)(F.ws + WS_OCMP); bf16_t* owin = (bf16_t*)(F.ws + WS_OWIN); bf16_t* osel = (bf16_t*)(F.ws + WS_OSEL); float* ml = (float*)(F.ws + WS_ML);
    unsigned* qctr = (unsigned*)(F.ws + WS_CTL) + CW_QUEUE + 64 * rep;
    float* wsf = (float*)(w.lds + L_WS) + w.wid * 64;
    float* part = (float*)(w.lds + L_PART); unsigned* selm = (unsigned*)(w.lds + L_SELM); float* vals = (float*)(w.lds + L_VALS) + w.wid * 64; volatile int* itemw = (volatile int*)(w.lds + L_ITEM);
    const int hr = w.wid >> 1, th = w.wid & 1;
    for (;;) {
        __syncthreads();
        if (F.tid == 0) itemw[0] = (int)atomicAdd(qctr, 1u);
        __syncthreads();
        const int item = itemw[0];
        if (item >= 640) break;
        WV_INIT();
        const int ent = ATT_ITEMS[item >> 3], bg = item & 7, type = ent >> 5, qb = ent & 31, b = bg >> 1, g = bg & 1, h = 4 * g + hr;
        const int t0 = qb * 64 + th * 32, tpos = t0 + w.r32, tok0 = b * SEQ + t0;
        const size_t qoff = (((size_t)b * NH + h) * SEQ + t0 + w.r32) * HD + w.hi * 8;
        const size_t kvoff = ((size_t)b * NG + g) * SEQ * HD;
        bf16x8 qr[8];
        f32x16 o[4];
#ifndef ATT_NO_WIN
        if (type == 2) {
#pragma unroll
            for (int d0 = 0; d0 < 8; ++d0) qr[d0] = *(const bf16x8*)(qrp + qoff + d0 * 16);
#pragma unroll
            for (int d = 0; d < 4; ++d) o[d] = f32x16{};
            float m_reg = -1e30f, l_reg = 0.f;
            flash_pass<1>(w, kv + (size_t)4 * (4 * MB / 2) + kvoff, kv + (size_t)5 * (4 * MB / 2) + kvoff, qb >= 8 ? qb - 8 : 0, qb + 1, qr, tpos, t0, 0u, o, m_reg, l_reg);
            if (w.hi == 0) wsf[w.r32] = 1.f / l_reg;
            asm volatile("s_waitcnt lgkmcnt(0)" ::: "memory");
            store_o(w, o, wsf, owin + (size_t)tok0 * 1024 + h * HD);
            continue;
        }
#endif
#ifndef ATT_NO_CMP
        {
#pragma unroll
            for (int d0 = 0; d0 < 8; ++d0) qr[d0] = *(const bf16x8*)(qn + qoff + d0 * 16);
            const bf16_t* Kc = ckv + (size_t)bg * 128 * HD; const bf16_t* Vc = ckv + (size_t)1024 * HD + (size_t)bg * 128 * HD;
            dma_tile(w, Kc, Vc, 0); dma_tile(w, Kc + 64 * HD, Vc + 64 * HD, 1);
            asm volatile("s_waitcnt vmcnt(0)" ::: "memory");
            __syncthreads();
            f32x16 pA0, pA1, pB0, pB1;
            qkt<0>(w, qr, pA0, pA1); qkt<1>(w, qr, pB0, pB1);
            const int nmax = tpos >= 31 ? ((tpos - 31) >> 4) : -1;
            const float NEG = -__builtin_inff();
            float pmax = NEG;
#pragma unroll
            for (int r = 0; r < 16; ++r) { const int n = crow(r, w.hi);
                pA0[r] = (n <= nmax) ? pA0[r] : NEG; pA1[r] = (n + 32 <= nmax) ? pA1[r] : NEG; pB0[r] = (n + 64 <= nmax) ? pB0[r] : NEG; pB1[r] = (n + 96 <= nmax) ? pB1[r] : NEG;
                pmax = fmaxf(fmaxf(pmax, pA0[r]), fmaxf(pA1[r], fmaxf(pB0[r], pB1[r]))); }
            pmax = swap_max(pmax);
            const float mm = (pmax == NEG) ? 0.f : pmax;
            const float mnL = -mm * C2;
            float ps = 0.f;
#pragma unroll
            for (int r = 0; r < 16; ++r) { pA0[r] = __builtin_amdgcn_exp2f(fmaf(pA0[r], C2, mnL)); pA1[r] = __builtin_amdgcn_exp2f(fmaf(pA1[r], C2, mnL));
                pB0[r] = __builtin_amdgcn_exp2f(fmaf(pB0[r], C2, mnL)); pB1[r] = __builtin_amdgcn_exp2f(fmaf(pB1[r], C2, mnL)); ps += (pA0[r] + pA1[r]) + (pB0[r] + pB1[r]); }
            ps = swap_sum(ps);
            const float inv = ps > 0.f ? 1.f / ps : 0.f;
#pragma unroll
            for (int r = 0; r < 16; ++r) { pA0[r] *= inv; pA1[r] *= inv; pB0[r] *= inv; pB1[r] *= inv; }
            {
                float av[16], bv[16];
#pragma unroll
                for (int gq = 0; gq < 4; ++gq) {
                    av[gq]      = pA0[4 * gq] + pA0[4 * gq + 1] + pA0[4 * gq + 2] + 0.5f * pA0[4 * gq + 3]; bv[gq]      = 0.5f * pA0[4 * gq + 3];
                    av[4 + gq]  = pA1[4 * gq] + pA1[4 * gq + 1] + pA1[4 * gq + 2] + 0.5f * pA1[4 * gq + 3]; bv[4 + gq]  = 0.5f * pA1[4 * gq + 3];
                    av[8 + gq]  = pB0[4 * gq] + pB0[4 * gq + 1] + pB0[4 * gq + 2] + 0.5f * pB0[4 * gq + 3]; bv[8 + gq]  = 0.5f * pB0[4 * gq + 3];
                    av[12 + gq] = pB1[4 * gq] + pB1[4 * gq + 1] + pB1[4 * gq + 2] + 0.5f * pB1[4 * gq + 3]; bv[12 + gq] = 0.5f * pB1[4 * gq + 3];
                }
                float* prow = part + ((size_t)hr * 64 + th * 32 + w.r32) * 33;
#pragma unroll
                for (int idx = 0; idx < 16; ++idx) {
                    const float bo = __shfl_xor(bv[idx], 32);
                    const float bprev = (idx > 0) ? __shfl_xor(bv[idx > 0 ? idx - 1 : 0], 32) : 0.f;
                    const float inc = w.hi ? bo : bprev;
                    prow[2 * idx + w.hi] = av[idx] + inc;
                }
            }
            if (type == 0) {
                bf16x8 pa0, pa1, pa2, pa3;
#pragma unroll
                for (int d = 0; d < 4; ++d) o[d] = f32x16{};
                pack_p(pA0, pA1, pa0, pa1, pa2, pa3); pv_tile<0>(o, w.vb0, pa0, pa1, pa2, pa3);
                pack_p(pB0, pB1, pa0, pa1, pa2, pa3); pv_tile<1>(o, w.vb0, pa0, pa1, pa2, pa3);
                if (w.hi == 0) wsf[w.r32] = 1.f;
                asm volatile("s_waitcnt lgkmcnt(0)" ::: "memory");
                store_o(w, o, wsf, ocmp + (size_t)tok0 * 1024 + h * HD);
            }
            __syncthreads();
#pragma unroll 1
            for (int ps2 = 0; ps2 < 4; ++ps2) {
                int ln = w.lane; asm volatile("" : "+v"(ln));
                const int j = ln & 31, hi2 = ln >> 5;
                const int tk = 8 * w.wid + 2 * ps2 + hi2, t = qb * 64 + tk, cur = qb;
                float imp = 0.f;
#pragma unroll
                for (int r = 0; r < 4; ++r) imp += part[((size_t)r * 64 + tk) * 33 + j];
                const bool ok = (64 * j <= t), forced = (j == 0) || (cur - j >= 0 && cur - j < 2);
                const float val = (ok && forced) ? 1.0e30f : (ok ? imp : -1.0e30f);
                vals[ln] = val;
                asm volatile("s_waitcnt lgkmcnt(0)" ::: "memory");
                int rank = 0;
#pragma unroll
                for (int jj = 0; jj < 32; ++jj) { const float o2 = vals[hi2 * 32 + jj]; rank += (o2 > val || (o2 == val && jj < j)) ? 1 : 0; }
                const unsigned long long bal = __ballot(rank < 16 && val >= 0.f);
                if (w.lane == 0) { selm[8 * w.wid + 2 * ps2] = (unsigned)bal; selm[8 * w.wid + 2 * ps2 + 1] = (unsigned)(bal >> 32); }
            }
            __syncthreads();
        }
#endif
#ifndef ATT_NO_SEL
        {
            WV_INIT();
            const unsigned sm = selm[th * 32 + w.r32];
            const int ntile = qb + 1, hsplit = (ntile + 1) >> 1;
            const int ja = (qb >= 16 && type == 1) ? hsplit : 0, jb = (qb >= 16 && type == 0) ? hsplit : ntile;
#pragma unroll
            for (int d0 = 0; d0 < 8; ++d0) qr[d0] = *(const bf16x8*)(qrp + qoff + d0 * 16);
#pragma unroll
            for (int d = 0; d < 4; ++d) o[d] = f32x16{};
            float m_reg = -1e30f, l_reg = 0.f;
            flash_pass<0>(w, kv + (size_t)2 * (4 * MB / 2) + kvoff, kv + (size_t)3 * (4 * MB / 2) + kvoff, ja, jb, qr, tpos, t0, sm, o, m_reg, l_reg);
            if (w.hi == 0) { wsf[w.r32] = l_reg > 0.f ? 1.f / l_reg : 0.f; float* mp = ml + (((size_t)type * NT + tok0 + w.r32) * NH + h) * 2; mp[0] = m_reg; mp[1] = l_reg; }
            asm volatile("s_waitcnt lgkmcnt(0)" ::: "memory");
            store_o(w, o, wsf, osel + (size_t)type * NT * 1024 + (size_t)tok0 * 1024 + h * HD);
        }
#endif
    }
}

struct CvtTile { const float* src; const float* ksc; bf16_t* dst0; int sld, ldd, mode; };
__device__ __forceinline__ CvtTile cvt_decode(const Frame& F, int t) {
    CvtTile c; c.ksc = nullptr; c.mode = 0;
    if (t < 4096) { const int e = t >> 7, mat = (t >> 6) & 1, kt = (t >> 1) & 31, nt = t & 1;
        c.src = (mat ? F.in[I_WUP] : F.in[I_WGATE]) + ((size_t)e * DM + kt * 64) * FF + nt * 256; c.sld = FF; c.ksc = F.in[I_LNMOE] + kt * 64;
        c.dst0 = (bf16_t*)(F.ws + WS_W1T) + ((size_t)e * 1024 + nt * 512 + mat * 128) * DM + kt * 64; c.ldd = DM; c.mode = 1; return c; }
    t -= 4096;
    if (t < 2048) { const int e = t >> 6, kt = (t >> 3) & 7, nt = t & 7;
        c.src = F.in[I_WDOWN] + ((size_t)e * FF + kt * 64) * DM + nt * 256; c.sld = DM;
        c.dst0 = (bf16_t*)(F.ws + WS_W2T) + ((size_t)e * 2048 + nt * 256) * FF + kt * 64; c.ldd = FF; return c; }
    t -= 2048;
    if (t < 256) { const int kt = t >> 3, nt = t & 7;
        c.src = F.in[I_WOUT] + (size_t)kt * 64 * DM + nt * 256; c.sld = DM; c.dst0 = (bf16_t*)(F.ws + WS_WOUTT) + (size_t)nt * 256 * DM + kt * 64; c.ldd = DM; return c; }
    t -= 256;
    if (t < 480) { const int kt = t / 15, nt = t % 15;
        c.src = F.in[I_WIN] + (size_t)kt * 64 * INW; c.sld = INW; c.ksc = F.in[I_LNMIX] + kt * 64;
        c.dst0 = (bf16_t*)(F.ws + WS_WINT) + (size_t)nt * 256 * DM + kt * 64; c.ldd = DM; c.mode = 2 + nt; return c; }
    t -= 480;
    { const int kv = t >> 6, kt = t & 63;
      c.src = (kv ? F.in[I_WV1] : F.in[I_WK1]) + (size_t)kt * 64 * 256; c.sld = 256; c.dst0 = (bf16_t*)(F.ws + WS_CMPW) + (size_t)kv * 256 * 4096 + kt * 64; c.ldd = 4096; return c; }
}
constexpr int N_CVT_TILES = 4096 + 2048 + 256 + 480 + 128;
__device__ __forceinline__ void cvt_load(const CvtTile& c, int nq, int kq, float4 (&v)[8]) {
    const float* p = c.src + 4 * nq; bool valid = true;
    if (c.mode >= 2) { const int n = (c.mode - 2) * 256 + 4 * nq; int sc = -1; if (n < 2560) sc = n; else if (n < 3584) sc = n + 24; else if (n < 3608) sc = n - 1024; valid = sc >= 0; p = c.src + (valid ? sc : 0); }
#pragma unroll
    for (int i = 0; i < 8; ++i) v[i] = valid ? *(const float4*)(p + (size_t)(kq * 8 + i) * c.sld) : make_float4(0.f, 0.f, 0.f, 0.f);
}

constexpr int CVT_RUN = 4;
__device__ __forceinline__ void cvt_stream(const Frame& F, int t_lo, int t_hi, unsigned* queue) {
    float* T = F.lds;
    volatile int* nxtw = (volatile int*)(F.lds + 64 * 257);
    const int tid = F.tid, nq = tid & 63, kq = tid >> 6;
    int tA, tB; float4 vA[8], vB[8]; CvtTile cA, cB;
    if (queue) { __syncthreads(); if (tid == 0) { nxtw[0] = t_lo + CVT_RUN * (int)atomicAdd(queue, 1u); nxtw[1] = t_lo + CVT_RUN * (int)atomicAdd(queue, 1u); } __syncthreads(); tA = nxtw[0]; tB = nxtw[1]; }
    else { tA = t_lo + F.bid; tB = tA + F.G; }
    if (tA < t_hi) { cA = cvt_decode(F, tA); cvt_load(cA, nq, kq, vA); }
    if (tB < t_hi) { cB = cvt_decode(F, tB); cvt_load(cB, nq, kq, vB); }
#define CVT_STEP(tX, cX, vX, slot) do {                                                                                                     \
        const bool pop = queue && (((tX) - t_lo) % CVT_RUN == CVT_RUN - 1);                 \
        int tn_reg = 0;                                                                                                                      \
        if (pop && tid == 0) tn_reg = t_lo + CVT_RUN * (int)atomicAdd(queue, 1u);                                                            \
        __syncthreads();                                                                                                                     \
        _Pragma("unroll") for (int i = 0; i < 8; ++i) { const float s = cX.ksc ? cX.ksc[kq * 8 + i] : 1.f; float* tp = T + (kq * 8 + i) * 257 + 4 * nq; \
            tp[0] = vX[i].x * s; tp[1] = vX[i].y * s; tp[2] = vX[i].z * s; tp[3] = vX[i].w * s; }                                           \
        if (pop && tid == 0) nxtw[slot] = tn_reg;                                                                                            \
        __syncthreads();                                                                                                                     \
        const CvtTile cc = cX; const int tn = queue ? (pop ? nxtw[slot] : tX + 1) : tX + 2 * F.G;                                            \
        if (tn < t_hi) { cX = cvt_decode(F, tn); cvt_load(cX, nq, kq, vX); }                                                                 \
        _Pragma("unroll") for (int j = 0; j < 4; ++j) { const int id = tid + 512 * j, n = id >> 3, kc = id & 7; const float* tp = T + (kc * 8) * 257 + n; \
            pg8::u32x4 w; w.x = pg8::cvt_pk_bf16(tp[0], tp[257]); w.y = pg8::cvt_pk_bf16(tp[2 * 257], tp[3 * 257]); w.z = pg8::cvt_pk_bf16(tp[4 * 257], tp[5 * 257]); w.w = pg8::cvt_pk_bf16(tp[6 * 257], tp[7 * 257]); \
            const int rowi = (cc.mode == 1) ? ((n >> 7) * 256 + (n & 127)) : n;                                                              \
            *(pg8::u32x4*)(cc.dst0 + (size_t)rowi * cc.ldd + kc * 8) = w; }                                                                  \
        tX = tn; } while (0)
    while (tA < t_hi) {
        CVT_STEP(tA, cA, vA, 0);
        if (tB >= t_hi) { const int t2 = tA; tA = tB; tB = t2; const CvtTile c2 = cA; cA = cB; cB = c2;
#pragma unroll
            for (int i = 0; i < 8; ++i) { const float4 x = vA[i]; vA[i] = vB[i]; vB[i] = x; }
            continue; }
        CVT_STEP(tB, cB, vB, 1);
    }
    while (tB < t_hi) CVT_STEP(tB, cB, vB, 1);
#undef CVT_STEP
    __syncthreads();
}

__device__ __forceinline__ void p0_prologue(const Frame& F) {
    const float* x = F.in[I_X];
    bf16_t* xb = (bf16_t*)(F.ws + WS_XB); float* rstd1 = (float*)(F.ws + WS_RSTD1);
    const int gw = F.bid * NWAVES + F.wave, nw = F.G * NWAVES, lane = F.lane;
    for (int r = gw; r < NT; r += nw) {
        float4 v[8]; float ss = 0.f;
#pragma unroll
        for (int i = 0; i < 8; ++i) { v[i] = *(const float4*)(x + (size_t)r * DM + i * 256 + lane * 4); ss += v[i].x * v[i].x + v[i].y * v[i].y + v[i].z * v[i].z + v[i].w * v[i].w; }
        ss = wave_sum(ss);
        if (lane == 0) rstd1[r] = rsqrtf(ss * (1.f / DM) + EPS);
#pragma unroll
        for (int i = 0; i < 8; ++i) { uint2 w; w.x = pg8::cvt_pk_bf16(v[i].x, v[i].y); w.y = pg8::cvt_pk_bf16(v[i].z, v[i].w);
            *(uint2*)(xb + (size_t)r * DM + i * 256 + lane * 4) = w; }
    }
    cvt_stream(F, 6400, N_CVT_TILES, nullptr);
    {
        const float* wp = F.in[I_WPOOL]; const float* ps = F.in[I_PSCALE]; const float* bp = F.in[I_BPOOL]; bf16_t* wpt = (bf16_t*)(F.ws + WS_POOLW); float* pb = (float*)(F.ws + WS_POOLB);
        for (int idx = F.bid * NTHREADS + F.tid; idx < 4 * 256 * 256; idx += F.G * NTHREADS) { const int k = idx & 255, n = (idx >> 8) & 255, g = idx >> 16;
            wpt[idx] = f2bf(wp[((size_t)g * 256 + k) * 256 + n] * ps[g * 256 + n]); }
        for (int idx = F.bid * NTHREADS + F.tid; idx < 1024; idx += F.G * NTHREADS) pb[idx] = bp[idx] * ps[idx];
    }
    {
        const float* lnm = F.in[I_LNMOE]; const float* wre = F.in[I_WRE]; const float* wrg = F.in[I_WRG]; float* WR = (float*)(F.ws + WS_WR); float* WG4 = (float*)(F.ws + WS_WG4);
        for (int idx = F.bid * NTHREADS + F.tid; idx < DM * 32; idx += F.G * NTHREADS) { const int k = idx >> 5, c = idx & 31; WR[idx] = lnm[k] * wre[((size_t)(c >> 3) * DM + k) * 8 + (c & 7)]; }
        for (int idx = F.bid * NTHREADS + F.tid; idx < DM * 4; idx += F.G * NTHREADS) WG4[idx] = lnm[idx >> 2] * wrg[idx];
    }
    {
        const int* pos = (const int*)F.in[I_POS]; float* rc = (float*)(F.ws + WS_ROPEC); float* rs = (float*)(F.ws + WS_ROPES);
        for (int idx = F.bid * NTHREADS + F.tid; idx < NB * SEQ * 16; idx += F.G * NTHREADS) {
            const int i = idx & 15, bs = idx >> 4;
            const float inv = exp2f(-(float)i * (1.f / 16.f) * 18.931568569324174f);
            const float ang = (float)pos[bs] * inv;
            rc[idx] = cosf(ang); rs[idx] = sinf(ang);
        }
    }
    for (int it = F.bid; it < 64; it += F.G) {
        const int kv = it >> 5, jb = (it >> 3) & 3, mc = it & 7;
        const float* pe = (kv ? F.in[I_PEV] : F.in[I_PEK]); const float* w1 = (kv ? F.in[I_WV1] : F.in[I_WK1]);
        const int mg = F.tid >> 6, j = jb * 64 + (F.tid & 63);
        float a = 0.f;
#pragma unroll 8
        for (int m = mc * 512 + mg; m < mc * 512 + 512; m += 8) a += pe[m] * w1[(size_t)m * 256 + j];
        __syncthreads();
        F.lds[F.tid] = a;
        __syncthreads();
        if (F.tid < 64) { float s = 0.f; for (int q = 0; q < 8; ++q) s += F.lds[q * 64 + F.tid]; ((float*)(F.ws + WS_BIAS1))[(mc * 2 + kv) * 256 + j] = s; }
        __syncthreads();
    }
}

struct EpiProj {
    const float* rstd1; const float* rc; const float* rs; bf16_t* qn; bf16_t* qr; bf16_t* kv; float* u; float* gates;
    __device__ __forceinline__ void operator()(const pg8::f32x4 (&acc)[2][2][4][2], const pg8::Unit& un, int wr, int wc, int fr, int fq) const {
        const int pn = un.pn;
#pragma unroll
        for (int ai = 0; ai < 2; ++ai)
#pragma unroll
            for (int m = 0; m < 4; ++m) {
                const int row = un.pm * 256 + ai * 128 + wr * 64 + m * 16 + fr; const float r1 = rstd1[row]; const int b = row >> 11, s = row & 2047;
                if (pn < 10) {
                    const bool ropeu = (pn < 4) || pn == 6 || pn == 8;
                    pg8::f32x4 c4 = {1.f, 1.f, 1.f, 1.f}, s4 = {0.f, 0.f, 0.f, 0.f};
                    if (ropeu && wc == 0) { c4 = *(const pg8::f32x4*)(rc + (size_t)row * 16 + 4 * fq); s4 = *(const pg8::f32x4*)(rs + (size_t)row * 16 + 4 * fq); }
#pragma unroll
                    for (int bj = 0; bj < 2; ++bj) {
                        const pg8::f32x4 v0 = acc[ai][bj][m][0] * r1, v1 = acc[ai][bj][m][1] * r1;
                        const int d0 = 32 * wc + 4 * fq;
                        pg8::f32x4 o0 = v0, o1 = v1;
                        if (ropeu && wc == 0) { o0 = v0 * c4 - v1 * s4; o1 = v1 * c4 + v0 * s4; }
                        uint2 w0, w1; w0.x = pg8::cvt_pk_bf16(o0[0], o0[1]); w0.y = pg8::cvt_pk_bf16(o0[2], o0[3]); w1.x = pg8::cvt_pk_bf16(o1[0], o1[1]); w1.y = pg8::cvt_pk_bf16(o1[2], o1[3]);
                        if (pn < 4) {
                            const size_t o = (((size_t)b * NH + 2 * pn + bj) * SEQ + s) * HD + d0;
                            uint2 n0, n1; n0.x = pg8::cvt_pk_bf16(v0[0], v0[1]); n0.y = pg8::cvt_pk_bf16(v0[2], v0[3]); n1.x = pg8::cvt_pk_bf16(v1[0], v1[1]); n1.y = pg8::cvt_pk_bf16(v1[2], v1[3]);
                            *(uint2*)(qn + o) = n0; *(uint2*)(qn + o + 16) = n1; *(uint2*)(qr + o) = w0; *(uint2*)(qr + o + 16) = w1;
                        } else {
                            const size_t o = (size_t)(pn - 4) * (4 * MB / 2) + (((size_t)b * NG + bj) * SEQ + s) * HD + d0;
                            *(uint2*)(kv + o) = w0; *(uint2*)(kv + o + 16) = w1;
                        }
                    }
                } else if (pn < 14) {
#pragma unroll
                    for (int bj = 0; bj < 2; ++bj)
#pragma unroll
                        for (int n = 0; n < 2; ++n) *(pg8::f32x4*)(u + (size_t)row * 1024 + (pn - 10) * 256 + bj * 128 + wc * 32 + n * 16 + 4 * fq) = acc[ai][bj][m][n] * r1;
                } else {
                    if (wc == 0) { *(pg8::f32x4*)(gates + (size_t)row * 24 + 4 * fq) = acc[ai][0][m][0] * r1; if (fq < 2) *(pg8::f32x4*)(gates + (size_t)row * 24 + 16 + 4 * fq) = acc[ai][0][m][1] * r1; }
                }
            }
    }
};

__device__ __forceinline__ void p1_proj(const Frame& F, LAS unsigned char* stage) {
    pg8::DenseOrder S; S.init(F.ws + WS_XB, F.ws + WS_WINT, DM, DM, NT, INWP, F.G, F.bid);
    EpiProj E{(const float*)(F.ws + WS_RSTD1), (const float*)(F.ws + WS_ROPEC), (const float*)(F.ws + WS_ROPES), (bf16_t*)(F.ws + WS_QN), (bf16_t*)(F.ws + WS_QR), (bf16_t*)(F.ws + WS_KV),
              (float*)(F.ws + WS_U), (float*)(F.ws + WS_GATES)};
    pg8::gemm_phase<EpiProj, pg8::DenseOrder, false>(stage, DM, DM, DM, S, E);
}

struct CmpOrder {
    const char* kc; const char* w1t; int c;
    __device__ __forceinline__ bool next(int i, pg8::Unit& u) const { if (i > 0) return false; u.e = c >> 5; u.pm = (c >> 3) & 3; u.pn = c & 7; u.li = 0; return true; }
    __device__ __forceinline__ const char* a_base(const pg8::Unit& u) const { return kc + (size_t)u.e * 4 * MB + ((size_t)u.pm * 256 * 2048 + u.pn * 512) * 2; }
    __device__ __forceinline__ const char* b_base(const pg8::Unit& u) const { return w1t + ((size_t)u.e * 256 * 4096 + u.pn * 512) * 2; }
    __device__ __forceinline__ unsigned a_row_off(const pg8::Unit&, int r) const { return (unsigned)r * 4096u; }
};
struct EpiCmp {
    float* part;
    __device__ __forceinline__ void operator()(const pg8::f32x4 (&acc)[2][2][4][2], const pg8::Unit& un, int wr, int wc, int fr, int fq) const {
        float* base = part + (((size_t)un.pn * 2 + un.e) * 1024 + un.pm * 256) * 256;
#pragma unroll
        for (int ai = 0; ai < 2; ++ai)
#pragma unroll
            for (int m = 0; m < 4; ++m) { float* rowp = base + (size_t)(ai * 128 + wr * 64 + m * 16 + fr) * 256 + wc * 32 + 4 * fq;
#pragma unroll
                for (int bj = 0; bj < 2; ++bj)
#pragma unroll
                    for (int n = 0; n < 2; ++n) *(pg8::f32x4*)(rowp + bj * 128 + n * 16) = acc[ai][bj][m][n]; }
    }
};
struct PoolOrder {
    const char* d; const char* wpt; int c;
    __device__ __forceinline__ bool next(int i, pg8::Unit& u) const { if (i > 0) return false; u.pm = c >> 2; u.pn = 0; u.e = c & 3; u.li = 0; return true; }
    __device__ __forceinline__ const char* a_base(const pg8::Unit& u) const { return d + ((size_t)u.pm * 256 * 1024 + u.e * 256) * 2; }
    __device__ __forceinline__ const char* b_base(const pg8::Unit& u) const { return wpt + (size_t)u.e * 256 * 256 * 2; }
    __device__ __forceinline__ unsigned a_row_off(const pg8::Unit&, int r) const { return (unsigned)r * 2048u; }
};
struct EpiPool {
    const float* pb; float* opool;
    __device__ __forceinline__ void operator()(const pg8::f32x4 (&acc)[2][2][4][2], const pg8::Unit& un, int wr, int wc, int fr, int fq) const {
#pragma unroll
        for (int ai = 0; ai < 2; ++ai)
#pragma unroll
            for (int m = 0; m < 4; ++m) { const int row = un.pm * 256 + ai * 128 + wr * 64 + m * 16 + fr;
#pragma unroll
                for (int bj = 0; bj < 2; ++bj)
#pragma unroll
                    for (int n = 0; n < 2; ++n) { const int c = un.e * 256 + bj * 128 + wc * 32 + n * 16 + 4 * fq;
                        *(pg8::f32x4*)(opool + (size_t)row * 1024 + c) = acc[ai][bj][m][n] + *(const pg8::f32x4*)(pb + c); } }
    }
};
__device__ __forceinline__ void p3_mid(const Frame& F, LAS unsigned char* stage, int rep) {
    if (F.bid < 64) {
        CmpOrder S{(const char*)(F.ws + WS_KV), (const char*)(F.ws + WS_CMPW), F.bid};
        EpiCmp E{(float*)(F.ws + WS_CPART)};
        pg8::gemm_phase<EpiCmp, CmpOrder, false>(stage, 512, 2048, 4096, S, E);
    } else if (F.bid < 192) {
        const int c = F.bid - 64, pm = c >> 2, gi = c & 3, w = 2 << gi;
        const float* u = (const float*)(F.ws + WS_U); bf16_t* d = (bf16_t*)(F.ws + WS_DBUF);
        for (int task = F.tid; task < 256 * 16; task += 2 * NTHREADS) {
            const int cc = task & 255, col = gi * 256 + cc;
            float uv[2][31];
#pragma unroll
            for (int tt = 0; tt < 2; ++tt) { const int ch = (task >> 8) + 2 * tt, r0 = pm * 256 + ch * 16, s0 = r0 & 2047;
#pragma unroll
                for (int q = 0; q < 31; ++q) { const int s = s0 - 15 + q; uv[tt][q] = (s >= 0) ? u[(size_t)(r0 - 15 + q) * 1024 + col] : 0.f; } }
#pragma unroll
            for (int tt = 0; tt < 2; ++tt) { const int ch = (task >> 8) + 2 * tt, r0 = pm * 256 + ch * 16, s0 = r0 & 2047;
#pragma unroll
                for (int i = 0; i < 16; ++i) { float sum = 0.f;
#pragma unroll
                    for (int q = 0; q < 16; ++q) if (q < w) sum += uv[tt][15 + i - q];
                    const int s = s0 + i, cnt = (s + 1 < w) ? s + 1 : w;
                    d[(size_t)(r0 + i) * 1024 + col] = f2bf(sum / (float)cnt - uv[tt][15 + i]); } }
        }
        asm volatile("s_waitcnt vmcnt(0)" ::: "memory");
        __syncthreads();
        PoolOrder S{(const char*)(F.ws + WS_DBUF), (const char*)(F.ws + WS_POOLW), c};
        EpiPool E{(const float*)(F.ws + WS_POOLB), (float*)(F.ws + WS_OPOOL)};
        pg8::gemm_phase<EpiPool, PoolOrder, false>(stage, 256, 1024, 256, S, E);
    }
    cvt_stream(F, 6144, 6400, (unsigned*)(F.ws + WS_CTL) + CW_CVTQ + 64 * rep);
}

__device__ __forceinline__ void p4_cmp2(const Frame& F) {
    const float* part = (const float*)(F.ws + WS_CPART); const float* bias1p = (const float*)(F.ws + WS_BIAS1); bf16_t* ckv = (bf16_t*)(F.ws + WS_CMPKV);
    float* H = F.lds;
    for (int it = F.bid; it < 128; it += F.G) {
        const int kvi = it >> 6, r0 = (it & 63) * 16; const float* w2 = kvi ? F.in[I_WV2] : F.in[I_WK2];
        __syncthreads();
#pragma unroll
        for (int j = 0; j < 2; ++j) { const int idx = F.tid + 512 * j, r = idx >> 6, c = (idx & 63) * 4;
            pg8::f32x4 s = {0.f, 0.f, 0.f, 0.f};
#pragma unroll
            for (int sp = 0; sp < 8; ++sp) s += *(const pg8::f32x4*)(part + (((size_t)sp * 2 + kvi) * 1024 + r0 + r) * 256 + c) + *(const pg8::f32x4*)(bias1p + (sp * 2 + kvi) * 256 + c);
            H[r * 260 + c] = gelu_tanh(s[0]); H[r * 260 + c + 1] = gelu_tanh(s[1]); H[r * 260 + c + 2] = gelu_tanh(s[2]); H[r * 260 + c + 3] = gelu_tanh(s[3]); }
        __syncthreads();
        const int r = F.tid >> 5, c0 = (F.tid & 31) * 4;
        pg8::f32x4 acc = {0.f, 0.f, 0.f, 0.f};
#pragma unroll 8
        for (int k = 0; k < 256; ++k) acc += *(const pg8::f32x4*)(w2 + (size_t)k * 128 + c0) * H[r * 260 + k];
        const int R = r0 + r; const bool pad = (R & 127) == 127;
        uint2 w; w.x = pad ? 0u : pg8::cvt_pk_bf16(acc[0], acc[1]); w.y = pad ? 0u : pg8::cvt_pk_bf16(acc[2], acc[3]);
        *(uint2*)(ckv + ((size_t)kvi * 1024 + R) * 128 + c0) = w;
    }
}

__device__ __forceinline__ void unpack8(const pg8::u32x4 w, float (&f)[8]) {
    f[0] = __uint_as_float(w.x << 16); f[1] = __uint_as_float(w.x & 0xFFFF0000u); f[2] = __uint_as_float(w.y << 16); f[3] = __uint_as_float(w.y & 0xFFFF0000u);
    f[4] = __uint_as_float(w.z << 16); f[5] = __uint_as_float(w.z & 0xFFFF0000u); f[6] = __uint_as_float(w.w << 16); f[7] = __uint_as_float(w.w & 0xFFFF0000u);
}
__device__ __forceinline__ void p6_mix(const Frame& F) {
    const bf16_t* ocmp = (const bf16_t*)(F.ws + WS_OCMP); const bf16_t* owin = (const bf16_t*)(F.ws + WS_OWIN); const bf16_t* osel = (const bf16_t*)(F.ws + WS_OSEL);
    const float* ml = (const float*)(F.ws + WS_ML); const float* gates = (const float*)(F.ws + WS_GATES);
    const float* opool = (const float*)(F.ws + WS_OPOOL); bf16_t* mix = (bf16_t*)(F.ws + WS_MIX);
    const float* gn = F.in[I_GNNSA]; const float* gp = F.in[I_GNPOOL];
    const int gw = F.bid * NWAVES + F.wave, nw = F.G * NWAVES, lane = F.lane, h = lane >> 3;
    for (int r = gw; r < NT; r += nw) {
        const bool split = ((r & 2047) >> 6) >= 16;
        const size_t o = (size_t)r * 1024 + lane * 16;
        const float* gq = gates + (size_t)r * 24 + h * 3;
        const float g0 = 1.f / (1.f + __expf(-gq[0])), g1 = 1.f / (1.f + __expf(-gq[1])), g2 = 1.f / (1.f + __expf(-gq[2]));
        float w0 = 1.f, w1 = 0.f;
        if (split) { const float* m0p = ml + ((size_t)r * NH + h) * 2; const float* m1p = ml + (((size_t)NT + r) * NH + h) * 2;
            const float m0 = m0p[0], l0 = m0p[1], m1 = m1p[0], l1 = m1p[1], M = fmaxf(m0, m1);
            const float a0 = l0 * exp2f((m0 - M) * att::C2), a1 = l1 * exp2f((m1 - M) * att::C2), inv = 1.f / (a0 + a1); w0 = a0 * inv; w1 = a1 * inv; }
        float a[16], p[16]; float sa = 0.f, sp = 0.f;
#pragma unroll
        for (int hf = 0; hf < 2; ++hf) {
            float c8[8], w8[8], s8[8], t8[8];
            unpack8(*(const pg8::u32x4*)(ocmp + o + hf * 8), c8); unpack8(*(const pg8::u32x4*)(owin + o + hf * 8), w8); unpack8(*(const pg8::u32x4*)(osel + o + hf * 8), s8);
            if (split) unpack8(*(const pg8::u32x4*)(osel + (size_t)NT * 1024 + o + hf * 8), t8);
#pragma unroll
            for (int j = 0; j < 8; ++j) { const float os = split ? (w0 * s8[j] + w1 * t8[j]) : s8[j]; a[hf * 8 + j] = g0 * c8[j] + g1 * os + g2 * w8[j]; sa += a[hf * 8 + j] * a[hf * 8 + j]; }
        }
#pragma unroll
        for (int q = 0; q < 4; ++q) { const pg8::f32x4 v = *(const pg8::f32x4*)(opool + o + q * 4); p[q * 4] = v[0]; p[q * 4 + 1] = v[1]; p[q * 4 + 2] = v[2]; p[q * 4 + 3] = v[3]; sp += v[0] * v[0] + v[1] * v[1] + v[2] * v[2] + v[3] * v[3]; }
        sa = wave_sum(sa); sp = wave_sum(sp);
        const float ra = rsqrtf(sa * (1.f / 1024.f) + EPS), rp = rsqrtf(sp * (1.f / 1024.f) + EPS);
        float ga[16], gb[16];
#pragma unroll
        for (int q = 0; q < 4; ++q) { const pg8::f32x4 v = *(const pg8::f32x4*)(gn + lane * 16 + q * 4), u = *(const pg8::f32x4*)(gp + lane * 16 + q * 4);
            ga[q * 4] = v[0]; ga[q * 4 + 1] = v[1]; ga[q * 4 + 2] = v[2]; ga[q * 4 + 3] = v[3]; gb[q * 4] = u[0]; gb[q * 4 + 1] = u[1]; gb[q * 4 + 2] = u[2]; gb[q * 4 + 3] = u[3]; }
#pragma unroll
        for (int hf = 0; hf < 2; ++hf) { pg8::u32x4 wa, wb;
            wa.x = pg8::cvt_pk_bf16(a[hf * 8] * ra * ga[hf * 8], a[hf * 8 + 1] * ra * ga[hf * 8 + 1]); wa.y = pg8::cvt_pk_bf16(a[hf * 8 + 2] * ra * ga[hf * 8 + 2], a[hf * 8 + 3] * ra * ga[hf * 8 + 3]);
            wa.z = pg8::cvt_pk_bf16(a[hf * 8 + 4] * ra * ga[hf * 8 + 4], a[hf * 8 + 5] * ra * ga[hf * 8 + 5]); wa.w = pg8::cvt_pk_bf16(a[hf * 8 + 6] * ra * ga[hf * 8 + 6], a[hf * 8 + 7] * ra * ga[hf * 8 + 7]);
            wb.x = pg8::cvt_pk_bf16(p[hf * 8] * rp * gb[hf * 8], p[hf * 8 + 1] * rp * gb[hf * 8 + 1]); wb.y = pg8::cvt_pk_bf16(p[hf * 8 + 2] * rp * gb[hf * 8 + 2], p[hf * 8 + 3] * rp * gb[hf * 8 + 3]);
            wb.z = pg8::cvt_pk_bf16(p[hf * 8 + 4] * rp * gb[hf * 8 + 4], p[hf * 8 + 5] * rp * gb[hf * 8 + 5]); wb.w = pg8::cvt_pk_bf16(p[hf * 8 + 6] * rp * gb[hf * 8 + 6], p[hf * 8 + 7] * rp * gb[hf * 8 + 7]);
            *(pg8::u32x4*)(mix + (size_t)r * DM + lane * 16 + hf * 8) = wa; *(pg8::u32x4*)(mix + (size_t)r * DM + 1024 + lane * 16 + hf * 8) = wb; }
    }
}

struct EpiOut {
    const float* x; float* out; bf16_t* x1b; const float* lnm;
    __device__ __forceinline__ void operator()(const pg8::f32x4 (&acc)[2][2][4][2], const pg8::Unit& un, int wr, int wc, int fr, int fq) const {
#pragma unroll
        for (int ai = 0; ai < 2; ++ai)
#pragma unroll
            for (int m = 0; m < 4; ++m) {
                const int row = un.pm * 256 + ai * 128 + wr * 64 + m * 16 + fr;
#pragma unroll
                for (int bj = 0; bj < 2; ++bj)
#pragma unroll
                    for (int n = 0; n < 2; ++n) {
                        const size_t o = (size_t)row * DM + un.pn * 256 + bj * 128 + wc * 32 + n * 16 + 4 * fq;
                        const pg8::f32x4 v = acc[ai][bj][m][n] + *(const pg8::f32x4*)(x + o);
                        *(pg8::f32x4*)(out + o) = v;
                        const pg8::f32x4 g = *(const pg8::f32x4*)(lnm + un.pn * 256 + bj * 128 + wc * 32 + n * 16 + 4 * fq);
                        uint2 w; w.x = pg8::cvt_pk_bf16(v[0] * g[0], v[1] * g[1]); w.y = pg8::cvt_pk_bf16(v[2] * g[2], v[3] * g[3]); *(uint2*)(x1b + o) = w;
                    }
            }
    }
};
__device__ __forceinline__ void p7_out(const Frame& F, LAS unsigned char* stage) {
    pg8::DenseOrder S; S.init(F.ws + WS_MIX, F.ws + WS_WOUTT, DM, DM, NT, DM, F.G, F.bid);
    EpiOut E{F.in[I_X], F.out, (bf16_t*)(F.ws + WS_X1B), F.in[I_LNMOE]};
    pg8::gemm_phase<EpiOut, pg8::DenseOrder, false>(stage, DM, DM, DM, S, E);
}

__device__ __forceinline__ void p8_router(const Frame& F, int dummy) {
    typedef float f32x16 __attribute__((ext_vector_type(16)));
    const float* WR = (const float*)(F.ws + WS_WR); const float* WG4 = (const float*)(F.ws + WS_WG4); const float* brg = F.in[I_BRG]; const float* bre = F.in[I_BRE];
    float* rstd2 = (float*)(F.ws + (dummy ? WS_DBUF : WS_RSTD2)); int* arow = (int*)(F.ws + (dummy ? WS_DBUF + MB : WS_AROW)); int* tokl = (int*)(F.ws + (dummy ? WS_DBUF + 2 * MB : WS_TOKL)); float* gatel = (float*)(F.ws + (dummy ? WS_DBUF + 4 * MB : WS_GATEL));
    unsigned* cnt = (unsigned*)(F.ws + WS_CTL) + (dummy ? 8192 : CW_CNT);
    float* part = F.lds; float* ssp = part + 8 * 32 * 33; float* lgp = ssp + 256;
    const int lane = F.lane, row = lane & 31, half = lane >> 5, kbase = F.wave * 256;
    for (int it = F.bid; it < NT / 32; it += F.G) {
        const int tok0 = it * 32;
        const float* xp = F.out + (size_t)(tok0 + row) * DM + kbase + 4 * half;
        f32x16 acc = {0.f, 0.f, 0.f, 0.f, 0.f, 0.f, 0.f, 0.f, 0.f, 0.f, 0.f, 0.f, 0.f, 0.f, 0.f, 0.f};
        float ss = 0.f, lg0 = 0.f, lg1 = 0.f, lg2 = 0.f, lg3 = 0.f;
#pragma unroll 4
        for (int kb = 0; kb < 256; kb += 8) {
            const float4 xa = *(const float4*)(xp + kb);
            const int k0 = kbase + kb + 4 * half;
            ss += xa.x * xa.x + xa.y * xa.y + xa.z * xa.z + xa.w * xa.w;
            const float av[4] = {xa.x, xa.y, xa.z, xa.w};
#pragma unroll
            for (int j = 0; j < 4; ++j) {
                const float bv = WR[(size_t)(k0 + j) * 32 + row]; const float4 w4 = *(const float4*)(WG4 + (size_t)(k0 + j) * 4);
                acc = __builtin_amdgcn_mfma_f32_32x32x2f32(av[j], bv, acc, 0, 0, 0);
                lg0 += av[j] * w4.x; lg1 += av[j] * w4.y; lg2 += av[j] * w4.z; lg3 += av[j] * w4.w;
            }
        }
        ss += __shfl_xor(ss, 32); lg0 += __shfl_xor(lg0, 32); lg1 += __shfl_xor(lg1, 32); lg2 += __shfl_xor(lg2, 32); lg3 += __shfl_xor(lg3, 32);
        __syncthreads();
#pragma unroll
        for (int r = 0; r < 16; ++r) part[(F.wave * 32 + (r & 3) + 8 * (r >> 2) + 4 * half) * 33 + row] = acc[r];
        if (half == 0) { ssp[F.wave * 32 + row] = ss; float* q = lgp + (F.wave * 32 + row) * 4; q[0] = lg0; q[1] = lg1; q[2] = lg2; q[3] = lg3; }
        __syncthreads();
        if (F.wave == 0 && lane < 32) {
            const int t = lane, r = tok0 + t;
            float s2 = 0.f, lg[4] = {0.f, 0.f, 0.f, 0.f};
#pragma unroll
            for (int w = 0; w < 8; ++w) { s2 += ssp[w * 32 + t]; const float* q = lgp + (w * 32 + t) * 4; lg[0] += q[0]; lg[1] += q[1]; lg[2] += q[2]; lg[3] += q[3]; }
            const float rs = rsqrtf(s2 * (1.f / DM) + EPS);
#pragma unroll
            for (int j = 0; j < 4; ++j) lg[j] = lg[j] * rs + brg[j];
            int gs = 0; float gm = lg[0];
#pragma unroll
            for (int j = 1; j < 4; ++j) if (lg[j] > gm) { gm = lg[j]; gs = j; }
            float den = 0.f;
#pragma unroll
            for (int j = 0; j < 4; ++j) den += __expf(lg[j] - gm);
            const float pg = 1.f / den;
            float le[8];
#pragma unroll
            for (int j = 0; j < 8; ++j) { float s = 0.f;
#pragma unroll
                for (int w = 0; w < 8; ++w) s += part[(w * 32 + t) * 33 + gs * 8 + j];
                le[j] = s * rs + bre[gs * 8 + j]; }
            int e0 = 0; float m0 = le[0];
#pragma unroll
            for (int j = 1; j < 8; ++j) if (le[j] > m0) { m0 = le[j]; e0 = j; }
            int e1 = -1; float m1 = -3.0e38f;
#pragma unroll
            for (int j = 0; j < 8; ++j) if (j != e0 && le[j] > m1) { m1 = le[j]; e1 = j; }
            const float p1 = __expf(m1 - m0);
            const float gate0 = pg / (1.f + p1), gate1 = pg * p1 / (1.f + p1);
            rstd2[r] = rs;
            const int ea = gs * 8 + e0, eb = gs * 8 + e1;
            const unsigned sa = atomicAdd(&cnt[64 * ea], 1u), sb = atomicAdd(&cnt[64 * eb], 1u);
            tokl[ea * 8192 + sa] = r; gatel[ea * 8192 + sa] = gate0; tokl[eb * 8192 + sb] = r; gatel[eb * 8192 + sb] = gate1;
            arow[2 * r] = ea * 8192 + (int)sa; arow[2 * r + 1] = eb * 8192 + (int)sb;
        }
    }
}

__device__ __forceinline__ void moe_counts(const Frame& F, int* cnts  , int* pst  ) {
    const unsigned* cnt = (const unsigned*)(F.ws + WS_CTL) + CW_CNT;
    __syncthreads();
    if (F.tid < 32) cnts[F.tid] = (int)__hip_atomic_load(&cnt[64 * F.tid], __ATOMIC_RELAXED, __HIP_MEMORY_SCOPE_AGENT);
    __syncthreads();
    if (F.tid == 0) { int a = 0; for (int e = 0; e < 32; ++e) { pst[e] = a; a += (cnts[e] + 255) & ~255; } pst[32] = a; }
    __syncthreads();
}

constexpr int MOE_TAB_OFF = 1024 + 131072;
struct MoeTabs { int* cnts; int* pst; int* ust; int* rowtok; };
__device__ __forceinline__ MoeTabs moe_tabs(unsigned char* lds_raw) { MoeTabs T; T.cnts = (int*)(lds_raw + MOE_TAB_OFF); T.pst = T.cnts + 32; T.ust = T.pst + 40; T.rowtok = T.ust + 40; return T; }
template <int NTN> __device__ __forceinline__ void moe_units(const Frame& F, const MoeTabs& T) {
    moe_counts(F, T.cnts, T.pst);
    if (F.tid == 0) { int a = 0; for (int e = 0; e < 32; ++e) { T.ust[e] = a; a += ((T.cnts[e] + 255) >> 8) * NTN; } T.ust[32] = a; }
    __syncthreads();
}
template <int NTN> struct MoeOrder2 {
    const int* cnts; const int* pst; const int* ust; const int* rowtok; const bf16_t* A; const float* W0; const float* W1; int G, c, lda, ldb, gather;
    __device__ __forceinline__ bool next(int i, g2::Unit& u) const {
        const int L = i * G + c; if (L >= ust[32]) return false;
        int e = 0; while (ust[e + 1] <= L) ++e;
        const int w = L - ust[e], nmt = (cnts[e] + 255) >> 8; u.e = e; u.pn = w / nmt; u.pm = w - u.pn * nmt; u.li = i; return true;
    }
    __device__ __forceinline__ const bf16_t* a_row(const g2::Unit& u, int r) const {
        if (gather) { const int tk = rowtok[u.li * 256 + r]; return A + (size_t)(tk < 0 ? 0 : tk) * lda; }
        return A + (size_t)(pst[u.e] + u.pm * 256 + r) * lda;
    }
    __device__ __forceinline__ const float* b_col(const g2::Unit& u, int col) const {
        if (gather) { const int wcp = col >> 5, n = (col >> 4) & 1, i = col & 15; return (n ? W1 : W0) + (size_t)u.e * DM * FF + u.pn * 64 + 16 * wcp + i; }
        return W0 + (size_t)u.e * FF * DM + u.pn * 128 + col;
    }
};
struct EpiMoe1 {
    const int* pst; const int* rowtok; const float* rstd2; bf16_t* act;
    __device__ __forceinline__ void operator()(const pg8::f32x4 (&acc)[2][4][2], const g2::Unit& un, int wr, int wc, int fr, int fq) const {
#pragma unroll
        for (int ai = 0; ai < 2; ++ai)
#pragma unroll
            for (int m = 0; m < 4; ++m) {
                const int r = ai * 128 + wr * 64 + m * 16 + fr; const int tk = rowtok[un.li * 256 + r];
                if (tk >= 0) {
                    const float rs = rstd2[tk];
                    const pg8::f32x4 vg = acc[ai][m][0] * rs, vu = acc[ai][m][1] * rs; float o[4];
#pragma unroll
                    for (int j = 0; j < 4; ++j) o[j] = vg[j] / (1.f + __expf(-vg[j])) * vu[j];
                    uint2 w; w.x = pg8::cvt_pk_bf16(o[0], o[1]); w.y = pg8::cvt_pk_bf16(o[2], o[3]);
                    *(uint2*)(act + (size_t)(pst[un.e] + un.pm * 256 + r) * FF + un.pn * 64 + wc * 16 + 4 * fq) = w;
                }
            }
    }
};
struct EpiMoe2 {
    const int* cnts; const int* pst; const float* gatel; bf16_t* y;
    __device__ __forceinline__ void operator()(const pg8::f32x4 (&acc)[2][4][2], const g2::Unit& un, int wr, int wc, int fr, int fq) const {
#pragma unroll
        for (int ai = 0; ai < 2; ++ai)
#pragma unroll
            for (int m = 0; m < 4; ++m) {
                const int slot = un.pm * 256 + ai * 128 + wr * 64 + m * 16 + fr;
                if (slot < cnts[un.e]) {
                    const float gt = gatel[un.e * 8192 + slot];
                    bf16_t* dst = y + (size_t)(pst[un.e] + slot) * DM + un.pn * 128 + wc * 32 + 4 * fq;
#pragma unroll
                    for (int n = 0; n < 2; ++n) { const pg8::f32x4 v = acc[ai][m][n] * gt; uint2 w; w.x = pg8::cvt_pk_bf16(v[0], v[1]); w.y = pg8::cvt_pk_bf16(v[2], v[3]); *(uint2*)(dst + n * 16) = w; }
                }
            }
    }
};

__device__ __forceinline__ void p9_moe1(const Frame& F, unsigned char* lds_raw, LAS unsigned char* stage) {
    const MoeTabs T = moe_tabs(lds_raw);
    moe_units<8>(F, T);
    const int vc = (F.G % 8 == 0) ? (F.bid % 8) * (F.G / 8) + F.bid / 8 : F.bid;
    MoeOrder2<8> S{T.cnts, T.pst, T.ust, T.rowtok, (const bf16_t*)(F.ws + WS_X1B), F.in[I_WGATE], F.in[I_WUP], F.G, vc, DM, FF, 1};
    { const int* tokl = (const int*)(F.ws + WS_TOKL); g2::Unit u;
      for (int i = 0; i < 4 && S.next(i, u); ++i) { if (F.tid < 256) { const int slot = u.pm * 256 + F.tid; T.rowtok[i * 256 + F.tid] = slot < T.cnts[u.e] ? tokl[u.e * 8192 + slot] : -1; } } }
    asm volatile("s_waitcnt vmcnt(0) lgkmcnt(0)" ::: "memory");
    __syncthreads();
    EpiMoe1 E{T.pst, T.rowtok, (const float*)(F.ws + WS_RSTD2), (bf16_t*)(F.ws + WS_ACT)};
    g2::gemm<DM / 64, EpiMoe1, MoeOrder2<8>>(stage, S, E);
}

__device__ __forceinline__ void p10_moe2(const Frame& F, unsigned char* lds_raw, LAS unsigned char* stage) {
    const MoeTabs T = moe_tabs(lds_raw);
    moe_units<16>(F, T);
    const int vc = (F.G % 8 == 0) ? (F.bid % 8) * (F.G / 8) + F.bid / 8 : F.bid;
    MoeOrder2<16> S{T.cnts, T.pst, T.ust, nullptr, (const bf16_t*)(F.ws + WS_ACT), F.in[I_WDOWN], nullptr, F.G, vc, FF, DM, 0};
    EpiMoe2 E{T.cnts, T.pst, (const float*)(F.ws + WS_GATEL), (bf16_t*)(F.ws + WS_Y)};
    g2::gemm<FF / 64, EpiMoe2, MoeOrder2<16>>(stage, S, E);
}

__device__ __forceinline__ void p11_final(const Frame& F, int dummy) {
    int* cnts = (int*)(F.lds + 3072); int* pst = cnts + 32;
    moe_counts(F, cnts, pst);
    const bf16_t* y = (const bf16_t*)(F.ws + WS_Y); const int* arow = (const int*)(F.ws + WS_AROW); const float* lnf = F.in[I_LNFINAL];
    const int gw = F.bid * NWAVES + F.wave, nw = F.G * NWAVES, lane = F.lane;
    for (int r = gw; r < NT; r += nw) {
        const int a0 = arow[2 * r], a1 = arow[2 * r + 1];
        const size_t r0 = (size_t)(pst[a0 >> 13] + (a0 & 8191)), r1 = (size_t)(pst[a1 >> 13] + (a1 & 8191));
        float v[32]; float ss = 0.f;
#pragma unroll
        for (int i = 0; i < 8; ++i) { const int c = i * 256 + lane * 4; const float4 xv = *(const float4*)(F.out + (size_t)r * DM + c);
            const uint2 ya = *(const uint2*)(y + r0 * DM + c), yb = *(const uint2*)(y + r1 * DM + c);
            v[4 * i]     = xv.x + __uint_as_float(ya.x << 16) + __uint_as_float(yb.x << 16);
            v[4 * i + 1] = xv.y + __uint_as_float(ya.x & 0xFFFF0000u) + __uint_as_float(yb.x & 0xFFFF0000u);
            v[4 * i + 2] = xv.z + __uint_as_float(ya.y << 16) + __uint_as_float(yb.y << 16);
            v[4 * i + 3] = xv.w + __uint_as_float(ya.y & 0xFFFF0000u) + __uint_as_float(yb.y & 0xFFFF0000u);
            ss += v[4 * i] * v[4 * i] + v[4 * i + 1] * v[4 * i + 1] + v[4 * i + 2] * v[4 * i + 2] + v[4 * i + 3] * v[4 * i + 3]; }
        ss = wave_sum(ss);
        const float rs = rsqrtf(ss * (1.f / DM) + EPS);
#pragma unroll
        for (int i = 0; i < 8; ++i) { const int c = i * 256 + lane * 4; const float4 g = *(const float4*)(lnf + c);
            float4 o; o.x = v[4 * i] * rs * g.x; o.y = v[4 * i + 1] * rs * g.y; o.z = v[4 * i + 2] * rs * g.z; o.w = v[4 * i + 3] * rs * g.w;
            *(float4*)((dummy ? (float*)(F.ws + WS_W1T) : F.out) + (size_t)r * DM + c) = o; }
    }
}

constexpr int NPHASE = 11;
__global__ void __launch_bounds__(NTHREADS, 2) fwd(Args args) {
    extern __shared__ __attribute__((aligned(16))) unsigned char lds_raw[];
    Frame F;
#pragma unroll
    for (int i = 0; i < N_IN; ++i) F.in[i] = args.in[i];
    F.out = args.out; F.ws = args.ws;
    F.lds = (float*)(lds_raw + 16);
    F.tid = threadIdx.x; F.lane = F.tid & 63; F.wave = __builtin_amdgcn_readfirstlane(F.tid >> 6); F.G = gridDim.x; F.bid = blockIdx.x;
    if (F.tid < 4) ((LAS unsigned*)lds_raw)[F.tid] = 0u;
    __syncthreads();
    XcdBarrier bar; bar.bar = (unsigned*)(F.ws + WS_CTL); bar.x = 0; bar.st = nullptr;
    if (N_LAUNCHES == 1) bar = xcd_barrier_post((unsigned*)(F.ws + WS_CTL), (volatile LAS unsigned*)lds_raw);
    const int lo = args.ph_lo, hi = args.ph_hi;
#ifndef ONLY_PHASE
#define ONLY_PHASE -1
#endif
#define IN(k) (lo <= (k) && (k) < hi && (ONLY_PHASE < 0 || ONLY_PHASE == (k)))
#define SEAM(k) do { if (IN(k) && IN((k) + 1)) { xcd_barrier(bar); if (PROBE_REPEAT == 12) xcd_barrier(bar); } } while (0)
    LAS unsigned char* stage = (LAS unsigned char*)lds_raw + 1024;
#define RUN(k, ...) do { if (IN(k)) { __VA_ARGS__; if (PROBE_REPEAT == (k)) { xcd_barrier(bar); __VA_ARGS__; } } } while (0)
    RUN(0, p0_prologue(F));
    if (PROBE_REPEAT == 11 && IN(0)) { xcd_barrier(bar); cvt_stream(F, 0, 6400, nullptr); }
    SEAM(0);
    RUN(1, p1_proj(F, stage));
    SEAM(1);
    if (IN(2)) { p3_mid(F, stage, 0); if (PROBE_REPEAT == 2) { xcd_barrier(bar); p3_mid(F, stage, 1); } }
    SEAM(2);
    RUN(3, p4_cmp2(F));
    SEAM(3);
    if (IN(4)) {
#pragma unroll 1
        for (int rep = 0; rep < (PROBE_REPEAT == 4 ? 2 : 1); ++rep) { if (rep) xcd_barrier(bar); p_attn(F, lds_raw, rep); } }
    SEAM(4);
    RUN(5, p6_mix(F));
    SEAM(5);
    RUN(6, p7_out(F, stage));
    SEAM(6);
    if (IN(7)) { if (PROBE_REPEAT == 7) { p8_router(F, 1); xcd_barrier(bar); } p8_router(F, 0); }
    SEAM(7);
    if (IN(8)) {
#pragma unroll 1
        for (int rep = 0; rep < (PROBE_REPEAT == 8 ? 2 : 1); ++rep) { if (rep) xcd_barrier(bar); p9_moe1(F, lds_raw, stage); } }
    SEAM(8);
    if (IN(9)) {
#pragma unroll 1
        for (int rep = 0; rep < (PROBE_REPEAT == 9 ? 2 : 1); ++rep) { if (rep) xcd_barrier(bar); p10_moe2(F, lds_raw, stage); } }
    SEAM(9);
    if (IN(10)) { if (PROBE_REPEAT == 10) { p11_final(F, 1); xcd_barrier(bar); } p11_final(F, 0); }
#undef RUN
#undef IN
#undef SEAM
}

extern "C" void kernel_launch(void* const* d_in, const int* in_sizes, int n_in, void* d_out, int out_size, void* d_ws, size_t ws_size, hipStream_t stream) {
    static int grid = 0;
    if (grid == 0) {
        if (n_in != N_IN || out_size != NT * DM || ws_size < WS_END) { fprintf(stderr, "kernel_launch: unexpected shapes: n_in %d out %d ws %zu (need %zu)\n", n_in, out_size, ws_size, (size_t)WS_END); grid = -1; return; }
        int dev = 0, cus = 0, per_cu = 0;
        if (hipGetDevice(&dev) != hipSuccess || hipDeviceGetAttribute(&cus, hipDeviceAttributeMultiprocessorCount, dev) != hipSuccess) { grid = -1; return; }
        if (hipFuncSetAttribute((const void*)fwd, hipFuncAttributeMaxDynamicSharedMemorySize, LDS_BYTES) != hipSuccess) { fprintf(stderr, "kernel_launch: hipFuncSetAttribute failed\n"); grid = -1; return; }
        if (hipOccupancyMaxActiveBlocksPerMultiprocessor(&per_cu, (const void*)fwd, NTHREADS, LDS_BYTES) != hipSuccess || per_cu < 1) { fprintf(stderr, "kernel_launch: occupancy query says %d\n", per_cu); }
        (void)hipGetLastError();
        grid = cus;
    }
    if (grid < 0) return;
    (void)in_sizes;
    (void)hipMemsetAsync((char*)d_ws + WS_CTL, 0, CTL_ZERO_BYTES, stream);
    Args a{};
    for (int i = 0; i < N_IN; ++i) a.in[i] = (const float*)d_in[i];
    a.out = (float*)d_out; a.ws = (unsigned char*)d_ws;
    if (N_LAUNCHES == 1) { a.ph_lo = 0; a.ph_hi = NPHASE; hipLaunchKernelGGL(fwd, dim3(grid), dim3(NTHREADS), LDS_BYTES, stream, a); }
    else { for (int p = 0; p < NPHASE; ++p) { a.ph_lo = p; a.ph_hi = p + 1; hipLaunchKernelGGL(fwd, dim3(grid), dim3(NTHREADS), LDS_BYTES, stream, a); } }
}
```

```cpp
#include <hip/hip_runtime.h>
#include <cstdio>
#include <cstdint>

#ifndef PROBE_REPEAT
#define PROBE_REPEAT -1
#endif
#ifndef MERGE_CMP2
#define MERGE_CMP2 0
#endif
#ifndef PROBE_WG
#define PROBE_WG 0
#endif
#ifndef N_LAUNCHES
#define N_LAUNCHES 1
#endif

#define XB_TMO      128
#define XB_XCNT(j)  (256  + 64 * (j))
#define XB_XSUB(j)  (1280 + 64 * (j))
#define XB_XGEN(j)  (2304 + 64 * (j))
#define XB_TOP      3328
#define XB_TOPGEN   3392
#define XCD_BAR_WORDS 3456
#define XB_SPIN_CAP (1u << 21)
#define LAS __attribute__((address_space(3)))

__device__ __forceinline__ unsigned xb_ld(unsigned* p)              { return __hip_atomic_load(p, __ATOMIC_RELAXED, __HIP_MEMORY_SCOPE_AGENT); }
__device__ __forceinline__ unsigned xb_add(unsigned* p, unsigned v) { return __hip_atomic_fetch_add(p, v, __ATOMIC_RELAXED, __HIP_MEMORY_SCOPE_AGENT); }
__device__ __forceinline__ unsigned xb_xcc_id() { return (unsigned)__builtin_amdgcn_s_getreg((3 << 11) | 20) & 0xFu; }
#define XB_SPIN(cond, bar) do { unsigned _sp = 0; while (cond) { __builtin_amdgcn_s_sleep(1); \
    if ((++_sp & 255u) == 0u) { if (xb_ld(&(bar)[XB_TMO])) break; if (_sp > XB_SPIN_CAP) { atomicAdd(&(bar)[XB_TMO], 1u); break; } } } } while (0)

struct XcdBarrier { unsigned* bar; unsigned x; volatile LAS unsigned* st; int wave; };

__device__ __forceinline__ XcdBarrier xcd_barrier_post(unsigned* bar, volatile LAS unsigned* st) {
    XcdBarrier b; b.bar = bar; b.x = xb_xcc_id(); b.st = st;
    if (threadIdx.x == 0) (void)xb_add(&bar[XB_XCNT(b.x)], 1u);
    return b;
}
__device__ __forceinline__ void xcd_barrier_complete(unsigned* bar, unsigned x, unsigned& nloc, unsigned& nx) {
    const unsigned G = gridDim.x * gridDim.y * gridDim.z;
    unsigned sum, cnt, mine, sp = 0u;
    for (;;) {
        sum = 0u; cnt = 0u; mine = 0u;
#pragma unroll
        for (unsigned j = 0; j < 16; ++j) { const unsigned c = xb_ld(&bar[XB_XCNT(j)]); sum += c; cnt += (c > 0u) ? 1u : 0u; mine = (j == x) ? c : mine; }
        if (sum == G) break;
        __builtin_amdgcn_s_sleep(1);
        if ((++sp & 255u) == 0u) { if (xb_ld(&bar[XB_TMO])) break; if (sp > XB_SPIN_CAP) { atomicAdd(&bar[XB_TMO], 1u); break; } }
    }
    nloc = mine > 0u ? mine : 1u; nx = cnt > 0u ? cnt : 1u;
}
__device__ __forceinline__ int fresh_lane();
__device__ __forceinline__ void xcd_barrier(const XcdBarrier& b) {
    asm volatile("s_waitcnt vmcnt(0)" ::: "memory");
    __syncthreads();
    if (b.wave == 0 && fresh_lane() == 0) {
        unsigned* bar = b.bar;
        __builtin_amdgcn_s_waitcnt(0);
        unsigned nloc = b.st[0], nx = b.st[1];
        if (nloc == 0u) { xcd_barrier_complete(bar, b.x, nloc, nx); b.st[0] = nloc; b.st[1] = nx; }
        const unsigned old = xb_add(&bar[XB_XSUB(b.x)], 1u);
        const unsigned gen = old / nloc;
        if (old + 1u == (gen + 1u) * nloc) {
            __builtin_amdgcn_fence(__ATOMIC_RELEASE, "agent");
            asm volatile("s_waitcnt vmcnt(0)" ::: "memory");
            const unsigned og = xb_add(&bar[XB_TOP], 1u);
            const unsigned tg = og / nx;
            if (og + 1u == (tg + 1u) * nx) xb_add(&bar[XB_TOPGEN], 1u);
            else XB_SPIN(xb_ld(&bar[XB_TOPGEN]) == tg, bar);
            __builtin_amdgcn_fence(__ATOMIC_ACQUIRE, "agent");
            xb_add(&bar[XB_XGEN(b.x)], 1u);
            asm volatile("s_waitcnt vmcnt(0)" ::: "memory");
        } else {
            XB_SPIN(xb_ld(&bar[XB_XGEN(b.x)]) == gen, bar);
            __builtin_amdgcn_fence(__ATOMIC_ACQUIRE, "agent");
            asm volatile("s_waitcnt vmcnt(0)" ::: "memory");
        }
    }
    __syncthreads();
}

typedef unsigned short bf16_t;
constexpr int NB = 4, SEQ = 2048, DM = 2048, NT = NB * SEQ;
constexpr int NH = 8, NG = 2, HD = 128, INW = 3608, INWP = 3840;
constexpr int NCMP = 127, NSEL = 32, NEXP = 32, FF = 512;
constexpr float EPS = 1e-6f;
constexpr float SCALE = 0.08838834764831845f;
constexpr int NTHREADS = 512, NWAVES = 8;
constexpr int LDS_BYTES = 147456;
constexpr int YROWS = 24576;

enum { I_X = 0, I_POS, I_LNMIX, I_WIN, I_PEK, I_WK1, I_WK2, I_PEV, I_WV1, I_WV2, I_WPOOL, I_BPOOL, I_PSCALE, I_GNNSA, I_GNPOOL, I_WOUT, I_LNMOE,
       I_WRG, I_BRG, I_WRE, I_BRE, I_WGATE, I_WUP, I_WDOWN, I_LNFINAL, N_IN };

constexpr size_t MB = 1024 * 1024;
constexpr size_t WS_CTL   = 0;
constexpr size_t CTL_ZERO_BYTES = 65536;
constexpr int    CW_CNT   = 4096;
constexpr size_t WS_RSTD1 = 1 * MB;
constexpr size_t WS_RSTD2 = 1 * MB + 65536;
constexpr size_t WS_BIAS1 = 1 * MB + 131072;
constexpr size_t WS_AROW  = 1 * MB + 262144;
constexpr size_t WS_WR    = 1 * MB + 393216;
constexpr size_t WS_WG4   = 1 * MB + 655360;
constexpr size_t WS_WRP   = 32 * MB;
constexpr size_t WS_PL    = 40 * MB;
constexpr size_t WS_ROPEC = 2 * MB;
constexpr size_t WS_ROPES = 2 * MB + 524288;
constexpr size_t WS_GATES = 3 * MB;
constexpr size_t WS_TOKL  = 4 * MB;
constexpr size_t WS_GATEL = 5 * MB;
constexpr size_t WS_HID   = 6 * MB;
constexpr size_t WS_CMPKV = 8 * MB;
constexpr size_t WS_WINT  = 9 * MB;
constexpr size_t WS_WOUTT = 24 * MB;
constexpr size_t WS_W1T   = 32 * MB;
constexpr size_t WS_W2T   = 160 * MB;
constexpr size_t WS_CMPW  = 224 * MB;
constexpr size_t WS_POOLW = 228 * MB;
constexpr size_t WS_POOLB = 228 * MB + 524288;
constexpr size_t WS_CPART = 447 * MB;
constexpr size_t WS_DBUF  = 463 * MB;
constexpr size_t WS_XB    = 230 * MB;
constexpr size_t WS_QN    = 262 * MB;
constexpr size_t WS_QR    = 278 * MB;
constexpr size_t WS_KV    = 294 * MB;
constexpr size_t WS_U     = 319 * MB;
constexpr size_t WS_Y     = 230 * MB;
constexpr size_t WS_OWIN  = 351 * MB;
constexpr size_t WS_OCMP  = 367 * MB;
constexpr size_t WS_OSEL  = 319 * MB;
constexpr size_t WS_ML    = 6 * MB;
constexpr size_t WS_X1B   = 351 * MB;
constexpr size_t WS_OPOOL = 383 * MB;
constexpr size_t WS_ACT   = 383 * MB;
constexpr size_t WS_MIX   = 415 * MB;
constexpr size_t WS_END   = 479 * MB;

__device__ __forceinline__ bf16_t f2bf(float f) { unsigned u = __float_as_uint(f); u += 0x7FFFu + ((u >> 16) & 1u); return (bf16_t)(u >> 16); }
__device__ __forceinline__ float bf2f(bf16_t b) { return __uint_as_float(((unsigned)b) << 16); }
__device__ __forceinline__ float wave_sum(float v) {
#pragma unroll
    for (int o = 32; o >= 1; o >>= 1) v += __shfl_xor(v, o);
    return v;
}
__device__ __forceinline__ float wave_max(float v) {
#pragma unroll
    for (int o = 32; o >= 1; o >>= 1) v = fmaxf(v, __shfl_xor(v, o));
    return v;
}

__device__ __forceinline__ int fresh_lane() { int l; asm volatile("v_mbcnt_lo_u32_b32 %0, -1, 0\n\tv_mbcnt_hi_u32_b32 %0, -1, %0" : "=v"(l)); return l; }
struct Args { const float* in[N_IN]; float* out; unsigned char* ws; int ph_lo, ph_hi; };

struct Frame {
    const float* in[N_IN]; float* out; unsigned char* ws;
    float* lds;
    int tid, lane, wave, G, bid;
};

__device__ __forceinline__ float gelu_tanh(float x) { const float u = 0.7978845608028654f * (x + 0.044715f * x * x * x); return 0.5f * x * (1.f + tanhf(u)); }


namespace pg8 {
typedef short bf16x8 __attribute__((ext_vector_type(8)));
typedef float f32x4 __attribute__((ext_vector_type(4)));
typedef unsigned u32x4 __attribute__((ext_vector_type(4)));
constexpr int BM = 256, BK = 64, HALF = 128, HTB = HALF * BK * 2, STAGE_BYTES = 8 * HTB, NXCD = 8, WGM = 8;
__device__ __forceinline__ int lds_byte(int r, int c) { const int st = (r >> 4) * 2 + (c >> 5), rr = r & 15, cc = c & 31, ob = rr * 64 + cc * 2; return st * 1024 + (ob ^ (((ob >> 9) & 1) << 5)); }
__device__ __forceinline__ void stage_rc(int b, int& R, int& C) { const int st = b / 1024, sb = b % 1024, swz = sb ^ (((sb >> 9) & 1) << 5); R = (st >> 1) * 16 + swz / 64; C = (st & 1) * 32 + (swz % 64) / 2; }
struct Unit { int pm, pn, e, li; };
__device__ __forceinline__ unsigned cvt_pk_bf16(float lo, float hi) { unsigned r; asm volatile("v_cvt_pk_bf16_f32 %0, %1, %2" : "=v"(r) : "v"(lo), "v"(hi)); return r; }

struct DenseOrder {
    const char* A; const char* Bt; int lda, ldb; int nM, nN, nwg, G, c;
    __device__ void init(const void* A_, const void* Bt_, int lda_, int ldb_, int M, int N, int G_, int c_) { A = (const char*)A_; Bt = (const char*)Bt_; lda = lda_; ldb = ldb_; nM = M / BM; nN = N / BM; nwg = nM * nN; G = G_; c = c_; }
    __device__ __forceinline__ bool next(int i, Unit& u) const {
        const long L = (long)i * G + c; if (L >= nwg) return false;
        int wgid = (int)L; { const int q = nwg / NXCD, r = nwg % NXCD, xcd = wgid % NXCD, off = wgid / NXCD; wgid = (xcd < r ? xcd * (q + 1) : r * (q + 1) + (xcd - r) * q) + off; }
        const int nig = WGM * nN, gid = wgid / nig, fm = gid * WGM, gsz = (nM - fm) < WGM ? (nM - fm) : WGM;
        u.pm = fm + ((wgid % nig) % gsz); u.pn = (wgid % nig) / gsz; u.e = 0; u.li = i; return true;
    }
    __device__ __forceinline__ const char* a_base(const Unit& u) const { return A + (size_t)u.pm * BM * lda * 2; }
    __device__ __forceinline__ const char* b_base(const Unit& u) const { return Bt + (size_t)u.pn * BM * ldb * 2; }
    __device__ __forceinline__ unsigned a_row_off(const Unit&, int r) const { return (unsigned)r * (unsigned)lda * 2u; }
};

template <class Epi, class Sched, bool GATHER>
__device__ __forceinline__ void gemm_phase(LAS unsigned char* lds, const int K, const int lda, const int ldb, const Sched& S, const Epi& E) {
    const int tid = threadIdx.x, wid = __builtin_amdgcn_readfirstlane(tid >> 6), lane = tid & 63, wr = wid >> 2, wc = wid & 3, fr = lane & 15, fq = lane >> 4;
    const int nt = K / BK;
    int sR[2], sC[2];
#pragma unroll
    for (int i = 0; i < 2; ++i) stage_rc(tid * 16 + i * 8192, sR[i], sC[i]);
    unsigned voffB[2], voffA[2][2], nvoffA[2][2];
#pragma unroll
    for (int i = 0; i < 2; ++i) voffB[i] = (unsigned)(sR[i] * ldb + sC[i]) * 2u;
    const size_t kstep = (size_t)(BK * 2);
    const size_t hstepB = (size_t)HALF * ldb * 2;
    const unsigned ldsw = (unsigned)wid * 1024u;
    const int aoff = lds_byte(wr * 64 + fr, fq * 8), boff = lds_byte(wc * 32 + fr, fq * 8);
#define PG8_SA(b, h) (((b) * 2 + (h)) * HTB)
#define PG8_SB(b, h) ((4 + (b) * 2 + (h)) * HTB)
#define PG8_STAGE(bufoff, gbase, voff) do { _Pragma("unroll") for (int _i = 0; _i < 2; ++_i) \
        __builtin_amdgcn_global_load_lds((const unsigned*)((const char*)(gbase) + (voff)[_i]), (LAS unsigned*)(lds + (bufoff) + ldsw + _i * 8192), 16, 0, 0); } while (0)
#define PG8_LDA(dst, b, h) do { _Pragma("unroll") for (int m = 0; m < 4; ++m) _Pragma("unroll") for (int k = 0; k < 2; ++k) dst[m][k] = *(const LAS bf16x8*)(lds + PG8_SA(b, h) + aoff + m * 2048 + k * 1024); } while (0)
#define PG8_LDB(dst, b, h) do { _Pragma("unroll") for (int n = 0; n < 2; ++n) _Pragma("unroll") for (int k = 0; k < 2; ++k) dst[n][k] = *(const LAS bf16x8*)(lds + PG8_SB(b, h) + boff + n * 2048 + k * 1024); } while (0)
#define PG8_MMA(ai, bj, At, Bt) do { __builtin_amdgcn_s_setprio(1); _Pragma("unroll") for (int m = 0; m < 4; ++m) _Pragma("unroll") for (int n = 0; n < 2; ++n) _Pragma("unroll") for (int k = 0; k < 2; ++k) \
        { acc[ai][bj][m][n] = __builtin_amdgcn_mfma_f32_16x16x32_bf16(Bt[n][k], At[m][k], acc[ai][bj][m][n], 0, 0, 0); if (PROBE_REPEAT == 21) dummy = __builtin_amdgcn_mfma_f32_16x16x32_bf16(Bt[n][k], At[m][k], dummy, 0, 0, 0); } __builtin_amdgcn_s_setprio(0); } while (0)
#define PG8_WAIT_V(n) asm volatile("s_waitcnt vmcnt(" #n ")" ::: "memory")
#define PG8_WAIT_L(n) asm volatile("s_waitcnt lgkmcnt(" #n ")" ::: "memory")
#define PG8_BAR __builtin_amdgcn_s_barrier()
#define PG8_SCHED __builtin_amdgcn_sched_barrier(0)
#define PG8_AOFFS(dst, u) do { _Pragma("unroll") for (int _h = 0; _h < 2; ++_h) _Pragma("unroll") for (int _i = 0; _i < 2; ++_i) dst[_h][_i] = S.a_row_off(u, _h * HALF + sR[_i]) + (unsigned)sC[_i] * 2u; } while (0)
    Unit cur, nxt; int ui = 0;
    if (!S.next(0, cur)) return;
    f32x4 acc[2][2][4][2];
#pragma unroll
    for (int a = 0; a < 2; ++a)
#pragma unroll
        for (int b = 0; b < 2; ++b)
#pragma unroll
            for (int m = 0; m < 4; ++m)
#pragma unroll
                for (int n = 0; n < 2; ++n) acc[a][b][m][n] = (f32x4){0.f, 0.f, 0.f, 0.f};
    bf16x8 At[4][2], B0[2][2], B1[2][2]; f32x4 dummy = {0.f, 0.f, 0.f, 0.f};
    const char* cA = S.a_base(cur); const char* cB = S.b_base(cur);
    PG8_AOFFS(voffA, cur);
    PG8_STAGE(PG8_SB(0, 0), cB, voffB); PG8_STAGE(PG8_SA(0, 0), cA, voffA[0]); PG8_STAGE(PG8_SB(0, 1), cB + hstepB, voffB); PG8_STAGE(PG8_SA(0, 1), cA, voffA[1]);
    if (wr == 1) PG8_BAR;
    PG8_WAIT_V(4); PG8_BAR;
    PG8_STAGE(PG8_SB(1, 0), cB + kstep, voffB); PG8_STAGE(PG8_SA(1, 0), cA + kstep, voffA[0]); PG8_STAGE(PG8_SB(1, 1), cB + hstepB + kstep, voffB);
    PG8_WAIT_V(6); PG8_BAR;
    for (;;) {
        const bool has_next = S.next(ui + 1, nxt);
        const char* nA = has_next ? S.a_base(nxt) : cA; const char* nB = has_next ? S.b_base(nxt) : cB;
        if (GATHER) { if (has_next) { PG8_AOFFS(nvoffA, nxt); } else {
#pragma unroll
            for (int _h = 0; _h < 2; ++_h)
#pragma unroll
                for (int _i = 0; _i < 2; ++_i) nvoffA[_h][_i] = voffA[_h][_i]; } }
        for (int t = 0; t < nt; t += 2) {
            const bool last = (t == nt - 2);
            const char* a1 = cA + (size_t)(t + 1) * kstep;
            const char* a2 = last ? nA : cA + (size_t)(t + 2) * kstep; const char* b2 = last ? nB : cB + (size_t)(t + 2) * kstep;
            const char* a3 = a2 + kstep; const char* b3 = b2 + kstep;
            unsigned vA2[2][2];
#pragma unroll
            for (int _h = 0; _h < 2; ++_h)
#pragma unroll
                for (int _i = 0; _i < 2; ++_i) vA2[_h][_i] = (GATHER && last) ? nvoffA[_h][_i] : voffA[_h][_i];
            PG8_LDB(B0, 0, 0); PG8_SCHED; PG8_LDA(At, 0, 0); PG8_STAGE(PG8_SA(1, 1), a1, voffA[1]);
            PG8_WAIT_L(8); PG8_BAR; PG8_WAIT_L(0); PG8_MMA(0, 0, At, B0); PG8_BAR; PG8_SCHED;
            PG8_LDB(B1, 0, 1); PG8_STAGE(PG8_SB(0, 0), b2, voffB);
            PG8_BAR; PG8_WAIT_L(0); PG8_MMA(0, 1, At, B1); PG8_BAR;
            PG8_LDA(At, 0, 1); PG8_STAGE(PG8_SA(0, 0), a2, vA2[0]);
            PG8_BAR; PG8_WAIT_L(0); PG8_MMA(1, 0, At, B0); PG8_BAR; PG8_SCHED;
            PG8_STAGE(PG8_SB(0, 1), b2 + hstepB, voffB);
            PG8_WAIT_V(6); PG8_BAR; PG8_MMA(1, 1, At, B1); PG8_BAR;
            PG8_LDB(B0, 1, 0); PG8_SCHED; PG8_LDA(At, 1, 0); PG8_STAGE(PG8_SA(0, 1), a2, vA2[1]);
            PG8_WAIT_L(8); PG8_BAR; PG8_WAIT_L(0); PG8_MMA(0, 0, At, B0); PG8_BAR; PG8_SCHED;
            PG8_LDB(B1, 1, 1); PG8_STAGE(PG8_SB(1, 0), b3, voffB);
            PG8_BAR; PG8_WAIT_L(0); PG8_MMA(0, 1, At, B1); PG8_BAR;
            PG8_LDA(At, 1, 1); PG8_STAGE(PG8_SA(1, 0), a3, vA2[0]);
            PG8_BAR; PG8_WAIT_L(0); PG8_MMA(1, 0, At, B0); PG8_BAR; PG8_SCHED;
            PG8_STAGE(PG8_SB(1, 1), b3 + hstepB, voffB);
            PG8_WAIT_V(6); PG8_BAR; PG8_MMA(1, 1, At, B1); PG8_BAR;
        }
        if constexpr (!Epi::AFTER_DRAIN) E(acc, cur, wr, wc, fr, fq);
        if (!has_next) break;
#pragma unroll
        for (int a = 0; a < 2; ++a)
#pragma unroll
            for (int b = 0; b < 2; ++b)
#pragma unroll
                for (int m = 0; m < 4; ++m)
#pragma unroll
                    for (int n = 0; n < 2; ++n) acc[a][b][m][n] = (f32x4){0.f, 0.f, 0.f, 0.f};
        cur = nxt; cA = nA; cB = nB; ++ui;
        if (GATHER) {
#pragma unroll
            for (int _h = 0; _h < 2; ++_h)
#pragma unroll
                for (int _i = 0; _i < 2; ++_i) voffA[_h][_i] = nvoffA[_h][_i]; }
    }
    if (PROBE_REPEAT == 21) asm volatile("" :: "v"(dummy));
    PG8_WAIT_V(0);
    if (wr == 0) PG8_BAR;
    PG8_BAR;
    if constexpr (Epi::AFTER_DRAIN) E.fused(acc, cur, wr, wc, fr, fq, lds);
#undef PG8_SA
#undef PG8_SB
#undef PG8_STAGE
#undef PG8_LDA
#undef PG8_LDB
#undef PG8_MMA
#undef PG8_WAIT_V
#undef PG8_WAIT_L
#undef PG8_BAR
#undef PG8_SCHED
#undef PG8_AOFFS
}
}


namespace g2 {
using pg8::bf16x8; using pg8::f32x4; using pg8::lds_byte; using pg8::cvt_pk_bf16;
typedef short s16x4 __attribute__((ext_vector_type(4)));
constexpr int A_BYTES = 32768, B_BYTES = 16384, STG = A_BYTES + B_BYTES;
struct Unit { int e, pm, pn, li, half; };
template <int NT_, class Epi, class Sched>
__device__ __forceinline__ void gemm(LAS unsigned char* lds, const Sched& S, const Epi& E, const int wave_, unsigned long long* tprobe = nullptr) {
#if defined(__HIP_DEVICE_COMPILE__)
    const int wid = wave_, lane = fresh_lane(), tid = wid * 64 + lane, wr = wid >> 2, wc = wid & 3, fr = lane & 15, fq = lane >> 4;
    constexpr int nt = NT_;
    unsigned long long tacc = 0ull;
#define TCK() ((PROBE_REPEAT >= 30 && PROBE_REPEAT <= 33) ? (unsigned long long)__builtin_readcyclecounter() : 0ull)
    const unsigned long long t_all0 = TCK();
    const int awoff0 = lds_byte((tid >> 3) & 127, (tid & 7) * 8);
    const int bkr = tid >> 5, bnq = tid & 31;
    const int bwoff0 = A_BYTES + bkr * 256 + ((((bnq >> 2)) ^ ((bkr & 3) | (((bkr >> 3) & 1) << 2))) * 32) + (bnq & 3) * 8;
#define awoff(j) (awoff0 + ((j) & 1) * 8192 + ((j) >> 1) * 16384)
#define bwoff(j) (bwoff0 + (j) * 4096)
    const int aoff = lds_byte(wr * 64 + fr, fq * 8);
    int boff[2];
    { const int q = (lane >> 2) & 3, p = lane & 3, f = q | ((fq & 1) << 2);
#pragma unroll
      for (int n = 0; n < 2; ++n) boff[n] = A_BYTES + (8 * fq + q) * 256 + (((2 * wc + n) ^ f) * 32) + 8 * p; }
    const int ldsb = (int)(uintptr_t)lds;
    Unit u, un;
    if (!S.next(0, u)) return;
    unsigned pa[4], pan[4]; const float* pb; const float* pbn;
    const size_t bstep = (size_t)16 * S.ldb;
#define G2_PTRS(PA, PB, U) do { _Pragma("unroll") for (int j = 0; j < 4; ++j) { const int id = tid + 512 * j; PA[j] = S.a_off(U, id >> 3) + (unsigned)(id & 7) * 16u; } PB = S.b_col(U, 4 * bnq) + (size_t)bkr * S.ldb; } while (0)
    G2_PTRS(pa, pb, u);
    f32x4 acc[2][4][2];
#pragma unroll
    for (int a = 0; a < 2; ++a)
#pragma unroll
        for (int m = 0; m < 4; ++m)
#pragma unroll
            for (int n = 0; n < 2; ++n) acc[a][m][n] = (f32x4){0.f, 0.f, 0.f, 0.f};
    f32x4 dummy = {0.f, 0.f, 0.f, 0.f};
    bf16x8 ra0[4], ra1[4]; f32x4 rb0[4], rb1[4];
    bool hf = u.half != 0; const bool hfn = false; (void)hfn; int nvalid = S.nvalid(u);
#define G2_LOADA(RA, PA, HF, t) do { _Pragma("unroll") for (int j = 0; j < 4; ++j) if (j < 2 || !(HF)) RA[j] = *(const bf16x8*)((const char*)S.A + PA[j] + (unsigned)(t) * 128u); } while (0)
#define G2_LOADB(RB, PB, t) do { _Pragma("unroll") for (int j = 0; j < 4; ++j) RB[j] = *(const f32x4*)(PB + (size_t)(t) * 64 * S.ldb + j * bstep); } while (0)
#define G2_WRITE_A(st, RA, j) do { *(LAS bf16x8*)(lds + (st) * STG + awoff(j)) = RA[j]; } while (0)
#define G2_WRITE_B(st, RB, j) do { uint2 w_; w_.x = cvt_pk_bf16(RB[j][0], RB[j][1]); w_.y = cvt_pk_bf16(RB[j][2], RB[j][3]); *(LAS uint2*)(lds + (st) * STG + bwoff(j)) = w_; } while (0)
#define G2_TR(dst, n, imm) asm volatile("ds_read_b64_tr_b16 %0, %1 offset:%2" : "=&v"(dst) : "v"(ldsb + boff[n]), "i"(imm) : "memory")
#define G2_COMPUTE(st, DOW, WA, WB, HFC, HFW) do { const unsigned long long tc0_ = TCK(); \
        s16x4 b00l, b00h, b01l, b01h, b10l, b10h, b11l, b11h;        \
        G2_TR(b00l, 0, (st) * STG); G2_TR(b00h, 0, (st) * STG + 1024); G2_TR(b01l, 0, (st) * STG + 8192); G2_TR(b01h, 0, (st) * STG + 8192 + 1024); \
        G2_TR(b10l, 1, (st) * STG); G2_TR(b10h, 1, (st) * STG + 1024); G2_TR(b11l, 1, (st) * STG + 8192); G2_TR(b11h, 1, (st) * STG + 8192 + 1024); \
        bf16x8 At[4][2]; \
        _Pragma("unroll") for (int m = 0; m < 4; ++m) _Pragma("unroll") for (int k = 0; k < 2; ++k) At[m][k] = *(const LAS bf16x8*)(lds + (st) * STG + aoff + m * 2048 + k * 1024); \
        asm volatile("s_waitcnt lgkmcnt(0)" ::: "memory"); __builtin_amdgcn_sched_barrier(0); \
        if (PROBE_REPEAT == 31) tacc += TCK() - tc0_; \
        const bf16x8 B00 = {b00l[0], b00l[1], b00l[2], b00l[3], b00h[0], b00h[1], b00h[2], b00h[3]}, B01 = {b01l[0], b01l[1], b01l[2], b01l[3], b01h[0], b01h[1], b01h[2], b01h[3]}; \
        const bf16x8 B10 = {b10l[0], b10l[1], b10l[2], b10l[3], b10h[0], b10h[1], b10h[2], b10h[3]}, B11 = {b11l[0], b11l[1], b11l[2], b11l[3], b11h[0], b11h[1], b11h[2], b11h[3]}; \
        _Pragma("unroll") for (int a = 0; a < 2; ++a) { \
            _Pragma("unroll") for (int m = 0; m < 4; ++m) { \
                __builtin_amdgcn_s_setprio(1); \
                if (128 * a + 64 * wr + 16 * m < nvalid) {                 \
                acc[a][m][0] = __builtin_amdgcn_mfma_f32_16x16x32_bf16(B00, At[m][0], acc[a][m][0], 0, 0, 0); acc[a][m][0] = __builtin_amdgcn_mfma_f32_16x16x32_bf16(B01, At[m][1], acc[a][m][0], 0, 0, 0); \
                acc[a][m][1] = __builtin_amdgcn_mfma_f32_16x16x32_bf16(B10, At[m][0], acc[a][m][1], 0, 0, 0); acc[a][m][1] = __builtin_amdgcn_mfma_f32_16x16x32_bf16(B11, At[m][1], acc[a][m][1], 0, 0, 0); } \
                if (PROBE_REPEAT == 20) { dummy = __builtin_amdgcn_mfma_f32_16x16x32_bf16(B00, At[m][0], dummy, 0, 0, 0); dummy = __builtin_amdgcn_mfma_f32_16x16x32_bf16(B01, At[m][1], dummy, 0, 0, 0); dummy = __builtin_amdgcn_mfma_f32_16x16x32_bf16(B10, At[m][0], dummy, 0, 0, 0); dummy = __builtin_amdgcn_mfma_f32_16x16x32_bf16(B11, At[m][1], dummy, 0, 0, 0); } \
                __builtin_amdgcn_s_setprio(0); \
                if (DOW) { if (a == 0) { if (m < 2 || !(HFW)) G2_WRITE_A((st) ^ 1, WA, m); if (HFC) G2_WRITE_B((st) ^ 1, WB, m); } else G2_WRITE_B((st) ^ 1, WB, m); __builtin_amdgcn_sched_barrier(0); } } \
            if (HFC) break;                                               \
            if (a == 0) { __builtin_amdgcn_sched_barrier(0); \
                _Pragma("unroll") for (int m = 0; m < 4; ++m) _Pragma("unroll") for (int k = 0; k < 2; ++k) At[m][k] = *(const LAS bf16x8*)(lds + (st) * STG + 16384 + aoff + m * 2048 + k * 1024); \
                asm volatile("s_waitcnt lgkmcnt(0)" ::: "memory"); __builtin_amdgcn_sched_barrier(0); } } \
        if (PROBE_REPEAT == 32) tacc += TCK() - tc0_; } while (0)
    for (int ui = 0;; ++ui) {
        G2_LOADA(ra0, pa, hf, 0); G2_LOADB(rb0, pb, 0); G2_LOADA(ra1, pa, hf, 1); G2_LOADB(rb1, pb, 1);
        __syncthreads();
#pragma unroll
        for (int j = 0; j < 4; ++j) { if (j < 2 || !hf) G2_WRITE_A(0, ra0, j); G2_WRITE_B(0, rb0, j); }
        if (nt > 2) { G2_LOADA(ra0, pa, hf, 2); G2_LOADB(rb0, pb, 2); }
        __syncthreads();
#define G2_STEP(t) do { \
            G2_COMPUTE(0, true, ra1, rb1, hf, hf); \
            if ((t) + 3 < nt) { G2_LOADA(ra1, pa, hf, (t) + 3); G2_LOADB(rb1, pb, (t) + 3); } \
            __syncthreads(); \
            if ((t) + 2 < nt) { G2_COMPUTE(1, true, ra0, rb0, hf, hf); } else { G2_COMPUTE(1, false, ra0, rb0, hf, hf); } \
            if ((t) + 4 < nt) { G2_LOADA(ra0, pa, hf, (t) + 4); G2_LOADB(rb0, pb, (t) + 4); } \
            __syncthreads(); } while (0)
        G2_STEP(0); G2_STEP(2); G2_STEP(4); G2_STEP(6);
        if constexpr (NT_ > 8) { G2_STEP(8); G2_STEP(10); G2_STEP(12); G2_STEP(14); G2_STEP(16); G2_STEP(18); G2_STEP(20); G2_STEP(22); G2_STEP(24); G2_STEP(26); G2_STEP(28); G2_STEP(30); }
        static_assert(NT_ == 8 || NT_ == 32, "expand G2_STEP for this K");
#undef G2_STEP
        if (PROBE_REPEAT == 20) asm volatile("" :: "v"(dummy));
        E(acc, u, wr, wc, fr, fq);
        if (!S.next(ui + 1, un)) break;
#pragma unroll
        for (int a = 0; a < 2; ++a)
#pragma unroll
            for (int m = 0; m < 4; ++m)
#pragma unroll
                for (int n = 0; n < 2; ++n) acc[a][m][n] = (f32x4){0.f, 0.f, 0.f, 0.f};
        u.e = un.e; u.pm = un.pm; u.pn = un.pn; u.li = un.li; u.half = un.half; hf = u.half != 0; nvalid = S.nvalid(u);
        G2_PTRS(pa, pb, u);
    }
#undef G2_PTRS
#undef awoff
#undef bwoff
#undef G2_LOADA
#undef G2_LOADB
#undef G2_WRITE_A
#undef G2_WRITE_B
#undef G2_TR
#undef G2_COMPUTE
    if (PROBE_REPEAT == 33) tacc = TCK() - t_all0;
    if (tprobe && blockIdx.x == PROBE_WG && threadIdx.x == 0) *tprobe = tacc;
#undef TCK
#endif
}
}

namespace att {
typedef short bf16x8 __attribute__((ext_vector_type(8)));
typedef short s16x4 __attribute__((ext_vector_type(4)));
typedef float f32x16 __attribute__((ext_vector_type(16)));
typedef float f32x4 __attribute__((ext_vector_type(4)));
typedef unsigned u32x4 __attribute__((ext_vector_type(4)));
constexpr int SHM = 16384;
constexpr int NBUF = 3;
constexpr int L_K = 0, L_V = NBUF * SHM, L_WS = 2 * NBUF * SHM, L_PART = L_WS + 8 * 64 * 4, L_SELM = L_PART + 4 * 64 * 33 * 4, L_VALS = L_SELM + 256, L_ITEM = L_VALS + 8 * 64 * 4, L_END = L_ITEM + 16;
constexpr float C2 = 1.4426950408889634f * SCALE;
#define KSWZ(row, colB) ((row) * 256 + ((colB) ^ (((row) & 7) << 4)))
#define SBAR() __builtin_amdgcn_sched_barrier(0)
__device__ __forceinline__ int v_st(int k, int c) { const int kk = (k & ~0xC) | ((k & 4) << 1) | ((k & 8) >> 1); return ((kk >> 3) * 4 + (c >> 5)) * 512 + ((kk & 7) * 32 + (c & 31)) * 2; }
__device__ __forceinline__ int v_rd_base(int lane) { return ((lane & 3) << 3) | (((lane >> 2) & 3) << 6) | (((lane >> 4) & 1) << 5) | (((lane >> 5) & 1) << 8); }
constexpr int v_rd_off(int d0, int ks, int half) { return d0 * 512 + ks * 4096 + half * 2048; }
__device__ __forceinline__ int crow(int r, int hi) { return (r & 3) + 8 * (r >> 2) + 4 * hi; }
__device__ __forceinline__ unsigned cvtpk(float lo, float hi) { unsigned r; asm volatile("v_cvt_pk_bf16_f32 %0, %1, %2" : "=v"(r) : "v"(lo), "v"(hi)); return r; }
__device__ __forceinline__ float swap_max(float v) { auto rr = __builtin_amdgcn_permlane32_swap(__float_as_uint(v), __float_as_uint(v), false, false); return fmaxf(__uint_as_float(rr[0]), __uint_as_float(rr[1])); }
__device__ __forceinline__ float swap_sum(float v) { auto rr = __builtin_amdgcn_permlane32_swap(__float_as_uint(v), __float_as_uint(v), false, false); return __uint_as_float(rr[0]) + __uint_as_float(rr[1]); }

struct WV { int tid, wid, lane, r32, hi, vb0; unsigned ksrc[2], vsrc[2]; char* lds; LAS unsigned char* ldsL; };
__device__ __forceinline__ void wv_src_init(WV& w) {
#pragma unroll
    for (int i = 0; i < 2; ++i) {
        const int L = (w.wid * 2 + i) * 1024 + w.lane * 16;
        { const int row = L >> 8, colB = (L & 255) ^ ((row & 7) << 4); w.ksrc[i] = (unsigned)(row * 256 + colB); }
        { const int sub = L >> 9, kkhi = sub >> 2, cblk = sub & 3, within = L & 511, kklo = within >> 6, cc = (within >> 1) & 31;
          const int kk = kkhi * 8 + kklo, k = (kk & ~0xC) | ((kk & 4) << 1) | ((kk & 8) >> 1), c = cblk * 32 + cc; w.vsrc[i] = (unsigned)(k * 256 + c * 2); }
    }
}
__device__ __forceinline__ void dma_tile(const WV& w, const bf16_t* Kt, const bf16_t* Vt, int buf) {
    int ln = w.lane; asm volatile("" : "+v"(ln));
#pragma unroll
    for (int i = 0; i < 2; ++i) {
        const int L = (w.wid * 2 + i) * 1024 + ln * 16;
        const int row = L >> 8, colB = (L & 255) ^ ((row & 7) << 4); const unsigned ksrc = (unsigned)(row * 256 + colB);
        const int sub = L >> 9, kkhi = sub >> 2, cblk = sub & 3, within = L & 511, kklo = within >> 6, cc = (within >> 1) & 31;
        const int kk = kkhi * 8 + kklo, k = (kk & ~0xC) | ((kk & 4) << 1) | ((kk & 8) >> 1), c = cblk * 32 + cc; const unsigned vsrc = (unsigned)(k * 256 + c * 2);
        __builtin_amdgcn_global_load_lds((const unsigned*)((const char*)Vt + vsrc), (LAS unsigned*)(w.ldsL + L_V + buf * SHM + (w.wid * 2 + i) * 1024), 16, 0, 0);
        __builtin_amdgcn_global_load_lds((const unsigned*)((const char*)Kt + ksrc), (LAS unsigned*)(w.ldsL + L_K + buf * SHM + (w.wid * 2 + i) * 1024), 16, 0, 0);
    }
}
template <int BUF>
__device__ __forceinline__ void qkt(const WV& w, const bf16x8 (&qr)[8], f32x16& p0, f32x16& p1) {
    p0 = f32x16{}; p1 = f32x16{};
    const LAS char* kb[4];
#pragma unroll
    for (int dd = 0; dd < 4; ++dd) kb[dd] = (const LAS char*)w.ldsL + L_K + KSWZ(w.r32, (dd * 16 + w.hi * 8) * 2);
#pragma unroll
    for (int d0 = 0; d0 < 8; ++d0) { const LAS char* a = kb[d0 & 3] + BUF * SHM + (d0 >> 2) * 128;
        const bf16x8 b0 = *reinterpret_cast<const LAS bf16x8*>(a); const bf16x8 b1 = *reinterpret_cast<const LAS bf16x8*>(a + 32 * 256);
        p0 = __builtin_amdgcn_mfma_f32_32x32x16_bf16(b0, qr[d0], p0, 0, 0, 0);
        p1 = __builtin_amdgcn_mfma_f32_32x32x16_bf16(b1, qr[d0], p1, 0, 0, 0);
        if (d0 == 3) SBAR(); }
}
__device__ __forceinline__ void pack_p(const f32x16& p0, const f32x16& p1, bf16x8& pa0, bf16x8& pa1, bf16x8& pa2, bf16x8& pa3) {
#define PK4(P, B_, OUT) do { unsigned a0 = cvtpk(P[B_+0], P[B_+1]), a1 = cvtpk(P[B_+2], P[B_+3]); unsigned b0 = cvtpk(P[B_+4], P[B_+5]), b1 = cvtpk(P[B_+6], P[B_+7]); \
        auto r0 = __builtin_amdgcn_permlane32_swap(a0, b0, false, false); auto r1 = __builtin_amdgcn_permlane32_swap(a1, b1, false, false); \
        u32x4 w_ = {r0[0], r1[0], r0[1], r1[1]}; OUT = *reinterpret_cast<bf16x8*>(&w_); } while (0)
    PK4(p0, 0, pa0); PK4(p0, 8, pa1); PK4(p1, 0, pa2); PK4(p1, 8, pa3);
#undef PK4
}
template <int VB>
__device__ __forceinline__ void pv_tile(f32x16* o, int vb0, bf16x8 pa0, bf16x8 pa1, bf16x8 pa2, bf16x8 pa3) {
#define TRRD(dst, off) asm volatile("ds_read_b64_tr_b16 %0, %1 offset:%2" : "=&v"(dst) : "v"(vb0), "i"(off) : "memory")
#define PV_D0(d0) do { s16x4 l0, l1, l2, l3, h0, h1, h2, h3; constexpr int b_ = VB * SHM + v_rd_off(d0, 0, 0); \
        TRRD(l0, b_); TRRD(h0, b_ + 2048); TRRD(l1, b_ + 4096); TRRD(h1, b_ + 6144); TRRD(l2, b_ + 8192); TRRD(h2, b_ + 10240); TRRD(l3, b_ + 12288); TRRD(h3, b_ + 14336); \
        asm volatile("s_waitcnt lgkmcnt(0)" ::: "memory"); SBAR(); \
        o[d0] = __builtin_amdgcn_mfma_f32_32x32x16_bf16(pa0, (bf16x8){l0[0], l0[1], l0[2], l0[3], h0[0], h0[1], h0[2], h0[3]}, o[d0], 0, 0, 0); \
        o[d0] = __builtin_amdgcn_mfma_f32_32x32x16_bf16(pa1, (bf16x8){l1[0], l1[1], l1[2], l1[3], h1[0], h1[1], h1[2], h1[3]}, o[d0], 0, 0, 0); \
        o[d0] = __builtin_amdgcn_mfma_f32_32x32x16_bf16(pa2, (bf16x8){l2[0], l2[1], l2[2], l2[3], h2[0], h2[1], h2[2], h2[3]}, o[d0], 0, 0, 0); \
        o[d0] = __builtin_amdgcn_mfma_f32_32x32x16_bf16(pa3, (bf16x8){l3[0], l3[1], l3[2], l3[3], h3[0], h3[1], h3[2], h3[3]}, o[d0], 0, 0, 0); } while (0)
    PV_D0(0); PV_D0(1); PV_D0(2); PV_D0(3);
#undef PV_D0
#undef TRRD
}
__device__ __forceinline__ void store_o(const WV& w, const f32x16* o, const float* tab, bf16_t* outp) {
    bf16_t* lp = outp + (size_t)w.hi * 4096 + w.r32;
#pragma unroll
    for (int r = 0; r < 16; ++r) { const int q = crow(r, w.hi); const float sc = tab[q];
        bf16_t* p = lp; asm volatile("" : "+v"(p));
        p += ((r & 3) + 8 * (r >> 2)) * 1024;
#pragma unroll
        for (int d0 = 0; d0 < 4; ++d0) { const float v = o[d0][r] * sc; const float vn = __shfl_xor(v, 1);
            if ((w.r32 & 1) == 0) *(__attribute__((address_space(1))) unsigned*)(p + d0 * 32) = cvtpk(v, vn); } }
}

template <int MODE>
__device__ __forceinline__ void flash_pass(const WV& w, const bf16_t* Kp, const bf16_t* Vp, int j_lo, int j_hi, const bf16x8 (&qr)[8], int tpos, int tw0, unsigned selmask,
                                           f32x16 (&o)[4], float& m_reg, float& l_reg) {
    float* al_l = (float*)(w.lds + L_WS) + w.wid * 64;
    dma_tile(w, Kp + (size_t)j_lo * 64 * HD, Vp + (size_t)j_lo * 64 * HD, 0);
    if (j_lo + 1 < j_hi) dma_tile(w, Kp + (size_t)(j_lo + 1) * 64 * HD, Vp + (size_t)(j_lo + 1) * 64 * HD, 1);
#define FSTEP(BUF, jj) do { const int jt = (jj);                                                                                  \
        if (jt + 1 < j_hi) asm volatile("s_waitcnt vmcnt(4)" ::: "memory"); else asm volatile("s_waitcnt vmcnt(0)" ::: "memory");   \
        asm volatile("s_waitcnt lgkmcnt(0)" ::: "memory"); __builtin_amdgcn_s_barrier(); asm volatile("" ::: "memory");          \
        if (jt + 2 < j_hi) dma_tile(w, Kp + (size_t)(jt + 2) * 64 * HD, Vp + (size_t)(jt + 2) * 64 * HD, ((BUF) + 2) % 3);         \
        f32x16 p0, p1;                                                                                                           \
        qkt<BUF>(w, qr, p0, p1);                                                                                                 \
        const int kb = jt * 64;                                                                                                  \
        { const float NEG = -__builtin_inff();                                                                                   \
          const bool need = (kb + 63 > tw0) || (MODE == 1 && kb <= tw0 + 31 - 512);                                              \
          if (need) { const int dq = tpos - kb - 4 * w.hi; const unsigned W = (MODE == 1) ? 512u : 0x7fffffffu;                  \
              _Pragma("unroll") for (int r = 0; r < 16; ++r) { const int c = (r & 3) + 8 * (r >> 2); if ((unsigned)(dq - c) >= W) p0[r] = NEG; if ((unsigned)(dq - c - 32) >= W) p1[r] = NEG; } } \
          if (MODE == 0) { const bool sel = (selmask >> jt) & 1u;                                                                \
              if (!__all(sel)) { _Pragma("unroll") for (int r = 0; r < 16; ++r) { p0[r] = sel ? p0[r] : NEG; p1[r] = sel ? p1[r] : NEG; } } } } \
        float pmax = p0[0];                                                                                                      \
        _Pragma("unroll") for (int r = 1; r < 16; ++r) pmax = fmaxf(pmax, p0[r]);                                                \
        _Pragma("unroll") for (int r = 0; r < 16; ++r) pmax = fmaxf(pmax, p1[r]);                                                \
        pmax = swap_max(pmax);                                                                                                   \
        float mn = m_reg, alpha = 1.f;                                                                                           \
        const bool resc = !__all((pmax - m_reg) * SCALE <= 8.f);          \
        if (resc) { mn = fmaxf(m_reg, pmax); alpha = __builtin_amdgcn_exp2f((m_reg - mn) * C2); m_reg = mn; }                     \
        const float mnL = -mn * C2;                                                                                              \
        float ps = 0.f;                                                                                                          \
        _Pragma("unroll") for (int r = 0; r < 16; ++r) { p0[r] = __builtin_amdgcn_exp2f(fmaf(p0[r], C2, mnL)); ps += p0[r]; }    \
        _Pragma("unroll") for (int r = 0; r < 16; ++r) { p1[r] = __builtin_amdgcn_exp2f(fmaf(p1[r], C2, mnL)); ps += p1[r]; }    \
        ps = swap_sum(ps);                                                                                                       \
        l_reg = l_reg * alpha + ps;                                                                                              \
        if (resc) { if (w.hi == 0) al_l[w.r32] = alpha;                                                                          \
            asm volatile("s_waitcnt lgkmcnt(0)" ::: "memory");                                                                   \
            _Pragma("unroll") for (int r = 0; r < 16; ++r) { const float a = al_l[crow(r, w.hi)];                                \
                _Pragma("unroll") for (int d = 0; d < 4; ++d) o[d][r] *= a; } }                                                  \
        bf16x8 pa0, pa1, pa2, pa3;                                                                                               \
        pack_p(p0, p1, pa0, pa1, pa2, pa3);                                                                                      \
        pv_tile<BUF>(o, w.vb0, pa0, pa1, pa2, pa3);                                                                              \
    } while (0)
    int j = j_lo;
    for (; j + 2 < j_hi; j += 3) { FSTEP(0, j); FSTEP(1, j + 1); FSTEP(2, j + 2); }
    if (j < j_hi) { FSTEP(0, j); if (j + 1 < j_hi) FSTEP(1, j + 1); }
#undef FSTEP
    __syncthreads();
}
}

__device__ const unsigned char ATT_ITEMS[80] = {15, 30, 31, 63, 14, 28, 29, 61, 62, 13, 26, 27, 59, 60, 12, 24, 25, 57, 58, 11, 22, 23, 55, 56, 10, 20, 21, 53, 54, 9, 18, 19, 51, 52, 8, 16, 17, 49, 50, 7, 48, 6, 5,
    72, 73, 74, 75, 76, 77, 78, 79, 80, 81, 82, 83, 84, 85, 86, 87, 88, 89, 90, 91, 92, 93, 94, 95, 4, 71, 3, 70, 2, 69, 1, 68, 0, 67, 66, 65, 64};
constexpr int CW_QUEUE = 6144;
constexpr int CW_CVTQ = 6144 + 256;
constexpr int CW_CMPR = 8192 + 2048;

__device__ __forceinline__ void p_attn(const Frame& F, unsigned char* lds_raw, int rep) {
    using namespace att;
    WV w;
#define WV_INIT() do { int ln_ = F.lane; asm volatile("" : "+v"(ln_)); w.tid = F.wave * 64 + ln_; w.wid = F.wave; w.lane = ln_; w.r32 = ln_ & 31; w.hi = ln_ >> 5; \
        w.lds = (char*)lds_raw + 1024; w.ldsL = (LAS unsigned char*)lds_raw + 1024; w.vb0 = (int)(uintptr_t)(w.lds) + att::L_V + v_rd_base(ln_); } while (0)
    WV_INIT();
    const bf16_t* qn = (const bf16_t*)(F.ws + WS_QN); const bf16_t* qrp = (const bf16_t*)(F.ws + WS_QR); const bf16_t* kv = (const bf16_t*)(F.ws + WS_KV);
    const bf16_t* ckv = (const bf16_t*)(F.ws + WS_CMPKV);
    bf16_t* ocmp = (bf16_t*)(F.ws + WS_OCMP); bf16_t* owin = (bf16_t*)(F.ws + WS_OWIN); bf16_t* osel = (bf16_t*)(F.ws + WS_OSEL); float* ml = (float*)(F.ws + WS_ML);
    unsigned* qctr = (unsigned*)(F.ws + WS_CTL) + CW_QUEUE + 64 * rep;
    float* wsf = (float*)(w.lds + L_WS) + w.wid * 64;
    float* part = (float*)(w.lds + L_PART); unsigned* selm = (unsigned*)(w.lds + L_SELM); float* vals = (float*)(w.lds + L_VALS) + w.wid * 64; volatile int* itemw = (volatile int*)(w.lds + L_ITEM);
    const int hr = w.wid >> 1, th = w.wid & 1;
    for (;;) {
        __syncthreads();
        if (F.tid == 0) itemw[0] = (int)atomicAdd(qctr, 1u);
        __syncthreads();
        const int item = itemw[0];
        if (item >= 640) break;
        WV_INIT();
        const int ent = ATT_ITEMS[item >> 3], bg = item & 7, type = ent >> 5, qb = ent & 31, b = bg >> 1, g = bg & 1, h = 4 * g + hr;
        const int t0 = qb * 64 + th * 32, tpos = t0 + w.r32, tok0 = b * SEQ + t0;
        const size_t qoff = (((size_t)b * NH + h) * SEQ + t0 + w.r32) * HD + w.hi * 8;
        const size_t kvoff = ((size_t)b * NG + g) * SEQ * HD;
        bf16x8 qr[8];
        f32x16 o[4];
#ifndef ATT_NO_WIN
        if (type == 2) {
#pragma unroll
            for (int d0 = 0; d0 < 8; ++d0) qr[d0] = *(const bf16x8*)(qrp + qoff + d0 * 16);
#pragma unroll
            for (int d = 0; d < 4; ++d) o[d] = f32x16{};
            float m_reg = -1e30f, l_reg = 0.f;
            flash_pass<1>(w, kv + (size_t)4 * (4 * MB / 2) + kvoff, kv + (size_t)5 * (4 * MB / 2) + kvoff, qb >= 8 ? qb - 8 : 0, qb + 1, qr, tpos, t0, 0u, o, m_reg, l_reg);
            if (w.hi == 0) wsf[w.r32] = 1.f / l_reg;
            asm volatile("s_waitcnt lgkmcnt(0)" ::: "memory");
            store_o(w, o, wsf, owin + (size_t)tok0 * 1024 + h * HD);
            continue;
        }
#endif
#ifndef ATT_NO_CMP
        {
#pragma unroll
            for (int d0 = 0; d0 < 8; ++d0) qr[d0] = *(const bf16x8*)(qn + qoff + d0 * 16);
            const bf16_t* Kc = ckv + (size_t)bg * 128 * HD; const bf16_t* Vc = ckv + (size_t)1024 * HD + (size_t)bg * 128 * HD;
            dma_tile(w, Kc, Vc, 0); dma_tile(w, Kc + 64 * HD, Vc + 64 * HD, 1);
            asm volatile("s_waitcnt vmcnt(0)" ::: "memory");
            __syncthreads();
            f32x16 pA0, pA1, pB0, pB1;
            qkt<0>(w, qr, pA0, pA1); qkt<1>(w, qr, pB0, pB1);
            const int nmax = tpos >= 31 ? ((tpos - 31) >> 4) : -1;
            const float NEG = -__builtin_inff();
            float pmax = NEG;
#pragma unroll
            for (int r = 0; r < 16; ++r) { const int n = crow(r, w.hi);
                pA0[r] = (n <= nmax) ? pA0[r] : NEG; pA1[r] = (n + 32 <= nmax) ? pA1[r] : NEG; pB0[r] = (n + 64 <= nmax) ? pB0[r] : NEG; pB1[r] = (n + 96 <= nmax) ? pB1[r] : NEG;
                pmax = fmaxf(fmaxf(pmax, pA0[r]), fmaxf(pA1[r], fmaxf(pB0[r], pB1[r]))); }
            pmax = swap_max(pmax);
            const float mm = (pmax == NEG) ? 0.f : pmax;
            const float mnL = -mm * C2;
            float ps = 0.f;
#pragma unroll
            for (int r = 0; r < 16; ++r) { pA0[r] = __builtin_amdgcn_exp2f(fmaf(pA0[r], C2, mnL)); pA1[r] = __builtin_amdgcn_exp2f(fmaf(pA1[r], C2, mnL));
                pB0[r] = __builtin_amdgcn_exp2f(fmaf(pB0[r], C2, mnL)); pB1[r] = __builtin_amdgcn_exp2f(fmaf(pB1[r], C2, mnL)); ps += (pA0[r] + pA1[r]) + (pB0[r] + pB1[r]); }
            ps = swap_sum(ps);
            const float inv = ps > 0.f ? 1.f / ps : 0.f;
#pragma unroll
            for (int r = 0; r < 16; ++r) { pA0[r] *= inv; pA1[r] *= inv; pB0[r] *= inv; pB1[r] *= inv; }
            {
                float av[16], bv[16];
#pragma unroll
                for (int gq = 0; gq < 4; ++gq) {
                    av[gq]      = pA0[4 * gq] + pA0[4 * gq + 1] + pA0[4 * gq + 2] + 0.5f * pA0[4 * gq + 3]; bv[gq]      = 0.5f * pA0[4 * gq + 3];
                    av[4 + gq]  = pA1[4 * gq] + pA1[4 * gq + 1] + pA1[4 * gq + 2] + 0.5f * pA1[4 * gq + 3]; bv[4 + gq]  = 0.5f * pA1[4 * gq + 3];
                    av[8 + gq]  = pB0[4 * gq] + pB0[4 * gq + 1] + pB0[4 * gq + 2] + 0.5f * pB0[4 * gq + 3]; bv[8 + gq]  = 0.5f * pB0[4 * gq + 3];
                    av[12 + gq] = pB1[4 * gq] + pB1[4 * gq + 1] + pB1[4 * gq + 2] + 0.5f * pB1[4 * gq + 3]; bv[12 + gq] = 0.5f * pB1[4 * gq + 3];
                }
                float* prow = part + ((size_t)hr * 64 + th * 32 + w.r32) * 33;
#pragma unroll
                for (int idx = 0; idx < 16; ++idx) {
                    const float bo = __shfl_xor(bv[idx], 32);
                    const float bprev = (idx > 0) ? __shfl_xor(bv[idx > 0 ? idx - 1 : 0], 32) : 0.f;
                    const float inc = w.hi ? bo : bprev;
                    prow[2 * idx + w.hi] = av[idx] + inc;
                }
            }
            if (type == 0) {
                bf16x8 pa0, pa1, pa2, pa3;
#pragma unroll
                for (int d = 0; d < 4; ++d) o[d] = f32x16{};
                pack_p(pA0, pA1, pa0, pa1, pa2, pa3); pv_tile<0>(o, w.vb0, pa0, pa1, pa2, pa3);
                pack_p(pB0, pB1, pa0, pa1, pa2, pa3); pv_tile<1>(o, w.vb0, pa0, pa1, pa2, pa3);
                if (w.hi == 0) wsf[w.r32] = 1.f;
                asm volatile("s_waitcnt lgkmcnt(0)" ::: "memory");
                store_o(w, o, wsf, ocmp + (size_t)tok0 * 1024 + h * HD);
            }
            __syncthreads();
#pragma unroll 1
            for (int ps2 = 0; ps2 < 4; ++ps2) {
                int ln = w.lane; asm volatile("" : "+v"(ln));
                const int j = ln & 31, hi2 = ln >> 5;
                const int tk = 8 * w.wid + 2 * ps2 + hi2, t = qb * 64 + tk, cur = qb;
                float imp = 0.f;
#pragma unroll
                for (int r = 0; r < 4; ++r) imp += part[((size_t)r * 64 + tk) * 33 + j];
                const bool ok = (64 * j <= t), forced = (j == 0) || (cur - j >= 0 && cur - j < 2);
                const float val = (ok && forced) ? 1.0e30f : (ok ? imp : -1.0e30f);
                vals[ln] = val;
                asm volatile("s_waitcnt lgkmcnt(0)" ::: "memory");
                int rank = 0;
#pragma unroll
                for (int jj = 0; jj < 32; ++jj) { const float o2 = vals[hi2 * 32 + jj]; rank += (o2 > val || (o2 == val && jj < j)) ? 1 : 0; }
                const unsigned long long bal = __ballot(rank < 16 && val >= 0.f);
                if (w.lane == 0) { selm[8 * w.wid + 2 * ps2] = (unsigned)bal; selm[8 * w.wid + 2 * ps2 + 1] = (unsigned)(bal >> 32); }
            }
            __syncthreads();
        }
#endif
#ifndef ATT_NO_SEL
        {
            WV_INIT();
            const unsigned sm = selm[th * 32 + w.r32];
            const int ntile = qb + 1, hsplit = (ntile + 1) >> 1;
            const int ja = (qb >= 16 && type == 1) ? hsplit : 0, jb = (qb >= 16 && type == 0) ? hsplit : ntile;
#pragma unroll
            for (int d0 = 0; d0 < 8; ++d0) qr[d0] = *(const bf16x8*)(qrp + qoff + d0 * 16);
#pragma unroll
            for (int d = 0; d < 4; ++d) o[d] = f32x16{};
            float m_reg = -1e30f, l_reg = 0.f;
            flash_pass<0>(w, kv + (size_t)2 * (4 * MB / 2) + kvoff, kv + (size_t)3 * (4 * MB / 2) + kvoff, ja, jb, qr, tpos, t0, sm, o, m_reg, l_reg);
            if (w.hi == 0) { wsf[w.r32] = l_reg > 0.f ? 1.f / l_reg : 0.f; float* mp = ml + (((size_t)type * NT + tok0 + w.r32) * NH + h) * 2; mp[0] = m_reg; mp[1] = l_reg; }
            asm volatile("s_waitcnt lgkmcnt(0)" ::: "memory");
            store_o(w, o, wsf, osel + (size_t)type * NT * 1024 + (size_t)tok0 * 1024 + h * HD);
        }
#endif
    }
}

struct CvtTile { const float* src; const float* ksc; bf16_t* dst0; int sld, ldd, mode; };
__device__ __forceinline__ CvtTile cvt_decode(const Frame& F, int t) {
    CvtTile c; c.ksc = nullptr; c.mode = 0;
    if (t < 4096) { const int e = t >> 7, mat = (t >> 6) & 1, kt = (t >> 1) & 31, nt = t & 1;
        c.src = (mat ? F.in[I_WUP] : F.in[I_WGATE]) + ((size_t)e * DM + kt * 64) * FF + nt * 256; c.sld = FF; c.ksc = F.in[I_LNMOE] + kt * 64;
        c.dst0 = (bf16_t*)(F.ws + WS_W1T) + ((size_t)e * 1024 + nt * 512 + mat * 128) * DM + kt * 64; c.ldd = DM; c.mode = 1; return c; }
    t -= 4096;
    if (t < 2048) { const int e = t >> 6, kt = (t >> 3) & 7, nt = t & 7;
        c.src = F.in[I_WDOWN] + ((size_t)e * FF + kt * 64) * DM + nt * 256; c.sld = DM;
        c.dst0 = (bf16_t*)(F.ws + WS_W2T) + ((size_t)e * 2048 + nt * 256) * FF + kt * 64; c.ldd = FF; return c; }
    t -= 2048;
    if (t < 256) { const int kt = t >> 3, nt = t & 7;
        c.src = F.in[I_WOUT] + (size_t)kt * 64 * DM + nt * 256; c.sld = DM; c.dst0 = (bf16_t*)(F.ws + WS_WOUTT) + (size_t)nt * 256 * DM + kt * 64; c.ldd = DM; return c; }
    t -= 256;
    if (t < 480) { const int kt = t / 15, nt = t % 15;
        c.src = F.in[I_WIN] + (size_t)kt * 64 * INW; c.sld = INW; c.ksc = F.in[I_LNMIX] + kt * 64;
        c.dst0 = (bf16_t*)(F.ws + WS_WINT) + (size_t)nt * 256 * DM + kt * 64; c.ldd = DM; c.mode = 2 + nt; return c; }
    t -= 480;
    { const int kv = t >> 6, kt = t & 63;
      c.src = (kv ? F.in[I_WV1] : F.in[I_WK1]) + (size_t)kt * 64 * 256; c.sld = 256; c.dst0 = (bf16_t*)(F.ws + WS_CMPW) + (size_t)kv * 256 * 4096 + kt * 64; c.ldd = 4096; return c; }
}
constexpr int N_CVT_TILES = 4096 + 2048 + 256 + 480 + 128;
__device__ __forceinline__ void cvt_load(const CvtTile& c, int nq, int kq, float4 (&v)[8]) {
    const float* p = c.src + 4 * nq; bool valid = true;
    if (c.mode >= 2) { const int n = (c.mode - 2) * 256 + 4 * nq; int sc = -1; if (n < 2560) sc = n; else if (n < 3584) sc = n + 24; else if (n < 3608) sc = n - 1024; valid = sc >= 0; p = c.src + (valid ? sc : 0); }
#pragma unroll
    for (int i = 0; i < 8; ++i) v[i] = valid ? *(const float4*)(p + (size_t)(kq * 8 + i) * c.sld) : make_float4(0.f, 0.f, 0.f, 0.f);
}

constexpr int CVT_RUN = 4;
__device__ __forceinline__ void cvt_stream(const Frame& F, int t_lo, int t_hi, unsigned* queue, int sfirst = -1, int sstride = 0) {
    if (sfirst < 0) { sfirst = F.bid; sstride = F.G; }
    float* T = F.lds;
    volatile int* nxtw = (volatile int*)(F.lds + 64 * 257);
    const int tid = F.tid, nq = tid & 63, kq = tid >> 6;
    int tA, tB; float4 vA[8], vB[8]; CvtTile cA, cB;
    if (queue) { __syncthreads(); if (tid == 0) { nxtw[0] = t_lo + CVT_RUN * (int)atomicAdd(queue, 1u); nxtw[1] = t_lo + CVT_RUN * (int)atomicAdd(queue, 1u); } __syncthreads(); tA = nxtw[0]; tB = nxtw[1]; }
    else { tA = t_lo + sfirst; tB = tA + sstride; }
    if (tA < t_hi) { cA = cvt_decode(F, tA); cvt_load(cA, nq, kq, vA); }
    if (tB < t_hi) { cB = cvt_decode(F, tB); cvt_load(cB, nq, kq, vB); }
#define CVT_STEP(tX, cX, vX, slot) do {                                                                                                     \
        const bool pop = queue && (((tX) - t_lo) % CVT_RUN == CVT_RUN - 1);                 \
        int tn_reg = 0;                                                                                                                      \
        if (pop && tid == 0) tn_reg = t_lo + CVT_RUN * (int)atomicAdd(queue, 1u);                                                            \
        __syncthreads();                                                                                                                     \
        _Pragma("unroll") for (int i = 0; i < 8; ++i) { const float s = cX.ksc ? cX.ksc[kq * 8 + i] : 1.f; float* tp = T + (kq * 8 + i) * 257 + 4 * nq; \
            tp[0] = vX[i].x * s; tp[1] = vX[i].y * s; tp[2] = vX[i].z * s; tp[3] = vX[i].w * s; }                                           \
        if (pop && tid == 0) nxtw[slot] = tn_reg;                                                                                            \
        __syncthreads();                                                                                                                     \
        const CvtTile cc = cX; const int tn = queue ? (pop ? nxtw[slot] : tX + 1) : tX + 2 * sstride;                                            \
        if (tn < t_hi) { cX = cvt_decode(F, tn); cvt_load(cX, nq, kq, vX); }                                                                 \
        _Pragma("unroll") for (int j = 0; j < 4; ++j) { const int id = tid + 512 * j, n = id >> 3, kc = id & 7; const float* tp = T + (kc * 8) * 257 + n; \
            pg8::u32x4 w; w.x = pg8::cvt_pk_bf16(tp[0], tp[257]); w.y = pg8::cvt_pk_bf16(tp[2 * 257], tp[3 * 257]); w.z = pg8::cvt_pk_bf16(tp[4 * 257], tp[5 * 257]); w.w = pg8::cvt_pk_bf16(tp[6 * 257], tp[7 * 257]); \
            const int rowi = (cc.mode == 1) ? ((n >> 7) * 256 + (n & 127)) : n;                                                              \
            *(pg8::u32x4*)(cc.dst0 + (size_t)rowi * cc.ldd + kc * 8) = w; }                                                                  \
        tX = tn; } while (0)
    while (tA < t_hi) {
        CVT_STEP(tA, cA, vA, 0);
        if (tB >= t_hi) { const int t2 = tA; tA = tB; tB = t2; const CvtTile c2 = cA; cA = cB; cB = c2;
#pragma unroll
            for (int i = 0; i < 8; ++i) { const float4 x = vA[i]; vA[i] = vB[i]; vB[i] = x; }
            continue; }
        CVT_STEP(tB, cB, vB, 1);
    }
    while (tB < t_hi) CVT_STEP(tB, cB, vB, 1);
#undef CVT_STEP
    __syncthreads();
}

__device__ __forceinline__ void p0_prologue(const Frame& F) {
    const float* x = F.in[I_X];
    bf16_t* xb = (bf16_t*)(F.ws + WS_XB); float* rstd1 = (float*)(F.ws + WS_RSTD1);
    const int gw = F.bid * NWAVES + F.wave, nw = F.G * NWAVES, lane = F.lane;
    for (int r = gw; r < NT; r += 2 * nw) {
        const int r2 = r + nw; const bool has2 = r2 < NT;
        float4 v[8], v2[8]; float ss = 0.f, ss2 = 0.f;
#pragma unroll
        for (int i = 0; i < 8; ++i) { v[i] = *(const float4*)(x + (size_t)r * DM + i * 256 + lane * 4); v2[i] = has2 ? *(const float4*)(x + (size_t)r2 * DM + i * 256 + lane * 4) : make_float4(0.f, 0.f, 0.f, 0.f); }
#pragma unroll
        for (int i = 0; i < 8; ++i) { ss += v[i].x * v[i].x + v[i].y * v[i].y + v[i].z * v[i].z + v[i].w * v[i].w; ss2 += v2[i].x * v2[i].x + v2[i].y * v2[i].y + v2[i].z * v2[i].z + v2[i].w * v2[i].w; }
        ss = wave_sum(ss); ss2 = wave_sum(ss2);
        if (lane == 0) { rstd1[r] = rsqrtf(ss * (1.f / DM) + EPS); if (has2) rstd1[r2] = rsqrtf(ss2 * (1.f / DM) + EPS); }
#pragma unroll
        for (int i = 0; i < 8; ++i) { uint2 w; w.x = pg8::cvt_pk_bf16(v[i].x, v[i].y); w.y = pg8::cvt_pk_bf16(v[i].z, v[i].w);
            *(uint2*)(xb + (size_t)r * DM + i * 256 + lane * 4) = w;
            if (has2) { uint2 w2; w2.x = pg8::cvt_pk_bf16(v2[i].x, v2[i].y); w2.y = pg8::cvt_pk_bf16(v2[i].z, v2[i].w); *(uint2*)(xb + (size_t)r2 * DM + i * 256 + lane * 4) = w2; } }
    }
    cvt_stream(F, 6400, N_CVT_TILES, nullptr);
    {
        const float* wp = F.in[I_WPOOL]; const float* ps = F.in[I_PSCALE]; const float* bp = F.in[I_BPOOL]; bf16_t* wpt = (bf16_t*)(F.ws + WS_POOLW); float* pb = (float*)(F.ws + WS_POOLB);
        for (int idx = F.bid * NTHREADS + F.tid; idx < 4 * 256 * 256; idx += F.G * NTHREADS) { const int k = idx & 255, n = (idx >> 8) & 255, g = idx >> 16;
            wpt[idx] = f2bf(wp[((size_t)g * 256 + k) * 256 + n] * ps[g * 256 + n]); }
        for (int idx = F.bid * NTHREADS + F.tid; idx < 1024; idx += F.G * NTHREADS) pb[idx] = bp[idx] * ps[idx];
    }
    { const float* lnm = F.in[I_LNMOE]; const float* wre = F.in[I_WRE]; const float* wrg = F.in[I_WRG]; float* WRP = (float*)(F.ws + WS_WRP);
      for (int idx = F.bid * NTHREADS + F.tid; idx < DM * 48; idx += F.G * NTHREADS) { const int k = idx / 48, c = idx - k * 48;
          WRP[idx] = c < 32 ? lnm[k] * wre[((size_t)(c >> 3) * DM + k) * 8 + (c & 7)] : (c < 36 ? lnm[k] * wrg[k * 4 + (c - 32)] : 0.f); } }
    {
        const float* lnm = F.in[I_LNMOE]; const float* wre = F.in[I_WRE]; const float* wrg = F.in[I_WRG]; float* WR = (float*)(F.ws + WS_WR); float* WG4 = (float*)(F.ws + WS_WG4);
        for (int idx = F.bid * NTHREADS + F.tid; idx < DM * 32; idx += F.G * NTHREADS) { const int k = idx >> 5, c = idx & 31; WR[idx] = lnm[k] * wre[((size_t)(c >> 3) * DM + k) * 8 + (c & 7)]; }
        for (int idx = F.bid * NTHREADS + F.tid; idx < DM * 4; idx += F.G * NTHREADS) WG4[idx] = lnm[idx >> 2] * wrg[idx];
    }
    {
        const int* pos = (const int*)F.in[I_POS]; float* rc = (float*)(F.ws + WS_ROPEC); float* rs = (float*)(F.ws + WS_ROPES);
        for (int idx = F.bid * NTHREADS + F.tid; idx < NB * SEQ * 16; idx += F.G * NTHREADS) {
            const int i = idx & 15, bs = idx >> 4;
            const float inv = exp2f(-(float)i * (1.f / 16.f) * 18.931568569324174f);
            const float ang = (float)pos[bs] * inv;
            rc[idx] = cosf(ang); rs[idx] = sinf(ang);
        }
    }
    for (int it = F.bid; it < 256; it += F.G) {
        const int kv = it >> 7, jb = (it >> 5) & 3, mc = it & 31;
        const float* pe = (kv ? F.in[I_PEV] : F.in[I_PEK]); const float* w1 = (kv ? F.in[I_WV1] : F.in[I_WK1]);
        const int mg = F.tid >> 6, j = jb * 64 + (F.tid & 63);
        float a = 0.f;
#pragma unroll
        for (int q = 0; q < 16; ++q) { const int m = mc * 128 + mg + 8 * q; a += pe[m] * w1[(size_t)m * 256 + j]; }
        __syncthreads();
        F.lds[F.tid] = a;
        __syncthreads();
        if (F.tid < 64) { float s = 0.f; for (int q = 0; q < 8; ++q) s += F.lds[q * 64 + F.tid]; ((float*)(F.ws + WS_BIAS1))[(mc * 2 + kv) * 256 + j] = s; }
        __syncthreads();
    }
}

struct EpiProj {
    static constexpr bool AFTER_DRAIN = false;
    const float* rstd1; const float* rc; const float* rs; bf16_t* qn; bf16_t* qr; bf16_t* kv; bf16_t* u; float* gates;
    __device__ __forceinline__ void operator()(const pg8::f32x4 (&acc)[2][2][4][2], const pg8::Unit& un, int wr, int wc, int fr, int fq) const {
        const int pn = un.pn;
#pragma unroll
        for (int ai = 0; ai < 2; ++ai)
#pragma unroll
            for (int m = 0; m < 4; ++m) {
                const int row = un.pm * 256 + ai * 128 + wr * 64 + m * 16 + fr; const float r1 = rstd1[row]; const int b = row >> 11, s = row & 2047;
                if (pn < 10) {
                    const bool ropeu = (pn < 4) || pn == 6 || pn == 8;
                    pg8::f32x4 c4 = {1.f, 1.f, 1.f, 1.f}, s4 = {0.f, 0.f, 0.f, 0.f};
                    if (ropeu && wc == 0) { c4 = *(const pg8::f32x4*)(rc + (size_t)row * 16 + 4 * fq); s4 = *(const pg8::f32x4*)(rs + (size_t)row * 16 + 4 * fq); }
#pragma unroll
                    for (int bj = 0; bj < 2; ++bj) {
                        const pg8::f32x4 v0 = acc[ai][bj][m][0] * r1, v1 = acc[ai][bj][m][1] * r1;
                        const int d0 = 32 * wc + 4 * fq;
                        pg8::f32x4 o0 = v0, o1 = v1;
                        if (ropeu && wc == 0) { o0 = v0 * c4 - v1 * s4; o1 = v1 * c4 + v0 * s4; }
                        uint2 w0, w1; w0.x = pg8::cvt_pk_bf16(o0[0], o0[1]); w0.y = pg8::cvt_pk_bf16(o0[2], o0[3]); w1.x = pg8::cvt_pk_bf16(o1[0], o1[1]); w1.y = pg8::cvt_pk_bf16(o1[2], o1[3]);
                        if (pn < 4) {
                            const size_t o = (((size_t)b * NH + 2 * pn + bj) * SEQ + s) * HD + d0;
                            uint2 n0, n1; n0.x = pg8::cvt_pk_bf16(v0[0], v0[1]); n0.y = pg8::cvt_pk_bf16(v0[2], v0[3]); n1.x = pg8::cvt_pk_bf16(v1[0], v1[1]); n1.y = pg8::cvt_pk_bf16(v1[2], v1[3]);
                            *(uint2*)(qn + o) = n0; *(uint2*)(qn + o + 16) = n1; *(uint2*)(qr + o) = w0; *(uint2*)(qr + o + 16) = w1;
                        } else {
                            const size_t o = (size_t)(pn - 4) * (4 * MB / 2) + (((size_t)b * NG + bj) * SEQ + s) * HD + d0;
                            *(uint2*)(kv + o) = w0; *(uint2*)(kv + o + 16) = w1;
                        }
                    }
                } else if (pn < 14) {
#pragma unroll
                    for (int bj = 0; bj < 2; ++bj)
#pragma unroll
                        for (int n = 0; n < 2; ++n) { const pg8::f32x4 v = acc[ai][bj][m][n] * r1; uint2 w_; w_.x = pg8::cvt_pk_bf16(v[0], v[1]); w_.y = pg8::cvt_pk_bf16(v[2], v[3]);
                            *(uint2*)(u + (size_t)row * 1024 + (pn - 10) * 256 + bj * 128 + wc * 32 + n * 16 + 4 * fq) = w_; }
                } else {
                    if (wc == 0) { *(pg8::f32x4*)(gates + (size_t)row * 24 + 4 * fq) = acc[ai][0][m][0] * r1; if (fq < 2) *(pg8::f32x4*)(gates + (size_t)row * 24 + 16 + 4 * fq) = acc[ai][0][m][1] * r1; }
                }
            }
    }
};

__device__ __forceinline__ void p1_proj(const Frame& F, LAS unsigned char* stage) {
    pg8::DenseOrder S; S.init(F.ws + WS_XB, F.ws + WS_WINT, DM, DM, NT, INWP, F.G, F.bid);
    EpiProj E{(const float*)(F.ws + WS_RSTD1), (const float*)(F.ws + WS_ROPEC), (const float*)(F.ws + WS_ROPES), (bf16_t*)(F.ws + WS_QN), (bf16_t*)(F.ws + WS_QR), (bf16_t*)(F.ws + WS_KV),
              (bf16_t*)(F.ws + WS_U), (float*)(F.ws + WS_GATES)};
    pg8::gemm_phase<EpiProj, pg8::DenseOrder, false>(stage, DM, DM, DM, S, E);
}

__device__ __forceinline__ void p4_cmp2(const Frame& F, int first, int stride, bool gated) {
    const float* part = (const float*)(F.ws + WS_CPART); const float* bias1p = (const float*)(F.ws + WS_BIAS1); bf16_t* ckv = (bf16_t*)(F.ws + WS_CMPKV);
    float* H = F.lds;
    float* W2 = F.lds + 8 * 260;
    unsigned* ctl = (unsigned*)(F.ws + WS_CTL);
    int w2_of = -1;
    for (int it = first; it < 256; it += stride) {
        const int kvi = it >> 7, r0 = (it & 127) * 8; const float* w2 = kvi ? F.in[I_WV2] : F.in[I_WK2];
        __syncthreads();
        if (gated && F.tid == 0) { unsigned* cw = ctl + CW_CMPR + 64 * (kvi * 4 + (r0 >> 8)); unsigned sp = 0;
            while (__hip_atomic_load(cw, __ATOMIC_RELAXED, __HIP_MEMORY_SCOPE_AGENT) < 8u) { __builtin_amdgcn_s_sleep(2);
                if ((++sp & 255u) == 0u) { if (xb_ld(&ctl[XB_TMO])) break; if (sp > XB_SPIN_CAP) { atomicAdd(&ctl[XB_TMO], 1u); break; } } }
            __builtin_amdgcn_fence(__ATOMIC_ACQUIRE, "agent"); asm volatile("s_waitcnt vmcnt(0)" ::: "memory"); }
        if (gated) __syncthreads();
        if (w2_of != kvi) {
#pragma unroll
            for (int j = 0; j < 16; ++j) { const int idx = F.tid + 512 * j; *(pg8::f32x4*)(W2 + idx * 4) = *(const pg8::f32x4*)(w2 + idx * 4); }
            w2_of = kvi;
        }
        { const int r = F.tid >> 6, c = (F.tid & 63) * 4;
            pg8::f32x4 s = {0.f, 0.f, 0.f, 0.f};
#pragma unroll
            for (int sp = 0; sp < 8; ++sp) s += *(const pg8::f32x4*)(part + (((size_t)sp * 2 + kvi) * 1024 + r0 + r) * 256 + c);
#pragma unroll
            for (int sp = 0; sp < 32; ++sp) s += *(const pg8::f32x4*)(bias1p + (sp * 2 + kvi) * 256 + c);
            H[r * 260 + c] = gelu_tanh(s[0]); H[r * 260 + c + 1] = gelu_tanh(s[1]); H[r * 260 + c + 2] = gelu_tanh(s[2]); H[r * 260 + c + 3] = gelu_tanh(s[3]); }
        __syncthreads();
        const int r = F.tid >> 6, c0 = (F.tid & 63) * 2;
        float a0 = 0.f, a1 = 0.f;
#pragma unroll 16
        for (int k = 0; k < 256; ++k) { const float hv = H[r * 260 + k]; const float2 wv = *(const float2*)(W2 + k * 128 + c0); a0 += hv * wv.x; a1 += hv * wv.y; }
        const int R = r0 + r; const bool pad = (R & 127) == 127;
        *(unsigned*)(ckv + ((size_t)kvi * 1024 + R) * 128 + c0) = pad ? 0u : pg8::cvt_pk_bf16(a0, a1);
    }
}

struct CmpOrder {
    const char* kc; const char* w1t; int c;
    __device__ __forceinline__ bool next(int i, pg8::Unit& u) const { if (i > 0) return false; u.e = c >> 5; u.pm = (c >> 3) & 3; u.pn = c & 7; u.li = 0; return true; }
    __device__ __forceinline__ const char* a_base(const pg8::Unit& u) const { return kc + (size_t)u.e * 4 * MB + ((size_t)u.pm * 256 * 2048 + u.pn * 512) * 2; }
    __device__ __forceinline__ const char* b_base(const pg8::Unit& u) const { return w1t + ((size_t)u.e * 256 * 4096 + u.pn * 512) * 2; }
    __device__ __forceinline__ unsigned a_row_off(const pg8::Unit&, int r) const { return (unsigned)r * 4096u; }
};
struct EpiCmp {
    static constexpr bool AFTER_DRAIN = false;
    float* part;
    __device__ __forceinline__ void operator()(const pg8::f32x4 (&acc)[2][2][4][2], const pg8::Unit& un, int wr, int wc, int fr, int fq) const {
        float* base = part + (((size_t)un.pn * 2 + un.e) * 1024 + un.pm * 256) * 256;
#pragma unroll
        for (int ai = 0; ai < 2; ++ai)
#pragma unroll
            for (int m = 0; m < 4; ++m) { float* rowp = base + (size_t)(ai * 128 + wr * 64 + m * 16 + fr) * 256 + wc * 32 + 4 * fq;
#pragma unroll
                for (int bj = 0; bj < 2; ++bj)
#pragma unroll
                    for (int n = 0; n < 2; ++n) *(pg8::f32x4*)(rowp + bj * 128 + n * 16) = acc[ai][bj][m][n]; }
    }
};
struct PoolOrder {
    const char* d; const char* wpt; int c;
    __device__ __forceinline__ bool next(int i, pg8::Unit& u) const { if (i > 0) return false; u.pm = c >> 2; u.pn = 0; u.e = c & 3; u.li = 0; return true; }
    __device__ __forceinline__ const char* a_base(const pg8::Unit& u) const { return d + ((size_t)u.pm * 256 * 1024 + u.e * 256) * 2; }
    __device__ __forceinline__ const char* b_base(const pg8::Unit& u) const { return wpt + (size_t)u.e * 256 * 256 * 2; }
    __device__ __forceinline__ unsigned a_row_off(const pg8::Unit&, int r) const { return (unsigned)r * 2048u; }
};
struct EpiPool {
    static constexpr bool AFTER_DRAIN = false;
    const float* pb; bf16_t* opool;
    __device__ __forceinline__ void operator()(const pg8::f32x4 (&acc)[2][2][4][2], const pg8::Unit& un, int wr, int wc, int fr, int fq) const {
#pragma unroll
        for (int ai = 0; ai < 2; ++ai)
#pragma unroll
            for (int m = 0; m < 4; ++m) { const int row = un.pm * 256 + ai * 128 + wr * 64 + m * 16 + fr;
#pragma unroll
                for (int bj = 0; bj < 2; ++bj)
#pragma unroll
                    for (int n = 0; n < 2; ++n) { const int c = un.e * 256 + bj * 128 + wc * 32 + n * 16 + 4 * fq;
                        const pg8::f32x4 v = acc[ai][bj][m][n] + *(const pg8::f32x4*)(pb + c); uint2 w_; w_.x = pg8::cvt_pk_bf16(v[0], v[1]); w_.y = pg8::cvt_pk_bf16(v[2], v[3]);
                        *(uint2*)(opool + (size_t)row * 1024 + c) = w_; } }
    }
};
__device__ __forceinline__ void p2a_mid(const Frame& F, LAS unsigned char* stage) {
    if (F.bid < 64) {
        CmpOrder S{(const char*)(F.ws + WS_KV), (const char*)(F.ws + WS_CMPW), F.bid};
        EpiCmp E{(float*)(F.ws + WS_CPART)};
        pg8::gemm_phase<EpiCmp, CmpOrder, false>(stage, 512, 2048, 4096, S, E);
    } else {
        const bf16_t* u = (const bf16_t*)(F.ws + WS_U); bf16_t* d = (bf16_t*)(F.ws + WS_DBUF);
        for (int ch = F.bid - 64; ch < NT / 16; ch += F.G - 64) {
            const int r0 = ch * 16, s0 = r0 & 2047, col = 2 * F.tid, w = 2 << (col >> 8);
            float u0[31], u1[31];
#pragma unroll
            for (int q = 0; q < 31; ++q) { const int s = s0 - 15 + q; const unsigned pr = (s >= 0) ? *(const unsigned*)(u + (size_t)(r0 - 15 + q) * 1024 + col) : 0u;
                u0[q] = __uint_as_float(pr << 16); u1[q] = __uint_as_float(pr & 0xFFFF0000u); }
#pragma unroll
            for (int i = 0; i < 16; ++i) { float sa = 0.f, sb = 0.f;
#pragma unroll
                for (int q = 0; q < 16; ++q) if (q < w) { sa += u0[15 + i - q]; sb += u1[15 + i - q]; }
                const int s = s0 + i, cnt = (s + 1 < w) ? s + 1 : w; const float ic = 1.f / (float)cnt;
                *(unsigned*)(d + (size_t)(r0 + i) * 1024 + col) = pg8::cvt_pk_bf16(sa * ic - u0[15 + i], sb * ic - u1[15 + i]); }
        }
    }
}
__device__ __forceinline__ void p2b_mid(const Frame& F, LAS unsigned char* stage) {
    if (F.bid < 128) {
        PoolOrder S{(const char*)(F.ws + WS_DBUF), (const char*)(F.ws + WS_POOLW), F.bid};
        EpiPool E{(const float*)(F.ws + WS_POOLB), (bf16_t*)(F.ws + WS_OPOOL)};
        pg8::gemm_phase<EpiPool, PoolOrder, false>(stage, 256, 1024, 256, S, E);
    } else {
        p4_cmp2(F, F.bid - 128, F.G - 128, false);
        cvt_stream(F, 6144, 6400, nullptr, F.bid - 128, F.G - 128);
    }
}

__device__ __forceinline__ void unpack8(const pg8::u32x4 w, float (&f)[8]) {
    f[0] = __uint_as_float(w.x << 16); f[1] = __uint_as_float(w.x & 0xFFFF0000u); f[2] = __uint_as_float(w.y << 16); f[3] = __uint_as_float(w.y & 0xFFFF0000u);
    f[4] = __uint_as_float(w.z << 16); f[5] = __uint_as_float(w.z & 0xFFFF0000u); f[6] = __uint_as_float(w.w << 16); f[7] = __uint_as_float(w.w & 0xFFFF0000u);
}
__device__ __forceinline__ void p6_mix(const Frame& F) {
    const bf16_t* ocmp = (const bf16_t*)(F.ws + WS_OCMP); const bf16_t* owin = (const bf16_t*)(F.ws + WS_OWIN); const bf16_t* osel = (const bf16_t*)(F.ws + WS_OSEL);
    const float* ml = (const float*)(F.ws + WS_ML); const float* gates = (const float*)(F.ws + WS_GATES);
    const bf16_t* opool = (const bf16_t*)(F.ws + WS_OPOOL); bf16_t* mix = (bf16_t*)(F.ws + WS_MIX);
    const float* gn = F.in[I_GNNSA]; const float* gp = F.in[I_GNPOOL];
    const int gw = F.bid * NWAVES + F.wave, nw = F.G * NWAVES, lane = F.lane, h = lane >> 3;
    for (int r = gw; r < NT; r += nw) {
        const bool split = ((r & 2047) >> 6) >= 16;
        const size_t o = (size_t)r * 1024 + lane * 16;
        const float* gq = gates + (size_t)r * 24 + h * 3;
        const float g0 = 1.f / (1.f + __expf(-gq[0])), g1 = 1.f / (1.f + __expf(-gq[1])), g2 = 1.f / (1.f + __expf(-gq[2]));
        float w0 = 1.f, w1 = 0.f;
        if (split) { const float* m0p = ml + ((size_t)r * NH + h) * 2; const float* m1p = ml + (((size_t)NT + r) * NH + h) * 2;
            const float m0 = m0p[0], l0 = m0p[1], m1 = m1p[0], l1 = m1p[1], M = fmaxf(m0, m1);
            const float a0 = l0 * exp2f((m0 - M) * att::C2), a1 = l1 * exp2f((m1 - M) * att::C2), inv = 1.f / (a0 + a1); w0 = a0 * inv; w1 = a1 * inv; }
        float a[16], p[16]; float sa = 0.f, sp = 0.f;
#pragma unroll
        for (int hf = 0; hf < 2; ++hf) {
            float c8[8], w8[8], s8[8], t8[8];
            unpack8(*(const pg8::u32x4*)(ocmp + o + hf * 8), c8); unpack8(*(const pg8::u32x4*)(owin + o + hf * 8), w8); unpack8(*(const pg8::u32x4*)(osel + o + hf * 8), s8);
            if (split) unpack8(*(const pg8::u32x4*)(osel + (size_t)NT * 1024 + o + hf * 8), t8);
#pragma unroll
            for (int j = 0; j < 8; ++j) { const float os = split ? (w0 * s8[j] + w1 * t8[j]) : s8[j]; a[hf * 8 + j] = g0 * c8[j] + g1 * os + g2 * w8[j]; sa += a[hf * 8 + j] * a[hf * 8 + j]; }
        }
#pragma unroll
        for (int q = 0; q < 2; ++q) { float p8[8]; unpack8(*(const pg8::u32x4*)(opool + o + q * 8), p8);
#pragma unroll
            for (int j = 0; j < 8; ++j) { p[q * 8 + j] = p8[j]; sp += p8[j] * p8[j]; } }
        sa = wave_sum(sa); sp = wave_sum(sp);
        const float ra = rsqrtf(sa * (1.f / 1024.f) + EPS), rp = rsqrtf(sp * (1.f / 1024.f) + EPS);
        float ga[16], gb[16];
#pragma unroll
        for (int q = 0; q < 4; ++q) { const pg8::f32x4 v = *(const pg8::f32x4*)(gn + lane * 16 + q * 4), u = *(const pg8::f32x4*)(gp + lane * 16 + q * 4);
            ga[q * 4] = v[0]; ga[q * 4 + 1] = v[1]; ga[q * 4 + 2] = v[2]; ga[q * 4 + 3] = v[3]; gb[q * 4] = u[0]; gb[q * 4 + 1] = u[1]; gb[q * 4 + 2] = u[2]; gb[q * 4 + 3] = u[3]; }
#pragma unroll
        for (int hf = 0; hf < 2; ++hf) { pg8::u32x4 wa, wb;
            wa.x = pg8::cvt_pk_bf16(a[hf * 8] * ra * ga[hf * 8], a[hf * 8 + 1] * ra * ga[hf * 8 + 1]); wa.y = pg8::cvt_pk_bf16(a[hf * 8 + 2] * ra * ga[hf * 8 + 2], a[hf * 8 + 3] * ra * ga[hf * 8 + 3]);
            wa.z = pg8::cvt_pk_bf16(a[hf * 8 + 4] * ra * ga[hf * 8 + 4], a[hf * 8 + 5] * ra * ga[hf * 8 + 5]); wa.w = pg8::cvt_pk_bf16(a[hf * 8 + 6] * ra * ga[hf * 8 + 6], a[hf * 8 + 7] * ra * ga[hf * 8 + 7]);
            wb.x = pg8::cvt_pk_bf16(p[hf * 8] * rp * gb[hf * 8], p[hf * 8 + 1] * rp * gb[hf * 8 + 1]); wb.y = pg8::cvt_pk_bf16(p[hf * 8 + 2] * rp * gb[hf * 8 + 2], p[hf * 8 + 3] * rp * gb[hf * 8 + 3]);
            wb.z = pg8::cvt_pk_bf16(p[hf * 8 + 4] * rp * gb[hf * 8 + 4], p[hf * 8 + 5] * rp * gb[hf * 8 + 5]); wb.w = pg8::cvt_pk_bf16(p[hf * 8 + 6] * rp * gb[hf * 8 + 6], p[hf * 8 + 7] * rp * gb[hf * 8 + 7]);
            *(pg8::u32x4*)(mix + (size_t)r * DM + lane * 16 + hf * 8) = wa; *(pg8::u32x4*)(mix + (size_t)r * DM + 1024 + lane * 16 + hf * 8) = wb; }
    }
}

struct EpiOut {
    static constexpr bool AFTER_DRAIN = true;
    const float* x; float* out; bf16_t* x1b; const float* lnm; const float* wrp; float* pl;
    __device__ __forceinline__ void fused(pg8::f32x4 (&acc)[2][2][4][2], const pg8::Unit& un, int wr, int wc, int fr, int fq, LAS unsigned char* lds) const {
#pragma unroll
        for (int ai = 0; ai < 2; ++ai)
#pragma unroll
            for (int m = 0; m < 4; ++m) {
                const int row = un.pm * 256 + ai * 128 + wr * 64 + m * 16 + fr;
#pragma unroll
                for (int bj = 0; bj < 2; ++bj)
#pragma unroll
                    for (int n = 0; n < 2; ++n) {
                        const size_t o = (size_t)row * DM + un.pn * 256 + bj * 128 + wc * 32 + n * 16 + 4 * fq;
                        const pg8::f32x4 v = acc[ai][bj][m][n] + *(const pg8::f32x4*)(x + o);
                        acc[ai][bj][m][n] = v;
                        *(pg8::f32x4*)(out + o) = v;
                        const pg8::f32x4 g = *(const pg8::f32x4*)(lnm + un.pn * 256 + bj * 128 + wc * 32 + n * 16 + 4 * fq);
                        uint2 w; w.x = pg8::cvt_pk_bf16(v[0] * g[0], v[1] * g[1]); w.y = pg8::cvt_pk_bf16(v[2] * g[2], v[3] * g[3]); *(uint2*)(x1b + o) = w;
                    }
            }
        float* red = (float*)((unsigned char*)lds);
        const int tid = threadIdx.x;
#pragma unroll 1
        for (int ai = 0; ai < 2; ++ai) {
#pragma unroll
            for (int m = 0; m < 4; ++m) {
                pg8::f32x4 D0 = {0.f, 0.f, 0.f, 0.f}, D1 = D0, D2 = D0; float s2 = 0.f;
#pragma unroll
                for (int bj = 0; bj < 2; ++bj)
#pragma unroll
                    for (int n = 0; n < 2; ++n) {
                        const pg8::f32x4 v = (ai == 0) ? acc[0][bj][m][n] : acc[1][bj][m][n];
                        s2 += v[0] * v[0] + v[1] * v[1] + v[2] * v[2] + v[3] * v[3];
                        const float* wb = wrp + (size_t)(un.pn * 256 + bj * 128 + wc * 32 + n * 16 + 4 * fq) * 48 + fr;
#pragma unroll
                        for (int j = 0; j < 4; ++j) {
                            D0 = __builtin_amdgcn_mfma_f32_16x16x4f32(v[j], wb[j * 48], D0, 0, 0, 0);
                            D1 = __builtin_amdgcn_mfma_f32_16x16x4f32(v[j], wb[j * 48 + 16], D1, 0, 0, 0);
                            D2 = __builtin_amdgcn_mfma_f32_16x16x4f32(v[j], wb[j * 48 + 32], D2, 0, 0, 0);
                        }
                    }
                s2 += __shfl_xor(s2, 16); s2 += __shfl_xor(s2, 32);
                float* rr = red + ((size_t)wc * 128 + wr * 64 + m * 16) * 40;
#pragma unroll
                for (int r = 0; r < 4; ++r) { float* q = rr + (4 * fq + r) * 40; q[fr] = D0[r]; q[16 + fr] = D1[r]; if (fr < 8) q[32 + fr] = D2[r]; }
                if (fq == 0) rr[fr * 40 + 36] = s2;
            }
            __syncthreads();
            for (int idx = tid; idx < 128 * 40; idx += 512) { const int r = idx / 40, c = idx - r * 40;
                const float s = (red[idx] + red[128 * 40 + idx]) + (red[2 * 128 * 40 + idx] + red[3 * 128 * 40 + idx]);
                if (c < 37) pl[((size_t)un.pn * NT + un.pm * 256 + ai * 128 + r) * 40 + c] = s; }
            __syncthreads();
        }
    }
};
__device__ __forceinline__ void p7_out(const Frame& F, LAS unsigned char* stage) {
    pg8::DenseOrder S; S.init(F.ws + WS_MIX, F.ws + WS_WOUTT, DM, DM, NT, DM, F.G, F.bid);
    EpiOut E{F.in[I_X], F.out, (bf16_t*)(F.ws + WS_X1B), F.in[I_LNMOE], (const float*)(F.ws + WS_WRP), (float*)(F.ws + WS_PL)};
    pg8::gemm_phase<EpiOut, pg8::DenseOrder, false>(stage, DM, DM, DM, S, E);
}

__device__ __forceinline__ void p8_router(const Frame& F, int dummy) {
    const float* pl = (const float*)(F.ws + WS_PL); const float* brg = F.in[I_BRG]; const float* bre = F.in[I_BRE];
    float* rstd2 = (float*)(F.ws + WS_RSTD2); int* arow = (int*)(F.ws + WS_AROW); int* tokl = (int*)(F.ws + WS_TOKL); float* gatel = (float*)(F.ws + WS_GATEL);
    unsigned* cnt = (unsigned*)(F.ws + WS_CTL) + CW_CNT; (void)dummy;
    const int gw = F.bid * NWAVES + F.wave, nw = F.G * NWAVES, lane = F.lane, tl = lane >> 3, pn = lane & 7;
    for (int wv = gw; wv < NT / 8; wv += nw) {
        const int r = wv * 8 + tl;
        const float* p = pl + ((size_t)pn * NT + r) * 40;
        float v[37];
#pragma unroll
        for (int q = 0; q < 9; ++q) { const pg8::f32x4 t = *(const pg8::f32x4*)(p + 4 * q); v[4 * q] = t[0]; v[4 * q + 1] = t[1]; v[4 * q + 2] = t[2]; v[4 * q + 3] = t[3]; }
        v[36] = p[36];
#pragma unroll
        for (int c = 0; c < 37; ++c) { v[c] += __shfl_xor(v[c], 1); v[c] += __shfl_xor(v[c], 2); v[c] += __shfl_xor(v[c], 4); }
        if (pn == 0) {
            const float rs = rsqrtf(v[36] * (1.f / DM) + EPS);
            float lg[4];
#pragma unroll
            for (int j = 0; j < 4; ++j) lg[j] = v[32 + j] * rs + brg[j];
            int gs = 0; float gm = lg[0];
#pragma unroll
            for (int j = 1; j < 4; ++j) if (lg[j] > gm) { gm = lg[j]; gs = j; }
            float den = 0.f;
#pragma unroll
            for (int j = 0; j < 4; ++j) den += __expf(lg[j] - gm);
            const float pg = 1.f / den;
            float le[8];
#pragma unroll
            for (int j = 0; j < 8; ++j) { const float s = (gs == 0) ? v[j] : (gs == 1) ? v[8 + j] : (gs == 2) ? v[16 + j] : v[24 + j]; le[j] = s * rs + bre[gs * 8 + j]; }
            int e0 = 0; float m0 = le[0];
#pragma unroll
            for (int j = 1; j < 8; ++j) if (le[j] > m0) { m0 = le[j]; e0 = j; }
            int e1 = -1; float m1 = -3.0e38f;
#pragma unroll
            for (int j = 0; j < 8; ++j) if (j != e0 && le[j] > m1) { m1 = le[j]; e1 = j; }
            const float p1 = __expf(m1 - m0);
            const float gate0 = pg / (1.f + p1), gate1 = pg * p1 / (1.f + p1);
            rstd2[r] = rs;
            const int ea = gs * 8 + e0, eb = gs * 8 + e1;
            const unsigned sa = atomicAdd(&cnt[64 * ea], 1u), sb = atomicAdd(&cnt[64 * eb], 1u);
            tokl[ea * 8192 + sa] = r; gatel[ea * 8192 + sa] = gate0; tokl[eb * 8192 + sb] = r; gatel[eb * 8192 + sb] = gate1;
            arow[2 * r] = ea * 8192 + (int)sa; arow[2 * r + 1] = eb * 8192 + (int)sb;
        }
    }
}

__device__ __forceinline__ void moe_counts(const Frame& F, int* cnts  , int* pst  ) {
    const unsigned* cnt = (const unsigned*)(F.ws + WS_CTL) + CW_CNT;
    __syncthreads();
    if (F.tid < 32) cnts[F.tid] = (int)__hip_atomic_load(&cnt[64 * F.tid], __ATOMIC_RELAXED, __HIP_MEMORY_SCOPE_AGENT);
    __syncthreads();
    if (F.tid == 0) { int a = 0; for (int e = 0; e < 32; ++e) { pst[e] = a; a += (cnts[e] + 255) & ~255; } pst[32] = a; }
    __syncthreads();
}

constexpr int MOE_TAB_OFF = 1024 + 131072;
struct MoeTabs { int* cnts; int* pst; int* ust; int* usth; int* rowtok; };
__device__ __forceinline__ MoeTabs moe_tabs(unsigned char* lds_raw) { MoeTabs T; T.cnts = (int*)(lds_raw + MOE_TAB_OFF); T.pst = T.cnts + 32; T.ust = T.pst + 40; T.usth = T.ust + 40; T.rowtok = T.usth + 40; return T; }
template <int NTN> __device__ __forceinline__ void moe_units(const Frame& F, const MoeTabs& T) {
    moe_counts(F, T.cnts, T.pst);
    if (F.tid == 0) { int a = 0, h = 0; for (int e = 0; e < 32; ++e) { const int c = T.cnts[e], nmt = (c + 255) >> 8, hl = (nmt > 0 && c - 256 * (nmt - 1) <= 128) ? 1 : 0;
            T.ust[e] = a; T.usth[e] = h; a += (nmt - hl) * NTN; h += hl * NTN; } T.ust[32] = a; T.usth[32] = h; }
    __syncthreads();
}
template <int NTN> struct MoeOrder2 {
    const int* cnts; const int* pst; const int* ust; const int* usth; const int* rowtok; const bf16_t* A; const float* W0; const float* W1; int G, c, lda, ldb, gather;
    __device__ __forceinline__ bool next(int i, g2::Unit& u) const {
        int L = i * G + c; u.li = i;
        if (L < ust[32]) {
            int e = 0; while (ust[e + 1] <= L) ++e;
            const int w = L - ust[e], c_ = cnts[e], nmt = (c_ + 255) >> 8, nf = nmt - ((c_ - 256 * (nmt - 1) <= 128) ? 1 : 0);
            u.e = e; u.pn = w / nf; u.pm = w - u.pn * nf; u.half = 0; return true; }
        L -= ust[32]; if (L >= usth[32]) return false;
        int e = 0; while (usth[e + 1] <= L) ++e;
        u.e = e; u.pn = L - usth[e]; u.pm = ((cnts[e] + 255) >> 8) - 1; u.half = 1; return true;
    }
    __device__ __forceinline__ int nvalid(const g2::Unit& u) const { const int v = cnts[u.e] - u.pm * 256; return v < 256 ? v : 256; }
    __device__ __forceinline__ unsigned a_off(const g2::Unit& u, int r) const {
        if (gather) { const int tk = rowtok[u.li * 256 + r]; return (unsigned)(tk < 0 ? 0 : tk) * (unsigned)lda * 2u; }
        return (unsigned)(pst[u.e] + u.pm * 256 + r) * (unsigned)lda * 2u;
    }
    __device__ __forceinline__ const float* b_col(const g2::Unit& u, int col) const {
        if (gather) { const int wcp = col >> 5, n = (col >> 4) & 1, i = col & 15; return (n ? W1 : W0) + (size_t)u.e * DM * FF + u.pn * 64 + 16 * wcp + i; }
        return W0 + (size_t)u.e * FF * DM + u.pn * 128 + col;
    }
};
struct EpiMoe1 {
    const int* pst; const int* rowtok; const float* rstd2; bf16_t* act;
    __device__ __forceinline__ void operator()(const pg8::f32x4 (&acc)[2][4][2], const g2::Unit& un, int wr, int wc, int fr, int fq) const {
#pragma unroll
        for (int ai = 0; ai < 2; ++ai)
#pragma unroll
            for (int m = 0; m < 4; ++m) {
                const int r = ai * 128 + wr * 64 + m * 16 + fr; const int tk = rowtok[un.li * 256 + r];
                if (tk >= 0) {
                    const float rs = rstd2[tk];
                    const pg8::f32x4 vg = acc[ai][m][0] * rs, vu = acc[ai][m][1] * rs; float o[4];
#pragma unroll
                    for (int j = 0; j < 4; ++j) o[j] = vg[j] / (1.f + __expf(-vg[j])) * vu[j];
                    uint2 w; w.x = pg8::cvt_pk_bf16(o[0], o[1]); w.y = pg8::cvt_pk_bf16(o[2], o[3]);
                    *(uint2*)(act + (size_t)(pst[un.e] + un.pm * 256 + r) * FF + un.pn * 64 + wc * 16 + 4 * fq) = w;
                }
            }
    }
};
struct EpiMoe2 {
    const int* cnts; const int* pst; const float* gatel; bf16_t* y;
    __device__ __forceinline__ void operator()(const pg8::f32x4 (&acc)[2][4][2], const g2::Unit& un, int wr, int wc, int fr, int fq) const {
#pragma unroll
        for (int ai = 0; ai < 2; ++ai)
#pragma unroll
            for (int m = 0; m < 4; ++m) {
                const int slot = un.pm * 256 + ai * 128 + wr * 64 + m * 16 + fr;
                if (slot < cnts[un.e]) {
                    const float gt = gatel[un.e * 8192 + slot];
                    bf16_t* dst = y + (size_t)(pst[un.e] + slot) * DM + un.pn * 128 + wc * 32 + 4 * fq;
#pragma unroll
                    for (int n = 0; n < 2; ++n) { const pg8::f32x4 v = acc[ai][m][n] * gt; uint2 w; w.x = pg8::cvt_pk_bf16(v[0], v[1]); w.y = pg8::cvt_pk_bf16(v[2], v[3]); *(uint2*)(dst + n * 16) = w; }
                }
            }
    }
};

__device__ __forceinline__ void p9_moe1(const Frame& F, unsigned char* lds_raw, LAS unsigned char* stage) {
    const MoeTabs T = moe_tabs(lds_raw);
    moe_units<8>(F, T);
    const int vc = (F.G % 8 == 0) ? (F.bid % 8) * (F.G / 8) + F.bid / 8 : F.bid;
    MoeOrder2<8> S{T.cnts, T.pst, T.ust, T.usth, T.rowtok, (const bf16_t*)(F.ws + WS_X1B), F.in[I_WGATE], F.in[I_WUP], F.G, vc, DM, FF, 1};
    { const int* tokl = (const int*)(F.ws + WS_TOKL); g2::Unit u;
      for (int i = 0; i < 4 && S.next(i, u); ++i) { if (F.tid < 256) { const int slot = u.pm * 256 + F.tid; T.rowtok[i * 256 + F.tid] = slot < T.cnts[u.e] ? tokl[u.e * 8192 + slot] : -1; } } }
    asm volatile("s_waitcnt vmcnt(0) lgkmcnt(0)" ::: "memory");
    __syncthreads();
    EpiMoe1 E{T.pst, T.rowtok, (const float*)(F.ws + WS_RSTD2), (bf16_t*)(F.ws + WS_ACT)};
    g2::gemm<DM / 64, EpiMoe1, MoeOrder2<8>>(stage, S, E, F.wave, (PROBE_REPEAT >= 30 && PROBE_REPEAT <= 33) ? (unsigned long long*)(lds_raw + 512) : nullptr);
}

__device__ __forceinline__ void p10_moe2(const Frame& F, unsigned char* lds_raw, LAS unsigned char* stage) {
    const MoeTabs T = moe_tabs(lds_raw);
    moe_units<16>(F, T);
    const int vc = (F.G % 8 == 0) ? (F.bid % 8) * (F.G / 8) + F.bid / 8 : F.bid;
    MoeOrder2<16> S{T.cnts, T.pst, T.ust, T.usth, nullptr, (const bf16_t*)(F.ws + WS_ACT), F.in[I_WDOWN], nullptr, F.G, vc, FF, DM, 0};
    EpiMoe2 E{T.cnts, T.pst, (const float*)(F.ws + WS_GATEL), (bf16_t*)(F.ws + WS_Y)};
    g2::gemm<FF / 64, EpiMoe2, MoeOrder2<16>>(stage, S, E, F.wave);
}

__device__ __forceinline__ void p11_final(const Frame& F, int dummy) {
    int* cnts = (int*)(F.lds + 3072); int* pst = cnts + 32;
    moe_counts(F, cnts, pst);
    const bf16_t* y = (const bf16_t*)(F.ws + WS_Y); const int* arow = (const int*)(F.ws + WS_AROW); const float* lnf = F.in[I_LNFINAL];
    const int gw = F.bid * NWAVES + F.wave, nw = F.G * NWAVES, lane = fresh_lane();
    for (int r = gw; r < NT; r += nw) {
        const int a0 = arow[2 * r], a1 = arow[2 * r + 1];
        const size_t r0 = (size_t)(pst[a0 >> 13] + (a0 & 8191)), r1 = (size_t)(pst[a1 >> 13] + (a1 & 8191));
        float v[32]; float ss = 0.f;
#pragma unroll
        for (int i = 0; i < 8; ++i) { const int c = i * 256 + lane * 4; const float4 xv = *(const float4*)(F.out + (size_t)r * DM + c);
            const uint2 ya = *(const uint2*)(y + r0 * DM + c), yb = *(const uint2*)(y + r1 * DM + c);
            v[4 * i]     = xv.x + __uint_as_float(ya.x << 16) + __uint_as_float(yb.x << 16);
            v[4 * i + 1] = xv.y + __uint_as_float(ya.x & 0xFFFF0000u) + __uint_as_float(yb.x & 0xFFFF0000u);
            v[4 * i + 2] = xv.z + __uint_as_float(ya.y << 16) + __uint_as_float(yb.y << 16);
            v[4 * i + 3] = xv.w + __uint_as_float(ya.y & 0xFFFF0000u) + __uint_as_float(yb.y & 0xFFFF0000u);
            ss += v[4 * i] * v[4 * i] + v[4 * i + 1] * v[4 * i + 1] + v[4 * i + 2] * v[4 * i + 2] + v[4 * i + 3] * v[4 * i + 3]; }
        ss = wave_sum(ss);
        const float rs = rsqrtf(ss * (1.f / DM) + EPS);
#pragma unroll
        for (int i = 0; i < 8; ++i) { const int c = i * 256 + lane * 4; const float4 g = *(const float4*)(lnf + c);
            float4 o; o.x = v[4 * i] * rs * g.x; o.y = v[4 * i + 1] * rs * g.y; o.z = v[4 * i + 2] * rs * g.z; o.w = v[4 * i + 3] * rs * g.w;
            *(float4*)((dummy ? (float*)(F.ws + WS_W1T) : F.out) + (size_t)r * DM + c) = o; }
    }
}

constexpr int NPHASE = 11;
__global__ void __launch_bounds__(NTHREADS, 2) fwd(Args args) {
    extern __shared__ __attribute__((aligned(16))) unsigned char lds_raw[];
    Frame F;
#pragma unroll
    for (int i = 0; i < N_IN; ++i) F.in[i] = args.in[i];
    F.out = args.out; F.ws = args.ws;
    F.lds = (float*)(lds_raw + 16);
    F.tid = threadIdx.x; F.lane = F.tid & 63; F.wave = __builtin_amdgcn_readfirstlane(F.tid >> 6); F.G = gridDim.x; F.bid = blockIdx.x;
    if (F.tid < 4) ((LAS unsigned*)lds_raw)[F.tid] = 0u;
    __syncthreads();
    XcdBarrier bar; bar.bar = (unsigned*)(F.ws + WS_CTL); bar.x = 0; bar.st = nullptr;
    if (N_LAUNCHES == 1) bar = xcd_barrier_post((unsigned*)(F.ws + WS_CTL), (volatile LAS unsigned*)lds_raw);
    bar.wave = F.wave;
    const int lo = args.ph_lo, hi = args.ph_hi;
#ifndef ONLY_PHASE
#define ONLY_PHASE -1
#endif
#define IN(k) (lo <= (k) && (k) < hi && (ONLY_PHASE < 0 || ONLY_PHASE == (k)))
#define SEAM(k) do { if (IN(k) && IN((k) + 1)) { const unsigned long long tb_ = (PROBE_REPEAT >= 40) ? (unsigned long long)__builtin_readcyclecounter() : 0ull; xcd_barrier(bar); if (PROBE_REPEAT == 12) xcd_barrier(bar); \
        if (PROBE_REPEAT == 40 || PROBE_REPEAT == 41 + (k)) tbar += (unsigned long long)__builtin_readcyclecounter() - tb_; if (PROBE_REPEAT == 60 + (k)) tbar = (unsigned long long)__builtin_readcyclecounter() - t_k0; } } while (0)
    unsigned long long tbar = 0ull; const unsigned long long t_k0 = (PROBE_REPEAT >= 60) ? (unsigned long long)__builtin_readcyclecounter() : 0ull;
    LAS unsigned char* stage = (LAS unsigned char*)lds_raw + 1024;
#define RUN(k, ...) do { if (IN(k)) { __VA_ARGS__; if (PROBE_REPEAT == (k)) { xcd_barrier(bar); __VA_ARGS__; } } } while (0)
    RUN(0, p0_prologue(F));
    if (PROBE_REPEAT == 11 && IN(0)) { xcd_barrier(bar); cvt_stream(F, 0, 6400, nullptr); }
    SEAM(0);
    RUN(1, p1_proj(F, stage));
    SEAM(1);
    RUN(2, p2a_mid(F, stage));
    SEAM(2);
    RUN(3, p2b_mid(F, stage));
    SEAM(3);
    if (IN(4)) {
#pragma unroll 1
        for (int rep = 0; rep < (PROBE_REPEAT == 4 ? 2 : 1); ++rep) { if (rep) xcd_barrier(bar); p_attn(F, lds_raw, rep); } }
    SEAM(4);
    RUN(5, p6_mix(F));
    SEAM(5);
    RUN(6, p7_out(F, stage));
    SEAM(6);
    if (IN(7)) { if (PROBE_REPEAT == 7) { p8_router(F, 1); xcd_barrier(bar); } p8_router(F, 0); }
    SEAM(7);
#define REFRESH_LANE() do { F.lane = fresh_lane(); F.tid = F.wave * 64 + F.lane; } while (0)
    REFRESH_LANE();
    if (IN(8)) {
#pragma unroll 1
        for (int rep = 0; rep < (PROBE_REPEAT == 8 ? 2 : 1); ++rep) { if (rep) xcd_barrier(bar); p9_moe1(F, lds_raw, stage); } }
    SEAM(8);
    REFRESH_LANE();
    if (IN(9)) {
#pragma unroll 1
        for (int rep = 0; rep < (PROBE_REPEAT == 9 ? 2 : 1); ++rep) { if (rep) xcd_barrier(bar); p10_moe2(F, lds_raw, stage); } }
    SEAM(9);
    REFRESH_LANE();
    if (IN(10)) { if (PROBE_REPEAT == 10) { p11_final(F, 1); xcd_barrier(bar); } const unsigned long long tf0 = (PROBE_REPEAT == 70) ? (unsigned long long)__builtin_readcyclecounter() : 0ull; p11_final(F, 0); if (PROBE_REPEAT == 70) tbar = (unsigned long long)__builtin_readcyclecounter() - tf0; }
#undef RUN
    if (PROBE_REPEAT >= 40 && blockIdx.x == PROBE_WG && threadIdx.x == 0) *(volatile unsigned long long*)(lds_raw + 512) = tbar;
    if (((PROBE_REPEAT >= 30 && PROBE_REPEAT <= 33) || PROBE_REPEAT >= 40) && blockIdx.x == PROBE_WG && threadIdx.x == 0) {
        const unsigned long long want = 4ull * *(volatile unsigned long long*)(lds_raw + 512), t0 = __builtin_readcyclecounter();
        while ((unsigned long long)__builtin_readcyclecounter() - t0 < want) __builtin_amdgcn_s_sleep(8);
    }
#undef IN
#undef SEAM
}

extern "C" void kernel_launch(void* const* d_in, const int* in_sizes, int n_in, void* d_out, int out_size, void* d_ws, size_t ws_size, hipStream_t stream) {
    static int grid = 0;
    if (grid == 0) {
        if (n_in != N_IN || out_size != NT * DM || ws_size < WS_END) { fprintf(stderr, "kernel_launch: unexpected shapes: n_in %d out %d ws %zu (need %zu)\n", n_in, out_size, ws_size, (size_t)WS_END); grid = -1; return; }
        int dev = 0, cus = 0, per_cu = 0;
        if (hipGetDevice(&dev) != hipSuccess || hipDeviceGetAttribute(&cus, hipDeviceAttributeMultiprocessorCount, dev) != hipSuccess) { grid = -1; return; }
        if (hipFuncSetAttribute((const void*)fwd, hipFuncAttributeMaxDynamicSharedMemorySize, LDS_BYTES) != hipSuccess) { fprintf(stderr, "kernel_launch: hipFuncSetAttribute failed\n"); grid = -1; return; }
        if (hipOccupancyMaxActiveBlocksPerMultiprocessor(&per_cu, (const void*)fwd, NTHREADS, LDS_BYTES) != hipSuccess || per_cu < 1) { fprintf(stderr, "kernel_launch: occupancy query says %d\n", per_cu); }
        (void)hipGetLastError();
        grid = cus;
    }
    if (grid < 0) return;
    (void)in_sizes;
    (void)hipMemsetAsync((char*)d_ws + WS_CTL, 0, CTL_ZERO_BYTES, stream);
    Args a{};
    for (int i = 0; i < N_IN; ++i) a.in[i] = (const float*)d_in[i];
    a.out = (float*)d_out; a.ws = (unsigned char*)d_ws;
    if (N_LAUNCHES == 1) { a.ph_lo = 0; a.ph_hi = NPHASE; hipLaunchKernelGGL(fwd, dim3(grid), dim3(NTHREADS), LDS_BYTES, stream, a); }
    else { for (int p = 0; p < NPHASE; ++p) { a.ph_lo = p; a.ph_hi = p + 1; hipLaunchKernelGGL(fwd, dim3(grid), dim3(NTHREADS), LDS_BYTES, stream, a); } }
}
```

```cpp
#include <hip/hip_runtime.h>
#include <cstdio>
#include <cstdint>

#ifndef PROBE_REPEAT
#define PROBE_REPEAT -1
#endif
#ifndef MERGE_CMP2
#define MERGE_CMP2 0
#endif
#ifndef PROBE_WG
#define PROBE_WG 0
#endif
#ifndef N_LAUNCHES
#define N_LAUNCHES 1
#endif

#define XB_TMO      128
#define XB_XCNT(j)  (256  + 64 * (j))
#define XB_XSUB(j)  (1280 + 64 * (j))
#define XB_XGEN(j)  (2304 + 64 * (j))
#define XB_TOP      3328
#define XB_TOPGEN   3392
#define XCD_BAR_WORDS 3456
#define XB_SPIN_CAP (1u << 21)
#define LAS __attribute__((address_space(3)))

__device__ __forceinline__ unsigned xb_ld(unsigned* p)              { return __hip_atomic_load(p, __ATOMIC_RELAXED, __HIP_MEMORY_SCOPE_AGENT); }
__device__ __forceinline__ unsigned xb_add(unsigned* p, unsigned v) { return __hip_atomic_fetch_add(p, v, __ATOMIC_RELAXED, __HIP_MEMORY_SCOPE_AGENT); }
__device__ __forceinline__ unsigned xb_xcc_id() { return (unsigned)__builtin_amdgcn_s_getreg((3 << 11) | 20) & 0xFu; }
#define XB_SPIN(cond, bar) do { unsigned _sp = 0; while (cond) { __builtin_amdgcn_s_sleep(1); \
    if ((++_sp & 255u) == 0u) { if (xb_ld(&(bar)[XB_TMO])) break; if (_sp > XB_SPIN_CAP) { atomicAdd(&(bar)[XB_TMO], 1u); break; } } } } while (0)

struct XcdBarrier { unsigned* bar; unsigned x; volatile LAS unsigned* st; int wave; };

__device__ __forceinline__ XcdBarrier xcd_barrier_post(unsigned* bar, volatile LAS unsigned* st) {
    XcdBarrier b; b.bar = bar; b.x = xb_xcc_id(); b.st = st;
    if (threadIdx.x == 0) (void)xb_add(&bar[XB_XCNT(b.x)], 1u);
    return b;
}
__device__ __forceinline__ void xcd_barrier_complete(unsigned* bar, unsigned x, unsigned& nloc, unsigned& nx) {
    const unsigned G = gridDim.x * gridDim.y * gridDim.z;
    unsigned sum, cnt, mine, sp = 0u;
    for (;;) {
        sum = 0u; cnt = 0u; mine = 0u;
#pragma unroll
        for (unsigned j = 0; j < 16; ++j) { const unsigned c = xb_ld(&bar[XB_XCNT(j)]); sum += c; cnt += (c > 0u) ? 1u : 0u; mine = (j == x) ? c : mine; }
        if (sum == G) break;
        __builtin_amdgcn_s_sleep(1);
        if ((++sp & 255u) == 0u) { if (xb_ld(&bar[XB_TMO])) break; if (sp > XB_SPIN_CAP) { atomicAdd(&bar[XB_TMO], 1u); break; } }
    }
    nloc = mine > 0u ? mine : 1u; nx = cnt > 0u ? cnt : 1u;
}
__device__ __forceinline__ int fresh_lane();
__device__ __forceinline__ void xcd_barrier(const XcdBarrier& b) {
    asm volatile("s_waitcnt vmcnt(0)" ::: "memory");
    __syncthreads();
    if (b.wave == 0 && fresh_lane() == 0) {
        unsigned* bar = b.bar;
        __builtin_amdgcn_s_waitcnt(0);
        unsigned nloc = b.st[0], nx = b.st[1];
        if (nloc == 0u) { xcd_barrier_complete(bar, b.x, nloc, nx); b.st[0] = nloc; b.st[1] = nx; }
        const unsigned old = xb_add(&bar[XB_XSUB(b.x)], 1u);
        const unsigned gen = old / nloc;
        if (old + 1u == (gen + 1u) * nloc) {
            __builtin_amdgcn_fence(__ATOMIC_RELEASE, "agent");
            asm volatile("s_waitcnt vmcnt(0)" ::: "memory");
            const unsigned og = xb_add(&bar[XB_TOP], 1u);
            const unsigned tg = og / nx;
            if (og + 1u == (tg + 1u) * nx) xb_add(&bar[XB_TOPGEN], 1u);
            else XB_SPIN(xb_ld(&bar[XB_TOPGEN]) == tg, bar);
            __builtin_amdgcn_fence(__ATOMIC_ACQUIRE, "agent");
            xb_add(&bar[XB_XGEN(b.x)], 1u);
            asm volatile("s_waitcnt vmcnt(0)" ::: "memory");
        } else {
            XB_SPIN(xb_ld(&bar[XB_XGEN(b.x)]) == gen, bar);
            __builtin_amdgcn_fence(__ATOMIC_ACQUIRE, "agent");
            asm volatile("s_waitcnt vmcnt(0)" ::: "memory");
        }
    }
    __syncthreads();
}

typedef unsigned short bf16_t;
constexpr int NB = 4, SEQ = 2048, DM = 2048, NT = NB * SEQ;
constexpr int NH = 8, NG = 2, HD = 128, INW = 3608, INWP = 3840;
constexpr int NCMP = 127, NSEL = 32, NEXP = 32, FF = 512;
constexpr float EPS = 1e-6f;
constexpr float SCALE = 0.08838834764831845f;
constexpr int NTHREADS = 512, NWAVES = 8;
constexpr int LDS_BYTES = 147456;
constexpr int YROWS = 24576;

enum { I_X = 0, I_POS, I_LNMIX, I_WIN, I_PEK, I_WK1, I_WK2, I_PEV, I_WV1, I_WV2, I_WPOOL, I_BPOOL, I_PSCALE, I_GNNSA, I_GNPOOL, I_WOUT, I_LNMOE,
       I_WRG, I_BRG, I_WRE, I_BRE, I_WGATE, I_WUP, I_WDOWN, I_LNFINAL, N_IN };

constexpr size_t MB = 1024 * 1024;
constexpr size_t WS_CTL   = 0;
constexpr size_t CTL_ZERO_BYTES = 65536;
constexpr int    CW_CNT   = 4096;
constexpr size_t WS_RSTD1 = 1 * MB;
constexpr size_t WS_RSTD2 = 1 * MB + 65536;
constexpr size_t WS_BIAS1 = 1 * MB + 131072;
constexpr size_t WS_AROW  = 1 * MB + 262144;
constexpr size_t WS_WR    = 1 * MB + 393216;
constexpr size_t WS_WG4   = 1 * MB + 655360;
constexpr size_t WS_WRP   = 32 * MB;
constexpr size_t WS_PL    = 40 * MB;
constexpr size_t WS_ROPEC = 2 * MB;
constexpr size_t WS_ROPES = 2 * MB + 524288;
constexpr size_t WS_GATES = 3 * MB;
constexpr size_t WS_TOKL  = 4 * MB;
constexpr size_t WS_GATEL = 5 * MB;
constexpr size_t WS_HID   = 6 * MB;
constexpr size_t WS_CMPKV = 8 * MB;
constexpr size_t WS_WINT  = 9 * MB;
constexpr size_t WS_WOUTT = 24 * MB;
constexpr size_t WS_W1T   = 32 * MB;
constexpr size_t WS_W2T   = 160 * MB;
constexpr size_t WS_CMPW  = 224 * MB;
constexpr size_t WS_POOLW = 228 * MB;
constexpr size_t WS_POOLB = 228 * MB + 524288;
constexpr size_t WS_CPART = 447 * MB;
constexpr size_t WS_DBUF  = 463 * MB;
constexpr size_t WS_XB    = 230 * MB;
constexpr size_t WS_QN    = 262 * MB;
constexpr size_t WS_QR    = 278 * MB;
constexpr size_t WS_KV    = 294 * MB;
constexpr size_t WS_U     = 319 * MB;
constexpr size_t WS_Y     = 230 * MB;
constexpr size_t WS_OWIN  = 351 * MB;
constexpr size_t WS_OCMP  = 367 * MB;
constexpr size_t WS_OSEL  = 319 * MB;
constexpr size_t WS_ML    = 6 * MB;
constexpr size_t WS_X1B   = 351 * MB;
constexpr size_t WS_OPOOL = 383 * MB;
constexpr size_t WS_ACT   = 383 * MB;
constexpr size_t WS_MIX   = 415 * MB;
constexpr size_t WS_END   = 479 * MB;

__device__ __forceinline__ bf16_t f2bf(float f) { unsigned u = __float_as_uint(f); u += 0x7FFFu + ((u >> 16) & 1u); return (bf16_t)(u >> 16); }
__device__ __forceinline__ float bf2f(bf16_t b) { return __uint_as_float(((unsigned)b) << 16); }
__device__ __forceinline__ float wave_sum(float v) {
#pragma unroll
    for (int o = 32; o >= 1; o >>= 1) v += __shfl_xor(v, o);
    return v;
}
__device__ __forceinline__ float wave_max(float v) {
#pragma unroll
    for (int o = 32; o >= 1; o >>= 1) v = fmaxf(v, __shfl_xor(v, o));
    return v;
}

__device__ __forceinline__ int fresh_lane() { int l; asm volatile("v_mbcnt_lo_u32_b32 %0, -1, 0\n\tv_mbcnt_hi_u32_b32 %0, -1, %0" : "=v"(l)); return l; }
struct Args { const float* in[N_IN]; float* out; unsigned char* ws; int ph_lo, ph_hi; };

struct Frame {
    const float* in[N_IN]; float* out; unsigned char* ws;
    float* lds;
    int tid, lane, wave, G, bid;
};

__device__ __forceinline__ float gelu_tanh(float x) { const float u = 0.7978845608028654f * (x + 0.044715f * x * x * x); return 0.5f * x * (1.f + tanhf(u)); }


namespace pg8 {
typedef short bf16x8 __attribute__((ext_vector_type(8)));
typedef float f32x4 __attribute__((ext_vector_type(4)));
typedef unsigned u32x4 __attribute__((ext_vector_type(4)));
constexpr int BM = 256, BK = 64, HALF = 128, HTB = HALF * BK * 2, STAGE_BYTES = 8 * HTB, NXCD = 8, WGM = 8;
__device__ __forceinline__ int lds_byte(int r, int c) { const int st = (r >> 4) * 2 + (c >> 5), rr = r & 15, cc = c & 31, ob = rr * 64 + cc * 2; return st * 1024 + (ob ^ (((ob >> 9) & 1) << 5)); }
__device__ __forceinline__ void stage_rc(int b, int& R, int& C) { const int st = b / 1024, sb = b % 1024, swz = sb ^ (((sb >> 9) & 1) << 5); R = (st >> 1) * 16 + swz / 64; C = (st & 1) * 32 + (swz % 64) / 2; }
struct Unit { int pm, pn, e, li; };
__device__ __forceinline__ unsigned cvt_pk_bf16(float lo, float hi) { unsigned r; asm volatile("v_cvt_pk_bf16_f32 %0, %1, %2" : "=v"(r) : "v"(lo), "v"(hi)); return r; }

struct DenseOrder {
    const char* A; const char* Bt; int lda, ldb; int nM, nN, nwg, G, c;
    __device__ void init(const void* A_, const void* Bt_, int lda_, int ldb_, int M, int N, int G_, int c_) { A = (const char*)A_; Bt = (const char*)Bt_; lda = lda_; ldb = ldb_; nM = M / BM; nN = N / BM; nwg = nM * nN; G = G_; c = c_; }
    __device__ __forceinline__ bool next(int i, Unit& u) const {
        const long L = (long)i * G + c; if (L >= nwg) return false;
        int wgid = (int)L; { const int q = nwg / NXCD, r = nwg % NXCD, xcd = wgid % NXCD, off = wgid / NXCD; wgid = (xcd < r ? xcd * (q + 1) : r * (q + 1) + (xcd - r) * q) + off; }
        const int nig = WGM * nN, gid = wgid / nig, fm = gid * WGM, gsz = (nM - fm) < WGM ? (nM - fm) : WGM;
        u.pm = fm + ((wgid % nig) % gsz); u.pn = (wgid % nig) / gsz; u.e = 0; u.li = i; return true;
    }
    __device__ __forceinline__ const char* a_base(const Unit& u) const { return A + (size_t)u.pm * BM * lda * 2; }
    __device__ __forceinline__ const char* b_base(const Unit& u) const { return Bt + (size_t)u.pn * BM * ldb * 2; }
    __device__ __forceinline__ unsigned a_row_off(const Unit&, int r) const { return (unsigned)r * (unsigned)lda * 2u; }
};

template <class Epi, class Sched, bool GATHER>
__device__ __forceinline__ void gemm_phase(LAS unsigned char* lds, const int K, const int lda, const int ldb, const Sched& S, const Epi& E) {
    const int tid = threadIdx.x, wid = __builtin_amdgcn_readfirstlane(tid >> 6), lane = tid & 63, wr = wid >> 2, wc = wid & 3, fr = lane & 15, fq = lane >> 4;
    const int nt = K / BK;
    int sR[2], sC[2];
#pragma unroll
    for (int i = 0; i < 2; ++i) stage_rc(tid * 16 + i * 8192, sR[i], sC[i]);
    unsigned voffB[2], voffA[2][2], nvoffA[2][2];
#pragma unroll
    for (int i = 0; i < 2; ++i) voffB[i] = (unsigned)(sR[i] * ldb + sC[i]) * 2u;
    const size_t kstep = (size_t)(BK * 2);
    const size_t hstepB = (size_t)HALF * ldb * 2;
    const unsigned ldsw = (unsigned)wid * 1024u;
    const int aoff = lds_byte(wr * 64 + fr, fq * 8), boff = lds_byte(wc * 32 + fr, fq * 8);
#define PG8_SA(b, h) (((b) * 2 + (h)) * HTB)
#define PG8_SB(b, h) ((4 + (b) * 2 + (h)) * HTB)
#define PG8_STAGE(bufoff, gbase, voff) do { _Pragma("unroll") for (int _i = 0; _i < 2; ++_i) \
        __builtin_amdgcn_global_load_lds((const unsigned*)((const char*)(gbase) + (voff)[_i]), (LAS unsigned*)(lds + (bufoff) + ldsw + _i * 8192), 16, 0, 0); } while (0)
#define PG8_LDA(dst, b, h) do { _Pragma("unroll") for (int m = 0; m < 4; ++m) _Pragma("unroll") for (int k = 0; k < 2; ++k) dst[m][k] = *(const LAS bf16x8*)(lds + PG8_SA(b, h) + aoff + m * 2048 + k * 1024); } while (0)
#define PG8_LDB(dst, b, h) do { _Pragma("unroll") for (int n = 0; n < 2; ++n) _Pragma("unroll") for (int k = 0; k < 2; ++k) dst[n][k] = *(const LAS bf16x8*)(lds + PG8_SB(b, h) + boff + n * 2048 + k * 1024); } while (0)
#define PG8_MMA(ai, bj, At, Bt) do { __builtin_amdgcn_s_setprio(1); _Pragma("unroll") for (int m = 0; m < 4; ++m) _Pragma("unroll") for (int n = 0; n < 2; ++n) _Pragma("unroll") for (int k = 0; k < 2; ++k) \
        { acc[ai][bj][m][n] = __builtin_amdgcn_mfma_f32_16x16x32_bf16(Bt[n][k], At[m][k], acc[ai][bj][m][n], 0, 0, 0); if (PROBE_REPEAT == 21) dummy = __builtin_amdgcn_mfma_f32_16x16x32_bf16(Bt[n][k], At[m][k], dummy, 0, 0, 0); } __builtin_amdgcn_s_setprio(0); } while (0)
#define PG8_WAIT_V(n) asm volatile("s_waitcnt vmcnt(" #n ")" ::: "memory")
#define PG8_WAIT_L(n) asm volatile("s_waitcnt lgkmcnt(" #n ")" ::: "memory")
#define PG8_BAR __builtin_amdgcn_s_barrier()
#define PG8_SCHED __builtin_amdgcn_sched_barrier(0)
#define PG8_AOFFS(dst, u) do { _Pragma("unroll") for (int _h = 0; _h < 2; ++_h) _Pragma("unroll") for (int _i = 0; _i < 2; ++_i) dst[_h][_i] = S.a_row_off(u, _h * HALF + sR[_i]) + (unsigned)sC[_i] * 2u; } while (0)
    Unit cur, nxt; int ui = 0;
    if (!S.next(0, cur)) return;
    f32x4 acc[2][2][4][2];
#pragma unroll
    for (int a = 0; a < 2; ++a)
#pragma unroll
        for (int b = 0; b < 2; ++b)
#pragma unroll
            for (int m = 0; m < 4; ++m)
#pragma unroll
                for (int n = 0; n < 2; ++n) acc[a][b][m][n] = (f32x4){0.f, 0.f, 0.f, 0.f};
    bf16x8 At[4][2], B0[2][2], B1[2][2]; f32x4 dummy = {0.f, 0.f, 0.f, 0.f};
    const char* cA = S.a_base(cur); const char* cB = S.b_base(cur);
    PG8_AOFFS(voffA, cur);
    PG8_STAGE(PG8_SB(0, 0), cB, voffB); PG8_STAGE(PG8_SA(0, 0), cA, voffA[0]); PG8_STAGE(PG8_SB(0, 1), cB + hstepB, voffB); PG8_STAGE(PG8_SA(0, 1), cA, voffA[1]);
    if (wr == 1) PG8_BAR;
    PG8_WAIT_V(4); PG8_BAR;
    PG8_STAGE(PG8_SB(1, 0), cB + kstep, voffB); PG8_STAGE(PG8_SA(1, 0), cA + kstep, voffA[0]); PG8_STAGE(PG8_SB(1, 1), cB + hstepB + kstep, voffB);
    PG8_WAIT_V(6); PG8_BAR;
    for (;;) {
        const bool has_next = S.next(ui + 1, nxt);
        const char* nA = has_next ? S.a_base(nxt) : cA; const char* nB = has_next ? S.b_base(nxt) : cB;
        if (GATHER) { if (has_next) { PG8_AOFFS(nvoffA, nxt); } else {
#pragma unroll
            for (int _h = 0; _h < 2; ++_h)
#pragma unroll
                for (int _i = 0; _i < 2; ++_i) nvoffA[_h][_i] = voffA[_h][_i]; } }
        for (int t = 0; t < nt; t += 2) {
            const bool last = (t == nt - 2);
            const char* a1 = cA + (size_t)(t + 1) * kstep;
            const char* a2 = last ? nA : cA + (size_t)(t + 2) * kstep; const char* b2 = last ? nB : cB + (size_t)(t + 2) * kstep;
            const char* a3 = a2 + kstep; const char* b3 = b2 + kstep;
            unsigned vA2[2][2];
#pragma unroll
            for (int _h = 0; _h < 2; ++_h)
#pragma unroll
                for (int _i = 0; _i < 2; ++_i) vA2[_h][_i] = (GATHER && last) ? nvoffA[_h][_i] : voffA[_h][_i];
            PG8_LDB(B0, 0, 0); PG8_SCHED; PG8_LDA(At, 0, 0); PG8_STAGE(PG8_SA(1, 1), a1, voffA[1]);
            PG8_WAIT_L(8); PG8_BAR; PG8_WAIT_L(0); PG8_MMA(0, 0, At, B0); PG8_BAR; PG8_SCHED;
            PG8_LDB(B1, 0, 1); PG8_STAGE(PG8_SB(0, 0), b2, voffB);
            PG8_BAR; PG8_WAIT_L(0); PG8_MMA(0, 1, At, B1); PG8_BAR;
            PG8_LDA(At, 0, 1); PG8_STAGE(PG8_SA(0, 0), a2, vA2[0]);
            PG8_BAR; PG8_WAIT_L(0); PG8_MMA(1, 0, At, B0); PG8_BAR; PG8_SCHED;
            PG8_STAGE(PG8_SB(0, 1), b2 + hstepB, voffB);
            PG8_WAIT_V(6); PG8_BAR; PG8_MMA(1, 1, At, B1); PG8_BAR;
            PG8_LDB(B0, 1, 0); PG8_SCHED; PG8_LDA(At, 1, 0); PG8_STAGE(PG8_SA(0, 1), a2, vA2[1]);
            PG8_WAIT_L(8); PG8_BAR; PG8_WAIT_L(0); PG8_MMA(0, 0, At, B0); PG8_BAR; PG8_SCHED;
            PG8_LDB(B1, 1, 1); PG8_STAGE(PG8_SB(1, 0), b3, voffB);
            PG8_BAR; PG8_WAIT_L(0); PG8_MMA(0, 1, At, B1); PG8_BAR;
            PG8_LDA(At, 1, 1); PG8_STAGE(PG8_SA(1, 0), a3, vA2[0]);
            PG8_BAR; PG8_WAIT_L(0); PG8_MMA(1, 0, At, B0); PG8_BAR; PG8_SCHED;
            PG8_STAGE(PG8_SB(1, 1), b3 + hstepB, voffB);
            PG8_WAIT_V(6); PG8_BAR; PG8_MMA(1, 1, At, B1); PG8_BAR;
        }
        if constexpr (!Epi::AFTER_DRAIN) E(acc, cur, wr, wc, fr, fq);
        if (!has_next) break;
#pragma unroll
        for (int a = 0; a < 2; ++a)
#pragma unroll
            for (int b = 0; b < 2; ++b)
#pragma unroll
                for (int m = 0; m < 4; ++m)
#pragma unroll
                    for (int n = 0; n < 2; ++n) acc[a][b][m][n] = (f32x4){0.f, 0.f, 0.f, 0.f};
        cur = nxt; cA = nA; cB = nB; ++ui;
        if (GATHER) {
#pragma unroll
            for (int _h = 0; _h < 2; ++_h)
#pragma unroll
                for (int _i = 0; _i < 2; ++_i) voffA[_h][_i] = nvoffA[_h][_i]; }
    }
    if (PROBE_REPEAT == 21) asm volatile("" :: "v"(dummy));
    PG8_WAIT_V(0);
    if (wr == 0) PG8_BAR;
    PG8_BAR;
    if constexpr (Epi::AFTER_DRAIN) E.fused(acc, cur, wr, wc, fr, fq, lds);
#undef PG8_SA
#undef PG8_SB
#undef PG8_STAGE
#undef PG8_LDA
#undef PG8_LDB
#undef PG8_MMA
#undef PG8_WAIT_V
#undef PG8_WAIT_L
#undef PG8_BAR
#undef PG8_SCHED
#undef PG8_AOFFS
}
}


namespace g2 {
using pg8::bf16x8; using pg8::f32x4; using pg8::lds_byte; using pg8::cvt_pk_bf16;
typedef short s16x4 __attribute__((ext_vector_type(4)));
constexpr int A_BYTES = 32768, B_BYTES = 16384, STG = A_BYTES + B_BYTES;
struct Unit { int e, pm, pn, li, half; };
template <int NT_, class Epi, class Sched>
__device__ __forceinline__ void gemm(LAS unsigned char* lds, const Sched& S, const Epi& E, const int wave_, unsigned long long* tprobe = nullptr) {
#if defined(__HIP_DEVICE_COMPILE__)
    const int wid = wave_, lane = fresh_lane(), tid = wid * 64 + lane, wr = wid >> 2, wc = wid & 3, fr = lane & 15, fq = lane >> 4;
    constexpr int nt = NT_;
    unsigned long long tacc = 0ull;
#define TCK() ((PROBE_REPEAT >= 30 && PROBE_REPEAT <= 33) ? (unsigned long long)__builtin_readcyclecounter() : 0ull)
    const unsigned long long t_all0 = TCK();
    const int awoff0 = lds_byte((tid >> 3) & 127, (tid & 7) * 8);
    const int bkr = tid >> 5, bnq = tid & 31;
    const int bwoff0 = A_BYTES + bkr * 256 + ((((bnq >> 2)) ^ ((bkr & 3) | (((bkr >> 3) & 1) << 2))) * 32) + (bnq & 3) * 8;
#define awoff(j) (awoff0 + ((j) & 1) * 8192 + ((j) >> 1) * 16384)
#define bwoff(j) (bwoff0 + (j) * 4096)
    const int aoff = lds_byte(wr * 64 + fr, fq * 8);
    int boff[2];
    { const int q = (lane >> 2) & 3, p = lane & 3, f = q | ((fq & 1) << 2);
#pragma unroll
      for (int n = 0; n < 2; ++n) boff[n] = A_BYTES + (8 * fq + q) * 256 + (((2 * wc + n) ^ f) * 32) + 8 * p; }
    const int ldsb = (int)(uintptr_t)lds;
    Unit u, un;
    if (!S.next(0, u)) return;
    unsigned pa[4], pan[4]; const float* pb; const float* pbn;
    const size_t bstep = (size_t)16 * S.ldb;
#define G2_PTRS(PA, PB, U) do { _Pragma("unroll") for (int j = 0; j < 4; ++j) { const int id = tid + 512 * j; PA[j] = S.a_off(U, id >> 3) + (unsigned)(id & 7) * 16u; } PB = S.b_col(U, 4 * bnq) + (size_t)bkr * S.ldb; } while (0)
    G2_PTRS(pa, pb, u);
    f32x4 acc[2][4][2];
#pragma unroll
    for (int a = 0; a < 2; ++a)
#pragma unroll
        for (int m = 0; m < 4; ++m)
#pragma unroll
            for (int n = 0; n < 2; ++n) acc[a][m][n] = (f32x4){0.f, 0.f, 0.f, 0.f};
    f32x4 dummy = {0.f, 0.f, 0.f, 0.f};
    bf16x8 ra0[4], ra1[4]; f32x4 rb0[4], rb1[4];
    bool hf = u.half != 0; const bool hfn = false; (void)hfn; int nvalid = S.nvalid(u);
#define G2_LOADA(RA, PA, HF, t) do { _Pragma("unroll") for (int j = 0; j < 4; ++j) if (j < 2 || !(HF)) RA[j] = *(const bf16x8*)((const char*)S.A + PA[j] + (unsigned)(t) * 128u); } while (0)
#define G2_LOADB(RB, PB, t) do { _Pragma("unroll") for (int j = 0; j < 4; ++j) RB[j] = *(const f32x4*)(PB + (size_t)(t) * 64 * S.ldb + j * bstep); } while (0)
#define G2_WRITE_A(st, RA, j) do { *(LAS bf16x8*)(lds + (st) * STG + awoff(j)) = RA[j]; } while (0)
#define G2_WRITE_B(st, RB, j) do { uint2 w_; w_.x = cvt_pk_bf16(RB[j][0], RB[j][1]); w_.y = cvt_pk_bf16(RB[j][2], RB[j][3]); *(LAS uint2*)(lds + (st) * STG + bwoff(j)) = w_; } while (0)
#define G2_TR(dst, n, imm) asm volatile("ds_read_b64_tr_b16 %0, %1 offset:%2" : "=&v"(dst) : "v"(ldsb + boff[n]), "i"(imm) : "memory")
#define G2_COMPUTE(st, DOW, WA, WB, HFC, HFW) do { const unsigned long long tc0_ = TCK(); \
        s16x4 b00l, b00h, b01l, b01h, b10l, b10h, b11l, b11h;        \
        G2_TR(b00l, 0, (st) * STG); G2_TR(b00h, 0, (st) * STG + 1024); G2_TR(b01l, 0, (st) * STG + 8192); G2_TR(b01h, 0, (st) * STG + 8192 + 1024); \
        G2_TR(b10l, 1, (st) * STG); G2_TR(b10h, 1, (st) * STG + 1024); G2_TR(b11l, 1, (st) * STG + 8192); G2_TR(b11h, 1, (st) * STG + 8192 + 1024); \
        bf16x8 At[4][2]; \
        _Pragma("unroll") for (int m = 0; m < 4; ++m) _Pragma("unroll") for (int k = 0; k < 2; ++k) At[m][k] = *(const LAS bf16x8*)(lds + (st) * STG + aoff + m * 2048 + k * 1024); \
        asm volatile("s_waitcnt lgkmcnt(0)" ::: "memory"); __builtin_amdgcn_sched_barrier(0); \
        if (PROBE_REPEAT == 31) tacc += TCK() - tc0_; \
        const bf16x8 B00 = {b00l[0], b00l[1], b00l[2], b00l[3], b00h[0], b00h[1], b00h[2], b00h[3]}, B01 = {b01l[0], b01l[1], b01l[2], b01l[3], b01h[0], b01h[1], b01h[2], b01h[3]}; \
        const bf16x8 B10 = {b10l[0], b10l[1], b10l[2], b10l[3], b10h[0], b10h[1], b10h[2], b10h[3]}, B11 = {b11l[0], b11l[1], b11l[2], b11l[3], b11h[0], b11h[1], b11h[2], b11h[3]}; \
        _Pragma("unroll") for (int a = 0; a < 2; ++a) { \
            _Pragma("unroll") for (int m = 0; m < 4; ++m) { \
                __builtin_amdgcn_s_setprio(1); \
                if (128 * a + 64 * wr + 16 * m < nvalid) {                 \
                acc[a][m][0] = __builtin_amdgcn_mfma_f32_16x16x32_bf16(B00, At[m][0], acc[a][m][0], 0, 0, 0); acc[a][m][0] = __builtin_amdgcn_mfma_f32_16x16x32_bf16(B01, At[m][1], acc[a][m][0], 0, 0, 0); \
                acc[a][m][1] = __builtin_amdgcn_mfma_f32_16x16x32_bf16(B10, At[m][0], acc[a][m][1], 0, 0, 0); acc[a][m][1] = __builtin_amdgcn_mfma_f32_16x16x32_bf16(B11, At[m][1], acc[a][m][1], 0, 0, 0); } \
                if (PROBE_REPEAT == 20) { dummy = __builtin_amdgcn_mfma_f32_16x16x32_bf16(B00, At[m][0], dummy, 0, 0, 0); dummy = __builtin_amdgcn_mfma_f32_16x16x32_bf16(B01, At[m][1], dummy, 0, 0, 0); dummy = __builtin_amdgcn_mfma_f32_16x16x32_bf16(B10, At[m][0], dummy, 0, 0, 0); dummy = __builtin_amdgcn_mfma_f32_16x16x32_bf16(B11, At[m][1], dummy, 0, 0, 0); } \
                __builtin_amdgcn_s_setprio(0); \
                if (DOW) { if (a == 0) { if (m < 2 || !(HFW)) G2_WRITE_A((st) ^ 1, WA, m); if (HFC) G2_WRITE_B((st) ^ 1, WB, m); } else G2_WRITE_B((st) ^ 1, WB, m); __builtin_amdgcn_sched_barrier(0); } } \
            if (HFC) break;                                               \
            if (a == 0) { __builtin_amdgcn_sched_barrier(0); \
                _Pragma("unroll") for (int m = 0; m < 4; ++m) _Pragma("unroll") for (int k = 0; k < 2; ++k) At[m][k] = *(const LAS bf16x8*)(lds + (st) * STG + 16384 + aoff + m * 2048 + k * 1024); \
                asm volatile("s_waitcnt lgkmcnt(0)" ::: "memory"); __builtin_amdgcn_sched_barrier(0); } } \
        if (PROBE_REPEAT == 32) tacc += TCK() - tc0_; } while (0)
    for (int ui = 0;; ++ui) {
        G2_LOADA(ra0, pa, hf, 0); G2_LOADB(rb0, pb, 0); G2_LOADA(ra1, pa, hf, 1); G2_LOADB(rb1, pb, 1);
        __syncthreads();
#pragma unroll
        for (int j = 0; j < 4; ++j) { if (j < 2 || !hf) G2_WRITE_A(0, ra0, j); G2_WRITE_B(0, rb0, j); }
        if (nt > 2) { G2_LOADA(ra0, pa, hf, 2); G2_LOADB(rb0, pb, 2); }
        __syncthreads();
#define G2_STEP(t) do { \
            G2_COMPUTE(0, true, ra1, rb1, hf, hf); \
            if ((t) + 3 < nt) { G2_LOADA(ra1, pa, hf, (t) + 3); G2_LOADB(rb1, pb, (t) + 3); } \
            __syncthreads(); \
            if ((t) + 2 < nt) { G2_COMPUTE(1, true, ra0, rb0, hf, hf); } else { G2_COMPUTE(1, false, ra0, rb0, hf, hf); } \
            if ((t) + 4 < nt) { G2_LOADA(ra0, pa, hf, (t) + 4); G2_LOADB(rb0, pb, (t) + 4); } \
            __syncthreads(); } while (0)
        G2_STEP(0); G2_STEP(2); G2_STEP(4); G2_STEP(6);
        if constexpr (NT_ > 8) { G2_STEP(8); G2_STEP(10); G2_STEP(12); G2_STEP(14); G2_STEP(16); G2_STEP(18); G2_STEP(20); G2_STEP(22); G2_STEP(24); G2_STEP(26); G2_STEP(28); G2_STEP(30); }
        static_assert(NT_ == 8 || NT_ == 32, "expand G2_STEP for this K");
#undef G2_STEP
        if (PROBE_REPEAT == 20) asm volatile("" :: "v"(dummy));
        E(acc, u, wr, wc, fr, fq);
        if (!S.next(ui + 1, un)) break;
#pragma unroll
        for (int a = 0; a < 2; ++a)
#pragma unroll
            for (int m = 0; m < 4; ++m)
#pragma unroll
                for (int n = 0; n < 2; ++n) acc[a][m][n] = (f32x4){0.f, 0.f, 0.f, 0.f};
        u.e = un.e; u.pm = un.pm; u.pn = un.pn; u.li = un.li; u.half = un.half; hf = u.half != 0; nvalid = S.nvalid(u);
        G2_PTRS(pa, pb, u);
    }
#undef G2_PTRS
#undef awoff
#undef bwoff
#undef G2_LOADA
#undef G2_LOADB
#undef G2_WRITE_A
#undef G2_WRITE_B
#undef G2_TR
#undef G2_COMPUTE
    if (PROBE_REPEAT == 33) tacc = TCK() - t_all0;
    if (tprobe && blockIdx.x == PROBE_WG && threadIdx.x == 0) *tprobe = tacc;
#undef TCK
#endif
}
}

namespace att {
typedef short bf16x8 __attribute__((ext_vector_type(8)));
typedef short s16x4 __attribute__((ext_vector_type(4)));
typedef float f32x16 __attribute__((ext_vector_type(16)));
typedef float f32x4 __attribute__((ext_vector_type(4)));
typedef unsigned u32x4 __attribute__((ext_vector_type(4)));
constexpr int SHM = 16384;
constexpr int NBUF = 3;
constexpr int L_K = 0, L_V = NBUF * SHM, L_WS = 2 * NBUF * SHM, L_PART = L_WS + 8 * 64 * 4, L_SELM = L_PART + 4 * 64 * 33 * 4, L_VALS = L_SELM + 256, L_ITEM = L_VALS + 8 * 64 * 4, L_END = L_ITEM + 16;
constexpr float C2 = 1.4426950408889634f * SCALE;
#define KSWZ(row, colB) ((row) * 256 + ((colB) ^ (((row) & 7) << 4)))
#define SBAR() __builtin_amdgcn_sched_barrier(0)
__device__ __forceinline__ int v_st(int k, int c) { const int kk = (k & ~0xC) | ((k & 4) << 1) | ((k & 8) >> 1); return ((kk >> 3) * 4 + (c >> 5)) * 512 + ((kk & 7) * 32 + (c & 31)) * 2; }
__device__ __forceinline__ int v_rd_base(int lane) { return ((lane & 3) << 3) | (((lane >> 2) & 3) << 6) | (((lane >> 4) & 1) << 5) | (((lane >> 5) & 1) << 8); }
constexpr int v_rd_off(int d0, int ks, int half) { return d0 * 512 + ks * 4096 + half * 2048; }
__device__ __forceinline__ int crow(int r, int hi) { return (r & 3) + 8 * (r >> 2) + 4 * hi; }
__device__ __forceinline__ unsigned cvtpk(float lo, float hi) { unsigned r; asm volatile("v_cvt_pk_bf16_f32 %0, %1, %2" : "=v"(r) : "v"(lo), "v"(hi)); return r; }
__device__ __forceinline__ float swap_max(float v) { auto rr = __builtin_amdgcn_permlane32_swap(__float_as_uint(v), __float_as_uint(v), false, false); return fmaxf(__uint_as_float(rr[0]), __uint_as_float(rr[1])); }
__device__ __forceinline__ float swap_sum(float v) { auto rr = __builtin_amdgcn_permlane32_swap(__float_as_uint(v), __float_as_uint(v), false, false); return __uint_as_float(rr[0]) + __uint_as_float(rr[1]); }

struct WV { int tid, wid, lane, r32, hi, vb0; unsigned ksrc[2], vsrc[2]; char* lds; LAS unsigned char* ldsL; };
__device__ __forceinline__ void wv_src_init(WV& w) {
#pragma unroll
    for (int i = 0; i < 2; ++i) {
        const int L = (w.wid * 2 + i) * 1024 + w.lane * 16;
        { const int row = L >> 8, colB = (L & 255) ^ ((row & 7) << 4); w.ksrc[i] = (unsigned)(row * 256 + colB); }
        { const int sub = L >> 9, kkhi = sub >> 2, cblk = sub & 3, within = L & 511, kklo = within >> 6, cc = (within >> 1) & 31;
          const int kk = kkhi * 8 + kklo, k = (kk & ~0xC) | ((kk & 4) << 1) | ((kk & 8) >> 1), c = cblk * 32 + cc; w.vsrc[i] = (unsigned)(k * 256 + c * 2); }
    }
}
__device__ __forceinline__ void dma_tile(const WV& w, const bf16_t* Kt, const bf16_t* Vt, int buf) {
    int ln = w.lane; asm volatile("" : "+v"(ln));
#pragma unroll
    for (int i = 0; i < 2; ++i) {
        const int L = (w.wid * 2 + i) * 1024 + ln * 16;
        const int row = L >> 8, colB = (L & 255) ^ ((row & 7) << 4); const unsigned ksrc = (unsigned)(row * 256 + colB);
        const int sub = L >> 9, kkhi = sub >> 2, cblk = sub & 3, within = L & 511, kklo = within >> 6, cc = (within >> 1) & 31;
        const int kk = kkhi * 8 + kklo, k = (kk & ~0xC) | ((kk & 4) << 1) | ((kk & 8) >> 1), c = cblk * 32 + cc; const unsigned vsrc = (unsigned)(k * 256 + c * 2);
        __builtin_amdgcn_global_load_lds((const unsigned*)((const char*)Vt + vsrc), (LAS unsigned*)(w.ldsL + L_V + buf * SHM + (w.wid * 2 + i) * 1024), 16, 0, 0);
        __builtin_amdgcn_global_load_lds((const unsigned*)((const char*)Kt + ksrc), (LAS unsigned*)(w.ldsL + L_K + buf * SHM + (w.wid * 2 + i) * 1024), 16, 0, 0);
    }
}
template <int BUF>
__device__ __forceinline__ void qkt(const WV& w, const bf16x8 (&qr)[8], f32x16& p0, f32x16& p1) {
    p0 = f32x16{}; p1 = f32x16{};
    const LAS char* kb[4];
#pragma unroll
    for (int dd = 0; dd < 4; ++dd) kb[dd] = (const LAS char*)w.ldsL + L_K + KSWZ(w.r32, (dd * 16 + w.hi * 8) * 2);
#pragma unroll
    for (int d0 = 0; d0 < 8; ++d0) { const LAS char* a = kb[d0 & 3] + BUF * SHM + (d0 >> 2) * 128;
        const bf16x8 b0 = *reinterpret_cast<const LAS bf16x8*>(a); const bf16x8 b1 = *reinterpret_cast<const LAS bf16x8*>(a + 32 * 256);
        p0 = __builtin_amdgcn_mfma_f32_32x32x16_bf16(b0, qr[d0], p0, 0, 0, 0);
        p1 = __builtin_amdgcn_mfma_f32_32x32x16_bf16(b1, qr[d0], p1, 0, 0, 0);
        if (d0 == 3) SBAR(); }
}
__device__ __forceinline__ void pack_p(const f32x16& p0, const f32x16& p1, bf16x8& pa0, bf16x8& pa1, bf16x8& pa2, bf16x8& pa3) {
#define PK4(P, B_, OUT) do { unsigned a0 = cvtpk(P[B_+0], P[B_+1]), a1 = cvtpk(P[B_+2], P[B_+3]); unsigned b0 = cvtpk(P[B_+4], P[B_+5]), b1 = cvtpk(P[B_+6], P[B_+7]); \
        auto r0 = __builtin_amdgcn_permlane32_swap(a0, b0, false, false); auto r1 = __builtin_amdgcn_permlane32_swap(a1, b1, false, false); \
        u32x4 w_ = {r0[0], r1[0], r0[1], r1[1]}; OUT = *reinterpret_cast<bf16x8*>(&w_); } while (0)
    PK4(p0, 0, pa0); PK4(p0, 8, pa1); PK4(p1, 0, pa2); PK4(p1, 8, pa3);
#undef PK4
}
template <int VB>
__device__ __forceinline__ void pv_tile(f32x16* o, int vb0, bf16x8 pa0, bf16x8 pa1, bf16x8 pa2, bf16x8 pa3) {
#define TRRD(dst, off) asm volatile("ds_read_b64_tr_b16 %0, %1 offset:%2" : "=&v"(dst) : "v"(vb0), "i"(off) : "memory")
#define PV_D0(d0) do { s16x4 l0, l1, l2, l3, h0, h1, h2, h3; constexpr int b_ = VB * SHM + v_rd_off(d0, 0, 0); \
        TRRD(l0, b_); TRRD(h0, b_ + 2048); TRRD(l1, b_ + 4096); TRRD(h1, b_ + 6144); TRRD(l2, b_ + 8192); TRRD(h2, b_ + 10240); TRRD(l3, b_ + 12288); TRRD(h3, b_ + 14336); \
        asm volatile("s_waitcnt lgkmcnt(0)" ::: "memory"); SBAR(); \
        o[d0] = __builtin_amdgcn_mfma_f32_32x32x16_bf16(pa0, (bf16x8){l0[0], l0[1], l0[2], l0[3], h0[0], h0[1], h0[2], h0[3]}, o[d0], 0, 0, 0); \
        o[d0] = __builtin_amdgcn_mfma_f32_32x32x16_bf16(pa1, (bf16x8){l1[0], l1[1], l1[2], l1[3], h1[0], h1[1], h1[2], h1[3]}, o[d0], 0, 0, 0); \
        o[d0] = __builtin_amdgcn_mfma_f32_32x32x16_bf16(pa2, (bf16x8){l2[0], l2[1], l2[2], l2[3], h2[0], h2[1], h2[2], h2[3]}, o[d0], 0, 0, 0); \
        o[d0] = __builtin_amdgcn_mfma_f32_32x32x16_bf16(pa3, (bf16x8){l3[0], l3[1], l3[2], l3[3], h3[0], h3[1], h3[2], h3[3]}, o[d0], 0, 0, 0); } while (0)
    PV_D0(0); PV_D0(1); PV_D0(2); PV_D0(3);
#undef PV_D0
#undef TRRD
}
__device__ __forceinline__ void store_o(const WV& w, const f32x16* o, const float* tab, bf16_t* outp) {
    bf16_t* lp = outp + (size_t)w.hi * 4096 + w.r32;
#pragma unroll
    for (int r = 0; r < 16; ++r) { const int q = crow(r, w.hi); const float sc = tab[q];
        bf16_t* p = lp; asm volatile("" : "+v"(p));
        p += ((r & 3) + 8 * (r >> 2)) * 1024;
#pragma unroll
        for (int d0 = 0; d0 < 4; ++d0) { const float v = o[d0][r] * sc; const float vn = __shfl_xor(v, 1);
            if ((w.r32 & 1) == 0) *(__attribute__((address_space(1))) unsigned*)(p + d0 * 32) = cvtpk(v, vn); } }
}

template <int MODE>
__device__ __forceinline__ void flash_pass(const WV& w, const bf16_t* Kp, const bf16_t* Vp, int j_lo, int j_hi, const bf16x8 (&qr)[8], int tpos, int tw0, unsigned selmask,
                                           f32x16 (&o)[4], float& m_reg, float& l_reg) {
    float* al_l = (float*)(w.lds + L_WS) + w.wid * 64;
    dma_tile(w, Kp + (size_t)j_lo * 64 * HD, Vp + (size_t)j_lo * 64 * HD, 0);
    if (j_lo + 1 < j_hi) dma_tile(w, Kp + (size_t)(j_lo + 1) * 64 * HD, Vp + (size_t)(j_lo + 1) * 64 * HD, 1);
#define FSTEP(BUF, jj) do { const int jt = (jj);                                                                                  \
        if (jt + 1 < j_hi) asm volatile("s_waitcnt vmcnt(4)" ::: "memory"); else asm volatile("s_waitcnt vmcnt(0)" ::: "memory");   \
        asm volatile("s_waitcnt lgkmcnt(0)" ::: "memory"); __builtin_amdgcn_s_barrier(); asm volatile("" ::: "memory");          \
        if (jt + 2 < j_hi) dma_tile(w, Kp + (size_t)(jt + 2) * 64 * HD, Vp + (size_t)(jt + 2) * 64 * HD, ((BUF) + 2) % 3);         \
        f32x16 p0, p1;                                                                                                           \
        qkt<BUF>(w, qr, p0, p1);                                                                                                 \
        const int kb = jt * 64;                                                                                                  \
        { const float NEG = -__builtin_inff();                                                                                   \
          const bool need = (kb + 63 > tw0) || (MODE == 1 && kb <= tw0 + 31 - 512);                                              \
          if (need) { const int dq = tpos - kb - 4 * w.hi; const unsigned W = (MODE == 1) ? 512u : 0x7fffffffu;                  \
              _Pragma("unroll") for (int r = 0; r < 16; ++r) { const int c = (r & 3) + 8 * (r >> 2); if ((unsigned)(dq - c) >= W) p0[r] = NEG; if ((unsigned)(dq - c - 32) >= W) p1[r] = NEG; } } \
          if (MODE == 0) { const bool sel = (selmask >> jt) & 1u;                                                                \
              if (!__all(sel)) { _Pragma("unroll") for (int r = 0; r < 16; ++r) { p0[r] = sel ? p0[r] : NEG; p1[r] = sel ? p1[r] : NEG; } } } } \
        float pmax = p0[0];                                                                                                      \
        _Pragma("unroll") for (int r = 1; r < 16; ++r) pmax = fmaxf(pmax, p0[r]);                                                \
        _Pragma("unroll") for (int r = 0; r < 16; ++r) pmax = fmaxf(pmax, p1[r]);                                                \
        pmax = swap_max(pmax);                                                                                                   \
        float mn = m_reg, alpha = 1.f;                                                                                           \
        const bool resc = !__all((pmax - m_reg) * SCALE <= 8.f);          \
        if (resc) { mn = fmaxf(m_reg, pmax); alpha = __builtin_amdgcn_exp2f((m_reg - mn) * C2); m_reg = mn; }                     \
        const float mnL = -mn * C2;                                                                                              \
        float ps = 0.f;                                                                                                          \
        _Pragma("unroll") for (int r = 0; r < 16; ++r) { p0[r] = __builtin_amdgcn_exp2f(fmaf(p0[r], C2, mnL)); ps += p0[r]; }    \
        _Pragma("unroll") for (int r = 0; r < 16; ++r) { p1[r] = __builtin_amdgcn_exp2f(fmaf(p1[r], C2, mnL)); ps += p1[r]; }    \
        ps = swap_sum(ps);                                                                                                       \
        l_reg = l_reg * alpha + ps;                                                                                              \
        if (resc) { if (w.hi == 0) al_l[w.r32] = alpha;                                                                          \
            asm volatile("s_waitcnt lgkmcnt(0)" ::: "memory");                                                                   \
            _Pragma("unroll") for (int r = 0; r < 16; ++r) { const float a = al_l[crow(r, w.hi)];                                \
                _Pragma("unroll") for (int d = 0; d < 4; ++d) o[d][r] *= a; } }                                                  \
        bf16x8 pa0, pa1, pa2, pa3;                                                                                               \
        pack_p(p0, p1, pa0, pa1, pa2, pa3);                                                                                      \
        pv_tile<BUF>(o, w.vb0, pa0, pa1, pa2, pa3);                                                                              \
    } while (0)
    int j = j_lo;
    for (; j + 2 < j_hi; j += 3) { FSTEP(0, j); FSTEP(1, j + 1); FSTEP(2, j + 2); }
    if (j < j_hi) { FSTEP(0, j); if (j + 1 < j_hi) FSTEP(1, j + 1); }
#undef FSTEP
    __syncthreads();
}
}

__device__ const unsigned char ATT_ITEMS[80] = {15, 30, 31, 63, 14, 28, 29, 61, 62, 13, 26, 27, 59, 60, 12, 24, 25, 57, 58, 11, 22, 23, 55, 56, 10, 20, 21, 53, 54, 9, 18, 19, 51, 52, 8, 16, 17, 49, 50, 7, 48, 6, 5,
    72, 73, 74, 75, 76, 77, 78, 79, 80, 81, 82, 83, 84, 85, 86, 87, 88, 89, 90, 91, 92, 93, 94, 95, 4, 71, 3, 70, 2, 69, 1, 68, 0, 67, 66, 65, 64};
constexpr int CW_QUEUE = 6144;
constexpr int CW_CVTQ = 6144 + 256;
constexpr int CW_CMPR = 8192 + 2048;

__device__ __forceinline__ void p_attn(const Frame& F, unsigned char* lds_raw, int rep) {
    using namespace att;
    WV w;
#define WV_INIT() do { int ln_ = F.lane; asm volatile("" : "+v"(ln_)); w.tid = F.wave * 64 + ln_; w.wid = F.wave; w.lane = ln_; w.r32 = ln_ & 31; w.hi = ln_ >> 5; \
        w.lds = (char*)lds_raw + 1024; w.ldsL = (LAS unsigned char*)lds_raw + 1024; w.vb0 = (int)(uintptr_t)(w.lds) + att::L_V + v_rd_base(ln_); } while (0)
    WV_INIT();
    const bf16_t* qn = (const bf16_t*)(F.ws + WS_QN); const bf16_t* qrp = (const bf16_t*)(F.ws + WS_QR); const bf16_t* kv = (const bf16_t*)(F.ws + WS_KV);
    const bf16_t* ckv = (const bf16_t*)(F.ws + WS_CMPKV);
    bf16_t* ocmp = (bf16_t*)(F.ws + WS_OCMP); bf16_t* owin = (bf16_t*)(F.ws + WS_OWIN); bf16_t* osel = (bf16_t*)(F.ws + WS_OSEL); float* ml = (float*)(F.ws + WS_ML);
    unsigned* qctr = (unsigned*)(F.ws + WS_CTL) + CW_QUEUE + 64 * rep;
    float* wsf = (float*)(w.lds + L_WS) + w.wid * 64;
    float* part = (float*)(w.lds + L_PART); unsigned* selm = (unsigned*)(w.lds + L_SELM); float* vals = (float*)(w.lds + L_VALS) + w.wid * 64; volatile int* itemw = (volatile int*)(w.lds + L_ITEM);
    const int hr = w.wid >> 1, th = w.wid & 1;
    for (;;) {
        __syncthreads();
        if (F.tid == 0) itemw[0] = (int)atomicAdd(qctr, 1u);
        __syncthreads();
        const int item = itemw[0];
        if (item >= 640) break;
        WV_INIT();
        const int ent = ATT_ITEMS[item >> 3], bg = item & 7, type = ent >> 5, qb = ent & 31, b = bg >> 1, g = bg & 1, h = 4 * g + hr;
        const int t0 = qb * 64 + th * 32, tpos = t0 + w.r32, tok0 = b * SEQ + t0;
        const size_t qoff = (((size_t)b * NH + h) * SEQ + t0 + w.r32) * HD + w.hi * 8;
        const size_t kvoff = ((size_t)b * NG + g) * SEQ * HD;
        bf16x8 qr[8];
        f32x16 o[4];
#ifndef ATT_NO_WIN
        if (type == 2) {
#pragma unroll
            for (int d0 = 0; d0 < 8; ++d0) qr[d0] = *(const bf16x8*)(qrp + qoff + d0 * 16);
#pragma unroll
            for (int d = 0; d < 4; ++d) o[d] = f32x16{};
            float m_reg = -1e30f, l_reg = 0.f;
            flash_pass<1>(w, kv + (size_t)4 * (4 * MB / 2) + kvoff, kv + (size_t)5 * (4 * MB / 2) + kvoff, qb >= 8 ? qb - 8 : 0, qb + 1, qr, tpos, t0, 0u, o, m_reg, l_reg);
            if (w.hi == 0) wsf[w.r32] = 1.f / l_reg;
            asm volatile("s_waitcnt lgkmcnt(0)" ::: "memory");
            store_o(w, o, wsf, owin + (size_t)tok0 * 1024 + h * HD);
            continue;
        }
#endif
#ifndef ATT_NO_CMP
        {
#pragma unroll
            for (int d0 = 0; d0 < 8; ++d0) qr[d0] = *(const bf16x8*)(qn + qoff + d0 * 16);
            const bf16_t* Kc = ckv + (size_t)bg * 128 * HD; const bf16_t* Vc = ckv + (size_t)1024 * HD + (size_t)bg * 128 * HD;
            dma_tile(w, Kc, Vc, 0); dma_tile(w, Kc + 64 * HD, Vc + 64 * HD, 1);
            asm volatile("s_waitcnt vmcnt(0)" ::: "memory");
            __syncthreads();
            f32x16 pA0, pA1, pB0, pB1;
            qkt<0>(w, qr, pA0, pA1); qkt<1>(w, qr, pB0, pB1);
            const int nmax = tpos >= 31 ? ((tpos - 31) >> 4) : -1;
            const float NEG = -__builtin_inff();
            float pmax = NEG;
#pragma unroll
            for (int r = 0; r < 16; ++r) { const int n = crow(r, w.hi);
                pA0[r] = (n <= nmax) ? pA0[r] : NEG; pA1[r] = (n + 32 <= nmax) ? pA1[r] : NEG; pB0[r] = (n + 64 <= nmax) ? pB0[r] : NEG; pB1[r] = (n + 96 <= nmax) ? pB1[r] : NEG;
                pmax = fmaxf(fmaxf(pmax, pA0[r]), fmaxf(pA1[r], fmaxf(pB0[r], pB1[r]))); }
            pmax = swap_max(pmax);
            const float mm = (pmax == NEG) ? 0.f : pmax;
            const float mnL = -mm * C2;
            float ps = 0.f;
#pragma unroll
            for (int r = 0; r < 16; ++r) { pA0[r] = __builtin_amdgcn_exp2f(fmaf(pA0[r], C2, mnL)); pA1[r] = __builtin_amdgcn_exp2f(fmaf(pA1[r], C2, mnL));
                pB0[r] = __builtin_amdgcn_exp2f(fmaf(pB0[r], C2, mnL)); pB1[r] = __builtin_amdgcn_exp2f(fmaf(pB1[r], C2, mnL)); ps += (pA0[r] + pA1[r]) + (pB0[r] + pB1[r]); }
            ps = swap_sum(ps);
            const float inv = ps > 0.f ? 1.f / ps : 0.f;
#pragma unroll
            for (int r = 0; r < 16; ++r) { pA0[r] *= inv; pA1[r] *= inv; pB0[r] *= inv; pB1[r] *= inv; }
            {
                float av[16], bv[16];
#pragma unroll
                for (int gq = 0; gq < 4; ++gq) {
                    av[gq]      = pA0[4 * gq] + pA0[4 * gq + 1] + pA0[4 * gq + 2] + 0.5f * pA0[4 * gq + 3]; bv[gq]      = 0.5f * pA0[4 * gq + 3];
                    av[4 + gq]  = pA1[4 * gq] + pA1[4 * gq + 1] + pA1[4 * gq + 2] + 0.5f * pA1[4 * gq + 3]; bv[4 + gq]  = 0.5f * pA1[4 * gq + 3];
                    av[8 + gq]  = pB0[4 * gq] + pB0[4 * gq + 1] + pB0[4 * gq + 2] + 0.5f * pB0[4 * gq + 3]; bv[8 + gq]  = 0.5f * pB0[4 * gq + 3];
                    av[12 + gq] = pB1[4 * gq] + pB1[4 * gq + 1] + pB1[4 * gq + 2] + 0.5f * pB1[4 * gq + 3]; bv[12 + gq] = 0.5f * pB1[4 * gq + 3];
                }
                float* prow = part + ((size_t)hr * 64 + th * 32 + w.r32) * 33;
#pragma unroll
                for (int idx = 0; idx < 16; ++idx) {
                    const float bo = __shfl_xor(bv[idx], 32);
                    const float bprev = (idx > 0) ? __shfl_xor(bv[idx > 0 ? idx - 1 : 0], 32) : 0.f;
                    const float inc = w.hi ? bo : bprev;
                    prow[2 * idx + w.hi] = av[idx] + inc;
                }
            }
            if (type == 0) {
                bf16x8 pa0, pa1, pa2, pa3;
#pragma unroll
                for (int d = 0; d < 4; ++d) o[d] = f32x16{};
                pack_p(pA0, pA1, pa0, pa1, pa2, pa3); pv_tile<0>(o, w.vb0, pa0, pa1, pa2, pa3);
                pack_p(pB0, pB1, pa0, pa1, pa2, pa3); pv_tile<1>(o, w.vb0, pa0, pa1, pa2, pa3);
                if (w.hi == 0) wsf[w.r32] = 1.f;
                asm volatile("s_waitcnt lgkmcnt(0)" ::: "memory");
                store_o(w, o, wsf, ocmp + (size_t)tok0 * 1024 + h * HD);
            }
            __syncthreads();
#pragma unroll 1
            for (int ps2 = 0; ps2 < 4; ++ps2) {
                int ln = w.lane; asm volatile("" : "+v"(ln));
                const int j = ln & 31, hi2 = ln >> 5;
                const int tk = 8 * w.wid + 2 * ps2 + hi2, t = qb * 64 + tk, cur = qb;
                float imp = 0.f;
#pragma unroll
                for (int r = 0; r < 4; ++r) imp += part[((size_t)r * 64 + tk) * 33 + j];
                const bool ok = (64 * j <= t), forced = (j == 0) || (cur - j >= 0 && cur - j < 2);
                const float val = (ok && forced) ? 1.0e30f : (ok ? imp : -1.0e30f);
                vals[ln] = val;
                asm volatile("s_waitcnt lgkmcnt(0)" ::: "memory");
                int rank = 0;
#pragma unroll
                for (int jj = 0; jj < 32; ++jj) { const float o2 = vals[hi2 * 32 + jj]; rank += (o2 > val || (o2 == val && jj < j)) ? 1 : 0; }
                const unsigned long long bal = __ballot(rank < 16 && val >= 0.f);
                if (w.lane == 0) { selm[8 * w.wid + 2 * ps2] = (unsigned)bal; selm[8 * w.wid + 2 * ps2 + 1] = (unsigned)(bal >> 32); }
            }
            __syncthreads();
        }
#endif
#ifndef ATT_NO_SEL
        {
            WV_INIT();
            const unsigned sm = selm[th * 32 + w.r32];
            const int ntile = qb + 1, hsplit = (ntile + 1) >> 1;
            const int ja = (qb >= 16 && type == 1) ? hsplit : 0, jb = (qb >= 16 && type == 0) ? hsplit : ntile;
#pragma unroll
            for (int d0 = 0; d0 < 8; ++d0) qr[d0] = *(const bf16x8*)(qrp + qoff + d0 * 16);
#pragma unroll
            for (int d = 0; d < 4; ++d) o[d] = f32x16{};
            float m_reg = -1e30f, l_reg = 0.f;
            flash_pass<0>(w, kv + (size_t)2 * (4 * MB / 2) + kvoff, kv + (size_t)3 * (4 * MB / 2) + kvoff, ja, jb, qr, tpos, t0, sm, o, m_reg, l_reg);
            if (w.hi == 0) { wsf[w.r32] = l_reg > 0.f ? 1.f / l_reg : 0.f; float* mp = ml + (((size_t)type * NT + tok0 + w.r32) * NH + h) * 2; mp[0] = m_reg; mp[1] = l_reg; }
            asm volatile("s_waitcnt lgkmcnt(0)" ::: "memory");
            store_o(w, o, wsf, osel + (size_t)type * NT * 1024 + (size_t)tok0 * 1024 + h * HD);
        }
#endif
    }
}

struct CvtTile { const float* src; const float* ksc; bf16_t* dst0; int sld, ldd, mode; };
__device__ __forceinline__ CvtTile cvt_decode(const Frame& F, int t) {
    CvtTile c; c.ksc = nullptr; c.mode = 0;
    if (t < 4096) { const int e = t >> 7, mat = (t >> 6) & 1, kt = (t >> 1) & 31, nt = t & 1;
        c.src = (mat ? F.in[I_WUP] : F.in[I_WGATE]) + ((size_t)e * DM + kt * 64) * FF + nt * 256; c.sld = FF; c.ksc = F.in[I_LNMOE] + kt * 64;
        c.dst0 = (bf16_t*)(F.ws + WS_W1T) + ((size_t)e * 1024 + nt * 512 + mat * 128) * DM + kt * 64; c.ldd = DM; c.mode = 1; return c; }
    t -= 4096;
    if (t < 2048) { const int e = t >> 6, kt = (t >> 3) & 7, nt = t & 7;
        c.src = F.in[I_WDOWN] + ((size_t)e * FF + kt * 64) * DM + nt * 256; c.sld = DM;
        c.dst0 = (bf16_t*)(F.ws + WS_W2T) + ((size_t)e * 2048 + nt * 256) * FF + kt * 64; c.ldd = FF; return c; }
    t -= 2048;
    if (t < 256) { const int kt = t >> 3, nt = t & 7;
        c.src = F.in[I_WOUT] + (size_t)kt * 64 * DM + nt * 256; c.sld = DM; c.dst0 = (bf16_t*)(F.ws + WS_WOUTT) + (size_t)nt * 256 * DM + kt * 64; c.ldd = DM; return c; }
    t -= 256;
    if (t < 480) { const int kt = t / 15, nt = t % 15;
        c.src = F.in[I_WIN] + (size_t)kt * 64 * INW; c.sld = INW; c.ksc = F.in[I_LNMIX] + kt * 64;
        c.dst0 = (bf16_t*)(F.ws + WS_WINT) + (size_t)nt * 256 * DM + kt * 64; c.ldd = DM; c.mode = 2 + nt; return c; }
    t -= 480;
    { const int kv = t >> 6, kt = t & 63;
      c.src = (kv ? F.in[I_WV1] : F.in[I_WK1]) + (size_t)kt * 64 * 256; c.sld = 256; c.dst0 = (bf16_t*)(F.ws + WS_CMPW) + (size_t)kv * 256 * 4096 + kt * 64; c.ldd = 4096; return c; }
}
constexpr int N_CVT_TILES = 4096 + 2048 + 256 + 480 + 128;
__device__ __forceinline__ void cvt_load(const CvtTile& c, int nq, int kq, float4 (&v)[8]) {
    const float* p = c.src + 4 * nq; bool valid = true;
    if (c.mode >= 2) { const int n = (c.mode - 2) * 256 + 4 * nq; int sc = -1; if (n < 2560) sc = n; else if (n < 3584) sc = n + 24; else if (n < 3608) sc = n - 1024; valid = sc >= 0; p = c.src + (valid ? sc : 0); }
#pragma unroll
    for (int i = 0; i < 8; ++i) v[i] = valid ? *(const float4*)(p + (size_t)(kq * 8 + i) * c.sld) : make_float4(0.f, 0.f, 0.f, 0.f);
}

constexpr int CVT_RUN = 4;
__device__ __forceinline__ void cvt_stream(const Frame& F, int t_lo, int t_hi, unsigned* queue, int sfirst = -1, int sstride = 0) {
    if (sfirst < 0) { sfirst = F.bid; sstride = F.G; }
    float* T = F.lds;
    volatile int* nxtw = (volatile int*)(F.lds + 64 * 257);
    const int tid = F.tid, nq = tid & 63, kq = tid >> 6;
    int tA, tB; float4 vA[8], vB[8]; CvtTile cA, cB;
    if (queue) { __syncthreads(); if (tid == 0) { nxtw[0] = t_lo + CVT_RUN * (int)atomicAdd(queue, 1u); nxtw[1] = t_lo + CVT_RUN * (int)atomicAdd(queue, 1u); } __syncthreads(); tA = nxtw[0]; tB = nxtw[1]; }
    else { tA = t_lo + sfirst; tB = tA + sstride; }
    if (tA < t_hi) { cA = cvt_decode(F, tA); cvt_load(cA, nq, kq, vA); }
    if (tB < t_hi) { cB = cvt_decode(F, tB); cvt_load(cB, nq, kq, vB); }
#define CVT_STEP(tX, cX, vX, slot) do {                                                                                                     \
        const bool pop = queue && (((tX) - t_lo) % CVT_RUN == CVT_RUN - 1);                 \
        int tn_reg = 0;                                                                                                                      \
        if (pop && tid == 0) tn_reg = t_lo + CVT_RUN * (int)atomicAdd(queue, 1u);                                                            \
        __syncthreads();                                                                                                                     \
        _Pragma("unroll") for (int i = 0; i < 8; ++i) { const float s = cX.ksc ? cX.ksc[kq * 8 + i] : 1.f; float* tp = T + (kq * 8 + i) * 257 + 4 * nq; \
            tp[0] = vX[i].x * s; tp[1] = vX[i].y * s; tp[2] = vX[i].z * s; tp[3] = vX[i].w * s; }                                           \
        if (pop && tid == 0) nxtw[slot] = tn_reg;                                                                                            \
        __syncthreads();                                                                                                                     \
        const CvtTile cc = cX; const int tn = queue ? (pop ? nxtw[slot] : tX + 1) : tX + 2 * sstride;                                            \
        if (tn < t_hi) { cX = cvt_decode(F, tn); cvt_load(cX, nq, kq, vX); }                                                                 \
        _Pragma("unroll") for (int j = 0; j < 4; ++j) { const int id = tid + 512 * j, n = id >> 3, kc = id & 7; const float* tp = T + (kc * 8) * 257 + n; \
            pg8::u32x4 w; w.x = pg8::cvt_pk_bf16(tp[0], tp[257]); w.y = pg8::cvt_pk_bf16(tp[2 * 257], tp[3 * 257]); w.z = pg8::cvt_pk_bf16(tp[4 * 257], tp[5 * 257]); w.w = pg8::cvt_pk_bf16(tp[6 * 257], tp[7 * 257]); \
            const int rowi = (cc.mode == 1) ? ((n >> 7) * 256 + (n & 127)) : n;                                                              \
            *(pg8::u32x4*)(cc.dst0 + (size_t)rowi * cc.ldd + kc * 8) = w; }                                                                  \
        tX = tn; } while (0)
    while (tA < t_hi) {
        CVT_STEP(tA, cA, vA, 0);
        if (tB >= t_hi) { const int t2 = tA; tA = tB; tB = t2; const CvtTile c2 = cA; cA = cB; cB = c2;
#pragma unroll
            for (int i = 0; i < 8; ++i) { const float4 x = vA[i]; vA[i] = vB[i]; vB[i] = x; }
            continue; }
        CVT_STEP(tB, cB, vB, 1);
    }
    while (tB < t_hi) CVT_STEP(tB, cB, vB, 1);
#undef CVT_STEP
    __syncthreads();
}

__device__ __forceinline__ void p0_tables(const Frame& F, int first, int stride) {
    {
        const float* wp = F.in[I_WPOOL]; const float* ps = F.in[I_PSCALE]; const float* bp = F.in[I_BPOOL]; bf16_t* wpt = (bf16_t*)(F.ws + WS_POOLW); float* pb = (float*)(F.ws + WS_POOLB);
        for (int idx = first * NTHREADS + F.tid; idx < 4 * 256 * 256; idx += stride * NTHREADS) { const int k = idx & 255, n = (idx >> 8) & 255, g = idx >> 16;
            wpt[idx] = f2bf(wp[((size_t)g * 256 + k) * 256 + n] * ps[g * 256 + n]); }
        for (int idx = first * NTHREADS + F.tid; idx < 1024; idx += stride * NTHREADS) pb[idx] = bp[idx] * ps[idx];
    }
    { const float* lnm = F.in[I_LNMOE]; const float* wre = F.in[I_WRE]; const float* wrg = F.in[I_WRG]; float* WRP = (float*)(F.ws + WS_WRP);
      for (int idx = first * NTHREADS + F.tid; idx < DM * 48; idx += stride * NTHREADS) { const int k = idx / 48, c = idx - k * 48;
          WRP[idx] = c < 32 ? lnm[k] * wre[((size_t)(c >> 3) * DM + k) * 8 + (c & 7)] : (c < 36 ? lnm[k] * wrg[k * 4 + (c - 32)] : 0.f); } }
    for (int it = first; it < 256; it += stride) {
        const int kv = it >> 7, jb = (it >> 5) & 3, mc = it & 31;
        const float* pe = (kv ? F.in[I_PEV] : F.in[I_PEK]); const float* w1 = (kv ? F.in[I_WV1] : F.in[I_WK1]);
        const int mg = F.tid >> 6, j = jb * 64 + (F.tid & 63);
        float a = 0.f;
#pragma unroll
        for (int q = 0; q < 16; ++q) { const int m = mc * 128 + mg + 8 * q; a += pe[m] * w1[(size_t)m * 256 + j]; }
        __syncthreads();
        F.lds[F.tid] = a;
        __syncthreads();
        if (F.tid < 64) { float s = 0.f; for (int q = 0; q < 8; ++q) s += F.lds[q * 64 + F.tid]; ((float*)(F.ws + WS_BIAS1))[(mc * 2 + kv) * 256 + j] = s; }
        __syncthreads();
    }
}
__device__ __forceinline__ void p0_prologue(const Frame& F) {
    const float* x = F.in[I_X];
    bf16_t* xb = (bf16_t*)(F.ws + WS_XB); float* rstd1 = (float*)(F.ws + WS_RSTD1);
    const int gw = F.bid * NWAVES + F.wave, nw = F.G * NWAVES, lane = F.lane;
    for (int r = gw; r < NT; r += 2 * nw) {
        const int r2 = r + nw; const bool has2 = r2 < NT;
        float4 v[8], v2[8]; float ss = 0.f, ss2 = 0.f;
#pragma unroll
        for (int i = 0; i < 8; ++i) { v[i] = *(const float4*)(x + (size_t)r * DM + i * 256 + lane * 4); v2[i] = has2 ? *(const float4*)(x + (size_t)r2 * DM + i * 256 + lane * 4) : make_float4(0.f, 0.f, 0.f, 0.f); }
#pragma unroll
        for (int i = 0; i < 8; ++i) { ss += v[i].x * v[i].x + v[i].y * v[i].y + v[i].z * v[i].z + v[i].w * v[i].w; ss2 += v2[i].x * v2[i].x + v2[i].y * v2[i].y + v2[i].z * v2[i].z + v2[i].w * v2[i].w; }
        ss = wave_sum(ss); ss2 = wave_sum(ss2);
        if (lane == 0) { rstd1[r] = rsqrtf(ss * (1.f / DM) + EPS); if (has2) rstd1[r2] = rsqrtf(ss2 * (1.f / DM) + EPS); }
#pragma unroll
        for (int i = 0; i < 8; ++i) { uint2 w; w.x = pg8::cvt_pk_bf16(v[i].x, v[i].y); w.y = pg8::cvt_pk_bf16(v[i].z, v[i].w);
            *(uint2*)(xb + (size_t)r * DM + i * 256 + lane * 4) = w;
            if (has2) { uint2 w2; w2.x = pg8::cvt_pk_bf16(v2[i].x, v2[i].y); w2.y = pg8::cvt_pk_bf16(v2[i].z, v2[i].w); *(uint2*)(xb + (size_t)r2 * DM + i * 256 + lane * 4) = w2; } }
    }
    cvt_stream(F, 6400, N_CVT_TILES, nullptr);
    {
        const int* pos = (const int*)F.in[I_POS]; float* rc = (float*)(F.ws + WS_ROPEC); float* rs = (float*)(F.ws + WS_ROPES);
        for (int idx = F.bid * NTHREADS + F.tid; idx < NB * SEQ * 16; idx += F.G * NTHREADS) {
            const int i = idx & 15, bs = idx >> 4;
            const float inv = exp2f(-(float)i * (1.f / 16.f) * 18.931568569324174f);
            const float ang = (float)pos[bs] * inv;
            rc[idx] = cosf(ang); rs[idx] = sinf(ang);
        }
    }
}

struct EpiProj {
    static constexpr bool AFTER_DRAIN = false;
    const float* rstd1; const float* rc; const float* rs; bf16_t* qn; bf16_t* qr; bf16_t* kv; bf16_t* u; float* gates;
    __device__ __forceinline__ void operator()(const pg8::f32x4 (&acc)[2][2][4][2], const pg8::Unit& un, int wr, int wc, int fr, int fq) const {
        const int pn = un.pn;
#pragma unroll
        for (int ai = 0; ai < 2; ++ai)
#pragma unroll
            for (int m = 0; m < 4; ++m) {
                const int row = un.pm * 256 + ai * 128 + wr * 64 + m * 16 + fr; const float r1 = rstd1[row]; const int b = row >> 11, s = row & 2047;
                if (pn < 10) {
                    const bool ropeu = (pn < 4) || pn == 6 || pn == 8;
                    pg8::f32x4 c4 = {1.f, 1.f, 1.f, 1.f}, s4 = {0.f, 0.f, 0.f, 0.f};
                    if (ropeu && wc == 0) { c4 = *(const pg8::f32x4*)(rc + (size_t)row * 16 + 4 * fq); s4 = *(const pg8::f32x4*)(rs + (size_t)row * 16 + 4 * fq); }
#pragma unroll
                    for (int bj = 0; bj < 2; ++bj) {
                        const pg8::f32x4 v0 = acc[ai][bj][m][0] * r1, v1 = acc[ai][bj][m][1] * r1;
                        const int d0 = 32 * wc + 4 * fq;
                        pg8::f32x4 o0 = v0, o1 = v1;
                        if (ropeu && wc == 0) { o0 = v0 * c4 - v1 * s4; o1 = v1 * c4 + v0 * s4; }
                        uint2 w0, w1; w0.x = pg8::cvt_pk_bf16(o0[0], o0[1]); w0.y = pg8::cvt_pk_bf16(o0[2], o0[3]); w1.x = pg8::cvt_pk_bf16(o1[0], o1[1]); w1.y = pg8::cvt_pk_bf16(o1[2], o1[3]);
                        if (pn < 4) {
                            const size_t o = (((size_t)b * NH + 2 * pn + bj) * SEQ + s) * HD + d0;
                            uint2 n0, n1; n0.x = pg8::cvt_pk_bf16(v0[0], v0[1]); n0.y = pg8::cvt_pk_bf16(v0[2], v0[3]); n1.x = pg8::cvt_pk_bf16(v1[0], v1[1]); n1.y = pg8::cvt_pk_bf16(v1[2], v1[3]);
                            *(uint2*)(qn + o) = n0; *(uint2*)(qn + o + 16) = n1; *(uint2*)(qr + o) = w0; *(uint2*)(qr + o + 16) = w1;
                        } else {
                            const size_t o = (size_t)(pn - 4) * (4 * MB / 2) + (((size_t)b * NG + bj) * SEQ + s) * HD + d0;
                            *(uint2*)(kv + o) = w0; *(uint2*)(kv + o + 16) = w1;
                        }
                    }
                } else if (pn < 14) {
#pragma unroll
                    for (int bj = 0; bj < 2; ++bj)
#pragma unroll
                        for (int n = 0; n < 2; ++n) { const pg8::f32x4 v = acc[ai][bj][m][n] * r1; uint2 w_; w_.x = pg8::cvt_pk_bf16(v[0], v[1]); w_.y = pg8::cvt_pk_bf16(v[2], v[3]);
                            *(uint2*)(u + (size_t)row * 1024 + (pn - 10) * 256 + bj * 128 + wc * 32 + n * 16 + 4 * fq) = w_; }
                } else {
                    if (wc == 0) { *(pg8::f32x4*)(gates + (size_t)row * 24 + 4 * fq) = acc[ai][0][m][0] * r1; if (fq < 2) *(pg8::f32x4*)(gates + (size_t)row * 24 + 16 + 4 * fq) = acc[ai][0][m][1] * r1; }
                }
            }
    }
};

__device__ __forceinline__ void p1_proj(const Frame& F, LAS unsigned char* stage) {
    pg8::DenseOrder S; S.init(F.ws + WS_XB, F.ws + WS_WINT, DM, DM, NT, INWP, F.G, F.bid);
    EpiProj E{(const float*)(F.ws + WS_RSTD1), (const float*)(F.ws + WS_ROPEC), (const float*)(F.ws + WS_ROPES), (bf16_t*)(F.ws + WS_QN), (bf16_t*)(F.ws + WS_QR), (bf16_t*)(F.ws + WS_KV),
              (bf16_t*)(F.ws + WS_U), (float*)(F.ws + WS_GATES)};
    pg8::gemm_phase<EpiProj, pg8::DenseOrder, false>(stage, DM, DM, DM, S, E);
}

__device__ __forceinline__ void p4_cmp2(const Frame& F, int first, int stride, bool gated) {
    const float* part = (const float*)(F.ws + WS_CPART); const float* bias1p = (const float*)(F.ws + WS_BIAS1); bf16_t* ckv = (bf16_t*)(F.ws + WS_CMPKV);
    float* H = F.lds;
    float* W2 = F.lds + 8 * 260;
    unsigned* ctl = (unsigned*)(F.ws + WS_CTL);
    int w2_of = -1;
    for (int it = first; it < 256; it += stride) {
        const int kvi = it >> 7, r0 = (it & 127) * 8; const float* w2 = kvi ? F.in[I_WV2] : F.in[I_WK2];
        __syncthreads();
        if (gated && F.tid == 0) { unsigned* cw = ctl + CW_CMPR + 64 * (kvi * 4 + (r0 >> 8)); unsigned sp = 0;
            while (__hip_atomic_load(cw, __ATOMIC_RELAXED, __HIP_MEMORY_SCOPE_AGENT) < 8u) { __builtin_amdgcn_s_sleep(2);
                if ((++sp & 255u) == 0u) { if (xb_ld(&ctl[XB_TMO])) break; if (sp > XB_SPIN_CAP) { atomicAdd(&ctl[XB_TMO], 1u); break; } } }
            __builtin_amdgcn_fence(__ATOMIC_ACQUIRE, "agent"); asm volatile("s_waitcnt vmcnt(0)" ::: "memory"); }
        if (gated) __syncthreads();
        if (w2_of != kvi) {
#pragma unroll
            for (int j = 0; j < 16; ++j) { const int idx = F.tid + 512 * j; *(pg8::f32x4*)(W2 + idx * 4) = *(const pg8::f32x4*)(w2 + idx * 4); }
            w2_of = kvi;
        }
        { const int r = F.tid >> 6, c = (F.tid & 63) * 4;
            pg8::f32x4 s = {0.f, 0.f, 0.f, 0.f};
#pragma unroll
            for (int sp = 0; sp < 8; ++sp) s += *(const pg8::f32x4*)(part + (((size_t)sp * 2 + kvi) * 1024 + r0 + r) * 256 + c);
#pragma unroll
            for (int sp = 0; sp < 32; ++sp) s += *(const pg8::f32x4*)(bias1p + (sp * 2 + kvi) * 256 + c);
            H[r * 260 + c] = gelu_tanh(s[0]); H[r * 260 + c + 1] = gelu_tanh(s[1]); H[r * 260 + c + 2] = gelu_tanh(s[2]); H[r * 260 + c + 3] = gelu_tanh(s[3]); }
        __syncthreads();
        const int r = F.tid >> 6, c0 = (F.tid & 63) * 2;
        float a0 = 0.f, a1 = 0.f;
#pragma unroll 16
        for (int k = 0; k < 256; ++k) { const float hv = H[r * 260 + k]; const float2 wv = *(const float2*)(W2 + k * 128 + c0); a0 += hv * wv.x; a1 += hv * wv.y; }
        const int R = r0 + r; const bool pad = (R & 127) == 127;
        *(unsigned*)(ckv + ((size_t)kvi * 1024 + R) * 128 + c0) = pad ? 0u : pg8::cvt_pk_bf16(a0, a1);
    }
}

struct CmpOrder {
    const char* kc; const char* w1t; int c;
    __device__ __forceinline__ bool next(int i, pg8::Unit& u) const { if (i > 0) return false; u.e = c >> 5; u.pm = (c >> 3) & 3; u.pn = c & 7; u.li = 0; return true; }
    __device__ __forceinline__ const char* a_base(const pg8::Unit& u) const { return kc + (size_t)u.e * 4 * MB + ((size_t)u.pm * 256 * 2048 + u.pn * 512) * 2; }
    __device__ __forceinline__ const char* b_base(const pg8::Unit& u) const { return w1t + ((size_t)u.e * 256 * 4096 + u.pn * 512) * 2; }
    __device__ __forceinline__ unsigned a_row_off(const pg8::Unit&, int r) const { return (unsigned)r * 4096u; }
};
struct EpiCmp {
    static constexpr bool AFTER_DRAIN = false;
    float* part;
    __device__ __forceinline__ void operator()(const pg8::f32x4 (&acc)[2][2][4][2], const pg8::Unit& un, int wr, int wc, int fr, int fq) const {
        float* base = part + (((size_t)un.pn * 2 + un.e) * 1024 + un.pm * 256) * 256;
#pragma unroll
        for (int ai = 0; ai < 2; ++ai)
#pragma unroll
            for (int m = 0; m < 4; ++m) { float* rowp = base + (size_t)(ai * 128 + wr * 64 + m * 16 + fr) * 256 + wc * 32 + 4 * fq;
#pragma unroll
                for (int bj = 0; bj < 2; ++bj)
#pragma unroll
                    for (int n = 0; n < 2; ++n) *(pg8::f32x4*)(rowp + bj * 128 + n * 16) = acc[ai][bj][m][n]; }
    }
};
struct PoolOrder {
    const char* d; const char* wpt; int c;
    __device__ __forceinline__ bool next(int i, pg8::Unit& u) const { if (i > 0) return false; u.pm = c >> 2; u.pn = 0; u.e = c & 3; u.li = 0; return true; }
    __device__ __forceinline__ const char* a_base(const pg8::Unit& u) const { return d + ((size_t)u.pm * 256 * 1024 + u.e * 256) * 2; }
    __device__ __forceinline__ const char* b_base(const pg8::Unit& u) const { return wpt + (size_t)u.e * 256 * 256 * 2; }
    __device__ __forceinline__ unsigned a_row_off(const pg8::Unit&, int r) const { return (unsigned)r * 2048u; }
};
struct EpiPool {
    static constexpr bool AFTER_DRAIN = false;
    const float* pb; bf16_t* opool;
    __device__ __forceinline__ void operator()(const pg8::f32x4 (&acc)[2][2][4][2], const pg8::Unit& un, int wr, int wc, int fr, int fq) const {
#pragma unroll
        for (int ai = 0; ai < 2; ++ai)
#pragma unroll
            for (int m = 0; m < 4; ++m) { const int row = un.pm * 256 + ai * 128 + wr * 64 + m * 16 + fr;
#pragma unroll
                for (int bj = 0; bj < 2; ++bj)
#pragma unroll
                    for (int n = 0; n < 2; ++n) { const int c = un.e * 256 + bj * 128 + wc * 32 + n * 16 + 4 * fq;
                        const pg8::f32x4 v = acc[ai][bj][m][n] + *(const pg8::f32x4*)(pb + c); uint2 w_; w_.x = pg8::cvt_pk_bf16(v[0], v[1]); w_.y = pg8::cvt_pk_bf16(v[2], v[3]);
                        *(uint2*)(opool + (size_t)row * 1024 + c) = w_; } }
    }
};
__device__ __forceinline__ void p2a_mid(const Frame& F, LAS unsigned char* stage) {
    if (F.bid < 64) {
        CmpOrder S{(const char*)(F.ws + WS_KV), (const char*)(F.ws + WS_CMPW), F.bid};
        EpiCmp E{(float*)(F.ws + WS_CPART)};
        pg8::gemm_phase<EpiCmp, CmpOrder, false>(stage, 512, 2048, 4096, S, E);
    } else {
        const bf16_t* u = (const bf16_t*)(F.ws + WS_U); bf16_t* d = (bf16_t*)(F.ws + WS_DBUF);
        for (int ch = F.bid - 64; ch < NT / 16; ch += F.G - 64) {
            const int r0 = ch * 16, s0 = r0 & 2047, col = 2 * F.tid, w = 2 << (col >> 8);
            float u0[31], u1[31];
#pragma unroll
            for (int q = 0; q < 31; ++q) { const int s = s0 - 15 + q; const unsigned pr = (s >= 0) ? *(const unsigned*)(u + (size_t)(r0 - 15 + q) * 1024 + col) : 0u;
                u0[q] = __uint_as_float(pr << 16); u1[q] = __uint_as_float(pr & 0xFFFF0000u); }
#pragma unroll
            for (int i = 0; i < 16; ++i) { float sa = 0.f, sb = 0.f;
#pragma unroll
                for (int q = 0; q < 16; ++q) if (q < w) { sa += u0[15 + i - q]; sb += u1[15 + i - q]; }
                const int s = s0 + i, cnt = (s + 1 < w) ? s + 1 : w; const float ic = 1.f / (float)cnt;
                *(unsigned*)(d + (size_t)(r0 + i) * 1024 + col) = pg8::cvt_pk_bf16(sa * ic - u0[15 + i], sb * ic - u1[15 + i]); }
        }
        p0_tables(F, F.bid - 64, F.G - 64);
    }
}
__device__ __forceinline__ void p2b_mid(const Frame& F, LAS unsigned char* stage) {
    if (F.bid < 128) {
        PoolOrder S{(const char*)(F.ws + WS_DBUF), (const char*)(F.ws + WS_POOLW), F.bid};
        EpiPool E{(const float*)(F.ws + WS_POOLB), (bf16_t*)(F.ws + WS_OPOOL)};
        pg8::gemm_phase<EpiPool, PoolOrder, false>(stage, 256, 1024, 256, S, E);
    } else {
        p4_cmp2(F, F.bid - 128, F.G - 128, false);
        cvt_stream(F, 6144, 6400, nullptr, F.bid - 128, F.G - 128);
    }
}

__device__ __forceinline__ void unpack8(const pg8::u32x4 w, float (&f)[8]) {
    f[0] = __uint_as_float(w.x << 16); f[1] = __uint_as_float(w.x & 0xFFFF0000u); f[2] = __uint_as_float(w.y << 16); f[3] = __uint_as_float(w.y & 0xFFFF0000u);
    f[4] = __uint_as_float(w.z << 16); f[5] = __uint_as_float(w.z & 0xFFFF0000u); f[6] = __uint_as_float(w.w << 16); f[7] = __uint_as_float(w.w & 0xFFFF0000u);
}
__device__ __forceinline__ void p6_mix(const Frame& F) {
    const bf16_t* ocmp = (const bf16_t*)(F.ws + WS_OCMP); const bf16_t* owin = (const bf16_t*)(F.ws + WS_OWIN); const bf16_t* osel = (const bf16_t*)(F.ws + WS_OSEL);
    const float* ml = (const float*)(F.ws + WS_ML); const float* gates = (const float*)(F.ws + WS_GATES);
    const bf16_t* opool = (const bf16_t*)(F.ws + WS_OPOOL); bf16_t* mix = (bf16_t*)(F.ws + WS_MIX);
    const float* gn = F.in[I_GNNSA]; const float* gp = F.in[I_GNPOOL];
    const int gw = F.bid * NWAVES + F.wave, nw = F.G * NWAVES, lane = F.lane, h = lane >> 3;
    for (int r = gw; r < NT; r += nw) {
        const bool split = ((r & 2047) >> 6) >= 16;
        const size_t o = (size_t)r * 1024 + lane * 16;
        const float* gq = gates + (size_t)r * 24 + h * 3;
        const float g0 = 1.f / (1.f + __expf(-gq[0])), g1 = 1.f / (1.f + __expf(-gq[1])), g2 = 1.f / (1.f + __expf(-gq[2]));
        float w0 = 1.f, w1 = 0.f;
        if (split) { const float* m0p = ml + ((size_t)r * NH + h) * 2; const float* m1p = ml + (((size_t)NT + r) * NH + h) * 2;
            const float m0 = m0p[0], l0 = m0p[1], m1 = m1p[0], l1 = m1p[1], M = fmaxf(m0, m1);
            const float a0 = l0 * exp2f((m0 - M) * att::C2), a1 = l1 * exp2f((m1 - M) * att::C2), inv = 1.f / (a0 + a1); w0 = a0 * inv; w1 = a1 * inv; }
        float a[16], p[16]; float sa = 0.f, sp = 0.f;
#pragma unroll
        for (int hf = 0; hf < 2; ++hf) {
            float c8[8], w8[8], s8[8], t8[8];
            unpack8(*(const pg8::u32x4*)(ocmp + o + hf * 8), c8); unpack8(*(const pg8::u32x4*)(owin + o + hf * 8), w8); unpack8(*(const pg8::u32x4*)(osel + o + hf * 8), s8);
            if (split) unpack8(*(const pg8::u32x4*)(osel + (size_t)NT * 1024 + o + hf * 8), t8);
#pragma unroll
            for (int j = 0; j < 8; ++j) { const float os = split ? (w0 * s8[j] + w1 * t8[j]) : s8[j]; a[hf * 8 + j] = g0 * c8[j] + g1 * os + g2 * w8[j]; sa += a[hf * 8 + j] * a[hf * 8 + j]; }
        }
#pragma unroll
        for (int q = 0; q < 2; ++q) { float p8[8]; unpack8(*(const pg8::u32x4*)(opool + o + q * 8), p8);
#pragma unroll
            for (int j = 0; j < 8; ++j) { p[q * 8 + j] = p8[j]; sp += p8[j] * p8[j]; } }
        sa = wave_sum(sa); sp = wave_sum(sp);
        const float ra = rsqrtf(sa * (1.f / 1024.f) + EPS), rp = rsqrtf(sp * (1.f / 1024.f) + EPS);
        float ga[16], gb[16];
#pragma unroll
        for (int q = 0; q < 4; ++q) { const pg8::f32x4 v = *(const pg8::f32x4*)(gn + lane * 16 + q * 4), u = *(const pg8::f32x4*)(gp + lane * 16 + q * 4);
            ga[q * 4] = v[0]; ga[q * 4 + 1] = v[1]; ga[q * 4 + 2] = v[2]; ga[q * 4 + 3] = v[3]; gb[q * 4] = u[0]; gb[q * 4 + 1] = u[1]; gb[q * 4 + 2] = u[2]; gb[q * 4 + 3] = u[3]; }
#pragma unroll
        for (int hf = 0; hf < 2; ++hf) { pg8::u32x4 wa, wb;
            wa.x = pg8::cvt_pk_bf16(a[hf * 8] * ra * ga[hf * 8], a[hf * 8 + 1] * ra * ga[hf * 8 + 1]); wa.y = pg8::cvt_pk_bf16(a[hf * 8 + 2] * ra * ga[hf * 8 + 2], a[hf * 8 + 3] * ra * ga[hf * 8 + 3]);
            wa.z = pg8::cvt_pk_bf16(a[hf * 8 + 4] * ra * ga[hf * 8 + 4], a[hf * 8 + 5] * ra * ga[hf * 8 + 5]); wa.w = pg8::cvt_pk_bf16(a[hf * 8 + 6] * ra * ga[hf * 8 + 6], a[hf * 8 + 7] * ra * ga[hf * 8 + 7]);
            wb.x = pg8::cvt_pk_bf16(p[hf * 8] * rp * gb[hf * 8], p[hf * 8 + 1] * rp * gb[hf * 8 + 1]); wb.y = pg8::cvt_pk_bf16(p[hf * 8 + 2] * rp * gb[hf * 8 + 2], p[hf * 8 + 3] * rp * gb[hf * 8 + 3]);
            wb.z = pg8::cvt_pk_bf16(p[hf * 8 + 4] * rp * gb[hf * 8 + 4], p[hf * 8 + 5] * rp * gb[hf * 8 + 5]); wb.w = pg8::cvt_pk_bf16(p[hf * 8 + 6] * rp * gb[hf * 8 + 6], p[hf * 8 + 7] * rp * gb[hf * 8 + 7]);
            *(pg8::u32x4*)(mix + (size_t)r * DM + lane * 16 + hf * 8) = wa; *(pg8::u32x4*)(mix + (size_t)r * DM + 1024 + lane * 16 + hf * 8) = wb; }
    }
}

struct EpiOut {
    static constexpr bool AFTER_DRAIN = true;
    const float* x; float* out; bf16_t* x1b; const float* lnm; const float* wrp; float* pl;
    __device__ __forceinline__ void fused(pg8::f32x4 (&acc)[2][2][4][2], const pg8::Unit& un, int wr, int wc, int fr, int fq, LAS unsigned char* lds) const {
#pragma unroll
        for (int ai = 0; ai < 2; ++ai)
#pragma unroll
            for (int m = 0; m < 4; ++m) {
                const int row = un.pm * 256 + ai * 128 + wr * 64 + m * 16 + fr;
#pragma unroll
                for (int bj = 0; bj < 2; ++bj)
#pragma unroll
                    for (int n = 0; n < 2; ++n) {
                        const size_t o = (size_t)row * DM + un.pn * 256 + bj * 128 + wc * 32 + n * 16 + 4 * fq;
                        const pg8::f32x4 v = acc[ai][bj][m][n] + *(const pg8::f32x4*)(x + o);
                        acc[ai][bj][m][n] = v;
                        *(pg8::f32x4*)(out + o) = v;
                        const pg8::f32x4 g = *(const pg8::f32x4*)(lnm + un.pn * 256 + bj * 128 + wc * 32 + n * 16 + 4 * fq);
                        uint2 w; w.x = pg8::cvt_pk_bf16(v[0] * g[0], v[1] * g[1]); w.y = pg8::cvt_pk_bf16(v[2] * g[2], v[3] * g[3]); *(uint2*)(x1b + o) = w;
                    }
            }
        float* red = (float*)((unsigned char*)lds);
        const int tid = threadIdx.x;
#pragma unroll 1
        for (int ai = 0; ai < 2; ++ai) {
#pragma unroll
            for (int m = 0; m < 4; ++m) {
                pg8::f32x4 D0 = {0.f, 0.f, 0.f, 0.f}, D1 = D0, D2 = D0; float s2 = 0.f;
#pragma unroll
                for (int bj = 0; bj < 2; ++bj)
#pragma unroll
                    for (int n = 0; n < 2; ++n) {
                        const pg8::f32x4 v = (ai == 0) ? acc[0][bj][m][n] : acc[1][bj][m][n];
                        s2 += v[0] * v[0] + v[1] * v[1] + v[2] * v[2] + v[3] * v[3];
                        const float* wb = wrp + (size_t)(un.pn * 256 + bj * 128 + wc * 32 + n * 16 + 4 * fq) * 48 + fr;
#pragma unroll
                        for (int j = 0; j < 4; ++j) {
                            D0 = __builtin_amdgcn_mfma_f32_16x16x4f32(v[j], wb[j * 48], D0, 0, 0, 0);
                            D1 = __builtin_amdgcn_mfma_f32_16x16x4f32(v[j], wb[j * 48 + 16], D1, 0, 0, 0);
                            D2 = __builtin_amdgcn_mfma_f32_16x16x4f32(v[j], wb[j * 48 + 32], D2, 0, 0, 0);
                        }
                    }
                s2 += __shfl_xor(s2, 16); s2 += __shfl_xor(s2, 32);
                float* rr = red + ((size_t)wc * 128 + wr * 64 + m * 16) * 40;
#pragma unroll
                for (int r = 0; r < 4; ++r) { float* q = rr + (4 * fq + r) * 40; q[fr] = D0[r]; q[16 + fr] = D1[r]; if (fr < 8) q[32 + fr] = D2[r]; }
                if (fq == 0) rr[fr * 40 + 36] = s2;
            }
            __syncthreads();
            for (int idx = tid; idx < 128 * 40; idx += 512) { const int r = idx / 40, c = idx - r * 40;
                const float s = (red[idx] + red[128 * 40 + idx]) + (red[2 * 128 * 40 + idx] + red[3 * 128 * 40 + idx]);
                if (c < 37) pl[((size_t)un.pn * NT + un.pm * 256 + ai * 128 + r) * 40 + c] = s; }
            __syncthreads();
        }
    }
};
__device__ __forceinline__ void p7_out(const Frame& F, LAS unsigned char* stage) {
    pg8::DenseOrder S; S.init(F.ws + WS_MIX, F.ws + WS_WOUTT, DM, DM, NT, DM, F.G, F.bid);
    EpiOut E{F.in[I_X], F.out, (bf16_t*)(F.ws + WS_X1B), F.in[I_LNMOE], (const float*)(F.ws + WS_WRP), (float*)(F.ws + WS_PL)};
    pg8::gemm_phase<EpiOut, pg8::DenseOrder, false>(stage, DM, DM, DM, S, E);
}

__device__ __forceinline__ void p8_router(const Frame& F, int dummy) {
    const float* pl = (const float*)(F.ws + WS_PL); const float* brg = F.in[I_BRG]; const float* bre = F.in[I_BRE];
    float* rstd2 = (float*)(F.ws + WS_RSTD2); int* arow = (int*)(F.ws + WS_AROW); int* tokl = (int*)(F.ws + WS_TOKL); float* gatel = (float*)(F.ws + WS_GATEL);
    unsigned* cnt = (unsigned*)(F.ws + WS_CTL) + CW_CNT; (void)dummy;
    const int gw = F.bid * NWAVES + F.wave, nw = F.G * NWAVES, lane = F.lane, tl = lane >> 3, pn = lane & 7;
    for (int wv = gw; wv < NT / 8; wv += nw) {
        const int r = wv * 8 + tl;
        const float* p = pl + ((size_t)pn * NT + r) * 40;
        float v[37];
#pragma unroll
        for (int q = 0; q < 9; ++q) { const pg8::f32x4 t = *(const pg8::f32x4*)(p + 4 * q); v[4 * q] = t[0]; v[4 * q + 1] = t[1]; v[4 * q + 2] = t[2]; v[4 * q + 3] = t[3]; }
        v[36] = p[36];
#pragma unroll
        for (int c = 0; c < 37; ++c) { v[c] += __shfl_xor(v[c], 1); v[c] += __shfl_xor(v[c], 2); v[c] += __shfl_xor(v[c], 4); }
        if (pn == 0) {
            const float rs = rsqrtf(v[36] * (1.f / DM) + EPS);
            float lg[4];
#pragma unroll
            for (int j = 0; j < 4; ++j) lg[j] = v[32 + j] * rs + brg[j];
            int gs = 0; float gm = lg[0];
#pragma unroll
            for (int j = 1; j < 4; ++j) if (lg[j] > gm) { gm = lg[j]; gs = j; }
            float den = 0.f;
#pragma unroll
            for (int j = 0; j < 4; ++j) den += __expf(lg[j] - gm);
            const float pg = 1.f / den;
            float le[8];
#pragma unroll
            for (int j = 0; j < 8; ++j) { const float s = (gs == 0) ? v[j] : (gs == 1) ? v[8 + j] : (gs == 2) ? v[16 + j] : v[24 + j]; le[j] = s * rs + bre[gs * 8 + j]; }
            int e0 = 0; float m0 = le[0];
#pragma unroll
            for (int j = 1; j < 8; ++j) if (le[j] > m0) { m0 = le[j]; e0 = j; }
            int e1 = -1; float m1 = -3.0e38f;
#pragma unroll
            for (int j = 0; j < 8; ++j) if (j != e0 && le[j] > m1) { m1 = le[j]; e1 = j; }
            const float p1 = __expf(m1 - m0);
            const float gate0 = pg / (1.f + p1), gate1 = pg * p1 / (1.f + p1);
            rstd2[r] = rs;
            const int ea = gs * 8 + e0, eb = gs * 8 + e1;
            const unsigned sa = atomicAdd(&cnt[64 * ea], 1u), sb = atomicAdd(&cnt[64 * eb], 1u);
            tokl[ea * 8192 + sa] = r; gatel[ea * 8192 + sa] = gate0; tokl[eb * 8192 + sb] = r; gatel[eb * 8192 + sb] = gate1;
            arow[2 * r] = ea * 8192 + (int)sa; arow[2 * r + 1] = eb * 8192 + (int)sb;
        }
    }
}

__device__ __forceinline__ void moe_counts(const Frame& F, int* cnts  , int* pst  ) {
    const unsigned* cnt = (const unsigned*)(F.ws + WS_CTL) + CW_CNT;
    __syncthreads();
    if (F.tid < 32) cnts[F.tid] = (int)__hip_atomic_load(&cnt[64 * F.tid], __ATOMIC_RELAXED, __HIP_MEMORY_SCOPE_AGENT);
    __syncthreads();
    if (F.tid == 0) { int a = 0; for (int e = 0; e < 32; ++e) { pst[e] = a; a += (cnts[e] + 255) & ~255; } pst[32] = a; }
    __syncthreads();
}

constexpr int MOE_TAB_OFF = 1024 + 131072;
struct MoeTabs { int* cnts; int* pst; int* ust; int* usth; int* rowtok; };
__device__ __forceinline__ MoeTabs moe_tabs(unsigned char* lds_raw) { MoeTabs T; T.cnts = (int*)(lds_raw + MOE_TAB_OFF); T.pst = T.cnts + 32; T.ust = T.pst + 40; T.usth = T.ust + 40; T.rowtok = T.usth + 40; return T; }
template <int NTN> __device__ __forceinline__ void moe_units(const Frame& F, const MoeTabs& T) {
    moe_counts(F, T.cnts, T.pst);
    if (F.tid == 0) { int a = 0, h = 0; for (int e = 0; e < 32; ++e) { const int c = T.cnts[e], nmt = (c + 255) >> 8, hl = (nmt > 0 && c - 256 * (nmt - 1) <= 128) ? 1 : 0;
            T.ust[e] = a; T.usth[e] = h; a += (nmt - hl) * NTN; h += hl * NTN; } T.ust[32] = a; T.usth[32] = h; }
    __syncthreads();
}
template <int NTN> struct MoeOrder2 {
    const int* cnts; const int* pst; const int* ust; const int* usth; const int* rowtok; const bf16_t* A; const float* W0; const float* W1; int G, c, lda, ldb, gather;
    __device__ __forceinline__ bool next(int i, g2::Unit& u) const {
        int L = i * G + c; u.li = i;
        if (L < ust[32]) {
            int e = 0; while (ust[e + 1] <= L) ++e;
            const int w = L - ust[e], c_ = cnts[e], nmt = (c_ + 255) >> 8, nf = nmt - ((c_ - 256 * (nmt - 1) <= 128) ? 1 : 0);
            u.e = e; u.pn = w / nf; u.pm = w - u.pn * nf; u.half = 0; return true; }
        L -= ust[32]; if (L >= usth[32]) return false;
        int e = 0; while (usth[e + 1] <= L) ++e;
        u.e = e; u.pn = L - usth[e]; u.pm = ((cnts[e] + 255) >> 8) - 1; u.half = 1; return true;
    }
    __device__ __forceinline__ int nvalid(const g2::Unit& u) const { const int v = cnts[u.e] - u.pm * 256; return v < 256 ? v : 256; }
    __device__ __forceinline__ unsigned a_off(const g2::Unit& u, int r) const {
        if (gather) { const int tk = rowtok[u.li * 256 + r]; return (unsigned)(tk < 0 ? 0 : tk) * (unsigned)lda * 2u; }
        return (unsigned)(pst[u.e] + u.pm * 256 + r) * (unsigned)lda * 2u;
    }
    __device__ __forceinline__ const float* b_col(const g2::Unit& u, int col) const {
        if (gather) { const int wcp = col >> 5, n = (col >> 4) & 1, i = col & 15; return (n ? W1 : W0) + (size_t)u.e * DM * FF + u.pn * 64 + 16 * wcp + i; }
        return W0 + (size_t)u.e * FF * DM + u.pn * 128 + col;
    }
};
struct EpiMoe1 {
    const int* pst; const int* rowtok; const float* rstd2; bf16_t* act;
    __device__ __forceinline__ void operator()(const pg8::f32x4 (&acc)[2][4][2], const g2::Unit& un, int wr, int wc, int fr, int fq) const {
#pragma unroll
        for (int ai = 0; ai < 2; ++ai)
#pragma unroll
            for (int m = 0; m < 4; ++m) {
                const int r = ai * 128 + wr * 64 + m * 16 + fr; const int tk = rowtok[un.li * 256 + r];
                if (tk >= 0) {
                    const float rs = rstd2[tk];
                    const pg8::f32x4 vg = acc[ai][m][0] * rs, vu = acc[ai][m][1] * rs; float o[4];
#pragma unroll
                    for (int j = 0; j < 4; ++j) o[j] = vg[j] / (1.f + __expf(-vg[j])) * vu[j];
                    uint2 w; w.x = pg8::cvt_pk_bf16(o[0], o[1]); w.y = pg8::cvt_pk_bf16(o[2], o[3]);
                    *(uint2*)(act + (size_t)(pst[un.e] + un.pm * 256 + r) * FF + un.pn * 64 + wc * 16 + 4 * fq) = w;
                }
            }
    }
};
struct EpiMoe2 {
    const int* cnts; const int* pst; const float* gatel; bf16_t* y;
    __device__ __forceinline__ void operator()(const pg8::f32x4 (&acc)[2][4][2], const g2::Unit& un, int wr, int wc, int fr, int fq) const {
#pragma unroll
        for (int ai = 0; ai < 2; ++ai)
#pragma unroll
            for (int m = 0; m < 4; ++m) {
                const int slot = un.pm * 256 + ai * 128 + wr * 64 + m * 16 + fr;
                if (slot < cnts[un.e]) {
                    const float gt = gatel[un.e * 8192 + slot];
                    bf16_t* dst = y + (size_t)(pst[un.e] + slot) * DM + un.pn * 128 + wc * 32 + 4 * fq;
#pragma unroll
                    for (int n = 0; n < 2; ++n) { const pg8::f32x4 v = acc[ai][m][n] * gt; uint2 w; w.x = pg8::cvt_pk_bf16(v[0], v[1]); w.y = pg8::cvt_pk_bf16(v[2], v[3]); *(uint2*)(dst + n * 16) = w; }
                }
            }
    }
};

__device__ __forceinline__ void p9_moe1(const Frame& F, unsigned char* lds_raw, LAS unsigned char* stage) {
    const MoeTabs T = moe_tabs(lds_raw);
    moe_units<8>(F, T);
    const int vc = (F.G % 8 == 0) ? (F.bid % 8) * (F.G / 8) + F.bid / 8 : F.bid;
    MoeOrder2<8> S{T.cnts, T.pst, T.ust, T.usth, T.rowtok, (const bf16_t*)(F.ws + WS_X1B), F.in[I_WGATE], F.in[I_WUP], F.G, vc, DM, FF, 1};
    { const int* tokl = (const int*)(F.ws + WS_TOKL); g2::Unit u;
      for (int i = 0; i < 4 && S.next(i, u); ++i) { if (F.tid < 256) { const int slot = u.pm * 256 + F.tid; T.rowtok[i * 256 + F.tid] = slot < T.cnts[u.e] ? tokl[u.e * 8192 + slot] : -1; } } }
    asm volatile("s_waitcnt vmcnt(0) lgkmcnt(0)" ::: "memory");
    __syncthreads();
    EpiMoe1 E{T.pst, T.rowtok, (const float*)(F.ws + WS_RSTD2), (bf16_t*)(F.ws + WS_ACT)};
    g2::gemm<DM / 64, EpiMoe1, MoeOrder2<8>>(stage, S, E, F.wave, (PROBE_REPEAT >= 30 && PROBE_REPEAT <= 33) ? (unsigned long long*)(lds_raw + 512) : nullptr);
}

__device__ __forceinline__ void p10_moe2(const Frame& F, unsigned char* lds_raw, LAS unsigned char* stage) {
    const MoeTabs T = moe_tabs(lds_raw);
    moe_units<16>(F, T);
    const int vc = (F.G % 8 == 0) ? (F.bid % 8) * (F.G / 8) + F.bid / 8 : F.bid;
    MoeOrder2<16> S{T.cnts, T.pst, T.ust, T.usth, nullptr, (const bf16_t*)(F.ws + WS_ACT), F.in[I_WDOWN], nullptr, F.G, vc, FF, DM, 0};
    EpiMoe2 E{T.cnts, T.pst, (const float*)(F.ws + WS_GATEL), (bf16_t*)(F.ws + WS_Y)};
    g2::gemm<FF / 64, EpiMoe2, MoeOrder2<16>>(stage, S, E, F.wave);
}

__device__ __forceinline__ void p11_final(const Frame& F, int dummy) {
    int* cnts = (int*)(F.lds + 3072); int* pst = cnts + 32;
    moe_counts(F, cnts, pst);
    const bf16_t* y = (const bf16_t*)(F.ws + WS_Y); const int* arow = (const int*)(F.ws + WS_AROW); const float* lnf = F.in[I_LNFINAL];
    const int gw = F.bid * NWAVES + F.wave, nw = F.G * NWAVES, lane = fresh_lane();
    for (int r = gw; r < NT; r += nw) {
        const int a0 = arow[2 * r], a1 = arow[2 * r + 1];
        const size_t r0 = (size_t)(pst[a0 >> 13] + (a0 & 8191)), r1 = (size_t)(pst[a1 >> 13] + (a1 & 8191));
        float v[32]; float ss = 0.f;
#pragma unroll
        for (int i = 0; i < 8; ++i) { const int c = i * 256 + lane * 4; const float4 xv = *(const float4*)(F.out + (size_t)r * DM + c);
            const uint2 ya = *(const uint2*)(y + r0 * DM + c), yb = *(const uint2*)(y + r1 * DM + c);
            v[4 * i]     = xv.x + __uint_as_float(ya.x << 16) + __uint_as_float(yb.x << 16);
            v[4 * i + 1] = xv.y + __uint_as_float(ya.x & 0xFFFF0000u) + __uint_as_float(yb.x & 0xFFFF0000u);
            v[4 * i + 2] = xv.z + __uint_as_float(ya.y << 16) + __uint_as_float(yb.y << 16);
            v[4 * i + 3] = xv.w + __uint_as_float(ya.y & 0xFFFF0000u) + __uint_as_float(yb.y & 0xFFFF0000u);
            ss += v[4 * i] * v[4 * i] + v[4 * i + 1] * v[4 * i + 1] + v[4 * i + 2] * v[4 * i + 2] + v[4 * i + 3] * v[4 * i + 3]; }
        ss = wave_sum(ss);
        const float rs = rsqrtf(ss * (1.f / DM) + EPS);
#pragma unroll
        for (int i = 0; i < 8; ++i) { const int c = i * 256 + lane * 4; const float4 g = *(const float4*)(lnf + c);
            float4 o; o.x = v[4 * i] * rs * g.x; o.y = v[4 * i + 1] * rs * g.y; o.z = v[4 * i + 2] * rs * g.z; o.w = v[4 * i + 3] * rs * g.w;
            *(float4*)((dummy ? (float*)(F.ws + WS_W1T) : F.out) + (size_t)r * DM + c) = o; }
    }
}

constexpr int NPHASE = 11;
__global__ void __launch_bounds__(NTHREADS, 2) fwd(Args args) {
    extern __shared__ __attribute__((aligned(16))) unsigned char lds_raw[];
    Frame F;
#pragma unroll
    for (int i = 0; i < N_IN; ++i) F.in[i] = args.in[i];
    F.out = args.out; F.ws = args.ws;
    F.lds = (float*)(lds_raw + 16);
    F.tid = threadIdx.x; F.lane = F.tid & 63; F.wave = __builtin_amdgcn_readfirstlane(F.tid >> 6); F.G = gridDim.x; F.bid = blockIdx.x;
    if (F.tid < 4) ((LAS unsigned*)lds_raw)[F.tid] = 0u;
    __syncthreads();
    XcdBarrier bar; bar.bar = (unsigned*)(F.ws + WS_CTL); bar.x = 0; bar.st = nullptr;
    if (N_LAUNCHES == 1) bar = xcd_barrier_post((unsigned*)(F.ws + WS_CTL), (volatile LAS unsigned*)lds_raw);
    bar.wave = F.wave;
    const int lo = args.ph_lo, hi = args.ph_hi;
#ifndef ONLY_PHASE
#define ONLY_PHASE -1
#endif
#define IN(k) (lo <= (k) && (k) < hi && (ONLY_PHASE < 0 || ONLY_PHASE == (k)))
#define SEAM(k) do { if (IN(k) && IN((k) + 1)) { const unsigned long long tb_ = (PROBE_REPEAT >= 40) ? (unsigned long long)__builtin_readcyclecounter() : 0ull; xcd_barrier(bar); if (PROBE_REPEAT == 12) xcd_barrier(bar); \
        if (PROBE_REPEAT == 40 || PROBE_REPEAT == 41 + (k)) tbar += (unsigned long long)__builtin_readcyclecounter() - tb_; if (PROBE_REPEAT == 60 + (k)) tbar = (unsigned long long)__builtin_readcyclecounter() - t_k0; } } while (0)
    unsigned long long tbar = 0ull; const unsigned long long t_k0 = (PROBE_REPEAT >= 60) ? (unsigned long long)__builtin_readcyclecounter() : 0ull;
    LAS unsigned char* stage = (LAS unsigned char*)lds_raw + 1024;
#define RUN(k, ...) do { if (IN(k)) { __VA_ARGS__; if (PROBE_REPEAT == (k)) { xcd_barrier(bar); __VA_ARGS__; } } } while (0)
    RUN(0, p0_prologue(F));
    if (PROBE_REPEAT == 11 && IN(0)) { xcd_barrier(bar); cvt_stream(F, 0, 6400, nullptr); }
    SEAM(0);
    RUN(1, p1_proj(F, stage));
    SEAM(1);
    RUN(2, p2a_mid(F, stage));
    SEAM(2);
    RUN(3, p2b_mid(F, stage));
    SEAM(3);
    if (IN(4)) {
#pragma unroll 1
        for (int rep = 0; rep < (PROBE_REPEAT == 4 ? 2 : 1); ++rep) { if (rep) xcd_barrier(bar); p_attn(F, lds_raw, rep); } }
    SEAM(4);
    RUN(5, p6_mix(F));
    SEAM(5);
    RUN(6, p7_out(F, stage));
    SEAM(6);
    if (IN(7)) { if (PROBE_REPEAT == 7) { p8_router(F, 1); xcd_barrier(bar); } p8_router(F, 0); }
    SEAM(7);
#define REFRESH_LANE() do { F.lane = fresh_lane(); F.tid = F.wave * 64 + F.lane; } while (0)
    REFRESH_LANE();
    if (IN(8)) {
#pragma unroll 1
        for (int rep = 0; rep < (PROBE_REPEAT == 8 ? 2 : 1); ++rep) { if (rep) xcd_barrier(bar); p9_moe1(F, lds_raw, stage); } }
    SEAM(8);
    REFRESH_LANE();
    if (IN(9)) {
#pragma unroll 1
        for (int rep = 0; rep < (PROBE_REPEAT == 9 ? 2 : 1); ++rep) { if (rep) xcd_barrier(bar); p10_moe2(F, lds_raw, stage); } }
    SEAM(9);
    REFRESH_LANE();
    if (IN(10)) { if (PROBE_REPEAT == 10) { p11_final(F, 1); xcd_barrier(bar); } const unsigned long long tf0 = (PROBE_REPEAT == 70) ? (unsigned long long)__builtin_readcyclecounter() : 0ull; p11_final(F, 0); if (PROBE_REPEAT == 70) tbar = (unsigned long long)__builtin_readcyclecounter() - tf0; }
#undef RUN
    if (PROBE_REPEAT >= 40 && blockIdx.x == PROBE_WG && threadIdx.x == 0) *(volatile unsigned long long*)(lds_raw + 512) = tbar;
    if (((PROBE_REPEAT >= 30 && PROBE_REPEAT <= 33) || PROBE_REPEAT >= 40) && blockIdx.x == PROBE_WG && threadIdx.x == 0) {
        const unsigned long long want = 4ull * *(volatile unsigned long long*)(lds_raw + 512), t0 = __builtin_readcyclecounter();
        while ((unsigned long long)__builtin_readcyclecounter() - t0 < want) __builtin_amdgcn_s_sleep(8);
    }
#undef IN
#undef SEAM
}

extern "C" void kernel_launch(void* const* d_in, const int* in_sizes, int n_in, void* d_out, int out_size, void* d_ws, size_t ws_size, hipStream_t stream) {
    static int grid = 0;
    if (grid == 0) {
        if (n_in != N_IN || out_size != NT * DM || ws_size < WS_END) { fprintf(stderr, "kernel_launch: unexpected shapes: n_in %d out %d ws %zu (need %zu)\n", n_in, out_size, ws_size, (size_t)WS_END); grid = -1; return; }
        int dev = 0, cus = 0, per_cu = 0;
        if (hipGetDevice(&dev) != hipSuccess || hipDeviceGetAttribute(&cus, hipDeviceAttributeMultiprocessorCount, dev) != hipSuccess) { grid = -1; return; }
        if (hipFuncSetAttribute((const void*)fwd, hipFuncAttributeMaxDynamicSharedMemorySize, LDS_BYTES) != hipSuccess) { fprintf(stderr, "kernel_launch: hipFuncSetAttribute failed\n"); grid = -1; return; }
        if (hipOccupancyMaxActiveBlocksPerMultiprocessor(&per_cu, (const void*)fwd, NTHREADS, LDS_BYTES) != hipSuccess || per_cu < 1) { fprintf(stderr, "kernel_launch: occupancy query says %d\n", per_cu); }
        (void)hipGetLastError();
        grid = cus;
    }
    if (grid < 0) return;
    (void)in_sizes;
    (void)hipMemsetAsync((char*)d_ws + WS_CTL, 0, CTL_ZERO_BYTES, stream);
    Args a{};
    for (int i = 0; i < N_IN; ++i) a.in[i] = (const float*)d_in[i];
    a.out = (float*)d_out; a.ws = (unsigned char*)d_ws;
    if (N_LAUNCHES == 1) { a.ph_lo = 0; a.ph_hi = NPHASE; hipLaunchKernelGGL(fwd, dim3(grid), dim3(NTHREADS), LDS_BYTES, stream, a); }
    else { for (int p = 0; p < NPHASE; ++p) { a.ph_lo = p; a.ph_hi = p + 1; hipLaunchKernelGGL(fwd, dim3(grid), dim3(NTHREADS), LDS_BYTES, stream, a); } }
}
```

```cpp
#include <hip/hip_runtime.h>
#include <cstdio>
#include <cstdint>

#ifndef PROBE_REPEAT
#define PROBE_REPEAT -1
#endif
#ifndef MERGE_CMP2
#define MERGE_CMP2 0
#endif
#ifndef PROBE_WG
#define PROBE_WG 0
#endif
#ifndef N_LAUNCHES
#define N_LAUNCHES 1
#endif

#define XB_TMO      128
#define XB_XCNT(j)  (256  + 64 * (j))
#define XB_XSUB(j)  (1280 + 64 * (j))
#define XB_XGEN(j)  (2304 + 64 * (j))
#define XB_TOP      3328
#define XB_TOPGEN   3392
#define XCD_BAR_WORDS 3456
#define XB_SPIN_CAP (1u << 21)
#define LAS __attribute__((address_space(3)))

__device__ __forceinline__ unsigned xb_ld(unsigned* p)              { return __hip_atomic_load(p, __ATOMIC_RELAXED, __HIP_MEMORY_SCOPE_AGENT); }
__device__ __forceinline__ unsigned xb_add(unsigned* p, unsigned v) { return __hip_atomic_fetch_add(p, v, __ATOMIC_RELAXED, __HIP_MEMORY_SCOPE_AGENT); }
__device__ __forceinline__ unsigned xb_xcc_id() { return (unsigned)__builtin_amdgcn_s_getreg((3 << 11) | 20) & 0xFu; }
#define XB_SPIN(cond, bar) do { unsigned _sp = 0; while (cond) { __builtin_amdgcn_s_sleep(1); \
    if ((++_sp & 255u) == 0u) { if (xb_ld(&(bar)[XB_TMO])) break; if (_sp > XB_SPIN_CAP) { atomicAdd(&(bar)[XB_TMO], 1u); break; } } } } while (0)

struct XcdBarrier { unsigned* bar; unsigned x; volatile LAS unsigned* st; int wave; };

__device__ __forceinline__ XcdBarrier xcd_barrier_post(unsigned* bar, volatile LAS unsigned* st) {
    XcdBarrier b; b.bar = bar; b.x = xb_xcc_id(); b.st = st;
    if (threadIdx.x == 0) (void)xb_add(&bar[XB_XCNT(b.x)], 1u);
    return b;
}
__device__ __forceinline__ void xcd_barrier_complete(unsigned* bar, unsigned x, unsigned& nloc, unsigned& nx) {
    const unsigned G = gridDim.x * gridDim.y * gridDim.z;
    unsigned sum, cnt, mine, sp = 0u;
    for (;;) {
        sum = 0u; cnt = 0u; mine = 0u;
#pragma unroll
        for (unsigned j = 0; j < 16; ++j) { const unsigned c = xb_ld(&bar[XB_XCNT(j)]); sum += c; cnt += (c > 0u) ? 1u : 0u; mine = (j == x) ? c : mine; }
        if (sum == G) break;
        __builtin_amdgcn_s_sleep(1);
        if ((++sp & 255u) == 0u) { if (xb_ld(&bar[XB_TMO])) break; if (sp > XB_SPIN_CAP) { atomicAdd(&bar[XB_TMO], 1u); break; } }
    }
    nloc = mine > 0u ? mine : 1u; nx = cnt > 0u ? cnt : 1u;
}
__device__ __forceinline__ int fresh_lane();
__device__ __forceinline__ void xcd_barrier(const XcdBarrier& b) {
    asm volatile("s_waitcnt vmcnt(0)" ::: "memory");
    __syncthreads();
    if (b.wave == 0 && fresh_lane() == 0) {
        unsigned* bar = b.bar;
        __builtin_amdgcn_s_waitcnt(0);
        unsigned nloc = b.st[0], nx = b.st[1];
        if (nloc == 0u) { xcd_barrier_complete(bar, b.x, nloc, nx); b.st[0] = nloc; b.st[1] = nx; }
        const unsigned old = xb_add(&bar[XB_XSUB(b.x)], 1u);
        const unsigned gen = old / nloc;
        if (old + 1u == (gen + 1u) * nloc) {
            __builtin_amdgcn_fence(__ATOMIC_RELEASE, "agent");
            asm volatile("s_waitcnt vmcnt(0)" ::: "memory");
            const unsigned og = xb_add(&bar[XB_TOP], 1u);
            const unsigned tg = og / nx;
            if (og + 1u == (tg + 1u) * nx) xb_add(&bar[XB_TOPGEN], 1u);
            else XB_SPIN(xb_ld(&bar[XB_TOPGEN]) == tg, bar);
            __builtin_amdgcn_fence(__ATOMIC_ACQUIRE, "agent");
            xb_add(&bar[XB_XGEN(b.x)], 1u);
            asm volatile("s_waitcnt vmcnt(0)" ::: "memory");
        } else {
            XB_SPIN(xb_ld(&bar[XB_XGEN(b.x)]) == gen, bar);
            __builtin_amdgcn_fence(__ATOMIC_ACQUIRE, "agent");
            asm volatile("s_waitcnt vmcnt(0)" ::: "memory");
        }
    }
    __syncthreads();
}

typedef unsigned short bf16_t;
constexpr int NB = 4, SEQ = 2048, DM = 2048, NT = NB * SEQ;
constexpr int NH = 8, NG = 2, HD = 128, INW = 3608, INWP = 3840;
constexpr int NCMP = 127, NSEL = 32, NEXP = 32, FF = 512;
constexpr float EPS = 1e-6f;
constexpr float SCALE = 0.08838834764831845f;
constexpr int NTHREADS = 512, NWAVES = 8;
constexpr int LDS_BYTES = 147456;
constexpr int YROWS = 24576;

enum { I_X = 0, I_POS, I_LNMIX, I_WIN, I_PEK, I_WK1, I_WK2, I_PEV, I_WV1, I_WV2, I_WPOOL, I_BPOOL, I_PSCALE, I_GNNSA, I_GNPOOL, I_WOUT, I_LNMOE,
       I_WRG, I_BRG, I_WRE, I_BRE, I_WGATE, I_WUP, I_WDOWN, I_LNFINAL, N_IN };

constexpr size_t MB = 1024 * 1024;
constexpr size_t WS_CTL   = 0;
constexpr size_t CTL_ZERO_BYTES = 65536;
constexpr int    CW_CNT   = 4096;
constexpr size_t WS_RSTD1 = 1 * MB;
constexpr size_t WS_RSTD2 = 1 * MB + 65536;
constexpr size_t WS_BIAS1 = 1 * MB + 131072;
constexpr size_t WS_AROW  = 1 * MB + 262144;
constexpr size_t WS_WR    = 1 * MB + 393216;
constexpr size_t WS_WG4   = 1 * MB + 655360;
constexpr size_t WS_WRP   = 32 * MB;
constexpr size_t WS_PL    = 40 * MB;
constexpr size_t WS_ROPEC = 2 * MB;
constexpr size_t WS_ROPES = 2 * MB + 524288;
constexpr size_t WS_GATES = 3 * MB;
constexpr size_t WS_TOKL  = 4 * MB;
constexpr size_t WS_GATEL = 5 * MB;
constexpr size_t WS_HID   = 6 * MB;
constexpr size_t WS_CMPKV = 8 * MB;
constexpr size_t WS_WINT  = 9 * MB;
constexpr size_t WS_WOUTT = 24 * MB;
constexpr size_t WS_W1T   = 32 * MB;
constexpr size_t WS_W2T   = 160 * MB;
constexpr size_t WS_CMPW  = 224 * MB;
constexpr size_t WS_POOLW = 228 * MB;
constexpr size_t WS_POOLB = 228 * MB + 524288;
constexpr size_t WS_CPART = 447 * MB;
constexpr size_t WS_DBUF  = 463 * MB;
constexpr size_t WS_XB    = 230 * MB;
constexpr size_t WS_QN    = 262 * MB;
constexpr size_t WS_QR    = 278 * MB;
constexpr size_t WS_KV    = 294 * MB;
constexpr size_t WS_U     = 319 * MB;
constexpr size_t WS_Y     = 230 * MB;
constexpr size_t WS_OWIN  = 351 * MB;
constexpr size_t WS_OCMP  = 367 * MB;
constexpr size_t WS_OSEL  = 319 * MB;
constexpr size_t WS_ML    = 6 * MB;
constexpr size_t WS_X1B   = 351 * MB;
constexpr size_t WS_OPOOL = 383 * MB;
constexpr size_t WS_ACT   = 383 * MB;
constexpr size_t WS_MIX   = 415 * MB;
constexpr size_t WS_END   = 479 * MB;

__device__ __forceinline__ bf16_t f2bf(float f) { unsigned u = __float_as_uint(f); u += 0x7FFFu + ((u >> 16) & 1u); return (bf16_t)(u >> 16); }
__device__ __forceinline__ float bf2f(bf16_t b) { return __uint_as_float(((unsigned)b) << 16); }
__device__ __forceinline__ float wave_sum(float v) {
#pragma unroll
    for (int o = 32; o >= 1; o >>= 1) v += __shfl_xor(v, o);
    return v;
}
__device__ __forceinline__ float wave_max(float v) {
#pragma unroll
    for (int o = 32; o >= 1; o >>= 1) v = fmaxf(v, __shfl_xor(v, o));
    return v;
}

__device__ __forceinline__ int fresh_lane() { int l; asm volatile("v_mbcnt_lo_u32_b32 %0, -1, 0\n\tv_mbcnt_hi_u32_b32 %0, -1, %0" : "=v"(l)); return l; }
struct Args { const float* in[N_IN]; float* out; unsigned char* ws; int ph_lo, ph_hi; };

struct Frame {
    const float* in[N_IN]; float* out; unsigned char* ws;
    float* lds;
    int tid, lane, wave, G, bid;
};

__device__ __forceinline__ float gelu_tanh(float x) { const float u = 0.7978845608028654f * (x + 0.044715f * x * x * x); return 0.5f * x * (1.f + tanhf(u)); }


namespace pg8 {
typedef short bf16x8 __attribute__((ext_vector_type(8)));
typedef float f32x4 __attribute__((ext_vector_type(4)));
typedef unsigned u32x4 __attribute__((ext_vector_type(4)));
constexpr int BM = 256, BK = 64, HALF = 128, HTB = HALF * BK * 2, STAGE_BYTES = 8 * HTB, NXCD = 8, WGM = 8;
__device__ __forceinline__ int lds_byte(int r, int c) { const int st = (r >> 4) * 2 + (c >> 5), rr = r & 15, cc = c & 31, ob = rr * 64 + cc * 2; return st * 1024 + (ob ^ (((ob >> 9) & 1) << 5)); }
__device__ __forceinline__ void stage_rc(int b, int& R, int& C) { const int st = b / 1024, sb = b % 1024, swz = sb ^ (((sb >> 9) & 1) << 5); R = (st >> 1) * 16 + swz / 64; C = (st & 1) * 32 + (swz % 64) / 2; }
struct Unit { int pm, pn, e, li; };
__device__ __forceinline__ unsigned cvt_pk_bf16(float lo, float hi) { unsigned r; asm volatile("v_cvt_pk_bf16_f32 %0, %1, %2" : "=v"(r) : "v"(lo), "v"(hi)); return r; }

struct DenseOrder {
    const char* A; const char* Bt; int lda, ldb; int nM, nN, nwg, G, c;
    __device__ void init(const void* A_, const void* Bt_, int lda_, int ldb_, int M, int N, int G_, int c_) { A = (const char*)A_; Bt = (const char*)Bt_; lda = lda_; ldb = ldb_; nM = M / BM; nN = N / BM; nwg = nM * nN; G = G_; c = c_; }
    __device__ __forceinline__ bool next(int i, Unit& u) const {
        const long L = (long)i * G + c; if (L >= nwg) return false;
        int wgid = (int)L; { const int q = nwg / NXCD, r = nwg % NXCD, xcd = wgid % NXCD, off = wgid / NXCD; wgid = (xcd < r ? xcd * (q + 1) : r * (q + 1) + (xcd - r) * q) + off; }
        const int nig = WGM * nN, gid = wgid / nig, fm = gid * WGM, gsz = (nM - fm) < WGM ? (nM - fm) : WGM;
        u.pm = fm + ((wgid % nig) % gsz); u.pn = (wgid % nig) / gsz; u.e = 0; u.li = i; return true;
    }
    __device__ __forceinline__ const char* a_base(const Unit& u) const { return A + (size_t)u.pm * BM * lda * 2; }
    __device__ __forceinline__ const char* b_base(const Unit& u) const { return Bt + (size_t)u.pn * BM * ldb * 2; }
    __device__ __forceinline__ unsigned a_row_off(const Unit&, int r) const { return (unsigned)r * (unsigned)lda * 2u; }
};

template <class Epi, class Sched, bool GATHER>
__device__ __forceinline__ void gemm_phase(LAS unsigned char* lds, const int K, const int lda, const int ldb, const Sched& S, const Epi& E) {
    const int tid = threadIdx.x, wid = __builtin_amdgcn_readfirstlane(tid >> 6), lane = tid & 63, wr = wid >> 2, wc = wid & 3, fr = lane & 15, fq = lane >> 4;
    const int nt = K / BK;
    int sR[2], sC[2];
#pragma unroll
    for (int i = 0; i < 2; ++i) stage_rc(tid * 16 + i * 8192, sR[i], sC[i]);
    unsigned voffB[2], voffA[2][2], nvoffA[2][2];
#pragma unroll
    for (int i = 0; i < 2; ++i) voffB[i] = (unsigned)(sR[i] * ldb + sC[i]) * 2u;
    const size_t kstep = (size_t)(BK * 2);
    const size_t hstepB = (size_t)HALF * ldb * 2;
    const unsigned ldsw = (unsigned)wid * 1024u;
    const int aoff = lds_byte(wr * 64 + fr, fq * 8), boff = lds_byte(wc * 32 + fr, fq * 8);
#define PG8_SA(b, h) (((b) * 2 + (h)) * HTB)
#define PG8_SB(b, h) ((4 + (b) * 2 + (h)) * HTB)
#define PG8_STAGE(bufoff, gbase, voff) do { _Pragma("unroll") for (int _i = 0; _i < 2; ++_i) \
        __builtin_amdgcn_global_load_lds((const unsigned*)((const char*)(gbase) + (voff)[_i]), (LAS unsigned*)(lds + (bufoff) + ldsw + _i * 8192), 16, 0, 0); } while (0)
#define PG8_LDA(dst, b, h) do { _Pragma("unroll") for (int m = 0; m < 4; ++m) _Pragma("unroll") for (int k = 0; k < 2; ++k) dst[m][k] = *(const LAS bf16x8*)(lds + PG8_SA(b, h) + aoff + m * 2048 + k * 1024); } while (0)
#define PG8_LDB(dst, b, h) do { _Pragma("unroll") for (int n = 0; n < 2; ++n) _Pragma("unroll") for (int k = 0; k < 2; ++k) dst[n][k] = *(const LAS bf16x8*)(lds + PG8_SB(b, h) + boff + n * 2048 + k * 1024); } while (0)
#define PG8_MMA(ai, bj, At, Bt) do { __builtin_amdgcn_s_setprio(1); _Pragma("unroll") for (int m = 0; m < 4; ++m) _Pragma("unroll") for (int n = 0; n < 2; ++n) _Pragma("unroll") for (int k = 0; k < 2; ++k) \
        { acc[ai][bj][m][n] = __builtin_amdgcn_mfma_f32_16x16x32_bf16(Bt[n][k], At[m][k], acc[ai][bj][m][n], 0, 0, 0); if (PROBE_REPEAT == 21) dummy = __builtin_amdgcn_mfma_f32_16x16x32_bf16(Bt[n][k], At[m][k], dummy, 0, 0, 0); } __builtin_amdgcn_s_setprio(0); } while (0)
#define PG8_WAIT_V(n) asm volatile("s_waitcnt vmcnt(" #n ")" ::: "memory")
#define PG8_WAIT_L(n) asm volatile("s_waitcnt lgkmcnt(" #n ")" ::: "memory")
#define PG8_BAR __builtin_amdgcn_s_barrier()
#define PG8_SCHED __builtin_amdgcn_sched_barrier(0)
#define PG8_AOFFS(dst, u) do { _Pragma("unroll") for (int _h = 0; _h < 2; ++_h) _Pragma("unroll") for (int _i = 0; _i < 2; ++_i) dst[_h][_i] = S.a_row_off(u, _h * HALF + sR[_i]) + (unsigned)sC[_i] * 2u; } while (0)
    Unit cur, nxt; int ui = 0;
    if (!S.next(0, cur)) return;
    f32x4 acc[2][2][4][2];
#pragma unroll
    for (int a = 0; a < 2; ++a)
#pragma unroll
        for (int b = 0; b < 2; ++b)
#pragma unroll
            for (int m = 0; m < 4; ++m)
#pragma unroll
                for (int n = 0; n < 2; ++n) acc[a][b][m][n] = (f32x4){0.f, 0.f, 0.f, 0.f};
    bf16x8 At[4][2], B0[2][2], B1[2][2]; f32x4 dummy = {0.f, 0.f, 0.f, 0.f};
    const char* cA = S.a_base(cur); const char* cB = S.b_base(cur);
    PG8_AOFFS(voffA, cur);
    PG8_STAGE(PG8_SB(0, 0), cB, voffB); PG8_STAGE(PG8_SA(0, 0), cA, voffA[0]); PG8_STAGE(PG8_SB(0, 1), cB + hstepB, voffB); PG8_STAGE(PG8_SA(0, 1), cA, voffA[1]);
    if (wr == 1) PG8_BAR;
    PG8_WAIT_V(4); PG8_BAR;
    PG8_STAGE(PG8_SB(1, 0), cB + kstep, voffB); PG8_STAGE(PG8_SA(1, 0), cA + kstep, voffA[0]); PG8_STAGE(PG8_SB(1, 1), cB + hstepB + kstep, voffB);
    PG8_WAIT_V(6); PG8_BAR;
    for (;;) {
        const bool has_next = S.next(ui + 1, nxt);
        const char* nA = has_next ? S.a_base(nxt) : cA; const char* nB = has_next ? S.b_base(nxt) : cB;
        if (GATHER) { if (has_next) { PG8_AOFFS(nvoffA, nxt); } else {
#pragma unroll
            for (int _h = 0; _h < 2; ++_h)
#pragma unroll
                for (int _i = 0; _i < 2; ++_i) nvoffA[_h][_i] = voffA[_h][_i]; } }
        for (int t = 0; t < nt; t += 2) {
            const bool last = (t == nt - 2);
            const char* a1 = cA + (size_t)(t + 1) * kstep;
            const char* a2 = last ? nA : cA + (size_t)(t + 2) * kstep; const char* b2 = last ? nB : cB + (size_t)(t + 2) * kstep;
            const char* a3 = a2 + kstep; const char* b3 = b2 + kstep;
            unsigned vA2[2][2];
#pragma unroll
            for (int _h = 0; _h < 2; ++_h)
#pragma unroll
                for (int _i = 0; _i < 2; ++_i) vA2[_h][_i] = (GATHER && last) ? nvoffA[_h][_i] : voffA[_h][_i];
            PG8_LDB(B0, 0, 0); PG8_SCHED; PG8_LDA(At, 0, 0); PG8_STAGE(PG8_SA(1, 1), a1, voffA[1]);
            PG8_WAIT_L(8); PG8_BAR; PG8_WAIT_L(0); PG8_MMA(0, 0, At, B0); PG8_BAR; PG8_SCHED;
            PG8_LDB(B1, 0, 1); PG8_STAGE(PG8_SB(0, 0), b2, voffB);
            PG8_BAR; PG8_WAIT_L(0); PG8_MMA(0, 1, At, B1); PG8_BAR;
            PG8_LDA(At, 0, 1); PG8_STAGE(PG8_SA(0, 0), a2, vA2[0]);
            PG8_BAR; PG8_WAIT_L(0); PG8_MMA(1, 0, At, B0); PG8_BAR; PG8_SCHED;
            PG8_STAGE(PG8_SB(0, 1), b2 + hstepB, voffB);
            PG8_WAIT_V(6); PG8_BAR; PG8_MMA(1, 1, At, B1); PG8_BAR;
            PG8_LDB(B0, 1, 0); PG8_SCHED; PG8_LDA(At, 1, 0); PG8_STAGE(PG8_SA(0, 1), a2, vA2[1]);
            PG8_WAIT_L(8); PG8_BAR; PG8_WAIT_L(0); PG8_MMA(0, 0, At, B0); PG8_BAR; PG8_SCHED;
            PG8_LDB(B1, 1, 1); PG8_STAGE(PG8_SB(1, 0), b3, voffB);
            PG8_BAR; PG8_WAIT_L(0); PG8_MMA(0, 1, At, B1); PG8_BAR;
            PG8_LDA(At, 1, 1); PG8_STAGE(PG8_SA(1, 0), a3, vA2[0]);
            PG8_BAR; PG8_WAIT_L(0); PG8_MMA(1, 0, At, B0); PG8_BAR; PG8_SCHED;
            PG8_STAGE(PG8_SB(1, 1), b3 + hstepB, voffB);
            PG8_WAIT_V(6); PG8_BAR; PG8_MMA(1, 1, At, B1); PG8_BAR;
        }
        if constexpr (!Epi::AFTER_DRAIN) E(acc, cur, wr, wc, fr, fq);
        if (!has_next) break;
#pragma unroll
        for (int a = 0; a < 2; ++a)
#pragma unroll
            for (int b = 0; b < 2; ++b)
#pragma unroll
                for (int m = 0; m < 4; ++m)
#pragma unroll
                    for (int n = 0; n < 2; ++n) acc[a][b][m][n] = (f32x4){0.f, 0.f, 0.f, 0.f};
        cur = nxt; cA = nA; cB = nB; ++ui;
        if (GATHER) {
#pragma unroll
            for (int _h = 0; _h < 2; ++_h)
#pragma unroll
                for (int _i = 0; _i < 2; ++_i) voffA[_h][_i] = nvoffA[_h][_i]; }
    }
    if (PROBE_REPEAT == 21) asm volatile("" :: "v"(dummy));
    PG8_WAIT_V(0);
    if (wr == 0) PG8_BAR;
    PG8_BAR;
    if constexpr (Epi::AFTER_DRAIN) E.fused(acc, cur, wr, wc, fr, fq, lds);
#undef PG8_SA
#undef PG8_SB
#undef PG8_STAGE
#undef PG8_LDA
#undef PG8_LDB
#undef PG8_MMA
#undef PG8_WAIT_V
#undef PG8_WAIT_L
#undef PG8_BAR
#undef PG8_SCHED
#undef PG8_AOFFS
}
}


namespace g2 {
using pg8::bf16x8; using pg8::f32x4; using pg8::lds_byte; using pg8::cvt_pk_bf16;
typedef short s16x4 __attribute__((ext_vector_type(4)));
constexpr int A_BYTES = 32768, B_BYTES = 16384, STG = A_BYTES + B_BYTES;
struct Unit { int e, pm, pn, li, half; };
template <int NT_, class Epi, class Sched>
__device__ __forceinline__ void gemm(LAS unsigned char* lds, const Sched& S, const Epi& E, const int wave_, unsigned long long* tprobe = nullptr) {
#if defined(__HIP_DEVICE_COMPILE__)
    const int wid = wave_, lane = fresh_lane(), tid = wid * 64 + lane, wr = wid >> 2, wc = wid & 3, fr = lane & 15, fq = lane >> 4;
    constexpr int nt = NT_;
    unsigned long long tacc = 0ull;
#define TCK() ((PROBE_REPEAT >= 30 && PROBE_REPEAT <= 33) ? (unsigned long long)__builtin_readcyclecounter() : 0ull)
    const unsigned long long t_all0 = TCK();
    const int awoff0 = lds_byte((tid >> 3) & 127, (tid & 7) * 8);
    const int bkr = tid >> 5, bnq = tid & 31;
    const int bwoff0 = A_BYTES + bkr * 256 + ((((bnq >> 2)) ^ ((bkr & 3) | (((bkr >> 3) & 1) << 2))) * 32) + (bnq & 3) * 8;
#define awoff(j) (awoff0 + ((j) & 1) * 8192 + ((j) >> 1) * 16384)
#define bwoff(j) (bwoff0 + (j) * 4096)
    const int aoff = lds_byte(wr * 64 + fr, fq * 8);
    int boff[2];
    { const int q = (lane >> 2) & 3, p = lane & 3, f = q | ((fq & 1) << 2);
#pragma unroll
      for (int n = 0; n < 2; ++n) boff[n] = A_BYTES + (8 * fq + q) * 256 + (((2 * wc + n) ^ f) * 32) + 8 * p; }
    const int ldsb = (int)(uintptr_t)lds;
    Unit u, un;
    if (!S.next(0, u)) return;
    unsigned pa[4], pan[4]; const float* pb; const float* pbn;
    const size_t bstep = (size_t)16 * S.ldb;
#define G2_PTRS(PA, PB, U) do { _Pragma("unroll") for (int j = 0; j < 4; ++j) { const int id = tid + 512 * j; PA[j] = S.a_off(U, id >> 3) + (unsigned)(id & 7) * 16u; } PB = S.b_col(U, 4 * bnq) + (size_t)bkr * S.ldb; } while (0)
    G2_PTRS(pa, pb, u);
    f32x4 acc[2][4][2];
#pragma unroll
    for (int a = 0; a < 2; ++a)
#pragma unroll
        for (int m = 0; m < 4; ++m)
#pragma unroll
            for (int n = 0; n < 2; ++n) acc[a][m][n] = (f32x4){0.f, 0.f, 0.f, 0.f};
    f32x4 dummy = {0.f, 0.f, 0.f, 0.f};
    bf16x8 ra0[4], ra1[4]; f32x4 rb0[4], rb1[4];
    bool hf = u.half != 0; const bool hfn = false; (void)hfn; int nvalid = S.nvalid(u);
#define G2_LOADA(RA, PA, HF, t) do { _Pragma("unroll") for (int j = 0; j < 4; ++j) if (j < 2 || !(HF)) RA[j] = *(const bf16x8*)((const char*)S.A + PA[j] + (unsigned)(t) * 128u); } while (0)
#define G2_LOADB(RB, PB, t) do { _Pragma("unroll") for (int j = 0; j < 4; ++j) RB[j] = *(const f32x4*)(PB + (size_t)(t) * 64 * S.ldb + j * bstep); } while (0)
#define G2_WRITE_A(st, RA, j) do { *(LAS bf16x8*)(lds + (st) * STG + awoff(j)) = RA[j]; } while (0)
#define G2_WRITE_B(st, RB, j) do { uint2 w_; w_.x = cvt_pk_bf16(RB[j][0], RB[j][1]); w_.y = cvt_pk_bf16(RB[j][2], RB[j][3]); *(LAS uint2*)(lds + (st) * STG + bwoff(j)) = w_; } while (0)
#define G2_TR(dst, n, imm) asm volatile("ds_read_b64_tr_b16 %0, %1 offset:%2" : "=&v"(dst) : "v"(ldsb + boff[n]), "i"(imm) : "memory")
#define G2_COMPUTE(st, DOW, WA, WB, HFC, HFW) do { const unsigned long long tc0_ = TCK(); \
        s16x4 b00l, b00h, b01l, b01h, b10l, b10h, b11l, b11h;        \
        G2_TR(b00l, 0, (st) * STG); G2_TR(b00h, 0, (st) * STG + 1024); G2_TR(b01l, 0, (st) * STG + 8192); G2_TR(b01h, 0, (st) * STG + 8192 + 1024); \
        G2_TR(b10l, 1, (st) * STG); G2_TR(b10h, 1, (st) * STG + 1024); G2_TR(b11l, 1, (st) * STG + 8192); G2_TR(b11h, 1, (st) * STG + 8192 + 1024); \
        bf16x8 At[4][2]; \
        _Pragma("unroll") for (int m = 0; m < 4; ++m) _Pragma("unroll") for (int k = 0; k < 2; ++k) At[m][k] = *(const LAS bf16x8*)(lds + (st) * STG + aoff + m * 2048 + k * 1024); \
        asm volatile("s_waitcnt lgkmcnt(0)" ::: "memory"); __builtin_amdgcn_sched_barrier(0); \
        if (PROBE_REPEAT == 31) tacc += TCK() - tc0_; \
        const bf16x8 B00 = {b00l[0], b00l[1], b00l[2], b00l[3], b00h[0], b00h[1], b00h[2], b00h[3]}, B01 = {b01l[0], b01l[1], b01l[2], b01l[3], b01h[0], b01h[1], b01h[2], b01h[3]}; \
        const bf16x8 B10 = {b10l[0], b10l[1], b10l[2], b10l[3], b10h[0], b10h[1], b10h[2], b10h[3]}, B11 = {b11l[0], b11l[1], b11l[2], b11l[3], b11h[0], b11h[1], b11h[2], b11h[3]}; \
        _Pragma("unroll") for (int a = 0; a < 2; ++a) { \
            _Pragma("unroll") for (int m = 0; m < 4; ++m) { \
                __builtin_amdgcn_s_setprio(1); \
                if (128 * a + 64 * wr + 16 * m < nvalid) {                 \
                acc[a][m][0] = __builtin_amdgcn_mfma_f32_16x16x32_bf16(B00, At[m][0], acc[a][m][0], 0, 0, 0); acc[a][m][0] = __builtin_amdgcn_mfma_f32_16x16x32_bf16(B01, At[m][1], acc[a][m][0], 0, 0, 0); \
                acc[a][m][1] = __builtin_amdgcn_mfma_f32_16x16x32_bf16(B10, At[m][0], acc[a][m][1], 0, 0, 0); acc[a][m][1] = __builtin_amdgcn_mfma_f32_16x16x32_bf16(B11, At[m][1], acc[a][m][1], 0, 0, 0); } \
                if (PROBE_REPEAT == 20) { dummy = __builtin_amdgcn_mfma_f32_16x16x32_bf16(B00, At[m][0], dummy, 0, 0, 0); dummy = __builtin_amdgcn_mfma_f32_16x16x32_bf16(B01, At[m][1], dummy, 0, 0, 0); dummy = __builtin_amdgcn_mfma_f32_16x16x32_bf16(B10, At[m][0], dummy, 0, 0, 0); dummy = __builtin_amdgcn_mfma_f32_16x16x32_bf16(B11, At[m][1], dummy, 0, 0, 0); } \
                __builtin_amdgcn_s_setprio(0); \
                if (DOW) { if (a == 0) { if (m < 2 || !(HFW)) G2_WRITE_A((st) ^ 1, WA, m); if (HFC) G2_WRITE_B((st) ^ 1, WB, m); } else G2_WRITE_B((st) ^ 1, WB, m); __builtin_amdgcn_sched_barrier(0); } } \
            if (HFC) break;                                               \
            if (a == 0) { __builtin_amdgcn_sched_barrier(0); \
                _Pragma("unroll") for (int m = 0; m < 4; ++m) _Pragma("unroll") for (int k = 0; k < 2; ++k) At[m][k] = *(const LAS bf16x8*)(lds + (st) * STG + 16384 + aoff + m * 2048 + k * 1024); \
                asm volatile("s_waitcnt lgkmcnt(0)" ::: "memory"); __builtin_amdgcn_sched_barrier(0); } } \
        if (PROBE_REPEAT == 32) tacc += TCK() - tc0_; } while (0)
    for (int ui = 0;; ++ui) {
        G2_LOADA(ra0, pa, hf, 0); G2_LOADB(rb0, pb, 0); G2_LOADA(ra1, pa, hf, 1); G2_LOADB(rb1, pb, 1);
        __syncthreads();
#pragma unroll
        for (int j = 0; j < 4; ++j) { if (j < 2 || !hf) G2_WRITE_A(0, ra0, j); G2_WRITE_B(0, rb0, j); }
        if (nt > 2) { G2_LOADA(ra0, pa, hf, 2); G2_LOADB(rb0, pb, 2); }
        __syncthreads();
#define G2_STEP(t) do { \
            G2_COMPUTE(0, true, ra1, rb1, hf, hf); \
            if ((t) + 3 < nt) { G2_LOADA(ra1, pa, hf, (t) + 3); G2_LOADB(rb1, pb, (t) + 3); } \
            __syncthreads(); \
            if ((t) + 2 < nt) { G2_COMPUTE(1, true, ra0, rb0, hf, hf); } else { G2_COMPUTE(1, false, ra0, rb0, hf, hf); } \
            if ((t) + 4 < nt) { G2_LOADA(ra0, pa, hf, (t) + 4); G2_LOADB(rb0, pb, (t) + 4); } \
            __syncthreads(); } while (0)
        G2_STEP(0); G2_STEP(2); G2_STEP(4); G2_STEP(6);
        if constexpr (NT_ > 8) { G2_STEP(8); G2_STEP(10); G2_STEP(12); G2_STEP(14); G2_STEP(16); G2_STEP(18); G2_STEP(20); G2_STEP(22); G2_STEP(24); G2_STEP(26); G2_STEP(28); G2_STEP(30); }
        static_assert(NT_ == 8 || NT_ == 32, "expand G2_STEP for this K");
#undef G2_STEP
        if (PROBE_REPEAT == 20) asm volatile("" :: "v"(dummy));
        E(acc, u, wr, wc, fr, fq);
        if (!S.next(ui + 1, un)) break;
#pragma unroll
        for (int a = 0; a < 2; ++a)
#pragma unroll
            for (int m = 0; m < 4; ++m)
#pragma unroll
                for (int n = 0; n < 2; ++n) acc[a][m][n] = (f32x4){0.f, 0.f, 0.f, 0.f};
        u.e = un.e; u.pm = un.pm; u.pn = un.pn; u.li = un.li; u.half = un.half; hf = u.half != 0; nvalid = S.nvalid(u);
        G2_PTRS(pa, pb, u);
    }
#undef G2_PTRS
#undef awoff
#undef bwoff
#undef G2_LOADA
#undef G2_LOADB
#undef G2_WRITE_A
#undef G2_WRITE_B
#undef G2_TR
#undef G2_COMPUTE
    if (PROBE_REPEAT == 33) tacc = TCK() - t_all0;
    if (tprobe && blockIdx.x == PROBE_WG && threadIdx.x == 0) *tprobe = tacc;
#undef TCK
#endif
}
}

namespace att {
typedef short bf16x8 __attribute__((ext_vector_type(8)));
typedef short s16x4 __attribute__((ext_vector_type(4)));
typedef float f32x16 __attribute__((ext_vector_type(16)));
typedef float f32x4 __attribute__((ext_vector_type(4)));
typedef unsigned u32x4 __attribute__((ext_vector_type(4)));
constexpr int SHM = 16384;
constexpr int NBUF = 3;
constexpr int L_K = 0, L_V = NBUF * SHM, L_WS = 2 * NBUF * SHM, L_PART = L_WS + 8 * 64 * 4, L_SELM = L_PART + 4 * 64 * 33 * 4, L_VALS = L_SELM + 256, L_ITEM = L_VALS + 8 * 64 * 4, L_END = L_ITEM + 16;
constexpr float C2 = 1.4426950408889634f * SCALE;
#define KSWZ(row, colB) ((row) * 256 + ((colB) ^ (((row) & 7) << 4)))
#define SBAR() __builtin_amdgcn_sched_barrier(0)
__device__ __forceinline__ int v_st(int k, int c) { const int kk = (k & ~0xC) | ((k & 4) << 1) | ((k & 8) >> 1); return ((kk >> 3) * 4 + (c >> 5)) * 512 + ((kk & 7) * 32 + (c & 31)) * 2; }
__device__ __forceinline__ int v_rd_base(int lane) { return ((lane & 3) << 3) | (((lane >> 2) & 3) << 6) | (((lane >> 4) & 1) << 5) | (((lane >> 5) & 1) << 8); }
constexpr int v_rd_off(int d0, int ks, int half) { return d0 * 512 + ks * 4096 + half * 2048; }
__device__ __forceinline__ int crow(int r, int hi) { return (r & 3) + 8 * (r >> 2) + 4 * hi; }
__device__ __forceinline__ unsigned cvtpk(float lo, float hi) { unsigned r; asm volatile("v_cvt_pk_bf16_f32 %0, %1, %2" : "=v"(r) : "v"(lo), "v"(hi)); return r; }
__device__ __forceinline__ float swap_max(float v) { auto rr = __builtin_amdgcn_permlane32_swap(__float_as_uint(v), __float_as_uint(v), false, false); return fmaxf(__uint_as_float(rr[0]), __uint_as_float(rr[1])); }
__device__ __forceinline__ float swap_sum(float v) { auto rr = __builtin_amdgcn_permlane32_swap(__float_as_uint(v), __float_as_uint(v), false, false); return __uint_as_float(rr[0]) + __uint_as_float(rr[1]); }

struct WV { int tid, wid, lane, r32, hi, vb0; unsigned ksrc[2], vsrc[2]; char* lds; LAS unsigned char* ldsL; };
__device__ __forceinline__ void wv_src_init(WV& w) {
#pragma unroll
    for (int i = 0; i < 2; ++i) {
        const int L = (w.wid * 2 + i) * 1024 + w.lane * 16;
        { const int row = L >> 8, colB = (L & 255) ^ ((row & 7) << 4); w.ksrc[i] = (unsigned)(row * 256 + colB); }
        { const int sub = L >> 9, kkhi = sub >> 2, cblk = sub & 3, within = L & 511, kklo = within >> 6, cc = (within >> 1) & 31;
          const int kk = kkhi * 8 + kklo, k = (kk & ~0xC) | ((kk & 4) << 1) | ((kk & 8) >> 1), c = cblk * 32 + cc; w.vsrc[i] = (unsigned)(k * 256 + c * 2); }
    }
}
__device__ __forceinline__ void dma_tile(const WV& w, const bf16_t* Kt, const bf16_t* Vt, int buf) {
    int ln = w.lane; asm volatile("" : "+v"(ln));
#pragma unroll
    for (int i = 0; i < 2; ++i) {
        const int L = (w.wid * 2 + i) * 1024 + ln * 16;
        const int row = L >> 8, colB = (L & 255) ^ ((row & 7) << 4); const unsigned ksrc = (unsigned)(row * 256 + colB);
        const int sub = L >> 9, kkhi = sub >> 2, cblk = sub & 3, within = L & 511, kklo = within >> 6, cc = (within >> 1) & 31;
        const int kk = kkhi * 8 + kklo, k = (kk & ~0xC) | ((kk & 4) << 1) | ((kk & 8) >> 1), c = cblk * 32 + cc; const unsigned vsrc = (unsigned)(k * 256 + c * 2);
        __builtin_amdgcn_global_load_lds((const unsigned*)((const char*)Vt + vsrc), (LAS unsigned*)(w.ldsL + L_V + buf * SHM + (w.wid * 2 + i) * 1024), 16, 0, 0);
        __builtin_amdgcn_global_load_lds((const unsigned*)((const char*)Kt + ksrc), (LAS unsigned*)(w.ldsL + L_K + buf * SHM + (w.wid * 2 + i) * 1024), 16, 0, 0);
    }
}
template <int BUF>
__device__ __forceinline__ void qkt(const WV& w, const bf16x8 (&qr)[8], f32x16& p0, f32x16& p1) {
    p0 = f32x16{}; p1 = f32x16{};
    const LAS char* kb[4];
#pragma unroll
    for (int dd = 0; dd < 4; ++dd) kb[dd] = (const LAS char*)w.ldsL + L_K + KSWZ(w.r32, (dd * 16 + w.hi * 8) * 2);
#pragma unroll
    for (int d0 = 0; d0 < 8; ++d0) { const LAS char* a = kb[d0 & 3] + BUF * SHM + (d0 >> 2) * 128;
        const bf16x8 b0 = *reinterpret_cast<const LAS bf16x8*>(a); const bf16x8 b1 = *reinterpret_cast<const LAS bf16x8*>(a + 32 * 256);
        p0 = __builtin_amdgcn_mfma_f32_32x32x16_bf16(b0, qr[d0], p0, 0, 0, 0);
        p1 = __builtin_amdgcn_mfma_f32_32x32x16_bf16(b1, qr[d0], p1, 0, 0, 0);
        if (d0 == 3) SBAR(); }
}
__device__ __forceinline__ void pack_p(const f32x16& p0, const f32x16& p1, bf16x8& pa0, bf16x8& pa1, bf16x8& pa2, bf16x8& pa3) {
#define PK4(P, B_, OUT) do { unsigned a0 = cvtpk(P[B_+0], P[B_+1]), a1 = cvtpk(P[B_+2], P[B_+3]); unsigned b0 = cvtpk(P[B_+4], P[B_+5]), b1 = cvtpk(P[B_+6], P[B_+7]); \
        auto r0 = __builtin_amdgcn_permlane32_swap(a0, b0, false, false); auto r1 = __builtin_amdgcn_permlane32_swap(a1, b1, false, false); \
        u32x4 w_ = {r0[0], r1[0], r0[1], r1[1]}; OUT = *reinterpret_cast<bf16x8*>(&w_); } while (0)
    PK4(p0, 0, pa0); PK4(p0, 8, pa1); PK4(p1, 0, pa2); PK4(p1, 8, pa3);
#undef PK4
}
template <int VB>
__device__ __forceinline__ void pv_tile(f32x16* o, int vb0, bf16x8 pa0, bf16x8 pa1, bf16x8 pa2, bf16x8 pa3) {
#define TRRD(dst, off) asm volatile("ds_read_b64_tr_b16 %0, %1 offset:%2" : "=&v"(dst) : "v"(vb0), "i"(off) : "memory")
#define PV_D0(d0) do { s16x4 l0, l1, l2, l3, h0, h1, h2, h3; constexpr int b_ = VB * SHM + v_rd_off(d0, 0, 0); \
        TRRD(l0, b_); TRRD(h0, b_ + 2048); TRRD(l1, b_ + 4096); TRRD(h1, b_ + 6144); TRRD(l2, b_ + 8192); TRRD(h2, b_ + 10240); TRRD(l3, b_ + 12288); TRRD(h3, b_ + 14336); \
        asm volatile("s_waitcnt lgkmcnt(0)" ::: "memory"); SBAR(); \
        o[d0] = __builtin_amdgcn_mfma_f32_32x32x16_bf16(pa0, (bf16x8){l0[0], l0[1], l0[2], l0[3], h0[0], h0[1], h0[2], h0[3]}, o[d0], 0, 0, 0); \
        o[d0] = __builtin_amdgcn_mfma_f32_32x32x16_bf16(pa1, (bf16x8){l1[0], l1[1], l1[2], l1[3], h1[0], h1[1], h1[2], h1[3]}, o[d0], 0, 0, 0); \
        o[d0] = __builtin_amdgcn_mfma_f32_32x32x16_bf16(pa2, (bf16x8){l2[0], l2[1], l2[2], l2[3], h2[0], h2[1], h2[2], h2[3]}, o[d0], 0, 0, 0); \
        o[d0] = __builtin_amdgcn_mfma_f32_32x32x16_bf16(pa3, (bf16x8){l3[0], l3[1], l3[2], l3[3], h3[0], h3[1], h3[2], h3[3]}, o[d0], 0, 0, 0); } while (0)
    PV_D0(0); PV_D0(1); PV_D0(2); PV_D0(3);
#undef PV_D0
#undef TRRD
}
__device__ __forceinline__ void store_o(const WV& w, const f32x16* o, const float* tab, bf16_t* outp) {
    bf16_t* lp = outp + (size_t)w.hi * 4096 + w.r32;
#pragma unroll
    for (int r = 0; r < 16; ++r) { const int q = crow(r, w.hi); const float sc = tab[q];
        bf16_t* p = lp; asm volatile("" : "+v"(p));
        p += ((r & 3) + 8 * (r >> 2)) * 1024;
#pragma unroll
        for (int d0 = 0; d0 < 4; ++d0) { const float v = o[d0][r] * sc; const float vn = __shfl_xor(v, 1);
            if ((w.r32 & 1) == 0) *(__attribute__((address_space(1))) unsigned*)(p + d0 * 32) = cvtpk(v, vn); } }
}

template <int MODE>
__device__ __forceinline__ void flash_pass(const WV& w, const bf16_t* Kp, const bf16_t* Vp, int j_lo, int j_hi, const bf16x8 (&qr)[8], int tpos, int tw0, unsigned selmask,
                                           f32x16 (&o)[4], float& m_reg, float& l_reg) {
    float* al_l = (float*)(w.lds + L_WS) + w.wid * 64;
    dma_tile(w, Kp + (size_t)j_lo * 64 * HD, Vp + (size_t)j_lo * 64 * HD, 0);
    if (j_lo + 1 < j_hi) dma_tile(w, Kp + (size_t)(j_lo + 1) * 64 * HD, Vp + (size_t)(j_lo + 1) * 64 * HD, 1);
#define FSTEP(BUF, jj) do { const int jt = (jj);                                                                                  \
        if (jt + 1 < j_hi) asm volatile("s_waitcnt vmcnt(4)" ::: "memory"); else asm volatile("s_waitcnt vmcnt(0)" ::: "memory");   \
        asm volatile("s_waitcnt lgkmcnt(0)" ::: "memory"); __builtin_amdgcn_s_barrier(); asm volatile("" ::: "memory");          \
        if (jt + 2 < j_hi) dma_tile(w, Kp + (size_t)(jt + 2) * 64 * HD, Vp + (size_t)(jt + 2) * 64 * HD, ((BUF) + 2) % 3);         \
        f32x16 p0, p1;                                                                                                           \
        qkt<BUF>(w, qr, p0, p1);                                                                                                 \
        const int kb = jt * 64;                                                                                                  \
        { const float NEG = -__builtin_inff();                                                                                   \
          const bool need = (kb + 63 > tw0) || (MODE == 1 && kb <= tw0 + 31 - 512);                                              \
          if (need) { const int dq = tpos - kb - 4 * w.hi; const unsigned W = (MODE == 1) ? 512u : 0x7fffffffu;                  \
              _Pragma("unroll") for (int r = 0; r < 16; ++r) { const int c = (r & 3) + 8 * (r >> 2); if ((unsigned)(dq - c) >= W) p0[r] = NEG; if ((unsigned)(dq - c - 32) >= W) p1[r] = NEG; } } \
          if (MODE == 0) { const bool sel = (selmask >> jt) & 1u;                                                                \
              if (!__all(sel)) { _Pragma("unroll") for (int r = 0; r < 16; ++r) { p0[r] = sel ? p0[r] : NEG; p1[r] = sel ? p1[r] : NEG; } } } } \
        float pmax = p0[0];                                                                                                      \
        _Pragma("unroll") for (int r = 1; r < 16; ++r) pmax = fmaxf(pmax, p0[r]);                                                \
        _Pragma("unroll") for (int r = 0; r < 16; ++r) pmax = fmaxf(pmax, p1[r]);                                                \
        pmax = swap_max(pmax);                                                                                                   \
        float mn = m_reg, alpha = 1.f;                                                                                           \
        const bool resc = !__all((pmax - m_reg) * SCALE <= 8.f);          \
        if (resc) { mn = fmaxf(m_reg, pmax); alpha = __builtin_amdgcn_exp2f((m_reg - mn) * C2); m_reg = mn; }                     \
        const float mnL = -mn * C2;                                                                                              \
        float ps = 0.f;                                                                                                          \
        _Pragma("unroll") for (int r = 0; r < 16; ++r) { p0[r] = __builtin_amdgcn_exp2f(fmaf(p0[r], C2, mnL)); ps += p0[r]; }    \
        _Pragma("unroll") for (int r = 0; r < 16; ++r) { p1[r] = __builtin_amdgcn_exp2f(fmaf(p1[r], C2, mnL)); ps += p1[r]; }    \
        ps = swap_sum(ps);                                                                                                       \
        l_reg = l_reg * alpha + ps;                                                                                              \
        if (resc) { if (w.hi == 0) al_l[w.r32] = alpha;                                                                          \
            asm volatile("s_waitcnt lgkmcnt(0)" ::: "memory");                                                                   \
            _Pragma("unroll") for (int r = 0; r < 16; ++r) { const float a = al_l[crow(r, w.hi)];                                \
                _Pragma("unroll") for (int d = 0; d < 4; ++d) o[d][r] *= a; } }                                                  \
        bf16x8 pa0, pa1, pa2, pa3;                                                                                               \
        pack_p(p0, p1, pa0, pa1, pa2, pa3);                                                                                      \
        pv_tile<BUF>(o, w.vb0, pa0, pa1, pa2, pa3);                                                                              \
    } while (0)
    int j = j_lo;
    for (; j + 2 < j_hi; j += 3) { FSTEP(0, j); FSTEP(1, j + 1); FSTEP(2, j + 2); }
    if (j < j_hi) { FSTEP(0, j); if (j + 1 < j_hi) FSTEP(1, j + 1); }
#undef FSTEP
    __syncthreads();
}
}

__device__ const unsigned char ATT_ITEMS[80] = {15, 30, 31, 63, 14, 28, 29, 61, 62, 13, 26, 27, 59, 60, 12, 24, 25, 57, 58, 11, 22, 23, 55, 56, 10, 20, 21, 53, 54, 9, 18, 19, 51, 52, 8, 16, 17, 49, 50, 7, 48, 6, 5,
    72, 73, 74, 75, 76, 77, 78, 79, 80, 81, 82, 83, 84, 85, 86, 87, 88, 89, 90, 91, 92, 93, 94, 95, 4, 71, 3, 70, 2, 69, 1, 68, 0, 67, 66, 65, 64};
constexpr int CW_QUEUE = 6144;
constexpr int CW_CVTQ = 6144 + 256;
constexpr int CW_CMPR = 8192 + 2048;

__device__ __forceinline__ void p_attn(const Frame& F, unsigned char* lds_raw, int rep) {
    using namespace att;
    WV w;
#define WV_INIT() do { int ln_ = F.lane; asm volatile("" : "+v"(ln_)); w.tid = F.wave * 64 + ln_; w.wid = F.wave; w.lane = ln_; w.r32 = ln_ & 31; w.hi = ln_ >> 5; \
        w.lds = (char*)lds_raw + 1024; w.ldsL = (LAS unsigned char*)lds_raw + 1024; w.vb0 = (int)(uintptr_t)(w.lds) + att::L_V + v_rd_base(ln_); } while (0)
    WV_INIT();
    const bf16_t* qn = (const bf16_t*)(F.ws + WS_QN); const bf16_t* qrp = (const bf16_t*)(F.ws + WS_QR); const bf16_t* kv = (const bf16_t*)(F.ws + WS_KV);
    const bf16_t* ckv = (const bf16_t*)(F.ws + WS_CMPKV);
    bf16_t* ocmp = (bf16_t*)(F.ws + WS_OCMP); bf16_t* owin = (bf16_t*)(F.ws + WS_OWIN); bf16_t* osel = (bf16_t*)(F.ws + WS_OSEL); float* ml = (float*)(F.ws + WS_ML);
    unsigned* qctr = (unsigned*)(F.ws + WS_CTL) + CW_QUEUE + 64 * rep;
    float* wsf = (float*)(w.lds + L_WS) + w.wid * 64;
    float* part = (float*)(w.lds + L_PART); unsigned* selm = (unsigned*)(w.lds + L_SELM); float* vals = (float*)(w.lds + L_VALS) + w.wid * 64; volatile int* itemw = (volatile int*)(w.lds + L_ITEM);
    const int hr = w.wid >> 1, th = w.wid & 1;
    for (;;) {
        __syncthreads();
        if (F.tid == 0) itemw[0] = (int)atomicAdd(qctr, 1u);
        __syncthreads();
        const int item = itemw[0];
        if (item >= 640) break;
        WV_INIT();
        const int ent = ATT_ITEMS[item >> 3], bg = item & 7, type = ent >> 5, qb = ent & 31, b = bg >> 1, g = bg & 1, h = 4 * g + hr;
        const int t0 = qb * 64 + th * 32, tpos = t0 + w.r32, tok0 = b * SEQ + t0;
        const size_t qoff = (((size_t)b * NH + h) * SEQ + t0 + w.r32) * HD + w.hi * 8;
        const size_t kvoff = ((size_t)b * NG + g) * SEQ * HD;
        bf16x8 qr[8];
        f32x16 o[4];
#ifndef ATT_NO_WIN
        if (type == 2) {
#pragma unroll
            for (int d0 = 0; d0 < 8; ++d0) qr[d0] = *(const bf16x8*)(qrp + qoff + d0 * 16);
#pragma unroll
            for (int d = 0; d < 4; ++d) o[d] = f32x16{};
            float m_reg = -1e30f, l_reg = 0.f;
            flash_pass<1>(w, kv + (size_t)4 * (4 * MB / 2) + kvoff, kv + (size_t)5 * (4 * MB / 2) + kvoff, qb >= 8 ? qb - 8 : 0, qb + 1, qr, tpos, t0, 0u, o, m_reg, l_reg);
            if (w.hi == 0) wsf[w.r32] = 1.f / l_reg;
            asm volatile("s_waitcnt lgkmcnt(0)" ::: "memory");
            store_o(w, o, wsf, owin + (size_t)tok0 * 1024 + h * HD);
            continue;
        }
#endif
#ifndef ATT_NO_CMP
        {
#pragma unroll
            for (int d0 = 0; d0 < 8; ++d0) qr[d0] = *(const bf16x8*)(qn + qoff + d0 * 16);
            const bf16_t* Kc = ckv + (size_t)bg * 128 * HD; const bf16_t* Vc = ckv + (size_t)1024 * HD + (size_t)bg * 128 * HD;
            dma_tile(w, Kc, Vc, 0); dma_tile(w, Kc + 64 * HD, Vc + 64 * HD, 1);
            asm volatile("s_waitcnt vmcnt(0)" ::: "memory");
            __syncthreads();
            f32x16 pA0, pA1, pB0, pB1;
            qkt<0>(w, qr, pA0, pA1); qkt<1>(w, qr, pB0, pB1);
            const int nmax = tpos >= 31 ? ((tpos - 31) >> 4) : -1;
            const float NEG = -__builtin_inff();
            float pmax = NEG;
#pragma unroll
            for (int r = 0; r < 16; ++r) { const int n = crow(r, w.hi);
                pA0[r] = (n <= nmax) ? pA0[r] : NEG; pA1[r] = (n + 32 <= nmax) ? pA1[r] : NEG; pB0[r] = (n + 64 <= nmax) ? pB0[r] : NEG; pB1[r] = (n + 96 <= nmax) ? pB1[r] : NEG;
                pmax = fmaxf(fmaxf(pmax, pA0[r]), fmaxf(pA1[r], fmaxf(pB0[r], pB1[r]))); }
            pmax = swap_max(pmax);
            const float mm = (pmax == NEG) ? 0.f : pmax;
            const float mnL = -mm * C2;
            float ps = 0.f;
#pragma unroll
            for (int r = 0; r < 16; ++r) { pA0[r] = __builtin_amdgcn_exp2f(fmaf(pA0[r], C2, mnL)); pA1[r] = __builtin_amdgcn_exp2f(fmaf(pA1[r], C2, mnL));
                pB0[r] = __builtin_amdgcn_exp2f(fmaf(pB0[r], C2, mnL)); pB1[r] = __builtin_amdgcn_exp2f(fmaf(pB1[r], C2, mnL)); ps += (pA0[r] + pA1[r]) + (pB0[r] + pB1[r]); }
            ps = swap_sum(ps);
            const float inv = ps > 0.f ? 1.f / ps : 0.f;
#pragma unroll
            for (int r = 0; r < 16; ++r) { pA0[r] *= inv; pA1[r] *= inv; pB0[r] *= inv; pB1[r] *= inv; }
            {
                float av[16], bv[16];
#pragma unroll
                for (int gq = 0; gq < 4; ++gq) {
                    av[gq]      = pA0[4 * gq] + pA0[4 * gq + 1] + pA0[4 * gq + 2] + 0.5f * pA0[4 * gq + 3]; bv[gq]      = 0.5f * pA0[4 * gq + 3];
                    av[4 + gq]  = pA1[4 * gq] + pA1[4 * gq + 1] + pA1[4 * gq + 2] + 0.5f * pA1[4 * gq + 3]; bv[4 + gq]  = 0.5f * pA1[4 * gq + 3];
                    av[8 + gq]  = pB0[4 * gq] + pB0[4 * gq + 1] + pB0[4 * gq + 2] + 0.5f * pB0[4 * gq + 3]; bv[8 + gq]  = 0.5f * pB0[4 * gq + 3];
                    av[12 + gq] = pB1[4 * gq] + pB1[4 * gq + 1] + pB1[4 * gq + 2] + 0.5f * pB1[4 * gq + 3]; bv[12 + gq] = 0.5f * pB1[4 * gq + 3];
                }
                float* prow = part + ((size_t)hr * 64 + th * 32 + w.r32) * 33;
#pragma unroll
                for (int idx = 0; idx < 16; ++idx) {
                    const float bo = __shfl_xor(bv[idx], 32);
                    const float bprev = (idx > 0) ? __shfl_xor(bv[idx > 0 ? idx - 1 : 0], 32) : 0.f;
                    const float inc = w.hi ? bo : bprev;
                    prow[2 * idx + w.hi] = av[idx] + inc;
                }
            }
            if (type == 0) {
                bf16x8 pa0, pa1, pa2, pa3;
#pragma unroll
                for (int d = 0; d < 4; ++d) o[d] = f32x16{};
                pack_p(pA0, pA1, pa0, pa1, pa2, pa3); pv_tile<0>(o, w.vb0, pa0, pa1, pa2, pa3);
                pack_p(pB0, pB1, pa0, pa1, pa2, pa3); pv_tile<1>(o, w.vb0, pa0, pa1, pa2, pa3);
                if (w.hi == 0) wsf[w.r32] = 1.f;
                asm volatile("s_waitcnt lgkmcnt(0)" ::: "memory");
                store_o(w, o, wsf, ocmp + (size_t)tok0 * 1024 + h * HD);
            }
            __syncthreads();
#pragma unroll 1
            for (int ps2 = 0; ps2 < 4; ++ps2) {
                int ln = w.lane; asm volatile("" : "+v"(ln));
                const int j = ln & 31, hi2 = ln >> 5;
                const int tk = 8 * w.wid + 2 * ps2 + hi2, t = qb * 64 + tk, cur = qb;
                float imp = 0.f;
#pragma unroll
                for (int r = 0; r < 4; ++r) imp += part[((size_t)r * 64 + tk) * 33 + j];
                const bool ok = (64 * j <= t), forced = (j == 0) || (cur - j >= 0 && cur - j < 2);
                const float val = (ok && forced) ? 1.0e30f : (ok ? imp : -1.0e30f);
                vals[ln] = val;
                asm volatile("s_waitcnt lgkmcnt(0)" ::: "memory");
                int rank = 0;
#pragma unroll
                for (int jj = 0; jj < 32; ++jj) { const float o2 = vals[hi2 * 32 + jj]; rank += (o2 > val || (o2 == val && jj < j)) ? 1 : 0; }
                const unsigned long long bal = __ballot(rank < 16 && val >= 0.f);
                if (w.lane == 0) { selm[8 * w.wid + 2 * ps2] = (unsigned)bal; selm[8 * w.wid + 2 * ps2 + 1] = (unsigned)(bal >> 32); }
            }
            __syncthreads();
        }
#endif
#ifndef ATT_NO_SEL
        {
            WV_INIT();
            const unsigned sm = selm[th * 32 + w.r32];
            const int ntile = qb + 1, hsplit = (ntile + 1) >> 1;
            const int ja = (qb >= 16 && type == 1) ? hsplit : 0, jb = (qb >= 16 && type == 0) ? hsplit : ntile;
#pragma unroll
            for (int d0 = 0; d0 < 8; ++d0) qr[d0] = *(const bf16x8*)(qrp + qoff + d0 * 16);
#pragma unroll
            for (int d = 0; d < 4; ++d) o[d] = f32x16{};
            float m_reg = -1e30f, l_reg = 0.f;
            flash_pass<0>(w, kv + (size_t)2 * (4 * MB / 2) + kvoff, kv + (size_t)3 * (4 * MB / 2) + kvoff, ja, jb, qr, tpos, t0, sm, o, m_reg, l_reg);
            if (w.hi == 0) { wsf[w.r32] = l_reg > 0.f ? 1.f / l_reg : 0.f; float* mp = ml + (((size_t)type * NT + tok0 + w.r32) * NH + h) * 2; mp[0] = m_reg; mp[1] = l_reg; }
            asm volatile("s_waitcnt lgkmcnt(0)" ::: "memory");
            store_o(w, o, wsf, osel + (size_t)type * NT * 1024 + (size_t)tok0 * 1024 + h * HD);
        }
#endif
    }
}

struct CvtTile { const float* src; const float* ksc; bf16_t* dst0; int sld, ldd, mode; };
__device__ __forceinline__ CvtTile cvt_decode(const Frame& F, int t) {
    CvtTile c; c.ksc = nullptr; c.mode = 0;
    if (t < 4096) { const int e = t >> 7, mat = (t >> 6) & 1, kt = (t >> 1) & 31, nt = t & 1;
        c.src = (mat ? F.in[I_WUP] : F.in[I_WGATE]) + ((size_t)e * DM + kt * 64) * FF + nt * 256; c.sld = FF; c.ksc = F.in[I_LNMOE] + kt * 64;
        c.dst0 = (bf16_t*)(F.ws + WS_W1T) + ((size_t)e * 1024 + nt * 512 + mat * 128) * DM + kt * 64; c.ldd = DM; c.mode = 1; return c; }
    t -= 4096;
    if (t < 2048) { const int e = t >> 6, kt = (t >> 3) & 7, nt = t & 7;
        c.src = F.in[I_WDOWN] + ((size_t)e * FF + kt * 64) * DM + nt * 256; c.sld = DM;
        c.dst0 = (bf16_t*)(F.ws + WS_W2T) + ((size_t)e * 2048 + nt * 256) * FF + kt * 64; c.ldd = FF; return c; }
    t -= 2048;
    if (t < 256) { const int kt = t >> 3, nt = t & 7;
        c.src = F.in[I_WOUT] + (size_t)kt * 64 * DM + nt * 256; c.sld = DM; c.dst0 = (bf16_t*)(F.ws + WS_WOUTT) + (size_t)nt * 256 * DM + kt * 64; c.ldd = DM; return c; }
    t -= 256;
    if (t < 480) { const int kt = t / 15, nt = t % 15;
        c.src = F.in[I_WIN] + (size_t)kt * 64 * INW; c.sld = INW; c.ksc = F.in[I_LNMIX] + kt * 64;
        c.dst0 = (bf16_t*)(F.ws + WS_WINT) + (size_t)nt * 256 * DM + kt * 64; c.ldd = DM; c.mode = 2 + nt; return c; }
    t -= 480;
    { const int kv = t >> 6, kt = t & 63;
      c.src = (kv ? F.in[I_WV1] : F.in[I_WK1]) + (size_t)kt * 64 * 256; c.sld = 256; c.dst0 = (bf16_t*)(F.ws + WS_CMPW) + (size_t)kv * 256 * 4096 + kt * 64; c.ldd = 4096; return c; }
}
constexpr int N_CVT_TILES = 4096 + 2048 + 256 + 480 + 128;
__device__ __forceinline__ void cvt_load(const CvtTile& c, int nq, int kq, float4 (&v)[8]) {
    const float* p = c.src + 4 * nq; bool valid = true;
    if (c.mode >= 2) { const int n = (c.mode - 2) * 256 + 4 * nq; int sc = -1; if (n < 2560) sc = n; else if (n < 3584) sc = n + 24; else if (n < 3608) sc = n - 1024; valid = sc >= 0; p = c.src + (valid ? sc : 0); }
#pragma unroll
    for (int i = 0; i < 8; ++i) v[i] = valid ? *(const float4*)(p + (size_t)(kq * 8 + i) * c.sld) : make_float4(0.f, 0.f, 0.f, 0.f);
}

constexpr int CVT_RUN = 4;
__device__ __forceinline__ void cvt_stream(const Frame& F, int t_lo, int t_hi, unsigned* queue, int sfirst = -1, int sstride = 0) {
    if (sfirst < 0) { sfirst = F.bid; sstride = F.G; }
    float* T = F.lds;
    volatile int* nxtw = (volatile int*)(F.lds + 64 * 257);
    const int tid = F.tid, nq = tid & 63, kq = tid >> 6;
    int tA, tB; float4 vA[8], vB[8]; CvtTile cA, cB;
    if (queue) { __syncthreads(); if (tid == 0) { nxtw[0] = t_lo + CVT_RUN * (int)atomicAdd(queue, 1u); nxtw[1] = t_lo + CVT_RUN * (int)atomicAdd(queue, 1u); } __syncthreads(); tA = nxtw[0]; tB = nxtw[1]; }
    else { tA = t_lo + sfirst; tB = tA + sstride; }
    if (tA < t_hi) { cA = cvt_decode(F, tA); cvt_load(cA, nq, kq, vA); }
    if (tB < t_hi) { cB = cvt_decode(F, tB); cvt_load(cB, nq, kq, vB); }
#define CVT_STEP(tX, cX, vX, slot) do {                                                                                                     \
        const bool pop = queue && (((tX) - t_lo) % CVT_RUN == CVT_RUN - 1);                 \
        int tn_reg = 0;                                                                                                                      \
        if (pop && tid == 0) tn_reg = t_lo + CVT_RUN * (int)atomicAdd(queue, 1u);                                                            \
        __syncthreads();                                                                                                                     \
        _Pragma("unroll") for (int i = 0; i < 8; ++i) { const float s = cX.ksc ? cX.ksc[kq * 8 + i] : 1.f; float* tp = T + (kq * 8 + i) * 257 + 4 * nq; \
            tp[0] = vX[i].x * s; tp[1] = vX[i].y * s; tp[2] = vX[i].z * s; tp[3] = vX[i].w * s; }                                           \
        if (pop && tid == 0) nxtw[slot] = tn_reg;                                                                                            \
        __syncthreads();                                                                                                                     \
        const CvtTile cc = cX; const int tn = queue ? (pop ? nxtw[slot] : tX + 1) : tX + 2 * sstride;                                            \
        if (tn < t_hi) { cX = cvt_decode(F, tn); cvt_load(cX, nq, kq, vX); }                                                                 \
        _Pragma("unroll") for (int j = 0; j < 4; ++j) { const int id = tid + 512 * j, n = id >> 3, kc = id & 7; const float* tp = T + (kc * 8) * 257 + n; \
            pg8::u32x4 w; w.x = pg8::cvt_pk_bf16(tp[0], tp[257]); w.y = pg8::cvt_pk_bf16(tp[2 * 257], tp[3 * 257]); w.z = pg8::cvt_pk_bf16(tp[4 * 257], tp[5 * 257]); w.w = pg8::cvt_pk_bf16(tp[6 * 257], tp[7 * 257]); \
            const int rowi = (cc.mode == 1) ? ((n >> 7) * 256 + (n & 127)) : n;                                                              \
            *(pg8::u32x4*)(cc.dst0 + (size_t)rowi * cc.ldd + kc * 8) = w; }                                                                  \
        tX = tn; } while (0)
    while (tA < t_hi) {
        CVT_STEP(tA, cA, vA, 0);
        if (tB >= t_hi) { const int t2 = tA; tA = tB; tB = t2; const CvtTile c2 = cA; cA = cB; cB = c2;
#pragma unroll
            for (int i = 0; i < 8; ++i) { const float4 x = vA[i]; vA[i] = vB[i]; vB[i] = x; }
            continue; }
        CVT_STEP(tB, cB, vB, 1);
    }
    while (tB < t_hi) CVT_STEP(tB, cB, vB, 1);
#undef CVT_STEP
    __syncthreads();
}

__device__ __forceinline__ void p0_tables(const Frame& F, int first, int stride) {
    {
        const float* wp = F.in[I_WPOOL]; const float* ps = F.in[I_PSCALE]; const float* bp = F.in[I_BPOOL]; bf16_t* wpt = (bf16_t*)(F.ws + WS_POOLW); float* pb = (float*)(F.ws + WS_POOLB);
        for (int idx = first * NTHREADS + F.tid; idx < 4 * 256 * 256; idx += stride * NTHREADS) { const int k = idx & 255, n = (idx >> 8) & 255, g = idx >> 16;
            wpt[idx] = f2bf(wp[((size_t)g * 256 + k) * 256 + n] * ps[g * 256 + n]); }
        for (int idx = first * NTHREADS + F.tid; idx < 1024; idx += stride * NTHREADS) pb[idx] = bp[idx] * ps[idx];
    }
    { const float* lnm = F.in[I_LNMOE]; const float* wre = F.in[I_WRE]; const float* wrg = F.in[I_WRG]; float* WRP = (float*)(F.ws + WS_WRP);
      for (int idx = first * NTHREADS + F.tid; idx < DM * 48; idx += stride * NTHREADS) { const int k = idx / 48, c = idx - k * 48;
          WRP[idx] = c < 32 ? lnm[k] * wre[((size_t)(c >> 3) * DM + k) * 8 + (c & 7)] : (c < 36 ? lnm[k] * wrg[k * 4 + (c - 32)] : 0.f); } }
    for (int it = first; it < 256; it += stride) {
        const int kv = it >> 7, jb = (it >> 5) & 3, mc = it & 31;
        const float* pe = (kv ? F.in[I_PEV] : F.in[I_PEK]); const float* w1 = (kv ? F.in[I_WV1] : F.in[I_WK1]);
        const int mg = F.tid >> 6, j = jb * 64 + (F.tid & 63);
        float a = 0.f;
#pragma unroll
        for (int q = 0; q < 16; ++q) { const int m = mc * 128 + mg + 8 * q; a += pe[m] * w1[(size_t)m * 256 + j]; }
        __syncthreads();
        F.lds[F.tid] = a;
        __syncthreads();
        if (F.tid < 64) { float s = 0.f; for (int q = 0; q < 8; ++q) s += F.lds[q * 64 + F.tid]; ((float*)(F.ws + WS_BIAS1))[(mc * 2 + kv) * 256 + j] = s; }
        __syncthreads();
    }
}
__device__ __forceinline__ void p0_prologue(const Frame& F) {
    const float* x = F.in[I_X];
    bf16_t* xb = (bf16_t*)(F.ws + WS_XB); float* rstd1 = (float*)(F.ws + WS_RSTD1);
    const int gw = F.bid * NWAVES + F.wave, nw = F.G * NWAVES, lane = F.lane;
    for (int r = gw; r < NT; r += 2 * nw) {
        const int r2 = r + nw; const bool has2 = r2 < NT;
        float4 v[8], v2[8]; float ss = 0.f, ss2 = 0.f;
#pragma unroll
        for (int i = 0; i < 8; ++i) { v[i] = *(const float4*)(x + (size_t)r * DM + i * 256 + lane * 4); v2[i] = has2 ? *(const float4*)(x + (size_t)r2 * DM + i * 256 + lane * 4) : make_float4(0.f, 0.f, 0.f, 0.f); }
#pragma unroll
        for (int i = 0; i < 8; ++i) { ss += v[i].x * v[i].x + v[i].y * v[i].y + v[i].z * v[i].z + v[i].w * v[i].w; ss2 += v2[i].x * v2[i].x + v2[i].y * v2[i].y + v2[i].z * v2[i].z + v2[i].w * v2[i].w; }
        ss = wave_sum(ss); ss2 = wave_sum(ss2);
        if (lane == 0) { rstd1[r] = rsqrtf(ss * (1.f / DM) + EPS); if (has2) rstd1[r2] = rsqrtf(ss2 * (1.f / DM) + EPS); }
#pragma unroll
        for (int i = 0; i < 8; ++i) { uint2 w; w.x = pg8::cvt_pk_bf16(v[i].x, v[i].y); w.y = pg8::cvt_pk_bf16(v[i].z, v[i].w);
            *(uint2*)(xb + (size_t)r * DM + i * 256 + lane * 4) = w;
            if (has2) { uint2 w2; w2.x = pg8::cvt_pk_bf16(v2[i].x, v2[i].y); w2.y = pg8::cvt_pk_bf16(v2[i].z, v2[i].w); *(uint2*)(xb + (size_t)r2 * DM + i * 256 + lane * 4) = w2; } }
    }
    cvt_stream(F, 6400, N_CVT_TILES, nullptr);
    {
        const int* pos = (const int*)F.in[I_POS]; float* rc = (float*)(F.ws + WS_ROPEC); float* rs = (float*)(F.ws + WS_ROPES);
        for (int idx = F.bid * NTHREADS + F.tid; idx < NB * SEQ * 16; idx += F.G * NTHREADS) {
            const int i = idx & 15, bs = idx >> 4;
            const float inv = exp2f(-(float)i * (1.f / 16.f) * 18.931568569324174f);
            const float ang = (float)pos[bs] * inv;
            rc[idx] = cosf(ang); rs[idx] = sinf(ang);
        }
    }
}

struct EpiProj {
    static constexpr bool AFTER_DRAIN = false;
    const float* rstd1; const float* rc; const float* rs; bf16_t* qn; bf16_t* qr; bf16_t* kv; bf16_t* u; float* gates;
    __device__ __forceinline__ void operator()(const pg8::f32x4 (&acc)[2][2][4][2], const pg8::Unit& un, int wr, int wc, int fr, int fq) const {
        const int pn = un.pn;
#pragma unroll
        for (int ai = 0; ai < 2; ++ai)
#pragma unroll
            for (int m = 0; m < 4; ++m) {
                const int row = un.pm * 256 + ai * 128 + wr * 64 + m * 16 + fr; const float r1 = rstd1[row]; const int b = row >> 11, s = row & 2047;
                if (pn < 10) {
                    const bool ropeu = (pn < 4) || pn == 6 || pn == 8;
                    pg8::f32x4 c4 = {1.f, 1.f, 1.f, 1.f}, s4 = {0.f, 0.f, 0.f, 0.f};
                    if (ropeu && wc == 0) { c4 = *(const pg8::f32x4*)(rc + (size_t)row * 16 + 4 * fq); s4 = *(const pg8::f32x4*)(rs + (size_t)row * 16 + 4 * fq); }
#pragma unroll
                    for (int bj = 0; bj < 2; ++bj) {
                        const pg8::f32x4 v0 = acc[ai][bj][m][0] * r1, v1 = acc[ai][bj][m][1] * r1;
                        const int d0 = 32 * wc + 4 * fq;
                        pg8::f32x4 o0 = v0, o1 = v1;
                        if (ropeu && wc == 0) { o0 = v0 * c4 - v1 * s4; o1 = v1 * c4 + v0 * s4; }
                        uint2 w0, w1; w0.x = pg8::cvt_pk_bf16(o0[0], o0[1]); w0.y = pg8::cvt_pk_bf16(o0[2], o0[3]); w1.x = pg8::cvt_pk_bf16(o1[0], o1[1]); w1.y = pg8::cvt_pk_bf16(o1[2], o1[3]);
                        if (pn < 4) {
                            const size_t o = (((size_t)b * NH + 2 * pn + bj) * SEQ + s) * HD + d0;
                            uint2 n0, n1; n0.x = pg8::cvt_pk_bf16(v0[0], v0[1]); n0.y = pg8::cvt_pk_bf16(v0[2], v0[3]); n1.x = pg8::cvt_pk_bf16(v1[0], v1[1]); n1.y = pg8::cvt_pk_bf16(v1[2], v1[3]);
                            *(uint2*)(qn + o) = n0; *(uint2*)(qn + o + 16) = n1; *(uint2*)(qr + o) = w0; *(uint2*)(qr + o + 16) = w1;
                        } else {
                            const size_t o = (size_t)(pn - 4) * (4 * MB / 2) + (((size_t)b * NG + bj) * SEQ + s) * HD + d0;
                            *(uint2*)(kv + o) = w0; *(uint2*)(kv + o + 16) = w1;
                        }
                    }
                } else if (pn < 14) {
#pragma unroll
                    for (int bj = 0; bj < 2; ++bj)
#pragma unroll
                        for (int n = 0; n < 2; ++n) { const pg8::f32x4 v = acc[ai][bj][m][n] * r1; uint2 w_; w_.x = pg8::cvt_pk_bf16(v[0], v[1]); w_.y = pg8::cvt_pk_bf16(v[2], v[3]);
                            *(uint2*)(u + (size_t)row * 1024 + (pn - 10) * 256 + bj * 128 + wc * 32 + n * 16 + 4 * fq) = w_; }
                } else {
                    if (wc == 0) { *(pg8::f32x4*)(gates + (size_t)row * 24 + 4 * fq) = acc[ai][0][m][0] * r1; if (fq < 2) *(pg8::f32x4*)(gates + (size_t)row * 24 + 16 + 4 * fq) = acc[ai][0][m][1] * r1; }
                }
            }
    }
};

__device__ __forceinline__ void p1_proj(const Frame& F, LAS unsigned char* stage) {
    pg8::DenseOrder S; S.init(F.ws + WS_XB, F.ws + WS_WINT, DM, DM, NT, INWP, F.G, F.bid);
    EpiProj E{(const float*)(F.ws + WS_RSTD1), (const float*)(F.ws + WS_ROPEC), (const float*)(F.ws + WS_ROPES), (bf16_t*)(F.ws + WS_QN), (bf16_t*)(F.ws + WS_QR), (bf16_t*)(F.ws + WS_KV),
              (bf16_t*)(F.ws + WS_U), (float*)(F.ws + WS_GATES)};
    pg8::gemm_phase<EpiProj, pg8::DenseOrder, false>(stage, DM, DM, DM, S, E);
}

__device__ __forceinline__ void p4_cmp2(const Frame& F, int first, int stride, bool gated) {
    const float* part = (const float*)(F.ws + WS_CPART); const float* bias1p = (const float*)(F.ws + WS_BIAS1); bf16_t* ckv = (bf16_t*)(F.ws + WS_CMPKV);
    float* H = F.lds;
    float* W2 = F.lds + 8 * 260;
    unsigned* ctl = (unsigned*)(F.ws + WS_CTL);
    int w2_of = -1;
    for (int it = first; it < 256; it += stride) {
        const int kvi = it >> 7, r0 = (it & 127) * 8; const float* w2 = kvi ? F.in[I_WV2] : F.in[I_WK2];
        __syncthreads();
        if (gated && F.tid == 0) { unsigned* cw = ctl + CW_CMPR + 64 * (kvi * 4 + (r0 >> 8)); unsigned sp = 0;
            while (__hip_atomic_load(cw, __ATOMIC_RELAXED, __HIP_MEMORY_SCOPE_AGENT) < 8u) { __builtin_amdgcn_s_sleep(2);
                if ((++sp & 255u) == 0u) { if (xb_ld(&ctl[XB_TMO])) break; if (sp > XB_SPIN_CAP) { atomicAdd(&ctl[XB_TMO], 1u); break; } } }
            __builtin_amdgcn_fence(__ATOMIC_ACQUIRE, "agent"); asm volatile("s_waitcnt vmcnt(0)" ::: "memory"); }
        if (gated) __syncthreads();
        if (w2_of != kvi) {
#pragma unroll
            for (int j = 0; j < 16; ++j) { const int idx = F.tid + 512 * j; *(pg8::f32x4*)(W2 + idx * 4) = *(const pg8::f32x4*)(w2 + idx * 4); }
            w2_of = kvi;
        }
        { const int r = F.tid >> 6, c = (F.tid & 63) * 4;
            pg8::f32x4 s = {0.f, 0.f, 0.f, 0.f};
#pragma unroll
            for (int sp = 0; sp < 8; ++sp) s += *(const pg8::f32x4*)(part + (((size_t)sp * 2 + kvi) * 1024 + r0 + r) * 256 + c);
#pragma unroll
            for (int sp = 0; sp < 32; ++sp) s += *(const pg8::f32x4*)(bias1p + (sp * 2 + kvi) * 256 + c);
            H[r * 260 + c] = gelu_tanh(s[0]); H[r * 260 + c + 1] = gelu_tanh(s[1]); H[r * 260 + c + 2] = gelu_tanh(s[2]); H[r * 260 + c + 3] = gelu_tanh(s[3]); }
        __syncthreads();
        const int r = F.tid >> 6, c0 = (F.tid & 63) * 2;
        float a0 = 0.f, a1 = 0.f;
#pragma unroll 16
        for (int k = 0; k < 256; ++k) { const float hv = H[r * 260 + k]; const float2 wv = *(const float2*)(W2 + k * 128 + c0); a0 += hv * wv.x; a1 += hv * wv.y; }
        const int R = r0 + r; const bool pad = (R & 127) == 127;
        *(unsigned*)(ckv + ((size_t)kvi * 1024 + R) * 128 + c0) = pad ? 0u : pg8::cvt_pk_bf16(a0, a1);
    }
}

struct CmpOrder {
    const char* kc; const char* w1t; int c;
    __device__ __forceinline__ bool next(int i, pg8::Unit& u) const { if (i > 0) return false; u.e = c >> 5; u.pm = (c >> 3) & 3; u.pn = c & 7; u.li = 0; return true; }
    __device__ __forceinline__ const char* a_base(const pg8::Unit& u) const { return kc + (size_t)u.e * 4 * MB + ((size_t)u.pm * 256 * 2048 + u.pn * 512) * 2; }
    __device__ __forceinline__ const char* b_base(const pg8::Unit& u) const { return w1t + ((size_t)u.e * 256 * 4096 + u.pn * 512) * 2; }
    __device__ __forceinline__ unsigned a_row_off(const pg8::Unit&, int r) const { return (unsigned)r * 4096u; }
};
struct EpiCmp {
    static constexpr bool AFTER_DRAIN = false;
    float* part;
    __device__ __forceinline__ void operator()(const pg8::f32x4 (&acc)[2][2][4][2], const pg8::Unit& un, int wr, int wc, int fr, int fq) const {
        float* base = part + (((size_t)un.pn * 2 + un.e) * 1024 + un.pm * 256) * 256;
#pragma unroll
        for (int ai = 0; ai < 2; ++ai)
#pragma unroll
            for (int m = 0; m < 4; ++m) { float* rowp = base + (size_t)(ai * 128 + wr * 64 + m * 16 + fr) * 256 + wc * 32 + 4 * fq;
#pragma unroll
                for (int bj = 0; bj < 2; ++bj)
#pragma unroll
                    for (int n = 0; n < 2; ++n) *(pg8::f32x4*)(rowp + bj * 128 + n * 16) = acc[ai][bj][m][n]; }
    }
};
struct PoolOrder {
    const char* d; const char* wpt; int c;
    __device__ __forceinline__ bool next(int i, pg8::Unit& u) const { if (i > 0) return false; u.pm = c >> 2; u.pn = 0; u.e = c & 3; u.li = 0; return true; }
    __device__ __forceinline__ const char* a_base(const pg8::Unit& u) const { return d + ((size_t)u.pm * 256 * 1024 + u.e * 256) * 2; }
    __device__ __forceinline__ const char* b_base(const pg8::Unit& u) const { return wpt + (size_t)u.e * 256 * 256 * 2; }
    __device__ __forceinline__ unsigned a_row_off(const pg8::Unit&, int r) const { return (unsigned)r * 2048u; }
};
struct EpiPool {
    static constexpr bool AFTER_DRAIN = false;
    const float* pb; bf16_t* opool;
    __device__ __forceinline__ void operator()(const pg8::f32x4 (&acc)[2][2][4][2], const pg8::Unit& un, int wr, int wc, int fr, int fq) const {
#pragma unroll
        for (int ai = 0; ai < 2; ++ai)
#pragma unroll
            for (int m = 0; m < 4; ++m) { const int row = un.pm * 256 + ai * 128 + wr * 64 + m * 16 + fr;
#pragma unroll
                for (int bj = 0; bj < 2; ++bj)
#pragma unroll
                    for (int n = 0; n < 2; ++n) { const int c = un.e * 256 + bj * 128 + wc * 32 + n * 16 + 4 * fq;
                        const pg8::f32x4 v = acc[ai][bj][m][n] + *(const pg8::f32x4*)(pb + c); uint2 w_; w_.x = pg8::cvt_pk_bf16(v[0], v[1]); w_.y = pg8::cvt_pk_bf16(v[2], v[3]);
                        *(uint2*)(opool + (size_t)row * 1024 + c) = w_; } }
    }
};
__device__ __forceinline__ void p2a_mid(const Frame& F, LAS unsigned char* stage) {
    if (F.bid < 64) {
        CmpOrder S{(const char*)(F.ws + WS_KV), (const char*)(F.ws + WS_CMPW), F.bid};
        EpiCmp E{(float*)(F.ws + WS_CPART)};
        pg8::gemm_phase<EpiCmp, CmpOrder, false>(stage, 512, 2048, 4096, S, E);
    } else {
        const bf16_t* u = (const bf16_t*)(F.ws + WS_U); bf16_t* d = (bf16_t*)(F.ws + WS_DBUF);
        for (int ch = F.bid - 64; ch < NT / 16; ch += F.G - 64) {
            const int r0 = ch * 16, s0 = r0 & 2047, col = 2 * F.tid, w = 2 << (col >> 8);
            float u0[31], u1[31];
#pragma unroll
            for (int q = 0; q < 31; ++q) { const int s = s0 - 15 + q; const unsigned pr = (s >= 0) ? *(const unsigned*)(u + (size_t)(r0 - 15 + q) * 1024 + col) : 0u;
                u0[q] = __uint_as_float(pr << 16); u1[q] = __uint_as_float(pr & 0xFFFF0000u); }
#pragma unroll
            for (int i = 0; i < 16; ++i) { float sa = 0.f, sb = 0.f;
#pragma unroll
                for (int q = 0; q < 16; ++q) if (q < w) { sa += u0[15 + i - q]; sb += u1[15 + i - q]; }
                const int s = s0 + i, cnt = (s + 1 < w) ? s + 1 : w; const float ic = 1.f / (float)cnt;
                *(unsigned*)(d + (size_t)(r0 + i) * 1024 + col) = pg8::cvt_pk_bf16(sa * ic - u0[15 + i], sb * ic - u1[15 + i]); }
        }
        p0_tables(F, F.bid - 64, F.G - 64);
    }
}
__device__ __forceinline__ void p2b_mid(const Frame& F, LAS unsigned char* stage) {
    if (F.bid < 128) {
        PoolOrder S{(const char*)(F.ws + WS_DBUF), (const char*)(F.ws + WS_POOLW), F.bid};
        EpiPool E{(const float*)(F.ws + WS_POOLB), (bf16_t*)(F.ws + WS_OPOOL)};
        pg8::gemm_phase<EpiPool, PoolOrder, false>(stage, 256, 1024, 256, S, E);
    } else {
        p4_cmp2(F, F.bid - 128, F.G - 128, false);
        cvt_stream(F, 6144, 6400, nullptr, F.bid - 128, F.G - 128);
    }
}

__device__ __forceinline__ void unpack8(const pg8::u32x4 w, float (&f)[8]) {
    f[0] = __uint_as_float(w.x << 16); f[1] = __uint_as_float(w.x & 0xFFFF0000u); f[2] = __uint_as_float(w.y << 16); f[3] = __uint_as_float(w.y & 0xFFFF0000u);
    f[4] = __uint_as_float(w.z << 16); f[5] = __uint_as_float(w.z & 0xFFFF0000u); f[6] = __uint_as_float(w.w << 16); f[7] = __uint_as_float(w.w & 0xFFFF0000u);
}
__device__ __forceinline__ void p6_mix(const Frame& F) {
    const bf16_t* ocmp = (const bf16_t*)(F.ws + WS_OCMP); const bf16_t* owin = (const bf16_t*)(F.ws + WS_OWIN); const bf16_t* osel = (const bf16_t*)(F.ws + WS_OSEL);
    const float* ml = (const float*)(F.ws + WS_ML); const float* gates = (const float*)(F.ws + WS_GATES);
    const bf16_t* opool = (const bf16_t*)(F.ws + WS_OPOOL); bf16_t* mix = (bf16_t*)(F.ws + WS_MIX);
    const float* gn = F.in[I_GNNSA]; const float* gp = F.in[I_GNPOOL];
    const int gw = F.bid * NWAVES + F.wave, nw = F.G * NWAVES, lane = F.lane, h = lane >> 3;
    for (int r = gw; r < NT; r += nw) {
        const bool split = ((r & 2047) >> 6) >= 16;
        const size_t o = (size_t)r * 1024 + lane * 16;
        const float* gq = gates + (size_t)r * 24 + h * 3;
        const float g0 = 1.f / (1.f + __expf(-gq[0])), g1 = 1.f / (1.f + __expf(-gq[1])), g2 = 1.f / (1.f + __expf(-gq[2]));
        float w0 = 1.f, w1 = 0.f;
        if (split) { const float* m0p = ml + ((size_t)r * NH + h) * 2; const float* m1p = ml + (((size_t)NT + r) * NH + h) * 2;
            const float m0 = m0p[0], l0 = m0p[1], m1 = m1p[0], l1 = m1p[1], M = fmaxf(m0, m1);
            const float a0 = l0 * exp2f((m0 - M) * att::C2), a1 = l1 * exp2f((m1 - M) * att::C2), inv = 1.f / (a0 + a1); w0 = a0 * inv; w1 = a1 * inv; }
        float a[16], p[16]; float sa = 0.f, sp = 0.f;
#pragma unroll
        for (int hf = 0; hf < 2; ++hf) {
            float c8[8], w8[8], s8[8], t8[8];
            unpack8(*(const pg8::u32x4*)(ocmp + o + hf * 8), c8); unpack8(*(const pg8::u32x4*)(owin + o + hf * 8), w8); unpack8(*(const pg8::u32x4*)(osel + o + hf * 8), s8);
            if (split) unpack8(*(const pg8::u32x4*)(osel + (size_t)NT * 1024 + o + hf * 8), t8);
#pragma unroll
            for (int j = 0; j < 8; ++j) { const float os = split ? (w0 * s8[j] + w1 * t8[j]) : s8[j]; a[hf * 8 + j] = g0 * c8[j] + g1 * os + g2 * w8[j]; sa += a[hf * 8 + j] * a[hf * 8 + j]; }
        }
#pragma unroll
        for (int q = 0; q < 2; ++q) { float p8[8]; unpack8(*(const pg8::u32x4*)(opool + o + q * 8), p8);
#pragma unroll
            for (int j = 0; j < 8; ++j) { p[q * 8 + j] = p8[j]; sp += p8[j] * p8[j]; } }
        sa = wave_sum(sa); sp = wave_sum(sp);
        const float ra = rsqrtf(sa * (1.f / 1024.f) + EPS), rp = rsqrtf(sp * (1.f / 1024.f) + EPS);
        float ga[16], gb[16];
#pragma unroll
        for (int q = 0; q < 4; ++q) { const pg8::f32x4 v = *(const pg8::f32x4*)(gn + lane * 16 + q * 4), u = *(const pg8::f32x4*)(gp + lane * 16 + q * 4);
            ga[q * 4] = v[0]; ga[q * 4 + 1] = v[1]; ga[q * 4 + 2] = v[2]; ga[q * 4 + 3] = v[3]; gb[q * 4] = u[0]; gb[q * 4 + 1] = u[1]; gb[q * 4 + 2] = u[2]; gb[q * 4 + 3] = u[3]; }
#pragma unroll
        for (int hf = 0; hf < 2; ++hf) { pg8::u32x4 wa, wb;
            wa.x = pg8::cvt_pk_bf16(a[hf * 8] * ra * ga[hf * 8], a[hf * 8 + 1] * ra * ga[hf * 8 + 1]); wa.y = pg8::cvt_pk_bf16(a[hf * 8 + 2] * ra * ga[hf * 8 + 2], a[hf * 8 + 3] * ra * ga[hf * 8 + 3]);
            wa.z = pg8::cvt_pk_bf16(a[hf * 8 + 4] * ra * ga[hf * 8 + 4], a[hf * 8 + 5] * ra * ga[hf * 8 + 5]); wa.w = pg8::cvt_pk_bf16(a[hf * 8 + 6] * ra * ga[hf * 8 + 6], a[hf * 8 + 7] * ra * ga[hf * 8 + 7]);
            wb.x = pg8::cvt_pk_bf16(p[hf * 8] * rp * gb[hf * 8], p[hf * 8 + 1] * rp * gb[hf * 8 + 1]); wb.y = pg8::cvt_pk_bf16(p[hf * 8 + 2] * rp * gb[hf * 8 + 2], p[hf * 8 + 3] * rp * gb[hf * 8 + 3]);
            wb.z = pg8::cvt_pk_bf16(p[hf * 8 + 4] * rp * gb[hf * 8 + 4], p[hf * 8 + 5] * rp * gb[hf * 8 + 5]); wb.w = pg8::cvt_pk_bf16(p[hf * 8 + 6] * rp * gb[hf * 8 + 6], p[hf * 8 + 7] * rp * gb[hf * 8 + 7]);
            *(pg8::u32x4*)(mix + (size_t)r * DM + lane * 16 + hf * 8) = wa; *(pg8::u32x4*)(mix + (size_t)r * DM + 1024 + lane * 16 + hf * 8) = wb; }
    }
}

struct EpiOut {
    static constexpr bool AFTER_DRAIN = true;
    const float* x; float* out; bf16_t* x1b; const float* lnm; const float* wrp; float* pl;
    __device__ __forceinline__ void fused(pg8::f32x4 (&acc)[2][2][4][2], const pg8::Unit& un, int wr, int wc, int fr, int fq, LAS unsigned char* lds) const {
#pragma unroll
        for (int ai = 0; ai < 2; ++ai)
#pragma unroll
            for (int m = 0; m < 4; ++m) {
                const int row = un.pm * 256 + ai * 128 + wr * 64 + m * 16 + fr;
#pragma unroll
                for (int bj = 0; bj < 2; ++bj)
#pragma unroll
                    for (int n = 0; n < 2; ++n) {
                        const size_t o = (size_t)row * DM + un.pn * 256 + bj * 128 + wc * 32 + n * 16 + 4 * fq;
                        const pg8::f32x4 v = acc[ai][bj][m][n] + *(const pg8::f32x4*)(x + o);
                        acc[ai][bj][m][n] = v;
                        const pg8::f32x4 g = *(const pg8::f32x4*)(lnm + un.pn * 256 + bj * 128 + wc * 32 + n * 16 + 4 * fq);
                        uint2 w; w.x = pg8::cvt_pk_bf16(v[0] * g[0], v[1] * g[1]); w.y = pg8::cvt_pk_bf16(v[2] * g[2], v[3] * g[3]); *(uint2*)(x1b + o) = w;
                    }
            }
        float* red = (float*)((unsigned char*)lds);
        const int tid = threadIdx.x;
#pragma unroll 1
        for (int ai = 0; ai < 2; ++ai) {
#pragma unroll
            for (int m = 0; m < 4; ++m) {
                pg8::f32x4 D0 = {0.f, 0.f, 0.f, 0.f}, D1 = D0, D2 = D0; float s2 = 0.f;
#pragma unroll
                for (int bj = 0; bj < 2; ++bj)
#pragma unroll
                    for (int n = 0; n < 2; ++n) {
                        const pg8::f32x4 v = (ai == 0) ? acc[0][bj][m][n] : acc[1][bj][m][n];
                        s2 += v[0] * v[0] + v[1] * v[1] + v[2] * v[2] + v[3] * v[3];
                        const float* wb = wrp + (size_t)(un.pn * 256 + bj * 128 + wc * 32 + n * 16 + 4 * fq) * 48 + fr;
#pragma unroll
                        for (int j = 0; j < 4; ++j) {
                            D0 = __builtin_amdgcn_mfma_f32_16x16x4f32(v[j], wb[j * 48], D0, 0, 0, 0);
                            D1 = __builtin_amdgcn_mfma_f32_16x16x4f32(v[j], wb[j * 48 + 16], D1, 0, 0, 0);
                            D2 = __builtin_amdgcn_mfma_f32_16x16x4f32(v[j], wb[j * 48 + 32], D2, 0, 0, 0);
                        }
                    }
                s2 += __shfl_xor(s2, 16); s2 += __shfl_xor(s2, 32);
                float* rr = red + ((size_t)wc * 128 + wr * 64 + m * 16) * 40;
#pragma unroll
                for (int r = 0; r < 4; ++r) { float* q = rr + (4 * fq + r) * 40; q[fr] = D0[r]; q[16 + fr] = D1[r]; if (fr < 8) q[32 + fr] = D2[r]; }
                if (fq == 0) rr[fr * 40 + 36] = s2;
            }
            __syncthreads();
            for (int idx = tid; idx < 128 * 40; idx += 512) { const int r = idx / 40, c = idx - r * 40;
                const float s = (red[idx] + red[128 * 40 + idx]) + (red[2 * 128 * 40 + idx] + red[3 * 128 * 40 + idx]);
                if (c < 37) pl[((size_t)un.pn * NT + un.pm * 256 + ai * 128 + r) * 40 + c] = s; }
            __syncthreads();
        }
    }
};
__device__ __forceinline__ void p7_out(const Frame& F, LAS unsigned char* stage) {
    pg8::DenseOrder S; S.init(F.ws + WS_MIX, F.ws + WS_WOUTT, DM, DM, NT, DM, F.G, F.bid);
    EpiOut E{F.in[I_X], F.out, (bf16_t*)(F.ws + WS_X1B), F.in[I_LNMOE], (const float*)(F.ws + WS_WRP), (float*)(F.ws + WS_PL)};
    pg8::gemm_phase<EpiOut, pg8::DenseOrder, false>(stage, DM, DM, DM, S, E);
}

__device__ __forceinline__ void p8_router(const Frame& F, int dummy) {
    const float* pl = (const float*)(F.ws + WS_PL); const float* brg = F.in[I_BRG]; const float* bre = F.in[I_BRE];
    float* rstd2 = (float*)(F.ws + WS_RSTD2); int* arow = (int*)(F.ws + WS_AROW); int* tokl = (int*)(F.ws + WS_TOKL); float* gatel = (float*)(F.ws + WS_GATEL);
    unsigned* cnt = (unsigned*)(F.ws + WS_CTL) + CW_CNT; (void)dummy;
    const int gw = F.bid * NWAVES + F.wave, nw = F.G * NWAVES, lane = F.lane, tl = lane >> 3, pn = lane & 7;
    for (int wv = gw; wv < NT / 8; wv += nw) {
        const int r = wv * 8 + tl;
        const float* p = pl + ((size_t)pn * NT + r) * 40;
        float v[37];
#pragma unroll
        for (int q = 0; q < 9; ++q) { const pg8::f32x4 t = *(const pg8::f32x4*)(p + 4 * q); v[4 * q] = t[0]; v[4 * q + 1] = t[1]; v[4 * q + 2] = t[2]; v[4 * q + 3] = t[3]; }
        v[36] = p[36];
#pragma unroll
        for (int c = 0; c < 37; ++c) { v[c] += __shfl_xor(v[c], 1); v[c] += __shfl_xor(v[c], 2); v[c] += __shfl_xor(v[c], 4); }
        if (pn == 0) {
            const float rs = rsqrtf(v[36] * (1.f / DM) + EPS);
            float lg[4];
#pragma unroll
            for (int j = 0; j < 4; ++j) lg[j] = v[32 + j] * rs + brg[j];
            int gs = 0; float gm = lg[0];
#pragma unroll
            for (int j = 1; j < 4; ++j) if (lg[j] > gm) { gm = lg[j]; gs = j; }
            float den = 0.f;
#pragma unroll
            for (int j = 0; j < 4; ++j) den += __expf(lg[j] - gm);
            const float pg = 1.f / den;
            float le[8];
#pragma unroll
            for (int j = 0; j < 8; ++j) { const float s = (gs == 0) ? v[j] : (gs == 1) ? v[8 + j] : (gs == 2) ? v[16 + j] : v[24 + j]; le[j] = s * rs + bre[gs * 8 + j]; }
            int e0 = 0; float m0 = le[0];
#pragma unroll
            for (int j = 1; j < 8; ++j) if (le[j] > m0) { m0 = le[j]; e0 = j; }
            int e1 = -1; float m1 = -3.0e38f;
#pragma unroll
            for (int j = 0; j < 8; ++j) if (j != e0 && le[j] > m1) { m1 = le[j]; e1 = j; }
            const float p1 = __expf(m1 - m0);
            const float gate0 = pg / (1.f + p1), gate1 = pg * p1 / (1.f + p1);
            rstd2[r] = rs;
            const int ea = gs * 8 + e0, eb = gs * 8 + e1;
            const unsigned sa = atomicAdd(&cnt[64 * ea], 1u), sb = atomicAdd(&cnt[64 * eb], 1u);
            tokl[ea * 8192 + sa] = r; gatel[ea * 8192 + sa] = gate0; tokl[eb * 8192 + sb] = r; gatel[eb * 8192 + sb] = gate1;
            arow[2 * r] = ea * 8192 + (int)sa; arow[2 * r + 1] = eb * 8192 + (int)sb;
        }
    }
}

__device__ __forceinline__ void moe_counts(const Frame& F, int* cnts  , int* pst  ) {
    const unsigned* cnt = (const unsigned*)(F.ws + WS_CTL) + CW_CNT;
    __syncthreads();
    if (F.tid < 32) cnts[F.tid] = (int)__hip_atomic_load(&cnt[64 * F.tid], __ATOMIC_RELAXED, __HIP_MEMORY_SCOPE_AGENT);
    __syncthreads();
    if (F.tid == 0) { int a = 0; for (int e = 0; e < 32; ++e) { pst[e] = a; a += (cnts[e] + 255) & ~255; } pst[32] = a; }
    __syncthreads();
}

constexpr int MOE_TAB_OFF = 1024 + 131072;
struct MoeTabs { int* cnts; int* pst; int* ust; int* usth; int* rowtok; };
__device__ __forceinline__ MoeTabs moe_tabs(unsigned char* lds_raw) { MoeTabs T; T.cnts = (int*)(lds_raw + MOE_TAB_OFF); T.pst = T.cnts + 32; T.ust = T.pst + 40; T.usth = T.ust + 40; T.rowtok = T.usth + 40; return T; }
template <int NTN> __device__ __forceinline__ void moe_units(const Frame& F, const MoeTabs& T) {
    moe_counts(F, T.cnts, T.pst);
    if (F.tid == 0) { int a = 0, h = 0; for (int e = 0; e < 32; ++e) { const int c = T.cnts[e], nmt = (c + 255) >> 8, hl = (nmt > 0 && c - 256 * (nmt - 1) <= 128) ? 1 : 0;
            T.ust[e] = a; T.usth[e] = h; a += (nmt - hl) * NTN; h += hl * NTN; } T.ust[32] = a; T.usth[32] = h; }
    __syncthreads();
}
template <int NTN> struct MoeOrder2 {
    const int* cnts; const int* pst; const int* ust; const int* usth; const int* rowtok; const bf16_t* A; const float* W0; const float* W1; int G, c, lda, ldb, gather;
    __device__ __forceinline__ bool next(int i, g2::Unit& u) const {
        int L = i * G + c; u.li = i;
        if (L < ust[32]) {
            int e = 0; while (ust[e + 1] <= L) ++e;
            const int w = L - ust[e], c_ = cnts[e], nmt = (c_ + 255) >> 8, nf = nmt - ((c_ - 256 * (nmt - 1) <= 128) ? 1 : 0);
            u.e = e; u.pn = w / nf; u.pm = w - u.pn * nf; u.half = 0; return true; }
        L -= ust[32]; if (L >= usth[32]) return false;
        int e = 0; while (usth[e + 1] <= L) ++e;
        u.e = e; u.pn = L - usth[e]; u.pm = ((cnts[e] + 255) >> 8) - 1; u.half = 1; return true;
    }
    __device__ __forceinline__ int nvalid(const g2::Unit& u) const { const int v = cnts[u.e] - u.pm * 256; return v < 256 ? v : 256; }
    __device__ __forceinline__ unsigned a_off(const g2::Unit& u, int r) const {
        if (gather) { const int tk = rowtok[u.li * 256 + r]; return (unsigned)(tk < 0 ? 0 : tk) * (unsigned)lda * 2u; }
        return (unsigned)(pst[u.e] + u.pm * 256 + r) * (unsigned)lda * 2u;
    }
    __device__ __forceinline__ const float* b_col(const g2::Unit& u, int col) const {
        if (gather) { const int wcp = col >> 5, n = (col >> 4) & 1, i = col & 15; return (n ? W1 : W0) + (size_t)u.e * DM * FF + u.pn * 64 + 16 * wcp + i; }
        return W0 + (size_t)u.e * FF * DM + u.pn * 128 + col;
    }
};
struct EpiMoe1 {
    const int* pst; const int* rowtok; const float* rstd2; bf16_t* act;
    __device__ __forceinline__ void operator()(const pg8::f32x4 (&acc)[2][4][2], const g2::Unit& un, int wr, int wc, int fr, int fq) const {
#pragma unroll
        for (int ai = 0; ai < 2; ++ai)
#pragma unroll
            for (int m = 0; m < 4; ++m) {
                const int r = ai * 128 + wr * 64 + m * 16 + fr; const int tk = rowtok[un.li * 256 + r];
                if (tk >= 0) {
                    const float rs = rstd2[tk];
                    const pg8::f32x4 vg = acc[ai][m][0] * rs, vu = acc[ai][m][1] * rs; float o[4];
#pragma unroll
                    for (int j = 0; j < 4; ++j) o[j] = vg[j] / (1.f + __expf(-vg[j])) * vu[j];
                    uint2 w; w.x = pg8::cvt_pk_bf16(o[0], o[1]); w.y = pg8::cvt_pk_bf16(o[2], o[3]);
                    *(uint2*)(act + (size_t)(pst[un.e] + un.pm * 256 + r) * FF + un.pn * 64 + wc * 16 + 4 * fq) = w;
                }
            }
    }
};
struct EpiMoe2 {
    const int* cnts; const int* pst; const float* gatel; bf16_t* y;
    __device__ __forceinline__ void operator()(const pg8::f32x4 (&acc)[2][4][2], const g2::Unit& un, int wr, int wc, int fr, int fq) const {
#pragma unroll
        for (int ai = 0; ai < 2; ++ai)
#pragma unroll
            for (int m = 0; m < 4; ++m) {
                const int slot = un.pm * 256 + ai * 128 + wr * 64 + m * 16 + fr;
                if (slot < cnts[un.e]) {
                    const float gt = gatel[un.e * 8192 + slot];
                    bf16_t* dst = y + (size_t)(pst[un.e] + slot) * DM + un.pn * 128 + wc * 32 + 4 * fq;
#pragma unroll
                    for (int n = 0; n < 2; ++n) { const pg8::f32x4 v = acc[ai][m][n] * gt; uint2 w; w.x = pg8::cvt_pk_bf16(v[0], v[1]); w.y = pg8::cvt_pk_bf16(v[2], v[3]); *(uint2*)(dst + n * 16) = w; }
                }
            }
    }
};

__device__ __forceinline__ void p9_moe1(const Frame& F, unsigned char* lds_raw, LAS unsigned char* stage) {
    const MoeTabs T = moe_tabs(lds_raw);
    moe_units<8>(F, T);
    const int vc = (F.G % 8 == 0) ? (F.bid % 8) * (F.G / 8) + F.bid / 8 : F.bid;
    MoeOrder2<8> S{T.cnts, T.pst, T.ust, T.usth, T.rowtok, (const bf16_t*)(F.ws + WS_X1B), F.in[I_WGATE], F.in[I_WUP], F.G, vc, DM, FF, 1};
    { const int* tokl = (const int*)(F.ws + WS_TOKL); g2::Unit u;
      for (int i = 0; i < 4 && S.next(i, u); ++i) { if (F.tid < 256) { const int slot = u.pm * 256 + F.tid; T.rowtok[i * 256 + F.tid] = slot < T.cnts[u.e] ? tokl[u.e * 8192 + slot] : -1; } } }
    asm volatile("s_waitcnt vmcnt(0) lgkmcnt(0)" ::: "memory");
    __syncthreads();
    EpiMoe1 E{T.pst, T.rowtok, (const float*)(F.ws + WS_RSTD2), (bf16_t*)(F.ws + WS_ACT)};
    g2::gemm<DM / 64, EpiMoe1, MoeOrder2<8>>(stage, S, E, F.wave, (PROBE_REPEAT >= 30 && PROBE_REPEAT <= 33) ? (unsigned long long*)(lds_raw + 512) : nullptr);
}

__device__ __forceinline__ void p10_moe2(const Frame& F, unsigned char* lds_raw, LAS unsigned char* stage) {
    const MoeTabs T = moe_tabs(lds_raw);
    moe_units<16>(F, T);
    const int vc = (F.G % 8 == 0) ? (F.bid % 8) * (F.G / 8) + F.bid / 8 : F.bid;
    MoeOrder2<16> S{T.cnts, T.pst, T.ust, T.usth, nullptr, (const bf16_t*)(F.ws + WS_ACT), F.in[I_WDOWN], nullptr, F.G, vc, FF, DM, 0};
    EpiMoe2 E{T.cnts, T.pst, (const float*)(F.ws + WS_GATEL), (bf16_t*)(F.ws + WS_Y)};
    g2::gemm<FF / 64, EpiMoe2, MoeOrder2<16>>(stage, S, E, F.wave);
}

__device__ __forceinline__ void p11_final(const Frame& F, int dummy) {
    int* cnts = (int*)(F.lds + 3072); int* pst = cnts + 32;
    moe_counts(F, cnts, pst);
    const bf16_t* y = (const bf16_t*)(F.ws + WS_Y); const int* arow = (const int*)(F.ws + WS_AROW); const float* lnf = F.in[I_LNFINAL];
    const int gw = F.bid * NWAVES + F.wave, nw = F.G * NWAVES, lane = fresh_lane();
    const bf16_t* x1b = (const bf16_t*)(F.ws + WS_X1B); const float* lnm = F.in[I_LNMOE];
    float4 ig[8];
#pragma unroll
    for (int i = 0; i < 8; ++i) { const float4 g = *(const float4*)(lnm + i * 256 + lane * 4); ig[i].x = 1.f / g.x; ig[i].y = 1.f / g.y; ig[i].z = 1.f / g.z; ig[i].w = 1.f / g.w; }
    for (int r = gw; r < NT; r += nw) {
        const int a0 = arow[2 * r], a1 = arow[2 * r + 1];
        const size_t r0 = (size_t)(pst[a0 >> 13] + (a0 & 8191)), r1 = (size_t)(pst[a1 >> 13] + (a1 & 8191));
        float v[32]; float ss = 0.f;
#pragma unroll
        for (int i = 0; i < 8; ++i) { const int c = i * 256 + lane * 4; const uint2 xq = *(const uint2*)(x1b + (size_t)r * DM + c);
            float4 xv; xv.x = __uint_as_float(xq.x << 16) * ig[i].x; xv.y = __uint_as_float(xq.x & 0xFFFF0000u) * ig[i].y; xv.z = __uint_as_float(xq.y << 16) * ig[i].z; xv.w = __uint_as_float(xq.y & 0xFFFF0000u) * ig[i].w;
            const uint2 ya = *(const uint2*)(y + r0 * DM + c), yb = *(const uint2*)(y + r1 * DM + c);
            v[4 * i]     = xv.x + __uint_as_float(ya.x << 16) + __uint_as_float(yb.x << 16);
            v[4 * i + 1] = xv.y + __uint_as_float(ya.x & 0xFFFF0000u) + __uint_as_float(yb.x & 0xFFFF0000u);
            v[4 * i + 2] = xv.z + __uint_as_float(ya.y << 16) + __uint_as_float(yb.y << 16);
            v[4 * i + 3] = xv.w + __uint_as_float(ya.y & 0xFFFF0000u) + __uint_as_float(yb.y & 0xFFFF0000u);
            ss += v[4 * i] * v[4 * i] + v[4 * i + 1] * v[4 * i + 1] + v[4 * i + 2] * v[4 * i + 2] + v[4 * i + 3] * v[4 * i + 3]; }
        ss = wave_sum(ss);
        const float rs = rsqrtf(ss * (1.f / DM) + EPS);
#pragma unroll
        for (int i = 0; i < 8; ++i) { const int c = i * 256 + lane * 4; const float4 g = *(const float4*)(lnf + c);
            float4 o; o.x = v[4 * i] * rs * g.x; o.y = v[4 * i + 1] * rs * g.y; o.z = v[4 * i + 2] * rs * g.z; o.w = v[4 * i + 3] * rs * g.w;
            *(float4*)((dummy ? (float*)(F.ws + WS_W1T) : F.out) + (size_t)r * DM + c) = o; }
    }
}

constexpr int NPHASE = 11;
__global__ void __launch_bounds__(NTHREADS, 2) fwd(Args args) {
    extern __shared__ __attribute__((aligned(16))) unsigned char lds_raw[];
    Frame F;
#pragma unroll
    for (int i = 0; i < N_IN; ++i) F.in[i] = args.in[i];
    F.out = args.out; F.ws = args.ws;
    F.lds = (float*)(lds_raw + 16);
    F.tid = threadIdx.x; F.lane = F.tid & 63; F.wave = __builtin_amdgcn_readfirstlane(F.tid >> 6); F.G = gridDim.x; F.bid = blockIdx.x;
    if (F.tid < 4) ((LAS unsigned*)lds_raw)[F.tid] = 0u;
    __syncthreads();
    XcdBarrier bar; bar.bar = (unsigned*)(F.ws + WS_CTL); bar.x = 0; bar.st = nullptr;
    if (N_LAUNCHES == 1) bar = xcd_barrier_post((unsigned*)(F.ws + WS_CTL), (volatile LAS unsigned*)lds_raw);
    bar.wave = F.wave;
    const int lo = args.ph_lo, hi = args.ph_hi;
#ifndef ONLY_PHASE
#define ONLY_PHASE -1
#endif
#define IN(k) (lo <= (k) && (k) < hi && (ONLY_PHASE < 0 || ONLY_PHASE == (k)))
#define SEAM(k) do { if (IN(k) && IN((k) + 1)) { const unsigned long long tb_ = (PROBE_REPEAT >= 40) ? (unsigned long long)__builtin_readcyclecounter() : 0ull; xcd_barrier(bar); if (PROBE_REPEAT == 12) xcd_barrier(bar); \
        if (PROBE_REPEAT == 40 || PROBE_REPEAT == 41 + (k)) tbar += (unsigned long long)__builtin_readcyclecounter() - tb_; if (PROBE_REPEAT == 60 + (k)) tbar = (unsigned long long)__builtin_readcyclecounter() - t_k0; } } while (0)
    unsigned long long tbar = 0ull; const unsigned long long t_k0 = (PROBE_REPEAT >= 60) ? (unsigned long long)__builtin_readcyclecounter() : 0ull;
    LAS unsigned char* stage = (LAS unsigned char*)lds_raw + 1024;
#define RUN(k, ...) do { if (IN(k)) { __VA_ARGS__; if (PROBE_REPEAT == (k)) { xcd_barrier(bar); __VA_ARGS__; } } } while (0)
    RUN(0, p0_prologue(F));
    if (PROBE_REPEAT == 11 && IN(0)) { xcd_barrier(bar); cvt_stream(F, 0, 6400, nullptr); }
    SEAM(0);
    RUN(1, p1_proj(F, stage));
    SEAM(1);
    RUN(2, p2a_mid(F, stage));
    SEAM(2);
    RUN(3, p2b_mid(F, stage));
    SEAM(3);
    if (IN(4)) {
#pragma unroll 1
        for (int rep = 0; rep < (PROBE_REPEAT == 4 ? 2 : 1); ++rep) { if (rep) xcd_barrier(bar); p_attn(F, lds_raw, rep); } }
    SEAM(4);
    RUN(5, p6_mix(F));
    SEAM(5);
    RUN(6, p7_out(F, stage));
    SEAM(6);
    if (IN(7)) { if (PROBE_REPEAT == 7) { p8_router(F, 1); xcd_barrier(bar); } p8_router(F, 0); }
    SEAM(7);
#define REFRESH_LANE() do { F.lane = fresh_lane(); F.tid = F.wave * 64 + F.lane; } while (0)
    REFRESH_LANE();
    if (IN(8)) {
#pragma unroll 1
        for (int rep = 0; rep < (PROBE_REPEAT == 8 ? 2 : 1); ++rep) { if (rep) xcd_barrier(bar); p9_moe1(F, lds_raw, stage); } }
    SEAM(8);
    REFRESH_LANE();
    if (IN(9)) {
#pragma unroll 1
        for (int rep = 0; rep < (PROBE_REPEAT == 9 ? 2 : 1); ++rep) { if (rep) xcd_barrier(bar); p10_moe2(F, lds_raw, stage); } }
    SEAM(9);
    REFRESH_LANE();
    if (IN(10)) { if (PROBE_REPEAT == 10) { p11_final(F, 1); xcd_barrier(bar); } const unsigned long long tf0 = (PROBE_REPEAT == 70) ? (unsigned long long)__builtin_readcyclecounter() : 0ull; p11_final(F, 0); if (PROBE_REPEAT == 70) tbar = (unsigned long long)__builtin_readcyclecounter() - tf0; }
#undef RUN
    if (PROBE_REPEAT >= 40 && blockIdx.x == PROBE_WG && threadIdx.x == 0) *(volatile unsigned long long*)(lds_raw + 512) = tbar;
    if (((PROBE_REPEAT >= 30 && PROBE_REPEAT <= 33) || PROBE_REPEAT >= 40) && blockIdx.x == PROBE_WG && threadIdx.x == 0) {
        const unsigned long long want = 4ull * *(volatile unsigned long long*)(lds_raw + 512), t0 = __builtin_readcyclecounter();
        while ((unsigned long long)__builtin_readcyclecounter() - t0 < want) __builtin_amdgcn_s_sleep(8);
    }
#undef IN
#undef SEAM
}

extern "C" void kernel_launch(void* const* d_in, const int* in_sizes, int n_in, void* d_out, int out_size, void* d_ws, size_t ws_size, hipStream_t stream) {
    static int grid = 0;
    if (grid == 0) {
        if (n_in != N_IN || out_size != NT * DM || ws_size < WS_END) { fprintf(stderr, "kernel_launch: unexpected shapes: n_in %d out %d ws %zu (need %zu)\n", n_in, out_size, ws_size, (size_t)WS_END); grid = -1; return; }
        int dev = 0, cus = 0, per_cu = 0;
        if (hipGetDevice(&dev) != hipSuccess || hipDeviceGetAttribute(&cus, hipDeviceAttributeMultiprocessorCount, dev) != hipSuccess) { grid = -1; return; }
        if (hipFuncSetAttribute((const void*)fwd, hipFuncAttributeMaxDynamicSharedMemorySize, LDS_BYTES) != hipSuccess) { fprintf(stderr, "kernel_launch: hipFuncSetAttribute failed\n"); grid = -1; return; }
        if (hipOccupancyMaxActiveBlocksPerMultiprocessor(&per_cu, (const void*)fwd, NTHREADS, LDS_BYTES) != hipSuccess || per_cu < 1) { fprintf(stderr, "kernel_launch: occupancy query says %d\n", per_cu); }
        (void)hipGetLastError();
        grid = cus;
    }
    if (grid < 0) return;
    (void)in_sizes;
    (void)hipMemsetAsync((char*)d_ws + WS_CTL, 0, CTL_ZERO_BYTES, stream);
    Args a{};
    for (int i = 0; i < N_IN; ++i) a.in[i] = (const float*)d_in[i];
    a.out = (float*)d_out; a.ws = (unsigned char*)d_ws;
    if (N_LAUNCHES == 1) { a.ph_lo = 0; a.ph_hi = NPHASE; hipLaunchKernelGGL(fwd, dim3(grid), dim3(NTHREADS), LDS_BYTES, stream, a); }
    else { for (int p = 0; p < NPHASE; ++p) { a.ph_lo = p; a.ph_hi = p + 1; hipLaunchKernelGGL(fwd, dim3(grid), dim3(NTHREADS), LDS_BYTES, stream, a); } }
}
```

```cpp
#include <hip/hip_runtime.h>
#include <cstdio>
#include <cstdint>

#ifndef PROBE_REPEAT
#define PROBE_REPEAT -1
#endif
#ifndef MERGE_CMP2
#define MERGE_CMP2 0
#endif
#ifndef PROBE_WG
#define PROBE_WG 0
#endif
#ifndef N_LAUNCHES
#define N_LAUNCHES 1
#endif

#define XB_TMO      128
#define XB_XCNT(j)  (256  + 64 * (j))
#define XB_XSUB(j)  (1280 + 64 * (j))
#define XB_XGEN(j)  (2304 + 64 * (j))
#define XB_TOP      3328
#define XB_TOPGEN   3392
#define XCD_BAR_WORDS 3456
#define XB_SPIN_CAP (1u << 21)
#define LAS __attribute__((address_space(3)))

__device__ __forceinline__ unsigned xb_ld(unsigned* p)              { return __hip_atomic_load(p, __ATOMIC_RELAXED, __HIP_MEMORY_SCOPE_AGENT); }
__device__ __forceinline__ unsigned xb_add(unsigned* p, unsigned v) { return __hip_atomic_fetch_add(p, v, __ATOMIC_RELAXED, __HIP_MEMORY_SCOPE_AGENT); }
__device__ __forceinline__ unsigned xb_xcc_id() { return (unsigned)__builtin_amdgcn_s_getreg((3 << 11) | 20) & 0xFu; }
#define XB_SPIN(cond, bar) do { unsigned _sp = 0; while (cond) { __builtin_amdgcn_s_sleep(1); \
    if ((++_sp & 255u) == 0u) { if (xb_ld(&(bar)[XB_TMO])) break; if (_sp > XB_SPIN_CAP) { atomicAdd(&(bar)[XB_TMO], 1u); break; } } } } while (0)

struct XcdBarrier { unsigned* bar; unsigned x; volatile LAS unsigned* st; int wave; };

__device__ __forceinline__ XcdBarrier xcd_barrier_post(unsigned* bar, volatile LAS unsigned* st) {
    XcdBarrier b; b.bar = bar; b.x = xb_xcc_id(); b.st = st;
    if (threadIdx.x == 0) (void)xb_add(&bar[XB_XCNT(b.x)], 1u);
    return b;
}
__device__ __forceinline__ void xcd_barrier_complete(unsigned* bar, unsigned x, unsigned& nloc, unsigned& nx) {
    const unsigned G = gridDim.x * gridDim.y * gridDim.z;
    unsigned sum, cnt, mine, sp = 0u;
    for (;;) {
        sum = 0u; cnt = 0u; mine = 0u;
#pragma unroll
        for (unsigned j = 0; j < 16; ++j) { const unsigned c = xb_ld(&bar[XB_XCNT(j)]); sum += c; cnt += (c > 0u) ? 1u : 0u; mine = (j == x) ? c : mine; }
        if (sum == G) break;
        __builtin_amdgcn_s_sleep(1);
        if ((++sp & 255u) == 0u) { if (xb_ld(&bar[XB_TMO])) break; if (sp > XB_SPIN_CAP) { atomicAdd(&bar[XB_TMO], 1u); break; } }
    }
    nloc = mine > 0u ? mine : 1u; nx = cnt > 0u ? cnt : 1u;
}
__device__ __forceinline__ int fresh_lane();
__device__ __forceinline__ void xcd_barrier(const XcdBarrier& b) {
    asm volatile("s_waitcnt vmcnt(0)" ::: "memory");
    __syncthreads();
    if (b.wave == 0 && fresh_lane() == 0) {
        unsigned* bar = b.bar;
        __builtin_amdgcn_s_waitcnt(0);
        unsigned nloc = b.st[0], nx = b.st[1];
        if (nloc == 0u) { xcd_barrier_complete(bar, b.x, nloc, nx); b.st[0] = nloc; b.st[1] = nx; }
        const unsigned old = xb_add(&bar[XB_XSUB(b.x)], 1u);
        const unsigned gen = old / nloc;
        if (old + 1u == (gen + 1u) * nloc) {
            __builtin_amdgcn_fence(__ATOMIC_RELEASE, "agent");
            asm volatile("s_waitcnt vmcnt(0)" ::: "memory");
            const unsigned og = xb_add(&bar[XB_TOP], 1u);
            const unsigned tg = og / nx;
            if (og + 1u == (tg + 1u) * nx) xb_add(&bar[XB_TOPGEN], 1u);
            else XB_SPIN(xb_ld(&bar[XB_TOPGEN]) == tg, bar);
            __builtin_amdgcn_fence(__ATOMIC_ACQUIRE, "agent");
            xb_add(&bar[XB_XGEN(b.x)], 1u);
            asm volatile("s_waitcnt vmcnt(0)" ::: "memory");
        } else {
            XB_SPIN(xb_ld(&bar[XB_XGEN(b.x)]) == gen, bar);
            __builtin_amdgcn_fence(__ATOMIC_ACQUIRE, "agent");
            asm volatile("s_waitcnt vmcnt(0)" ::: "memory");
        }
    }
    __syncthreads();
}

typedef unsigned short bf16_t;
constexpr int NB = 4, SEQ = 2048, DM = 2048, NT = NB * SEQ;
constexpr int NH = 8, NG = 2, HD = 128, INW = 3608, INWP = 3840;
constexpr int NCMP = 127, NSEL = 32, NEXP = 32, FF = 512;
constexpr float EPS = 1e-6f;
constexpr float SCALE = 0.08838834764831845f;
constexpr int NTHREADS = 512, NWAVES = 8;
constexpr int LDS_BYTES = 147456;
constexpr int YROWS = 24576;

enum { I_X = 0, I_POS, I_LNMIX, I_WIN, I_PEK, I_WK1, I_WK2, I_PEV, I_WV1, I_WV2, I_WPOOL, I_BPOOL, I_PSCALE, I_GNNSA, I_GNPOOL, I_WOUT, I_LNMOE,
       I_WRG, I_BRG, I_WRE, I_BRE, I_WGATE, I_WUP, I_WDOWN, I_LNFINAL, N_IN };

constexpr size_t MB = 1024 * 1024;
constexpr size_t WS_CTL   = 0;
constexpr size_t CTL_ZERO_BYTES = 65536;
constexpr int    CW_CNT   = 4096;
constexpr size_t WS_RSTD1 = 1 * MB;
constexpr size_t WS_RSTD2 = 1 * MB + 65536;
constexpr size_t WS_BIAS1 = 1 * MB + 131072;
constexpr size_t WS_AROW  = 1 * MB + 262144;
constexpr size_t WS_WR    = 1 * MB + 393216;
constexpr size_t WS_WG4   = 1 * MB + 655360;
constexpr size_t WS_WRP   = 32 * MB;
constexpr size_t WS_PL    = 40 * MB;
constexpr size_t WS_ROPEC = 2 * MB;
constexpr size_t WS_ROPES = 2 * MB + 524288;
constexpr size_t WS_GATES = 3 * MB;
constexpr size_t WS_TOKL  = 4 * MB;
constexpr size_t WS_GATEL = 5 * MB;
constexpr size_t WS_HID   = 6 * MB;
constexpr size_t WS_CMPKV = 8 * MB;
constexpr size_t WS_WINT  = 9 * MB;
constexpr size_t WS_WOUTT = 24 * MB;
constexpr size_t WS_W1T   = 32 * MB;
constexpr size_t WS_W2T   = 160 * MB;
constexpr size_t WS_CMPW  = 224 * MB;
constexpr size_t WS_POOLW = 228 * MB;
constexpr size_t WS_POOLB = 228 * MB + 524288;
constexpr size_t WS_CPART = 447 * MB;
constexpr size_t WS_DBUF  = 463 * MB;
constexpr size_t WS_XB    = 230 * MB;
constexpr size_t WS_QN    = 262 * MB;
constexpr size_t WS_QR    = 278 * MB;
constexpr size_t WS_KV    = 294 * MB;
constexpr size_t WS_U     = 319 * MB;
constexpr size_t WS_Y     = 230 * MB;
constexpr size_t WS_OWIN  = 351 * MB;
constexpr size_t WS_OCMP  = 367 * MB;
constexpr size_t WS_OSEL  = 319 * MB;
constexpr size_t WS_ML    = 6 * MB;
constexpr size_t WS_X1B   = 351 * MB;
constexpr size_t WS_OPOOL = 383 * MB;
constexpr size_t WS_ACT   = 383 * MB;
constexpr size_t WS_MIX   = 415 * MB;
constexpr size_t WS_END   = 479 * MB;

__device__ __forceinline__ bf16_t f2bf(float f) { unsigned u = __float_as_uint(f); u += 0x7FFFu + ((u >> 16) & 1u); return (bf16_t)(u >> 16); }
__device__ __forceinline__ float bf2f(bf16_t b) { return __uint_as_float(((unsigned)b) << 16); }
__device__ __forceinline__ float wave_sum(float v) {
#pragma unroll
    for (int o = 32; o >= 1; o >>= 1) v += __shfl_xor(v, o);
    return v;
}
__device__ __forceinline__ float wave_max(float v) {
#pragma unroll
    for (int o = 32; o >= 1; o >>= 1) v = fmaxf(v, __shfl_xor(v, o));
    return v;
}

__device__ __forceinline__ int fresh_lane() { int l; asm volatile("v_mbcnt_lo_u32_b32 %0, -1, 0\n\tv_mbcnt_hi_u32_b32 %0, -1, %0" : "=v"(l)); return l; }
struct Args { const float* in[N_IN]; float* out; unsigned char* ws; int ph_lo, ph_hi; };

struct Frame {
    const float* in[N_IN]; float* out; unsigned char* ws;
    float* lds;
    int tid, lane, wave, G, bid;
};

__device__ __forceinline__ float gelu_tanh(float x) { const float u = 0.7978845608028654f * (x + 0.044715f * x * x * x); return 0.5f * x * (1.f + tanhf(u)); }


namespace pg8 {
typedef short bf16x8 __attribute__((ext_vector_type(8)));
typedef float f32x4 __attribute__((ext_vector_type(4)));
typedef unsigned u32x4 __attribute__((ext_vector_type(4)));
constexpr int BM = 256, BK = 64, HALF = 128, HTB = HALF * BK * 2, STAGE_BYTES = 8 * HTB, NXCD = 8, WGM = 8;
__device__ __forceinline__ int lds_byte(int r, int c) { const int st = (r >> 4) * 2 + (c >> 5), rr = r & 15, cc = c & 31, ob = rr * 64 + cc * 2; return st * 1024 + (ob ^ (((ob >> 9) & 1) << 5)); }
__device__ __forceinline__ void stage_rc(int b, int& R, int& C) { const int st = b / 1024, sb = b % 1024, swz = sb ^ (((sb >> 9) & 1) << 5); R = (st >> 1) * 16 + swz / 64; C = (st & 1) * 32 + (swz % 64) / 2; }
struct Unit { int pm, pn, e, li; };
__device__ __forceinline__ unsigned cvt_pk_bf16(float lo, float hi) { unsigned r; asm volatile("v_cvt_pk_bf16_f32 %0, %1, %2" : "=v"(r) : "v"(lo), "v"(hi)); return r; }

struct DenseOrder {
    const char* A; const char* Bt; int lda, ldb; int nM, nN, nwg, G, c;
    __device__ void init(const void* A_, const void* Bt_, int lda_, int ldb_, int M, int N, int G_, int c_) { A = (const char*)A_; Bt = (const char*)Bt_; lda = lda_; ldb = ldb_; nM = M / BM; nN = N / BM; nwg = nM * nN; G = G_; c = c_; }
    __device__ __forceinline__ bool next(int i, Unit& u) const {
        const long L = (long)i * G + c; if (L >= nwg) return false;
        int wgid = (int)L; { const int q = nwg / NXCD, r = nwg % NXCD, xcd = wgid % NXCD, off = wgid / NXCD; wgid = (xcd < r ? xcd * (q + 1) : r * (q + 1) + (xcd - r) * q) + off; }
        const int nig = WGM * nN, gid = wgid / nig, fm = gid * WGM, gsz = (nM - fm) < WGM ? (nM - fm) : WGM;
        u.pm = fm + ((wgid % nig) % gsz); u.pn = (wgid % nig) / gsz; u.e = 0; u.li = i; return true;
    }
    __device__ __forceinline__ const char* a_base(const Unit& u) const { return A + (size_t)u.pm * BM * lda * 2; }
    __device__ __forceinline__ const char* b_base(const Unit& u) const { return Bt + (size_t)u.pn * BM * ldb * 2; }
    __device__ __forceinline__ unsigned a_row_off(const Unit&, int r) const { return (unsigned)r * (unsigned)lda * 2u; }
};

template <class Epi, class Sched, bool GATHER>
__device__ __forceinline__ void gemm_phase(LAS unsigned char* lds, const int K, const int lda, const int ldb, const Sched& S, const Epi& E) {
    const int tid = threadIdx.x, wid = __builtin_amdgcn_readfirstlane(tid >> 6), lane = tid & 63, wr = wid >> 2, wc = wid & 3, fr = lane & 15, fq = lane >> 4;
    const int nt = K / BK;
    int sR[2], sC[2];
#pragma unroll
    for (int i = 0; i < 2; ++i) stage_rc(tid * 16 + i * 8192, sR[i], sC[i]);
    unsigned voffB[2], voffA[2][2], nvoffA[2][2];
#pragma unroll
    for (int i = 0; i < 2; ++i) voffB[i] = (unsigned)(sR[i] * ldb + sC[i]) * 2u;
    const size_t kstep = (size_t)(BK * 2);
    const size_t hstepB = (size_t)HALF * ldb * 2;
    const unsigned ldsw = (unsigned)wid * 1024u;
    const int aoff = lds_byte(wr * 64 + fr, fq * 8), boff = lds_byte(wc * 32 + fr, fq * 8);
#define PG8_SA(b, h) (((b) * 2 + (h)) * HTB)
#define PG8_SB(b, h) ((4 + (b) * 2 + (h)) * HTB)
#define PG8_STAGE(bufoff, gbase, voff) do { _Pragma("unroll") for (int _i = 0; _i < 2; ++_i) \
        __builtin_amdgcn_global_load_lds((const unsigned*)((const char*)(gbase) + (voff)[_i]), (LAS unsigned*)(lds + (bufoff) + ldsw + _i * 8192), 16, 0, 0); } while (0)
#define PG8_LDA(dst, b, h) do { _Pragma("unroll") for (int m = 0; m < 4; ++m) _Pragma("unroll") for (int k = 0; k < 2; ++k) dst[m][k] = *(const LAS bf16x8*)(lds + PG8_SA(b, h) + aoff + m * 2048 + k * 1024); } while (0)
#define PG8_LDB(dst, b, h) do { _Pragma("unroll") for (int n = 0; n < 2; ++n) _Pragma("unroll") for (int k = 0; k < 2; ++k) dst[n][k] = *(const LAS bf16x8*)(lds + PG8_SB(b, h) + boff + n * 2048 + k * 1024); } while (0)
#define PG8_MMA(ai, bj, At, Bt) do { __builtin_amdgcn_s_setprio(1); _Pragma("unroll") for (int m = 0; m < 4; ++m) _Pragma("unroll") for (int n = 0; n < 2; ++n) _Pragma("unroll") for (int k = 0; k < 2; ++k) \
        { acc[ai][bj][m][n] = __builtin_amdgcn_mfma_f32_16x16x32_bf16(Bt[n][k], At[m][k], acc[ai][bj][m][n], 0, 0, 0); if (PROBE_REPEAT == 21) dummy = __builtin_amdgcn_mfma_f32_16x16x32_bf16(Bt[n][k], At[m][k], dummy, 0, 0, 0); } __builtin_amdgcn_s_setprio(0); } while (0)
#define PG8_WAIT_V(n) asm volatile("s_waitcnt vmcnt(" #n ")" ::: "memory")
#define PG8_WAIT_L(n) asm volatile("s_waitcnt lgkmcnt(" #n ")" ::: "memory")
#define PG8_BAR __builtin_amdgcn_s_barrier()
#define PG8_SCHED __builtin_amdgcn_sched_barrier(0)
#define PG8_AOFFS(dst, u) do { _Pragma("unroll") for (int _h = 0; _h < 2; ++_h) _Pragma("unroll") for (int _i = 0; _i < 2; ++_i) dst[_h][_i] = S.a_row_off(u, _h * HALF + sR[_i]) + (unsigned)sC[_i] * 2u; } while (0)
    Unit cur, nxt; int ui = 0;
    if (!S.next(0, cur)) return;
    f32x4 acc[2][2][4][2];
#pragma unroll
    for (int a = 0; a < 2; ++a)
#pragma unroll
        for (int b = 0; b < 2; ++b)
#pragma unroll
            for (int m = 0; m < 4; ++m)
#pragma unroll
                for (int n = 0; n < 2; ++n) acc[a][b][m][n] = (f32x4){0.f, 0.f, 0.f, 0.f};
    bf16x8 At[4][2], B0[2][2], B1[2][2]; f32x4 dummy = {0.f, 0.f, 0.f, 0.f};
    const char* cA = S.a_base(cur); const char* cB = S.b_base(cur);
    PG8_AOFFS(voffA, cur);
    PG8_STAGE(PG8_SB(0, 0), cB, voffB); PG8_STAGE(PG8_SA(0, 0), cA, voffA[0]); PG8_STAGE(PG8_SB(0, 1), cB + hstepB, voffB); PG8_STAGE(PG8_SA(0, 1), cA, voffA[1]);
    if (wr == 1) PG8_BAR;
    PG8_WAIT_V(4); PG8_BAR;
    PG8_STAGE(PG8_SB(1, 0), cB + kstep, voffB); PG8_STAGE(PG8_SA(1, 0), cA + kstep, voffA[0]); PG8_STAGE(PG8_SB(1, 1), cB + hstepB + kstep, voffB);
    PG8_WAIT_V(6); PG8_BAR;
    for (;;) {
        const bool has_next = S.next(ui + 1, nxt);
        const char* nA = has_next ? S.a_base(nxt) : cA; const char* nB = has_next ? S.b_base(nxt) : cB;
        if (GATHER) { if (has_next) { PG8_AOFFS(nvoffA, nxt); } else {
#pragma unroll
            for (int _h = 0; _h < 2; ++_h)
#pragma unroll
                for (int _i = 0; _i < 2; ++_i) nvoffA[_h][_i] = voffA[_h][_i]; } }
        for (int t = 0; t < nt; t += 2) {
            const bool last = (t == nt - 2);
            const char* a1 = cA + (size_t)(t + 1) * kstep;
            const char* a2 = last ? nA : cA + (size_t)(t + 2) * kstep; const char* b2 = last ? nB : cB + (size_t)(t + 2) * kstep;
            const char* a3 = a2 + kstep; const char* b3 = b2 + kstep;
            unsigned vA2[2][2];
#pragma unroll
            for (int _h = 0; _h < 2; ++_h)
#pragma unroll
                for (int _i = 0; _i < 2; ++_i) vA2[_h][_i] = (GATHER && last) ? nvoffA[_h][_i] : voffA[_h][_i];
            PG8_LDB(B0, 0, 0); PG8_SCHED; PG8_LDA(At, 0, 0); PG8_STAGE(PG8_SA(1, 1), a1, voffA[1]);
            PG8_WAIT_L(8); PG8_BAR; PG8_WAIT_L(0); PG8_MMA(0, 0, At, B0); PG8_BAR; PG8_SCHED;
            PG8_LDB(B1, 0, 1); PG8_STAGE(PG8_SB(0, 0), b2, voffB);
            PG8_BAR; PG8_WAIT_L(0); PG8_MMA(0, 1, At, B1); PG8_BAR;
            PG8_LDA(At, 0, 1); PG8_STAGE(PG8_SA(0, 0), a2, vA2[0]);
            PG8_BAR; PG8_WAIT_L(0); PG8_MMA(1, 0, At, B0); PG8_BAR; PG8_SCHED;
            PG8_STAGE(PG8_SB(0, 1), b2 + hstepB, voffB);
            PG8_WAIT_V(6); PG8_BAR; PG8_MMA(1, 1, At, B1); PG8_BAR;
            PG8_LDB(B0, 1, 0); PG8_SCHED; PG8_LDA(At, 1, 0); PG8_STAGE(PG8_SA(0, 1), a2, vA2[1]);
            PG8_WAIT_L(8); PG8_BAR; PG8_WAIT_L(0); PG8_MMA(0, 0, At, B0); PG8_BAR; PG8_SCHED;
            PG8_LDB(B1, 1, 1); PG8_STAGE(PG8_SB(1, 0), b3, voffB);
            PG8_BAR; PG8_WAIT_L(0); PG8_MMA(0, 1, At, B1); PG8_BAR;
            PG8_LDA(At, 1, 1); PG8_STAGE(PG8_SA(1, 0), a3, vA2[0]);
            PG8_BAR; PG8_WAIT_L(0); PG8_MMA(1, 0, At, B0); PG8_BAR; PG8_SCHED;
            PG8_STAGE(PG8_SB(1, 1), b3 + hstepB, voffB);
            PG8_WAIT_V(6); PG8_BAR; PG8_MMA(1, 1, At, B1); PG8_BAR;
        }
        if constexpr (!Epi::AFTER_DRAIN) E(acc, cur, wr, wc, fr, fq);
        if (!has_next) break;
#pragma unroll
        for (int a = 0; a < 2; ++a)
#pragma unroll
            for (int b = 0; b < 2; ++b)
#pragma unroll
                for (int m = 0; m < 4; ++m)
#pragma unroll
                    for (int n = 0; n < 2; ++n) acc[a][b][m][n] = (f32x4){0.f, 0.f, 0.f, 0.f};
        cur = nxt; cA = nA; cB = nB; ++ui;
        if (GATHER) {
#pragma unroll
            for (int _h = 0; _h < 2; ++_h)
#pragma unroll
                for (int _i = 0; _i < 2; ++_i) voffA[_h][_i] = nvoffA[_h][_i]; }
    }
    if (PROBE_REPEAT == 21) asm volatile("" :: "v"(dummy));
    PG8_WAIT_V(0);
    if (wr == 0) PG8_BAR;
    PG8_BAR;
    if constexpr (Epi::AFTER_DRAIN) E.fused(acc, cur, wr, wc, fr, fq, lds);
#undef PG8_SA
#undef PG8_SB
#undef PG8_STAGE
#undef PG8_LDA
#undef PG8_LDB
#undef PG8_MMA
#undef PG8_WAIT_V
#undef PG8_WAIT_L
#undef PG8_BAR
#undef PG8_SCHED
#undef PG8_AOFFS
}
}


namespace g2 {
using pg8::bf16x8; using pg8::f32x4; using pg8::lds_byte; using pg8::cvt_pk_bf16;
typedef short s16x4 __attribute__((ext_vector_type(4)));
constexpr int A_BYTES = 32768, B_BYTES = 16384, STG = A_BYTES + B_BYTES;
struct Unit { int e, pm, pn, li, half; };
template <int NT_, class Epi, class Sched>
__device__ __forceinline__ void gemm(LAS unsigned char* lds, const Sched& S, const Epi& E, const int wave_, unsigned long long* tprobe = nullptr) {
#if defined(__HIP_DEVICE_COMPILE__)
    const int wid = wave_, lane = fresh_lane(), tid = wid * 64 + lane, wr = wid >> 2, wc = wid & 3, fr = lane & 15, fq = lane >> 4;
    constexpr int nt = NT_;
    unsigned long long tacc = 0ull;
#define TCK() ((PROBE_REPEAT >= 30 && PROBE_REPEAT <= 33) ? (unsigned long long)__builtin_readcyclecounter() : 0ull)
    const unsigned long long t_all0 = TCK();
    const int awoff0 = lds_byte((tid >> 3) & 127, (tid & 7) * 8);
    const int bkr = tid >> 5, bnq = tid & 31;
    const int bwoff0 = A_BYTES + bkr * 256 + ((((bnq >> 2)) ^ ((bkr & 3) | (((bkr >> 3) & 1) << 2))) * 32) + (bnq & 3) * 8;
#define awoff(j) (awoff0 + ((j) & 1) * 8192 + ((j) >> 1) * 16384)
#define bwoff(j) (bwoff0 + (j) * 4096)
    const int aoff = lds_byte(wr * 64 + fr, fq * 8);
    int boff[2];
    { const int q = (lane >> 2) & 3, p = lane & 3, f = q | ((fq & 1) << 2);
#pragma unroll
      for (int n = 0; n < 2; ++n) boff[n] = A_BYTES + (8 * fq + q) * 256 + (((2 * wc + n) ^ f) * 32) + 8 * p; }
    const int ldsb = (int)(uintptr_t)lds;
    Unit u, un;
    if (!S.next(0, u)) return;
    unsigned pa[4], pan[4]; const float* pb; const float* pbn;
    const size_t bstep = (size_t)16 * S.ldb;
#define G2_PTRS(PA, PB, U) do { _Pragma("unroll") for (int j = 0; j < 4; ++j) { const int id = tid + 512 * j; PA[j] = S.a_off(U, id >> 3) + (unsigned)(id & 7) * 16u; } PB = S.b_col(U, 4 * ((U).half >= 2 ? ((bnq & 15) | (((U).half & 1) << 4)) : bnq)) + (size_t)bkr * S.ldb; } while (0)
    G2_PTRS(pa, pb, u);
    f32x4 acc[2][4][2];
#pragma unroll
    for (int a = 0; a < 2; ++a)
#pragma unroll
        for (int m = 0; m < 4; ++m)
#pragma unroll
            for (int n = 0; n < 2; ++n) acc[a][m][n] = (f32x4){0.f, 0.f, 0.f, 0.f};
    f32x4 dummy = {0.f, 0.f, 0.f, 0.f};
    bf16x8 ra0[4], ra1[4]; f32x4 rb0[4], rb1[4];
#define G2_NVALID(U) (((U).half >= 2 && (wc >> 1) != ((U).half & 1)) ? 0 : S.nvalid(U))
    bool hf = u.half != 0; const bool hfn = false; (void)hfn; int nvalid = G2_NVALID(u);
#define G2_LOADA(RA, PA, HF, t) do { _Pragma("unroll") for (int j = 0; j < 4; ++j) if (j < 2 || !(HF)) RA[j] = *(const bf16x8*)((const char*)S.A + PA[j] + (unsigned)(t) * 128u); } while (0)
#define G2_LOADB(RB, PB, t) do { _Pragma("unroll") for (int j = 0; j < 4; ++j) RB[j] = *(const f32x4*)(PB + (size_t)(t) * 64 * S.ldb + j * bstep); } while (0)
#define G2_WRITE_A(st, RA, j) do { *(LAS bf16x8*)(lds + (st) * STG + awoff(j)) = RA[j]; } while (0)
#define G2_WRITE_B(st, RB, j) do { uint2 w_; w_.x = cvt_pk_bf16(RB[j][0], RB[j][1]); w_.y = cvt_pk_bf16(RB[j][2], RB[j][3]); *(LAS uint2*)(lds + (st) * STG + bwoff(j)) = w_; } while (0)
#define G2_TR(dst, n, imm) asm volatile("ds_read_b64_tr_b16 %0, %1 offset:%2" : "=&v"(dst) : "v"(ldsb + boff[n]), "i"(imm) : "memory")
#define G2_COMPUTE(st, DOW, WA, WB, HFC, HFW) do { const unsigned long long tc0_ = TCK(); \
        s16x4 b00l, b00h, b01l, b01h, b10l, b10h, b11l, b11h;        \
        G2_TR(b00l, 0, (st) * STG); G2_TR(b00h, 0, (st) * STG + 1024); G2_TR(b01l, 0, (st) * STG + 8192); G2_TR(b01h, 0, (st) * STG + 8192 + 1024); \
        G2_TR(b10l, 1, (st) * STG); G2_TR(b10h, 1, (st) * STG + 1024); G2_TR(b11l, 1, (st) * STG + 8192); G2_TR(b11h, 1, (st) * STG + 8192 + 1024); \
        bf16x8 At[4][2]; \
        _Pragma("unroll") for (int m = 0; m < 4; ++m) _Pragma("unroll") for (int k = 0; k < 2; ++k) At[m][k] = *(const LAS bf16x8*)(lds + (st) * STG + aoff + m * 2048 + k * 1024); \
        asm volatile("s_waitcnt lgkmcnt(0)" ::: "memory"); __builtin_amdgcn_sched_barrier(0); \
        if (PROBE_REPEAT == 31) tacc += TCK() - tc0_; \
        const bf16x8 B00 = {b00l[0], b00l[1], b00l[2], b00l[3], b00h[0], b00h[1], b00h[2], b00h[3]}, B01 = {b01l[0], b01l[1], b01l[2], b01l[3], b01h[0], b01h[1], b01h[2], b01h[3]}; \
        const bf16x8 B10 = {b10l[0], b10l[1], b10l[2], b10l[3], b10h[0], b10h[1], b10h[2], b10h[3]}, B11 = {b11l[0], b11l[1], b11l[2], b11l[3], b11h[0], b11h[1], b11h[2], b11h[3]}; \
        _Pragma("unroll") for (int a = 0; a < 2; ++a) { \
            _Pragma("unroll") for (int m = 0; m < 4; ++m) { \
                __builtin_amdgcn_s_setprio(1); \
                if (128 * a + 64 * wr + 16 * m < nvalid) {                 \
                acc[a][m][0] = __builtin_amdgcn_mfma_f32_16x16x32_bf16(B00, At[m][0], acc[a][m][0], 0, 0, 0); acc[a][m][0] = __builtin_amdgcn_mfma_f32_16x16x32_bf16(B01, At[m][1], acc[a][m][0], 0, 0, 0); \
                acc[a][m][1] = __builtin_amdgcn_mfma_f32_16x16x32_bf16(B10, At[m][0], acc[a][m][1], 0, 0, 0); acc[a][m][1] = __builtin_amdgcn_mfma_f32_16x16x32_bf16(B11, At[m][1], acc[a][m][1], 0, 0, 0); } \
                if (PROBE_REPEAT == 20) { dummy = __builtin_amdgcn_mfma_f32_16x16x32_bf16(B00, At[m][0], dummy, 0, 0, 0); dummy = __builtin_amdgcn_mfma_f32_16x16x32_bf16(B01, At[m][1], dummy, 0, 0, 0); dummy = __builtin_amdgcn_mfma_f32_16x16x32_bf16(B10, At[m][0], dummy, 0, 0, 0); dummy = __builtin_amdgcn_mfma_f32_16x16x32_bf16(B11, At[m][1], dummy, 0, 0, 0); } \
                __builtin_amdgcn_s_setprio(0); \
                if (DOW) { if (a == 0) { if (m < 2 || !(HFW)) G2_WRITE_A((st) ^ 1, WA, m); if (HFC) G2_WRITE_B((st) ^ 1, WB, m); } else G2_WRITE_B((st) ^ 1, WB, m); __builtin_amdgcn_sched_barrier(0); } } \
            if (HFC) break;                                               \
            if (a == 0) { __builtin_amdgcn_sched_barrier(0); \
                _Pragma("unroll") for (int m = 0; m < 4; ++m) _Pragma("unroll") for (int k = 0; k < 2; ++k) At[m][k] = *(const LAS bf16x8*)(lds + (st) * STG + 16384 + aoff + m * 2048 + k * 1024); \
                asm volatile("s_waitcnt lgkmcnt(0)" ::: "memory"); __builtin_amdgcn_sched_barrier(0); } } \
        if (PROBE_REPEAT == 32) tacc += TCK() - tc0_; } while (0)
    for (int ui = 0;; ++ui) {
        G2_LOADA(ra0, pa, hf, 0); G2_LOADB(rb0, pb, 0); G2_LOADA(ra1, pa, hf, 1); G2_LOADB(rb1, pb, 1);
        __syncthreads();
#pragma unroll
        for (int j = 0; j < 4; ++j) { if (j < 2 || !hf) G2_WRITE_A(0, ra0, j); G2_WRITE_B(0, rb0, j); }
        if (nt > 2) { G2_LOADA(ra0, pa, hf, 2); G2_LOADB(rb0, pb, 2); }
        __syncthreads();
#define G2_STEP(t) do { \
            G2_COMPUTE(0, true, ra1, rb1, hf, hf); \
            if ((t) + 3 < nt) { G2_LOADA(ra1, pa, hf, (t) + 3); G2_LOADB(rb1, pb, (t) + 3); } \
            __syncthreads(); \
            if ((t) + 2 < nt) { G2_COMPUTE(1, true, ra0, rb0, hf, hf); } else { G2_COMPUTE(1, false, ra0, rb0, hf, hf); } \
            if ((t) + 4 < nt) { G2_LOADA(ra0, pa, hf, (t) + 4); G2_LOADB(rb0, pb, (t) + 4); } \
            __syncthreads(); } while (0)
        G2_STEP(0); G2_STEP(2); G2_STEP(4); G2_STEP(6);
        if constexpr (NT_ > 8) { G2_STEP(8); G2_STEP(10); G2_STEP(12); G2_STEP(14); G2_STEP(16); G2_STEP(18); G2_STEP(20); G2_STEP(22); G2_STEP(24); G2_STEP(26); G2_STEP(28); G2_STEP(30); }
        static_assert(NT_ == 8 || NT_ == 32, "expand G2_STEP for this K");
#undef G2_STEP
        if (PROBE_REPEAT == 20) asm volatile("" :: "v"(dummy));
        E(acc, u, wr, wc, fr, fq);
        if (!S.next(ui + 1, un)) break;
#pragma unroll
        for (int a = 0; a < 2; ++a)
#pragma unroll
            for (int m = 0; m < 4; ++m)
#pragma unroll
                for (int n = 0; n < 2; ++n) acc[a][m][n] = (f32x4){0.f, 0.f, 0.f, 0.f};
        u.e = un.e; u.pm = un.pm; u.pn = un.pn; u.li = un.li; u.half = un.half; hf = u.half != 0; nvalid = G2_NVALID(u);
        G2_PTRS(pa, pb, u);
    }
#undef G2_PTRS
#undef G2_NVALID
#undef awoff
#undef bwoff
#undef G2_LOADA
#undef G2_LOADB
#undef G2_WRITE_A
#undef G2_WRITE_B
#undef G2_TR
#undef G2_COMPUTE
    if (PROBE_REPEAT == 33) tacc = TCK() - t_all0;
    if (tprobe && blockIdx.x == PROBE_WG && threadIdx.x == 0) *tprobe = tacc;
#undef TCK
#endif
}
}

namespace att {
typedef short bf16x8 __attribute__((ext_vector_type(8)));
typedef short s16x4 __attribute__((ext_vector_type(4)));
typedef float f32x16 __attribute__((ext_vector_type(16)));
typedef float f32x4 __attribute__((ext_vector_type(4)));
typedef unsigned u32x4 __attribute__((ext_vector_type(4)));
constexpr int SHM = 16384;
constexpr int NBUF = 3;
constexpr int L_K = 0, L_V = NBUF * SHM, L_WS = 2 * NBUF * SHM, L_PART = L_WS + 8 * 64 * 4, L_SELM = L_PART + 4 * 64 * 33 * 4, L_VALS = L_SELM + 256, L_ITEM = L_VALS + 8 * 64 * 4, L_END = L_ITEM + 16;
constexpr float C2 = 1.4426950408889634f * SCALE;
#define KSWZ(row, colB) ((row) * 256 + ((colB) ^ (((row) & 7) << 4)))
#define SBAR() __builtin_amdgcn_sched_barrier(0)
__device__ __forceinline__ int v_st(int k, int c) { const int kk = (k & ~0xC) | ((k & 4) << 1) | ((k & 8) >> 1); return ((kk >> 3) * 4 + (c >> 5)) * 512 + ((kk & 7) * 32 + (c & 31)) * 2; }
__device__ __forceinline__ int v_rd_base(int lane) { return ((lane & 3) << 3) | (((lane >> 2) & 3) << 6) | (((lane >> 4) & 1) << 5) | (((lane >> 5) & 1) << 8); }
constexpr int v_rd_off(int d0, int ks, int half) { return d0 * 512 + ks * 4096 + half * 2048; }
__device__ __forceinline__ int crow(int r, int hi) { return (r & 3) + 8 * (r >> 2) + 4 * hi; }
__device__ __forceinline__ unsigned cvtpk(float lo, float hi) { unsigned r; asm volatile("v_cvt_pk_bf16_f32 %0, %1, %2" : "=v"(r) : "v"(lo), "v"(hi)); return r; }
__device__ __forceinline__ float swap_max(float v) { auto rr = __builtin_amdgcn_permlane32_swap(__float_as_uint(v), __float_as_uint(v), false, false); return fmaxf(__uint_as_float(rr[0]), __uint_as_float(rr[1])); }
__device__ __forceinline__ float swap_sum(float v) { auto rr = __builtin_amdgcn_permlane32_swap(__float_as_uint(v), __float_as_uint(v), false, false); return __uint_as_float(rr[0]) + __uint_as_float(rr[1]); }

struct WV { int tid, wid, lane, r32, hi, vb0; unsigned ksrc[2], vsrc[2]; char* lds; LAS unsigned char* ldsL; };
__device__ __forceinline__ void wv_src_init(WV& w) {
#pragma unroll
    for (int i = 0; i < 2; ++i) {
        const int L = (w.wid * 2 + i) * 1024 + w.lane * 16;
        { const int row = L >> 8, colB = (L & 255) ^ ((row & 7) << 4); w.ksrc[i] = (unsigned)(row * 256 + colB); }
        { const int sub = L >> 9, kkhi = sub >> 2, cblk = sub & 3, within = L & 511, kklo = within >> 6, cc = (within >> 1) & 31;
          const int kk = kkhi * 8 + kklo, k = (kk & ~0xC) | ((kk & 4) << 1) | ((kk & 8) >> 1), c = cblk * 32 + cc; w.vsrc[i] = (unsigned)(k * 256 + c * 2); }
    }
}
__device__ __forceinline__ void dma_tile(const WV& w, const bf16_t* Kt, const bf16_t* Vt, int buf) {
    int ln = w.lane; asm volatile("" : "+v"(ln));
#pragma unroll
    for (int i = 0; i < 2; ++i) {
        const int L = (w.wid * 2 + i) * 1024 + ln * 16;
        const int row = L >> 8, colB = (L & 255) ^ ((row & 7) << 4); const unsigned ksrc = (unsigned)(row * 256 + colB);
        const int sub = L >> 9, kkhi = sub >> 2, cblk = sub & 3, within = L & 511, kklo = within >> 6, cc = (within >> 1) & 31;
        const int kk = kkhi * 8 + kklo, k = (kk & ~0xC) | ((kk & 4) << 1) | ((kk & 8) >> 1), c = cblk * 32 + cc; const unsigned vsrc = (unsigned)(k * 256 + c * 2);
        __builtin_amdgcn_global_load_lds((const unsigned*)((const char*)Vt + vsrc), (LAS unsigned*)(w.ldsL + L_V + buf * SHM + (w.wid * 2 + i) * 1024), 16, 0, 0);
        __builtin_amdgcn_global_load_lds((const unsigned*)((const char*)Kt + ksrc), (LAS unsigned*)(w.ldsL + L_K + buf * SHM + (w.wid * 2 + i) * 1024), 16, 0, 0);
    }
}
template <int BUF>
__device__ __forceinline__ void qkt(const WV& w, const bf16x8 (&qr)[8], f32x16& p0, f32x16& p1) {
    p0 = f32x16{}; p1 = f32x16{};
    const LAS char* kb[4];
#pragma unroll
    for (int dd = 0; dd < 4; ++dd) kb[dd] = (const LAS char*)w.ldsL + L_K + KSWZ(w.r32, (dd * 16 + w.hi * 8) * 2);
#pragma unroll
    for (int d0 = 0; d0 < 8; ++d0) { const LAS char* a = kb[d0 & 3] + BUF * SHM + (d0 >> 2) * 128;
        const bf16x8 b0 = *reinterpret_cast<const LAS bf16x8*>(a); const bf16x8 b1 = *reinterpret_cast<const LAS bf16x8*>(a + 32 * 256);
        p0 = __builtin_amdgcn_mfma_f32_32x32x16_bf16(b0, qr[d0], p0, 0, 0, 0);
        p1 = __builtin_amdgcn_mfma_f32_32x32x16_bf16(b1, qr[d0], p1, 0, 0, 0);
        if (d0 == 3) SBAR(); }
}
__device__ __forceinline__ void pack_p(const f32x16& p0, const f32x16& p1, bf16x8& pa0, bf16x8& pa1, bf16x8& pa2, bf16x8& pa3) {
#define PK4(P, B_, OUT) do { unsigned a0 = cvtpk(P[B_+0], P[B_+1]), a1 = cvtpk(P[B_+2], P[B_+3]); unsigned b0 = cvtpk(P[B_+4], P[B_+5]), b1 = cvtpk(P[B_+6], P[B_+7]); \
        auto r0 = __builtin_amdgcn_permlane32_swap(a0, b0, false, false); auto r1 = __builtin_amdgcn_permlane32_swap(a1, b1, false, false); \
        u32x4 w_ = {r0[0], r1[0], r0[1], r1[1]}; OUT = *reinterpret_cast<bf16x8*>(&w_); } while (0)
    PK4(p0, 0, pa0); PK4(p0, 8, pa1); PK4(p1, 0, pa2); PK4(p1, 8, pa3);
#undef PK4
}
template <int VB>
__device__ __forceinline__ void pv_tile(f32x16* o, int vb0, bf16x8 pa0, bf16x8 pa1, bf16x8 pa2, bf16x8 pa3) {
#define TRRD(dst, off) asm volatile("ds_read_b64_tr_b16 %0, %1 offset:%2" : "=&v"(dst) : "v"(vb0), "i"(off) : "memory")
#define PV_D0(d0) do { s16x4 l0, l1, l2, l3, h0, h1, h2, h3; constexpr int b_ = VB * SHM + v_rd_off(d0, 0, 0); \
        TRRD(l0, b_); TRRD(h0, b_ + 2048); TRRD(l1, b_ + 4096); TRRD(h1, b_ + 6144); TRRD(l2, b_ + 8192); TRRD(h2, b_ + 10240); TRRD(l3, b_ + 12288); TRRD(h3, b_ + 14336); \
        asm volatile("s_waitcnt lgkmcnt(0)" ::: "memory"); SBAR(); \
        o[d0] = __builtin_amdgcn_mfma_f32_32x32x16_bf16(pa0, (bf16x8){l0[0], l0[1], l0[2], l0[3], h0[0], h0[1], h0[2], h0[3]}, o[d0], 0, 0, 0); \
        o[d0] = __builtin_amdgcn_mfma_f32_32x32x16_bf16(pa1, (bf16x8){l1[0], l1[1], l1[2], l1[3], h1[0], h1[1], h1[2], h1[3]}, o[d0], 0, 0, 0); \
        o[d0] = __builtin_amdgcn_mfma_f32_32x32x16_bf16(pa2, (bf16x8){l2[0], l2[1], l2[2], l2[3], h2[0], h2[1], h2[2], h2[3]}, o[d0], 0, 0, 0); \
        o[d0] = __builtin_amdgcn_mfma_f32_32x32x16_bf16(pa3, (bf16x8){l3[0], l3[1], l3[2], l3[3], h3[0], h3[1], h3[2], h3[3]}, o[d0], 0, 0, 0); } while (0)
    PV_D0(0); PV_D0(1); PV_D0(2); PV_D0(3);
#undef PV_D0
#undef TRRD
}
__device__ __forceinline__ void store_o(const WV& w, const f32x16* o, const float* tab, bf16_t* outp) {
    bf16_t* lp = outp + (size_t)w.hi * 4096 + w.r32;
#pragma unroll
    for (int r = 0; r < 16; ++r) { const int q = crow(r, w.hi); const float sc = tab[q];
        bf16_t* p = lp; asm volatile("" : "+v"(p));
        p += ((r & 3) + 8 * (r >> 2)) * 1024;
#pragma unroll
        for (int d0 = 0; d0 < 4; ++d0) { const float v = o[d0][r] * sc; const float vn = __shfl_xor(v, 1);
            if ((w.r32 & 1) == 0) *(__attribute__((address_space(1))) unsigned*)(p + d0 * 32) = cvtpk(v, vn); } }
}

template <int MODE>
__device__ __forceinline__ void flash_pass(const WV& w, const bf16_t* Kp, const bf16_t* Vp, int j_lo, int j_hi, const bf16x8 (&qr)[8], int tpos, int tw0, unsigned selmask,
                                           f32x16 (&o)[4], float& m_reg, float& l_reg) {
    float* al_l = (float*)(w.lds + L_WS) + w.wid * 64;
    dma_tile(w, Kp + (size_t)j_lo * 64 * HD, Vp + (size_t)j_lo * 64 * HD, 0);
    if (j_lo + 1 < j_hi) dma_tile(w, Kp + (size_t)(j_lo + 1) * 64 * HD, Vp + (size_t)(j_lo + 1) * 64 * HD, 1);
#define FSTEP(BUF, jj) do { const int jt = (jj);                                                                                  \
        if (jt + 1 < j_hi) asm volatile("s_waitcnt vmcnt(4)" ::: "memory"); else asm volatile("s_waitcnt vmcnt(0)" ::: "memory");   \
        asm volatile("s_waitcnt lgkmcnt(0)" ::: "memory"); __builtin_amdgcn_s_barrier(); asm volatile("" ::: "memory");          \
        if (jt + 2 < j_hi) dma_tile(w, Kp + (size_t)(jt + 2) * 64 * HD, Vp + (size_t)(jt + 2) * 64 * HD, ((BUF) + 2) % 3);         \
        f32x16 p0, p1;                                                                                                           \
        qkt<BUF>(w, qr, p0, p1);                                                                                                 \
        const int kb = jt * 64;                                                                                                  \
        { const float NEG = -__builtin_inff();                                                                                   \
          const bool need = (kb + 63 > tw0) || (MODE == 1 && kb <= tw0 + 31 - 512);                                              \
          if (need) { const int dq = tpos - kb - 4 * w.hi; const unsigned W = (MODE == 1) ? 512u : 0x7fffffffu;                  \
              _Pragma("unroll") for (int r = 0; r < 16; ++r) { const int c = (r & 3) + 8 * (r >> 2); if ((unsigned)(dq - c) >= W) p0[r] = NEG; if ((unsigned)(dq - c - 32) >= W) p1[r] = NEG; } } \
          if (MODE == 0) { const bool sel = (selmask >> jt) & 1u;                                                                \
              if (!__all(sel)) { _Pragma("unroll") for (int r = 0; r < 16; ++r) { p0[r] = sel ? p0[r] : NEG; p1[r] = sel ? p1[r] : NEG; } } } } \
        float pmax = p0[0];                                                                                                      \
        _Pragma("unroll") for (int r = 1; r < 16; ++r) pmax = fmaxf(pmax, p0[r]);                                                \
        _Pragma("unroll") for (int r = 0; r < 16; ++r) pmax = fmaxf(pmax, p1[r]);                                                \
        pmax = swap_max(pmax);                                                                                                   \
        float mn = m_reg, alpha = 1.f;                                                                                           \
        const bool resc = !__all((pmax - m_reg) * SCALE <= 8.f);          \
        if (resc) { mn = fmaxf(m_reg, pmax); alpha = __builtin_amdgcn_exp2f((m_reg - mn) * C2); m_reg = mn; }                     \
        const float mnL = -mn * C2;                                                                                              \
        float ps = 0.f;                                                                                                          \
        _Pragma("unroll") for (int r = 0; r < 16; ++r) { p0[r] = __builtin_amdgcn_exp2f(fmaf(p0[r], C2, mnL)); ps += p0[r]; }    \
        _Pragma("unroll") for (int r = 0; r < 16; ++r) { p1[r] = __builtin_amdgcn_exp2f(fmaf(p1[r], C2, mnL)); ps += p1[r]; }    \
        ps = swap_sum(ps);                                                                                                       \
        l_reg = l_reg * alpha + ps;                                                                                              \
        if (resc) { if (w.hi == 0) al_l[w.r32] = alpha;                                                                          \
            asm volatile("s_waitcnt lgkmcnt(0)" ::: "memory");                                                                   \
            _Pragma("unroll") for (int r = 0; r < 16; ++r) { const float a = al_l[crow(r, w.hi)];                                \
                _Pragma("unroll") for (int d = 0; d < 4; ++d) o[d][r] *= a; } }                                                  \
        bf16x8 pa0, pa1, pa2, pa3;                                                                                               \
        pack_p(p0, p1, pa0, pa1, pa2, pa3);                                                                                      \
        pv_tile<BUF>(o, w.vb0, pa0, pa1, pa2, pa3);                                                                              \
    } while (0)
    int j = j_lo;
    for (; j + 2 < j_hi; j += 3) { FSTEP(0, j); FSTEP(1, j + 1); FSTEP(2, j + 2); }
    if (j < j_hi) { FSTEP(0, j); if (j + 1 < j_hi) FSTEP(1, j + 1); }
#undef FSTEP
    __syncthreads();
}
}

__device__ const unsigned char ATT_ITEMS[80] = {15, 30, 31, 63, 14, 28, 29, 61, 62, 13, 26, 27, 59, 60, 12, 24, 25, 57, 58, 11, 22, 23, 55, 56, 10, 20, 21, 53, 54, 9, 18, 19, 51, 52, 8, 16, 17, 49, 50, 7, 48, 6, 5,
    72, 73, 74, 75, 76, 77, 78, 79, 80, 81, 82, 83, 84, 85, 86, 87, 88, 89, 90, 91, 92, 93, 94, 95, 4, 71, 3, 70, 2, 69, 1, 68, 0, 67, 66, 65, 64};
constexpr int CW_QUEUE = 6144;
constexpr int CW_CVTQ = 6144 + 256;
constexpr int CW_CMPR = 8192 + 2048;

__device__ __forceinline__ void p_attn(const Frame& F, unsigned char* lds_raw, int rep) {
    using namespace att;
    WV w;
#define WV_INIT() do { int ln_ = F.lane; asm volatile("" : "+v"(ln_)); w.tid = F.wave * 64 + ln_; w.wid = F.wave; w.lane = ln_; w.r32 = ln_ & 31; w.hi = ln_ >> 5; \
        w.lds = (char*)lds_raw + 1024; w.ldsL = (LAS unsigned char*)lds_raw + 1024; w.vb0 = (int)(uintptr_t)(w.lds) + att::L_V + v_rd_base(ln_); } while (0)
    WV_INIT();
    const bf16_t* qn = (const bf16_t*)(F.ws + WS_QN); const bf16_t* qrp = (const bf16_t*)(F.ws + WS_QR); const bf16_t* kv = (const bf16_t*)(F.ws + WS_KV);
    const bf16_t* ckv = (const bf16_t*)(F.ws + WS_CMPKV);
    bf16_t* ocmp = (bf16_t*)(F.ws + WS_OCMP); bf16_t* owin = (bf16_t*)(F.ws + WS_OWIN); bf16_t* osel = (bf16_t*)(F.ws + WS_OSEL); float* ml = (float*)(F.ws + WS_ML);
    unsigned* qctr = (unsigned*)(F.ws + WS_CTL) + CW_QUEUE + 64 * rep;
    float* wsf = (float*)(w.lds + L_WS) + w.wid * 64;
    float* part = (float*)(w.lds + L_PART); unsigned* selm = (unsigned*)(w.lds + L_SELM); float* vals = (float*)(w.lds + L_VALS) + w.wid * 64; volatile int* itemw = (volatile int*)(w.lds + L_ITEM);
    const int hr = w.wid >> 1, th = w.wid & 1;
    for (;;) {
        __syncthreads();
        if (F.tid == 0) itemw[0] = (int)atomicAdd(qctr, 1u);
        __syncthreads();
        const int item = itemw[0];
        if (item >= 640) break;
        WV_INIT();
        const int ent = ATT_ITEMS[item >> 3], bg = item & 7, type = ent >> 5, qb = ent & 31, b = bg >> 1, g = bg & 1, h = 4 * g + hr;
        const int t0 = qb * 64 + th * 32, tpos = t0 + w.r32, tok0 = b * SEQ + t0;
        const size_t qoff = (((size_t)b * NH + h) * SEQ + t0 + w.r32) * HD + w.hi * 8;
        const size_t kvoff = ((size_t)b * NG + g) * SEQ * HD;
        bf16x8 qr[8];
        f32x16 o[4];
#ifndef ATT_NO_WIN
        if (type == 2) {
#pragma unroll
            for (int d0 = 0; d0 < 8; ++d0) qr[d0] = *(const bf16x8*)(qrp + qoff + d0 * 16);
#pragma unroll
            for (int d = 0; d < 4; ++d) o[d] = f32x16{};
            float m_reg = -1e30f, l_reg = 0.f;
            flash_pass<1>(w, kv + (size_t)4 * (4 * MB / 2) + kvoff, kv + (size_t)5 * (4 * MB / 2) + kvoff, qb >= 8 ? qb - 8 : 0, qb + 1, qr, tpos, t0, 0u, o, m_reg, l_reg);
            if (w.hi == 0) wsf[w.r32] = 1.f / l_reg;
            asm volatile("s_waitcnt lgkmcnt(0)" ::: "memory");
            store_o(w, o, wsf, owin + (size_t)tok0 * 1024 + h * HD);
            continue;
        }
#endif
#ifndef ATT_NO_CMP
        {
#pragma unroll
            for (int d0 = 0; d0 < 8; ++d0) qr[d0] = *(const bf16x8*)(qn + qoff + d0 * 16);
            const bf16_t* Kc = ckv + (size_t)bg * 128 * HD; const bf16_t* Vc = ckv + (size_t)1024 * HD + (size_t)bg * 128 * HD;
            dma_tile(w, Kc, Vc, 0); dma_tile(w, Kc + 64 * HD, Vc + 64 * HD, 1);
            asm volatile("s_waitcnt vmcnt(0)" ::: "memory");
            __syncthreads();
            f32x16 pA0, pA1, pB0, pB1;
            qkt<0>(w, qr, pA0, pA1); qkt<1>(w, qr, pB0, pB1);
            const int nmax = tpos >= 31 ? ((tpos - 31) >> 4) : -1;
            const float NEG = -__builtin_inff();
            float pmax = NEG;
#pragma unroll
            for (int r = 0; r < 16; ++r) { const int n = crow(r, w.hi);
                pA0[r] = (n <= nmax) ? pA0[r] : NEG; pA1[r] = (n + 32 <= nmax) ? pA1[r] : NEG; pB0[r] = (n + 64 <= nmax) ? pB0[r] : NEG; pB1[r] = (n + 96 <= nmax) ? pB1[r] : NEG;
                pmax = fmaxf(fmaxf(pmax, pA0[r]), fmaxf(pA1[r], fmaxf(pB0[r], pB1[r]))); }
            pmax = swap_max(pmax);
            const float mm = (pmax == NEG) ? 0.f : pmax;
            const float mnL = -mm * C2;
            float ps = 0.f;
#pragma unroll
            for (int r = 0; r < 16; ++r) { pA0[r] = __builtin_amdgcn_exp2f(fmaf(pA0[r], C2, mnL)); pA1[r] = __builtin_amdgcn_exp2f(fmaf(pA1[r], C2, mnL));
                pB0[r] = __builtin_amdgcn_exp2f(fmaf(pB0[r], C2, mnL)); pB1[r] = __builtin_amdgcn_exp2f(fmaf(pB1[r], C2, mnL)); ps += (pA0[r] + pA1[r]) + (pB0[r] + pB1[r]); }
            ps = swap_sum(ps);
            const float inv = ps > 0.f ? 1.f / ps : 0.f;
#pragma unroll
            for (int r = 0; r < 16; ++r) { pA0[r] *= inv; pA1[r] *= inv; pB0[r] *= inv; pB1[r] *= inv; }
            {
                float av[16], bv[16];
#pragma unroll
                for (int gq = 0; gq < 4; ++gq) {
                    av[gq]      = pA0[4 * gq] + pA0[4 * gq + 1] + pA0[4 * gq + 2] + 0.5f * pA0[4 * gq + 3]; bv[gq]      = 0.5f * pA0[4 * gq + 3];
                    av[4 + gq]  = pA1[4 * gq] + pA1[4 * gq + 1] + pA1[4 * gq + 2] + 0.5f * pA1[4 * gq + 3]; bv[4 + gq]  = 0.5f * pA1[4 * gq + 3];
                    av[8 + gq]  = pB0[4 * gq] + pB0[4 * gq + 1] + pB0[4 * gq + 2] + 0.5f * pB0[4 * gq + 3]; bv[8 + gq]  = 0.5f * pB0[4 * gq + 3];
                    av[12 + gq] = pB1[4 * gq] + pB1[4 * gq + 1] + pB1[4 * gq + 2] + 0.5f * pB1[4 * gq + 3]; bv[12 + gq] = 0.5f * pB1[4 * gq + 3];
                }
                float* prow = part + ((size_t)hr * 64 + th * 32 + w.r32) * 33;
#pragma unroll
                for (int idx = 0; idx < 16; ++idx) {
                    const float bo = __shfl_xor(bv[idx], 32);
                    const float bprev = (idx > 0) ? __shfl_xor(bv[idx > 0 ? idx - 1 : 0], 32) : 0.f;
                    const float inc = w.hi ? bo : bprev;
                    prow[2 * idx + w.hi] = av[idx] + inc;
                }
            }
            if (type == 0) {
                bf16x8 pa0, pa1, pa2, pa3;
#pragma unroll
                for (int d = 0; d < 4; ++d) o[d] = f32x16{};
                pack_p(pA0, pA1, pa0, pa1, pa2, pa3); pv_tile<0>(o, w.vb0, pa0, pa1, pa2, pa3);
                pack_p(pB0, pB1, pa0, pa1, pa2, pa3); pv_tile<1>(o, w.vb0, pa0, pa1, pa2, pa3);
                if (w.hi == 0) wsf[w.r32] = 1.f;
                asm volatile("s_waitcnt lgkmcnt(0)" ::: "memory");
                store_o(w, o, wsf, ocmp + (size_t)tok0 * 1024 + h * HD);
            }
            __syncthreads();
#pragma unroll 1
            for (int ps2 = 0; ps2 < 4; ++ps2) {
                int ln = w.lane; asm volatile("" : "+v"(ln));
                const int j = ln & 31, hi2 = ln >> 5;
                const int tk = 8 * w.wid + 2 * ps2 + hi2, t = qb * 64 + tk, cur = qb;
                float imp = 0.f;
#pragma unroll
                for (int r = 0; r < 4; ++r) imp += part[((size_t)r * 64 + tk) * 33 + j];
                const bool ok = (64 * j <= t), forced = (j == 0) || (cur - j >= 0 && cur - j < 2);
                const float val = (ok && forced) ? 1.0e30f : (ok ? imp : -1.0e30f);
                vals[ln] = val;
                asm volatile("s_waitcnt lgkmcnt(0)" ::: "memory");
                int rank = 0;
#pragma unroll
                for (int jj = 0; jj < 32; ++jj) { const float o2 = vals[hi2 * 32 + jj]; rank += (o2 > val || (o2 == val && jj < j)) ? 1 : 0; }
                const unsigned long long bal = __ballot(rank < 16 && val >= 0.f);
                if (w.lane == 0) { selm[8 * w.wid + 2 * ps2] = (unsigned)bal; selm[8 * w.wid + 2 * ps2 + 1] = (unsigned)(bal >> 32); }
            }
            __syncthreads();
        }
#endif
#ifndef ATT_NO_SEL
        {
            WV_INIT();
            const unsigned sm = selm[th * 32 + w.r32];
            const int ntile = qb + 1, hsplit = (ntile + 1) >> 1;
            const int ja = (qb >= 16 && type == 1) ? hsplit : 0, jb = (qb >= 16 && type == 0) ? hsplit : ntile;
#pragma unroll
            for (int d0 = 0; d0 < 8; ++d0) qr[d0] = *(const bf16x8*)(qrp + qoff + d0 * 16);
#pragma unroll
            for (int d = 0; d < 4; ++d) o[d] = f32x16{};
            float m_reg = -1e30f, l_reg = 0.f;
            flash_pass<0>(w, kv + (size_t)2 * (4 * MB / 2) + kvoff, kv + (size_t)3 * (4 * MB / 2) + kvoff, ja, jb, qr, tpos, t0, sm, o, m_reg, l_reg);
            if (w.hi == 0) { wsf[w.r32] = l_reg > 0.f ? 1.f / l_reg : 0.f; float* mp = ml + (((size_t)type * NT + tok0 + w.r32) * NH + h) * 2; mp[0] = m_reg; mp[1] = l_reg; }
            asm volatile("s_waitcnt lgkmcnt(0)" ::: "memory");
            store_o(w, o, wsf, osel + (size_t)type * NT * 1024 + (size_t)tok0 * 1024 + h * HD);
        }
#endif
    }
}

struct CvtTile { const float* src; const float* ksc; bf16_t* dst0; int sld, ldd, mode; };
__device__ __forceinline__ CvtTile cvt_decode(const Frame& F, int t) {
    CvtTile c; c.ksc = nullptr; c.mode = 0;
    if (t < 4096) { const int e = t >> 7, mat = (t >> 6) & 1, kt = (t >> 1) & 31, nt = t & 1;
        c.src = (mat ? F.in[I_WUP] : F.in[I_WGATE]) + ((size_t)e * DM + kt * 64) * FF + nt * 256; c.sld = FF; c.ksc = F.in[I_LNMOE] + kt * 64;
        c.dst0 = (bf16_t*)(F.ws + WS_W1T) + ((size_t)e * 1024 + nt * 512 + mat * 128) * DM + kt * 64; c.ldd = DM; c.mode = 1; return c; }
    t -= 4096;
    if (t < 2048) { const int e = t >> 6, kt = (t >> 3) & 7, nt = t & 7;
        c.src = F.in[I_WDOWN] + ((size_t)e * FF + kt * 64) * DM + nt * 256; c.sld = DM;
        c.dst0 = (bf16_t*)(F.ws + WS_W2T) + ((size_t)e * 2048 + nt * 256) * FF + kt * 64; c.ldd = FF; return c; }
    t -= 2048;
    if (t < 256) { const int kt = t >> 3, nt = t & 7;
        c.src = F.in[I_WOUT] + (size_t)kt * 64 * DM + nt * 256; c.sld = DM; c.dst0 = (bf16_t*)(F.ws + WS_WOUTT) + (size_t)nt * 256 * DM + kt * 64; c.ldd = DM; return c; }
    t -= 256;
    if (t < 480) { const int kt = t / 15, nt = t % 15;
        c.src = F.in[I_WIN] + (size_t)kt * 64 * INW; c.sld = INW; c.ksc = F.in[I_LNMIX] + kt * 64;
        c.dst0 = (bf16_t*)(F.ws + WS_WINT) + (size_t)nt * 256 * DM + kt * 64; c.ldd = DM; c.mode = 2 + nt; return c; }
    t -= 480;
    { const int kv = t >> 6, kt = t & 63;
      c.src = (kv ? F.in[I_WV1] : F.in[I_WK1]) + (size_t)kt * 64 * 256; c.sld = 256; c.dst0 = (bf16_t*)(F.ws + WS_CMPW) + (size_t)kv * 256 * 4096 + kt * 64; c.ldd = 4096; return c; }
}
constexpr int N_CVT_TILES = 4096 + 2048 + 256 + 480 + 128;
__device__ __forceinline__ void cvt_load(const CvtTile& c, int nq, int kq, float4 (&v)[8]) {
    const float* p = c.src + 4 * nq; bool valid = true;
    if (c.mode >= 2) { const int n = (c.mode - 2) * 256 + 4 * nq; int sc = -1; if (n < 2560) sc = n; else if (n < 3584) sc = n + 24; else if (n < 3608) sc = n - 1024; valid = sc >= 0; p = c.src + (valid ? sc : 0); }
#pragma unroll
    for (int i = 0; i < 8; ++i) v[i] = valid ? *(const float4*)(p + (size_t)(kq * 8 + i) * c.sld) : make_float4(0.f, 0.f, 0.f, 0.f);
}

constexpr int CVT_RUN = 4;
__device__ __forceinline__ void cvt_stream(const Frame& F, int t_lo, int t_hi, unsigned* queue, int sfirst = -1, int sstride = 0) {
    if (sfirst < 0) { sfirst = F.bid; sstride = F.G; }
    float* T = F.lds;
    volatile int* nxtw = (volatile int*)(F.lds + 64 * 257);
    const int tid = F.tid, nq = tid & 63, kq = tid >> 6;
    int tA, tB; float4 vA[8], vB[8]; CvtTile cA, cB;
    if (queue) { __syncthreads(); if (tid == 0) { nxtw[0] = t_lo + CVT_RUN * (int)atomicAdd(queue, 1u); nxtw[1] = t_lo + CVT_RUN * (int)atomicAdd(queue, 1u); } __syncthreads(); tA = nxtw[0]; tB = nxtw[1]; }
    else { tA = t_lo + sfirst; tB = tA + sstride; }
    if (tA < t_hi) { cA = cvt_decode(F, tA); cvt_load(cA, nq, kq, vA); }
    if (tB < t_hi) { cB = cvt_decode(F, tB); cvt_load(cB, nq, kq, vB); }
#define CVT_STEP(tX, cX, vX, slot) do {                                                                                                     \
        const bool pop = queue && (((tX) - t_lo) % CVT_RUN == CVT_RUN - 1);                 \
        int tn_reg = 0;                                                                                                                      \
        if (pop && tid == 0) tn_reg = t_lo + CVT_RUN * (int)atomicAdd(queue, 1u);                                                            \
        __syncthreads();                                                                                                                     \
        _Pragma("unroll") for (int i = 0; i < 8; ++i) { const float s = cX.ksc ? cX.ksc[kq * 8 + i] : 1.f; float* tp = T + (kq * 8 + i) * 257 + 4 * nq; \
            tp[0] = vX[i].x * s; tp[1] = vX[i].y * s; tp[2] = vX[i].z * s; tp[3] = vX[i].w * s; }                                           \
        if (pop && tid == 0) nxtw[slot] = tn_reg;                                                                                            \
        __syncthreads();                                                                                                                     \
        const CvtTile cc = cX; const int tn = queue ? (pop ? nxtw[slot] : tX + 1) : tX + 2 * sstride;                                            \
        if (tn < t_hi) { cX = cvt_decode(F, tn); cvt_load(cX, nq, kq, vX); }                                                                 \
        _Pragma("unroll") for (int j = 0; j < 4; ++j) { const int id = tid + 512 * j, n = id >> 3, kc = id & 7; const float* tp = T + (kc * 8) * 257 + n; \
            pg8::u32x4 w; w.x = pg8::cvt_pk_bf16(tp[0], tp[257]); w.y = pg8::cvt_pk_bf16(tp[2 * 257], tp[3 * 257]); w.z = pg8::cvt_pk_bf16(tp[4 * 257], tp[5 * 257]); w.w = pg8::cvt_pk_bf16(tp[6 * 257], tp[7 * 257]); \
            const int rowi = (cc.mode == 1) ? ((n >> 7) * 256 + (n & 127)) : n;                                                              \
            *(pg8::u32x4*)(cc.dst0 + (size_t)rowi * cc.ldd + kc * 8) = w; }                                                                  \
        tX = tn; } while (0)
    while (tA < t_hi) {
        CVT_STEP(tA, cA, vA, 0);
        if (tB >= t_hi) { const int t2 = tA; tA = tB; tB = t2; const CvtTile c2 = cA; cA = cB; cB = c2;
#pragma unroll
            for (int i = 0; i < 8; ++i) { const float4 x = vA[i]; vA[i] = vB[i]; vB[i] = x; }
            continue; }
        CVT_STEP(tB, cB, vB, 1);
    }
    while (tB < t_hi) CVT_STEP(tB, cB, vB, 1);
#undef CVT_STEP
    __syncthreads();
}

__device__ __forceinline__ void p0_tables(const Frame& F, int first, int stride) {
    {
        const float* wp = F.in[I_WPOOL]; const float* ps = F.in[I_PSCALE]; const float* bp = F.in[I_BPOOL]; bf16_t* wpt = (bf16_t*)(F.ws + WS_POOLW); float* pb = (float*)(F.ws + WS_POOLB);
        for (int idx = first * NTHREADS + F.tid; idx < 4 * 256 * 256; idx += stride * NTHREADS) { const int k = idx & 255, n = (idx >> 8) & 255, g = idx >> 16;
            wpt[idx] = f2bf(wp[((size_t)g * 256 + k) * 256 + n] * ps[g * 256 + n]); }
        for (int idx = first * NTHREADS + F.tid; idx < 1024; idx += stride * NTHREADS) pb[idx] = bp[idx] * ps[idx];
    }
    { const float* lnm = F.in[I_LNMOE]; const float* wre = F.in[I_WRE]; const float* wrg = F.in[I_WRG]; float* WRP = (float*)(F.ws + WS_WRP);
      for (int idx = first * NTHREADS + F.tid; idx < DM * 48; idx += stride * NTHREADS) { const int k = idx / 48, c = idx - k * 48;
          WRP[idx] = c < 32 ? lnm[k] * wre[((size_t)(c >> 3) * DM + k) * 8 + (c & 7)] : (c < 36 ? lnm[k] * wrg[k * 4 + (c - 32)] : 0.f); } }
    for (int it = first; it < 256; it += stride) {
        const int kv = it >> 7, jb = (it >> 5) & 3, mc = it & 31;
        const float* pe = (kv ? F.in[I_PEV] : F.in[I_PEK]); const float* w1 = (kv ? F.in[I_WV1] : F.in[I_WK1]);
        const int mg = F.tid >> 6, j = jb * 64 + (F.tid & 63);
        float a = 0.f;
#pragma unroll
        for (int q = 0; q < 16; ++q) { const int m = mc * 128 + mg + 8 * q; a += pe[m] * w1[(size_t)m * 256 + j]; }
        __syncthreads();
        F.lds[F.tid] = a;
        __syncthreads();
        if (F.tid < 64) { float s = 0.f; for (int q = 0; q < 8; ++q) s += F.lds[q * 64 + F.tid]; ((float*)(F.ws + WS_BIAS1))[(mc * 2 + kv) * 256 + j] = s; }
        __syncthreads();
    }
}
__device__ __forceinline__ void p0_prologue(const Frame& F) {
    const float* x = F.in[I_X];
    bf16_t* xb = (bf16_t*)(F.ws + WS_XB); float* rstd1 = (float*)(F.ws + WS_RSTD1);
    const int gw = F.bid * NWAVES + F.wave, nw = F.G * NWAVES, lane = F.lane;
    for (int r = gw; r < NT; r += 2 * nw) {
        const int r2 = r + nw; const bool has2 = r2 < NT;
        float4 v[8], v2[8]; float ss = 0.f, ss2 = 0.f;
#pragma unroll
        for (int i = 0; i < 8; ++i) { v[i] = *(const float4*)(x + (size_t)r * DM + i * 256 + lane * 4); v2[i] = has2 ? *(const float4*)(x + (size_t)r2 * DM + i * 256 + lane * 4) : make_float4(0.f, 0.f, 0.f, 0.f); }
#pragma unroll
        for (int i = 0; i < 8; ++i) { ss += v[i].x * v[i].x + v[i].y * v[i].y + v[i].z * v[i].z + v[i].w * v[i].w; ss2 += v2[i].x * v2[i].x + v2[i].y * v2[i].y + v2[i].z * v2[i].z + v2[i].w * v2[i].w; }
        ss = wave_sum(ss); ss2 = wave_sum(ss2);
        if (lane == 0) { rstd1[r] = rsqrtf(ss * (1.f / DM) + EPS); if (has2) rstd1[r2] = rsqrtf(ss2 * (1.f / DM) + EPS); }
#pragma unroll
        for (int i = 0; i < 8; ++i) { uint2 w; w.x = pg8::cvt_pk_bf16(v[i].x, v[i].y); w.y = pg8::cvt_pk_bf16(v[i].z, v[i].w);
            *(uint2*)(xb + (size_t)r * DM + i * 256 + lane * 4) = w;
            if (has2) { uint2 w2; w2.x = pg8::cvt_pk_bf16(v2[i].x, v2[i].y); w2.y = pg8::cvt_pk_bf16(v2[i].z, v2[i].w); *(uint2*)(xb + (size_t)r2 * DM + i * 256 + lane * 4) = w2; } }
    }
    cvt_stream(F, 6400, N_CVT_TILES, nullptr);
    {
        const int* pos = (const int*)F.in[I_POS]; float* rc = (float*)(F.ws + WS_ROPEC); float* rs = (float*)(F.ws + WS_ROPES);
        for (int idx = F.bid * NTHREADS + F.tid; idx < NB * SEQ * 16; idx += F.G * NTHREADS) {
            const int i = idx & 15, bs = idx >> 4;
            const float inv = exp2f(-(float)i * (1.f / 16.f) * 18.931568569324174f);
            const float ang = (float)pos[bs] * inv;
            rc[idx] = cosf(ang); rs[idx] = sinf(ang);
        }
    }
}

struct EpiProj {
    static constexpr bool AFTER_DRAIN = false;
    const float* rstd1; const float* rc; const float* rs; bf16_t* qn; bf16_t* qr; bf16_t* kv; bf16_t* u; float* gates;
    __device__ __forceinline__ void operator()(const pg8::f32x4 (&acc)[2][2][4][2], const pg8::Unit& un, int wr, int wc, int fr, int fq) const {
        const int pn = un.pn;
#pragma unroll
        for (int ai = 0; ai < 2; ++ai)
#pragma unroll
            for (int m = 0; m < 4; ++m) {
                const int row = un.pm * 256 + ai * 128 + wr * 64 + m * 16 + fr; const float r1 = rstd1[row]; const int b = row >> 11, s = row & 2047;
                if (pn < 10) {
                    const bool ropeu = (pn < 4) || pn == 6 || pn == 8;
                    pg8::f32x4 c4 = {1.f, 1.f, 1.f, 1.f}, s4 = {0.f, 0.f, 0.f, 0.f};
                    if (ropeu && wc == 0) { c4 = *(const pg8::f32x4*)(rc + (size_t)row * 16 + 4 * fq); s4 = *(const pg8::f32x4*)(rs + (size_t)row * 16 + 4 * fq); }
#pragma unroll
                    for (int bj = 0; bj < 2; ++bj) {
                        const pg8::f32x4 v0 = acc[ai][bj][m][0] * r1, v1 = acc[ai][bj][m][1] * r1;
                        const int d0 = 32 * wc + 4 * fq;
                        pg8::f32x4 o0 = v0, o1 = v1;
                        if (ropeu && wc == 0) { o0 = v0 * c4 - v1 * s4; o1 = v1 * c4 + v0 * s4; }
                        uint2 w0, w1; w0.x = pg8::cvt_pk_bf16(o0[0], o0[1]); w0.y = pg8::cvt_pk_bf16(o0[2], o0[3]); w1.x = pg8::cvt_pk_bf16(o1[0], o1[1]); w1.y = pg8::cvt_pk_bf16(o1[2], o1[3]);
                        if (pn < 4) {
                            const size_t o = (((size_t)b * NH + 2 * pn + bj) * SEQ + s) * HD + d0;
                            uint2 n0, n1; n0.x = pg8::cvt_pk_bf16(v0[0], v0[1]); n0.y = pg8::cvt_pk_bf16(v0[2], v0[3]); n1.x = pg8::cvt_pk_bf16(v1[0], v1[1]); n1.y = pg8::cvt_pk_bf16(v1[2], v1[3]);
                            *(uint2*)(qn + o) = n0; *(uint2*)(qn + o + 16) = n1; *(uint2*)(qr + o) = w0; *(uint2*)(qr + o + 16) = w1;
                        } else {
                            const size_t o = (size_t)(pn - 4) * (4 * MB / 2) + (((size_t)b * NG + bj) * SEQ + s) * HD + d0;
                            *(uint2*)(kv + o) = w0; *(uint2*)(kv + o + 16) = w1;
                        }
                    }
                } else if (pn < 14) {
#pragma unroll
                    for (int bj = 0; bj < 2; ++bj)
#pragma unroll
                        for (int n = 0; n < 2; ++n) { const pg8::f32x4 v = acc[ai][bj][m][n] * r1; uint2 w_; w_.x = pg8::cvt_pk_bf16(v[0], v[1]); w_.y = pg8::cvt_pk_bf16(v[2], v[3]);
                            *(uint2*)(u + (size_t)row * 1024 + (pn - 10) * 256 + bj * 128 + wc * 32 + n * 16 + 4 * fq) = w_; }
                } else {
                    if (wc == 0) { *(pg8::f32x4*)(gates + (size_t)row * 24 + 4 * fq) = acc[ai][0][m][0] * r1; if (fq < 2) *(pg8::f32x4*)(gates + (size_t)row * 24 + 16 + 4 * fq) = acc[ai][0][m][1] * r1; }
                }
            }
    }
};

__device__ __forceinline__ void p1_proj(const Frame& F, LAS unsigned char* stage) {
    pg8::DenseOrder S; S.init(F.ws + WS_XB, F.ws + WS_WINT, DM, DM, NT, INWP, F.G, F.bid);
    EpiProj E{(const float*)(F.ws + WS_RSTD1), (const float*)(F.ws + WS_ROPEC), (const float*)(F.ws + WS_ROPES), (bf16_t*)(F.ws + WS_QN), (bf16_t*)(F.ws + WS_QR), (bf16_t*)(F.ws + WS_KV),
              (bf16_t*)(F.ws + WS_U), (float*)(F.ws + WS_GATES)};
    pg8::gemm_phase<EpiProj, pg8::DenseOrder, false>(stage, DM, DM, DM, S, E);
}

__device__ __forceinline__ void p4_cmp2(const Frame& F, int first, int stride, bool gated) {
    const float* part = (const float*)(F.ws + WS_CPART); const float* bias1p = (const float*)(F.ws + WS_BIAS1); bf16_t* ckv = (bf16_t*)(F.ws + WS_CMPKV);
    float* H = F.lds;
    float* W2 = F.lds + 8 * 260;
    unsigned* ctl = (unsigned*)(F.ws + WS_CTL);
    int w2_of = -1;
    for (int it = first; it < 256; it += stride) {
        const int kvi = it >> 7, r0 = (it & 127) * 8; const float* w2 = kvi ? F.in[I_WV2] : F.in[I_WK2];
        __syncthreads();
        if (gated && F.tid == 0) { unsigned* cw = ctl + CW_CMPR + 64 * (kvi * 4 + (r0 >> 8)); unsigned sp = 0;
            while (__hip_atomic_load(cw, __ATOMIC_RELAXED, __HIP_MEMORY_SCOPE_AGENT) < 8u) { __builtin_amdgcn_s_sleep(2);
                if ((++sp & 255u) == 0u) { if (xb_ld(&ctl[XB_TMO])) break; if (sp > XB_SPIN_CAP) { atomicAdd(&ctl[XB_TMO], 1u); break; } } }
            __builtin_amdgcn_fence(__ATOMIC_ACQUIRE, "agent"); asm volatile("s_waitcnt vmcnt(0)" ::: "memory"); }
        if (gated) __syncthreads();
        if (w2_of != kvi) {
#pragma unroll
            for (int j = 0; j < 16; ++j) { const int idx = F.tid + 512 * j; *(pg8::f32x4*)(W2 + idx * 4) = *(const pg8::f32x4*)(w2 + idx * 4); }
            w2_of = kvi;
        }
        { const int r = F.tid >> 6, c = (F.tid & 63) * 4;
            pg8::f32x4 s = {0.f, 0.f, 0.f, 0.f};
#pragma unroll
            for (int sp = 0; sp < 8; ++sp) s += *(const pg8::f32x4*)(part + (((size_t)sp * 2 + kvi) * 1024 + r0 + r) * 256 + c);
#pragma unroll
            for (int sp = 0; sp < 32; ++sp) s += *(const pg8::f32x4*)(bias1p + (sp * 2 + kvi) * 256 + c);
            H[r * 260 + c] = gelu_tanh(s[0]); H[r * 260 + c + 1] = gelu_tanh(s[1]); H[r * 260 + c + 2] = gelu_tanh(s[2]); H[r * 260 + c + 3] = gelu_tanh(s[3]); }
        __syncthreads();
        const int r = F.tid >> 6, c0 = (F.tid & 63) * 2;
        float a0 = 0.f, a1 = 0.f;
#pragma unroll 16
        for (int k = 0; k < 256; ++k) { const float hv = H[r * 260 + k]; const float2 wv = *(const float2*)(W2 + k * 128 + c0); a0 += hv * wv.x; a1 += hv * wv.y; }
        const int R = r0 + r; const bool pad = (R & 127) == 127;
        *(unsigned*)(ckv + ((size_t)kvi * 1024 + R) * 128 + c0) = pad ? 0u : pg8::cvt_pk_bf16(a0, a1);
    }
}

struct CmpOrder {
    const char* kc; const char* w1t; int c;
    __device__ __forceinline__ bool next(int i, pg8::Unit& u) const { if (i > 0) return false; u.e = c >> 5; u.pm = (c >> 3) & 3; u.pn = c & 7; u.li = 0; return true; }
    __device__ __forceinline__ const char* a_base(const pg8::Unit& u) const { return kc + (size_t)u.e * 4 * MB + ((size_t)u.pm * 256 * 2048 + u.pn * 512) * 2; }
    __device__ __forceinline__ const char* b_base(const pg8::Unit& u) const { return w1t + ((size_t)u.e * 256 * 4096 + u.pn * 512) * 2; }
    __device__ __forceinline__ unsigned a_row_off(const pg8::Unit&, int r) const { return (unsigned)r * 4096u; }
};
struct EpiCmp {
    static constexpr bool AFTER_DRAIN = false;
    float* part;
    __device__ __forceinline__ void operator()(const pg8::f32x4 (&acc)[2][2][4][2], const pg8::Unit& un, int wr, int wc, int fr, int fq) const {
        float* base = part + (((size_t)un.pn * 2 + un.e) * 1024 + un.pm * 256) * 256;
#pragma unroll
        for (int ai = 0; ai < 2; ++ai)
#pragma unroll
            for (int m = 0; m < 4; ++m) { float* rowp = base + (size_t)(ai * 128 + wr * 64 + m * 16 + fr) * 256 + wc * 32 + 4 * fq;
#pragma unroll
                for (int bj = 0; bj < 2; ++bj)
#pragma unroll
                    for (int n = 0; n < 2; ++n) *(pg8::f32x4*)(rowp + bj * 128 + n * 16) = acc[ai][bj][m][n]; }
    }
};
struct PoolOrder {
    const char* d; const char* wpt; int c;
    __device__ __forceinline__ bool next(int i, pg8::Unit& u) const { if (i > 0) return false; u.pm = c >> 2; u.pn = 0; u.e = c & 3; u.li = 0; return true; }
    __device__ __forceinline__ const char* a_base(const pg8::Unit& u) const { return d + ((size_t)u.pm * 256 * 1024 + u.e * 256) * 2; }
    __device__ __forceinline__ const char* b_base(const pg8::Unit& u) const { return wpt + (size_t)u.e * 256 * 256 * 2; }
    __device__ __forceinline__ unsigned a_row_off(const pg8::Unit&, int r) const { return (unsigned)r * 2048u; }
};
struct EpiPool {
    static constexpr bool AFTER_DRAIN = false;
    const float* pb; bf16_t* opool;
    __device__ __forceinline__ void operator()(const pg8::f32x4 (&acc)[2][2][4][2], const pg8::Unit& un, int wr, int wc, int fr, int fq) const {
#pragma unroll
        for (int ai = 0; ai < 2; ++ai)
#pragma unroll
            for (int m = 0; m < 4; ++m) { const int row = un.pm * 256 + ai * 128 + wr * 64 + m * 16 + fr;
#pragma unroll
                for (int bj = 0; bj < 2; ++bj)
#pragma unroll
                    for (int n = 0; n < 2; ++n) { const int c = un.e * 256 + bj * 128 + wc * 32 + n * 16 + 4 * fq;
                        const pg8::f32x4 v = acc[ai][bj][m][n] + *(const pg8::f32x4*)(pb + c); uint2 w_; w_.x = pg8::cvt_pk_bf16(v[0], v[1]); w_.y = pg8::cvt_pk_bf16(v[2], v[3]);
                        *(uint2*)(opool + (size_t)row * 1024 + c) = w_; } }
    }
};
__device__ __forceinline__ void p2a_mid(const Frame& F, LAS unsigned char* stage) {
    if (F.bid < 64) {
        CmpOrder S{(const char*)(F.ws + WS_KV), (const char*)(F.ws + WS_CMPW), F.bid};
        EpiCmp E{(float*)(F.ws + WS_CPART)};
        pg8::gemm_phase<EpiCmp, CmpOrder, false>(stage, 512, 2048, 4096, S, E);
    } else {
        const bf16_t* u = (const bf16_t*)(F.ws + WS_U); bf16_t* d = (bf16_t*)(F.ws + WS_DBUF);
        for (int ch = F.bid - 64; ch < NT / 16; ch += F.G - 64) {
            const int r0 = ch * 16, s0 = r0 & 2047, col = 2 * F.tid, w = 2 << (col >> 8);
            float u0[31], u1[31];
#pragma unroll
            for (int q = 0; q < 31; ++q) { const int s = s0 - 15 + q; const unsigned pr = (s >= 0) ? *(const unsigned*)(u + (size_t)(r0 - 15 + q) * 1024 + col) : 0u;
                u0[q] = __uint_as_float(pr << 16); u1[q] = __uint_as_float(pr & 0xFFFF0000u); }
#pragma unroll
            for (int i = 0; i < 16; ++i) { float sa = 0.f, sb = 0.f;
#pragma unroll
                for (int q = 0; q < 16; ++q) if (q < w) { sa += u0[15 + i - q]; sb += u1[15 + i - q]; }
                const int s = s0 + i, cnt = (s + 1 < w) ? s + 1 : w; const float ic = 1.f / (float)cnt;
                *(unsigned*)(d + (size_t)(r0 + i) * 1024 + col) = pg8::cvt_pk_bf16(sa * ic - u0[15 + i], sb * ic - u1[15 + i]); }
        }
        p0_tables(F, F.bid - 64, F.G - 64);
    }
}
__device__ __forceinline__ void p2b_mid(const Frame& F, LAS unsigned char* stage) {
    if (F.bid < 128) {
        PoolOrder S{(const char*)(F.ws + WS_DBUF), (const char*)(F.ws + WS_POOLW), F.bid};
        EpiPool E{(const float*)(F.ws + WS_POOLB), (bf16_t*)(F.ws + WS_OPOOL)};
        pg8::gemm_phase<EpiPool, PoolOrder, false>(stage, 256, 1024, 256, S, E);
    } else {
        p4_cmp2(F, F.bid - 128, F.G - 128, false);
        cvt_stream(F, 6144, 6400, nullptr, F.bid - 128, F.G - 128);
    }
}

__device__ __forceinline__ void unpack8(const pg8::u32x4 w, float (&f)[8]) {
    f[0] = __uint_as_float(w.x << 16); f[1] = __uint_as_float(w.x & 0xFFFF0000u); f[2] = __uint_as_float(w.y << 16); f[3] = __uint_as_float(w.y & 0xFFFF0000u);
    f[4] = __uint_as_float(w.z << 16); f[5] = __uint_as_float(w.z & 0xFFFF0000u); f[6] = __uint_as_float(w.w << 16); f[7] = __uint_as_float(w.w & 0xFFFF0000u);
}
__device__ __forceinline__ void p6_mix(const Frame& F) {
    const bf16_t* ocmp = (const bf16_t*)(F.ws + WS_OCMP); const bf16_t* owin = (const bf16_t*)(F.ws + WS_OWIN); const bf16_t* osel = (const bf16_t*)(F.ws + WS_OSEL);
    const float* ml = (const float*)(F.ws + WS_ML); const float* gates = (const float*)(F.ws + WS_GATES);
    const bf16_t* opool = (const bf16_t*)(F.ws + WS_OPOOL); bf16_t* mix = (bf16_t*)(F.ws + WS_MIX);
    const float* gn = F.in[I_GNNSA]; const float* gp = F.in[I_GNPOOL];
    const int gw = F.bid * NWAVES + F.wave, nw = F.G * NWAVES, lane = F.lane, h = lane >> 3;
    for (int r = gw; r < NT; r += nw) {
        const bool split = ((r & 2047) >> 6) >= 16;
        const size_t o = (size_t)r * 1024 + lane * 16;
        const float* gq = gates + (size_t)r * 24 + h * 3;
        const float g0 = 1.f / (1.f + __expf(-gq[0])), g1 = 1.f / (1.f + __expf(-gq[1])), g2 = 1.f / (1.f + __expf(-gq[2]));
        float w0 = 1.f, w1 = 0.f;
        if (split) { const float* m0p = ml + ((size_t)r * NH + h) * 2; const float* m1p = ml + (((size_t)NT + r) * NH + h) * 2;
            const float m0 = m0p[0], l0 = m0p[1], m1 = m1p[0], l1 = m1p[1], M = fmaxf(m0, m1);
            const float a0 = l0 * exp2f((m0 - M) * att::C2), a1 = l1 * exp2f((m1 - M) * att::C2), inv = 1.f / (a0 + a1); w0 = a0 * inv; w1 = a1 * inv; }
        float a[16], p[16]; float sa = 0.f, sp = 0.f;
#pragma unroll
        for (int hf = 0; hf < 2; ++hf) {
            float c8[8], w8[8], s8[8], t8[8];
            unpack8(*(const pg8::u32x4*)(ocmp + o + hf * 8), c8); unpack8(*(const pg8::u32x4*)(owin + o + hf * 8), w8); unpack8(*(const pg8::u32x4*)(osel + o + hf * 8), s8);
            if (split) unpack8(*(const pg8::u32x4*)(osel + (size_t)NT * 1024 + o + hf * 8), t8);
#pragma unroll
            for (int j = 0; j < 8; ++j) { const float os = split ? (w0 * s8[j] + w1 * t8[j]) : s8[j]; a[hf * 8 + j] = g0 * c8[j] + g1 * os + g2 * w8[j]; sa += a[hf * 8 + j] * a[hf * 8 + j]; }
        }
#pragma unroll
        for (int q = 0; q < 2; ++q) { float p8[8]; unpack8(*(const pg8::u32x4*)(opool + o + q * 8), p8);
#pragma unroll
            for (int j = 0; j < 8; ++j) { p[q * 8 + j] = p8[j]; sp += p8[j] * p8[j]; } }
        sa = wave_sum(sa); sp = wave_sum(sp);
        const float ra = rsqrtf(sa * (1.f / 1024.f) + EPS), rp = rsqrtf(sp * (1.f / 1024.f) + EPS);
        float ga[16], gb[16];
#pragma unroll
        for (int q = 0; q < 4; ++q) { const pg8::f32x4 v = *(const pg8::f32x4*)(gn + lane * 16 + q * 4), u = *(const pg8::f32x4*)(gp + lane * 16 + q * 4);
            ga[q * 4] = v[0]; ga[q * 4 + 1] = v[1]; ga[q * 4 + 2] = v[2]; ga[q * 4 + 3] = v[3]; gb[q * 4] = u[0]; gb[q * 4 + 1] = u[1]; gb[q * 4 + 2] = u[2]; gb[q * 4 + 3] = u[3]; }
#pragma unroll
        for (int hf = 0; hf < 2; ++hf) { pg8::u32x4 wa, wb;
            wa.x = pg8::cvt_pk_bf16(a[hf * 8] * ra * ga[hf * 8], a[hf * 8 + 1] * ra * ga[hf * 8 + 1]); wa.y = pg8::cvt_pk_bf16(a[hf * 8 + 2] * ra * ga[hf * 8 + 2], a[hf * 8 + 3] * ra * ga[hf * 8 + 3]);
            wa.z = pg8::cvt_pk_bf16(a[hf * 8 + 4] * ra * ga[hf * 8 + 4], a[hf * 8 + 5] * ra * ga[hf * 8 + 5]); wa.w = pg8::cvt_pk_bf16(a[hf * 8 + 6] * ra * ga[hf * 8 + 6], a[hf * 8 + 7] * ra * ga[hf * 8 + 7]);
            wb.x = pg8::cvt_pk_bf16(p[hf * 8] * rp * gb[hf * 8], p[hf * 8 + 1] * rp * gb[hf * 8 + 1]); wb.y = pg8::cvt_pk_bf16(p[hf * 8 + 2] * rp * gb[hf * 8 + 2], p[hf * 8 + 3] * rp * gb[hf * 8 + 3]);
            wb.z = pg8::cvt_pk_bf16(p[hf * 8 + 4] * rp * gb[hf * 8 + 4], p[hf * 8 + 5] * rp * gb[hf * 8 + 5]); wb.w = pg8::cvt_pk_bf16(p[hf * 8 + 6] * rp * gb[hf * 8 + 6], p[hf * 8 + 7] * rp * gb[hf * 8 + 7]);
            *(pg8::u32x4*)(mix + (size_t)r * DM + lane * 16 + hf * 8) = wa; *(pg8::u32x4*)(mix + (size_t)r * DM + 1024 + lane * 16 + hf * 8) = wb; }
    }
}

struct EpiOut {
    static constexpr bool AFTER_DRAIN = true;
    const float* x; float* out; bf16_t* x1b; const float* lnm; const float* wrp; float* pl;
    __device__ __forceinline__ void fused(pg8::f32x4 (&acc)[2][2][4][2], const pg8::Unit& un, int wr, int wc, int fr, int fq, LAS unsigned char* lds) const {
#pragma unroll
        for (int ai = 0; ai < 2; ++ai)
#pragma unroll
            for (int m = 0; m < 4; ++m) {
                const int row = un.pm * 256 + ai * 128 + wr * 64 + m * 16 + fr;
#pragma unroll
                for (int bj = 0; bj < 2; ++bj)
#pragma unroll
                    for (int n = 0; n < 2; ++n) {
                        const size_t o = (size_t)row * DM + un.pn * 256 + bj * 128 + wc * 32 + n * 16 + 4 * fq;
                        const pg8::f32x4 v = acc[ai][bj][m][n] + *(const pg8::f32x4*)(x + o);
                        acc[ai][bj][m][n] = v;
                        const pg8::f32x4 g = *(const pg8::f32x4*)(lnm + un.pn * 256 + bj * 128 + wc * 32 + n * 16 + 4 * fq);
                        uint2 w; w.x = pg8::cvt_pk_bf16(v[0] * g[0], v[1] * g[1]); w.y = pg8::cvt_pk_bf16(v[2] * g[2], v[3] * g[3]); *(uint2*)(x1b + o) = w;
                    }
            }
        float* red = (float*)((unsigned char*)lds);
        const int tid = threadIdx.x;
#pragma unroll 1
        for (int ai = 0; ai < 2; ++ai) {
#pragma unroll
            for (int m = 0; m < 4; ++m) {
                pg8::f32x4 D0 = {0.f, 0.f, 0.f, 0.f}, D1 = D0, D2 = D0; float s2 = 0.f;
#pragma unroll
                for (int bj = 0; bj < 2; ++bj)
#pragma unroll
                    for (int n = 0; n < 2; ++n) {
                        const pg8::f32x4 v = (ai == 0) ? acc[0][bj][m][n] : acc[1][bj][m][n];
                        s2 += v[0] * v[0] + v[1] * v[1] + v[2] * v[2] + v[3] * v[3];
                        const float* wb = wrp + (size_t)(un.pn * 256 + bj * 128 + wc * 32 + n * 16 + 4 * fq) * 48 + fr;
#pragma unroll
                        for (int j = 0; j < 4; ++j) {
                            D0 = __builtin_amdgcn_mfma_f32_16x16x4f32(v[j], wb[j * 48], D0, 0, 0, 0);
                            D1 = __builtin_amdgcn_mfma_f32_16x16x4f32(v[j], wb[j * 48 + 16], D1, 0, 0, 0);
                            D2 = __builtin_amdgcn_mfma_f32_16x16x4f32(v[j], wb[j * 48 + 32], D2, 0, 0, 0);
                        }
                    }
                s2 += __shfl_xor(s2, 16); s2 += __shfl_xor(s2, 32);
                float* rr = red + ((size_t)wc * 128 + wr * 64 + m * 16) * 40;
#pragma unroll
                for (int r = 0; r < 4; ++r) { float* q = rr + (4 * fq + r) * 40; q[fr] = D0[r]; q[16 + fr] = D1[r]; if (fr < 8) q[32 + fr] = D2[r]; }
                if (fq == 0) rr[fr * 40 + 36] = s2;
            }
            __syncthreads();
            for (int idx = tid; idx < 128 * 40; idx += 512) { const int r = idx / 40, c = idx - r * 40;
                const float s = (red[idx] + red[128 * 40 + idx]) + (red[2 * 128 * 40 + idx] + red[3 * 128 * 40 + idx]);
                if (c < 37) pl[((size_t)un.pn * NT + un.pm * 256 + ai * 128 + r) * 40 + c] = s; }
            __syncthreads();
        }
    }
};
__device__ __forceinline__ void p7_out(const Frame& F, LAS unsigned char* stage) {
    pg8::DenseOrder S; S.init(F.ws + WS_MIX, F.ws + WS_WOUTT, DM, DM, NT, DM, F.G, F.bid);
    EpiOut E{F.in[I_X], F.out, (bf16_t*)(F.ws + WS_X1B), F.in[I_LNMOE], (const float*)(F.ws + WS_WRP), (float*)(F.ws + WS_PL)};
    pg8::gemm_phase<EpiOut, pg8::DenseOrder, false>(stage, DM, DM, DM, S, E);
}

__device__ __forceinline__ void p8_router(const Frame& F, int dummy) {
    const float* pl = (const float*)(F.ws + WS_PL); const float* brg = F.in[I_BRG]; const float* bre = F.in[I_BRE];
    float* rstd2 = (float*)(F.ws + WS_RSTD2); int* arow = (int*)(F.ws + WS_AROW); int* tokl = (int*)(F.ws + WS_TOKL); float* gatel = (float*)(F.ws + WS_GATEL);
    unsigned* cnt = (unsigned*)(F.ws + WS_CTL) + CW_CNT; (void)dummy;
    const int gw = F.bid * NWAVES + F.wave, nw = F.G * NWAVES, lane = F.lane, tl = lane >> 3, pn = lane & 7;
    for (int wv = gw; wv < NT / 8; wv += nw) {
        const int r = wv * 8 + tl;
        const float* p = pl + ((size_t)pn * NT + r) * 40;
        float v[37];
#pragma unroll
        for (int q = 0; q < 9; ++q) { const pg8::f32x4 t = *(const pg8::f32x4*)(p + 4 * q); v[4 * q] = t[0]; v[4 * q + 1] = t[1]; v[4 * q + 2] = t[2]; v[4 * q + 3] = t[3]; }
        v[36] = p[36];
#pragma unroll
        for (int c = 0; c < 37; ++c) { v[c] += __shfl_xor(v[c], 1); v[c] += __shfl_xor(v[c], 2); v[c] += __shfl_xor(v[c], 4); }
        if (pn == 0) {
            const float rs = rsqrtf(v[36] * (1.f / DM) + EPS);
            float lg[4];
#pragma unroll
            for (int j = 0; j < 4; ++j) lg[j] = v[32 + j] * rs + brg[j];
            int gs = 0; float gm = lg[0];
#pragma unroll
            for (int j = 1; j < 4; ++j) if (lg[j] > gm) { gm = lg[j]; gs = j; }
            float den = 0.f;
#pragma unroll
            for (int j = 0; j < 4; ++j) den += __expf(lg[j] - gm);
            const float pg = 1.f / den;
            float le[8];
#pragma unroll
            for (int j = 0; j < 8; ++j) { const float s = (gs == 0) ? v[j] : (gs == 1) ? v[8 + j] : (gs == 2) ? v[16 + j] : v[24 + j]; le[j] = s * rs + bre[gs * 8 + j]; }
            int e0 = 0; float m0 = le[0];
#pragma unroll
            for (int j = 1; j < 8; ++j) if (le[j] > m0) { m0 = le[j]; e0 = j; }
            int e1 = -1; float m1 = -3.0e38f;
#pragma unroll
            for (int j = 0; j < 8; ++j) if (j != e0 && le[j] > m1) { m1 = le[j]; e1 = j; }
            const float p1 = __expf(m1 - m0);
            const float gate0 = pg / (1.f + p1), gate1 = pg * p1 / (1.f + p1);
            rstd2[r] = rs;
            const int ea = gs * 8 + e0, eb = gs * 8 + e1;
            const unsigned sa = atomicAdd(&cnt[64 * ea], 1u), sb = atomicAdd(&cnt[64 * eb], 1u);
            tokl[ea * 8192 + sa] = r; gatel[ea * 8192 + sa] = gate0; tokl[eb * 8192 + sb] = r; gatel[eb * 8192 + sb] = gate1;
            arow[2 * r] = ea * 8192 + (int)sa; arow[2 * r + 1] = eb * 8192 + (int)sb;
        }
    }
}

__device__ __forceinline__ void moe_counts(const Frame& F, int* cnts  , int* pst  ) {
    const unsigned* cnt = (const unsigned*)(F.ws + WS_CTL) + CW_CNT;
    __syncthreads();
    if (F.tid < 32) cnts[F.tid] = (int)__hip_atomic_load(&cnt[64 * F.tid], __ATOMIC_RELAXED, __HIP_MEMORY_SCOPE_AGENT);
    __syncthreads();
    if (F.tid == 0) { int a = 0; for (int e = 0; e < 32; ++e) { pst[e] = a; a += (cnts[e] + 255) & ~255; } pst[32] = a; }
    __syncthreads();
}

constexpr int MOE_TAB_OFF = 1024 + 131072;
struct MoeTabs { int* cnts; int* pst; int* ust; int* usth; int* rowtok; };
__device__ __forceinline__ MoeTabs moe_tabs(unsigned char* lds_raw) { MoeTabs T; T.cnts = (int*)(lds_raw + MOE_TAB_OFF); T.pst = T.cnts + 32; T.ust = T.pst + 40; T.usth = T.ust + 40; T.rowtok = T.usth + 40; return T; }
template <int NTN> __device__ __forceinline__ void moe_units(const Frame& F, const MoeTabs& T) {
    moe_counts(F, T.cnts, T.pst);
    if (F.tid == 0) { int a = 0, h = 0; for (int e = 0; e < 32; ++e) { const int c = T.cnts[e], nmt = (c + 255) >> 8, hl = (nmt > 0 && c - 256 * (nmt - 1) <= 128) ? 1 : 0;
            T.ust[e] = a; T.usth[e] = h; a += (nmt - hl) * NTN; h += hl * NTN; } T.ust[32] = a; T.usth[32] = h; }
    __syncthreads();
}
template <int NTN> struct MoeOrder2 {
    const int* cnts; const int* pst; const int* ust; const int* usth; const int* rowtok; const bf16_t* A; const float* W0; const float* W1; int G, c, lda, ldb, gather, narrow;
    __device__ __forceinline__ bool next(int i, g2::Unit& u) const {
        int L = i * G + c; u.li = i;
        if (L < ust[32]) {
            int e = 0; while (ust[e + 1] <= L) ++e;
            const int w = L - ust[e], c_ = cnts[e], nmt = (c_ + 255) >> 8, nf = nmt - ((c_ - 256 * (nmt - 1) <= 128) ? 1 : 0);
            u.e = e; u.pn = w / nf; u.pm = w - u.pn * nf; u.half = 0; return true; }
        L -= ust[32];
        const int Lh = narrow ? (L >> 1) : L; if (Lh >= usth[32]) return false;
        int e = 0; while (usth[e + 1] <= Lh) ++e;
        u.e = e; u.pn = Lh - usth[e]; u.pm = ((cnts[e] + 255) >> 8) - 1; u.half = narrow ? 2 + (L & 1) : 1; return true;
    }
    __device__ __forceinline__ int nvalid(const g2::Unit& u) const { const int v = cnts[u.e] - u.pm * 256; return v < 256 ? v : 256; }
    __device__ __forceinline__ unsigned a_off(const g2::Unit& u, int r) const {
        if (gather) { const int tk = rowtok[u.li * 256 + r]; return (unsigned)(tk < 0 ? 0 : tk) * (unsigned)lda * 2u; }
        return (unsigned)(pst[u.e] + u.pm * 256 + r) * (unsigned)lda * 2u;
    }
    __device__ __forceinline__ const float* b_col(const g2::Unit& u, int col) const {
        if (gather) { const int wcp = col >> 5, n = (col >> 4) & 1, i = col & 15; return (n ? W1 : W0) + (size_t)u.e * DM * FF + u.pn * 64 + 16 * wcp + i; }
        return W0 + (size_t)u.e * FF * DM + u.pn * 128 + col;
    }
};
struct EpiMoe1 {
    const int* pst; const int* rowtok; const float* rstd2; bf16_t* act;
    __device__ __forceinline__ void operator()(const pg8::f32x4 (&acc)[2][4][2], const g2::Unit& un, int wr, int wc, int fr, int fq) const {
        if (un.half >= 2 && (wc >> 1) != (un.half & 1)) return;
#pragma unroll
        for (int ai = 0; ai < 2; ++ai)
#pragma unroll
            for (int m = 0; m < 4; ++m) {
                const int r = ai * 128 + wr * 64 + m * 16 + fr; const int tk = rowtok[un.li * 256 + r];
                if (tk >= 0) {
                    const float rs = rstd2[tk];
                    const pg8::f32x4 vg = acc[ai][m][0] * rs, vu = acc[ai][m][1] * rs; float o[4];
#pragma unroll
                    for (int j = 0; j < 4; ++j) o[j] = vg[j] / (1.f + __expf(-vg[j])) * vu[j];
                    uint2 w; w.x = pg8::cvt_pk_bf16(o[0], o[1]); w.y = pg8::cvt_pk_bf16(o[2], o[3]);
                    *(uint2*)(act + (size_t)(pst[un.e] + un.pm * 256 + r) * FF + un.pn * 64 + wc * 16 + 4 * fq) = w;
                }
            }
    }
};
struct EpiMoe2 {
    const int* cnts; const int* pst; const float* gatel; bf16_t* y;
    __device__ __forceinline__ void operator()(const pg8::f32x4 (&acc)[2][4][2], const g2::Unit& un, int wr, int wc, int fr, int fq) const {
#pragma unroll
        for (int ai = 0; ai < 2; ++ai)
#pragma unroll
            for (int m = 0; m < 4; ++m) {
                const int slot = un.pm * 256 + ai * 128 + wr * 64 + m * 16 + fr;
                if (slot < cnts[un.e]) {
                    const float gt = gatel[un.e * 8192 + slot];
                    bf16_t* dst = y + (size_t)(pst[un.e] + slot) * DM + un.pn * 128 + wc * 32 + 4 * fq;
#pragma unroll
                    for (int n = 0; n < 2; ++n) { const pg8::f32x4 v = acc[ai][m][n] * gt; uint2 w; w.x = pg8::cvt_pk_bf16(v[0], v[1]); w.y = pg8::cvt_pk_bf16(v[2], v[3]); *(uint2*)(dst + n * 16) = w; }
                }
            }
    }
};

__device__ __forceinline__ void p9_moe1(const Frame& F, unsigned char* lds_raw, LAS unsigned char* stage) {
    const MoeTabs T = moe_tabs(lds_raw);
    moe_units<8>(F, T);
    const int vc = (F.G % 8 == 0) ? (F.bid % 8) * (F.G / 8) + F.bid / 8 : F.bid;
    MoeOrder2<8> S{T.cnts, T.pst, T.ust, T.usth, T.rowtok, (const bf16_t*)(F.ws + WS_X1B), F.in[I_WGATE], F.in[I_WUP], F.G, vc, DM, FF, 1, 1};
    { const int* tokl = (const int*)(F.ws + WS_TOKL); g2::Unit u;
      for (int i = 0; i < 4 && S.next(i, u); ++i) { if (F.tid < 256) { const int slot = u.pm * 256 + F.tid; T.rowtok[i * 256 + F.tid] = slot < T.cnts[u.e] ? tokl[u.e * 8192 + slot] : -1; } } }
    asm volatile("s_waitcnt vmcnt(0) lgkmcnt(0)" ::: "memory");
    __syncthreads();
    EpiMoe1 E{T.pst, T.rowtok, (const float*)(F.ws + WS_RSTD2), (bf16_t*)(F.ws + WS_ACT)};
    g2::gemm<DM / 64, EpiMoe1, MoeOrder2<8>>(stage, S, E, F.wave, (PROBE_REPEAT >= 30 && PROBE_REPEAT <= 33) ? (unsigned long long*)(lds_raw + 512) : nullptr);
}

__device__ __forceinline__ void p10_moe2(const Frame& F, unsigned char* lds_raw, LAS unsigned char* stage) {
    const MoeTabs T = moe_tabs(lds_raw);
    moe_units<16>(F, T);
    const int vc = (F.G % 8 == 0) ? (F.bid % 8) * (F.G / 8) + F.bid / 8 : F.bid;
    MoeOrder2<16> S{T.cnts, T.pst, T.ust, T.usth, nullptr, (const bf16_t*)(F.ws + WS_ACT), F.in[I_WDOWN], nullptr, F.G, vc, FF, DM, 0, 0};
    EpiMoe2 E{T.cnts, T.pst, (const float*)(F.ws + WS_GATEL), (bf16_t*)(F.ws + WS_Y)};
    g2::gemm<FF / 64, EpiMoe2, MoeOrder2<16>>(stage, S, E, F.wave);
}

__device__ __forceinline__ void p11_final(const Frame& F, int dummy) {
    int* cnts = (int*)(F.lds + 3072); int* pst = cnts + 32;
    moe_counts(F, cnts, pst);
    const bf16_t* y = (const bf16_t*)(F.ws + WS_Y); const int* arow = (const int*)(F.ws + WS_AROW); const float* lnf = F.in[I_LNFINAL];
    const int gw = F.bid * NWAVES + F.wave, nw = F.G * NWAVES, lane = fresh_lane();
    const bf16_t* x1b = (const bf16_t*)(F.ws + WS_X1B); const float* lnm = F.in[I_LNMOE];
    float4 ig[8];
#pragma unroll
    for (int i = 0; i < 8; ++i) { const float4 g = *(const float4*)(lnm + i * 256 + lane * 4); ig[i].x = 1.f / g.x; ig[i].y = 1.f / g.y; ig[i].z = 1.f / g.z; ig[i].w = 1.f / g.w; }
    for (int r = gw; r < NT; r += nw) {
        const int a0 = arow[2 * r], a1 = arow[2 * r + 1];
        const size_t r0 = (size_t)(pst[a0 >> 13] + (a0 & 8191)), r1 = (size_t)(pst[a1 >> 13] + (a1 & 8191));
        float v[32]; float ss = 0.f;
#pragma unroll
        for (int i = 0; i < 8; ++i) { const int c = i * 256 + lane * 4; const uint2 xq = *(const uint2*)(x1b + (size_t)r * DM + c);
            float4 xv; xv.x = __uint_as_float(xq.x << 16) * ig[i].x; xv.y = __uint_as_float(xq.x & 0xFFFF0000u) * ig[i].y; xv.z = __uint_as_float(xq.y << 16) * ig[i].z; xv.w = __uint_as_float(xq.y & 0xFFFF0000u) * ig[i].w;
            const uint2 ya = *(const uint2*)(y + r0 * DM + c), yb = *(const uint2*)(y + r1 * DM + c);
            v[4 * i]     = xv.x + __uint_as_float(ya.x << 16) + __uint_as_float(yb.x << 16);
            v[4 * i + 1] = xv.y + __uint_as_float(ya.x & 0xFFFF0000u) + __uint_as_float(yb.x & 0xFFFF0000u);
            v[4 * i + 2] = xv.z + __uint_as_float(ya.y << 16) + __uint_as_float(yb.y << 16);
            v[4 * i + 3] = xv.w + __uint_as_float(ya.y & 0xFFFF0000u) + __uint_as_float(yb.y & 0xFFFF0000u);
            ss += v[4 * i] * v[4 * i] + v[4 * i + 1] * v[4 * i + 1] + v[4 * i + 2] * v[4 * i + 2] + v[4 * i + 3] * v[4 * i + 3]; }
        ss = wave_sum(ss);
        const float rs = rsqrtf(ss * (1.f / DM) + EPS);
#pragma unroll
        for (int i = 0; i < 8; ++i) { const int c = i * 256 + lane * 4; const float4 g = *(const float4*)(lnf + c);
            float4 o; o.x = v[4 * i] * rs * g.x; o.y = v[4 * i + 1] * rs * g.y; o.z = v[4 * i + 2] * rs * g.z; o.w = v[4 * i + 3] * rs * g.w;
            *(float4*)((dummy ? (float*)(F.ws + WS_W1T) : F.out) + (size_t)r * DM + c) = o; }
    }
}

constexpr int NPHASE = 11;
__global__ void __launch_bounds__(NTHREADS, 2) fwd(Args args) {
    extern __shared__ __attribute__((aligned(16))) unsigned char lds_raw[];
    Frame F;
#pragma unroll
    for (int i = 0; i < N_IN; ++i) F.in[i] = args.in[i];
    F.out = args.out; F.ws = args.ws;
    F.lds = (float*)(lds_raw + 16);
    F.tid = threadIdx.x; F.lane = F.tid & 63; F.wave = __builtin_amdgcn_readfirstlane(F.tid >> 6); F.G = gridDim.x; F.bid = blockIdx.x;
    if (F.tid < 4) ((LAS unsigned*)lds_raw)[F.tid] = 0u;
    __syncthreads();
    XcdBarrier bar; bar.bar = (unsigned*)(F.ws + WS_CTL); bar.x = 0; bar.st = nullptr;
    if (N_LAUNCHES == 1) bar = xcd_barrier_post((unsigned*)(F.ws + WS_CTL), (volatile LAS unsigned*)lds_raw);
    bar.wave = F.wave;
    const int lo = args.ph_lo, hi = args.ph_hi;
#ifndef ONLY_PHASE
#define ONLY_PHASE -1
#endif
#define IN(k) (lo <= (k) && (k) < hi && (ONLY_PHASE < 0 || ONLY_PHASE == (k)))
#define SEAM(k) do { if (IN(k) && IN((k) + 1)) { const unsigned long long tb_ = (PROBE_REPEAT >= 40) ? (unsigned long long)__builtin_readcyclecounter() : 0ull; xcd_barrier(bar); if (PROBE_REPEAT == 12) xcd_barrier(bar); \
        if (PROBE_REPEAT == 40 || PROBE_REPEAT == 41 + (k)) tbar += (unsigned long long)__builtin_readcyclecounter() - tb_; if (PROBE_REPEAT == 60 + (k)) tbar = (unsigned long long)__builtin_readcyclecounter() - t_k0; } } while (0)
    unsigned long long tbar = 0ull; const unsigned long long t_k0 = (PROBE_REPEAT >= 60) ? (unsigned long long)__builtin_readcyclecounter() : 0ull;
    LAS unsigned char* stage = (LAS unsigned char*)lds_raw + 1024;
#define RUN(k, ...) do { if (IN(k)) { __VA_ARGS__; if (PROBE_REPEAT == (k)) { xcd_barrier(bar); __VA_ARGS__; } } } while (0)
    RUN(0, p0_prologue(F));
    if (PROBE_REPEAT == 11 && IN(0)) { xcd_barrier(bar); cvt_stream(F, 0, 6400, nullptr); }
    SEAM(0);
    RUN(1, p1_proj(F, stage));
    SEAM(1);
    RUN(2, p2a_mid(F, stage));
    SEAM(2);
    RUN(3, p2b_mid(F, stage));
    SEAM(3);
    if (IN(4)) {
#pragma unroll 1
        for (int rep = 0; rep < (PROBE_REPEAT == 4 ? 2 : 1); ++rep) { if (rep) xcd_barrier(bar); p_attn(F, lds_raw, rep); } }
    SEAM(4);
    RUN(5, p6_mix(F));
    SEAM(5);
    RUN(6, p7_out(F, stage));
    SEAM(6);
    if (IN(7)) { if (PROBE_REPEAT == 7) { p8_router(F, 1); xcd_barrier(bar); } p8_router(F, 0); }
    SEAM(7);
#define REFRESH_LANE() do { F.lane = fresh_lane(); F.tid = F.wave * 64 + F.lane; } while (0)
    REFRESH_LANE();
    if (IN(8)) {
#pragma unroll 1
        for (int rep = 0; rep < (PROBE_REPEAT == 8 ? 2 : 1); ++rep) { if (rep) xcd_barrier(bar); p9_moe1(F, lds_raw, stage); } }
    SEAM(8);
    REFRESH_LANE();
    if (IN(9)) {
#pragma unroll 1
        for (int rep = 0; rep < (PROBE_REPEAT == 9 ? 2 : 1); ++rep) { if (rep) xcd_barrier(bar); p10_moe2(F, lds_raw, stage); } }
    SEAM(9);
    REFRESH_LANE();
    if (IN(10)) { if (PROBE_REPEAT == 10) { p11_final(F, 1); xcd_barrier(bar); } const unsigned long long tf0 = (PROBE_REPEAT == 70) ? (unsigned long long)__builtin_readcyclecounter() : 0ull; p11_final(F, 0); if (PROBE_REPEAT == 70) tbar = (unsigned long long)__builtin_readcyclecounter() - tf0; }
#undef RUN
    if (PROBE_REPEAT >= 40 && blockIdx.x == PROBE_WG && threadIdx.x == 0) *(volatile unsigned long long*)(lds_raw + 512) = tbar;
    if (((PROBE_REPEAT >= 30 && PROBE_REPEAT <= 33) || PROBE_REPEAT >= 40) && blockIdx.x == PROBE_WG && threadIdx.x == 0) {
        const unsigned long long want = 4ull * *(volatile unsigned long long*)(lds_raw + 512), t0 = __builtin_readcyclecounter();
        while ((unsigned long long)__builtin_readcyclecounter() - t0 < want) __builtin_amdgcn_s_sleep(8);
    }
#undef IN
#undef SEAM
}

extern "C" void kernel_launch(void* const* d_in, const int* in_sizes, int n_in, void* d_out, int out_size, void* d_ws, size_t ws_size, hipStream_t stream) {
    static int grid = 0;
    if (grid == 0) {
        if (n_in != N_IN || out_size != NT * DM || ws_size < WS_END) { fprintf(stderr, "kernel_launch: unexpected shapes: n_in %d out %d ws %zu (need %zu)\n", n_in, out_size, ws_size, (size_t)WS_END); grid = -1; return; }
        int dev = 0, cus = 0, per_cu = 0;
        if (hipGetDevice(&dev) != hipSuccess || hipDeviceGetAttribute(&cus, hipDeviceAttributeMultiprocessorCount, dev) != hipSuccess) { grid = -1; return; }
        if (hipFuncSetAttribute((const void*)fwd, hipFuncAttributeMaxDynamicSharedMemorySize, LDS_BYTES) != hipSuccess) { fprintf(stderr, "kernel_launch: hipFuncSetAttribute failed\n"); grid = -1; return; }
        if (hipOccupancyMaxActiveBlocksPerMultiprocessor(&per_cu, (const void*)fwd, NTHREADS, LDS_BYTES) != hipSuccess || per_cu < 1) { fprintf(stderr, "kernel_launch: occupancy query says %d\n", per_cu); }
        (void)hipGetLastError();
        grid = cus;
    }
    if (grid < 0) return;
    (void)in_sizes;
    (void)hipMemsetAsync((char*)d_ws + WS_CTL, 0, CTL_ZERO_BYTES, stream);
    Args a{};
    for (int i = 0; i < N_IN; ++i) a.in[i] = (const float*)d_in[i];
    a.out = (float*)d_out; a.ws = (unsigned char*)d_ws;
    if (N_LAUNCHES == 1) { a.ph_lo = 0; a.ph_hi = NPHASE; hipLaunchKernelGGL(fwd, dim3(grid), dim3(NTHREADS), LDS_BYTES, stream, a); }
    else { for (int p = 0; p < NPHASE; ++p) { a.ph_lo = p; a.ph_hi = p + 1; hipLaunchKernelGGL(fwd, dim3(grid), dim3(NTHREADS), LDS_BYTES, stream, a); } }
}
```

```cpp
#include <hip/hip_runtime.h>
#include <cstdio>
#include <cstdint>

#ifndef PROBE_REPEAT
#define PROBE_REPEAT -1
#endif
#ifndef MERGE_CMP2
#define MERGE_CMP2 0
#endif
#ifndef PROBE_WG
#define PROBE_WG 0
#endif
#ifndef N_LAUNCHES
#define N_LAUNCHES 1
#endif

#define XB_TMO      128
#define XB_XCNT(j)  (256  + 64 * (j))
#define XB_XSUB(j)  (1280 + 64 * (j))
#define XB_XGEN(j)  (2304 + 64 * (j))
#define XB_TOP      3328
#define XB_TOPGEN   3392
#define XCD_BAR_WORDS 3456
#define XB_SPIN_CAP (1u << 21)
#define LAS __attribute__((address_space(3)))

__device__ __forceinline__ unsigned xb_ld(unsigned* p)              { return __hip_atomic_load(p, __ATOMIC_RELAXED, __HIP_MEMORY_SCOPE_AGENT); }
__device__ __forceinline__ unsigned xb_add(unsigned* p, unsigned v) { return __hip_atomic_fetch_add(p, v, __ATOMIC_RELAXED, __HIP_MEMORY_SCOPE_AGENT); }
__device__ __forceinline__ unsigned xb_xcc_id() { return (unsigned)__builtin_amdgcn_s_getreg((3 << 11) | 20) & 0xFu; }
#define XB_SPIN(cond, bar) do { unsigned _sp = 0; while (cond) { __builtin_amdgcn_s_sleep(1); \
    if ((++_sp & 255u) == 0u) { if (xb_ld(&(bar)[XB_TMO])) break; if (_sp > XB_SPIN_CAP) { atomicAdd(&(bar)[XB_TMO], 1u); break; } } } } while (0)

struct XcdBarrier { unsigned* bar; unsigned x; volatile LAS unsigned* st; int wave; };

__device__ __forceinline__ XcdBarrier xcd_barrier_post(unsigned* bar, volatile LAS unsigned* st) {
    XcdBarrier b; b.bar = bar; b.x = xb_xcc_id(); b.st = st;
    if (threadIdx.x == 0) (void)xb_add(&bar[XB_XCNT(b.x)], 1u);
    return b;
}
__device__ __forceinline__ void xcd_barrier_complete(unsigned* bar, unsigned x, unsigned& nloc, unsigned& nx) {
    const unsigned G = gridDim.x * gridDim.y * gridDim.z;
    unsigned sum, cnt, mine, sp = 0u;
    for (;;) {
        sum = 0u; cnt = 0u; mine = 0u;
#pragma unroll
        for (unsigned j = 0; j < 16; ++j) { const unsigned c = xb_ld(&bar[XB_XCNT(j)]); sum += c; cnt += (c > 0u) ? 1u : 0u; mine = (j == x) ? c : mine; }
        if (sum == G) break;
        __builtin_amdgcn_s_sleep(1);
        if ((++sp & 255u) == 0u) { if (xb_ld(&bar[XB_TMO])) break; if (sp > XB_SPIN_CAP) { atomicAdd(&bar[XB_TMO], 1u); break; } }
    }
    nloc = mine > 0u ? mine : 1u; nx = cnt > 0u ? cnt : 1u;
}
__device__ __forceinline__ int fresh_lane();
__device__ __forceinline__ void xcd_barrier(const XcdBarrier& b) {
    asm volatile("s_waitcnt vmcnt(0)" ::: "memory");
    __syncthreads();
    if (b.wave == 0 && fresh_lane() == 0) {
        unsigned* bar = b.bar;
        __builtin_amdgcn_s_waitcnt(0);
        unsigned nloc = b.st[0], nx = b.st[1];
        if (nloc == 0u) { xcd_barrier_complete(bar, b.x, nloc, nx); b.st[0] = nloc; b.st[1] = nx; }
        const unsigned old = xb_add(&bar[XB_XSUB(b.x)], 1u);
        const unsigned gen = old / nloc;
        if (old + 1u == (gen + 1u) * nloc) {
            __builtin_amdgcn_fence(__ATOMIC_RELEASE, "agent");
            asm volatile("s_waitcnt vmcnt(0)" ::: "memory");
            const unsigned og = xb_add(&bar[XB_TOP], 1u);
            const unsigned tg = og / nx;
            if (og + 1u == (tg + 1u) * nx) xb_add(&bar[XB_TOPGEN], 1u);
            else XB_SPIN(xb_ld(&bar[XB_TOPGEN]) == tg, bar);
            __builtin_amdgcn_fence(__ATOMIC_ACQUIRE, "agent");
            xb_add(&bar[XB_XGEN(b.x)], 1u);
            asm volatile("s_waitcnt vmcnt(0)" ::: "memory");
        } else {
            XB_SPIN(xb_ld(&bar[XB_XGEN(b.x)]) == gen, bar);
            __builtin_amdgcn_fence(__ATOMIC_ACQUIRE, "agent");
            asm volatile("s_waitcnt vmcnt(0)" ::: "memory");
        }
    }
    __syncthreads();
}

typedef unsigned short bf16_t;
constexpr int NB = 4, SEQ = 2048, DM = 2048, NT = NB * SEQ;
constexpr int NH = 8, NG = 2, HD = 128, INW = 3608, INWP = 3840;
constexpr int NCMP = 127, NSEL = 32, NEXP = 32, FF = 512;
constexpr float EPS = 1e-6f;
constexpr float SCALE = 0.08838834764831845f;
constexpr int NTHREADS = 512, NWAVES = 8;
constexpr int LDS_BYTES = 147456;
constexpr int YROWS = 24576;

enum { I_X = 0, I_POS, I_LNMIX, I_WIN, I_PEK, I_WK1, I_WK2, I_PEV, I_WV1, I_WV2, I_WPOOL, I_BPOOL, I_PSCALE, I_GNNSA, I_GNPOOL, I_WOUT, I_LNMOE,
       I_WRG, I_BRG, I_WRE, I_BRE, I_WGATE, I_WUP, I_WDOWN, I_LNFINAL, N_IN };

constexpr size_t MB = 1024 * 1024;
constexpr size_t WS_CTL   = 0;
constexpr size_t CTL_ZERO_BYTES = 65536;
constexpr int    CW_CNT   = 4096;
constexpr size_t WS_RSTD1 = 1 * MB;
constexpr size_t WS_RSTD2 = 1 * MB + 65536;
constexpr size_t WS_BIAS1 = 1 * MB + 131072;
constexpr size_t WS_AROW  = 1 * MB + 262144;
constexpr size_t WS_WR    = 1 * MB + 393216;
constexpr size_t WS_WG4   = 1 * MB + 655360;
constexpr size_t WS_WRP   = 32 * MB;
constexpr size_t WS_PL    = 40 * MB;
constexpr size_t WS_ROPEC = 2 * MB;
constexpr size_t WS_ROPES = 2 * MB + 524288;
constexpr size_t WS_GATES = 3 * MB;
constexpr size_t WS_TOKL  = 4 * MB;
constexpr size_t WS_GATEL = 5 * MB;
constexpr size_t WS_HID   = 6 * MB;
constexpr size_t WS_CMPKV = 8 * MB;
constexpr size_t WS_WINT  = 9 * MB;
constexpr size_t WS_WOUTT = 24 * MB;
constexpr size_t WS_W1T   = 32 * MB;
constexpr size_t WS_W2T   = 160 * MB;
constexpr size_t WS_CMPW  = 224 * MB;
constexpr size_t WS_POOLW = 228 * MB;
constexpr size_t WS_POOLB = 228 * MB + 524288;
constexpr size_t WS_CPART = 447 * MB;
constexpr size_t WS_DBUF  = 463 * MB;
constexpr size_t WS_XB    = 230 * MB;
constexpr size_t WS_QN    = 262 * MB;
constexpr size_t WS_QR    = 278 * MB;
constexpr size_t WS_KV    = 294 * MB;
constexpr size_t WS_U     = 319 * MB;
constexpr size_t WS_Y     = 230 * MB;
constexpr size_t WS_OWIN  = 351 * MB;
constexpr size_t WS_OCMP  = 367 * MB;
constexpr size_t WS_OSEL  = 319 * MB;
constexpr size_t WS_ML    = 6 * MB;
constexpr size_t WS_X1B   = 351 * MB;
constexpr size_t WS_OPOOL = 383 * MB;
constexpr size_t WS_ACT   = 383 * MB;
constexpr size_t WS_MIX   = 415 * MB;
constexpr size_t WS_END   = 479 * MB;

__device__ __forceinline__ bf16_t f2bf(float f) { unsigned u = __float_as_uint(f); u += 0x7FFFu + ((u >> 16) & 1u); return (bf16_t)(u >> 16); }
__device__ __forceinline__ float bf2f(bf16_t b) { return __uint_as_float(((unsigned)b) << 16); }
__device__ __forceinline__ float wave_sum(float v) {
#pragma unroll
    for (int o = 32; o >= 1; o >>= 1) v += __shfl_xor(v, o);
    return v;
}
__device__ __forceinline__ float wave_max(float v) {
#pragma unroll
    for (int o = 32; o >= 1; o >>= 1) v = fmaxf(v, __shfl_xor(v, o));
    return v;
}

__device__ __forceinline__ int fresh_lane() { int l; asm volatile("v_mbcnt_lo_u32_b32 %0, -1, 0\n\tv_mbcnt_hi_u32_b32 %0, -1, %0" : "=v"(l)); return l; }
struct Args { const float* in[N_IN]; float* out; unsigned char* ws; int ph_lo, ph_hi; };

struct Frame {
    const float* in[N_IN]; float* out; unsigned char* ws;
    float* lds;
    int tid, lane, wave, G, bid;
};

__device__ __forceinline__ float gelu_tanh(float x) { const float u = 0.7978845608028654f * (x + 0.044715f * x * x * x); return 0.5f * x * (1.f + tanhf(u)); }


namespace pg8 {
typedef short bf16x8 __attribute__((ext_vector_type(8)));
typedef float f32x4 __attribute__((ext_vector_type(4)));
typedef unsigned u32x4 __attribute__((ext_vector_type(4)));
constexpr int BM = 256, BK = 64, HALF = 128, HTB = HALF * BK * 2, STAGE_BYTES = 8 * HTB, NXCD = 8, WGM = 8;
__device__ __forceinline__ int lds_byte(int r, int c) { const int st = (r >> 4) * 2 + (c >> 5), rr = r & 15, cc = c & 31, ob = rr * 64 + cc * 2; return st * 1024 + (ob ^ (((ob >> 9) & 1) << 5)); }
__device__ __forceinline__ void stage_rc(int b, int& R, int& C) { const int st = b / 1024, sb = b % 1024, swz = sb ^ (((sb >> 9) & 1) << 5); R = (st >> 1) * 16 + swz / 64; C = (st & 1) * 32 + (swz % 64) / 2; }
struct Unit { int pm, pn, e, li; };
__device__ __forceinline__ unsigned cvt_pk_bf16(float lo, float hi) { unsigned r; asm volatile("v_cvt_pk_bf16_f32 %0, %1, %2" : "=v"(r) : "v"(lo), "v"(hi)); return r; }

struct DenseOrder {
    const char* A; const char* Bt; int lda, ldb; int nM, nN, nwg, G, c;
    __device__ void init(const void* A_, const void* Bt_, int lda_, int ldb_, int M, int N, int G_, int c_) { A = (const char*)A_; Bt = (const char*)Bt_; lda = lda_; ldb = ldb_; nM = M / BM; nN = N / BM; nwg = nM * nN; G = G_; c = c_; }
    __device__ __forceinline__ bool next(int i, Unit& u) const {
        const long L = (long)i * G + c; if (L >= nwg) return false;
        int wgid = (int)L; { const int q = nwg / NXCD, r = nwg % NXCD, xcd = wgid % NXCD, off = wgid / NXCD; wgid = (xcd < r ? xcd * (q + 1) : r * (q + 1) + (xcd - r) * q) + off; }
        const int nig = WGM * nN, gid = wgid / nig, fm = gid * WGM, gsz = (nM - fm) < WGM ? (nM - fm) : WGM;
        u.pm = fm + ((wgid % nig) % gsz); u.pn = (wgid % nig) / gsz; u.e = 0; u.li = i; return true;
    }
    __device__ __forceinline__ const char* a_base(const Unit& u) const { return A + (size_t)u.pm * BM * lda * 2; }
    __device__ __forceinline__ const char* b_base(const Unit& u) const { return Bt + (size_t)u.pn * BM * ldb * 2; }
    __device__ __forceinline__ unsigned a_row_off(const Unit&, int r) const { return (unsigned)r * (unsigned)lda * 2u; }
};

template <class Epi, class Sched, bool GATHER>
__device__ __forceinline__ void gemm_phase(LAS unsigned char* lds, const int K, const int lda, const int ldb, const Sched& S, const Epi& E) {
    const int tid = threadIdx.x, wid = __builtin_amdgcn_readfirstlane(tid >> 6), lane = tid & 63, wr = wid >> 2, wc = wid & 3, fr = lane & 15, fq = lane >> 4;
    const int nt = K / BK;
    int sR[2], sC[2];
#pragma unroll
    for (int i = 0; i < 2; ++i) stage_rc(tid * 16 + i * 8192, sR[i], sC[i]);
    unsigned voffB[2], voffA[2][2], nvoffA[2][2];
#pragma unroll
    for (int i = 0; i < 2; ++i) voffB[i] = (unsigned)(sR[i] * ldb + sC[i]) * 2u;
    const size_t kstep = (size_t)(BK * 2);
    const size_t hstepB = (size_t)HALF * ldb * 2;
    const unsigned ldsw = (unsigned)wid * 1024u;
    const int aoff = lds_byte(wr * 64 + fr, fq * 8), boff = lds_byte(wc * 32 + fr, fq * 8);
#define PG8_SA(b, h) (((b) * 2 + (h)) * HTB)
#define PG8_SB(b, h) ((4 + (b) * 2 + (h)) * HTB)
#define PG8_STAGE(bufoff, gbase, voff) do { _Pragma("unroll") for (int _i = 0; _i < 2; ++_i) \
        __builtin_amdgcn_global_load_lds((const unsigned*)((const char*)(gbase) + (voff)[_i]), (LAS unsigned*)(lds + (bufoff) + ldsw + _i * 8192), 16, 0, 0); } while (0)
#define PG8_LDA(dst, b, h) do { _Pragma("unroll") for (int m = 0; m < 4; ++m) _Pragma("unroll") for (int k = 0; k < 2; ++k) dst[m][k] = *(const LAS bf16x8*)(lds + PG8_SA(b, h) + aoff + m * 2048 + k * 1024); } while (0)
#define PG8_LDB(dst, b, h) do { _Pragma("unroll") for (int n = 0; n < 2; ++n) _Pragma("unroll") for (int k = 0; k < 2; ++k) dst[n][k] = *(const LAS bf16x8*)(lds + PG8_SB(b, h) + boff + n * 2048 + k * 1024); } while (0)
#define PG8_MMA(ai, bj, At, Bt) do { __builtin_amdgcn_s_setprio(1); _Pragma("unroll") for (int m = 0; m < 4; ++m) _Pragma("unroll") for (int n = 0; n < 2; ++n) _Pragma("unroll") for (int k = 0; k < 2; ++k) \
        { acc[ai][bj][m][n] = __builtin_amdgcn_mfma_f32_16x16x32_bf16(Bt[n][k], At[m][k], acc[ai][bj][m][n], 0, 0, 0); if (PROBE_REPEAT == 21) dummy = __builtin_amdgcn_mfma_f32_16x16x32_bf16(Bt[n][k], At[m][k], dummy, 0, 0, 0); } __builtin_amdgcn_s_setprio(0); } while (0)
#define PG8_WAIT_V(n) asm volatile("s_waitcnt vmcnt(" #n ")" ::: "memory")
#define PG8_WAIT_L(n) asm volatile("s_waitcnt lgkmcnt(" #n ")" ::: "memory")
#define PG8_BAR __builtin_amdgcn_s_barrier()
#define PG8_SCHED __builtin_amdgcn_sched_barrier(0)
#define PG8_AOFFS(dst, u) do { _Pragma("unroll") for (int _h = 0; _h < 2; ++_h) _Pragma("unroll") for (int _i = 0; _i < 2; ++_i) dst[_h][_i] = S.a_row_off(u, _h * HALF + sR[_i]) + (unsigned)sC[_i] * 2u; } while (0)
    Unit cur, nxt; int ui = 0;
    if (!S.next(0, cur)) return;
    f32x4 acc[2][2][4][2];
#pragma unroll
    for (int a = 0; a < 2; ++a)
#pragma unroll
        for (int b = 0; b < 2; ++b)
#pragma unroll
            for (int m = 0; m < 4; ++m)
#pragma unroll
                for (int n = 0; n < 2; ++n) acc[a][b][m][n] = (f32x4){0.f, 0.f, 0.f, 0.f};
    bf16x8 At[4][2], B0[2][2], B1[2][2]; f32x4 dummy = {0.f, 0.f, 0.f, 0.f};
    const char* cA = S.a_base(cur); const char* cB = S.b_base(cur);
    PG8_AOFFS(voffA, cur);
    PG8_STAGE(PG8_SB(0, 0), cB, voffB); PG8_STAGE(PG8_SA(0, 0), cA, voffA[0]); PG8_STAGE(PG8_SB(0, 1), cB + hstepB, voffB); PG8_STAGE(PG8_SA(0, 1), cA, voffA[1]);
    if (wr == 1) PG8_BAR;
    PG8_WAIT_V(4); PG8_BAR;
    PG8_STAGE(PG8_SB(1, 0), cB + kstep, voffB); PG8_STAGE(PG8_SA(1, 0), cA + kstep, voffA[0]); PG8_STAGE(PG8_SB(1, 1), cB + hstepB + kstep, voffB);
    PG8_WAIT_V(6); PG8_BAR;
    for (;;) {
        const bool has_next = S.next(ui + 1, nxt);
        const char* nA = has_next ? S.a_base(nxt) : cA; const char* nB = has_next ? S.b_base(nxt) : cB;
        if (GATHER) { if (has_next) { PG8_AOFFS(nvoffA, nxt); } else {
#pragma unroll
            for (int _h = 0; _h < 2; ++_h)
#pragma unroll
                for (int _i = 0; _i < 2; ++_i) nvoffA[_h][_i] = voffA[_h][_i]; } }
        for (int t = 0; t < nt; t += 2) {
            const bool last = (t == nt - 2);
            const char* a1 = cA + (size_t)(t + 1) * kstep;
            const char* a2 = last ? nA : cA + (size_t)(t + 2) * kstep; const char* b2 = last ? nB : cB + (size_t)(t + 2) * kstep;
            const char* a3 = a2 + kstep; const char* b3 = b2 + kstep;
            unsigned vA2[2][2];
#pragma unroll
            for (int _h = 0; _h < 2; ++_h)
#pragma unroll
                for (int _i = 0; _i < 2; ++_i) vA2[_h][_i] = (GATHER && last) ? nvoffA[_h][_i] : voffA[_h][_i];
            PG8_LDB(B0, 0, 0); PG8_SCHED; PG8_LDA(At, 0, 0); PG8_STAGE(PG8_SA(1, 1), a1, voffA[1]);
            PG8_WAIT_L(8); PG8_BAR; PG8_WAIT_L(0); PG8_MMA(0, 0, At, B0); PG8_BAR; PG8_SCHED;
            PG8_LDB(B1, 0, 1); PG8_STAGE(PG8_SB(0, 0), b2, voffB);
            PG8_BAR; PG8_WAIT_L(0); PG8_MMA(0, 1, At, B1); PG8_BAR;
            PG8_LDA(At, 0, 1); PG8_STAGE(PG8_SA(0, 0), a2, vA2[0]);
            PG8_BAR; PG8_WAIT_L(0); PG8_MMA(1, 0, At, B0); PG8_BAR; PG8_SCHED;
            PG8_STAGE(PG8_SB(0, 1), b2 + hstepB, voffB);
            PG8_WAIT_V(6); PG8_BAR; PG8_MMA(1, 1, At, B1); PG8_BAR;
            PG8_LDB(B0, 1, 0); PG8_SCHED; PG8_LDA(At, 1, 0); PG8_STAGE(PG8_SA(0, 1), a2, vA2[1]);
            PG8_WAIT_L(8); PG8_BAR; PG8_WAIT_L(0); PG8_MMA(0, 0, At, B0); PG8_BAR; PG8_SCHED;
            PG8_LDB(B1, 1, 1); PG8_STAGE(PG8_SB(1, 0), b3, voffB);
            PG8_BAR; PG8_WAIT_L(0); PG8_MMA(0, 1, At, B1); PG8_BAR;
            PG8_LDA(At, 1, 1); PG8_STAGE(PG8_SA(1, 0), a3, vA2[0]);
            PG8_BAR; PG8_WAIT_L(0); PG8_MMA(1, 0, At, B0); PG8_BAR; PG8_SCHED;
            PG8_STAGE(PG8_SB(1, 1), b3 + hstepB, voffB);
            PG8_WAIT_V(6); PG8_BAR; PG8_MMA(1, 1, At, B1); PG8_BAR;
        }
        if constexpr (!Epi::AFTER_DRAIN) E(acc, cur, wr, wc, fr, fq);
        if (!has_next) break;
#pragma unroll
        for (int a = 0; a < 2; ++a)
#pragma unroll
            for (int b = 0; b < 2; ++b)
#pragma unroll
                for (int m = 0; m < 4; ++m)
#pragma unroll
                    for (int n = 0; n < 2; ++n) acc[a][b][m][n] = (f32x4){0.f, 0.f, 0.f, 0.f};
        cur = nxt; cA = nA; cB = nB; ++ui;
        if (GATHER) {
#pragma unroll
            for (int _h = 0; _h < 2; ++_h)
#pragma unroll
                for (int _i = 0; _i < 2; ++_i) voffA[_h][_i] = nvoffA[_h][_i]; }
    }
    if (PROBE_REPEAT == 21) asm volatile("" :: "v"(dummy));
    PG8_WAIT_V(0);
    if (wr == 0) PG8_BAR;
    PG8_BAR;
    if constexpr (Epi::AFTER_DRAIN) E.fused(acc, cur, wr, wc, fr, fq, lds);
#undef PG8_SA
#undef PG8_SB
#undef PG8_STAGE
#undef PG8_LDA
#undef PG8_LDB
#undef PG8_MMA
#undef PG8_WAIT_V
#undef PG8_WAIT_L
#undef PG8_BAR
#undef PG8_SCHED
#undef PG8_AOFFS
}
}


namespace g2 {
using pg8::bf16x8; using pg8::f32x4; using pg8::lds_byte; using pg8::cvt_pk_bf16;
typedef short s16x4 __attribute__((ext_vector_type(4)));
constexpr int A_BYTES = 32768, B_BYTES = 16384, STG = A_BYTES + B_BYTES;
struct Unit { int e, pm, pn, li, half; };
template <int NT_, class Epi, class Sched>
__device__ __forceinline__ void gemm(LAS unsigned char* lds, const Sched& S, const Epi& E, const int wave_, unsigned long long* tprobe = nullptr) {
#if defined(__HIP_DEVICE_COMPILE__)
    const int wid = wave_, lane = fresh_lane(), tid = wid * 64 + lane, wr = wid >> 2, wc = wid & 3, fr = lane & 15, fq = lane >> 4;
    constexpr int nt = NT_;
    unsigned long long tacc = 0ull;
#define TCK() ((PROBE_REPEAT >= 30 && PROBE_REPEAT <= 33) ? (unsigned long long)__builtin_readcyclecounter() : 0ull)
    const unsigned long long t_all0 = TCK();
    const int awoff0 = lds_byte((tid >> 3) & 127, (tid & 7) * 8);
    const int bkr = tid >> 5, bnq = tid & 31;
    const int bwoff0 = A_BYTES + bkr * 256 + ((((bnq >> 2)) ^ ((bkr & 3) | (((bkr >> 3) & 1) << 2))) * 32) + (bnq & 3) * 8;
#define awoff(j) (awoff0 + ((j) & 1) * 8192 + ((j) >> 1) * 16384)
#define bwoff(j) (bwoff0 + (j) * 4096)
    const int aoff = lds_byte(wr * 64 + fr, fq * 8);
    int boff[2];
    { const int q = (lane >> 2) & 3, p = lane & 3, f = q | ((fq & 1) << 2);
#pragma unroll
      for (int n = 0; n < 2; ++n) boff[n] = A_BYTES + (8 * fq + q) * 256 + (((2 * wc + n) ^ f) * 32) + 8 * p; }
    const int ldsb = (int)(uintptr_t)lds;
    Unit u, un;
    if (!S.next(0, u)) return;
    unsigned pa[4], pan[4]; const float* pb; const float* pbn;
    const size_t bstep = (size_t)16 * S.ldb;
#define G2_PTRS(PA, PB, U) do { _Pragma("unroll") for (int j = 0; j < 4; ++j) { const int id = tid + 512 * j; PA[j] = S.a_off(U, id >> 3) + (unsigned)(id & 7) * 16u; } PB = S.b_col(U, 4 * ((U).half >= 2 ? ((bnq & 15) | (((U).half & 1) << 4)) : bnq)) + (size_t)bkr * S.ldb; } while (0)
    G2_PTRS(pa, pb, u);
    f32x4 acc[2][4][2];
#pragma unroll
    for (int a = 0; a < 2; ++a)
#pragma unroll
        for (int m = 0; m < 4; ++m)
#pragma unroll
            for (int n = 0; n < 2; ++n) acc[a][m][n] = (f32x4){0.f, 0.f, 0.f, 0.f};
    f32x4 dummy = {0.f, 0.f, 0.f, 0.f};
    bf16x8 ra0[4], ra1[4]; f32x4 rb0[4], rb1[4];
#define G2_NVALID(U) (((U).half >= 2 && (wc >> 1) != ((U).half & 1)) ? 0 : S.nvalid(U))
    bool hf = u.half != 0; const bool hfn = false; (void)hfn; int nvalid = G2_NVALID(u);
#define G2_LOADA(RA, PA, HF, t) do { _Pragma("unroll") for (int j = 0; j < 4; ++j) if (j < 2 || !(HF)) RA[j] = *(const bf16x8*)((const char*)S.A + PA[j] + (unsigned)(t) * 128u); } while (0)
#define G2_LOADB(RB, PB, t) do { _Pragma("unroll") for (int j = 0; j < 4; ++j) RB[j] = *(const f32x4*)(PB + (size_t)(t) * 64 * S.ldb + j * bstep); } while (0)
#define G2_WRITE_A(st, RA, j) do { *(LAS bf16x8*)(lds + (st) * STG + awoff(j)) = RA[j]; } while (0)
#define G2_WRITE_B(st, RB, j) do { uint2 w_; w_.x = cvt_pk_bf16(RB[j][0], RB[j][1]); w_.y = cvt_pk_bf16(RB[j][2], RB[j][3]); *(LAS uint2*)(lds + (st) * STG + bwoff(j)) = w_; } while (0)
#define G2_TR(dst, n, imm) asm volatile("ds_read_b64_tr_b16 %0, %1 offset:%2" : "=&v"(dst) : "v"(ldsb + boff[n]), "i"(imm) : "memory")
#define G2_COMPUTE(st, DOW, WA, WB, HFC, HFW) do { const unsigned long long tc0_ = TCK(); \
        s16x4 b00l, b00h, b01l, b01h, b10l, b10h, b11l, b11h;        \
        G2_TR(b00l, 0, (st) * STG); G2_TR(b00h, 0, (st) * STG + 1024); G2_TR(b01l, 0, (st) * STG + 8192); G2_TR(b01h, 0, (st) * STG + 8192 + 1024); \
        G2_TR(b10l, 1, (st) * STG); G2_TR(b10h, 1, (st) * STG + 1024); G2_TR(b11l, 1, (st) * STG + 8192); G2_TR(b11h, 1, (st) * STG + 8192 + 1024); \
        bf16x8 At[4][2]; \
        _Pragma("unroll") for (int m = 0; m < 4; ++m) _Pragma("unroll") for (int k = 0; k < 2; ++k) At[m][k] = *(const LAS bf16x8*)(lds + (st) * STG + aoff + m * 2048 + k * 1024); \
        asm volatile("s_waitcnt lgkmcnt(0)" ::: "memory"); __builtin_amdgcn_sched_barrier(0); \
        if (PROBE_REPEAT == 31) tacc += TCK() - tc0_; \
        const bf16x8 B00 = {b00l[0], b00l[1], b00l[2], b00l[3], b00h[0], b00h[1], b00h[2], b00h[3]}, B01 = {b01l[0], b01l[1], b01l[2], b01l[3], b01h[0], b01h[1], b01h[2], b01h[3]}; \
        const bf16x8 B10 = {b10l[0], b10l[1], b10l[2], b10l[3], b10h[0], b10h[1], b10h[2], b10h[3]}, B11 = {b11l[0], b11l[1], b11l[2], b11l[3], b11h[0], b11h[1], b11h[2], b11h[3]}; \
        _Pragma("unroll") for (int a = 0; a < 2; ++a) { \
            _Pragma("unroll") for (int m = 0; m < 4; ++m) { \
                __builtin_amdgcn_s_setprio(1); \
                if (128 * a + 64 * wr + 16 * m < nvalid) {                 \
                acc[a][m][0] = __builtin_amdgcn_mfma_f32_16x16x32_bf16(B00, At[m][0], acc[a][m][0], 0, 0, 0); acc[a][m][0] = __builtin_amdgcn_mfma_f32_16x16x32_bf16(B01, At[m][1], acc[a][m][0], 0, 0, 0); \
                acc[a][m][1] = __builtin_amdgcn_mfma_f32_16x16x32_bf16(B10, At[m][0], acc[a][m][1], 0, 0, 0); acc[a][m][1] = __builtin_amdgcn_mfma_f32_16x16x32_bf16(B11, At[m][1], acc[a][m][1], 0, 0, 0); } \
                if (PROBE_REPEAT == 20) { dummy = __builtin_amdgcn_mfma_f32_16x16x32_bf16(B00, At[m][0], dummy, 0, 0, 0); dummy = __builtin_amdgcn_mfma_f32_16x16x32_bf16(B01, At[m][1], dummy, 0, 0, 0); dummy = __builtin_amdgcn_mfma_f32_16x16x32_bf16(B10, At[m][0], dummy, 0, 0, 0); dummy = __builtin_amdgcn_mfma_f32_16x16x32_bf16(B11, At[m][1], dummy, 0, 0, 0); } \
                __builtin_amdgcn_s_setprio(0); \
                if (DOW) { if (a == 0) { if (m < 2 || !(HFW)) G2_WRITE_A((st) ^ 1, WA, m); if (HFC) G2_WRITE_B((st) ^ 1, WB, m); } else G2_WRITE_B((st) ^ 1, WB, m); __builtin_amdgcn_sched_barrier(0); } } \
            if (HFC) break;                                               \
            if (a == 0) { __builtin_amdgcn_sched_barrier(0); \
                _Pragma("unroll") for (int m = 0; m < 4; ++m) _Pragma("unroll") for (int k = 0; k < 2; ++k) At[m][k] = *(const LAS bf16x8*)(lds + (st) * STG + 16384 + aoff + m * 2048 + k * 1024); \
                asm volatile("s_waitcnt lgkmcnt(0)" ::: "memory"); __builtin_amdgcn_sched_barrier(0); } } \
        if (PROBE_REPEAT == 32) tacc += TCK() - tc0_; } while (0)
    for (int ui = 0;; ++ui) {
        G2_LOADA(ra0, pa, hf, 0); G2_LOADB(rb0, pb, 0); G2_LOADA(ra1, pa, hf, 1); G2_LOADB(rb1, pb, 1);
        __syncthreads();
#pragma unroll
        for (int j = 0; j < 4; ++j) { if (j < 2 || !hf) G2_WRITE_A(0, ra0, j); G2_WRITE_B(0, rb0, j); }
        if (nt > 2) { G2_LOADA(ra0, pa, hf, 2); G2_LOADB(rb0, pb, 2); }
        __syncthreads();
#define G2_STEP(t) do { \
            G2_COMPUTE(0, true, ra1, rb1, hf, hf); \
            if ((t) + 3 < nt) { G2_LOADA(ra1, pa, hf, (t) + 3); G2_LOADB(rb1, pb, (t) + 3); } \
            __syncthreads(); \
            if ((t) + 2 < nt) { G2_COMPUTE(1, true, ra0, rb0, hf, hf); } else { G2_COMPUTE(1, false, ra0, rb0, hf, hf); } \
            if ((t) + 4 < nt) { G2_LOADA(ra0, pa, hf, (t) + 4); G2_LOADB(rb0, pb, (t) + 4); } \
            __syncthreads(); } while (0)
        G2_STEP(0); G2_STEP(2); G2_STEP(4); G2_STEP(6);
        if constexpr (NT_ > 8) { G2_STEP(8); G2_STEP(10); G2_STEP(12); G2_STEP(14); G2_STEP(16); G2_STEP(18); G2_STEP(20); G2_STEP(22); G2_STEP(24); G2_STEP(26); G2_STEP(28); G2_STEP(30); }
        static_assert(NT_ == 8 || NT_ == 32, "expand G2_STEP for this K");
#undef G2_STEP
        if (PROBE_REPEAT == 20) asm volatile("" :: "v"(dummy));
        E(acc, u, wr, wc, fr, fq);
        if (!S.next(ui + 1, un)) break;
#pragma unroll
        for (int a = 0; a < 2; ++a)
#pragma unroll
            for (int m = 0; m < 4; ++m)
#pragma unroll
                for (int n = 0; n < 2; ++n) acc[a][m][n] = (f32x4){0.f, 0.f, 0.f, 0.f};
        u.e = un.e; u.pm = un.pm; u.pn = un.pn; u.li = un.li; u.half = un.half; hf = u.half != 0; nvalid = G2_NVALID(u);
        G2_PTRS(pa, pb, u);
    }
#undef G2_PTRS
#undef G2_NVALID
#undef awoff
#undef bwoff
#undef G2_LOADA
#undef G2_LOADB
#undef G2_WRITE_A
#undef G2_WRITE_B
#undef G2_TR
#undef G2_COMPUTE
    if (PROBE_REPEAT == 33) tacc = TCK() - t_all0;
    if (tprobe && blockIdx.x == PROBE_WG && threadIdx.x == 0) *tprobe = tacc;
#undef TCK
#endif
}
}

namespace att {
typedef short bf16x8 __attribute__((ext_vector_type(8)));
typedef short s16x4 __attribute__((ext_vector_type(4)));
typedef float f32x16 __attribute__((ext_vector_type(16)));
typedef float f32x4 __attribute__((ext_vector_type(4)));
typedef unsigned u32x4 __attribute__((ext_vector_type(4)));
constexpr int SHM = 16384;
constexpr int NBUF = 3;
constexpr int L_K = 0, L_V = NBUF * SHM, L_WS = 2 * NBUF * SHM, L_PART = L_WS + 8 * 64 * 4, L_SELM = L_PART + 4 * 64 * 33 * 4, L_VALS = L_SELM + 256, L_ITEM = L_VALS + 8 * 64 * 4, L_END = L_ITEM + 16;
constexpr float C2 = 1.4426950408889634f * SCALE;
#define KSWZ(row, colB) ((row) * 256 + ((colB) ^ (((row) & 7) << 4)))
#define SBAR() __builtin_amdgcn_sched_barrier(0)
__device__ __forceinline__ int v_st(int k, int c) { const int kk = (k & ~0xC) | ((k & 4) << 1) | ((k & 8) >> 1); return ((kk >> 3) * 4 + (c >> 5)) * 512 + ((kk & 7) * 32 + (c & 31)) * 2; }
__device__ __forceinline__ int v_rd_base(int lane) { return ((lane & 3) << 3) | (((lane >> 2) & 3) << 6) | (((lane >> 4) & 1) << 5) | (((lane >> 5) & 1) << 8); }
constexpr int v_rd_off(int d0, int ks, int half) { return d0 * 512 + ks * 4096 + half * 2048; }
__device__ __forceinline__ int crow(int r, int hi) { return (r & 3) + 8 * (r >> 2) + 4 * hi; }
__device__ __forceinline__ unsigned cvtpk(float lo, float hi) { unsigned r; asm volatile("v_cvt_pk_bf16_f32 %0, %1, %2" : "=v"(r) : "v"(lo), "v"(hi)); return r; }
__device__ __forceinline__ float swap_max(float v) { auto rr = __builtin_amdgcn_permlane32_swap(__float_as_uint(v), __float_as_uint(v), false, false); return fmaxf(__uint_as_float(rr[0]), __uint_as_float(rr[1])); }
__device__ __forceinline__ float swap_sum(float v) { auto rr = __builtin_amdgcn_permlane32_swap(__float_as_uint(v), __float_as_uint(v), false, false); return __uint_as_float(rr[0]) + __uint_as_float(rr[1]); }

struct WV { int tid, wid, lane, r32, hi, vb0; unsigned ksrc[2], vsrc[2]; char* lds; LAS unsigned char* ldsL; };
__device__ __forceinline__ void wv_src_init(WV& w) {
#pragma unroll
    for (int i = 0; i < 2; ++i) {
        const int L = (w.wid * 2 + i) * 1024 + w.lane * 16;
        { const int row = L >> 8, colB = (L & 255) ^ ((row & 7) << 4); w.ksrc[i] = (unsigned)(row * 256 + colB); }
        { const int sub = L >> 9, kkhi = sub >> 2, cblk = sub & 3, within = L & 511, kklo = within >> 6, cc = (within >> 1) & 31;
          const int kk = kkhi * 8 + kklo, k = (kk & ~0xC) | ((kk & 4) << 1) | ((kk & 8) >> 1), c = cblk * 32 + cc; w.vsrc[i] = (unsigned)(k * 256 + c * 2); }
    }
}
__device__ __forceinline__ void dma_tile(const WV& w, const bf16_t* Kt, const bf16_t* Vt, int buf) {
    int ln = w.lane; asm volatile("" : "+v"(ln));
#pragma unroll
    for (int i = 0; i < 2; ++i) {
        const int L = (w.wid * 2 + i) * 1024 + ln * 16;
        const int row = L >> 8, colB = (L & 255) ^ ((row & 7) << 4); const unsigned ksrc = (unsigned)(row * 256 + colB);
        const int sub = L >> 9, kkhi = sub >> 2, cblk = sub & 3, within = L & 511, kklo = within >> 6, cc = (within >> 1) & 31;
        const int kk = kkhi * 8 + kklo, k = (kk & ~0xC) | ((kk & 4) << 1) | ((kk & 8) >> 1), c = cblk * 32 + cc; const unsigned vsrc = (unsigned)(k * 256 + c * 2);
        __builtin_amdgcn_global_load_lds((const unsigned*)((const char*)Vt + vsrc), (LAS unsigned*)(w.ldsL + L_V + buf * SHM + (w.wid * 2 + i) * 1024), 16, 0, 0);
        __builtin_amdgcn_global_load_lds((const unsigned*)((const char*)Kt + ksrc), (LAS unsigned*)(w.ldsL + L_K + buf * SHM + (w.wid * 2 + i) * 1024), 16, 0, 0);
    }
}
template <int BUF>
__device__ __forceinline__ void qkt(const WV& w, const bf16x8 (&qr)[8], f32x16& p0, f32x16& p1) {
    p0 = f32x16{}; p1 = f32x16{};
    const LAS char* kb[4];
#pragma unroll
    for (int dd = 0; dd < 4; ++dd) kb[dd] = (const LAS char*)w.ldsL + L_K + KSWZ(w.r32, (dd * 16 + w.hi * 8) * 2);
#pragma unroll
    for (int d0 = 0; d0 < 8; ++d0) { const LAS char* a = kb[d0 & 3] + BUF * SHM + (d0 >> 2) * 128;
        const bf16x8 b0 = *reinterpret_cast<const LAS bf16x8*>(a); const bf16x8 b1 = *reinterpret_cast<const LAS bf16x8*>(a + 32 * 256);
        p0 = __builtin_amdgcn_mfma_f32_32x32x16_bf16(b0, qr[d0], p0, 0, 0, 0);
        p1 = __builtin_amdgcn_mfma_f32_32x32x16_bf16(b1, qr[d0], p1, 0, 0, 0);
        if (d0 == 3) SBAR(); }
}
__device__ __forceinline__ void pack_p(const f32x16& p0, const f32x16& p1, bf16x8& pa0, bf16x8& pa1, bf16x8& pa2, bf16x8& pa3) {
#define PK4(P, B_, OUT) do { unsigned a0 = cvtpk(P[B_+0], P[B_+1]), a1 = cvtpk(P[B_+2], P[B_+3]); unsigned b0 = cvtpk(P[B_+4], P[B_+5]), b1 = cvtpk(P[B_+6], P[B_+7]); \
        auto r0 = __builtin_amdgcn_permlane32_swap(a0, b0, false, false); auto r1 = __builtin_amdgcn_permlane32_swap(a1, b1, false, false); \
        u32x4 w_ = {r0[0], r1[0], r0[1], r1[1]}; OUT = *reinterpret_cast<bf16x8*>(&w_); } while (0)
    PK4(p0, 0, pa0); PK4(p0, 8, pa1); PK4(p1, 0, pa2); PK4(p1, 8, pa3);
#undef PK4
}
template <int VB>
__device__ __forceinline__ void pv_tile(f32x16* o, int vb0, bf16x8 pa0, bf16x8 pa1, bf16x8 pa2, bf16x8 pa3) {
#define TRRD(dst, off) asm volatile("ds_read_b64_tr_b16 %0, %1 offset:%2" : "=&v"(dst) : "v"(vb0), "i"(off) : "memory")
#define PV_D0(d0) do { s16x4 l0, l1, l2, l3, h0, h1, h2, h3; constexpr int b_ = VB * SHM + v_rd_off(d0, 0, 0); \
        TRRD(l0, b_); TRRD(h0, b_ + 2048); TRRD(l1, b_ + 4096); TRRD(h1, b_ + 6144); TRRD(l2, b_ + 8192); TRRD(h2, b_ + 10240); TRRD(l3, b_ + 12288); TRRD(h3, b_ + 14336); \
        asm volatile("s_waitcnt lgkmcnt(0)" ::: "memory"); SBAR(); \
        o[d0] = __builtin_amdgcn_mfma_f32_32x32x16_bf16(pa0, (bf16x8){l0[0], l0[1], l0[2], l0[3], h0[0], h0[1], h0[2], h0[3]}, o[d0], 0, 0, 0); \
        o[d0] = __builtin_amdgcn_mfma_f32_32x32x16_bf16(pa1, (bf16x8){l1[0], l1[1], l1[2], l1[3], h1[0], h1[1], h1[2], h1[3]}, o[d0], 0, 0, 0); \
        o[d0] = __builtin_amdgcn_mfma_f32_32x32x16_bf16(pa2, (bf16x8){l2[0], l2[1], l2[2], l2[3], h2[0], h2[1], h2[2], h2[3]}, o[d0], 0, 0, 0); \
        o[d0] = __builtin_amdgcn_mfma_f32_32x32x16_bf16(pa3, (bf16x8){l3[0], l3[1], l3[2], l3[3], h3[0], h3[1], h3[2], h3[3]}, o[d0], 0, 0, 0); } while (0)
    PV_D0(0); PV_D0(1); PV_D0(2); PV_D0(3);
#undef PV_D0
#undef TRRD
}
__device__ __forceinline__ void store_o(const WV& w, const f32x16* o, const float* tab, bf16_t* outp) {
    bf16_t* lp = outp + (size_t)w.hi * 4096 + w.r32;
#pragma unroll
    for (int r = 0; r < 16; ++r) { const int q = crow(r, w.hi); const float sc = tab[q];
        bf16_t* p = lp; asm volatile("" : "+v"(p));
        p += ((r & 3) + 8 * (r >> 2)) * 1024;
#pragma unroll
        for (int d0 = 0; d0 < 4; ++d0) { const float v = o[d0][r] * sc; const float vn = __shfl_xor(v, 1);
            if ((w.r32 & 1) == 0) *(__attribute__((address_space(1))) unsigned*)(p + d0 * 32) = cvtpk(v, vn); } }
}

template <int MODE>
__device__ __forceinline__ void flash_pass(const WV& w, const bf16_t* Kp, const bf16_t* Vp, int j_lo, int j_hi, const bf16x8 (&qr)[8], int tpos, int tw0, unsigned selmask,
                                           f32x16 (&o)[4], float& m_reg, float& l_reg) {
    float* al_l = (float*)(w.lds + L_WS) + w.wid * 64;
    dma_tile(w, Kp + (size_t)j_lo * 64 * HD, Vp + (size_t)j_lo * 64 * HD, 0);
    if (j_lo + 1 < j_hi) dma_tile(w, Kp + (size_t)(j_lo + 1) * 64 * HD, Vp + (size_t)(j_lo + 1) * 64 * HD, 1);
#define FSTEP(BUF, jj) do { const int jt = (jj);                                                                                  \
        if (jt + 1 < j_hi) asm volatile("s_waitcnt vmcnt(4)" ::: "memory"); else asm volatile("s_waitcnt vmcnt(0)" ::: "memory");   \
        asm volatile("s_waitcnt lgkmcnt(0)" ::: "memory"); __builtin_amdgcn_s_barrier(); asm volatile("" ::: "memory");          \
        if (jt + 2 < j_hi) dma_tile(w, Kp + (size_t)(jt + 2) * 64 * HD, Vp + (size_t)(jt + 2) * 64 * HD, ((BUF) + 2) % 3);         \
        f32x16 p0, p1;                                                                                                           \
        qkt<BUF>(w, qr, p0, p1);                                                                                                 \
        const int kb = jt * 64;                                                                                                  \
        { const float NEG = -__builtin_inff();                                                                                   \
          const bool need = (kb + 63 > tw0) || (MODE == 1 && kb <= tw0 + 31 - 512);                                              \
          if (need) { const int dq = tpos - kb - 4 * w.hi; const unsigned W = (MODE == 1) ? 512u : 0x7fffffffu;                  \
              _Pragma("unroll") for (int r = 0; r < 16; ++r) { const int c = (r & 3) + 8 * (r >> 2); if ((unsigned)(dq - c) >= W) p0[r] = NEG; if ((unsigned)(dq - c - 32) >= W) p1[r] = NEG; } } \
          if (MODE == 0) { const bool sel = (selmask >> jt) & 1u;                                                                \
              if (!__all(sel)) { _Pragma("unroll") for (int r = 0; r < 16; ++r) { p0[r] = sel ? p0[r] : NEG; p1[r] = sel ? p1[r] : NEG; } } } } \
        float pmax = p0[0];                                                                                                      \
        _Pragma("unroll") for (int r = 1; r < 16; ++r) pmax = fmaxf(pmax, p0[r]);                                                \
        _Pragma("unroll") for (int r = 0; r < 16; ++r) pmax = fmaxf(pmax, p1[r]);                                                \
        pmax = swap_max(pmax);                                                                                                   \
        float mn = m_reg, alpha = 1.f;                                                                                           \
        const bool resc = !__all((pmax - m_reg) * SCALE <= 8.f);          \
        if (resc) { mn = fmaxf(m_reg, pmax); alpha = __builtin_amdgcn_exp2f((m_reg - mn) * C2); m_reg = mn; }                     \
        const float mnL = -mn * C2;                                                                                              \
        float ps = 0.f;                                                                                                          \
        _Pragma("unroll") for (int r = 0; r < 16; ++r) { p0[r] = __builtin_amdgcn_exp2f(fmaf(p0[r], C2, mnL)); ps += p0[r]; }    \
        _Pragma("unroll") for (int r = 0; r < 16; ++r) { p1[r] = __builtin_amdgcn_exp2f(fmaf(p1[r], C2, mnL)); ps += p1[r]; }    \
        ps = swap_sum(ps);                                                                                                       \
        l_reg = l_reg * alpha + ps;                                                                                              \
        if (resc) { if (w.hi == 0) al_l[w.r32] = alpha;                                                                          \
            asm volatile("s_waitcnt lgkmcnt(0)" ::: "memory");                                                                   \
            _Pragma("unroll") for (int r = 0; r < 16; ++r) { const float a = al_l[crow(r, w.hi)];                                \
                _Pragma("unroll") for (int d = 0; d < 4; ++d) o[d][r] *= a; } }                                                  \
        bf16x8 pa0, pa1, pa2, pa3;                                                                                               \
        pack_p(p0, p1, pa0, pa1, pa2, pa3);                                                                                      \
        pv_tile<BUF>(o, w.vb0, pa0, pa1, pa2, pa3);                                                                              \
    } while (0)
    int j = j_lo;
    for (; j + 2 < j_hi; j += 3) { FSTEP(0, j); FSTEP(1, j + 1); FSTEP(2, j + 2); }
    if (j < j_hi) { FSTEP(0, j); if (j + 1 < j_hi) FSTEP(1, j + 1); }
#undef FSTEP
    __syncthreads();
}
}

__device__ const unsigned char ATT_ITEMS[80] = {15, 30, 31, 63, 14, 28, 29, 61, 62, 13, 26, 27, 59, 60, 12, 24, 25, 57, 58, 11, 22, 23, 55, 56, 10, 20, 21, 53, 54, 9, 18, 19, 51, 52, 8, 16, 17, 49, 50, 7, 48, 6, 5,
    72, 73, 74, 75, 76, 77, 78, 79, 80, 81, 82, 83, 84, 85, 86, 87, 88, 89, 90, 91, 92, 93, 94, 95, 4, 71, 3, 70, 2, 69, 1, 68, 0, 67, 66, 65, 64};
constexpr int CW_QUEUE = 6144;
constexpr int CW_CVTQ = 6144 + 256;
constexpr int CW_CMPR = 8192 + 2048;

__device__ __forceinline__ void p_attn(const Frame& F, unsigned char* lds_raw, int rep) {
    using namespace att;
    WV w;
#define WV_INIT() do { int ln_ = F.lane; asm volatile("" : "+v"(ln_)); w.tid = F.wave * 64 + ln_; w.wid = F.wave; w.lane = ln_; w.r32 = ln_ & 31; w.hi = ln_ >> 5; \
        w.lds = (char*)lds_raw + 1024; w.ldsL = (LAS unsigned char*)lds_raw + 1024; w.vb0 = (int)(uintptr_t)(w.lds) + att::L_V + v_rd_base(ln_); } while (0)
    WV_INIT();
    const bf16_t* qn = (const bf16_t*)(F.ws + WS_QN); const bf16_t* qrp = (const bf16_t*)(F.ws + WS_QR); const bf16_t* kv = (const bf16_t*)(F.ws + WS_KV);
    const bf16_t* ckv = (const bf16_t*)(F.ws + WS_CMPKV);
    bf16_t* ocmp = (bf16_t*)(F.ws + WS_OCMP); bf16_t* owin = (bf16_t*)(F.ws + WS_OWIN); bf16_t* osel = (bf16_t*)(F.ws + WS_OSEL); float* ml = (float*)(F.ws + WS_ML);
    unsigned* qctr = (unsigned*)(F.ws + WS_CTL) + CW_QUEUE + 64 * rep;
    float* wsf = (float*)(w.lds + L_WS) + w.wid * 64;
    float* part = (float*)(w.lds + L_PART); unsigned* selm = (unsigned*)(w.lds + L_SELM); float* vals = (float*)(w.lds + L_VALS) + w.wid * 64; volatile int* itemw = (volatile int*)(w.lds + L_ITEM);
    const int hr = w.wid >> 1, th = w.wid & 1;
    for (;;) {
        __syncthreads();
        if (F.tid == 0) itemw[0] = (int)atomicAdd(qctr, 1u);
        __syncthreads();
        const int item = itemw[0];
        if (item >= 640) break;
        WV_INIT();
        const int ent = ATT_ITEMS[item >> 3], bg = item & 7, type = ent >> 5, qb = ent & 31, b = bg >> 1, g = bg & 1, h = 4 * g + hr;
        const int t0 = qb * 64 + th * 32, tpos = t0 + w.r32, tok0 = b * SEQ + t0;
        const size_t qoff = (((size_t)b * NH + h) * SEQ + t0 + w.r32) * HD + w.hi * 8;
        const size_t kvoff = ((size_t)b * NG + g) * SEQ * HD;
        bf16x8 qr[8];
        f32x16 o[4];
#ifndef ATT_NO_WIN
        if (type == 2) {
#pragma unroll
            for (int d0 = 0; d0 < 8; ++d0) qr[d0] = *(const bf16x8*)(qrp + qoff + d0 * 16);
#pragma unroll
            for (int d = 0; d < 4; ++d) o[d] = f32x16{};
            float m_reg = -1e30f, l_reg = 0.f;
            flash_pass<1>(w, kv + (size_t)4 * (4 * MB / 2) + kvoff, kv + (size_t)5 * (4 * MB / 2) + kvoff, qb >= 8 ? qb - 8 : 0, qb + 1, qr, tpos, t0, 0u, o, m_reg, l_reg);
            if (w.hi == 0) wsf[w.r32] = 1.f / l_reg;
            asm volatile("s_waitcnt lgkmcnt(0)" ::: "memory");
            store_o(w, o, wsf, owin + (size_t)tok0 * 1024 + h * HD);
            continue;
        }
#endif
#ifndef ATT_NO_CMP
        {
#pragma unroll
            for (int d0 = 0; d0 < 8; ++d0) qr[d0] = *(const bf16x8*)(qn + qoff + d0 * 16);
            const bf16_t* Kc = ckv + (size_t)bg * 128 * HD; const bf16_t* Vc = ckv + (size_t)1024 * HD + (size_t)bg * 128 * HD;
            dma_tile(w, Kc, Vc, 0); dma_tile(w, Kc + 64 * HD, Vc + 64 * HD, 1);
            asm volatile("s_waitcnt vmcnt(0)" ::: "memory");
            __syncthreads();
            f32x16 pA0, pA1, pB0, pB1;
            qkt<0>(w, qr, pA0, pA1); qkt<1>(w, qr, pB0, pB1);
            const int nmax = tpos >= 31 ? ((tpos - 31) >> 4) : -1;
            const float NEG = -__builtin_inff();
            float pmax = NEG;
#pragma unroll
            for (int r = 0; r < 16; ++r) { const int n = crow(r, w.hi);
                pA0[r] = (n <= nmax) ? pA0[r] : NEG; pA1[r] = (n + 32 <= nmax) ? pA1[r] : NEG; pB0[r] = (n + 64 <= nmax) ? pB0[r] : NEG; pB1[r] = (n + 96 <= nmax) ? pB1[r] : NEG;
                pmax = fmaxf(fmaxf(pmax, pA0[r]), fmaxf(pA1[r], fmaxf(pB0[r], pB1[r]))); }
            pmax = swap_max(pmax);
            const float mm = (pmax == NEG) ? 0.f : pmax;
            const float mnL = -mm * C2;
            float ps = 0.f;
#pragma unroll
            for (int r = 0; r < 16; ++r) { pA0[r] = __builtin_amdgcn_exp2f(fmaf(pA0[r], C2, mnL)); pA1[r] = __builtin_amdgcn_exp2f(fmaf(pA1[r], C2, mnL));
                pB0[r] = __builtin_amdgcn_exp2f(fmaf(pB0[r], C2, mnL)); pB1[r] = __builtin_amdgcn_exp2f(fmaf(pB1[r], C2, mnL)); ps += (pA0[r] + pA1[r]) + (pB0[r] + pB1[r]); }
            ps = swap_sum(ps);
            const float inv = ps > 0.f ? 1.f / ps : 0.f;
#pragma unroll
            for (int r = 0; r < 16; ++r) { pA0[r] *= inv; pA1[r] *= inv; pB0[r] *= inv; pB1[r] *= inv; }
            {
                float av[16], bv[16];
#pragma unroll
                for (int gq = 0; gq < 4; ++gq) {
                    av[gq]      = pA0[4 * gq] + pA0[4 * gq + 1] + pA0[4 * gq + 2] + 0.5f * pA0[4 * gq + 3]; bv[gq]      = 0.5f * pA0[4 * gq + 3];
                    av[4 + gq]  = pA1[4 * gq] + pA1[4 * gq + 1] + pA1[4 * gq + 2] + 0.5f * pA1[4 * gq + 3]; bv[4 + gq]  = 0.5f * pA1[4 * gq + 3];
                    av[8 + gq]  = pB0[4 * gq] + pB0[4 * gq + 1] + pB0[4 * gq + 2] + 0.5f * pB0[4 * gq + 3]; bv[8 + gq]  = 0.5f * pB0[4 * gq + 3];
                    av[12 + gq] = pB1[4 * gq] + pB1[4 * gq + 1] + pB1[4 * gq + 2] + 0.5f * pB1[4 * gq + 3]; bv[12 + gq] = 0.5f * pB1[4 * gq + 3];
                }
                float* prow = part + ((size_t)hr * 64 + th * 32 + w.r32) * 33;
#pragma unroll
                for (int idx = 0; idx < 16; ++idx) {
                    const float bo = __shfl_xor(bv[idx], 32);
                    const float bprev = (idx > 0) ? __shfl_xor(bv[idx > 0 ? idx - 1 : 0], 32) : 0.f;
                    const float inc = w.hi ? bo : bprev;
                    prow[2 * idx + w.hi] = av[idx] + inc;
                }
            }
            if (type == 0) {
                bf16x8 pa0, pa1, pa2, pa3;
#pragma unroll
                for (int d = 0; d < 4; ++d) o[d] = f32x16{};
                pack_p(pA0, pA1, pa0, pa1, pa2, pa3); pv_tile<0>(o, w.vb0, pa0, pa1, pa2, pa3);
                pack_p(pB0, pB1, pa0, pa1, pa2, pa3); pv_tile<1>(o, w.vb0, pa0, pa1, pa2, pa3);
                if (w.hi == 0) wsf[w.r32] = 1.f;
                asm volatile("s_waitcnt lgkmcnt(0)" ::: "memory");
                store_o(w, o, wsf, ocmp + (size_t)tok0 * 1024 + h * HD);
            }
            __syncthreads();
#pragma unroll 1
            for (int ps2 = 0; ps2 < 4; ++ps2) {
                int ln = w.lane; asm volatile("" : "+v"(ln));
                const int j = ln & 31, hi2 = ln >> 5;
                const int tk = 8 * w.wid + 2 * ps2 + hi2, t = qb * 64 + tk, cur = qb;
                float imp = 0.f;
#pragma unroll
                for (int r = 0; r < 4; ++r) imp += part[((size_t)r * 64 + tk) * 33 + j];
                const bool ok = (64 * j <= t), forced = (j == 0) || (cur - j >= 0 && cur - j < 2);
                const float val = (ok && forced) ? 1.0e30f : (ok ? imp : -1.0e30f);
                vals[ln] = val;
                asm volatile("s_waitcnt lgkmcnt(0)" ::: "memory");
                int rank = 0;
#pragma unroll
                for (int jj = 0; jj < 32; ++jj) { const float o2 = vals[hi2 * 32 + jj]; rank += (o2 > val || (o2 == val && jj < j)) ? 1 : 0; }
                const unsigned long long bal = __ballot(rank < 16 && val >= 0.f);
                if (w.lane == 0) { selm[8 * w.wid + 2 * ps2] = (unsigned)bal; selm[8 * w.wid + 2 * ps2 + 1] = (unsigned)(bal >> 32); }
            }
            __syncthreads();
        }
#endif
#ifndef ATT_NO_SEL
        {
            WV_INIT();
            const unsigned sm = selm[th * 32 + w.r32];
            const int ntile = qb + 1, hsplit = (ntile + 1) >> 1;
            const int ja = (qb >= 16 && type == 1) ? hsplit : 0, jb = (qb >= 16 && type == 0) ? hsplit : ntile;
#pragma unroll
            for (int d0 = 0; d0 < 8; ++d0) qr[d0] = *(const bf16x8*)(qrp + qoff + d0 * 16);
#pragma unroll
            for (int d = 0; d < 4; ++d) o[d] = f32x16{};
            float m_reg = -1e30f, l_reg = 0.f;
            flash_pass<0>(w, kv + (size_t)2 * (4 * MB / 2) + kvoff, kv + (size_t)3 * (4 * MB / 2) + kvoff, ja, jb, qr, tpos, t0, sm, o, m_reg, l_reg);
            if (w.hi == 0) { wsf[w.r32] = l_reg > 0.f ? 1.f / l_reg : 0.f; float* mp = ml + (((size_t)type * NT + tok0 + w.r32) * NH + h) * 2; mp[0] = m_reg; mp[1] = l_reg; }
            asm volatile("s_waitcnt lgkmcnt(0)" ::: "memory");
            store_o(w, o, wsf, osel + (size_t)type * NT * 1024 + (size_t)tok0 * 1024 + h * HD);
        }
#endif
    }
}

struct CvtTile { const float* src; const float* ksc; bf16_t* dst0; int sld, ldd, mode; };
__device__ __forceinline__ CvtTile cvt_decode(const Frame& F, int t) {
    CvtTile c; c.ksc = nullptr; c.mode = 0;
    if (t < 4096) { const int e = t >> 7, mat = (t >> 6) & 1, kt = (t >> 1) & 31, nt = t & 1;
        c.src = (mat ? F.in[I_WUP] : F.in[I_WGATE]) + ((size_t)e * DM + kt * 64) * FF + nt * 256; c.sld = FF; c.ksc = F.in[I_LNMOE] + kt * 64;
        c.dst0 = (bf16_t*)(F.ws + WS_W1T) + ((size_t)e * 1024 + nt * 512 + mat * 128) * DM + kt * 64; c.ldd = DM; c.mode = 1; return c; }
    t -= 4096;
    if (t < 2048) { const int e = t >> 6, kt = (t >> 3) & 7, nt = t & 7;
        c.src = F.in[I_WDOWN] + ((size_t)e * FF + kt * 64) * DM + nt * 256; c.sld = DM;
        c.dst0 = (bf16_t*)(F.ws + WS_W2T) + ((size_t)e * 2048 + nt * 256) * FF + kt * 64; c.ldd = FF; return c; }
    t -= 2048;
    if (t < 256) { const int kt = t >> 3, nt = t & 7;
        c.src = F.in[I_WOUT] + (size_t)kt * 64 * DM + nt * 256; c.sld = DM; c.dst0 = (bf16_t*)(F.ws + WS_WOUTT) + (size_t)nt * 256 * DM + kt * 64; c.ldd = DM; return c; }
    t -= 256;
    if (t < 480) { const int kt = t / 15, nt = t % 15;
        c.src = F.in[I_WIN] + (size_t)kt * 64 * INW; c.sld = INW; c.ksc = F.in[I_LNMIX] + kt * 64;
        c.dst0 = (bf16_t*)(F.ws + WS_WINT) + (size_t)nt * 256 * DM + kt * 64; c.ldd = DM; c.mode = 2 + nt; return c; }
    t -= 480;
    { const int kv = t >> 6, kt = t & 63;
      c.src = (kv ? F.in[I_WV1] : F.in[I_WK1]) + (size_t)kt * 64 * 256; c.sld = 256; c.dst0 = (bf16_t*)(F.ws + WS_CMPW) + (size_t)kv * 256 * 4096 + kt * 64; c.ldd = 4096; return c; }
}
constexpr int N_CVT_TILES = 4096 + 2048 + 256 + 480 + 128;
__device__ __forceinline__ void cvt_load(const CvtTile& c, int nq, int kq, float4 (&v)[8]) {
    const float* p = c.src + 4 * nq; bool valid = true;
    if (c.mode >= 2) { const int n = (c.mode - 2) * 256 + 4 * nq; int sc = -1; if (n < 2560) sc = n; else if (n < 3584) sc = n + 24; else if (n < 3608) sc = n - 1024; valid = sc >= 0; p = c.src + (valid ? sc : 0); }
#pragma unroll
    for (int i = 0; i < 8; ++i) v[i] = valid ? *(const float4*)(p + (size_t)(kq * 8 + i) * c.sld) : make_float4(0.f, 0.f, 0.f, 0.f);
}

constexpr int CVT_RUN = 4;
__device__ __forceinline__ void cvt_stream(const Frame& F, int t_lo, int t_hi, unsigned* queue, int sfirst = -1, int sstride = 0) {
    if (sfirst < 0) { sfirst = F.bid; sstride = F.G; }
    float* T = F.lds;
    volatile int* nxtw = (volatile int*)(F.lds + 64 * 257);
    const int tid = F.tid, nq = tid & 63, kq = tid >> 6;
    int tA, tB; float4 vA[8], vB[8]; CvtTile cA, cB;
    if (queue) { __syncthreads(); if (tid == 0) { nxtw[0] = t_lo + CVT_RUN * (int)atomicAdd(queue, 1u); nxtw[1] = t_lo + CVT_RUN * (int)atomicAdd(queue, 1u); } __syncthreads(); tA = nxtw[0]; tB = nxtw[1]; }
    else { tA = t_lo + sfirst; tB = tA + sstride; }
    if (tA < t_hi) { cA = cvt_decode(F, tA); cvt_load(cA, nq, kq, vA); }
    if (tB < t_hi) { cB = cvt_decode(F, tB); cvt_load(cB, nq, kq, vB); }
#define CVT_STEP(tX, cX, vX, slot) do {                                                                                                     \
        const bool pop = queue && (((tX) - t_lo) % CVT_RUN == CVT_RUN - 1);                 \
        int tn_reg = 0;                                                                                                                      \
        if (pop && tid == 0) tn_reg = t_lo + CVT_RUN * (int)atomicAdd(queue, 1u);                                                            \
        __syncthreads();                                                                                                                     \
        _Pragma("unroll") for (int i = 0; i < 8; ++i) { const float s = cX.ksc ? cX.ksc[kq * 8 + i] : 1.f; float* tp = T + (kq * 8 + i) * 257 + 4 * nq; \
            tp[0] = vX[i].x * s; tp[1] = vX[i].y * s; tp[2] = vX[i].z * s; tp[3] = vX[i].w * s; }                                           \
        if (pop && tid == 0) nxtw[slot] = tn_reg;                                                                                            \
        __syncthreads();                                                                                                                     \
        const CvtTile cc = cX; const int tn = queue ? (pop ? nxtw[slot] : tX + 1) : tX + 2 * sstride;                                            \
        if (tn < t_hi) { cX = cvt_decode(F, tn); cvt_load(cX, nq, kq, vX); }                                                                 \
        _Pragma("unroll") for (int j = 0; j < 4; ++j) { const int id = tid + 512 * j, n = id >> 3, kc = id & 7; const float* tp = T + (kc * 8) * 257 + n; \
            pg8::u32x4 w; w.x = pg8::cvt_pk_bf16(tp[0], tp[257]); w.y = pg8::cvt_pk_bf16(tp[2 * 257], tp[3 * 257]); w.z = pg8::cvt_pk_bf16(tp[4 * 257], tp[5 * 257]); w.w = pg8::cvt_pk_bf16(tp[6 * 257], tp[7 * 257]); \
            const int rowi = (cc.mode == 1) ? ((n >> 7) * 256 + (n & 127)) : n;                                                              \
            *(pg8::u32x4*)(cc.dst0 + (size_t)rowi * cc.ldd + kc * 8) = w; }                                                                  \
        tX = tn; } while (0)
    while (tA < t_hi) {
        CVT_STEP(tA, cA, vA, 0);
        if (tB >= t_hi) { const int t2 = tA; tA = tB; tB = t2; const CvtTile c2 = cA; cA = cB; cB = c2;
#pragma unroll
            for (int i = 0; i < 8; ++i) { const float4 x = vA[i]; vA[i] = vB[i]; vB[i] = x; }
            continue; }
        CVT_STEP(tB, cB, vB, 1);
    }
    while (tB < t_hi) CVT_STEP(tB, cB, vB, 1);
#undef CVT_STEP
    __syncthreads();
}

__device__ __forceinline__ void p0_tables(const Frame& F, int first, int stride) {
    {
        const float* wp = F.in[I_WPOOL]; const float* ps = F.in[I_PSCALE]; const float* bp = F.in[I_BPOOL]; bf16_t* wpt = (bf16_t*)(F.ws + WS_POOLW); float* pb = (float*)(F.ws + WS_POOLB);
        for (int idx = first * NTHREADS + F.tid; idx < 4 * 256 * 256; idx += stride * NTHREADS) { const int k = idx & 255, n = (idx >> 8) & 255, g = idx >> 16;
            wpt[idx] = f2bf(wp[((size_t)g * 256 + k) * 256 + n] * ps[g * 256 + n]); }
        for (int idx = first * NTHREADS + F.tid; idx < 1024; idx += stride * NTHREADS) pb[idx] = bp[idx] * ps[idx];
    }
    { const float* lnm = F.in[I_LNMOE]; const float* wre = F.in[I_WRE]; const float* wrg = F.in[I_WRG]; float* WRP = (float*)(F.ws + WS_WRP);
      for (int idx = first * NTHREADS + F.tid; idx < DM * 48; idx += stride * NTHREADS) { const int k = idx / 48, c = idx - k * 48;
          WRP[idx] = c < 32 ? lnm[k] * wre[((size_t)(c >> 3) * DM + k) * 8 + (c & 7)] : (c < 36 ? lnm[k] * wrg[k * 4 + (c - 32)] : 0.f); } }
    for (int it = first; it < 256; it += stride) {
        const int kv = it >> 7, jb = (it >> 5) & 3, mc = it & 31;
        const float* pe = (kv ? F.in[I_PEV] : F.in[I_PEK]); const float* w1 = (kv ? F.in[I_WV1] : F.in[I_WK1]);
        const int mg = F.tid >> 6, j = jb * 64 + (F.tid & 63);
        float a = 0.f;
#pragma unroll
        for (int q = 0; q < 16; ++q) { const int m = mc * 128 + mg + 8 * q; a += pe[m] * w1[(size_t)m * 256 + j]; }
        __syncthreads();
        F.lds[F.tid] = a;
        __syncthreads();
        if (F.tid < 64) { float s = 0.f; for (int q = 0; q < 8; ++q) s += F.lds[q * 64 + F.tid]; ((float*)(F.ws + WS_BIAS1))[(mc * 2 + kv) * 256 + j] = s; }
        __syncthreads();
    }
}
__device__ __forceinline__ void p0_prologue(const Frame& F) {
    const float* x = F.in[I_X];
    bf16_t* xb = (bf16_t*)(F.ws + WS_XB); float* rstd1 = (float*)(F.ws + WS_RSTD1);
    const int gw = F.bid * NWAVES + F.wave, nw = F.G * NWAVES, lane = F.lane;
    for (int r = gw; r < NT; r += 2 * nw) {
        const int r2 = r + nw; const bool has2 = r2 < NT;
        float4 v[8], v2[8]; float ss = 0.f, ss2 = 0.f;
#pragma unroll
        for (int i = 0; i < 8; ++i) { v[i] = *(const float4*)(x + (size_t)r * DM + i * 256 + lane * 4); v2[i] = has2 ? *(const float4*)(x + (size_t)r2 * DM + i * 256 + lane * 4) : make_float4(0.f, 0.f, 0.f, 0.f); }
#pragma unroll
        for (int i = 0; i < 8; ++i) { ss += v[i].x * v[i].x + v[i].y * v[i].y + v[i].z * v[i].z + v[i].w * v[i].w; ss2 += v2[i].x * v2[i].x + v2[i].y * v2[i].y + v2[i].z * v2[i].z + v2[i].w * v2[i].w; }
        ss = wave_sum(ss); ss2 = wave_sum(ss2);
        if (lane == 0) { rstd1[r] = rsqrtf(ss * (1.f / DM) + EPS); if (has2) rstd1[r2] = rsqrtf(ss2 * (1.f / DM) + EPS); }
#pragma unroll
        for (int i = 0; i < 8; ++i) { uint2 w; w.x = pg8::cvt_pk_bf16(v[i].x, v[i].y); w.y = pg8::cvt_pk_bf16(v[i].z, v[i].w);
            *(uint2*)(xb + (size_t)r * DM + i * 256 + lane * 4) = w;
            if (has2) { uint2 w2; w2.x = pg8::cvt_pk_bf16(v2[i].x, v2[i].y); w2.y = pg8::cvt_pk_bf16(v2[i].z, v2[i].w); *(uint2*)(xb + (size_t)r2 * DM + i * 256 + lane * 4) = w2; } }
    }
    cvt_stream(F, 6400, N_CVT_TILES, nullptr);
    {
        const int* pos = (const int*)F.in[I_POS]; float* rc = (float*)(F.ws + WS_ROPEC); float* rs = (float*)(F.ws + WS_ROPES);
        for (int idx = F.bid * NTHREADS + F.tid; idx < NB * SEQ * 16; idx += F.G * NTHREADS) {
            const int i = idx & 15, bs = idx >> 4;
            const float inv = exp2f(-(float)i * (1.f / 16.f) * 18.931568569324174f);
            const float ang = (float)pos[bs] * inv;
            rc[idx] = cosf(ang); rs[idx] = sinf(ang);
        }
    }
}

struct EpiProj {
    static constexpr bool AFTER_DRAIN = false;
    const float* rstd1; const float* rc; const float* rs; bf16_t* qn; bf16_t* qr; bf16_t* kv; bf16_t* u; float* gates;
    __device__ __forceinline__ void operator()(const pg8::f32x4 (&acc)[2][2][4][2], const pg8::Unit& un, int wr, int wc, int fr, int fq) const {
        const int pn = un.pn;
#pragma unroll
        for (int ai = 0; ai < 2; ++ai)
#pragma unroll
            for (int m = 0; m < 4; ++m) {
                const int row = un.pm * 256 + ai * 128 + wr * 64 + m * 16 + fr; const float r1 = rstd1[row]; const int b = row >> 11, s = row & 2047;
                if (pn < 10) {
                    const bool ropeu = (pn < 4) || pn == 6 || pn == 8;
                    pg8::f32x4 c4 = {1.f, 1.f, 1.f, 1.f}, s4 = {0.f, 0.f, 0.f, 0.f};
                    if (ropeu && wc == 0) { c4 = *(const pg8::f32x4*)(rc + (size_t)row * 16 + 4 * fq); s4 = *(const pg8::f32x4*)(rs + (size_t)row * 16 + 4 * fq); }
#pragma unroll
                    for (int bj = 0; bj < 2; ++bj) {
                        const pg8::f32x4 v0 = acc[ai][bj][m][0] * r1, v1 = acc[ai][bj][m][1] * r1;
                        const int d0 = 32 * wc + 4 * fq;
                        pg8::f32x4 o0 = v0, o1 = v1;
                        if (ropeu && wc == 0) { o0 = v0 * c4 - v1 * s4; o1 = v1 * c4 + v0 * s4; }
                        uint2 w0, w1; w0.x = pg8::cvt_pk_bf16(o0[0], o0[1]); w0.y = pg8::cvt_pk_bf16(o0[2], o0[3]); w1.x = pg8::cvt_pk_bf16(o1[0], o1[1]); w1.y = pg8::cvt_pk_bf16(o1[2], o1[3]);
                        if (pn < 4) {
                            const size_t o = (((size_t)b * NH + 2 * pn + bj) * SEQ + s) * HD + d0;
                            uint2 n0, n1; n0.x = pg8::cvt_pk_bf16(v0[0], v0[1]); n0.y = pg8::cvt_pk_bf16(v0[2], v0[3]); n1.x = pg8::cvt_pk_bf16(v1[0], v1[1]); n1.y = pg8::cvt_pk_bf16(v1[2], v1[3]);
                            *(uint2*)(qn + o) = n0; *(uint2*)(qn + o + 16) = n1; *(uint2*)(qr + o) = w0; *(uint2*)(qr + o + 16) = w1;
                        } else {
                            const size_t o = (size_t)(pn - 4) * (4 * MB / 2) + (((size_t)b * NG + bj) * SEQ + s) * HD + d0;
                            *(uint2*)(kv + o) = w0; *(uint2*)(kv + o + 16) = w1;
                        }
                    }
                } else if (pn < 14) {
#pragma unroll
                    for (int bj = 0; bj < 2; ++bj)
#pragma unroll
                        for (int n = 0; n < 2; ++n) { const pg8::f32x4 v = acc[ai][bj][m][n] * r1; uint2 w_; w_.x = pg8::cvt_pk_bf16(v[0], v[1]); w_.y = pg8::cvt_pk_bf16(v[2], v[3]);
                            *(uint2*)(u + (size_t)row * 1024 + (pn - 10) * 256 + bj * 128 + wc * 32 + n * 16 + 4 * fq) = w_; }
                } else {
                    if (wc == 0) { *(pg8::f32x4*)(gates + (size_t)row * 24 + 4 * fq) = acc[ai][0][m][0] * r1; if (fq < 2) *(pg8::f32x4*)(gates + (size_t)row * 24 + 16 + 4 * fq) = acc[ai][0][m][1] * r1; }
                }
            }
    }
};

__device__ __forceinline__ void p1_proj(const Frame& F, LAS unsigned char* stage) {
    pg8::DenseOrder S; S.init(F.ws + WS_XB, F.ws + WS_WINT, DM, DM, NT, INWP, F.G, F.bid);
    EpiProj E{(const float*)(F.ws + WS_RSTD1), (const float*)(F.ws + WS_ROPEC), (const float*)(F.ws + WS_ROPES), (bf16_t*)(F.ws + WS_QN), (bf16_t*)(F.ws + WS_QR), (bf16_t*)(F.ws + WS_KV),
              (bf16_t*)(F.ws + WS_U), (float*)(F.ws + WS_GATES)};
    pg8::gemm_phase<EpiProj, pg8::DenseOrder, false>(stage, DM, DM, DM, S, E);
}

__device__ __forceinline__ void p4_cmp2(const Frame& F, int first, int stride, bool gated) {
    const float* part = (const float*)(F.ws + WS_CPART); const float* bias1p = (const float*)(F.ws + WS_BIAS1); bf16_t* ckv = (bf16_t*)(F.ws + WS_CMPKV);
    float* H = F.lds;
    float* W2 = F.lds + 8 * 260;
    unsigned* ctl = (unsigned*)(F.ws + WS_CTL);
    int w2_of = -1;
    for (int it = first; it < 256; it += stride) {
        const int kvi = it >> 7, r0 = (it & 127) * 8; const float* w2 = kvi ? F.in[I_WV2] : F.in[I_WK2];
        __syncthreads();
        if (gated && F.tid == 0) { unsigned* cw = ctl + CW_CMPR + 64 * (kvi * 4 + (r0 >> 8)); unsigned sp = 0;
            while (__hip_atomic_load(cw, __ATOMIC_RELAXED, __HIP_MEMORY_SCOPE_AGENT) < 8u) { __builtin_amdgcn_s_sleep(2);
                if ((++sp & 255u) == 0u) { if (xb_ld(&ctl[XB_TMO])) break; if (sp > XB_SPIN_CAP) { atomicAdd(&ctl[XB_TMO], 1u); break; } } }
            __builtin_amdgcn_fence(__ATOMIC_ACQUIRE, "agent"); asm volatile("s_waitcnt vmcnt(0)" ::: "memory"); }
        if (gated) __syncthreads();
        if (w2_of != kvi) {
#pragma unroll
            for (int j = 0; j < 16; ++j) { const int idx = F.tid + 512 * j; *(pg8::f32x4*)(W2 + idx * 4) = *(const pg8::f32x4*)(w2 + idx * 4); }
            w2_of = kvi;
        }
        { const int r = F.tid >> 6, c = (F.tid & 63) * 4;
            pg8::f32x4 s = {0.f, 0.f, 0.f, 0.f};
#pragma unroll
            for (int sp = 0; sp < 8; ++sp) s += *(const pg8::f32x4*)(part + (((size_t)sp * 2 + kvi) * 1024 + r0 + r) * 256 + c);
#pragma unroll
            for (int sp = 0; sp < 32; ++sp) s += *(const pg8::f32x4*)(bias1p + (sp * 2 + kvi) * 256 + c);
            H[r * 260 + c] = gelu_tanh(s[0]); H[r * 260 + c + 1] = gelu_tanh(s[1]); H[r * 260 + c + 2] = gelu_tanh(s[2]); H[r * 260 + c + 3] = gelu_tanh(s[3]); }
        __syncthreads();
        const int r = F.tid >> 6, c0 = (F.tid & 63) * 2;
        float a0 = 0.f, a1 = 0.f;
#pragma unroll 16
        for (int k = 0; k < 256; ++k) { const float hv = H[r * 260 + k]; const float2 wv = *(const float2*)(W2 + k * 128 + c0); a0 += hv * wv.x; a1 += hv * wv.y; }
        const int R = r0 + r; const bool pad = (R & 127) == 127;
        *(unsigned*)(ckv + ((size_t)kvi * 1024 + R) * 128 + c0) = pad ? 0u : pg8::cvt_pk_bf16(a0, a1);
    }
}

struct CmpOrder {
    const char* kc; const char* w1t; int c;
    __device__ __forceinline__ bool next(int i, pg8::Unit& u) const { if (i > 0) return false; u.e = c >> 5; u.pm = (c >> 3) & 3; u.pn = c & 7; u.li = 0; return true; }
    __device__ __forceinline__ const char* a_base(const pg8::Unit& u) const { return kc + (size_t)u.e * 4 * MB + ((size_t)u.pm * 256 * 2048 + u.pn * 512) * 2; }
    __device__ __forceinline__ const char* b_base(const pg8::Unit& u) const { return w1t + ((size_t)u.e * 256 * 4096 + u.pn * 512) * 2; }
    __device__ __forceinline__ unsigned a_row_off(const pg8::Unit&, int r) const { return (unsigned)r * 4096u; }
};
struct EpiCmp {
    static constexpr bool AFTER_DRAIN = false;
    float* part;
    __device__ __forceinline__ void operator()(const pg8::f32x4 (&acc)[2][2][4][2], const pg8::Unit& un, int wr, int wc, int fr, int fq) const {
        float* base = part + (((size_t)un.pn * 2 + un.e) * 1024 + un.pm * 256) * 256;
#pragma unroll
        for (int ai = 0; ai < 2; ++ai)
#pragma unroll
            for (int m = 0; m < 4; ++m) { float* rowp = base + (size_t)(ai * 128 + wr * 64 + m * 16 + fr) * 256 + wc * 32 + 4 * fq;
#pragma unroll
                for (int bj = 0; bj < 2; ++bj)
#pragma unroll
                    for (int n = 0; n < 2; ++n) *(pg8::f32x4*)(rowp + bj * 128 + n * 16) = acc[ai][bj][m][n]; }
    }
};
struct PoolOrder {
    const char* d; const char* wpt; int c;
    __device__ __forceinline__ bool next(int i, pg8::Unit& u) const { if (i > 0) return false; u.pm = c >> 2; u.pn = 0; u.e = c & 3; u.li = 0; return true; }
    __device__ __forceinline__ const char* a_base(const pg8::Unit& u) const { return d + ((size_t)u.pm * 256 * 1024 + u.e * 256) * 2; }
    __device__ __forceinline__ const char* b_base(const pg8::Unit& u) const { return wpt + (size_t)u.e * 256 * 256 * 2; }
    __device__ __forceinline__ unsigned a_row_off(const pg8::Unit&, int r) const { return (unsigned)r * 2048u; }
};
struct EpiPool {
    static constexpr bool AFTER_DRAIN = false;
    const float* pb; bf16_t* opool;
    __device__ __forceinline__ void operator()(const pg8::f32x4 (&acc)[2][2][4][2], const pg8::Unit& un, int wr, int wc, int fr, int fq) const {
#pragma unroll
        for (int ai = 0; ai < 2; ++ai)
#pragma unroll
            for (int m = 0; m < 4; ++m) { const int row = un.pm * 256 + ai * 128 + wr * 64 + m * 16 + fr;
#pragma unroll
                for (int bj = 0; bj < 2; ++bj)
#pragma unroll
                    for (int n = 0; n < 2; ++n) { const int c = un.e * 256 + bj * 128 + wc * 32 + n * 16 + 4 * fq;
                        const pg8::f32x4 v = acc[ai][bj][m][n] + *(const pg8::f32x4*)(pb + c); uint2 w_; w_.x = pg8::cvt_pk_bf16(v[0], v[1]); w_.y = pg8::cvt_pk_bf16(v[2], v[3]);
                        *(uint2*)(opool + (size_t)row * 1024 + c) = w_; } }
    }
};
__device__ __forceinline__ void p2a_mid(const Frame& F, LAS unsigned char* stage) {
    if (F.bid < 64) {
        CmpOrder S{(const char*)(F.ws + WS_KV), (const char*)(F.ws + WS_CMPW), F.bid};
        EpiCmp E{(float*)(F.ws + WS_CPART)};
        pg8::gemm_phase<EpiCmp, CmpOrder, false>(stage, 512, 2048, 4096, S, E);
    } else {
        const bf16_t* u = (const bf16_t*)(F.ws + WS_U); bf16_t* d = (bf16_t*)(F.ws + WS_DBUF);
        for (int ch = F.bid - 64; ch < NT / 16; ch += F.G - 64) {
            const int r0 = ch * 16, s0 = r0 & 2047, col = 2 * F.tid, w = 2 << (col >> 8);
            float u0[31], u1[31];
#pragma unroll
            for (int q = 0; q < 31; ++q) { const int s = s0 - 15 + q; const unsigned pr = (s >= 0) ? *(const unsigned*)(u + (size_t)(r0 - 15 + q) * 1024 + col) : 0u;
                u0[q] = __uint_as_float(pr << 16); u1[q] = __uint_as_float(pr & 0xFFFF0000u); }
#pragma unroll
            for (int i = 0; i < 16; ++i) { float sa = 0.f, sb = 0.f;
#pragma unroll
                for (int q = 0; q < 16; ++q) if (q < w) { sa += u0[15 + i - q]; sb += u1[15 + i - q]; }
                const int s = s0 + i, cnt = (s + 1 < w) ? s + 1 : w; const float ic = 1.f / (float)cnt;
                *(unsigned*)(d + (size_t)(r0 + i) * 1024 + col) = pg8::cvt_pk_bf16(sa * ic - u0[15 + i], sb * ic - u1[15 + i]); }
        }
        p0_tables(F, F.bid - 64, F.G - 64);
    }
}
__device__ __forceinline__ void p2b_mid(const Frame& F, LAS unsigned char* stage) {
    if (F.bid < 128) {
        PoolOrder S{(const char*)(F.ws + WS_DBUF), (const char*)(F.ws + WS_POOLW), F.bid};
        EpiPool E{(const float*)(F.ws + WS_POOLB), (bf16_t*)(F.ws + WS_OPOOL)};
        pg8::gemm_phase<EpiPool, PoolOrder, false>(stage, 256, 1024, 256, S, E);
    } else {
        p4_cmp2(F, F.bid - 128, F.G - 128, false);
        cvt_stream(F, 6144, 6400, nullptr, F.bid - 128, F.G - 128);
    }
}

__device__ __forceinline__ void unpack8(const pg8::u32x4 w, float (&f)[8]) {
    f[0] = __uint_as_float(w.x << 16); f[1] = __uint_as_float(w.x & 0xFFFF0000u); f[2] = __uint_as_float(w.y << 16); f[3] = __uint_as_float(w.y & 0xFFFF0000u);
    f[4] = __uint_as_float(w.z << 16); f[5] = __uint_as_float(w.z & 0xFFFF0000u); f[6] = __uint_as_float(w.w << 16); f[7] = __uint_as_float(w.w & 0xFFFF0000u);
}
__device__ __forceinline__ void p6_mix(const Frame& F) {
    const bf16_t* ocmp = (const bf16_t*)(F.ws + WS_OCMP); const bf16_t* owin = (const bf16_t*)(F.ws + WS_OWIN); const bf16_t* osel = (const bf16_t*)(F.ws + WS_OSEL);
    const float* ml = (const float*)(F.ws + WS_ML); const float* gates = (const float*)(F.ws + WS_GATES);
    const bf16_t* opool = (const bf16_t*)(F.ws + WS_OPOOL); bf16_t* mix = (bf16_t*)(F.ws + WS_MIX);
    const float* gn = F.in[I_GNNSA]; const float* gp = F.in[I_GNPOOL];
    const int gw = F.bid * NWAVES + F.wave, nw = F.G * NWAVES, lane = F.lane, h = lane >> 3;
    for (int r = gw; r < NT; r += nw) {
        const bool split = ((r & 2047) >> 6) >= 16;
        const size_t o = (size_t)r * 1024 + lane * 16;
        const float* gq = gates + (size_t)r * 24 + h * 3;
        const float g0 = 1.f / (1.f + __expf(-gq[0])), g1 = 1.f / (1.f + __expf(-gq[1])), g2 = 1.f / (1.f + __expf(-gq[2]));
        float w0 = 1.f, w1 = 0.f;
        if (split) { const float* m0p = ml + ((size_t)r * NH + h) * 2; const float* m1p = ml + (((size_t)NT + r) * NH + h) * 2;
            const float m0 = m0p[0], l0 = m0p[1], m1 = m1p[0], l1 = m1p[1], M = fmaxf(m0, m1);
            const float a0 = l0 * exp2f((m0 - M) * att::C2), a1 = l1 * exp2f((m1 - M) * att::C2), inv = 1.f / (a0 + a1); w0 = a0 * inv; w1 = a1 * inv; }
        float a[16], p[16]; float sa = 0.f, sp = 0.f;
#pragma unroll
        for (int hf = 0; hf < 2; ++hf) {
            float c8[8], w8[8], s8[8], t8[8];
            unpack8(*(const pg8::u32x4*)(ocmp + o + hf * 8), c8); unpack8(*(const pg8::u32x4*)(owin + o + hf * 8), w8); unpack8(*(const pg8::u32x4*)(osel + o + hf * 8), s8);
            if (split) unpack8(*(const pg8::u32x4*)(osel + (size_t)NT * 1024 + o + hf * 8), t8);
#pragma unroll
            for (int j = 0; j < 8; ++j) { const float os = split ? (w0 * s8[j] + w1 * t8[j]) : s8[j]; a[hf * 8 + j] = g0 * c8[j] + g1 * os + g2 * w8[j]; sa += a[hf * 8 + j] * a[hf * 8 + j]; }
        }
#pragma unroll
        for (int q = 0; q < 2; ++q) { float p8[8]; unpack8(*(const pg8::u32x4*)(opool + o + q * 8), p8);
#pragma unroll
            for (int j = 0; j < 8; ++j) { p[q * 8 + j] = p8[j]; sp += p8[j] * p8[j]; } }
        sa = wave_sum(sa); sp = wave_sum(sp);
        const float ra = rsqrtf(sa * (1.f / 1024.f) + EPS), rp = rsqrtf(sp * (1.f / 1024.f) + EPS);
        float ga[16], gb[16];
#pragma unroll
        for (int q = 0; q < 4; ++q) { const pg8::f32x4 v = *(const pg8::f32x4*)(gn + lane * 16 + q * 4), u = *(const pg8::f32x4*)(gp + lane * 16 + q * 4);
            ga[q * 4] = v[0]; ga[q * 4 + 1] = v[1]; ga[q * 4 + 2] = v[2]; ga[q * 4 + 3] = v[3]; gb[q * 4] = u[0]; gb[q * 4 + 1] = u[1]; gb[q * 4 + 2] = u[2]; gb[q * 4 + 3] = u[3]; }
#pragma unroll
        for (int hf = 0; hf < 2; ++hf) { pg8::u32x4 wa, wb;
            wa.x = pg8::cvt_pk_bf16(a[hf * 8] * ra * ga[hf * 8], a[hf * 8 + 1] * ra * ga[hf * 8 + 1]); wa.y = pg8::cvt_pk_bf16(a[hf * 8 + 2] * ra * ga[hf * 8 + 2], a[hf * 8 + 3] * ra * ga[hf * 8 + 3]);
            wa.z = pg8::cvt_pk_bf16(a[hf * 8 + 4] * ra * ga[hf * 8 + 4], a[hf * 8 + 5] * ra * ga[hf * 8 + 5]); wa.w = pg8::cvt_pk_bf16(a[hf * 8 + 6] * ra * ga[hf * 8 + 6], a[hf * 8 + 7] * ra * ga[hf * 8 + 7]);
            wb.x = pg8::cvt_pk_bf16(p[hf * 8] * rp * gb[hf * 8], p[hf * 8 + 1] * rp * gb[hf * 8 + 1]); wb.y = pg8::cvt_pk_bf16(p[hf * 8 + 2] * rp * gb[hf * 8 + 2], p[hf * 8 + 3] * rp * gb[hf * 8 + 3]);
            wb.z = pg8::cvt_pk_bf16(p[hf * 8 + 4] * rp * gb[hf * 8 + 4], p[hf * 8 + 5] * rp * gb[hf * 8 + 5]); wb.w = pg8::cvt_pk_bf16(p[hf * 8 + 6] * rp * gb[hf * 8 + 6], p[hf * 8 + 7] * rp * gb[hf * 8 + 7]);
            *(pg8::u32x4*)(mix + (size_t)r * DM + lane * 16 + hf * 8) = wa; *(pg8::u32x4*)(mix + (size_t)r * DM + 1024 + lane * 16 + hf * 8) = wb; }
    }
}

struct EpiOut {
    static constexpr bool AFTER_DRAIN = true;
    const float* x; float* out; bf16_t* x1b; const float* lnm; const float* wrp; float* pl;
    __device__ __forceinline__ void fused(pg8::f32x4 (&acc)[2][2][4][2], const pg8::Unit& un, int wr, int wc, int fr, int fq, LAS unsigned char* lds) const {
#pragma unroll
        for (int ai = 0; ai < 2; ++ai)
#pragma unroll
            for (int m = 0; m < 4; ++m) {
                const int row = un.pm * 256 + ai * 128 + wr * 64 + m * 16 + fr;
#pragma unroll
                for (int bj = 0; bj < 2; ++bj)
#pragma unroll
                    for (int n = 0; n < 2; ++n) {
                        const size_t o = (size_t)row * DM + un.pn * 256 + bj * 128 + wc * 32 + n * 16 + 4 * fq;
                        const pg8::f32x4 v = acc[ai][bj][m][n] + *(const pg8::f32x4*)(x + o);
                        acc[ai][bj][m][n] = v;
                        const pg8::f32x4 g = *(const pg8::f32x4*)(lnm + un.pn * 256 + bj * 128 + wc * 32 + n * 16 + 4 * fq);
                        uint2 w; w.x = pg8::cvt_pk_bf16(v[0] * g[0], v[1] * g[1]); w.y = pg8::cvt_pk_bf16(v[2] * g[2], v[3] * g[3]); *(uint2*)(x1b + o) = w;
                    }
            }
        float* red = (float*)((unsigned char*)lds);
        const int tid = threadIdx.x;
#pragma unroll 1
        for (int ai = 0; ai < 2; ++ai) {
#pragma unroll
            for (int m = 0; m < 4; ++m) {
                pg8::f32x4 D0 = {0.f, 0.f, 0.f, 0.f}, D1 = D0, D2 = D0; float s2 = 0.f;
#pragma unroll
                for (int bj = 0; bj < 2; ++bj)
#pragma unroll
                    for (int n = 0; n < 2; ++n) {
                        const pg8::f32x4 v = (ai == 0) ? acc[0][bj][m][n] : acc[1][bj][m][n];
                        s2 += v[0] * v[0] + v[1] * v[1] + v[2] * v[2] + v[3] * v[3];
                        const float* wb = wrp + (size_t)(un.pn * 256 + bj * 128 + wc * 32 + n * 16 + 4 * fq) * 48 + fr;
#pragma unroll
                        for (int j = 0; j < 4; ++j) {
                            D0 = __builtin_amdgcn_mfma_f32_16x16x4f32(v[j], wb[j * 48], D0, 0, 0, 0);
                            D1 = __builtin_amdgcn_mfma_f32_16x16x4f32(v[j], wb[j * 48 + 16], D1, 0, 0, 0);
                            D2 = __builtin_amdgcn_mfma_f32_16x16x4f32(v[j], wb[j * 48 + 32], D2, 0, 0, 0);
                        }
                    }
                s2 += __shfl_xor(s2, 16); s2 += __shfl_xor(s2, 32);
                float* rr = red + ((size_t)wc * 128 + wr * 64 + m * 16) * 40;
#pragma unroll
                for (int r = 0; r < 4; ++r) { float* q = rr + (4 * fq + r) * 40; q[fr] = D0[r]; q[16 + fr] = D1[r]; if (fr < 8) q[32 + fr] = D2[r]; }
                if (fq == 0) rr[fr * 40 + 36] = s2;
            }
            __syncthreads();
            for (int idx = tid; idx < 128 * 40; idx += 512) { const int r = idx / 40, c = idx - r * 40;
                const float s = (red[idx] + red[128 * 40 + idx]) + (red[2 * 128 * 40 + idx] + red[3 * 128 * 40 + idx]);
                if (c < 37) __hip_atomic_store(&pl[((size_t)un.pn * NT + un.pm * 256 + ai * 128 + r) * 40 + c], s, __ATOMIC_RELAXED, __HIP_MEMORY_SCOPE_AGENT); }
            __syncthreads();
        }
    }
};
__device__ __forceinline__ void p8_router(const Frame& F, int dummy, int wv0 = -1, int wv1 = NT / 8, int wstep = 0) {
    const float* pl = (const float*)(F.ws + WS_PL); const float* brg = F.in[I_BRG]; const float* bre = F.in[I_BRE];
    float* rstd2 = (float*)(F.ws + WS_RSTD2); int* arow = (int*)(F.ws + WS_AROW); int* tokl = (int*)(F.ws + WS_TOKL); float* gatel = (float*)(F.ws + WS_GATEL);
    unsigned* cnt = (unsigned*)(F.ws + WS_CTL) + (dummy ? 12288 : CW_CNT);
    const int gw = wv0 < 0 ? F.bid * NWAVES + F.wave : wv0 + F.wave, nw = wv0 < 0 ? F.G * NWAVES : wstep, lane = fresh_lane(), tl = lane >> 3, pn = lane & 7;
    for (int wv = gw; wv < wv1; wv += nw) {
        const int r = wv * 8 + tl;
        const float* p = pl + ((size_t)pn * NT + r) * 40;
        float v[37];
#pragma unroll
        for (int q = 0; q < 9; ++q) { const pg8::f32x4 t = *(const pg8::f32x4*)(p + 4 * q); v[4 * q] = t[0]; v[4 * q + 1] = t[1]; v[4 * q + 2] = t[2]; v[4 * q + 3] = t[3]; }
        v[36] = p[36];
#pragma unroll
        for (int c = 0; c < 37; ++c) { v[c] += __shfl_xor(v[c], 1); v[c] += __shfl_xor(v[c], 2); v[c] += __shfl_xor(v[c], 4); }
        if (pn == 0) {
            const float rs = rsqrtf(v[36] * (1.f / DM) + EPS);
            float lg[4];
#pragma unroll
            for (int j = 0; j < 4; ++j) lg[j] = v[32 + j] * rs + brg[j];
            int gs = 0; float gm = lg[0];
#pragma unroll
            for (int j = 1; j < 4; ++j) if (lg[j] > gm) { gm = lg[j]; gs = j; }
            float den = 0.f;
#pragma unroll
            for (int j = 0; j < 4; ++j) den += __expf(lg[j] - gm);
            const float pg = 1.f / den;
            float le[8];
#pragma unroll
            for (int j = 0; j < 8; ++j) { const float s = (gs == 0) ? v[j] : (gs == 1) ? v[8 + j] : (gs == 2) ? v[16 + j] : v[24 + j]; le[j] = s * rs + bre[gs * 8 + j]; }
            int e0 = 0; float m0 = le[0];
#pragma unroll
            for (int j = 1; j < 8; ++j) if (le[j] > m0) { m0 = le[j]; e0 = j; }
            int e1 = -1; float m1 = -3.0e38f;
#pragma unroll
            for (int j = 0; j < 8; ++j) if (j != e0 && le[j] > m1) { m1 = le[j]; e1 = j; }
            const float p1 = __expf(m1 - m0);
            const float gate0 = pg / (1.f + p1), gate1 = pg * p1 / (1.f + p1);
            rstd2[r] = rs;
            const int ea = gs * 8 + e0, eb = gs * 8 + e1;
            const unsigned sa = atomicAdd(&cnt[64 * ea], 1u), sb = atomicAdd(&cnt[64 * eb], 1u);
            tokl[ea * 8192 + sa] = r; gatel[ea * 8192 + sa] = gate0; tokl[eb * 8192 + sb] = r; gatel[eb * 8192 + sb] = gate1;
            arow[2 * r] = ea * 8192 + (int)sa; arow[2 * r + 1] = eb * 8192 + (int)sb;
        }
    }
}

constexpr int CW_PANEL = 12288 + 2048;
constexpr bool ROUTER_FUSED_OK = true;
__device__ __forceinline__ bool router_fused(const Frame& F) { return ROUTER_FUSED_OK && F.G == (NT / 256) * (DM / 256); }
__device__ __forceinline__ void p7_out(const Frame& F, LAS unsigned char* stage, unsigned char* lds_raw) {
    pg8::DenseOrder S; S.init(F.ws + WS_MIX, F.ws + WS_WOUTT, DM, DM, NT, DM, F.G, F.bid);
    EpiOut E{F.in[I_X], F.out, (bf16_t*)(F.ws + WS_X1B), F.in[I_LNMOE], (const float*)(F.ws + WS_WRP), (float*)(F.ws + WS_PL)};
    pg8::gemm_phase<EpiOut, pg8::DenseOrder, false>(stage, DM, DM, DM, S, E);
    if (router_fused(F)) {
        pg8::Unit u; (void)S.next(0, u);
        asm volatile("s_waitcnt vmcnt(0)" ::: "memory");
        __syncthreads();
        volatile LAS int* lastw = (volatile LAS int*)((LAS unsigned char*)lds_raw + 32);
        if (F.wave == 0 && fresh_lane() == 0) {
            const unsigned old = __hip_atomic_fetch_add((unsigned*)(F.ws + WS_CTL) + CW_PANEL + 64 * u.pm, 1u, __ATOMIC_RELAXED, __HIP_MEMORY_SCOPE_AGENT);
            if (old == 7u) { __builtin_amdgcn_fence(__ATOMIC_ACQUIRE, "agent"); asm volatile("s_waitcnt vmcnt(0)" ::: "memory"); }
            lastw[0] = (old == 7u) ? 1 : 0;
        }
        __syncthreads();
        if (lastw[0]) p8_router(F, 0, u.pm * 32, u.pm * 32 + 32, NWAVES);
    }
}

__device__ __forceinline__ void moe_counts(const Frame& F, int* cnts  , int* pst  ) {
    const unsigned* cnt = (const unsigned*)(F.ws + WS_CTL) + CW_CNT;
    __syncthreads();
    if (F.tid < 32) cnts[F.tid] = (int)__hip_atomic_load(&cnt[64 * F.tid], __ATOMIC_RELAXED, __HIP_MEMORY_SCOPE_AGENT);
    __syncthreads();
    if (F.tid == 0) { int a = 0; for (int e = 0; e < 32; ++e) { pst[e] = a; a += (cnts[e] + 255) & ~255; } pst[32] = a; }
    __syncthreads();
}

constexpr int MOE_TAB_OFF = 1024 + 131072;
struct MoeTabs { int* cnts; int* pst; int* ust; int* usth; int* rowtok; };
__device__ __forceinline__ MoeTabs moe_tabs(unsigned char* lds_raw) { MoeTabs T; T.cnts = (int*)(lds_raw + MOE_TAB_OFF); T.pst = T.cnts + 32; T.ust = T.pst + 40; T.usth = T.ust + 40; T.rowtok = T.usth + 40; return T; }
template <int NTN> __device__ __forceinline__ void moe_units(const Frame& F, const MoeTabs& T) {
    moe_counts(F, T.cnts, T.pst);
    if (F.tid == 0) { int a = 0, h = 0; for (int e = 0; e < 32; ++e) { const int c = T.cnts[e], nmt = (c + 255) >> 8, hl = (nmt > 0 && c - 256 * (nmt - 1) <= 128) ? 1 : 0;
            T.ust[e] = a; T.usth[e] = h; a += (nmt - hl) * NTN; h += hl * NTN; } T.ust[32] = a; T.usth[32] = h; }
    __syncthreads();
}
template <int NTN> struct MoeOrder2 {
    const int* cnts; const int* pst; const int* ust; const int* usth; const int* rowtok; const bf16_t* A; const float* W0; const float* W1; int G, c, lda, ldb, gather, narrow;
    __device__ __forceinline__ bool next(int i, g2::Unit& u) const {
        int L = i * G + c; u.li = i;
        if (L < ust[32]) {
            int e = 0; while (ust[e + 1] <= L) ++e;
            const int w = L - ust[e], c_ = cnts[e], nmt = (c_ + 255) >> 8, nf = nmt - ((c_ - 256 * (nmt - 1) <= 128) ? 1 : 0);
            u.e = e; u.pn = w / nf; u.pm = w - u.pn * nf; u.half = 0; return true; }
        L -= ust[32];
        const int Lh = narrow ? (L >> 1) : L; if (Lh >= usth[32]) return false;
        int e = 0; while (usth[e + 1] <= Lh) ++e;
        u.e = e; u.pn = Lh - usth[e]; u.pm = ((cnts[e] + 255) >> 8) - 1; u.half = narrow ? 2 + (L & 1) : 1; return true;
    }
    __device__ __forceinline__ int nvalid(const g2::Unit& u) const { const int v = cnts[u.e] - u.pm * 256; return v < 256 ? v : 256; }
    __device__ __forceinline__ unsigned a_off(const g2::Unit& u, int r) const {
        if (gather) { const int tk = rowtok[u.li * 256 + r]; return (unsigned)(tk < 0 ? 0 : tk) * (unsigned)lda * 2u; }
        return (unsigned)(pst[u.e] + u.pm * 256 + r) * (unsigned)lda * 2u;
    }
    __device__ __forceinline__ const float* b_col(const g2::Unit& u, int col) const {
        if (gather) { const int wcp = col >> 5, n = (col >> 4) & 1, i = col & 15; return (n ? W1 : W0) + (size_t)u.e * DM * FF + u.pn * 64 + 16 * wcp + i; }
        return W0 + (size_t)u.e * FF * DM + u.pn * 128 + col;
    }
};
struct EpiMoe1 {
    const int* pst; const int* rowtok; const float* rstd2; bf16_t* act;
    __device__ __forceinline__ void operator()(const pg8::f32x4 (&acc)[2][4][2], const g2::Unit& un, int wr, int wc, int fr, int fq) const {
        if (un.half >= 2 && (wc >> 1) != (un.half & 1)) return;
#pragma unroll
        for (int ai = 0; ai < 2; ++ai)
#pragma unroll
            for (int m = 0; m < 4; ++m) {
                const int r = ai * 128 + wr * 64 + m * 16 + fr; const int tk = rowtok[un.li * 256 + r];
                if (tk >= 0) {
                    const float rs = rstd2[tk];
                    const pg8::f32x4 vg = acc[ai][m][0] * rs, vu = acc[ai][m][1] * rs; float o[4];
#pragma unroll
                    for (int j = 0; j < 4; ++j) o[j] = vg[j] / (1.f + __expf(-vg[j])) * vu[j];
                    uint2 w; w.x = pg8::cvt_pk_bf16(o[0], o[1]); w.y = pg8::cvt_pk_bf16(o[2], o[3]);
                    *(uint2*)(act + (size_t)(pst[un.e] + un.pm * 256 + r) * FF + un.pn * 64 + wc * 16 + 4 * fq) = w;
                }
            }
    }
};
struct EpiMoe2 {
    const int* cnts; const int* pst; const float* gatel; bf16_t* y;
    __device__ __forceinline__ void operator()(const pg8::f32x4 (&acc)[2][4][2], const g2::Unit& un, int wr, int wc, int fr, int fq) const {
#pragma unroll
        for (int ai = 0; ai < 2; ++ai)
#pragma unroll
            for (int m = 0; m < 4; ++m) {
                const int slot = un.pm * 256 + ai * 128 + wr * 64 + m * 16 + fr;
                if (slot < cnts[un.e]) {
                    const float gt = gatel[un.e * 8192 + slot];
                    bf16_t* dst = y + (size_t)(pst[un.e] + slot) * DM + un.pn * 128 + wc * 32 + 4 * fq;
#pragma unroll
                    for (int n = 0; n < 2; ++n) { const pg8::f32x4 v = acc[ai][m][n] * gt; uint2 w; w.x = pg8::cvt_pk_bf16(v[0], v[1]); w.y = pg8::cvt_pk_bf16(v[2], v[3]); *(uint2*)(dst + n * 16) = w; }
                }
            }
    }
};

__device__ __forceinline__ void p9_moe1(const Frame& F, unsigned char* lds_raw, LAS unsigned char* stage) {
    const MoeTabs T = moe_tabs(lds_raw);
    moe_units<8>(F, T);
    const int vc = (F.G % 8 == 0) ? (F.bid % 8) * (F.G / 8) + F.bid / 8 : F.bid;
    MoeOrder2<8> S{T.cnts, T.pst, T.ust, T.usth, T.rowtok, (const bf16_t*)(F.ws + WS_X1B), F.in[I_WGATE], F.in[I_WUP], F.G, vc, DM, FF, 1, 1};
    { const int* tokl = (const int*)(F.ws + WS_TOKL); g2::Unit u;
      for (int i = 0; i < 4 && S.next(i, u); ++i) { if (F.tid < 256) { const int slot = u.pm * 256 + F.tid; T.rowtok[i * 256 + F.tid] = slot < T.cnts[u.e] ? tokl[u.e * 8192 + slot] : -1; } } }
    asm volatile("s_waitcnt vmcnt(0) lgkmcnt(0)" ::: "memory");
    __syncthreads();
    EpiMoe1 E{T.pst, T.rowtok, (const float*)(F.ws + WS_RSTD2), (bf16_t*)(F.ws + WS_ACT)};
    g2::gemm<DM / 64, EpiMoe1, MoeOrder2<8>>(stage, S, E, F.wave, (PROBE_REPEAT >= 30 && PROBE_REPEAT <= 33) ? (unsigned long long*)(lds_raw + 512) : nullptr);
}

__device__ __forceinline__ void p10_moe2(const Frame& F, unsigned char* lds_raw, LAS unsigned char* stage) {
    const MoeTabs T = moe_tabs(lds_raw);
    moe_units<16>(F, T);
    const int vc = (F.G % 8 == 0) ? (F.bid % 8) * (F.G / 8) + F.bid / 8 : F.bid;
    MoeOrder2<16> S{T.cnts, T.pst, T.ust, T.usth, nullptr, (const bf16_t*)(F.ws + WS_ACT), F.in[I_WDOWN], nullptr, F.G, vc, FF, DM, 0, 0};
    EpiMoe2 E{T.cnts, T.pst, (const float*)(F.ws + WS_GATEL), (bf16_t*)(F.ws + WS_Y)};
    g2::gemm<FF / 64, EpiMoe2, MoeOrder2<16>>(stage, S, E, F.wave);
}

__device__ __forceinline__ void p11_final(const Frame& F, int dummy) {
    int* cnts = (int*)(F.lds + 3072); int* pst = cnts + 32;
    moe_counts(F, cnts, pst);
    const bf16_t* y = (const bf16_t*)(F.ws + WS_Y); const int* arow = (const int*)(F.ws + WS_AROW); const float* lnf = F.in[I_LNFINAL];
    const int gw = F.bid * NWAVES + F.wave, nw = F.G * NWAVES, lane = fresh_lane();
    const bf16_t* x1b = (const bf16_t*)(F.ws + WS_X1B); const float* lnm = F.in[I_LNMOE];
    float4 ig[8];
#pragma unroll
    for (int i = 0; i < 8; ++i) { const float4 g = *(const float4*)(lnm + i * 256 + lane * 4); ig[i].x = 1.f / g.x; ig[i].y = 1.f / g.y; ig[i].z = 1.f / g.z; ig[i].w = 1.f / g.w; }
    for (int r = gw; r < NT; r += nw) {
        const int a0 = arow[2 * r], a1 = arow[2 * r + 1];
        const size_t r0 = (size_t)(pst[a0 >> 13] + (a0 & 8191)), r1 = (size_t)(pst[a1 >> 13] + (a1 & 8191));
        float v[32]; float ss = 0.f;
#pragma unroll
        for (int i = 0; i < 8; ++i) { const int c = i * 256 + lane * 4; const uint2 xq = *(const uint2*)(x1b + (size_t)r * DM + c);
            float4 xv; xv.x = __uint_as_float(xq.x << 16) * ig[i].x; xv.y = __uint_as_float(xq.x & 0xFFFF0000u) * ig[i].y; xv.z = __uint_as_float(xq.y << 16) * ig[i].z; xv.w = __uint_as_float(xq.y & 0xFFFF0000u) * ig[i].w;
            const uint2 ya = *(const uint2*)(y + r0 * DM + c), yb = *(const uint2*)(y + r1 * DM + c);
            v[4 * i]     = xv.x + __uint_as_float(ya.x << 16) + __uint_as_float(yb.x << 16);
            v[4 * i + 1] = xv.y + __uint_as_float(ya.x & 0xFFFF0000u) + __uint_as_float(yb.x & 0xFFFF0000u);
            v[4 * i + 2] = xv.z + __uint_as_float(ya.y << 16) + __uint_as_float(yb.y << 16);
            v[4 * i + 3] = xv.w + __uint_as_float(ya.y & 0xFFFF0000u) + __uint_as_float(yb.y & 0xFFFF0000u);
            ss += v[4 * i] * v[4 * i] + v[4 * i + 1] * v[4 * i + 1] + v[4 * i + 2] * v[4 * i + 2] + v[4 * i + 3] * v[4 * i + 3]; }
        ss = wave_sum(ss);
        const float rs = rsqrtf(ss * (1.f / DM) + EPS);
#pragma unroll
        for (int i = 0; i < 8; ++i) { const int c = i * 256 + lane * 4; const float4 g = *(const float4*)(lnf + c);
            float4 o; o.x = v[4 * i] * rs * g.x; o.y = v[4 * i + 1] * rs * g.y; o.z = v[4 * i + 2] * rs * g.z; o.w = v[4 * i + 3] * rs * g.w;
            *(float4*)((dummy ? (float*)(F.ws + WS_W1T) : F.out) + (size_t)r * DM + c) = o; }
    }
}

constexpr int NPHASE = 11;
__global__ void __launch_bounds__(NTHREADS, 2) fwd(Args args) {
    extern __shared__ __attribute__((aligned(16))) unsigned char lds_raw[];
    Frame F;
#pragma unroll
    for (int i = 0; i < N_IN; ++i) F.in[i] = args.in[i];
    F.out = args.out; F.ws = args.ws;
    F.lds = (float*)(lds_raw + 16);
    F.tid = threadIdx.x; F.lane = F.tid & 63; F.wave = __builtin_amdgcn_readfirstlane(F.tid >> 6); F.G = gridDim.x; F.bid = blockIdx.x;
    if (F.tid < 4) ((LAS unsigned*)lds_raw)[F.tid] = 0u;
    __syncthreads();
    XcdBarrier bar; bar.bar = (unsigned*)(F.ws + WS_CTL); bar.x = 0; bar.st = nullptr;
    if (N_LAUNCHES == 1) bar = xcd_barrier_post((unsigned*)(F.ws + WS_CTL), (volatile LAS unsigned*)lds_raw);
    bar.wave = F.wave;
    const int lo = args.ph_lo, hi = args.ph_hi;
#ifndef ONLY_PHASE
#define ONLY_PHASE -1
#endif
#define IN(k) (lo <= (k) && (k) < hi && (ONLY_PHASE < 0 || ONLY_PHASE == (k)))
#define SEAM(k) do { if (IN(k) && IN((k) + 1)) { const unsigned long long tb_ = (PROBE_REPEAT >= 40) ? (unsigned long long)__builtin_readcyclecounter() : 0ull; xcd_barrier(bar); if (PROBE_REPEAT == 12) xcd_barrier(bar); \
        if (PROBE_REPEAT == 40 || PROBE_REPEAT == 41 + (k)) tbar += (unsigned long long)__builtin_readcyclecounter() - tb_; if (PROBE_REPEAT == 60 + (k)) tbar = (unsigned long long)__builtin_readcyclecounter() - t_k0; } } while (0)
    unsigned long long tbar = 0ull; const unsigned long long t_k0 = (PROBE_REPEAT >= 60) ? (unsigned long long)__builtin_readcyclecounter() : 0ull;
    LAS unsigned char* stage = (LAS unsigned char*)lds_raw + 1024;
#define RUN(k, ...) do { if (IN(k)) { __VA_ARGS__; if (PROBE_REPEAT == (k)) { xcd_barrier(bar); __VA_ARGS__; } } } while (0)
    RUN(0, p0_prologue(F));
    if (PROBE_REPEAT == 11 && IN(0)) { xcd_barrier(bar); cvt_stream(F, 0, 6400, nullptr); }
    SEAM(0);
    RUN(1, p1_proj(F, stage));
    SEAM(1);
    RUN(2, p2a_mid(F, stage));
    SEAM(2);
    RUN(3, p2b_mid(F, stage));
    SEAM(3);
    if (IN(4)) {
#pragma unroll 1
        for (int rep = 0; rep < (PROBE_REPEAT == 4 ? 2 : 1); ++rep) { if (rep) xcd_barrier(bar); p_attn(F, lds_raw, rep); } }
    SEAM(4);
    RUN(5, p6_mix(F));
    SEAM(5);
    RUN(6, p7_out(F, stage, lds_raw));
    if (!router_fused(F)) { SEAM(6);
        if (IN(7)) p8_router(F, 0); }
    SEAM(7);
#define REFRESH_LANE() do { F.lane = fresh_lane(); F.tid = F.wave * 64 + F.lane; } while (0)
    REFRESH_LANE();
    if (IN(8)) {
#pragma unroll 1
        for (int rep = 0; rep < (PROBE_REPEAT == 8 ? 2 : 1); ++rep) { if (rep) xcd_barrier(bar); p9_moe1(F, lds_raw, stage); } }
    SEAM(8);
    REFRESH_LANE();
    if (IN(9)) {
#pragma unroll 1
        for (int rep = 0; rep < (PROBE_REPEAT == 9 ? 2 : 1); ++rep) { if (rep) xcd_barrier(bar); p10_moe2(F, lds_raw, stage); } }
    SEAM(9);
    REFRESH_LANE();
    if (IN(10)) { if (PROBE_REPEAT == 10) { p11_final(F, 1); xcd_barrier(bar); } const unsigned long long tf0 = (PROBE_REPEAT == 70) ? (unsigned long long)__builtin_readcyclecounter() : 0ull; p11_final(F, 0); if (PROBE_REPEAT == 70) tbar = (unsigned long long)__builtin_readcyclecounter() - tf0; }
#undef RUN
    if (PROBE_REPEAT >= 40 && blockIdx.x == PROBE_WG && threadIdx.x == 0) *(volatile unsigned long long*)(lds_raw + 512) = tbar;
    if (((PROBE_REPEAT >= 30 && PROBE_REPEAT <= 33) || PROBE_REPEAT >= 40) && blockIdx.x == PROBE_WG && threadIdx.x == 0) {
        const unsigned long long want = 4ull * *(volatile unsigned long long*)(lds_raw + 512), t0 = __builtin_readcyclecounter();
        while ((unsigned long long)__builtin_readcyclecounter() - t0 < want) __builtin_amdgcn_s_sleep(8);
    }
#undef IN
#undef SEAM
}

extern "C" void kernel_launch(void* const* d_in, const int* in_sizes, int n_in, void* d_out, int out_size, void* d_ws, size_t ws_size, hipStream_t stream) {
    static int grid = 0;
    if (grid == 0) {
        if (n_in != N_IN || out_size != NT * DM || ws_size < WS_END) { fprintf(stderr, "kernel_launch: unexpected shapes: n_in %d out %d ws %zu (need %zu)\n", n_in, out_size, ws_size, (size_t)WS_END); grid = -1; return; }
        int dev = 0, cus = 0, per_cu = 0;
        if (hipGetDevice(&dev) != hipSuccess || hipDeviceGetAttribute(&cus, hipDeviceAttributeMultiprocessorCount, dev) != hipSuccess) { grid = -1; return; }
        if (hipFuncSetAttribute((const void*)fwd, hipFuncAttributeMaxDynamicSharedMemorySize, LDS_BYTES) != hipSuccess) { fprintf(stderr, "kernel_launch: hipFuncSetAttribute failed\n"); grid = -1; return; }
        if (hipOccupancyMaxActiveBlocksPerMultiprocessor(&per_cu, (const void*)fwd, NTHREADS, LDS_BYTES) != hipSuccess || per_cu < 1) { fprintf(stderr, "kernel_launch: occupancy query says %d\n", per_cu); }
        (void)hipGetLastError();
        grid = cus;
    }
    if (grid < 0) return;
    (void)in_sizes;
    (void)hipMemsetAsync((char*)d_ws + WS_CTL, 0, CTL_ZERO_BYTES, stream);
    Args a{};
    for (int i = 0; i < N_IN; ++i) a.in[i] = (const float*)d_in[i];
    a.out = (float*)d_out; a.ws = (unsigned char*)d_ws;
    if (N_LAUNCHES == 1) { a.ph_lo = 0; a.ph_hi = NPHASE; hipLaunchKernelGGL(fwd, dim3(grid), dim3(NTHREADS), LDS_BYTES, stream, a); }
    else { for (int p = 0; p < NPHASE; ++p) { a.ph_lo = p; a.ph_hi = p + 1; hipLaunchKernelGGL(fwd, dim3(grid), dim3(NTHREADS), LDS_BYTES, stream, a); } }
}
```

```cpp
#include <hip/hip_runtime.h>
#include <cstdio>
#include <cstdint>

#ifndef PROBE_REPEAT
#define PROBE_REPEAT -1
#endif
#ifndef MERGE_CMP2
#define MERGE_CMP2 0
#endif
#ifndef PROBE_WG
#define PROBE_WG 0
#endif
#ifndef N_LAUNCHES
#define N_LAUNCHES 1
#endif

#define XB_TMO      128
#define XB_XCNT(j)  (256  + 64 * (j))
#define XB_XSUB(j)  (1280 + 64 * (j))
#define XB_XGEN(j)  (2304 + 64 * (j))
#define XB_TOP      3328
#define XB_TOPGEN   3392
#define XCD_BAR_WORDS 3456
#define XB_SPIN_CAP (1u << 21)
#define LAS __attribute__((address_space(3)))

__device__ __forceinline__ unsigned xb_ld(unsigned* p)              { return __hip_atomic_load(p, __ATOMIC_RELAXED, __HIP_MEMORY_SCOPE_AGENT); }
__device__ __forceinline__ unsigned xb_add(unsigned* p, unsigned v) { return __hip_atomic_fetch_add(p, v, __ATOMIC_RELAXED, __HIP_MEMORY_SCOPE_AGENT); }
__device__ __forceinline__ unsigned xb_xcc_id() { return (unsigned)__builtin_amdgcn_s_getreg((3 << 11) | 20) & 0xFu; }
#define XB_SPIN(cond, bar) do { unsigned _sp = 0; while (cond) { __builtin_amdgcn_s_sleep(1); \
    if ((++_sp & 255u) == 0u) { if (xb_ld(&(bar)[XB_TMO])) break; if (_sp > XB_SPIN_CAP) { atomicAdd(&(bar)[XB_TMO], 1u); break; } } } } while (0)

struct XcdBarrier { unsigned* bar; unsigned x; volatile LAS unsigned* st; int wave; };

__device__ __forceinline__ XcdBarrier xcd_barrier_post(unsigned* bar, volatile LAS unsigned* st) {
    XcdBarrier b; b.bar = bar; b.x = xb_xcc_id(); b.st = st;
    if (threadIdx.x == 0) (void)xb_add(&bar[XB_XCNT(b.x)], 1u);
    return b;
}
__device__ __forceinline__ void xcd_barrier_complete(unsigned* bar, unsigned x, unsigned& nloc, unsigned& nx) {
    const unsigned G = gridDim.x * gridDim.y * gridDim.z;
    unsigned sum, cnt, mine, sp = 0u;
    for (;;) {
        sum = 0u; cnt = 0u; mine = 0u;
#pragma unroll
        for (unsigned j = 0; j < 16; ++j) { const unsigned c = xb_ld(&bar[XB_XCNT(j)]); sum += c; cnt += (c > 0u) ? 1u : 0u; mine = (j == x) ? c : mine; }
        if (sum == G) break;
        __builtin_amdgcn_s_sleep(1);
        if ((++sp & 255u) == 0u) { if (xb_ld(&bar[XB_TMO])) break; if (sp > XB_SPIN_CAP) { atomicAdd(&bar[XB_TMO], 1u); break; } }
    }
    nloc = mine > 0u ? mine : 1u; nx = cnt > 0u ? cnt : 1u;
}
__device__ __forceinline__ int fresh_lane();
__device__ __forceinline__ void xcd_barrier(const XcdBarrier& b) {
    asm volatile("s_waitcnt vmcnt(0)" ::: "memory");
    __syncthreads();
    if (b.wave == 0 && fresh_lane() == 0) {
        unsigned* bar = b.bar;
        __builtin_amdgcn_s_waitcnt(0);
        unsigned nloc = b.st[0], nx = b.st[1];
        if (nloc == 0u) { xcd_barrier_complete(bar, b.x, nloc, nx); b.st[0] = nloc; b.st[1] = nx; }
        const unsigned old = xb_add(&bar[XB_XSUB(b.x)], 1u);
        const unsigned gen = old / nloc;
        if (old + 1u == (gen + 1u) * nloc) {
            __builtin_amdgcn_fence(__ATOMIC_RELEASE, "agent");
            asm volatile("s_waitcnt vmcnt(0)" ::: "memory");
            const unsigned og = xb_add(&bar[XB_TOP], 1u);
            const unsigned tg = og / nx;
            if (og + 1u == (tg + 1u) * nx) xb_add(&bar[XB_TOPGEN], 1u);
            else XB_SPIN(xb_ld(&bar[XB_TOPGEN]) == tg, bar);
            __builtin_amdgcn_fence(__ATOMIC_ACQUIRE, "agent");
            xb_add(&bar[XB_XGEN(b.x)], 1u);
            asm volatile("s_waitcnt vmcnt(0)" ::: "memory");
        } else {
            XB_SPIN(xb_ld(&bar[XB_XGEN(b.x)]) == gen, bar);
            __builtin_amdgcn_fence(__ATOMIC_ACQUIRE, "agent");
            asm volatile("s_waitcnt vmcnt(0)" ::: "memory");
        }
    }
    __syncthreads();
}

typedef unsigned short bf16_t;
constexpr int NB = 4, SEQ = 2048, DM = 2048, NT = NB * SEQ;
constexpr int NH = 8, NG = 2, HD = 128, INW = 3608, INWP = 3840;
constexpr int NCMP = 127, NSEL = 32, NEXP = 32, FF = 512;
constexpr float EPS = 1e-6f;
constexpr float SCALE = 0.08838834764831845f;
constexpr int NTHREADS = 512, NWAVES = 8;
constexpr int LDS_BYTES = 147456;
constexpr int YROWS = 24576;

enum { I_X = 0, I_POS, I_LNMIX, I_WIN, I_PEK, I_WK1, I_WK2, I_PEV, I_WV1, I_WV2, I_WPOOL, I_BPOOL, I_PSCALE, I_GNNSA, I_GNPOOL, I_WOUT, I_LNMOE,
       I_WRG, I_BRG, I_WRE, I_BRE, I_WGATE, I_WUP, I_WDOWN, I_LNFINAL, N_IN };

constexpr size_t MB = 1024 * 1024;
constexpr size_t WS_CTL   = 0;
constexpr size_t CTL_ZERO_BYTES = 65536;
constexpr int    CW_CNT   = 4096;
constexpr size_t WS_RSTD1 = 1 * MB;
constexpr size_t WS_RSTD2 = 1 * MB + 65536;
constexpr size_t WS_BIAS1 = 1 * MB + 131072;
constexpr size_t WS_AROW  = 1 * MB + 262144;
constexpr size_t WS_WR    = 1 * MB + 393216;
constexpr size_t WS_WG4   = 1 * MB + 655360;
constexpr size_t WS_WRP   = 32 * MB;
constexpr size_t WS_PL    = 40 * MB;
constexpr size_t WS_ROPEC = 2 * MB;
constexpr size_t WS_ROPES = 2 * MB + 524288;
constexpr size_t WS_GATES = 3 * MB;
constexpr size_t WS_TOKL  = 4 * MB;
constexpr size_t WS_GATEL = 5 * MB;
constexpr size_t WS_HID   = 6 * MB;
constexpr size_t WS_CMPKV = 8 * MB;
constexpr size_t WS_WINT  = 9 * MB;
constexpr size_t WS_WOUTT = 24 * MB;
constexpr size_t WS_W1T   = 32 * MB;
constexpr size_t WS_W2T   = 160 * MB;
constexpr size_t WS_CMPW  = 224 * MB;
constexpr size_t WS_POOLW = 228 * MB;
constexpr size_t WS_POOLB = 228 * MB + 524288;
constexpr size_t WS_CPART = 447 * MB;
constexpr size_t WS_DBUF  = 463 * MB;
constexpr size_t WS_XB    = 230 * MB;
constexpr size_t WS_QN    = 262 * MB;
constexpr size_t WS_QR    = 278 * MB;
constexpr size_t WS_KV    = 294 * MB;
constexpr size_t WS_U     = 319 * MB;
constexpr size_t WS_Y     = 230 * MB;
constexpr size_t WS_OWIN  = 351 * MB;
constexpr size_t WS_OCMP  = 367 * MB;
constexpr size_t WS_OSEL  = 319 * MB;
constexpr size_t WS_ML    = 6 * MB;
constexpr size_t WS_X1B   = 351 * MB;
constexpr size_t WS_OPOOL = 383 * MB;
constexpr size_t WS_ACT   = 383 * MB;
constexpr size_t WS_MIX   = 415 * MB;
constexpr size_t WS_END   = 479 * MB;

__device__ __forceinline__ bf16_t f2bf(float f) { unsigned u = __float_as_uint(f); u += 0x7FFFu + ((u >> 16) & 1u); return (bf16_t)(u >> 16); }
__device__ __forceinline__ float bf2f(bf16_t b) { return __uint_as_float(((unsigned)b) << 16); }
__device__ __forceinline__ float wave_sum(float v) {
#pragma unroll
    for (int o = 32; o >= 1; o >>= 1) v += __shfl_xor(v, o);
    return v;
}
__device__ __forceinline__ float wave_max(float v) {
#pragma unroll
    for (int o = 32; o >= 1; o >>= 1) v = fmaxf(v, __shfl_xor(v, o));
    return v;
}

__device__ __forceinline__ int fresh_lane() { int l; asm volatile("v_mbcnt_lo_u32_b32 %0, -1, 0\n\tv_mbcnt_hi_u32_b32 %0, -1, %0" : "=v"(l)); return l; }
struct Args { const float* in[N_IN]; float* out; unsigned char* ws; int ph_lo, ph_hi; };

struct Frame {
    const float* in[N_IN]; float* out; unsigned char* ws;
    float* lds;
    int tid, lane, wave, G, bid;
};

__device__ __forceinline__ float gelu_tanh(float x) { const float u = 0.7978845608028654f * (x + 0.044715f * x * x * x); return 0.5f * x * (1.f + tanhf(u)); }


namespace pg8 {
typedef short bf16x8 __attribute__((ext_vector_type(8)));
typedef float f32x4 __attribute__((ext_vector_type(4)));
typedef unsigned u32x4 __attribute__((ext_vector_type(4)));
constexpr int BM = 256, BK = 64, HALF = 128, HTB = HALF * BK * 2, STAGE_BYTES = 8 * HTB, NXCD = 8, WGM = 8;
__device__ __forceinline__ int lds_byte(int r, int c) { const int st = (r >> 4) * 2 + (c >> 5), rr = r & 15, cc = c & 31, ob = rr * 64 + cc * 2; return st * 1024 + (ob ^ (((ob >> 9) & 1) << 5)); }
__device__ __forceinline__ void stage_rc(int b, int& R, int& C) { const int st = b / 1024, sb = b % 1024, swz = sb ^ (((sb >> 9) & 1) << 5); R = (st >> 1) * 16 + swz / 64; C = (st & 1) * 32 + (swz % 64) / 2; }
struct Unit { int pm, pn, e, li; };
__device__ __forceinline__ unsigned cvt_pk_bf16(float lo, float hi) { unsigned r; asm volatile("v_cvt_pk_bf16_f32 %0, %1, %2" : "=v"(r) : "v"(lo), "v"(hi)); return r; }

struct DenseOrder {
    const char* A; const char* Bt; int lda, ldb; int nM, nN, nwg, G, c;
    __device__ void init(const void* A_, const void* Bt_, int lda_, int ldb_, int M, int N, int G_, int c_) { A = (const char*)A_; Bt = (const char*)Bt_; lda = lda_; ldb = ldb_; nM = M / BM; nN = N / BM; nwg = nM * nN; G = G_; c = c_; }
    __device__ __forceinline__ bool next(int i, Unit& u) const {
        const long L = (long)i * G + c; if (L >= nwg) return false;
        int wgid = (int)L; { const int q = nwg / NXCD, r = nwg % NXCD, xcd = wgid % NXCD, off = wgid / NXCD; wgid = (xcd < r ? xcd * (q + 1) : r * (q + 1) + (xcd - r) * q) + off; }
        const int nig = WGM * nN, gid = wgid / nig, fm = gid * WGM, gsz = (nM - fm) < WGM ? (nM - fm) : WGM;
        u.pm = fm + ((wgid % nig) % gsz); u.pn = (wgid % nig) / gsz; u.e = 0; u.li = i; return true;
    }
    __device__ __forceinline__ const char* a_base(const Unit& u) const { return A + (size_t)u.pm * BM * lda * 2; }
    __device__ __forceinline__ const char* b_base(const Unit& u) const { return Bt + (size_t)u.pn * BM * ldb * 2; }
    __device__ __forceinline__ unsigned a_row_off(const Unit&, int r) const { return (unsigned)r * (unsigned)lda * 2u; }
};

template <class Epi, class Sched, bool GATHER>
__device__ __forceinline__ void gemm_phase(LAS unsigned char* lds, const int K, const int lda, const int ldb, const Sched& S, const Epi& E) {
    const int tid = threadIdx.x, wid = __builtin_amdgcn_readfirstlane(tid >> 6), lane = tid & 63, wr = wid >> 2, wc = wid & 3, fr = lane & 15, fq = lane >> 4;
    const int nt = K / BK;
    int sR[2], sC[2];
#pragma unroll
    for (int i = 0; i < 2; ++i) stage_rc(tid * 16 + i * 8192, sR[i], sC[i]);
    unsigned voffB[2], voffA[2][2], nvoffA[2][2];
#pragma unroll
    for (int i = 0; i < 2; ++i) voffB[i] = (unsigned)(sR[i] * ldb + sC[i]) * 2u;
    const size_t kstep = (size_t)(BK * 2);
    const size_t hstepB = (size_t)HALF * ldb * 2;
    const unsigned ldsw = (unsigned)wid * 1024u;
    const int aoff = lds_byte(wr * 64 + fr, fq * 8), boff = lds_byte(wc * 32 + fr, fq * 8);
#define PG8_SA(b, h) (((b) * 2 + (h)) * HTB)
#define PG8_SB(b, h) ((4 + (b) * 2 + (h)) * HTB)
#define PG8_STAGE(bufoff, gbase, voff) do { _Pragma("unroll") for (int _i = 0; _i < 2; ++_i) \
        __builtin_amdgcn_global_load_lds((const unsigned*)((const char*)(gbase) + (voff)[_i]), (LAS unsigned*)(lds + (bufoff) + ldsw + _i * 8192), 16, 0, 0); } while (0)
#define PG8_LDA(dst, b, h) do { _Pragma("unroll") for (int m = 0; m < 4; ++m) _Pragma("unroll") for (int k = 0; k < 2; ++k) dst[m][k] = *(const LAS bf16x8*)(lds + PG8_SA(b, h) + aoff + m * 2048 + k * 1024); } while (0)
#define PG8_LDB(dst, b, h) do { _Pragma("unroll") for (int n = 0; n < 2; ++n) _Pragma("unroll") for (int k = 0; k < 2; ++k) dst[n][k] = *(const LAS bf16x8*)(lds + PG8_SB(b, h) + boff + n * 2048 + k * 1024); } while (0)
#define PG8_MMA(ai, bj, At, Bt) do { __builtin_amdgcn_s_setprio(1); _Pragma("unroll") for (int m = 0; m < 4; ++m) _Pragma("unroll") for (int n = 0; n < 2; ++n) _Pragma("unroll") for (int k = 0; k < 2; ++k) \
        { acc[ai][bj][m][n] = __builtin_amdgcn_mfma_f32_16x16x32_bf16(Bt[n][k], At[m][k], acc[ai][bj][m][n], 0, 0, 0); if (PROBE_REPEAT == 21) dummy = __builtin_amdgcn_mfma_f32_16x16x32_bf16(Bt[n][k], At[m][k], dummy, 0, 0, 0); } __builtin_amdgcn_s_setprio(0); } while (0)
#define PG8_WAIT_V(n) asm volatile("s_waitcnt vmcnt(" #n ")" ::: "memory")
#define PG8_WAIT_L(n) asm volatile("s_waitcnt lgkmcnt(" #n ")" ::: "memory")
#define PG8_BAR __builtin_amdgcn_s_barrier()
#define PG8_SCHED __builtin_amdgcn_sched_barrier(0)
#define PG8_AOFFS(dst, u) do { _Pragma("unroll") for (int _h = 0; _h < 2; ++_h) _Pragma("unroll") for (int _i = 0; _i < 2; ++_i) dst[_h][_i] = S.a_row_off(u, _h * HALF + sR[_i]) + (unsigned)sC[_i] * 2u; } while (0)
    Unit cur, nxt; int ui = 0;
    if (!S.next(0, cur)) return;
    f32x4 acc[2][2][4][2];
#pragma unroll
    for (int a = 0; a < 2; ++a)
#pragma unroll
        for (int b = 0; b < 2; ++b)
#pragma unroll
            for (int m = 0; m < 4; ++m)
#pragma unroll
                for (int n = 0; n < 2; ++n) acc[a][b][m][n] = (f32x4){0.f, 0.f, 0.f, 0.f};
    bf16x8 At[4][2], B0[2][2], B1[2][2]; f32x4 dummy = {0.f, 0.f, 0.f, 0.f};
    const char* cA = S.a_base(cur); const char* cB = S.b_base(cur);
    PG8_AOFFS(voffA, cur);
    PG8_STAGE(PG8_SB(0, 0), cB, voffB); PG8_STAGE(PG8_SA(0, 0), cA, voffA[0]); PG8_STAGE(PG8_SB(0, 1), cB + hstepB, voffB); PG8_STAGE(PG8_SA(0, 1), cA, voffA[1]);
    if (wr == 1) PG8_BAR;
    PG8_WAIT_V(4); PG8_BAR;
    PG8_STAGE(PG8_SB(1, 0), cB + kstep, voffB); PG8_STAGE(PG8_SA(1, 0), cA + kstep, voffA[0]); PG8_STAGE(PG8_SB(1, 1), cB + hstepB + kstep, voffB);
    PG8_WAIT_V(6); PG8_BAR;
    for (;;) {
        const bool has_next = S.next(ui + 1, nxt);
        const char* nA = has_next ? S.a_base(nxt) : cA; const char* nB = has_next ? S.b_base(nxt) : cB;
        if (GATHER) { if (has_next) { PG8_AOFFS(nvoffA, nxt); } else {
#pragma unroll
            for (int _h = 0; _h < 2; ++_h)
#pragma unroll
                for (int _i = 0; _i < 2; ++_i) nvoffA[_h][_i] = voffA[_h][_i]; } }
        for (int t = 0; t < nt; t += 2) {
            const bool last = (t == nt - 2);
            const char* a1 = cA + (size_t)(t + 1) * kstep;
            const char* a2 = last ? nA : cA + (size_t)(t + 2) * kstep; const char* b2 = last ? nB : cB + (size_t)(t + 2) * kstep;
            const char* a3 = a2 + kstep; const char* b3 = b2 + kstep;
            unsigned vA2[2][2];
#pragma unroll
            for (int _h = 0; _h < 2; ++_h)
#pragma unroll
                for (int _i = 0; _i < 2; ++_i) vA2[_h][_i] = (GATHER && last) ? nvoffA[_h][_i] : voffA[_h][_i];
            PG8_LDB(B0, 0, 0); PG8_SCHED; PG8_LDA(At, 0, 0); PG8_STAGE(PG8_SA(1, 1), a1, voffA[1]);
            PG8_WAIT_L(8); PG8_BAR; PG8_WAIT_L(0); PG8_MMA(0, 0, At, B0); PG8_BAR; PG8_SCHED;
            PG8_LDB(B1, 0, 1); PG8_STAGE(PG8_SB(0, 0), b2, voffB);
            PG8_BAR; PG8_WAIT_L(0); PG8_MMA(0, 1, At, B1); PG8_BAR;
            PG8_LDA(At, 0, 1); PG8_STAGE(PG8_SA(0, 0), a2, vA2[0]);
            PG8_BAR; PG8_WAIT_L(0); PG8_MMA(1, 0, At, B0); PG8_BAR; PG8_SCHED;
            PG8_STAGE(PG8_SB(0, 1), b2 + hstepB, voffB);
            PG8_WAIT_V(6); PG8_BAR; PG8_MMA(1, 1, At, B1); PG8_BAR;
            PG8_LDB(B0, 1, 0); PG8_SCHED; PG8_LDA(At, 1, 0); PG8_STAGE(PG8_SA(0, 1), a2, vA2[1]);
            PG8_WAIT_L(8); PG8_BAR; PG8_WAIT_L(0); PG8_MMA(0, 0, At, B0); PG8_BAR; PG8_SCHED;
            PG8_LDB(B1, 1, 1); PG8_STAGE(PG8_SB(1, 0), b3, voffB);
            PG8_BAR; PG8_WAIT_L(0); PG8_MMA(0, 1, At, B1); PG8_BAR;
            PG8_LDA(At, 1, 1); PG8_STAGE(PG8_SA(1, 0), a3, vA2[0]);
            PG8_BAR; PG8_WAIT_L(0); PG8_MMA(1, 0, At, B0); PG8_BAR; PG8_SCHED;
            PG8_STAGE(PG8_SB(1, 1), b3 + hstepB, voffB);
            PG8_WAIT_V(6); PG8_BAR; PG8_MMA(1, 1, At, B1); PG8_BAR;
        }
        if constexpr (!Epi::AFTER_DRAIN) E(acc, cur, wr, wc, fr, fq);
        if (!has_next) break;
#pragma unroll
        for (int a = 0; a < 2; ++a)
#pragma unroll
            for (int b = 0; b < 2; ++b)
#pragma unroll
                for (int m = 0; m < 4; ++m)
#pragma unroll
                    for (int n = 0; n < 2; ++n) acc[a][b][m][n] = (f32x4){0.f, 0.f, 0.f, 0.f};
        cur = nxt; cA = nA; cB = nB; ++ui;
        if (GATHER) {
#pragma unroll
            for (int _h = 0; _h < 2; ++_h)
#pragma unroll
                for (int _i = 0; _i < 2; ++_i) voffA[_h][_i] = nvoffA[_h][_i]; }
    }
    if (PROBE_REPEAT == 21) asm volatile("" :: "v"(dummy));
    PG8_WAIT_V(0);
    if (wr == 0) PG8_BAR;
    PG8_BAR;
    if constexpr (Epi::AFTER_DRAIN) E.fused(acc, cur, wr, wc, fr, fq, lds);
#undef PG8_SA
#undef PG8_SB
#undef PG8_STAGE
#undef PG8_LDA
#undef PG8_LDB
#undef PG8_MMA
#undef PG8_WAIT_V
#undef PG8_WAIT_L
#undef PG8_BAR
#undef PG8_SCHED
#undef PG8_AOFFS
}
}


namespace g2 {
using pg8::bf16x8; using pg8::f32x4; using pg8::lds_byte; using pg8::cvt_pk_bf16;
typedef short s16x4 __attribute__((ext_vector_type(4)));
constexpr int A_BYTES = 32768, B_BYTES = 16384, STG = A_BYTES + B_BYTES;
struct Unit { int e, pm, pn, li, half; };
template <int NT_, class Epi, class Sched>
__device__ __forceinline__ void gemm(LAS unsigned char* lds, const Sched& S, const Epi& E, const int wave_, unsigned long long* tprobe = nullptr) {
#if defined(__HIP_DEVICE_COMPILE__)
    const int wid = wave_, lane = fresh_lane(), tid = wid * 64 + lane, wr = wid >> 2, wc = wid & 3, fr = lane & 15, fq = lane >> 4;
    constexpr int nt = NT_;
    unsigned long long tacc = 0ull;
#define TCK() ((PROBE_REPEAT >= 30 && PROBE_REPEAT <= 33) ? (unsigned long long)__builtin_readcyclecounter() : 0ull)
    const unsigned long long t_all0 = TCK();
    const int awoff0 = lds_byte((tid >> 3) & 127, (tid & 7) * 8);
    const int bkr = tid >> 5, bnq = tid & 31;
    const int bwoff0 = A_BYTES + bkr * 256 + ((((bnq >> 2)) ^ ((bkr & 3) | (((bkr >> 3) & 1) << 2))) * 32) + (bnq & 3) * 8;
#define awoff(j) (awoff0 + ((j) & 1) * 8192 + ((j) >> 1) * 16384)
#define bwoff(j) (bwoff0 + (j) * 4096)
    const int aoff = lds_byte(wr * 64 + fr, fq * 8);
    int boff[2];
    { const int q = (lane >> 2) & 3, p = lane & 3, f = q | ((fq & 1) << 2);
#pragma unroll
      for (int n = 0; n < 2; ++n) boff[n] = A_BYTES + (8 * fq + q) * 256 + (((2 * wc + n) ^ f) * 32) + 8 * p; }
    const int ldsb = (int)(uintptr_t)lds;
    Unit u, un;
    if (!S.next(0, u)) return;
    unsigned pa[4], pan[4]; const float* pb; const float* pbn;
    const size_t bstep = (size_t)16 * S.ldb;
#define G2_PTRS(PA, PB, U) do { _Pragma("unroll") for (int j = 0; j < 4; ++j) { const int id = tid + 512 * j; PA[j] = S.a_off(U, id >> 3) + (unsigned)(id & 7) * 16u; } PB = S.b_col(U, 4 * ((U).half >= 2 ? ((bnq & 15) | (((U).half & 1) << 4)) : bnq)) + (size_t)bkr * S.ldb; } while (0)
    G2_PTRS(pa, pb, u);
    f32x4 acc[2][4][2];
#pragma unroll
    for (int a = 0; a < 2; ++a)
#pragma unroll
        for (int m = 0; m < 4; ++m)
#pragma unroll
            for (int n = 0; n < 2; ++n) acc[a][m][n] = (f32x4){0.f, 0.f, 0.f, 0.f};
    f32x4 dummy = {0.f, 0.f, 0.f, 0.f};
    bf16x8 ra0[4], ra1[4]; f32x4 rb0[4], rb1[4];
#define G2_NVALID(U) (((U).half >= 2 && (wc >> 1) != ((U).half & 1)) ? 0 : S.nvalid(U))
    bool hf = u.half != 0; const bool hfn = false; (void)hfn; int nvalid = G2_NVALID(u);
#define G2_LOADA(RA, PA, HF, t) do { _Pragma("unroll") for (int j = 0; j < 4; ++j) if (j < 2 || !(HF)) RA[j] = *(const bf16x8*)((const char*)S.A + PA[j] + (unsigned)(t) * 128u); } while (0)
#define G2_LOADB(RB, PB, t) do { _Pragma("unroll") for (int j = 0; j < 4; ++j) RB[j] = *(const f32x4*)(PB + (size_t)(t) * 64 * S.ldb + j * bstep); } while (0)
#define G2_WRITE_A(st, RA, j) do { *(LAS bf16x8*)(lds + (st) * STG + awoff(j)) = RA[j]; } while (0)
#define G2_WRITE_B(st, RB, j) do { uint2 w_; w_.x = cvt_pk_bf16(RB[j][0], RB[j][1]); w_.y = cvt_pk_bf16(RB[j][2], RB[j][3]); *(LAS uint2*)(lds + (st) * STG + bwoff(j)) = w_; } while (0)
#define G2_TR(dst, n, imm) asm volatile("ds_read_b64_tr_b16 %0, %1 offset:%2" : "=&v"(dst) : "v"(ldsb + boff[n]), "i"(imm) : "memory")
#define G2_COMPUTE(st, DOW, WA, WB, HFC, HFW) do { const unsigned long long tc0_ = TCK(); \
        s16x4 b00l, b00h, b01l, b01h, b10l, b10h, b11l, b11h;        \
        G2_TR(b00l, 0, (st) * STG); G2_TR(b00h, 0, (st) * STG + 1024); G2_TR(b01l, 0, (st) * STG + 8192); G2_TR(b01h, 0, (st) * STG + 8192 + 1024); \
        G2_TR(b10l, 1, (st) * STG); G2_TR(b10h, 1, (st) * STG + 1024); G2_TR(b11l, 1, (st) * STG + 8192); G2_TR(b11h, 1, (st) * STG + 8192 + 1024); \
        bf16x8 At[4][2]; \
        _Pragma("unroll") for (int m = 0; m < 4; ++m) _Pragma("unroll") for (int k = 0; k < 2; ++k) At[m][k] = *(const LAS bf16x8*)(lds + (st) * STG + aoff + m * 2048 + k * 1024); \
        asm volatile("s_waitcnt lgkmcnt(0)" ::: "memory"); __builtin_amdgcn_sched_barrier(0); \
        if (PROBE_REPEAT == 31) tacc += TCK() - tc0_; \
        const bf16x8 B00 = {b00l[0], b00l[1], b00l[2], b00l[3], b00h[0], b00h[1], b00h[2], b00h[3]}, B01 = {b01l[0], b01l[1], b01l[2], b01l[3], b01h[0], b01h[1], b01h[2], b01h[3]}; \
        const bf16x8 B10 = {b10l[0], b10l[1], b10l[2], b10l[3], b10h[0], b10h[1], b10h[2], b10h[3]}, B11 = {b11l[0], b11l[1], b11l[2], b11l[3], b11h[0], b11h[1], b11h[2], b11h[3]}; \
        _Pragma("unroll") for (int a = 0; a < 2; ++a) { \
            _Pragma("unroll") for (int m = 0; m < 4; ++m) { \
                __builtin_amdgcn_s_setprio(1); \
                if (128 * a + 64 * wr + 16 * m < nvalid) {                 \
                acc[a][m][0] = __builtin_amdgcn_mfma_f32_16x16x32_bf16(B00, At[m][0], acc[a][m][0], 0, 0, 0); acc[a][m][0] = __builtin_amdgcn_mfma_f32_16x16x32_bf16(B01, At[m][1], acc[a][m][0], 0, 0, 0); \
                acc[a][m][1] = __builtin_amdgcn_mfma_f32_16x16x32_bf16(B10, At[m][0], acc[a][m][1], 0, 0, 0); acc[a][m][1] = __builtin_amdgcn_mfma_f32_16x16x32_bf16(B11, At[m][1], acc[a][m][1], 0, 0, 0); } \
                if (PROBE_REPEAT == 20) { dummy = __builtin_amdgcn_mfma_f32_16x16x32_bf16(B00, At[m][0], dummy, 0, 0, 0); dummy = __builtin_amdgcn_mfma_f32_16x16x32_bf16(B01, At[m][1], dummy, 0, 0, 0); dummy = __builtin_amdgcn_mfma_f32_16x16x32_bf16(B10, At[m][0], dummy, 0, 0, 0); dummy = __builtin_amdgcn_mfma_f32_16x16x32_bf16(B11, At[m][1], dummy, 0, 0, 0); } \
                __builtin_amdgcn_s_setprio(0); \
                if (DOW) { if (a == 0) { if (m < 2 || !(HFW)) G2_WRITE_A((st) ^ 1, WA, m); if (HFC) G2_WRITE_B((st) ^ 1, WB, m); } else G2_WRITE_B((st) ^ 1, WB, m); __builtin_amdgcn_sched_barrier(0); } } \
            if (HFC) break;                                               \
            if (a == 0) { __builtin_amdgcn_sched_barrier(0); \
                _Pragma("unroll") for (int m = 0; m < 4; ++m) _Pragma("unroll") for (int k = 0; k < 2; ++k) At[m][k] = *(const LAS bf16x8*)(lds + (st) * STG + 16384 + aoff + m * 2048 + k * 1024); \
                asm volatile("s_waitcnt lgkmcnt(0)" ::: "memory"); __builtin_amdgcn_sched_barrier(0); } } \
        if (PROBE_REPEAT == 32) tacc += TCK() - tc0_; } while (0)
    for (int ui = 0;; ++ui) {
        G2_LOADA(ra0, pa, hf, 0); G2_LOADB(rb0, pb, 0); G2_LOADA(ra1, pa, hf, 1); G2_LOADB(rb1, pb, 1);
        __syncthreads();
#pragma unroll
        for (int j = 0; j < 4; ++j) { if (j < 2 || !hf) G2_WRITE_A(0, ra0, j); G2_WRITE_B(0, rb0, j); }
        if (nt > 2) { G2_LOADA(ra0, pa, hf, 2); G2_LOADB(rb0, pb, 2); }
        __syncthreads();
#define G2_STEP(t) do { \
            G2_COMPUTE(0, true, ra1, rb1, hf, hf); \
            if ((t) + 3 < nt) { G2_LOADA(ra1, pa, hf, (t) + 3); G2_LOADB(rb1, pb, (t) + 3); } \
            __syncthreads(); \
            if ((t) + 2 < nt) { G2_COMPUTE(1, true, ra0, rb0, hf, hf); } else { G2_COMPUTE(1, false, ra0, rb0, hf, hf); } \
            if ((t) + 4 < nt) { G2_LOADA(ra0, pa, hf, (t) + 4); G2_LOADB(rb0, pb, (t) + 4); } \
            __syncthreads(); } while (0)
        G2_STEP(0); G2_STEP(2); G2_STEP(4); G2_STEP(6);
        if constexpr (NT_ > 8) { G2_STEP(8); G2_STEP(10); G2_STEP(12); G2_STEP(14); G2_STEP(16); G2_STEP(18); G2_STEP(20); G2_STEP(22); G2_STEP(24); G2_STEP(26); G2_STEP(28); G2_STEP(30); }
        static_assert(NT_ == 8 || NT_ == 32, "expand G2_STEP for this K");
#undef G2_STEP
        if (PROBE_REPEAT == 20) asm volatile("" :: "v"(dummy));
        E(acc, u, wr, wc, fr, fq);
        if (!S.next(ui + 1, un)) break;
#pragma unroll
        for (int a = 0; a < 2; ++a)
#pragma unroll
            for (int m = 0; m < 4; ++m)
#pragma unroll
                for (int n = 0; n < 2; ++n) acc[a][m][n] = (f32x4){0.f, 0.f, 0.f, 0.f};
        u.e = un.e; u.pm = un.pm; u.pn = un.pn; u.li = un.li; u.half = un.half; hf = u.half != 0; nvalid = G2_NVALID(u);
        G2_PTRS(pa, pb, u);
    }
#undef G2_PTRS
#undef G2_NVALID
#undef awoff
#undef bwoff
#undef G2_LOADA
#undef G2_LOADB
#undef G2_WRITE_A
#undef G2_WRITE_B
#undef G2_TR
#undef G2_COMPUTE
    if (PROBE_REPEAT == 33) tacc = TCK() - t_all0;
    if (tprobe && blockIdx.x == PROBE_WG && threadIdx.x == 0) *tprobe = tacc;
#undef TCK
#endif
}
}

namespace att {
typedef short bf16x8 __attribute__((ext_vector_type(8)));
typedef short s16x4 __attribute__((ext_vector_type(4)));
typedef float f32x16 __attribute__((ext_vector_type(16)));
typedef float f32x4 __attribute__((ext_vector_type(4)));
typedef unsigned u32x4 __attribute__((ext_vector_type(4)));
constexpr int SHM = 16384;
constexpr int NBUF = 3;
constexpr int L_K = 0, L_V = NBUF * SHM, L_WS = 2 * NBUF * SHM, L_PART = L_WS + 8 * 64 * 4, L_SELM = L_PART + 4 * 64 * 33 * 4, L_VALS = L_SELM + 256, L_ITEM = L_VALS + 8 * 64 * 4, L_END = L_ITEM + 16;
constexpr float C2 = 1.4426950408889634f * SCALE;
#define KSWZ(row, colB) ((row) * 256 + ((colB) ^ (((row) & 7) << 4)))
#define SBAR() __builtin_amdgcn_sched_barrier(0)
__device__ __forceinline__ int v_st(int k, int c) { const int kk = (k & ~0xC) | ((k & 4) << 1) | ((k & 8) >> 1); return ((kk >> 3) * 4 + (c >> 5)) * 512 + ((kk & 7) * 32 + (c & 31)) * 2; }
__device__ __forceinline__ int v_rd_base(int lane) { return ((lane & 3) << 3) | (((lane >> 2) & 3) << 6) | (((lane >> 4) & 1) << 5) | (((lane >> 5) & 1) << 8); }
constexpr int v_rd_off(int d0, int ks, int half) { return d0 * 512 + ks * 4096 + half * 2048; }
__device__ __forceinline__ int crow(int r, int hi) { return (r & 3) + 8 * (r >> 2) + 4 * hi; }
__device__ __forceinline__ unsigned cvtpk(float lo, float hi) { unsigned r; asm volatile("v_cvt_pk_bf16_f32 %0, %1, %2" : "=v"(r) : "v"(lo), "v"(hi)); return r; }
__device__ __forceinline__ float swap_max(float v) { auto rr = __builtin_amdgcn_permlane32_swap(__float_as_uint(v), __float_as_uint(v), false, false); return fmaxf(__uint_as_float(rr[0]), __uint_as_float(rr[1])); }
__device__ __forceinline__ float swap_sum(float v) { auto rr = __builtin_amdgcn_permlane32_swap(__float_as_uint(v), __float_as_uint(v), false, false); return __uint_as_float(rr[0]) + __uint_as_float(rr[1]); }

struct WV { int tid, wid, lane, r32, hi, vb0; unsigned ksrc[2], vsrc[2]; char* lds; LAS unsigned char* ldsL; };
__device__ __forceinline__ void wv_src_init(WV& w) {
#pragma unroll
    for (int i = 0; i < 2; ++i) {
        const int L = (w.wid * 2 + i) * 1024 + w.lane * 16;
        { const int row = L >> 8, colB = (L & 255) ^ ((row & 7) << 4); w.ksrc[i] = (unsigned)(row * 256 + colB); }
        { const int sub = L >> 9, kkhi = sub >> 2, cblk = sub & 3, within = L & 511, kklo = within >> 6, cc = (within >> 1) & 31;
          const int kk = kkhi * 8 + kklo, k = (kk & ~0xC) | ((kk & 4) << 1) | ((kk & 8) >> 1), c = cblk * 32 + cc; w.vsrc[i] = (unsigned)(k * 256 + c * 2); }
    }
}
__device__ __forceinline__ void dma_tile(const WV& w, const bf16_t* Kt, const bf16_t* Vt, int buf) {
    int ln = w.lane; asm volatile("" : "+v"(ln));
#pragma unroll
    for (int i = 0; i < 2; ++i) {
        const int L = (w.wid * 2 + i) * 1024 + ln * 16;
        const int row = L >> 8, colB = (L & 255) ^ ((row & 7) << 4); const unsigned ksrc = (unsigned)(row * 256 + colB);
        const int sub = L >> 9, kkhi = sub >> 2, cblk = sub & 3, within = L & 511, kklo = within >> 6, cc = (within >> 1) & 31;
        const int kk = kkhi * 8 + kklo, k = (kk & ~0xC) | ((kk & 4) << 1) | ((kk & 8) >> 1), c = cblk * 32 + cc; const unsigned vsrc = (unsigned)(k * 256 + c * 2);
        __builtin_amdgcn_global_load_lds((const unsigned*)((const char*)Vt + vsrc), (LAS unsigned*)(w.ldsL + L_V + buf * SHM + (w.wid * 2 + i) * 1024), 16, 0, 0);
        __builtin_amdgcn_global_load_lds((const unsigned*)((const char*)Kt + ksrc), (LAS unsigned*)(w.ldsL + L_K + buf * SHM + (w.wid * 2 + i) * 1024), 16, 0, 0);
    }
}
template <int BUF>
__device__ __forceinline__ void qkt(const WV& w, const bf16x8 (&qr)[8], f32x16& p0, f32x16& p1) {
    p0 = f32x16{}; p1 = f32x16{};
    const LAS char* kb[4];
#pragma unroll
    for (int dd = 0; dd < 4; ++dd) kb[dd] = (const LAS char*)w.ldsL + L_K + KSWZ(w.r32, (dd * 16 + w.hi * 8) * 2);
#pragma unroll
    for (int d0 = 0; d0 < 8; ++d0) { const LAS char* a = kb[d0 & 3] + BUF * SHM + (d0 >> 2) * 128;
        const bf16x8 b0 = *reinterpret_cast<const LAS bf16x8*>(a); const bf16x8 b1 = *reinterpret_cast<const LAS bf16x8*>(a + 32 * 256);
        p0 = __builtin_amdgcn_mfma_f32_32x32x16_bf16(b0, qr[d0], p0, 0, 0, 0);
        p1 = __builtin_amdgcn_mfma_f32_32x32x16_bf16(b1, qr[d0], p1, 0, 0, 0);
        if (d0 == 3) SBAR(); }
}
__device__ __forceinline__ void pack_p(const f32x16& p0, const f32x16& p1, bf16x8& pa0, bf16x8& pa1, bf16x8& pa2, bf16x8& pa3) {
#define PK4(P, B_, OUT) do { unsigned a0 = cvtpk(P[B_+0], P[B_+1]), a1 = cvtpk(P[B_+2], P[B_+3]); unsigned b0 = cvtpk(P[B_+4], P[B_+5]), b1 = cvtpk(P[B_+6], P[B_+7]); \
        auto r0 = __builtin_amdgcn_permlane32_swap(a0, b0, false, false); auto r1 = __builtin_amdgcn_permlane32_swap(a1, b1, false, false); \
        u32x4 w_ = {r0[0], r1[0], r0[1], r1[1]}; OUT = *reinterpret_cast<bf16x8*>(&w_); } while (0)
    PK4(p0, 0, pa0); PK4(p0, 8, pa1); PK4(p1, 0, pa2); PK4(p1, 8, pa3);
#undef PK4
}
template <int VB>
__device__ __forceinline__ void pv_tile(f32x16* o, int vb0, bf16x8 pa0, bf16x8 pa1, bf16x8 pa2, bf16x8 pa3) {
#define TRRD(dst, off) asm volatile("ds_read_b64_tr_b16 %0, %1 offset:%2" : "=&v"(dst) : "v"(vb0), "i"(off) : "memory")
#define PV_D0(d0) do { s16x4 l0, l1, l2, l3, h0, h1, h2, h3; constexpr int b_ = VB * SHM + v_rd_off(d0, 0, 0); \
        TRRD(l0, b_); TRRD(h0, b_ + 2048); TRRD(l1, b_ + 4096); TRRD(h1, b_ + 6144); TRRD(l2, b_ + 8192); TRRD(h2, b_ + 10240); TRRD(l3, b_ + 12288); TRRD(h3, b_ + 14336); \
        asm volatile("s_waitcnt lgkmcnt(0)" ::: "memory"); SBAR(); \
        o[d0] = __builtin_amdgcn_mfma_f32_32x32x16_bf16(pa0, (bf16x8){l0[0], l0[1], l0[2], l0[3], h0[0], h0[1], h0[2], h0[3]}, o[d0], 0, 0, 0); \
        o[d0] = __builtin_amdgcn_mfma_f32_32x32x16_bf16(pa1, (bf16x8){l1[0], l1[1], l1[2], l1[3], h1[0], h1[1], h1[2], h1[3]}, o[d0], 0, 0, 0); \
        o[d0] = __builtin_amdgcn_mfma_f32_32x32x16_bf16(pa2, (bf16x8){l2[0], l2[1], l2[2], l2[3], h2[0], h2[1], h2[2], h2[3]}, o[d0], 0, 0, 0); \
        o[d0] = __builtin_amdgcn_mfma_f32_32x32x16_bf16(pa3, (bf16x8){l3[0], l3[1], l3[2], l3[3], h3[0], h3[1], h3[2], h3[3]}, o[d0], 0, 0, 0); } while (0)
    PV_D0(0); PV_D0(1); PV_D0(2); PV_D0(3);
#undef PV_D0
#undef TRRD
}
__device__ __forceinline__ void store_o(const WV& w, const f32x16* o, const float* tab, bf16_t* outp) {
    bf16_t* lp = outp + (size_t)w.hi * 4096 + w.r32;
#pragma unroll
    for (int r = 0; r < 16; ++r) { const int q = crow(r, w.hi); const float sc = tab[q];
        bf16_t* p = lp; asm volatile("" : "+v"(p));
        p += ((r & 3) + 8 * (r >> 2)) * 1024;
#pragma unroll
        for (int d0 = 0; d0 < 4; ++d0) { const float v = o[d0][r] * sc; const float vn = __shfl_xor(v, 1);
            if ((w.r32 & 1) == 0) __hip_atomic_store((unsigned*)(p + d0 * 32), cvtpk(v, vn), __ATOMIC_RELAXED, __HIP_MEMORY_SCOPE_AGENT); } }
}

template <int MODE>
__device__ __forceinline__ void flash_pass(const WV& w, const bf16_t* Kp, const bf16_t* Vp, int j_lo, int j_hi, const bf16x8 (&qr)[8], int tpos, int tw0, unsigned selmask,
                                           f32x16 (&o)[4], float& m_reg, float& l_reg) {
    float* al_l = (float*)(w.lds + L_WS) + w.wid * 64;
    dma_tile(w, Kp + (size_t)j_lo * 64 * HD, Vp + (size_t)j_lo * 64 * HD, 0);
    if (j_lo + 1 < j_hi) dma_tile(w, Kp + (size_t)(j_lo + 1) * 64 * HD, Vp + (size_t)(j_lo + 1) * 64 * HD, 1);
#define FSTEP(BUF, jj) do { const int jt = (jj);                                                                                  \
        if (jt + 1 < j_hi) asm volatile("s_waitcnt vmcnt(4)" ::: "memory"); else asm volatile("s_waitcnt vmcnt(0)" ::: "memory");   \
        asm volatile("s_waitcnt lgkmcnt(0)" ::: "memory"); __builtin_amdgcn_s_barrier(); asm volatile("" ::: "memory");          \
        if (jt + 2 < j_hi) dma_tile(w, Kp + (size_t)(jt + 2) * 64 * HD, Vp + (size_t)(jt + 2) * 64 * HD, ((BUF) + 2) % 3);         \
        f32x16 p0, p1;                                                                                                           \
        qkt<BUF>(w, qr, p0, p1);                                                                                                 \
        const int kb = jt * 64;                                                                                                  \
        { const float NEG = -__builtin_inff();                                                                                   \
          const bool need = (kb + 63 > tw0) || (MODE == 1 && kb <= tw0 + 31 - 512);                                              \
          if (need) { const int dq = tpos - kb - 4 * w.hi; const unsigned W = (MODE == 1) ? 512u : 0x7fffffffu;                  \
              _Pragma("unroll") for (int r = 0; r < 16; ++r) { const int c = (r & 3) + 8 * (r >> 2); if ((unsigned)(dq - c) >= W) p0[r] = NEG; if ((unsigned)(dq - c - 32) >= W) p1[r] = NEG; } } \
          if (MODE == 0) { const bool sel = (selmask >> jt) & 1u;                                                                \
              if (!__all(sel)) { _Pragma("unroll") for (int r = 0; r < 16; ++r) { p0[r] = sel ? p0[r] : NEG; p1[r] = sel ? p1[r] : NEG; } } } } \
        float pmax = p0[0];                                                                                                      \
        _Pragma("unroll") for (int r = 1; r < 16; ++r) pmax = fmaxf(pmax, p0[r]);                                                \
        _Pragma("unroll") for (int r = 0; r < 16; ++r) pmax = fmaxf(pmax, p1[r]);                                                \
        pmax = swap_max(pmax);                                                                                                   \
        float mn = m_reg, alpha = 1.f;                                                                                           \
        const bool resc = !__all((pmax - m_reg) * SCALE <= 8.f);          \
        if (resc) { mn = fmaxf(m_reg, pmax); alpha = __builtin_amdgcn_exp2f((m_reg - mn) * C2); m_reg = mn; }                     \
        const float mnL = -mn * C2;                                                                                              \
        float ps = 0.f;                                                                                                          \
        _Pragma("unroll") for (int r = 0; r < 16; ++r) { p0[r] = __builtin_amdgcn_exp2f(fmaf(p0[r], C2, mnL)); ps += p0[r]; }    \
        _Pragma("unroll") for (int r = 0; r < 16; ++r) { p1[r] = __builtin_amdgcn_exp2f(fmaf(p1[r], C2, mnL)); ps += p1[r]; }    \
        ps = swap_sum(ps);                                                                                                       \
        l_reg = l_reg * alpha + ps;                                                                                              \
        if (resc) { if (w.hi == 0) al_l[w.r32] = alpha;                                                                          \
            asm volatile("s_waitcnt lgkmcnt(0)" ::: "memory");                                                                   \
            _Pragma("unroll") for (int r = 0; r < 16; ++r) { const float a = al_l[crow(r, w.hi)];                                \
                _Pragma("unroll") for (int d = 0; d < 4; ++d) o[d][r] *= a; } }                                                  \
        bf16x8 pa0, pa1, pa2, pa3;                                                                                               \
        pack_p(p0, p1, pa0, pa1, pa2, pa3);                                                                                      \
        pv_tile<BUF>(o, w.vb0, pa0, pa1, pa2, pa3);                                                                              \
    } while (0)
    int j = j_lo;
    for (; j + 2 < j_hi; j += 3) { FSTEP(0, j); FSTEP(1, j + 1); FSTEP(2, j + 2); }
    if (j < j_hi) { FSTEP(0, j); if (j + 1 < j_hi) FSTEP(1, j + 1); }
#undef FSTEP
    __syncthreads();
}
}

__device__ const unsigned char ATT_ITEMS[80] = {15, 30, 31, 63, 14, 28, 29, 61, 62, 13, 26, 27, 59, 60, 12, 24, 25, 57, 58, 11, 22, 23, 55, 56, 10, 20, 21, 53, 54, 9, 18, 19, 51, 52, 8, 16, 17, 49, 50, 7, 48, 6, 5,
    72, 73, 74, 75, 76, 77, 78, 79, 80, 81, 82, 83, 84, 85, 86, 87, 88, 89, 90, 91, 92, 93, 94, 95, 4, 71, 3, 70, 2, 69, 1, 68, 0, 67, 66, 65, 64};
constexpr int CW_QUEUE = 6144;
constexpr int CW_CVTQ = 6144 + 256;
constexpr int CW_CMPR = 8192 + 2048;

constexpr int CW_MIXC = 12288;
template <int NR> __device__ __forceinline__ void mix_rows(const Frame& F, int r0, int lane);
__device__ __forceinline__ void p_attn(const Frame& F, unsigned char* lds_raw, int rep) {
    using namespace att;
    WV w;
#define WV_INIT() do { int ln_ = F.lane; asm volatile("" : "+v"(ln_)); w.tid = F.wave * 64 + ln_; w.wid = F.wave; w.lane = ln_; w.r32 = ln_ & 31; w.hi = ln_ >> 5; \
        w.lds = (char*)lds_raw + 1024; w.ldsL = (LAS unsigned char*)lds_raw + 1024; w.vb0 = (int)(uintptr_t)(w.lds) + att::L_V + v_rd_base(ln_); } while (0)
    WV_INIT();
    const bf16_t* qn = (const bf16_t*)(F.ws + WS_QN); const bf16_t* qrp = (const bf16_t*)(F.ws + WS_QR); const bf16_t* kv = (const bf16_t*)(F.ws + WS_KV);
    const bf16_t* ckv = (const bf16_t*)(F.ws + WS_CMPKV);
    bf16_t* ocmp = (bf16_t*)(F.ws + WS_OCMP); bf16_t* owin = (bf16_t*)(F.ws + WS_OWIN); bf16_t* osel = (bf16_t*)(F.ws + WS_OSEL); float* ml = (float*)(F.ws + WS_ML);
    unsigned* qctr = (unsigned*)(F.ws + WS_CTL) + CW_QUEUE + 64 * rep;
    float* wsf = (float*)(w.lds + L_WS) + w.wid * 64;
    float* part = (float*)(w.lds + L_PART); unsigned* selm = (unsigned*)(w.lds + L_SELM); float* vals = (float*)(w.lds + L_VALS) + w.wid * 64; volatile int* itemw = (volatile int*)(w.lds + L_ITEM);
    const int hr = w.wid >> 1, th = w.wid & 1;
    unsigned* mixc = (unsigned*)(F.ws + WS_CTL) + CW_MIXC;
    int prev = -1;
    for (;;) {
        asm volatile("s_waitcnt vmcnt(0)" ::: "memory");
        __syncthreads();
        if (F.tid == 0) { if (prev >= 0) (void)__hip_atomic_fetch_add(mixc + 16 * prev, 1u, __ATOMIC_RELAXED, __HIP_MEMORY_SCOPE_AGENT); itemw[0] = (int)atomicAdd(qctr, 1u); }
        __syncthreads();
        const int item = itemw[0];
        if (item >= 640 + 512) break;
        if (item >= 640) {
            const int mi = item - 640, mqb = 31 - (mi >> 4), mb = (mi >> 2) & 3, mh = mi & 3; const unsigned need = 2u * (2u + (mqb >= 16 ? 1u : 0u));
            if (F.tid == 0) { unsigned sp = 0u; while (xb_ld(mixc + 16 * (mb * 32 + mqb)) < need) { __builtin_amdgcn_s_sleep(2); if (++sp > (1u << 22)) break; }
                __builtin_amdgcn_fence(__ATOMIC_ACQUIRE, "agent"); asm volatile("s_waitcnt vmcnt(0)" ::: "memory"); }
            __syncthreads();
            mix_rows<2>(F, mb * SEQ + mqb * 64 + mh * 16 + F.wave * 2, fresh_lane());
            prev = -1; continue;
        }
        WV_INIT();
        const int ent = ATT_ITEMS[item >> 3], bg = item & 7, type = ent >> 5, qb = ent & 31, b = bg >> 1, g = bg & 1, h = 4 * g + hr;
        prev = b * 32 + qb;
        const int t0 = qb * 64 + th * 32, tpos = t0 + w.r32, tok0 = b * SEQ + t0;
        const size_t qoff = (((size_t)b * NH + h) * SEQ + t0 + w.r32) * HD + w.hi * 8;
        const size_t kvoff = ((size_t)b * NG + g) * SEQ * HD;
        bf16x8 qr[8];
        f32x16 o[4];
#ifndef ATT_NO_WIN
        if (type == 2) {
#pragma unroll
            for (int d0 = 0; d0 < 8; ++d0) qr[d0] = *(const bf16x8*)(qrp + qoff + d0 * 16);
#pragma unroll
            for (int d = 0; d < 4; ++d) o[d] = f32x16{};
            float m_reg = -1e30f, l_reg = 0.f;
            flash_pass<1>(w, kv + (size_t)4 * (4 * MB / 2) + kvoff, kv + (size_t)5 * (4 * MB / 2) + kvoff, qb >= 8 ? qb - 8 : 0, qb + 1, qr, tpos, t0, 0u, o, m_reg, l_reg);
            if (w.hi == 0) wsf[w.r32] = 1.f / l_reg;
            asm volatile("s_waitcnt lgkmcnt(0)" ::: "memory");
            store_o(w, o, wsf, owin + (size_t)tok0 * 1024 + h * HD);
            continue;
        }
#endif
#ifndef ATT_NO_CMP
        {
#pragma unroll
            for (int d0 = 0; d0 < 8; ++d0) qr[d0] = *(const bf16x8*)(qn + qoff + d0 * 16);
            const bf16_t* Kc = ckv + (size_t)bg * 128 * HD; const bf16_t* Vc = ckv + (size_t)1024 * HD + (size_t)bg * 128 * HD;
            dma_tile(w, Kc, Vc, 0); dma_tile(w, Kc + 64 * HD, Vc + 64 * HD, 1);
            asm volatile("s_waitcnt vmcnt(0)" ::: "memory");
            __syncthreads();
            f32x16 pA0, pA1, pB0, pB1;
            qkt<0>(w, qr, pA0, pA1); qkt<1>(w, qr, pB0, pB1);
            const int nmax = tpos >= 31 ? ((tpos - 31) >> 4) : -1;
            const float NEG = -__builtin_inff();
            float pmax = NEG;
#pragma unroll
            for (int r = 0; r < 16; ++r) { const int n = crow(r, w.hi);
                pA0[r] = (n <= nmax) ? pA0[r] : NEG; pA1[r] = (n + 32 <= nmax) ? pA1[r] : NEG; pB0[r] = (n + 64 <= nmax) ? pB0[r] : NEG; pB1[r] = (n + 96 <= nmax) ? pB1[r] : NEG;
                pmax = fmaxf(fmaxf(pmax, pA0[r]), fmaxf(pA1[r], fmaxf(pB0[r], pB1[r]))); }
            pmax = swap_max(pmax);
            const float mm = (pmax == NEG) ? 0.f : pmax;
            const float mnL = -mm * C2;
            float ps = 0.f;
#pragma unroll
            for (int r = 0; r < 16; ++r) { pA0[r] = __builtin_amdgcn_exp2f(fmaf(pA0[r], C2, mnL)); pA1[r] = __builtin_amdgcn_exp2f(fmaf(pA1[r], C2, mnL));
                pB0[r] = __builtin_amdgcn_exp2f(fmaf(pB0[r], C2, mnL)); pB1[r] = __builtin_amdgcn_exp2f(fmaf(pB1[r], C2, mnL)); ps += (pA0[r] + pA1[r]) + (pB0[r] + pB1[r]); }
            ps = swap_sum(ps);
            const float inv = ps > 0.f ? 1.f / ps : 0.f;
#pragma unroll
            for (int r = 0; r < 16; ++r) { pA0[r] *= inv; pA1[r] *= inv; pB0[r] *= inv; pB1[r] *= inv; }
            {
                float av[16], bv[16];
#pragma unroll
                for (int gq = 0; gq < 4; ++gq) {
                    av[gq]      = pA0[4 * gq] + pA0[4 * gq + 1] + pA0[4 * gq + 2] + 0.5f * pA0[4 * gq + 3]; bv[gq]      = 0.5f * pA0[4 * gq + 3];
                    av[4 + gq]  = pA1[4 * gq] + pA1[4 * gq + 1] + pA1[4 * gq + 2] + 0.5f * pA1[4 * gq + 3]; bv[4 + gq]  = 0.5f * pA1[4 * gq + 3];
                    av[8 + gq]  = pB0[4 * gq] + pB0[4 * gq + 1] + pB0[4 * gq + 2] + 0.5f * pB0[4 * gq + 3]; bv[8 + gq]  = 0.5f * pB0[4 * gq + 3];
                    av[12 + gq] = pB1[4 * gq] + pB1[4 * gq + 1] + pB1[4 * gq + 2] + 0.5f * pB1[4 * gq + 3]; bv[12 + gq] = 0.5f * pB1[4 * gq + 3];
                }
                float* prow = part + ((size_t)hr * 64 + th * 32 + w.r32) * 33;
#pragma unroll
                for (int idx = 0; idx < 16; ++idx) {
                    const float bo = __shfl_xor(bv[idx], 32);
                    const float bprev = (idx > 0) ? __shfl_xor(bv[idx > 0 ? idx - 1 : 0], 32) : 0.f;
                    const float inc = w.hi ? bo : bprev;
                    prow[2 * idx + w.hi] = av[idx] + inc;
                }
            }
            if (type == 0) {
                bf16x8 pa0, pa1, pa2, pa3;
#pragma unroll
                for (int d = 0; d < 4; ++d) o[d] = f32x16{};
                pack_p(pA0, pA1, pa0, pa1, pa2, pa3); pv_tile<0>(o, w.vb0, pa0, pa1, pa2, pa3);
                pack_p(pB0, pB1, pa0, pa1, pa2, pa3); pv_tile<1>(o, w.vb0, pa0, pa1, pa2, pa3);
                if (w.hi == 0) wsf[w.r32] = 1.f;
                asm volatile("s_waitcnt lgkmcnt(0)" ::: "memory");
                store_o(w, o, wsf, ocmp + (size_t)tok0 * 1024 + h * HD);
            }
            __syncthreads();
#pragma unroll 1
            for (int ps2 = 0; ps2 < 4; ++ps2) {
                int ln = w.lane; asm volatile("" : "+v"(ln));
                const int j = ln & 31, hi2 = ln >> 5;
                const int tk = 8 * w.wid + 2 * ps2 + hi2, t = qb * 64 + tk, cur = qb;
                float imp = 0.f;
#pragma unroll
                for (int r = 0; r < 4; ++r) imp += part[((size_t)r * 64 + tk) * 33 + j];
                const bool ok = (64 * j <= t), forced = (j == 0) || (cur - j >= 0 && cur - j < 2);
                const float val = (ok && forced) ? 1.0e30f : (ok ? imp : -1.0e30f);
                vals[ln] = val;
                asm volatile("s_waitcnt lgkmcnt(0)" ::: "memory");
                int rank = 0;
#pragma unroll
                for (int jj = 0; jj < 32; ++jj) { const float o2 = vals[hi2 * 32 + jj]; rank += (o2 > val || (o2 == val && jj < j)) ? 1 : 0; }
                const unsigned long long bal = __ballot(rank < 16 && val >= 0.f);
                if (w.lane == 0) { selm[8 * w.wid + 2 * ps2] = (unsigned)bal; selm[8 * w.wid + 2 * ps2 + 1] = (unsigned)(bal >> 32); }
            }
            __syncthreads();
        }
#endif
#ifndef ATT_NO_SEL
        {
            WV_INIT();
            const unsigned sm = selm[th * 32 + w.r32];
            const int ntile = qb + 1, hsplit = (ntile + 1) >> 1;
            const int ja = (qb >= 16 && type == 1) ? hsplit : 0, jb = (qb >= 16 && type == 0) ? hsplit : ntile;
#pragma unroll
            for (int d0 = 0; d0 < 8; ++d0) qr[d0] = *(const bf16x8*)(qrp + qoff + d0 * 16);
#pragma unroll
            for (int d = 0; d < 4; ++d) o[d] = f32x16{};
            float m_reg = -1e30f, l_reg = 0.f;
            flash_pass<0>(w, kv + (size_t)2 * (4 * MB / 2) + kvoff, kv + (size_t)3 * (4 * MB / 2) + kvoff, ja, jb, qr, tpos, t0, sm, o, m_reg, l_reg);
            if (w.hi == 0) { wsf[w.r32] = l_reg > 0.f ? 1.f / l_reg : 0.f; float* mp = ml + (((size_t)type * NT + tok0 + w.r32) * NH + h) * 2; __hip_atomic_store(mp, m_reg, __ATOMIC_RELAXED, __HIP_MEMORY_SCOPE_AGENT); __hip_atomic_store(mp + 1, l_reg, __ATOMIC_RELAXED, __HIP_MEMORY_SCOPE_AGENT); }
            asm volatile("s_waitcnt lgkmcnt(0)" ::: "memory");
            store_o(w, o, wsf, osel + (size_t)type * NT * 1024 + (size_t)tok0 * 1024 + h * HD);
        }
#endif
    }
}

struct CvtTile { const float* src; const float* ksc; bf16_t* dst0; int sld, ldd, mode; };
__device__ __forceinline__ CvtTile cvt_decode(const Frame& F, int t) {
    CvtTile c; c.ksc = nullptr; c.mode = 0;
    if (t < 4096) { const int e = t >> 7, mat = (t >> 6) & 1, kt = (t >> 1) & 31, nt = t & 1;
        c.src = (mat ? F.in[I_WUP] : F.in[I_WGATE]) + ((size_t)e * DM + kt * 64) * FF + nt * 256; c.sld = FF; c.ksc = F.in[I_LNMOE] + kt * 64;
        c.dst0 = (bf16_t*)(F.ws + WS_W1T) + ((size_t)e * 1024 + nt * 512 + mat * 128) * DM + kt * 64; c.ldd = DM; c.mode = 1; return c; }
    t -= 4096;
    if (t < 2048) { const int e = t >> 6, kt = (t >> 3) & 7, nt = t & 7;
        c.src = F.in[I_WDOWN] + ((size_t)e * FF + kt * 64) * DM + nt * 256; c.sld = DM;
        c.dst0 = (bf16_t*)(F.ws + WS_W2T) + ((size_t)e * 2048 + nt * 256) * FF + kt * 64; c.ldd = FF; return c; }
    t -= 2048;
    if (t < 256) { const int kt = t >> 3, nt = t & 7;
        c.src = F.in[I_WOUT] + (size_t)kt * 64 * DM + nt * 256; c.sld = DM; c.dst0 = (bf16_t*)(F.ws + WS_WOUTT) + (size_t)nt * 256 * DM + kt * 64; c.ldd = DM; return c; }
    t -= 256;
    if (t < 480) { const int kt = t / 15, nt = t % 15;
        c.src = F.in[I_WIN] + (size_t)kt * 64 * INW; c.sld = INW; c.ksc = F.in[I_LNMIX] + kt * 64;
        c.dst0 = (bf16_t*)(F.ws + WS_WINT) + (size_t)nt * 256 * DM + kt * 64; c.ldd = DM; c.mode = 2 + nt; return c; }
    t -= 480;
    { const int kv = t >> 6, kt = t & 63;
      c.src = (kv ? F.in[I_WV1] : F.in[I_WK1]) + (size_t)kt * 64 * 256; c.sld = 256; c.dst0 = (bf16_t*)(F.ws + WS_CMPW) + (size_t)kv * 256 * 4096 + kt * 64; c.ldd = 4096; return c; }
}
constexpr int N_CVT_TILES = 4096 + 2048 + 256 + 480 + 128;
__device__ __forceinline__ void cvt_load(const CvtTile& c, int nq, int kq, float4 (&v)[8]) {
    const float* p = c.src + 4 * nq; bool valid = true;
    if (c.mode >= 2) { const int n = (c.mode - 2) * 256 + 4 * nq; int sc = -1; if (n < 2560) sc = n; else if (n < 3584) sc = n + 24; else if (n < 3608) sc = n - 1024; valid = sc >= 0; p = c.src + (valid ? sc : 0); }
#pragma unroll
    for (int i = 0; i < 8; ++i) v[i] = valid ? *(const float4*)(p + (size_t)(kq * 8 + i) * c.sld) : make_float4(0.f, 0.f, 0.f, 0.f);
}

constexpr int CVT_RUN = 4;
__device__ __forceinline__ void cvt_stream(const Frame& F, int t_lo, int t_hi, unsigned* queue, int sfirst = -1, int sstride = 0) {
    if (sfirst < 0) { sfirst = F.bid; sstride = F.G; }
    float* T = F.lds;
    volatile int* nxtw = (volatile int*)(F.lds + 64 * 257);
    const int tid = F.tid, nq = tid & 63, kq = tid >> 6;
    int tA, tB; float4 vA[8], vB[8]; CvtTile cA, cB;
    if (queue) { __syncthreads(); if (tid == 0) { nxtw[0] = t_lo + CVT_RUN * (int)atomicAdd(queue, 1u); nxtw[1] = t_lo + CVT_RUN * (int)atomicAdd(queue, 1u); } __syncthreads(); tA = nxtw[0]; tB = nxtw[1]; }
    else { tA = t_lo + sfirst; tB = tA + sstride; }
    if (tA < t_hi) { cA = cvt_decode(F, tA); cvt_load(cA, nq, kq, vA); }
    if (tB < t_hi) { cB = cvt_decode(F, tB); cvt_load(cB, nq, kq, vB); }
#define CVT_STEP(tX, cX, vX, slot) do {                                                                                                     \
        const bool pop = queue && (((tX) - t_lo) % CVT_RUN == CVT_RUN - 1);                 \
        int tn_reg = 0;                                                                                                                      \
        if (pop && tid == 0) tn_reg = t_lo + CVT_RUN * (int)atomicAdd(queue, 1u);                                                            \
        __syncthreads();                                                                                                                     \
        _Pragma("unroll") for (int i = 0; i < 8; ++i) { const float s = cX.ksc ? cX.ksc[kq * 8 + i] : 1.f; float* tp = T + (kq * 8 + i) * 257 + 4 * nq; \
            tp[0] = vX[i].x * s; tp[1] = vX[i].y * s; tp[2] = vX[i].z * s; tp[3] = vX[i].w * s; }                                           \
        if (pop && tid == 0) nxtw[slot] = tn_reg;                                                                                            \
        __syncthreads();                                                                                                                     \
        const CvtTile cc = cX; const int tn = queue ? (pop ? nxtw[slot] : tX + 1) : tX + 2 * sstride;                                            \
        if (tn < t_hi) { cX = cvt_decode(F, tn); cvt_load(cX, nq, kq, vX); }                                                                 \
        _Pragma("unroll") for (int j = 0; j < 4; ++j) { const int id = tid + 512 * j, n = id >> 3, kc = id & 7; const float* tp = T + (kc * 8) * 257 + n; \
            pg8::u32x4 w; w.x = pg8::cvt_pk_bf16(tp[0], tp[257]); w.y = pg8::cvt_pk_bf16(tp[2 * 257], tp[3 * 257]); w.z = pg8::cvt_pk_bf16(tp[4 * 257], tp[5 * 257]); w.w = pg8::cvt_pk_bf16(tp[6 * 257], tp[7 * 257]); \
            const int rowi = (cc.mode == 1) ? ((n >> 7) * 256 + (n & 127)) : n;                                                              \
            *(pg8::u32x4*)(cc.dst0 + (size_t)rowi * cc.ldd + kc * 8) = w; }                                                                  \
        tX = tn; } while (0)
    while (tA < t_hi) {
        CVT_STEP(tA, cA, vA, 0);
        if (tB >= t_hi) { const int t2 = tA; tA = tB; tB = t2; const CvtTile c2 = cA; cA = cB; cB = c2;
#pragma unroll
            for (int i = 0; i < 8; ++i) { const float4 x = vA[i]; vA[i] = vB[i]; vB[i] = x; }
            continue; }
        CVT_STEP(tB, cB, vB, 1);
    }
    while (tB < t_hi) CVT_STEP(tB, cB, vB, 1);
#undef CVT_STEP
    __syncthreads();
}

__device__ __forceinline__ void p0_tables(const Frame& F, int first, int stride) {
    {
        const float* wp = F.in[I_WPOOL]; const float* ps = F.in[I_PSCALE]; const float* bp = F.in[I_BPOOL]; bf16_t* wpt = (bf16_t*)(F.ws + WS_POOLW); float* pb = (float*)(F.ws + WS_POOLB);
        for (int idx = first * NTHREADS + F.tid; idx < 4 * 256 * 256; idx += stride * NTHREADS) { const int k = idx & 255, n = (idx >> 8) & 255, g = idx >> 16;
            wpt[idx] = f2bf(wp[((size_t)g * 256 + k) * 256 + n] * ps[g * 256 + n]); }
        for (int idx = first * NTHREADS + F.tid; idx < 1024; idx += stride * NTHREADS) pb[idx] = bp[idx] * ps[idx];
    }
    { const float* lnm = F.in[I_LNMOE]; const float* wre = F.in[I_WRE]; const float* wrg = F.in[I_WRG]; float* WRP = (float*)(F.ws + WS_WRP);
      for (int idx = first * NTHREADS + F.tid; idx < DM * 48; idx += stride * NTHREADS) { const int k = idx / 48, c = idx - k * 48;
          WRP[idx] = c < 32 ? lnm[k] * wre[((size_t)(c >> 3) * DM + k) * 8 + (c & 7)] : (c < 36 ? lnm[k] * wrg[k * 4 + (c - 32)] : 0.f); } }
    for (int it = first; it < 256; it += stride) {
        const int kv = it >> 7, jb = (it >> 5) & 3, mc = it & 31;
        const float* pe = (kv ? F.in[I_PEV] : F.in[I_PEK]); const float* w1 = (kv ? F.in[I_WV1] : F.in[I_WK1]);
        const int mg = F.tid >> 6, j = jb * 64 + (F.tid & 63);
        float a = 0.f;
#pragma unroll
        for (int q = 0; q < 16; ++q) { const int m = mc * 128 + mg + 8 * q; a += pe[m] * w1[(size_t)m * 256 + j]; }
        __syncthreads();
        F.lds[F.tid] = a;
        __syncthreads();
        if (F.tid < 64) { float s = 0.f; for (int q = 0; q < 8; ++q) s += F.lds[q * 64 + F.tid]; ((float*)(F.ws + WS_BIAS1))[(mc * 2 + kv) * 256 + j] = s; }
        __syncthreads();
    }
}
__device__ __forceinline__ void p0_prologue(const Frame& F) {
    const float* x = F.in[I_X];
    bf16_t* xb = (bf16_t*)(F.ws + WS_XB); float* rstd1 = (float*)(F.ws + WS_RSTD1);
    const int gw = F.bid * NWAVES + F.wave, nw = F.G * NWAVES, lane = F.lane;
    for (int r = gw; r < NT; r += 2 * nw) {
        const int r2 = r + nw; const bool has2 = r2 < NT;
        float4 v[8], v2[8]; float ss = 0.f, ss2 = 0.f;
#pragma unroll
        for (int i = 0; i < 8; ++i) { v[i] = *(const float4*)(x + (size_t)r * DM + i * 256 + lane * 4); v2[i] = has2 ? *(const float4*)(x + (size_t)r2 * DM + i * 256 + lane * 4) : make_float4(0.f, 0.f, 0.f, 0.f); }
#pragma unroll
        for (int i = 0; i < 8; ++i) { ss += v[i].x * v[i].x + v[i].y * v[i].y + v[i].z * v[i].z + v[i].w * v[i].w; ss2 += v2[i].x * v2[i].x + v2[i].y * v2[i].y + v2[i].z * v2[i].z + v2[i].w * v2[i].w; }
        ss = wave_sum(ss); ss2 = wave_sum(ss2);
        if (lane == 0) { rstd1[r] = rsqrtf(ss * (1.f / DM) + EPS); if (has2) rstd1[r2] = rsqrtf(ss2 * (1.f / DM) + EPS); }
#pragma unroll
        for (int i = 0; i < 8; ++i) { uint2 w; w.x = pg8::cvt_pk_bf16(v[i].x, v[i].y); w.y = pg8::cvt_pk_bf16(v[i].z, v[i].w);
            *(uint2*)(xb + (size_t)r * DM + i * 256 + lane * 4) = w;
            if (has2) { uint2 w2; w2.x = pg8::cvt_pk_bf16(v2[i].x, v2[i].y); w2.y = pg8::cvt_pk_bf16(v2[i].z, v2[i].w); *(uint2*)(xb + (size_t)r2 * DM + i * 256 + lane * 4) = w2; } }
    }
    cvt_stream(F, 6400, N_CVT_TILES, nullptr);
    {
        const int* pos = (const int*)F.in[I_POS]; float* rc = (float*)(F.ws + WS_ROPEC); float* rs = (float*)(F.ws + WS_ROPES);
        for (int idx = F.bid * NTHREADS + F.tid; idx < NB * SEQ * 16; idx += F.G * NTHREADS) {
            const int i = idx & 15, bs = idx >> 4;
            const float inv = exp2f(-(float)i * (1.f / 16.f) * 18.931568569324174f);
            const float ang = (float)pos[bs] * inv;
            rc[idx] = cosf(ang); rs[idx] = sinf(ang);
        }
    }
}

struct EpiProj {
    static constexpr bool AFTER_DRAIN = false;
    const float* rstd1; const float* rc; const float* rs; bf16_t* qn; bf16_t* qr; bf16_t* kv; bf16_t* u; float* gates;
    __device__ __forceinline__ void operator()(const pg8::f32x4 (&acc)[2][2][4][2], const pg8::Unit& un, int wr, int wc, int fr, int fq) const {
        const int pn = un.pn;
#pragma unroll
        for (int ai = 0; ai < 2; ++ai)
#pragma unroll
            for (int m = 0; m < 4; ++m) {
                const int row = un.pm * 256 + ai * 128 + wr * 64 + m * 16 + fr; const float r1 = rstd1[row]; const int b = row >> 11, s = row & 2047;
                if (pn < 10) {
                    const bool ropeu = (pn < 4) || pn == 6 || pn == 8;
                    pg8::f32x4 c4 = {1.f, 1.f, 1.f, 1.f}, s4 = {0.f, 0.f, 0.f, 0.f};
                    if (ropeu && wc == 0) { c4 = *(const pg8::f32x4*)(rc + (size_t)row * 16 + 4 * fq); s4 = *(const pg8::f32x4*)(rs + (size_t)row * 16 + 4 * fq); }
#pragma unroll
                    for (int bj = 0; bj < 2; ++bj) {
                        const pg8::f32x4 v0 = acc[ai][bj][m][0] * r1, v1 = acc[ai][bj][m][1] * r1;
                        const int d0 = 32 * wc + 4 * fq;
                        pg8::f32x4 o0 = v0, o1 = v1;
                        if (ropeu && wc == 0) { o0 = v0 * c4 - v1 * s4; o1 = v1 * c4 + v0 * s4; }
                        uint2 w0, w1; w0.x = pg8::cvt_pk_bf16(o0[0], o0[1]); w0.y = pg8::cvt_pk_bf16(o0[2], o0[3]); w1.x = pg8::cvt_pk_bf16(o1[0], o1[1]); w1.y = pg8::cvt_pk_bf16(o1[2], o1[3]);
                        if (pn < 4) {
                            const size_t o = (((size_t)b * NH + 2 * pn + bj) * SEQ + s) * HD + d0;
                            uint2 n0, n1; n0.x = pg8::cvt_pk_bf16(v0[0], v0[1]); n0.y = pg8::cvt_pk_bf16(v0[2], v0[3]); n1.x = pg8::cvt_pk_bf16(v1[0], v1[1]); n1.y = pg8::cvt_pk_bf16(v1[2], v1[3]);
                            *(uint2*)(qn + o) = n0; *(uint2*)(qn + o + 16) = n1; *(uint2*)(qr + o) = w0; *(uint2*)(qr + o + 16) = w1;
                        } else {
                            const size_t o = (size_t)(pn - 4) * (4 * MB / 2) + (((size_t)b * NG + bj) * SEQ + s) * HD + d0;
                            *(uint2*)(kv + o) = w0; *(uint2*)(kv + o + 16) = w1;
                        }
                    }
                } else if (pn < 14) {
#pragma unroll
                    for (int bj = 0; bj < 2; ++bj)
#pragma unroll
                        for (int n = 0; n < 2; ++n) { const pg8::f32x4 v = acc[ai][bj][m][n] * r1; uint2 w_; w_.x = pg8::cvt_pk_bf16(v[0], v[1]); w_.y = pg8::cvt_pk_bf16(v[2], v[3]);
                            *(uint2*)(u + (size_t)row * 1024 + (pn - 10) * 256 + bj * 128 + wc * 32 + n * 16 + 4 * fq) = w_; }
                } else {
                    if (wc == 0) { *(pg8::f32x4*)(gates + (size_t)row * 24 + 4 * fq) = acc[ai][0][m][0] * r1; if (fq < 2) *(pg8::f32x4*)(gates + (size_t)row * 24 + 16 + 4 * fq) = acc[ai][0][m][1] * r1; }
                }
            }
    }
};

__device__ __forceinline__ void p1_proj(const Frame& F, LAS unsigned char* stage) {
    pg8::DenseOrder S; S.init(F.ws + WS_XB, F.ws + WS_WINT, DM, DM, NT, INWP, F.G, F.bid);
    EpiProj E{(const float*)(F.ws + WS_RSTD1), (const float*)(F.ws + WS_ROPEC), (const float*)(F.ws + WS_ROPES), (bf16_t*)(F.ws + WS_QN), (bf16_t*)(F.ws + WS_QR), (bf16_t*)(F.ws + WS_KV),
              (bf16_t*)(F.ws + WS_U), (float*)(F.ws + WS_GATES)};
    pg8::gemm_phase<EpiProj, pg8::DenseOrder, false>(stage, DM, DM, DM, S, E);
}

__device__ __forceinline__ void p4_cmp2(const Frame& F, int first, int stride, bool gated) {
    const float* part = (const float*)(F.ws + WS_CPART); const float* bias1p = (const float*)(F.ws + WS_BIAS1); bf16_t* ckv = (bf16_t*)(F.ws + WS_CMPKV);
    float* H = F.lds;
    float* W2 = F.lds + 8 * 260;
    unsigned* ctl = (unsigned*)(F.ws + WS_CTL);
    int w2_of = -1;
    for (int it = first; it < 256; it += stride) {
        const int kvi = it >> 7, r0 = (it & 127) * 8; const float* w2 = kvi ? F.in[I_WV2] : F.in[I_WK2];
        __syncthreads();
        if (gated && F.tid == 0) { unsigned* cw = ctl + CW_CMPR + 64 * (kvi * 4 + (r0 >> 8)); unsigned sp = 0;
            while (__hip_atomic_load(cw, __ATOMIC_RELAXED, __HIP_MEMORY_SCOPE_AGENT) < 8u) { __builtin_amdgcn_s_sleep(2);
                if ((++sp & 255u) == 0u) { if (xb_ld(&ctl[XB_TMO])) break; if (sp > XB_SPIN_CAP) { atomicAdd(&ctl[XB_TMO], 1u); break; } } }
            __builtin_amdgcn_fence(__ATOMIC_ACQUIRE, "agent"); asm volatile("s_waitcnt vmcnt(0)" ::: "memory"); }
        if (gated) __syncthreads();
        if (w2_of != kvi) {
#pragma unroll
            for (int j = 0; j < 16; ++j) { const int idx = F.tid + 512 * j; *(pg8::f32x4*)(W2 + idx * 4) = *(const pg8::f32x4*)(w2 + idx * 4); }
            w2_of = kvi;
        }
        { const int r = F.tid >> 6, c = (F.tid & 63) * 4;
            pg8::f32x4 s = {0.f, 0.f, 0.f, 0.f};
#pragma unroll
            for (int sp = 0; sp < 8; ++sp) s += *(const pg8::f32x4*)(part + (((size_t)sp * 2 + kvi) * 1024 + r0 + r) * 256 + c);
#pragma unroll
            for (int sp = 0; sp < 32; ++sp) s += *(const pg8::f32x4*)(bias1p + (sp * 2 + kvi) * 256 + c);
            H[r * 260 + c] = gelu_tanh(s[0]); H[r * 260 + c + 1] = gelu_tanh(s[1]); H[r * 260 + c + 2] = gelu_tanh(s[2]); H[r * 260 + c + 3] = gelu_tanh(s[3]); }
        __syncthreads();
        const int r = F.tid >> 6, c0 = (F.tid & 63) * 2;
        float a0 = 0.f, a1 = 0.f;
#pragma unroll 16
        for (int k = 0; k < 256; ++k) { const float hv = H[r * 260 + k]; const float2 wv = *(const float2*)(W2 + k * 128 + c0); a0 += hv * wv.x; a1 += hv * wv.y; }
        const int R = r0 + r; const bool pad = (R & 127) == 127;
        *(unsigned*)(ckv + ((size_t)kvi * 1024 + R) * 128 + c0) = pad ? 0u : pg8::cvt_pk_bf16(a0, a1);
    }
}

struct CmpOrder {
    const char* kc; const char* w1t; int c;
    __device__ __forceinline__ bool next(int i, pg8::Unit& u) const { if (i > 0) return false; u.e = c >> 5; u.pm = (c >> 3) & 3; u.pn = c & 7; u.li = 0; return true; }
    __device__ __forceinline__ const char* a_base(const pg8::Unit& u) const { return kc + (size_t)u.e * 4 * MB + ((size_t)u.pm * 256 * 2048 + u.pn * 512) * 2; }
    __device__ __forceinline__ const char* b_base(const pg8::Unit& u) const { return w1t + ((size_t)u.e * 256 * 4096 + u.pn * 512) * 2; }
    __device__ __forceinline__ unsigned a_row_off(const pg8::Unit&, int r) const { return (unsigned)r * 4096u; }
};
struct EpiCmp {
    static constexpr bool AFTER_DRAIN = false;
    float* part;
    __device__ __forceinline__ void operator()(const pg8::f32x4 (&acc)[2][2][4][2], const pg8::Unit& un, int wr, int wc, int fr, int fq) const {
        float* base = part + (((size_t)un.pn * 2 + un.e) * 1024 + un.pm * 256) * 256;
#pragma unroll
        for (int ai = 0; ai < 2; ++ai)
#pragma unroll
            for (int m = 0; m < 4; ++m) { float* rowp = base + (size_t)(ai * 128 + wr * 64 + m * 16 + fr) * 256 + wc * 32 + 4 * fq;
#pragma unroll
                for (int bj = 0; bj < 2; ++bj)
#pragma unroll
                    for (int n = 0; n < 2; ++n) *(pg8::f32x4*)(rowp + bj * 128 + n * 16) = acc[ai][bj][m][n]; }
    }
};
struct PoolOrder {
    const char* d; const char* wpt; int c;
    __device__ __forceinline__ bool next(int i, pg8::Unit& u) const { if (i > 0) return false; u.pm = c >> 2; u.pn = 0; u.e = c & 3; u.li = 0; return true; }
    __device__ __forceinline__ const char* a_base(const pg8::Unit& u) const { return d + ((size_t)u.pm * 256 * 1024 + u.e * 256) * 2; }
    __device__ __forceinline__ const char* b_base(const pg8::Unit& u) const { return wpt + (size_t)u.e * 256 * 256 * 2; }
    __device__ __forceinline__ unsigned a_row_off(const pg8::Unit&, int r) const { return (unsigned)r * 2048u; }
};
struct EpiPool {
    static constexpr bool AFTER_DRAIN = false;
    const float* pb; bf16_t* opool;
    __device__ __forceinline__ void operator()(const pg8::f32x4 (&acc)[2][2][4][2], const pg8::Unit& un, int wr, int wc, int fr, int fq) const {
#pragma unroll
        for (int ai = 0; ai < 2; ++ai)
#pragma unroll
            for (int m = 0; m < 4; ++m) { const int row = un.pm * 256 + ai * 128 + wr * 64 + m * 16 + fr;
#pragma unroll
                for (int bj = 0; bj < 2; ++bj)
#pragma unroll
                    for (int n = 0; n < 2; ++n) { const int c = un.e * 256 + bj * 128 + wc * 32 + n * 16 + 4 * fq;
                        const pg8::f32x4 v = acc[ai][bj][m][n] + *(const pg8::f32x4*)(pb + c); uint2 w_; w_.x = pg8::cvt_pk_bf16(v[0], v[1]); w_.y = pg8::cvt_pk_bf16(v[2], v[3]);
                        *(uint2*)(opool + (size_t)row * 1024 + c) = w_; } }
    }
};
__device__ __forceinline__ void p2a_mid(const Frame& F, LAS unsigned char* stage) {
    if (F.bid < 64) {
        CmpOrder S{(const char*)(F.ws + WS_KV), (const char*)(F.ws + WS_CMPW), F.bid};
        EpiCmp E{(float*)(F.ws + WS_CPART)};
        pg8::gemm_phase<EpiCmp, CmpOrder, false>(stage, 512, 2048, 4096, S, E);
    } else {
        const bf16_t* u = (const bf16_t*)(F.ws + WS_U); bf16_t* d = (bf16_t*)(F.ws + WS_DBUF);
        for (int ch = F.bid - 64; ch < NT / 16; ch += F.G - 64) {
            const int r0 = ch * 16, s0 = r0 & 2047, col = 2 * F.tid, w = 2 << (col >> 8);
            float u0[31], u1[31];
#pragma unroll
            for (int q = 0; q < 31; ++q) { const int s = s0 - 15 + q; const unsigned pr = (s >= 0) ? *(const unsigned*)(u + (size_t)(r0 - 15 + q) * 1024 + col) : 0u;
                u0[q] = __uint_as_float(pr << 16); u1[q] = __uint_as_float(pr & 0xFFFF0000u); }
#pragma unroll
            for (int i = 0; i < 16; ++i) { float sa = 0.f, sb = 0.f;
#pragma unroll
                for (int q = 0; q < 16; ++q) if (q < w) { sa += u0[15 + i - q]; sb += u1[15 + i - q]; }
                const int s = s0 + i, cnt = (s + 1 < w) ? s + 1 : w; const float ic = 1.f / (float)cnt;
                *(unsigned*)(d + (size_t)(r0 + i) * 1024 + col) = pg8::cvt_pk_bf16(sa * ic - u0[15 + i], sb * ic - u1[15 + i]); }
        }
        p0_tables(F, F.bid - 64, F.G - 64);
    }
}
__device__ __forceinline__ void p2b_mid(const Frame& F, LAS unsigned char* stage) {
    if (F.bid < 128) {
        PoolOrder S{(const char*)(F.ws + WS_DBUF), (const char*)(F.ws + WS_POOLW), F.bid};
        EpiPool E{(const float*)(F.ws + WS_POOLB), (bf16_t*)(F.ws + WS_OPOOL)};
        pg8::gemm_phase<EpiPool, PoolOrder, false>(stage, 256, 1024, 256, S, E);
    } else {
        p4_cmp2(F, F.bid - 128, F.G - 128, false);
        cvt_stream(F, 6144, 6400, nullptr, F.bid - 128, F.G - 128);
    }
}

__device__ __forceinline__ void unpack8(const pg8::u32x4 w, float (&f)[8]) {
    f[0] = __uint_as_float(w.x << 16); f[1] = __uint_as_float(w.x & 0xFFFF0000u); f[2] = __uint_as_float(w.y << 16); f[3] = __uint_as_float(w.y & 0xFFFF0000u);
    f[4] = __uint_as_float(w.z << 16); f[5] = __uint_as_float(w.z & 0xFFFF0000u); f[6] = __uint_as_float(w.w << 16); f[7] = __uint_as_float(w.w & 0xFFFF0000u);
}
struct MixRow { pg8::u32x4 c[2], w[2], s[2], t[2], p[2]; float gq0, gq1, gq2, m0, l0, m1, l1; };
__device__ __forceinline__ void mix_load(const Frame& F, int r, int lane, bool split, MixRow& R) {
    const bf16_t* ocmp = (const bf16_t*)(F.ws + WS_OCMP); const bf16_t* owin = (const bf16_t*)(F.ws + WS_OWIN); const bf16_t* osel = (const bf16_t*)(F.ws + WS_OSEL);
    const float* ml = (const float*)(F.ws + WS_ML); const float* gates = (const float*)(F.ws + WS_GATES); const bf16_t* opool = (const bf16_t*)(F.ws + WS_OPOOL);
    const int h = lane >> 3; const size_t o = (size_t)r * 1024 + lane * 16;
#pragma unroll
    for (int hf = 0; hf < 2; ++hf) { R.c[hf] = *(const pg8::u32x4*)(ocmp + o + hf * 8); R.w[hf] = *(const pg8::u32x4*)(owin + o + hf * 8); R.s[hf] = *(const pg8::u32x4*)(osel + o + hf * 8);
        R.t[hf] = split ? *(const pg8::u32x4*)(osel + (size_t)NT * 1024 + o + hf * 8) : R.s[hf]; R.p[hf] = *(const pg8::u32x4*)(opool + o + hf * 8); }
    const float* gq = gates + (size_t)r * 24 + h * 3; R.gq0 = gq[0]; R.gq1 = gq[1]; R.gq2 = gq[2];
    R.m0 = 0.f; R.l0 = 1.f; R.m1 = 0.f; R.l1 = 0.f;
    if (split) { const float* m0p = ml + ((size_t)r * NH + h) * 2; const float* m1p = ml + (((size_t)NT + r) * NH + h) * 2; R.m0 = m0p[0]; R.l0 = m0p[1]; R.m1 = m1p[0]; R.l1 = m1p[1]; }
}
__device__ __forceinline__ void mix_finish(const Frame& F, int r, int lane, bool split, const MixRow& R, const float (&ga)[16], const float (&gb)[16]) {
    bf16_t* mix = (bf16_t*)(F.ws + WS_MIX);
    const float g0 = 1.f / (1.f + __expf(-R.gq0)), g1 = 1.f / (1.f + __expf(-R.gq1)), g2 = 1.f / (1.f + __expf(-R.gq2));
    float w0 = 1.f, w1 = 0.f;
    if (split) { const float M = fmaxf(R.m0, R.m1); const float a0 = R.l0 * exp2f((R.m0 - M) * att::C2), a1 = R.l1 * exp2f((R.m1 - M) * att::C2), inv = 1.f / (a0 + a1); w0 = a0 * inv; w1 = a1 * inv; }
    float a[16], p[16]; float sa = 0.f, sp = 0.f;
#pragma unroll
    for (int hf = 0; hf < 2; ++hf) {
        float c8[8], w8[8], s8[8], t8[8], p8[8];
        unpack8(R.c[hf], c8); unpack8(R.w[hf], w8); unpack8(R.s[hf], s8); unpack8(R.t[hf], t8); unpack8(R.p[hf], p8);
#pragma unroll
        for (int j = 0; j < 8; ++j) { const float os = split ? (w0 * s8[j] + w1 * t8[j]) : s8[j]; a[hf * 8 + j] = g0 * c8[j] + g1 * os + g2 * w8[j]; sa += a[hf * 8 + j] * a[hf * 8 + j];
            p[hf * 8 + j] = p8[j]; sp += p8[j] * p8[j]; }
    }
    sa = wave_sum(sa); sp = wave_sum(sp);
    const float ra = rsqrtf(sa * (1.f / 1024.f) + EPS), rp = rsqrtf(sp * (1.f / 1024.f) + EPS);
#pragma unroll
    for (int hf = 0; hf < 2; ++hf) { pg8::u32x4 wa, wb;
        wa.x = pg8::cvt_pk_bf16(a[hf * 8] * ra * ga[hf * 8], a[hf * 8 + 1] * ra * ga[hf * 8 + 1]); wa.y = pg8::cvt_pk_bf16(a[hf * 8 + 2] * ra * ga[hf * 8 + 2], a[hf * 8 + 3] * ra * ga[hf * 8 + 3]);
        wa.z = pg8::cvt_pk_bf16(a[hf * 8 + 4] * ra * ga[hf * 8 + 4], a[hf * 8 + 5] * ra * ga[hf * 8 + 5]); wa.w = pg8::cvt_pk_bf16(a[hf * 8 + 6] * ra * ga[hf * 8 + 6], a[hf * 8 + 7] * ra * ga[hf * 8 + 7]);
        wb.x = pg8::cvt_pk_bf16(p[hf * 8] * rp * gb[hf * 8], p[hf * 8 + 1] * rp * gb[hf * 8 + 1]); wb.y = pg8::cvt_pk_bf16(p[hf * 8 + 2] * rp * gb[hf * 8 + 2], p[hf * 8 + 3] * rp * gb[hf * 8 + 3]);
        wb.z = pg8::cvt_pk_bf16(p[hf * 8 + 4] * rp * gb[hf * 8 + 4], p[hf * 8 + 5] * rp * gb[hf * 8 + 5]); wb.w = pg8::cvt_pk_bf16(p[hf * 8 + 6] * rp * gb[hf * 8 + 6], p[hf * 8 + 7] * rp * gb[hf * 8 + 7]);
        *(pg8::u32x4*)(mix + (size_t)r * DM + lane * 16 + hf * 8) = wa; *(pg8::u32x4*)(mix + (size_t)r * DM + 1024 + lane * 16 + hf * 8) = wb; }
}
template <int NR>
__device__ __forceinline__ void mix_rows(const Frame& F, int r0, int lane) {
    const float* gn = F.in[I_GNNSA]; const float* gp = F.in[I_GNPOOL];
    float ga[16], gb[16];
#pragma unroll
    for (int q = 0; q < 4; ++q) { const pg8::f32x4 v = *(const pg8::f32x4*)(gn + lane * 16 + q * 4), u = *(const pg8::f32x4*)(gp + lane * 16 + q * 4);
        ga[q * 4] = v[0]; ga[q * 4 + 1] = v[1]; ga[q * 4 + 2] = v[2]; ga[q * 4 + 3] = v[3]; gb[q * 4] = u[0]; gb[q * 4 + 1] = u[1]; gb[q * 4 + 2] = u[2]; gb[q * 4 + 3] = u[3]; }
    const bool split = ((r0 & 2047) >> 6) >= 16;
    MixRow A, B;
    mix_load(F, r0, lane, split, A);
#pragma unroll 1
    for (int i = 0; i < NR; i += 2) {
        mix_load(F, r0 + i + 1, lane, split, B);
        mix_finish(F, r0 + i, lane, split, A, ga, gb);
        if (i + 2 < NR) mix_load(F, r0 + i + 2, lane, split, A);
        mix_finish(F, r0 + i + 1, lane, split, B, ga, gb);
    }
}

struct EpiOut {
    static constexpr bool AFTER_DRAIN = true;
    const float* x; float* out; bf16_t* x1b; const float* lnm; const float* wrp; float* pl;
    __device__ __forceinline__ void fused(pg8::f32x4 (&acc)[2][2][4][2], const pg8::Unit& un, int wr, int wc, int fr, int fq, LAS unsigned char* lds) const {
#pragma unroll
        for (int ai = 0; ai < 2; ++ai)
#pragma unroll
            for (int m = 0; m < 4; ++m) {
                const int row = un.pm * 256 + ai * 128 + wr * 64 + m * 16 + fr;
#pragma unroll
                for (int bj = 0; bj < 2; ++bj)
#pragma unroll
                    for (int n = 0; n < 2; ++n) {
                        const size_t o = (size_t)row * DM + un.pn * 256 + bj * 128 + wc * 32 + n * 16 + 4 * fq;
                        const pg8::f32x4 v = acc[ai][bj][m][n] + *(const pg8::f32x4*)(x + o);
                        acc[ai][bj][m][n] = v;
                        const pg8::f32x4 g = *(const pg8::f32x4*)(lnm + un.pn * 256 + bj * 128 + wc * 32 + n * 16 + 4 * fq);
                        uint2 w; w.x = pg8::cvt_pk_bf16(v[0] * g[0], v[1] * g[1]); w.y = pg8::cvt_pk_bf16(v[2] * g[2], v[3] * g[3]); *(uint2*)(x1b + o) = w;
                    }
            }
        float* red = (float*)((unsigned char*)lds);
        const int tid = threadIdx.x;
#pragma unroll 1
        for (int ai = 0; ai < 2; ++ai) {
#pragma unroll
            for (int m = 0; m < 4; ++m) {
                pg8::f32x4 D0 = {0.f, 0.f, 0.f, 0.f}, D1 = D0, D2 = D0; float s2 = 0.f;
#pragma unroll
                for (int bj = 0; bj < 2; ++bj)
#pragma unroll
                    for (int n = 0; n < 2; ++n) {
                        const pg8::f32x4 v = (ai == 0) ? acc[0][bj][m][n] : acc[1][bj][m][n];
                        s2 += v[0] * v[0] + v[1] * v[1] + v[2] * v[2] + v[3] * v[3];
                        const float* wb = wrp + (size_t)(un.pn * 256 + bj * 128 + wc * 32 + n * 16 + 4 * fq) * 48 + fr;
#pragma unroll
                        for (int j = 0; j < 4; ++j) {
                            D0 = __builtin_amdgcn_mfma_f32_16x16x4f32(v[j], wb[j * 48], D0, 0, 0, 0);
                            D1 = __builtin_amdgcn_mfma_f32_16x16x4f32(v[j], wb[j * 48 + 16], D1, 0, 0, 0);
                            D2 = __builtin_amdgcn_mfma_f32_16x16x4f32(v[j], wb[j * 48 + 32], D2, 0, 0, 0);
                        }
                    }
                s2 += __shfl_xor(s2, 16); s2 += __shfl_xor(s2, 32);
                float* rr = red + ((size_t)wc * 128 + wr * 64 + m * 16) * 40;
#pragma unroll
                for (int r = 0; r < 4; ++r) { float* q = rr + (4 * fq + r) * 40; q[fr] = D0[r]; q[16 + fr] = D1[r]; if (fr < 8) q[32 + fr] = D2[r]; }
                if (fq == 0) rr[fr * 40 + 36] = s2;
            }
            __syncthreads();
            for (int idx = tid; idx < 128 * 40; idx += 512) { const int r = idx / 40, c = idx - r * 40;
                const float s = (red[idx] + red[128 * 40 + idx]) + (red[2 * 128 * 40 + idx] + red[3 * 128 * 40 + idx]);
                if (c < 37) __hip_atomic_store(&pl[((size_t)un.pn * NT + un.pm * 256 + ai * 128 + r) * 40 + c], s, __ATOMIC_RELAXED, __HIP_MEMORY_SCOPE_AGENT); }
            __syncthreads();
        }
    }
};
__device__ __forceinline__ void p8_router(const Frame& F, int dummy, int wv0 = -1, int wv1 = NT / 8, int wstep = 0) {
    const float* pl = (const float*)(F.ws + WS_PL); const float* brg = F.in[I_BRG]; const float* bre = F.in[I_BRE];
    float* rstd2 = (float*)(F.ws + WS_RSTD2); int* arow = (int*)(F.ws + WS_AROW); int* tokl = (int*)(F.ws + WS_TOKL); float* gatel = (float*)(F.ws + WS_GATEL);
    unsigned* cnt = (unsigned*)(F.ws + WS_CTL) + (dummy ? 10240 + 1024 : CW_CNT);
    const int gw = wv0 < 0 ? F.bid * NWAVES + F.wave : wv0 + F.wave, nw = wv0 < 0 ? F.G * NWAVES : wstep, lane = fresh_lane(), tl = lane >> 3, pn = lane & 7;
    for (int wv = gw; wv < wv1; wv += nw) {
        const int r = wv * 8 + tl;
        const float* p = pl + ((size_t)pn * NT + r) * 40;
        float v[37];
#pragma unroll
        for (int q = 0; q < 9; ++q) { const pg8::f32x4 t = *(const pg8::f32x4*)(p + 4 * q); v[4 * q] = t[0]; v[4 * q + 1] = t[1]; v[4 * q + 2] = t[2]; v[4 * q + 3] = t[3]; }
        v[36] = p[36];
#pragma unroll
        for (int c = 0; c < 37; ++c) { v[c] += __shfl_xor(v[c], 1); v[c] += __shfl_xor(v[c], 2); v[c] += __shfl_xor(v[c], 4); }
        if (pn == 0) {
            const float rs = rsqrtf(v[36] * (1.f / DM) + EPS);
            float lg[4];
#pragma unroll
            for (int j = 0; j < 4; ++j) lg[j] = v[32 + j] * rs + brg[j];
            int gs = 0; float gm = lg[0];
#pragma unroll
            for (int j = 1; j < 4; ++j) if (lg[j] > gm) { gm = lg[j]; gs = j; }
            float den = 0.f;
#pragma unroll
            for (int j = 0; j < 4; ++j) den += __expf(lg[j] - gm);
            const float pg = 1.f / den;
            float le[8];
#pragma unroll
            for (int j = 0; j < 8; ++j) { const float s = (gs == 0) ? v[j] : (gs == 1) ? v[8 + j] : (gs == 2) ? v[16 + j] : v[24 + j]; le[j] = s * rs + bre[gs * 8 + j]; }
            int e0 = 0; float m0 = le[0];
#pragma unroll
            for (int j = 1; j < 8; ++j) if (le[j] > m0) { m0 = le[j]; e0 = j; }
            int e1 = -1; float m1 = -3.0e38f;
#pragma unroll
            for (int j = 0; j < 8; ++j) if (j != e0 && le[j] > m1) { m1 = le[j]; e1 = j; }
            const float p1 = __expf(m1 - m0);
            const float gate0 = pg / (1.f + p1), gate1 = pg * p1 / (1.f + p1);
            rstd2[r] = rs;
            const int ea = gs * 8 + e0, eb = gs * 8 + e1;
            const unsigned sa = atomicAdd(&cnt[64 * ea], 1u), sb = atomicAdd(&cnt[64 * eb], 1u);
            tokl[ea * 8192 + sa] = r; gatel[ea * 8192 + sa] = gate0; tokl[eb * 8192 + sb] = r; gatel[eb * 8192 + sb] = gate1;
            arow[2 * r] = ea * 8192 + (int)sa; arow[2 * r + 1] = eb * 8192 + (int)sb;
        }
    }
}

constexpr int CW_PANEL = 12288 + 2048;
constexpr bool ROUTER_FUSED_OK = true;
__device__ __forceinline__ bool router_fused(const Frame& F) { return ROUTER_FUSED_OK && F.G == (NT / 256) * (DM / 256); }
__device__ __forceinline__ void p7_out(const Frame& F, LAS unsigned char* stage, unsigned char* lds_raw) {
    pg8::DenseOrder S; S.init(F.ws + WS_MIX, F.ws + WS_WOUTT, DM, DM, NT, DM, F.G, F.bid);
    EpiOut E{F.in[I_X], F.out, (bf16_t*)(F.ws + WS_X1B), F.in[I_LNMOE], (const float*)(F.ws + WS_WRP), (float*)(F.ws + WS_PL)};
    pg8::gemm_phase<EpiOut, pg8::DenseOrder, false>(stage, DM, DM, DM, S, E);
    if (router_fused(F)) {
        pg8::Unit u; (void)S.next(0, u);
        asm volatile("s_waitcnt vmcnt(0)" ::: "memory");
        __syncthreads();
        volatile LAS int* lastw = (volatile LAS int*)((LAS unsigned char*)lds_raw + 32);
        if (F.wave == 0 && fresh_lane() == 0) {
            const unsigned old = __hip_atomic_fetch_add((unsigned*)(F.ws + WS_CTL) + CW_PANEL + 64 * u.pm, 1u, __ATOMIC_RELAXED, __HIP_MEMORY_SCOPE_AGENT);
            if (old == 7u) { __builtin_amdgcn_fence(__ATOMIC_ACQUIRE, "agent"); asm volatile("s_waitcnt vmcnt(0)" ::: "memory"); }
            lastw[0] = (old == 7u) ? 1 : 0;
        }
        __syncthreads();
        if (lastw[0]) p8_router(F, 0, u.pm * 32, u.pm * 32 + 32, NWAVES);
    }
}

__device__ __forceinline__ void moe_counts(const Frame& F, int* cnts  , int* pst  ) {
    const unsigned* cnt = (const unsigned*)(F.ws + WS_CTL) + CW_CNT;
    __syncthreads();
    if (F.tid < 32) cnts[F.tid] = (int)__hip_atomic_load(&cnt[64 * F.tid], __ATOMIC_RELAXED, __HIP_MEMORY_SCOPE_AGENT);
    __syncthreads();
    if (F.tid == 0) { int a = 0; for (int e = 0; e < 32; ++e) { pst[e] = a; a += (cnts[e] + 255) & ~255; } pst[32] = a; }
    __syncthreads();
}

constexpr int MOE_TAB_OFF = 1024 + 131072;
struct MoeTabs { int* cnts; int* pst; int* ust; int* usth; int* rowtok; };
__device__ __forceinline__ MoeTabs moe_tabs(unsigned char* lds_raw) { MoeTabs T; T.cnts = (int*)(lds_raw + MOE_TAB_OFF); T.pst = T.cnts + 32; T.ust = T.pst + 40; T.usth = T.ust + 40; T.rowtok = T.usth + 40; return T; }
template <int NTN> __device__ __forceinline__ void moe_units(const Frame& F, const MoeTabs& T) {
    moe_counts(F, T.cnts, T.pst);
    if (F.tid == 0) { int a = 0, h = 0; for (int e = 0; e < 32; ++e) { const int c = T.cnts[e], nmt = (c + 255) >> 8, hl = (nmt > 0 && c - 256 * (nmt - 1) <= 128) ? 1 : 0;
            T.ust[e] = a; T.usth[e] = h; a += (nmt - hl) * NTN; h += hl * NTN; } T.ust[32] = a; T.usth[32] = h; }
    __syncthreads();
}
template <int NTN> struct MoeOrder2 {
    const int* cnts; const int* pst; const int* ust; const int* usth; const int* rowtok; const bf16_t* A; const float* W0; const float* W1; int G, c, lda, ldb, gather, narrow;
    __device__ __forceinline__ bool next(int i, g2::Unit& u) const {
        int L = i * G + c; u.li = i;
        if (L < ust[32]) {
            int e = 0; while (ust[e + 1] <= L) ++e;
            const int w = L - ust[e], c_ = cnts[e], nmt = (c_ + 255) >> 8, nf = nmt - ((c_ - 256 * (nmt - 1) <= 128) ? 1 : 0);
            u.e = e; u.pn = w / nf; u.pm = w - u.pn * nf; u.half = 0; return true; }
        L -= ust[32];
        const int Lh = narrow ? (L >> 1) : L; if (Lh >= usth[32]) return false;
        int e = 0; while (usth[e + 1] <= Lh) ++e;
        u.e = e; u.pn = Lh - usth[e]; u.pm = ((cnts[e] + 255) >> 8) - 1; u.half = narrow ? 2 + (L & 1) : 1; return true;
    }
    __device__ __forceinline__ int nvalid(const g2::Unit& u) const { const int v = cnts[u.e] - u.pm * 256; return v < 256 ? v : 256; }
    __device__ __forceinline__ unsigned a_off(const g2::Unit& u, int r) const {
        if (gather) { const int tk = rowtok[u.li * 256 + r]; return (unsigned)(tk < 0 ? 0 : tk) * (unsigned)lda * 2u; }
        return (unsigned)(pst[u.e] + u.pm * 256 + r) * (unsigned)lda * 2u;
    }
    __device__ __forceinline__ const float* b_col(const g2::Unit& u, int col) const {
        if (gather) { const int wcp = col >> 5, n = (col >> 4) & 1, i = col & 15; return (n ? W1 : W0) + (size_t)u.e * DM * FF + u.pn * 64 + 16 * wcp + i; }
        return W0 + (size_t)u.e * FF * DM + u.pn * 128 + col;
    }
};
struct EpiMoe1 {
    const int* pst; const int* rowtok; const float* rstd2; bf16_t* act;
    __device__ __forceinline__ void operator()(const pg8::f32x4 (&acc)[2][4][2], const g2::Unit& un, int wr, int wc, int fr, int fq) const {
        if (un.half >= 2 && (wc >> 1) != (un.half & 1)) return;
#pragma unroll
        for (int ai = 0; ai < 2; ++ai)
#pragma unroll
            for (int m = 0; m < 4; ++m) {
                const int r = ai * 128 + wr * 64 + m * 16 + fr; const int tk = rowtok[un.li * 256 + r];
                if (tk >= 0) {
                    const float rs = rstd2[tk];
                    const pg8::f32x4 vg = acc[ai][m][0] * rs, vu = acc[ai][m][1] * rs; float o[4];
#pragma unroll
                    for (int j = 0; j < 4; ++j) o[j] = vg[j] / (1.f + __expf(-vg[j])) * vu[j];
                    uint2 w; w.x = pg8::cvt_pk_bf16(o[0], o[1]); w.y = pg8::cvt_pk_bf16(o[2], o[3]);
                    *(uint2*)(act + (size_t)(pst[un.e] + un.pm * 256 + r) * FF + un.pn * 64 + wc * 16 + 4 * fq) = w;
                }
            }
    }
};
struct EpiMoe2 {
    const int* cnts; const int* pst; const float* gatel; bf16_t* y;
    __device__ __forceinline__ void operator()(const pg8::f32x4 (&acc)[2][4][2], const g2::Unit& un, int wr, int wc, int fr, int fq) const {
#pragma unroll
        for (int ai = 0; ai < 2; ++ai)
#pragma unroll
            for (int m = 0; m < 4; ++m) {
                const int slot = un.pm * 256 + ai * 128 + wr * 64 + m * 16 + fr;
                if (slot < cnts[un.e]) {
                    const float gt = gatel[un.e * 8192 + slot];
                    bf16_t* dst = y + (size_t)(pst[un.e] + slot) * DM + un.pn * 128 + wc * 32 + 4 * fq;
#pragma unroll
                    for (int n = 0; n < 2; ++n) { const pg8::f32x4 v = acc[ai][m][n] * gt; uint2 w; w.x = pg8::cvt_pk_bf16(v[0], v[1]); w.y = pg8::cvt_pk_bf16(v[2], v[3]); *(uint2*)(dst + n * 16) = w; }
                }
            }
    }
};

__device__ __forceinline__ void p9_moe1(const Frame& F, unsigned char* lds_raw, LAS unsigned char* stage) {
    const MoeTabs T = moe_tabs(lds_raw);
    moe_units<8>(F, T);
    const int vc = (F.G % 8 == 0) ? (F.bid % 8) * (F.G / 8) + F.bid / 8 : F.bid;
    MoeOrder2<8> S{T.cnts, T.pst, T.ust, T.usth, T.rowtok, (const bf16_t*)(F.ws + WS_X1B), F.in[I_WGATE], F.in[I_WUP], F.G, vc, DM, FF, 1, 1};
    { const int* tokl = (const int*)(F.ws + WS_TOKL); g2::Unit u;
      for (int i = 0; i < 4 && S.next(i, u); ++i) { if (F.tid < 256) { const int slot = u.pm * 256 + F.tid; T.rowtok[i * 256 + F.tid] = slot < T.cnts[u.e] ? tokl[u.e * 8192 + slot] : -1; } } }
    asm volatile("s_waitcnt vmcnt(0) lgkmcnt(0)" ::: "memory");
    __syncthreads();
    EpiMoe1 E{T.pst, T.rowtok, (const float*)(F.ws + WS_RSTD2), (bf16_t*)(F.ws + WS_ACT)};
    g2::gemm<DM / 64, EpiMoe1, MoeOrder2<8>>(stage, S, E, F.wave, (PROBE_REPEAT >= 30 && PROBE_REPEAT <= 33) ? (unsigned long long*)(lds_raw + 512) : nullptr);
}

__device__ __forceinline__ void p10_moe2(const Frame& F, unsigned char* lds_raw, LAS unsigned char* stage) {
    const MoeTabs T = moe_tabs(lds_raw);
    moe_units<16>(F, T);
    const int vc = (F.G % 8 == 0) ? (F.bid % 8) * (F.G / 8) + F.bid / 8 : F.bid;
    MoeOrder2<16> S{T.cnts, T.pst, T.ust, T.usth, nullptr, (const bf16_t*)(F.ws + WS_ACT), F.in[I_WDOWN], nullptr, F.G, vc, FF, DM, 0, 0};
    EpiMoe2 E{T.cnts, T.pst, (const float*)(F.ws + WS_GATEL), (bf16_t*)(F.ws + WS_Y)};
    g2::gemm<FF / 64, EpiMoe2, MoeOrder2<16>>(stage, S, E, F.wave);
}

__device__ __forceinline__ void p11_final(const Frame& F, int dummy) {
    int* cnts = (int*)(F.lds + 3072); int* pst = cnts + 32;
    moe_counts(F, cnts, pst);
    const bf16_t* y = (const bf16_t*)(F.ws + WS_Y); const int* arow = (const int*)(F.ws + WS_AROW); const float* lnf = F.in[I_LNFINAL];
    const int gw = F.bid * NWAVES + F.wave, nw = F.G * NWAVES, lane = fresh_lane();
    const bf16_t* x1b = (const bf16_t*)(F.ws + WS_X1B); const float* lnm = F.in[I_LNMOE];
    float4 ig[8];
#pragma unroll
    for (int i = 0; i < 8; ++i) { const float4 g = *(const float4*)(lnm + i * 256 + lane * 4); ig[i].x = 1.f / g.x; ig[i].y = 1.f / g.y; ig[i].z = 1.f / g.z; ig[i].w = 1.f / g.w; }
    for (int r = gw; r < NT; r += nw) {
        const int a0 = arow[2 * r], a1 = arow[2 * r + 1];
        const size_t r0 = (size_t)(pst[a0 >> 13] + (a0 & 8191)), r1 = (size_t)(pst[a1 >> 13] + (a1 & 8191));
        float v[32]; float ss = 0.f;
#pragma unroll
        for (int i = 0; i < 8; ++i) { const int c = i * 256 + lane * 4; const uint2 xq = *(const uint2*)(x1b + (size_t)r * DM + c);
            float4 xv; xv.x = __uint_as_float(xq.x << 16) * ig[i].x; xv.y = __uint_as_float(xq.x & 0xFFFF0000u) * ig[i].y; xv.z = __uint_as_float(xq.y << 16) * ig[i].z; xv.w = __uint_as_float(xq.y & 0xFFFF0000u) * ig[i].w;
            const uint2 ya = *(const uint2*)(y + r0 * DM + c), yb = *(const uint2*)(y + r1 * DM + c);
            v[4 * i]     = xv.x + __uint_as_float(ya.x << 16) + __uint_as_float(yb.x << 16);
            v[4 * i + 1] = xv.y + __uint_as_float(ya.x & 0xFFFF0000u) + __uint_as_float(yb.x & 0xFFFF0000u);
            v[4 * i + 2] = xv.z + __uint_as_float(ya.y << 16) + __uint_as_float(yb.y << 16);
            v[4 * i + 3] = xv.w + __uint_as_float(ya.y & 0xFFFF0000u) + __uint_as_float(yb.y & 0xFFFF0000u);
            ss += v[4 * i] * v[4 * i] + v[4 * i + 1] * v[4 * i + 1] + v[4 * i + 2] * v[4 * i + 2] + v[4 * i + 3] * v[4 * i + 3]; }
        ss = wave_sum(ss);
        const float rs = rsqrtf(ss * (1.f / DM) + EPS);
#pragma unroll
        for (int i = 0; i < 8; ++i) { const int c = i * 256 + lane * 4; const float4 g = *(const float4*)(lnf + c);
            float4 o; o.x = v[4 * i] * rs * g.x; o.y = v[4 * i + 1] * rs * g.y; o.z = v[4 * i + 2] * rs * g.z; o.w = v[4 * i + 3] * rs * g.w;
            *(float4*)((dummy ? (float*)(F.ws + WS_W1T) : F.out) + (size_t)r * DM + c) = o; }
    }
}

constexpr int NPHASE = 11;
__global__ void __launch_bounds__(NTHREADS, 2) fwd(Args args) {
    extern __shared__ __attribute__((aligned(16))) unsigned char lds_raw[];
    Frame F;
#pragma unroll
    for (int i = 0; i < N_IN; ++i) F.in[i] = args.in[i];
    F.out = args.out; F.ws = args.ws;
    F.lds = (float*)(lds_raw + 16);
    F.tid = threadIdx.x; F.lane = F.tid & 63; F.wave = __builtin_amdgcn_readfirstlane(F.tid >> 6); F.G = gridDim.x; F.bid = blockIdx.x;
    if (F.tid < 4) ((LAS unsigned*)lds_raw)[F.tid] = 0u;
    __syncthreads();
    XcdBarrier bar; bar.bar = (unsigned*)(F.ws + WS_CTL); bar.x = 0; bar.st = nullptr;
    if (N_LAUNCHES == 1) bar = xcd_barrier_post((unsigned*)(F.ws + WS_CTL), (volatile LAS unsigned*)lds_raw);
    bar.wave = F.wave;
    const int lo = args.ph_lo, hi = args.ph_hi;
#ifndef ONLY_PHASE
#define ONLY_PHASE -1
#endif
#define IN(k) (lo <= (k) && (k) < hi && (ONLY_PHASE < 0 || ONLY_PHASE == (k)))
#define SEAM(k) do { if (IN(k) && IN((k) + 1)) { const unsigned long long tb_ = (PROBE_REPEAT >= 40) ? (unsigned long long)__builtin_readcyclecounter() : 0ull; xcd_barrier(bar); if (PROBE_REPEAT == 12) xcd_barrier(bar); \
        if (PROBE_REPEAT == 40 || PROBE_REPEAT == 41 + (k)) tbar += (unsigned long long)__builtin_readcyclecounter() - tb_; if (PROBE_REPEAT == 60 + (k)) tbar = (unsigned long long)__builtin_readcyclecounter() - t_k0; } } while (0)
    unsigned long long tbar = 0ull; const unsigned long long t_k0 = (PROBE_REPEAT >= 60) ? (unsigned long long)__builtin_readcyclecounter() : 0ull;
    LAS unsigned char* stage = (LAS unsigned char*)lds_raw + 1024;
#define RUN(k, ...) do { if (IN(k)) { __VA_ARGS__; if (PROBE_REPEAT == (k)) { xcd_barrier(bar); __VA_ARGS__; } } } while (0)
    RUN(0, p0_prologue(F));
    if (PROBE_REPEAT == 11 && IN(0)) { xcd_barrier(bar); cvt_stream(F, 0, 6400, nullptr); }
    SEAM(0);
    RUN(1, p1_proj(F, stage));
    SEAM(1);
    RUN(2, p2a_mid(F, stage));
    SEAM(2);
    RUN(3, p2b_mid(F, stage));
    SEAM(3);
    if (IN(4)) {
#pragma unroll 1
        for (int rep = 0; rep < (PROBE_REPEAT == 4 ? 2 : 1); ++rep) { if (rep) xcd_barrier(bar); p_attn(F, lds_raw, rep); } }
    SEAM(5);
    RUN(6, p7_out(F, stage, lds_raw));
    if (!router_fused(F)) { SEAM(6);
        if (IN(7)) p8_router(F, 0); }
    SEAM(7);
#define REFRESH_LANE() do { F.lane = fresh_lane(); F.tid = F.wave * 64 + F.lane; } while (0)
    REFRESH_LANE();
    if (IN(8)) {
#pragma unroll 1
        for (int rep = 0; rep < (PROBE_REPEAT == 8 ? 2 : 1); ++rep) { if (rep) xcd_barrier(bar); p9_moe1(F, lds_raw, stage); } }
    SEAM(8);
    REFRESH_LANE();
    if (IN(9)) {
#pragma unroll 1
        for (int rep = 0; rep < (PROBE_REPEAT == 9 ? 2 : 1); ++rep) { if (rep) xcd_barrier(bar); p10_moe2(F, lds_raw, stage); } }
    SEAM(9);
    REFRESH_LANE();
    if (IN(10)) { if (PROBE_REPEAT == 10) { p11_final(F, 1); xcd_barrier(bar); } const unsigned long long tf0 = (PROBE_REPEAT == 70) ? (unsigned long long)__builtin_readcyclecounter() : 0ull; p11_final(F, 0); if (PROBE_REPEAT == 70) tbar = (unsigned long long)__builtin_readcyclecounter() - tf0; }
#undef RUN
    if (PROBE_REPEAT >= 40 && blockIdx.x == PROBE_WG && threadIdx.x == 0) *(volatile unsigned long long*)(lds_raw + 512) = tbar;
    if (((PROBE_REPEAT >= 30 && PROBE_REPEAT <= 33) || PROBE_REPEAT >= 40) && blockIdx.x == PROBE_WG && threadIdx.x == 0) {
        const unsigned long long want = 4ull * *(volatile unsigned long long*)(lds_raw + 512), t0 = __builtin_readcyclecounter();
        while ((unsigned long long)__builtin_readcyclecounter() - t0 < want) __builtin_amdgcn_s_sleep(8);
    }
#undef IN
#undef SEAM
}

extern "C" void kernel_launch(void* const* d_in, const int* in_sizes, int n_in, void* d_out, int out_size, void* d_ws, size_t ws_size, hipStream_t stream) {
    static int grid = 0;
    if (grid == 0) {
        if (n_in != N_IN || out_size != NT * DM || ws_size < WS_END) { fprintf(stderr, "kernel_launch: unexpected shapes: n_in %d out %d ws %zu (need %zu)\n", n_in, out_size, ws_size, (size_t)WS_END); grid = -1; return; }
        int dev = 0, cus = 0, per_cu = 0;
        if (hipGetDevice(&dev) != hipSuccess || hipDeviceGetAttribute(&cus, hipDeviceAttributeMultiprocessorCount, dev) != hipSuccess) { grid = -1; return; }
        if (hipFuncSetAttribute((const void*)fwd, hipFuncAttributeMaxDynamicSharedMemorySize, LDS_BYTES) != hipSuccess) { fprintf(stderr, "kernel_launch: hipFuncSetAttribute failed\n"); grid = -1; return; }
        if (hipOccupancyMaxActiveBlocksPerMultiprocessor(&per_cu, (const void*)fwd, NTHREADS, LDS_BYTES) != hipSuccess || per_cu < 1) { fprintf(stderr, "kernel_launch: occupancy query says %d\n", per_cu); }
        (void)hipGetLastError();
        grid = cus;
    }
    if (grid < 0) return;
    (void)in_sizes;
    (void)hipMemsetAsync((char*)d_ws + WS_CTL, 0, CTL_ZERO_BYTES, stream);
    Args a{};
    for (int i = 0; i < N_IN; ++i) a.in[i] = (const float*)d_in[i];
    a.out = (float*)d_out; a.ws = (unsigned char*)d_ws;
    if (N_LAUNCHES == 1) { a.ph_lo = 0; a.ph_hi = NPHASE; hipLaunchKernelGGL(fwd, dim3(grid), dim3(NTHREADS), LDS_BYTES, stream, a); }
    else { for (int p = 0; p < NPHASE; ++p) { a.ph_lo = p; a.ph_hi = p + 1; hipLaunchKernelGGL(fwd, dim3(grid), dim3(NTHREADS), LDS_BYTES, stream, a); } }
}
```

```cpp
#include <hip/hip_runtime.h>
#include <cstdio>
#include <cstdint>

#ifndef PROBE_REPEAT
#define PROBE_REPEAT -1
#endif
#ifndef MERGE_CMP2
#define MERGE_CMP2 0
#endif
#ifndef PROBE_WG
#define PROBE_WG 0
#endif
#ifndef N_LAUNCHES
#define N_LAUNCHES 1
#endif

#define XB_TMO      128
#define XB_XCNT(j)  (256  + 64 * (j))
#define XB_XSUB(j)  (1280 + 64 * (j))
#define XB_XGEN(j)  (2304 + 64 * (j))
#define XB_TOP      3328
#define XB_TOPGEN   3392
#define XCD_BAR_WORDS 3456
#define XB_SPIN_CAP (1u << 21)
#define LAS __attribute__((address_space(3)))

__device__ __forceinline__ unsigned xb_ld(unsigned* p)              { return __hip_atomic_load(p, __ATOMIC_RELAXED, __HIP_MEMORY_SCOPE_AGENT); }
__device__ __forceinline__ unsigned xb_add(unsigned* p, unsigned v) { return __hip_atomic_fetch_add(p, v, __ATOMIC_RELAXED, __HIP_MEMORY_SCOPE_AGENT); }
__device__ __forceinline__ unsigned xb_xcc_id() { return (unsigned)__builtin_amdgcn_s_getreg((3 << 11) | 20) & 0xFu; }
#define XB_SPIN(cond, bar) do { unsigned _sp = 0; while (cond) { __builtin_amdgcn_s_sleep(1); \
    if ((++_sp & 255u) == 0u) { if (xb_ld(&(bar)[XB_TMO])) break; if (_sp > XB_SPIN_CAP) { atomicAdd(&(bar)[XB_TMO], 1u); break; } } } } while (0)

struct XcdBarrier { unsigned* bar; unsigned x; volatile LAS unsigned* st; int wave; };

__device__ __forceinline__ XcdBarrier xcd_barrier_post(unsigned* bar, volatile LAS unsigned* st) {
    XcdBarrier b; b.bar = bar; b.x = xb_xcc_id(); b.st = st;
    if (threadIdx.x == 0) (void)xb_add(&bar[XB_XCNT(b.x)], 1u);
    return b;
}
__device__ __forceinline__ void xcd_barrier_complete(unsigned* bar, unsigned x, unsigned& nloc, unsigned& nx) {
    const unsigned G = gridDim.x * gridDim.y * gridDim.z;
    unsigned sum, cnt, mine, sp = 0u;
    for (;;) {
        sum = 0u; cnt = 0u; mine = 0u;
#pragma unroll
        for (unsigned j = 0; j < 16; ++j) { const unsigned c = xb_ld(&bar[XB_XCNT(j)]); sum += c; cnt += (c > 0u) ? 1u : 0u; mine = (j == x) ? c : mine; }
        if (sum == G) break;
        __builtin_amdgcn_s_sleep(1);
        if ((++sp & 255u) == 0u) { if (xb_ld(&bar[XB_TMO])) break; if (sp > XB_SPIN_CAP) { atomicAdd(&bar[XB_TMO], 1u); break; } }
    }
    nloc = mine > 0u ? mine : 1u; nx = cnt > 0u ? cnt : 1u;
}
__device__ __forceinline__ int fresh_lane();
__device__ __forceinline__ void xcd_barrier(const XcdBarrier& b) {
    asm volatile("s_waitcnt vmcnt(0)" ::: "memory");
    __syncthreads();
    if (b.wave == 0 && fresh_lane() == 0) {
        unsigned* bar = b.bar;
        __builtin_amdgcn_s_waitcnt(0);
        unsigned nloc = b.st[0], nx = b.st[1];
        if (nloc == 0u) { xcd_barrier_complete(bar, b.x, nloc, nx); b.st[0] = nloc; b.st[1] = nx; }
        const unsigned old = xb_add(&bar[XB_XSUB(b.x)], 1u);
        const unsigned gen = old / nloc;
        if (old + 1u == (gen + 1u) * nloc) {
            __builtin_amdgcn_fence(__ATOMIC_RELEASE, "agent");
            asm volatile("s_waitcnt vmcnt(0)" ::: "memory");
            const unsigned og = xb_add(&bar[XB_TOP], 1u);
            const unsigned tg = og / nx;
            if (og + 1u == (tg + 1u) * nx) xb_add(&bar[XB_TOPGEN], 1u);
            else XB_SPIN(xb_ld(&bar[XB_TOPGEN]) == tg, bar);
            __builtin_amdgcn_fence(__ATOMIC_ACQUIRE, "agent");
            xb_add(&bar[XB_XGEN(b.x)], 1u);
            asm volatile("s_waitcnt vmcnt(0)" ::: "memory");
        } else {
            XB_SPIN(xb_ld(&bar[XB_XGEN(b.x)]) == gen, bar);
            __builtin_amdgcn_fence(__ATOMIC_ACQUIRE, "agent");
            asm volatile("s_waitcnt vmcnt(0)" ::: "memory");
        }
    }
    __syncthreads();
}

typedef unsigned short bf16_t;
constexpr int NB = 4, SEQ = 2048, DM = 2048, NT = NB * SEQ;
constexpr int NH = 8, NG = 2, HD = 128, INW = 3608, INWP = 3840;
constexpr int NCMP = 127, NSEL = 32, NEXP = 32, FF = 512;
constexpr float EPS = 1e-6f;
constexpr float SCALE = 0.08838834764831845f;
constexpr int NTHREADS = 512, NWAVES = 8;
constexpr int LDS_BYTES = 147456;
constexpr int YROWS = 24576;

enum { I_X = 0, I_POS, I_LNMIX, I_WIN, I_PEK, I_WK1, I_WK2, I_PEV, I_WV1, I_WV2, I_WPOOL, I_BPOOL, I_PSCALE, I_GNNSA, I_GNPOOL, I_WOUT, I_LNMOE,
       I_WRG, I_BRG, I_WRE, I_BRE, I_WGATE, I_WUP, I_WDOWN, I_LNFINAL, N_IN };

constexpr size_t MB = 1024 * 1024;
constexpr size_t WS_CTL   = 0;
constexpr size_t CTL_ZERO_BYTES = 65536;
constexpr int    CW_CNT   = 4096;
constexpr size_t WS_RSTD1 = 1 * MB;
constexpr size_t WS_RSTD2 = 1 * MB + 65536;
constexpr size_t WS_BIAS1 = 1 * MB + 131072;
constexpr size_t WS_AROW  = 1 * MB + 262144;
constexpr size_t WS_WR    = 1 * MB + 393216;
constexpr size_t WS_WG4   = 1 * MB + 655360;
constexpr size_t WS_WRP   = 32 * MB;
constexpr size_t WS_WRPB  = 33 * MB;
constexpr size_t WS_PL    = 40 * MB;
constexpr size_t WS_ROPEC = 2 * MB;
constexpr size_t WS_ROPES = 2 * MB + 524288;
constexpr size_t WS_GATES = 3 * MB;
constexpr size_t WS_TOKL  = 4 * MB;
constexpr size_t WS_GATEL = 5 * MB;
constexpr size_t WS_HID   = 6 * MB;
constexpr size_t WS_CMPKV = 8 * MB;
constexpr size_t WS_WINT  = 9 * MB;
constexpr size_t WS_WOUTT = 24 * MB;
constexpr size_t WS_W1T   = 32 * MB;
constexpr size_t WS_W2T   = 160 * MB;
constexpr size_t WS_CMPW  = 224 * MB;
constexpr size_t WS_POOLW = 228 * MB;
constexpr size_t WS_POOLB = 228 * MB + 524288;
constexpr size_t WS_CPART = 447 * MB;
constexpr size_t WS_DBUF  = 463 * MB;
constexpr size_t WS_XB    = 230 * MB;
constexpr size_t WS_QN    = 262 * MB;
constexpr size_t WS_QR    = 278 * MB;
constexpr size_t WS_KV    = 294 * MB;
constexpr size_t WS_U     = 319 * MB;
constexpr size_t WS_Y     = 230 * MB;
constexpr size_t WS_OWIN  = 351 * MB;
constexpr size_t WS_OCMP  = 367 * MB;
constexpr size_t WS_OSEL  = 319 * MB;
constexpr size_t WS_ML    = 6 * MB;
constexpr size_t WS_X1B   = 351 * MB;
constexpr size_t WS_OPOOL = 383 * MB;
constexpr size_t WS_ACT   = 383 * MB;
constexpr size_t WS_MIX   = 415 * MB;
constexpr size_t WS_END   = 479 * MB;

__device__ __forceinline__ bf16_t f2bf(float f) { unsigned u = __float_as_uint(f); u += 0x7FFFu + ((u >> 16) & 1u); return (bf16_t)(u >> 16); }
__device__ __forceinline__ float bf2f(bf16_t b) { return __uint_as_float(((unsigned)b) << 16); }
__device__ __forceinline__ float wave_sum(float v) {
#pragma unroll
    for (int o = 32; o >= 1; o >>= 1) v += __shfl_xor(v, o);
    return v;
}
__device__ __forceinline__ float wave_max(float v) {
#pragma unroll
    for (int o = 32; o >= 1; o >>= 1) v = fmaxf(v, __shfl_xor(v, o));
    return v;
}

__device__ __forceinline__ int fresh_lane() { int l; asm volatile("v_mbcnt_lo_u32_b32 %0, -1, 0\n\tv_mbcnt_hi_u32_b32 %0, -1, %0" : "=v"(l)); return l; }
typedef __attribute__((address_space(1))) unsigned gu32_t;
__device__ __forceinline__ void st_wt(void* p, unsigned v) { __hip_atomic_store((gu32_t*)p, v, __ATOMIC_RELAXED, __HIP_MEMORY_SCOPE_AGENT); }
__device__ __forceinline__ void st_wt(void* p, float v) { __hip_atomic_store((gu32_t*)p, __float_as_uint(v), __ATOMIC_RELAXED, __HIP_MEMORY_SCOPE_AGENT); }
typedef unsigned u32x4_wt __attribute__((ext_vector_type(4)));
__device__ __forceinline__ void st_wt16(void* p, u32x4_wt v) { asm volatile("global_store_dwordx4 %0, %1, off sc1\n\ts_nop 1" :: "v"((gu32_t*)p), "v"(v) : "memory"); }
struct Args { const float* in[N_IN]; float* out; unsigned char* ws; int ph_lo, ph_hi; };

struct Frame {
    const float* in[N_IN]; float* out; unsigned char* ws;
    float* lds;
    int tid, lane, wave, G, bid;
};

__device__ __forceinline__ float gelu_tanh(float x) { const float u = 0.7978845608028654f * (x + 0.044715f * x * x * x); return 0.5f * x * (1.f + tanhf(u)); }


namespace pg8 {
typedef short bf16x8 __attribute__((ext_vector_type(8)));
typedef float f32x4 __attribute__((ext_vector_type(4)));
typedef unsigned u32x4 __attribute__((ext_vector_type(4)));
constexpr int BM = 256, BK = 64, HALF = 128, HTB = HALF * BK * 2, STAGE_BYTES = 8 * HTB, NXCD = 8, WGM = 8;
__device__ __forceinline__ int lds_byte(int r, int c) { const int st = (r >> 4) * 2 + (c >> 5), rr = r & 15, cc = c & 31, ob = rr * 64 + cc * 2; return st * 1024 + (ob ^ (((ob >> 9) & 1) << 5)); }
__device__ __forceinline__ void stage_rc(int b, int& R, int& C) { const int st = b / 1024, sb = b % 1024, swz = sb ^ (((sb >> 9) & 1) << 5); R = (st >> 1) * 16 + swz / 64; C = (st & 1) * 32 + (swz % 64) / 2; }
struct Unit { int pm, pn, e, li; };
__device__ __forceinline__ unsigned cvt_pk_bf16(float lo, float hi) { unsigned r; asm volatile("v_cvt_pk_bf16_f32 %0, %1, %2" : "=v"(r) : "v"(lo), "v"(hi)); return r; }

struct DenseOrder {
    const char* A; const char* Bt; int lda, ldb; int nM, nN, nwg, G, c;
    __device__ void init(const void* A_, const void* Bt_, int lda_, int ldb_, int M, int N, int G_, int c_) { A = (const char*)A_; Bt = (const char*)Bt_; lda = lda_; ldb = ldb_; nM = M / BM; nN = N / BM; nwg = nM * nN; G = G_; c = c_; }
    __device__ __forceinline__ bool next(int i, Unit& u) const {
        const long L = (long)i * G + c; if (L >= nwg) return false;
        int wgid = (int)L; { const int q = nwg / NXCD, r = nwg % NXCD, xcd = wgid % NXCD, off = wgid / NXCD; wgid = (xcd < r ? xcd * (q + 1) : r * (q + 1) + (xcd - r) * q) + off; }
        const int nig = WGM * nN, gid = wgid / nig, fm = gid * WGM, gsz = (nM - fm) < WGM ? (nM - fm) : WGM;
        u.pm = fm + ((wgid % nig) % gsz); u.pn = (wgid % nig) / gsz; u.e = 0; u.li = i; return true;
    }
    __device__ __forceinline__ const char* a_base(const Unit& u) const { return A + (size_t)u.pm * BM * lda * 2; }
    __device__ __forceinline__ const char* b_base(const Unit& u) const { return Bt + (size_t)u.pn * BM * ldb * 2; }
    __device__ __forceinline__ unsigned a_row_off(const Unit&, int r) const { return (unsigned)r * (unsigned)lda * 2u; }
};

template <class Epi, class Sched, bool GATHER>
__device__ __forceinline__ void gemm_phase(LAS unsigned char* lds, const int K, const int lda, const int ldb, const Sched& S, const Epi& E) {
    const int tid = threadIdx.x, wid = __builtin_amdgcn_readfirstlane(tid >> 6), lane = tid & 63, wr = wid >> 2, wc = wid & 3, fr = lane & 15, fq = lane >> 4;
    const int nt = K / BK;
    int sR[2], sC[2];
#pragma unroll
    for (int i = 0; i < 2; ++i) stage_rc(tid * 16 + i * 8192, sR[i], sC[i]);
    unsigned voffB[2], voffA[2][2], nvoffA[2][2];
#pragma unroll
    for (int i = 0; i < 2; ++i) voffB[i] = (unsigned)(sR[i] * ldb + sC[i]) * 2u;
    const size_t kstep = (size_t)(BK * 2);
    const size_t hstepB = (size_t)HALF * ldb * 2;
    const unsigned ldsw = (unsigned)wid * 1024u;
    const int aoff = lds_byte(wr * 64 + fr, fq * 8), boff = lds_byte(wc * 32 + fr, fq * 8);
#define PG8_SA(b, h) (((b) * 2 + (h)) * HTB)
#define PG8_SB(b, h) ((4 + (b) * 2 + (h)) * HTB)
#define PG8_STAGE(bufoff, gbase, voff) do { _Pragma("unroll") for (int _i = 0; _i < 2; ++_i) \
        __builtin_amdgcn_global_load_lds((const unsigned*)((const char*)(gbase) + (voff)[_i]), (LAS unsigned*)(lds + (bufoff) + ldsw + _i * 8192), 16, 0, 0); } while (0)
#define PG8_LDA(dst, b, h) do { _Pragma("unroll") for (int m = 0; m < 4; ++m) _Pragma("unroll") for (int k = 0; k < 2; ++k) dst[m][k] = *(const LAS bf16x8*)(lds + PG8_SA(b, h) + aoff + m * 2048 + k * 1024); } while (0)
#define PG8_LDB(dst, b, h) do { _Pragma("unroll") for (int n = 0; n < 2; ++n) _Pragma("unroll") for (int k = 0; k < 2; ++k) dst[n][k] = *(const LAS bf16x8*)(lds + PG8_SB(b, h) + boff + n * 2048 + k * 1024); } while (0)
#define PG8_MMA(ai, bj, At, Bt) do { __builtin_amdgcn_s_setprio(1); _Pragma("unroll") for (int m = 0; m < 4; ++m) _Pragma("unroll") for (int n = 0; n < 2; ++n) _Pragma("unroll") for (int k = 0; k < 2; ++k) \
        { acc[ai][bj][m][n] = __builtin_amdgcn_mfma_f32_16x16x32_bf16(Bt[n][k], At[m][k], acc[ai][bj][m][n], 0, 0, 0); if (PROBE_REPEAT == 21) dummy = __builtin_amdgcn_mfma_f32_16x16x32_bf16(Bt[n][k], At[m][k], dummy, 0, 0, 0); } __builtin_amdgcn_s_setprio(0); } while (0)
#define PG8_WAIT_V(n) asm volatile("s_waitcnt vmcnt(" #n ")" ::: "memory")
#define PG8_WAIT_L(n) asm volatile("s_waitcnt lgkmcnt(" #n ")" ::: "memory")
#define PG8_BAR __builtin_amdgcn_s_barrier()
#define PG8_SCHED __builtin_amdgcn_sched_barrier(0)
#define PG8_AOFFS(dst, u) do { _Pragma("unroll") for (int _h = 0; _h < 2; ++_h) _Pragma("unroll") for (int _i = 0; _i < 2; ++_i) dst[_h][_i] = S.a_row_off(u, _h * HALF + sR[_i]) + (unsigned)sC[_i] * 2u; } while (0)
    Unit cur, nxt; int ui = 0;
    if (!S.next(0, cur)) return;
    f32x4 acc[2][2][4][2];
#pragma unroll
    for (int a = 0; a < 2; ++a)
#pragma unroll
        for (int b = 0; b < 2; ++b)
#pragma unroll
            for (int m = 0; m < 4; ++m)
#pragma unroll
                for (int n = 0; n < 2; ++n) acc[a][b][m][n] = (f32x4){0.f, 0.f, 0.f, 0.f};
    bf16x8 At[4][2], B0[2][2], B1[2][2]; f32x4 dummy = {0.f, 0.f, 0.f, 0.f};
    const char* cA = S.a_base(cur); const char* cB = S.b_base(cur);
    PG8_AOFFS(voffA, cur);
    PG8_STAGE(PG8_SB(0, 0), cB, voffB); PG8_STAGE(PG8_SA(0, 0), cA, voffA[0]); PG8_STAGE(PG8_SB(0, 1), cB + hstepB, voffB); PG8_STAGE(PG8_SA(0, 1), cA, voffA[1]);
    if (wr == 1) PG8_BAR;
    PG8_WAIT_V(4); PG8_BAR;
    PG8_STAGE(PG8_SB(1, 0), cB + kstep, voffB); PG8_STAGE(PG8_SA(1, 0), cA + kstep, voffA[0]); PG8_STAGE(PG8_SB(1, 1), cB + hstepB + kstep, voffB);
    PG8_WAIT_V(6); PG8_BAR;
    for (;;) {
        const bool has_next = S.next(ui + 1, nxt);
        const char* nA = has_next ? S.a_base(nxt) : cA; const char* nB = has_next ? S.b_base(nxt) : cB;
        if (GATHER) { if (has_next) { PG8_AOFFS(nvoffA, nxt); } else {
#pragma unroll
            for (int _h = 0; _h < 2; ++_h)
#pragma unroll
                for (int _i = 0; _i < 2; ++_i) nvoffA[_h][_i] = voffA[_h][_i]; } }
        for (int t = 0; t < nt; t += 2) {
            const bool last = (t == nt - 2);
            const char* a1 = cA + (size_t)(t + 1) * kstep;
            const char* a2 = last ? nA : cA + (size_t)(t + 2) * kstep; const char* b2 = last ? nB : cB + (size_t)(t + 2) * kstep;
            const char* a3 = a2 + kstep; const char* b3 = b2 + kstep;
            unsigned vA2[2][2];
#pragma unroll
            for (int _h = 0; _h < 2; ++_h)
#pragma unroll
                for (int _i = 0; _i < 2; ++_i) vA2[_h][_i] = (GATHER && last) ? nvoffA[_h][_i] : voffA[_h][_i];
            PG8_LDB(B0, 0, 0); PG8_SCHED; PG8_LDA(At, 0, 0); PG8_STAGE(PG8_SA(1, 1), a1, voffA[1]);
            PG8_WAIT_L(8); PG8_BAR; PG8_WAIT_L(0); PG8_MMA(0, 0, At, B0); PG8_BAR; PG8_SCHED;
            PG8_LDB(B1, 0, 1); PG8_STAGE(PG8_SB(0, 0), b2, voffB);
            PG8_BAR; PG8_WAIT_L(0); PG8_MMA(0, 1, At, B1); PG8_BAR;
            PG8_LDA(At, 0, 1); PG8_STAGE(PG8_SA(0, 0), a2, vA2[0]);
            PG8_BAR; PG8_WAIT_L(0); PG8_MMA(1, 0, At, B0); PG8_BAR; PG8_SCHED;
            PG8_STAGE(PG8_SB(0, 1), b2 + hstepB, voffB);
            PG8_WAIT_V(6); PG8_BAR; PG8_MMA(1, 1, At, B1); PG8_BAR;
            PG8_LDB(B0, 1, 0); PG8_SCHED; PG8_LDA(At, 1, 0); PG8_STAGE(PG8_SA(0, 1), a2, vA2[1]);
            PG8_WAIT_L(8); PG8_BAR; PG8_WAIT_L(0); PG8_MMA(0, 0, At, B0); PG8_BAR; PG8_SCHED;
            PG8_LDB(B1, 1, 1); PG8_STAGE(PG8_SB(1, 0), b3, voffB);
            PG8_BAR; PG8_WAIT_L(0); PG8_MMA(0, 1, At, B1); PG8_BAR;
            PG8_LDA(At, 1, 1); PG8_STAGE(PG8_SA(1, 0), a3, vA2[0]);
            PG8_BAR; PG8_WAIT_L(0); PG8_MMA(1, 0, At, B0); PG8_BAR; PG8_SCHED;
            PG8_STAGE(PG8_SB(1, 1), b3 + hstepB, voffB);
            PG8_WAIT_V(6); PG8_BAR; PG8_MMA(1, 1, At, B1); PG8_BAR;
        }
        if constexpr (!Epi::AFTER_DRAIN) E(acc, cur, wr, wc, fr, fq);
        if (!has_next) break;
#pragma unroll
        for (int a = 0; a < 2; ++a)
#pragma unroll
            for (int b = 0; b < 2; ++b)
#pragma unroll
                for (int m = 0; m < 4; ++m)
#pragma unroll
                    for (int n = 0; n < 2; ++n) acc[a][b][m][n] = (f32x4){0.f, 0.f, 0.f, 0.f};
        cur = nxt; cA = nA; cB = nB; ++ui;
        if (GATHER) {
#pragma unroll
            for (int _h = 0; _h < 2; ++_h)
#pragma unroll
                for (int _i = 0; _i < 2; ++_i) voffA[_h][_i] = nvoffA[_h][_i]; }
    }
    if (PROBE_REPEAT == 21) asm volatile("" :: "v"(dummy));
    PG8_WAIT_V(0);
    if (wr == 0) PG8_BAR;
    PG8_BAR;
    if constexpr (Epi::AFTER_DRAIN) E.fused(acc, cur, wr, wc, fr, fq, lds);
#undef PG8_SA
#undef PG8_SB
#undef PG8_STAGE
#undef PG8_LDA
#undef PG8_LDB
#undef PG8_MMA
#undef PG8_WAIT_V
#undef PG8_WAIT_L
#undef PG8_BAR
#undef PG8_SCHED
#undef PG8_AOFFS
}
}


namespace g2 {
using pg8::bf16x8; using pg8::f32x4; using pg8::lds_byte; using pg8::cvt_pk_bf16;
typedef short s16x4 __attribute__((ext_vector_type(4)));
constexpr int A_BYTES = 32768, B_BYTES = 16384, STG = A_BYTES + B_BYTES;
struct Unit { int e, pm, pn, li, half; };
template <int NT_, class Epi, class Sched>
__device__ __forceinline__ void gemm(LAS unsigned char* lds, const Sched& S, const Epi& E, const int wave_, unsigned long long* tprobe = nullptr) {
#if defined(__HIP_DEVICE_COMPILE__)
    const int wid = wave_, lane = fresh_lane(), tid = wid * 64 + lane, wr = wid >> 1, wc = wid & 1, fr = lane & 15, fq = lane >> 4;
    constexpr int nt = NT_;
    unsigned long long tacc = 0ull;
#define TCK() ((PROBE_REPEAT >= 30 && PROBE_REPEAT <= 33) ? (unsigned long long)__builtin_readcyclecounter() : 0ull)
    const unsigned long long t_all0 = TCK();
    const int awoff0 = lds_byte((tid >> 3) & 127, (tid & 7) * 8);
    const int bkr = tid >> 5, bnq = tid & 31;
    const int bwoff0 = A_BYTES + bkr * 256 + ((((bnq >> 2)) ^ ((bkr & 3) | (((bkr >> 3) & 1) << 2))) * 32) + (bnq & 3) * 8;
#define awoff(j) (awoff0 + ((j) & 1) * 8192 + ((j) >> 1) * 16384)
#define bwoff(j) (bwoff0 + (j) * 4096)
    const int aoff = lds_byte(wr * 32 + fr, fq * 8);
    int boff[4];
    { const int q = (lane >> 2) & 3, p = lane & 3, f = q | ((fq & 1) << 2);
#pragma unroll
      for (int n = 0; n < 4; ++n) boff[n] = A_BYTES + (8 * fq + q) * 256 + (((4 * wc + n) ^ f) * 32) + 8 * p; }
    const int ldsb = (int)(uintptr_t)lds;
    Unit u, un;
    if (!S.next(0, u)) return;
    unsigned pa[4], pan[4]; const float* pb; const float* pbn;
    const size_t bstep = (size_t)16 * S.ldb;
#define G2_PTRS(PA, PB, U) do { _Pragma("unroll") for (int j = 0; j < 4; ++j) { const int id = tid + 512 * j; PA[j] = S.a_off(U, id >> 3) + (unsigned)(id & 7) * 16u; } PB = S.b_col(U, 4 * ((U).half >= 2 ? ((bnq & 15) | (((U).half & 1) << 4)) : bnq)) + (size_t)bkr * S.ldb; } while (0)
    G2_PTRS(pa, pb, u);
    f32x4 acc[2][2][4];
#pragma unroll
    for (int a = 0; a < 2; ++a)
#pragma unroll
        for (int m = 0; m < 2; ++m)
#pragma unroll
            for (int n = 0; n < 4; ++n) acc[a][m][n] = (f32x4){0.f, 0.f, 0.f, 0.f};
    f32x4 dummy = {0.f, 0.f, 0.f, 0.f};
    bf16x8 ra0[4], ra1[4]; f32x4 rb0[4], rb1[4];
#define G2_NVALID(U) (((U).half >= 2 && wc != ((U).half & 1)) ? 0 : S.nvalid(U))
    bool hf = u.half != 0; const bool hfn = false; (void)hfn; int nvalid = G2_NVALID(u); int na = (S.nvalid(u) + 63) >> 6;
#define G2_LOADA(RA, PA, HF, t) do { _Pragma("unroll") for (int j = 0; j < 4; ++j) if (j < na) RA[j] = *(const bf16x8*)((const char*)S.A + PA[j] + (unsigned)(t) * 128u); } while (0)
#define G2_LOADB(RB, PB, t) do { _Pragma("unroll") for (int j = 0; j < 4; ++j) RB[j] = *(const f32x4*)(PB + (size_t)(t) * 64 * S.ldb + j * bstep); } while (0)
#define G2_WRITE_A(st, RA, j) do { *(LAS bf16x8*)(lds + (st) * STG + awoff(j)) = RA[j]; } while (0)
#define G2_WRITE_B(st, RB, j) do { uint2 w_; w_.x = cvt_pk_bf16(RB[j][0], RB[j][1]); w_.y = cvt_pk_bf16(RB[j][2], RB[j][3]); *(LAS uint2*)(lds + (st) * STG + bwoff(j)) = w_; } while (0)
#define G2_TR(dst, n, imm) asm volatile("ds_read_b64_tr_b16 %0, %1 offset:%2" : "=&v"(dst) : "v"(ldsb + boff[n]), "i"(imm) : "memory")
#define G2_COMPUTE(st, DOW, WA, WB, HFC, HFW) do { \
        s16x4 bl[4][2], bh[4][2];                                         \
        _Pragma("unroll") for (int n = 0; n < 4; ++n) { G2_TR(bl[n][0], n, (st) * STG); G2_TR(bh[n][0], n, (st) * STG + 1024); G2_TR(bl[n][1], n, (st) * STG + 8192); G2_TR(bh[n][1], n, (st) * STG + 8192 + 1024); } \
        bf16x8 At[2][2]; \
        _Pragma("unroll") for (int m = 0; m < 2; ++m) _Pragma("unroll") for (int k = 0; k < 2; ++k) At[m][k] = *(const LAS bf16x8*)(lds + (st) * STG + aoff + m * 2048 + k * 1024); \
        asm volatile("s_waitcnt lgkmcnt(0)" ::: "memory"); __builtin_amdgcn_sched_barrier(0); \
        bf16x8 Bf[4][2]; \
        _Pragma("unroll") for (int n = 0; n < 4; ++n) _Pragma("unroll") for (int k = 0; k < 2; ++k) Bf[n][k] = (bf16x8){bl[n][k][0], bl[n][k][1], bl[n][k][2], bl[n][k][3], bh[n][k][0], bh[n][k][1], bh[n][k][2], bh[n][k][3]}; \
        _Pragma("unroll") for (int a = 0; a < 2; ++a) { \
            _Pragma("unroll") for (int m = 0; m < 2; ++m) { \
                __builtin_amdgcn_s_setprio(1); \
                if (128 * a + 32 * wr + 16 * m < nvalid) {                 \
                    _Pragma("unroll") for (int n = 0; n < 4; ++n) acc[a][m][n] = __builtin_amdgcn_mfma_f32_16x16x32_bf16(Bf[n][0], At[m][0], acc[a][m][n], 0, 0, 0); \
                    _Pragma("unroll") for (int n = 0; n < 4; ++n) acc[a][m][n] = __builtin_amdgcn_mfma_f32_16x16x32_bf16(Bf[n][1], At[m][1], acc[a][m][n], 0, 0, 0); } \
                __builtin_amdgcn_s_setprio(0); \
                if (DOW) { if (a == 0) { { if (2 * m < na) G2_WRITE_A((st) ^ 1, WA, 2 * m); if (2 * m + 1 < na) G2_WRITE_A((st) ^ 1, WA, 2 * m + 1); } if (HFC) { G2_WRITE_B((st) ^ 1, WB, 2 * m); G2_WRITE_B((st) ^ 1, WB, 2 * m + 1); } } \
                           else { G2_WRITE_B((st) ^ 1, WB, 2 * m); G2_WRITE_B((st) ^ 1, WB, 2 * m + 1); } __builtin_amdgcn_sched_barrier(0); } } \
            if (HFC) break;                                               \
            if (a == 0) { __builtin_amdgcn_sched_barrier(0); \
                _Pragma("unroll") for (int m = 0; m < 2; ++m) _Pragma("unroll") for (int k = 0; k < 2; ++k) At[m][k] = *(const LAS bf16x8*)(lds + (st) * STG + 16384 + aoff + m * 2048 + k * 1024); \
                asm volatile("s_waitcnt lgkmcnt(0)" ::: "memory"); __builtin_amdgcn_sched_barrier(0); } } \
        } while (0)
    for (int ui = 0;; ++ui) {
        G2_LOADA(ra0, pa, hf, 0); G2_LOADB(rb0, pb, 0); G2_LOADA(ra1, pa, hf, 1); G2_LOADB(rb1, pb, 1);
        __syncthreads();
#pragma unroll
        for (int j = 0; j < 4; ++j) { if (j < na) G2_WRITE_A(0, ra0, j); G2_WRITE_B(0, rb0, j); }
        if (nt > 2) { G2_LOADA(ra0, pa, hf, 2); G2_LOADB(rb0, pb, 2); }
        __syncthreads();
#define G2_STEP(t) do { \
            G2_COMPUTE(0, true, ra1, rb1, hf, hf); \
            if ((t) + 3 < nt) { G2_LOADA(ra1, pa, hf, (t) + 3); G2_LOADB(rb1, pb, (t) + 3); } \
            __syncthreads(); \
            if ((t) + 2 < nt) { G2_COMPUTE(1, true, ra0, rb0, hf, hf); } else { G2_COMPUTE(1, false, ra0, rb0, hf, hf); } \
            if ((t) + 4 < nt) { G2_LOADA(ra0, pa, hf, (t) + 4); G2_LOADB(rb0, pb, (t) + 4); } \
            __syncthreads(); } while (0)
        G2_STEP(0); G2_STEP(2); G2_STEP(4); G2_STEP(6);
        if constexpr (NT_ > 8) { G2_STEP(8); G2_STEP(10); G2_STEP(12); G2_STEP(14); G2_STEP(16); G2_STEP(18); G2_STEP(20); G2_STEP(22); G2_STEP(24); G2_STEP(26); G2_STEP(28); G2_STEP(30); }
        static_assert(NT_ == 8 || NT_ == 32, "expand G2_STEP for this K");
#undef G2_STEP
        E(acc, u, wr, wc, fr, fq);
        if (!S.next(ui + 1, un)) break;
#pragma unroll
        for (int a = 0; a < 2; ++a)
#pragma unroll
            for (int m = 0; m < 2; ++m)
#pragma unroll
                for (int n = 0; n < 4; ++n) acc[a][m][n] = (f32x4){0.f, 0.f, 0.f, 0.f};
        u.e = un.e; u.pm = un.pm; u.pn = un.pn; u.li = un.li; u.half = un.half; hf = u.half != 0; nvalid = G2_NVALID(u); na = (S.nvalid(u) + 63) >> 6;
        G2_PTRS(pa, pb, u);
    }
#undef G2_PTRS
#undef G2_NVALID
#undef awoff
#undef bwoff
#undef G2_LOADA
#undef G2_LOADB
#undef G2_WRITE_A
#undef G2_WRITE_B
#undef G2_TR
#undef G2_COMPUTE
    if (PROBE_REPEAT == 33) tacc = TCK() - t_all0;
    if (tprobe && blockIdx.x == PROBE_WG && threadIdx.x == 0) *tprobe = tacc;
#undef TCK
#endif
}
}

namespace att {
typedef short bf16x8 __attribute__((ext_vector_type(8)));
typedef short s16x4 __attribute__((ext_vector_type(4)));
typedef float f32x16 __attribute__((ext_vector_type(16)));
typedef float f32x4 __attribute__((ext_vector_type(4)));
typedef unsigned u32x4 __attribute__((ext_vector_type(4)));
constexpr int SHM = 16384;
constexpr int NBUF = 3;
constexpr int L_K = 0, L_V = NBUF * SHM, L_WS = 2 * NBUF * SHM, L_PART = L_WS + 8 * 64 * 4, L_SELM = L_PART + 4 * 64 * 33 * 4, L_VALS = L_SELM + 256, L_ITEM = L_VALS + 8 * 64 * 4, L_END = L_ITEM + 16;
constexpr float C2 = 1.4426950408889634f * SCALE;
#define KSWZ(row, colB) ((row) * 256 + ((colB) ^ (((row) & 7) << 4)))
#define SBAR() __builtin_amdgcn_sched_barrier(0)
__device__ __forceinline__ int v_st(int k, int c) { const int kk = (k & ~0xC) | ((k & 4) << 1) | ((k & 8) >> 1); return ((kk >> 3) * 4 + (c >> 5)) * 512 + ((kk & 7) * 32 + (c & 31)) * 2; }
__device__ __forceinline__ int v_rd_base(int lane) { return ((lane & 3) << 3) | (((lane >> 2) & 3) << 6) | (((lane >> 4) & 1) << 5) | (((lane >> 5) & 1) << 8); }
constexpr int v_rd_off(int d0, int ks, int half) { return d0 * 512 + ks * 4096 + half * 2048; }
__device__ __forceinline__ int crow(int r, int hi) { return (r & 3) + 8 * (r >> 2) + 4 * hi; }
__device__ __forceinline__ unsigned cvtpk(float lo, float hi) { unsigned r; asm volatile("v_cvt_pk_bf16_f32 %0, %1, %2" : "=v"(r) : "v"(lo), "v"(hi)); return r; }
__device__ __forceinline__ float swap_max(float v) { auto rr = __builtin_amdgcn_permlane32_swap(__float_as_uint(v), __float_as_uint(v), false, false); return fmaxf(__uint_as_float(rr[0]), __uint_as_float(rr[1])); }
__device__ __forceinline__ float swap_sum(float v) { auto rr = __builtin_amdgcn_permlane32_swap(__float_as_uint(v), __float_as_uint(v), false, false); return __uint_as_float(rr[0]) + __uint_as_float(rr[1]); }

struct WV { int tid, wid, lane, r32, hi, vb0; unsigned ksrc[2], vsrc[2]; char* lds; LAS unsigned char* ldsL; };
__device__ __forceinline__ void wv_src_init(WV& w) {
#pragma unroll
    for (int i = 0; i < 2; ++i) {
        const int L = (w.wid * 2 + i) * 1024 + w.lane * 16;
        { const int row = L >> 8, colB = (L & 255) ^ ((row & 7) << 4); w.ksrc[i] = (unsigned)(row * 256 + colB); }
        { const int sub = L >> 9, kkhi = sub >> 2, cblk = sub & 3, within = L & 511, kklo = within >> 6, cc = (within >> 1) & 31;
          const int kk = kkhi * 8 + kklo, k = (kk & ~0xC) | ((kk & 4) << 1) | ((kk & 8) >> 1), c = cblk * 32 + cc; w.vsrc[i] = (unsigned)(k * 256 + c * 2); }
    }
}
__device__ __forceinline__ void dma_tile(const WV& w, const bf16_t* Kt, const bf16_t* Vt, int buf) {
    int ln = w.lane; asm volatile("" : "+v"(ln));
#pragma unroll
    for (int i = 0; i < 2; ++i) {
        const int L = (w.wid * 2 + i) * 1024 + ln * 16;
        const int row = L >> 8, colB = (L & 255) ^ ((row & 7) << 4); const unsigned ksrc = (unsigned)(row * 256 + colB);
        const int sub = L >> 9, kkhi = sub >> 2, cblk = sub & 3, within = L & 511, kklo = within >> 6, cc = (within >> 1) & 31;
        const int kk = kkhi * 8 + kklo, k = (kk & ~0xC) | ((kk & 4) << 1) | ((kk & 8) >> 1), c = cblk * 32 + cc; const unsigned vsrc = (unsigned)(k * 256 + c * 2);
        __builtin_amdgcn_global_load_lds((const unsigned*)((const char*)Vt + vsrc), (LAS unsigned*)(w.ldsL + L_V + buf * SHM + (w.wid * 2 + i) * 1024), 16, 0, 0);
        __builtin_amdgcn_global_load_lds((const unsigned*)((const char*)Kt + ksrc), (LAS unsigned*)(w.ldsL + L_K + buf * SHM + (w.wid * 2 + i) * 1024), 16, 0, 0);
    }
}
template <int BUF>
__device__ __forceinline__ void qkt(const WV& w, const bf16x8 (&qr)[8], f32x16& p0, f32x16& p1) {
    p0 = f32x16{}; p1 = f32x16{};
    const LAS char* kb[4];
#pragma unroll
    for (int dd = 0; dd < 4; ++dd) kb[dd] = (const LAS char*)w.ldsL + L_K + KSWZ(w.r32, (dd * 16 + w.hi * 8) * 2);
#pragma unroll
    for (int d0 = 0; d0 < 8; ++d0) { const LAS char* a = kb[d0 & 3] + BUF * SHM + (d0 >> 2) * 128;
        const bf16x8 b0 = *reinterpret_cast<const LAS bf16x8*>(a); const bf16x8 b1 = *reinterpret_cast<const LAS bf16x8*>(a + 32 * 256);
        p0 = __builtin_amdgcn_mfma_f32_32x32x16_bf16(b0, qr[d0], p0, 0, 0, 0);
        p1 = __builtin_amdgcn_mfma_f32_32x32x16_bf16(b1, qr[d0], p1, 0, 0, 0);
        if (d0 == 3) SBAR(); }
}
__device__ __forceinline__ void pack_p(const f32x16& p0, const f32x16& p1, bf16x8& pa0, bf16x8& pa1, bf16x8& pa2, bf16x8& pa3) {
#define PK4(P, B_, OUT) do { unsigned a0 = cvtpk(P[B_+0], P[B_+1]), a1 = cvtpk(P[B_+2], P[B_+3]); unsigned b0 = cvtpk(P[B_+4], P[B_+5]), b1 = cvtpk(P[B_+6], P[B_+7]); \
        auto r0 = __builtin_amdgcn_permlane32_swap(a0, b0, false, false); auto r1 = __builtin_amdgcn_permlane32_swap(a1, b1, false, false); \
        u32x4 w_ = {r0[0], r1[0], r0[1], r1[1]}; OUT = *reinterpret_cast<bf16x8*>(&w_); } while (0)
    PK4(p0, 0, pa0); PK4(p0, 8, pa1); PK4(p1, 0, pa2); PK4(p1, 8, pa3);
#undef PK4
}
template <int VB>
__device__ __forceinline__ void pv_tile(f32x16* o, int vb0, bf16x8 pa0, bf16x8 pa1, bf16x8 pa2, bf16x8 pa3) {
#define TRRD(dst, off) asm volatile("ds_read_b64_tr_b16 %0, %1 offset:%2" : "=&v"(dst) : "v"(vb0), "i"(off) : "memory")
#define PV_D0(d0) do { s16x4 l0, l1, l2, l3, h0, h1, h2, h3; constexpr int b_ = VB * SHM + v_rd_off(d0, 0, 0); \
        TRRD(l0, b_); TRRD(h0, b_ + 2048); TRRD(l1, b_ + 4096); TRRD(h1, b_ + 6144); TRRD(l2, b_ + 8192); TRRD(h2, b_ + 10240); TRRD(l3, b_ + 12288); TRRD(h3, b_ + 14336); \
        asm volatile("s_waitcnt lgkmcnt(0)" ::: "memory"); SBAR(); \
        o[d0] = __builtin_amdgcn_mfma_f32_32x32x16_bf16(pa0, (bf16x8){l0[0], l0[1], l0[2], l0[3], h0[0], h0[1], h0[2], h0[3]}, o[d0], 0, 0, 0); \
        o[d0] = __builtin_amdgcn_mfma_f32_32x32x16_bf16(pa1, (bf16x8){l1[0], l1[1], l1[2], l1[3], h1[0], h1[1], h1[2], h1[3]}, o[d0], 0, 0, 0); \
        o[d0] = __builtin_amdgcn_mfma_f32_32x32x16_bf16(pa2, (bf16x8){l2[0], l2[1], l2[2], l2[3], h2[0], h2[1], h2[2], h2[3]}, o[d0], 0, 0, 0); \
        o[d0] = __builtin_amdgcn_mfma_f32_32x32x16_bf16(pa3, (bf16x8){l3[0], l3[1], l3[2], l3[3], h3[0], h3[1], h3[2], h3[3]}, o[d0], 0, 0, 0); } while (0)
    PV_D0(0); PV_D0(1); PV_D0(2); PV_D0(3);
#undef PV_D0
#undef TRRD
}
__device__ __forceinline__ void store_o(const WV& w, const f32x16* o, const float* tab, bf16_t* outp) {
    LAS unsigned char* stg = w.ldsL + ((w.wid < 4) ? (L_K + 2 * SHM + w.wid * 4096) : (L_V + 2 * SHM + (w.wid - 4) * 4096));
    float sc[16];
#pragma unroll
    for (int r = 0; r < 16; ++r) sc[r] = tab[crow(r, w.hi)];
#pragma unroll
    for (int hh = 0; hh < 2; ++hh) {
#pragma unroll
        for (int dd = 0; dd < 2; ++dd)
#pragma unroll
            for (int r = 0; r < 16; ++r) { const float v = o[2 * hh + dd][r] * sc[r];
                *(LAS bf16_t*)(stg + crow(r, w.hi) * 128 + (dd * 32 + w.r32) * 2) = (bf16_t)(cvtpk(v, v) & 0xFFFFu); }
        asm volatile("s_waitcnt lgkmcnt(0)" ::: "memory");
#pragma unroll
        for (int i = 0; i < 4; ++i) { const int row = 8 * i + (w.lane >> 3), ch = w.lane & 7;
            const u32x4 v = *(const LAS u32x4*)(stg + row * 128 + ch * 16);
            st_wt16(outp + (size_t)row * 1024 + hh * 64 + ch * 8, v); }
        asm volatile("s_waitcnt lgkmcnt(0)" ::: "memory");
    }
}

template <int MODE>
__device__ __forceinline__ void flash_pass(const WV& w, const bf16_t* Kp, const bf16_t* Vp, int j_lo, int j_hi, const bf16x8 (&qr)[8], int tpos, int tw0, unsigned selmask,
                                           f32x16 (&o)[4], float& m_reg, float& l_reg) {
    float* al_l = (float*)(w.lds + L_WS) + w.wid * 64;
    dma_tile(w, Kp + (size_t)j_lo * 64 * HD, Vp + (size_t)j_lo * 64 * HD, 0);
    if (j_lo + 1 < j_hi) dma_tile(w, Kp + (size_t)(j_lo + 1) * 64 * HD, Vp + (size_t)(j_lo + 1) * 64 * HD, 1);
#define FSTEP(BUF, jj) do { const int jt = (jj);                                                                                  \
        if (jt + 1 < j_hi) asm volatile("s_waitcnt vmcnt(4)" ::: "memory"); else asm volatile("s_waitcnt vmcnt(0)" ::: "memory");   \
        asm volatile("s_waitcnt lgkmcnt(0)" ::: "memory"); __builtin_amdgcn_s_barrier(); asm volatile("" ::: "memory");          \
        if (jt + 2 < j_hi) dma_tile(w, Kp + (size_t)(jt + 2) * 64 * HD, Vp + (size_t)(jt + 2) * 64 * HD, ((BUF) + 2) % 3);         \
        f32x16 p0, p1;                                                                                                           \
        qkt<BUF>(w, qr, p0, p1);                                                                                                 \
        const int kb = jt * 64;                                                                                                  \
        { const float NEG = -__builtin_inff();                                                                                   \
          const bool need = (kb + 63 > tw0) || (MODE == 1 && kb <= tw0 + 31 - 512);                                              \
          if (need) { const int dq = tpos - kb - 4 * w.hi; const unsigned W = (MODE == 1) ? 512u : 0x7fffffffu;                  \
              _Pragma("unroll") for (int r = 0; r < 16; ++r) { const int c = (r & 3) + 8 * (r >> 2); if ((unsigned)(dq - c) >= W) p0[r] = NEG; if ((unsigned)(dq - c - 32) >= W) p1[r] = NEG; } } \
          if (MODE == 0) { const bool sel = (selmask >> jt) & 1u;                                                                \
              if (!__all(sel)) { _Pragma("unroll") for (int r = 0; r < 16; ++r) { p0[r] = sel ? p0[r] : NEG; p1[r] = sel ? p1[r] : NEG; } } } } \
        float pmax = p0[0];                                                                                                      \
        _Pragma("unroll") for (int r = 1; r < 16; ++r) pmax = fmaxf(pmax, p0[r]);                                                \
        _Pragma("unroll") for (int r = 0; r < 16; ++r) pmax = fmaxf(pmax, p1[r]);                                                \
        pmax = swap_max(pmax);                                                                                                   \
        float mn = m_reg, alpha = 1.f;                                                                                           \
        const bool resc = !__all((pmax - m_reg) * SCALE <= 8.f);          \
        if (resc) { mn = fmaxf(m_reg, pmax); alpha = __builtin_amdgcn_exp2f((m_reg - mn) * C2); m_reg = mn; }                     \
        const float mnL = -mn * C2;                                                                                              \
        float ps = 0.f;                                                                                                          \
        _Pragma("unroll") for (int r = 0; r < 16; ++r) { p0[r] = __builtin_amdgcn_exp2f(fmaf(p0[r], C2, mnL)); ps += p0[r]; }    \
        _Pragma("unroll") for (int r = 0; r < 16; ++r) { p1[r] = __builtin_amdgcn_exp2f(fmaf(p1[r], C2, mnL)); ps += p1[r]; }    \
        ps = swap_sum(ps);                                                                                                       \
        l_reg = l_reg * alpha + ps;                                                                                              \
        if (resc) { if (w.hi == 0) al_l[w.r32] = alpha;                                                                          \
            asm volatile("s_waitcnt lgkmcnt(0)" ::: "memory");                                                                   \
            _Pragma("unroll") for (int r = 0; r < 16; ++r) { const float a = al_l[crow(r, w.hi)];                                \
                _Pragma("unroll") for (int d = 0; d < 4; ++d) o[d][r] *= a; } }                                                  \
        bf16x8 pa0, pa1, pa2, pa3;                                                                                               \
        pack_p(p0, p1, pa0, pa1, pa2, pa3);                                                                                      \
        pv_tile<BUF>(o, w.vb0, pa0, pa1, pa2, pa3);                                                                              \
    } while (0)
    int j = j_lo;
    for (; j + 2 < j_hi; j += 3) { FSTEP(0, j); FSTEP(1, j + 1); FSTEP(2, j + 2); }
    if (j < j_hi) { FSTEP(0, j); if (j + 1 < j_hi) FSTEP(1, j + 1); }
#undef FSTEP
    __syncthreads();
}
}

__device__ const unsigned char ATT_ITEMS[80] = {95, 94, 93, 92, 91, 90, 89, 88, 87, 86, 85, 84, 83, 82, 81, 80, 79, 78, 77, 76, 75, 74, 73, 72, 71, 70, 69, 68, 67, 66, 65, 64, 15, 30, 31, 63, 14, 28, 29, 61, 62, 13, 26, 27, 59, 60, 12, 24, 25, 57, 58, 11, 22, 23, 55, 56, 10, 20, 21, 53, 54, 9, 18, 19, 51, 52, 8, 16, 17, 49, 50, 7, 48, 6, 5, 4, 3, 2, 1, 0};
constexpr int CW_QUEUE = 6144;
constexpr int CW_CVTQ = 6144 + 256;
constexpr int CW_CMPR = 8192 + 2048;

constexpr int CW_MIDDONE = 11264;
constexpr int CW_MIXC = 12288;
template <int NR> __device__ __forceinline__ void mix_rows(const Frame& F, int r0, int lane);
__device__ __forceinline__ void p_attn(const Frame& F, unsigned char* lds_raw, int rep) {
    using namespace att;
    WV w;
#define WV_INIT() do { int ln_ = F.lane; asm volatile("" : "+v"(ln_)); w.tid = F.wave * 64 + ln_; w.wid = F.wave; w.lane = ln_; w.r32 = ln_ & 31; w.hi = ln_ >> 5; \
        w.lds = (char*)lds_raw + 1024; w.ldsL = (LAS unsigned char*)lds_raw + 1024; w.vb0 = (int)(uintptr_t)(w.lds) + att::L_V + v_rd_base(ln_); } while (0)
    WV_INIT();
    const bf16_t* qn = (const bf16_t*)(F.ws + WS_QN); const bf16_t* qrp = (const bf16_t*)(F.ws + WS_QR); const bf16_t* kv = (const bf16_t*)(F.ws + WS_KV);
    const bf16_t* ckv = (const bf16_t*)(F.ws + WS_CMPKV);
    bf16_t* ocmp = (bf16_t*)(F.ws + WS_OCMP); bf16_t* owin = (bf16_t*)(F.ws + WS_OWIN); bf16_t* osel = (bf16_t*)(F.ws + WS_OSEL); float* ml = (float*)(F.ws + WS_ML);
    unsigned* qctr = (unsigned*)(F.ws + WS_CTL) + CW_QUEUE + 64 * rep;
    float* wsf = (float*)(w.lds + L_WS) + w.wid * 64;
    float* part = (float*)(w.lds + L_PART); unsigned* selm = (unsigned*)(w.lds + L_SELM); float* vals = (float*)(w.lds + L_VALS) + w.wid * 64; volatile int* itemw = (volatile int*)(w.lds + L_ITEM);
    const int hr = w.wid >> 1, th = w.wid & 1;
    unsigned* mixc = (unsigned*)(F.ws + WS_CTL) + CW_MIXC;
    int prev = -1; bool mid_ok = false; int nxt_item = 0; bool have_nxt = false;
    for (;;) {
        if (prev >= 0) asm volatile("s_waitcnt vmcnt(0)" ::: "memory");
        __syncthreads();
        if (F.tid == 0) { if (prev >= 0) (void)__hip_atomic_fetch_add(mixc + 16 * prev, 1u, __ATOMIC_RELAXED, __HIP_MEMORY_SCOPE_AGENT);
            int it_ = have_nxt ? nxt_item : (int)atomicAdd(qctr, 1u); have_nxt = false;
            if (it_ < 256) { nxt_item = (int)atomicAdd(qctr, 1u); have_nxt = true; }
            itemw[0] = it_; }
        __syncthreads();
        const int item = itemw[0];
        if (item >= 640 + 512) break;
        if (!mid_ok && item >= 256) {
            if (F.tid == 0) { unsigned sp = 0u; while (xb_ld((unsigned*)(F.ws + WS_CTL) + CW_MIDDONE) < (unsigned)F.G) { __builtin_amdgcn_s_sleep(2); if (++sp > (1u << 22)) break; }
                __builtin_amdgcn_fence(__ATOMIC_ACQUIRE, "agent"); asm volatile("s_waitcnt vmcnt(0)" ::: "memory"); }
            __syncthreads();
            mid_ok = true;
        }
        if (item >= 640) {
            const int mi = item - 640, mqb = 31 - (mi >> 4), mb = (mi >> 2) & 3, mh = mi & 3; const unsigned need = 2u * (2u + (mqb >= 16 ? 1u : 0u));
            if (F.tid == 0) { unsigned sp = 0u; while (xb_ld(mixc + 16 * (mb * 32 + mqb)) < need) { __builtin_amdgcn_s_sleep(2); if (++sp > (1u << 22)) break; }
                __builtin_amdgcn_fence(__ATOMIC_ACQUIRE, "agent"); asm volatile("s_waitcnt vmcnt(0)" ::: "memory"); }
            __syncthreads();
            mix_rows<2>(F, mb * SEQ + mqb * 64 + mh * 16 + F.wave * 2, fresh_lane());
            prev = -1; continue;
        }
        WV_INIT();
        const int ent = ATT_ITEMS[item >> 3], bg = item & 7, type = ent >> 5, qb = ent & 31, b = bg >> 1, g = bg & 1, h = 4 * g + hr;
        prev = b * 32 + qb;
        const int t0 = qb * 64 + th * 32, tpos = t0 + w.r32, tok0 = b * SEQ + t0;
        const size_t qoff = (((size_t)b * NH + h) * SEQ + t0 + w.r32) * HD + w.hi * 8;
        const size_t kvoff = ((size_t)b * NG + g) * SEQ * HD;
        bf16x8 qr[8];
        f32x16 o[4];
#ifndef ATT_NO_WIN
        if (type == 2) {
#pragma unroll
            for (int d0 = 0; d0 < 8; ++d0) qr[d0] = *(const bf16x8*)(qrp + qoff + d0 * 16);
#pragma unroll
            for (int d = 0; d < 4; ++d) o[d] = f32x16{};
            float m_reg = -1e30f, l_reg = 0.f;
            flash_pass<1>(w, kv + (size_t)4 * (4 * MB / 2) + kvoff, kv + (size_t)5 * (4 * MB / 2) + kvoff, qb >= 8 ? qb - 8 : 0, qb + 1, qr, tpos, t0, 0u, o, m_reg, l_reg);
            if (w.hi == 0) wsf[w.r32] = 1.f / l_reg;
            asm volatile("s_waitcnt lgkmcnt(0)" ::: "memory");
            store_o(w, o, wsf, owin + (size_t)tok0 * 1024 + h * HD);
            continue;
        }
#endif
#ifndef ATT_NO_CMP
        {
#pragma unroll
            for (int d0 = 0; d0 < 8; ++d0) qr[d0] = *(const bf16x8*)(qn + qoff + d0 * 16);
            const bf16_t* Kc = ckv + (size_t)bg * 128 * HD; const bf16_t* Vc = ckv + (size_t)1024 * HD + (size_t)bg * 128 * HD;
            dma_tile(w, Kc, Vc, 0); dma_tile(w, Kc + 64 * HD, Vc + 64 * HD, 1);
            asm volatile("s_waitcnt vmcnt(0)" ::: "memory");
            __syncthreads();
            f32x16 pA0, pA1, pB0, pB1;
            qkt<0>(w, qr, pA0, pA1); qkt<1>(w, qr, pB0, pB1);
            const int nmax = tpos >= 31 ? ((tpos - 31) >> 4) : -1;
            const float NEG = -__builtin_inff();
            float pmax = NEG;
#pragma unroll
            for (int r = 0; r < 16; ++r) { const int n = crow(r, w.hi);
                pA0[r] = (n <= nmax) ? pA0[r] : NEG; pA1[r] = (n + 32 <= nmax) ? pA1[r] : NEG; pB0[r] = (n + 64 <= nmax) ? pB0[r] : NEG; pB1[r] = (n + 96 <= nmax) ? pB1[r] : NEG;
                pmax = fmaxf(fmaxf(pmax, pA0[r]), fmaxf(pA1[r], fmaxf(pB0[r], pB1[r]))); }
            pmax = swap_max(pmax);
            const float mm = (pmax == NEG) ? 0.f : pmax;
            const float mnL = -mm * C2;
            float ps = 0.f;
#pragma unroll
            for (int r = 0; r < 16; ++r) { pA0[r] = __builtin_amdgcn_exp2f(fmaf(pA0[r], C2, mnL)); pA1[r] = __builtin_amdgcn_exp2f(fmaf(pA1[r], C2, mnL));
                pB0[r] = __builtin_amdgcn_exp2f(fmaf(pB0[r], C2, mnL)); pB1[r] = __builtin_amdgcn_exp2f(fmaf(pB1[r], C2, mnL)); ps += (pA0[r] + pA1[r]) + (pB0[r] + pB1[r]); }
            ps = swap_sum(ps);
            const float inv = ps > 0.f ? 1.f / ps : 0.f;
#pragma unroll
            for (int r = 0; r < 16; ++r) { pA0[r] *= inv; pA1[r] *= inv; pB0[r] *= inv; pB1[r] *= inv; }
            {
                float av[16], bv[16];
#pragma unroll
                for (int gq = 0; gq < 4; ++gq) {
                    av[gq]      = pA0[4 * gq] + pA0[4 * gq + 1] + pA0[4 * gq + 2] + 0.5f * pA0[4 * gq + 3]; bv[gq]      = 0.5f * pA0[4 * gq + 3];
                    av[4 + gq]  = pA1[4 * gq] + pA1[4 * gq + 1] + pA1[4 * gq + 2] + 0.5f * pA1[4 * gq + 3]; bv[4 + gq]  = 0.5f * pA1[4 * gq + 3];
                    av[8 + gq]  = pB0[4 * gq] + pB0[4 * gq + 1] + pB0[4 * gq + 2] + 0.5f * pB0[4 * gq + 3]; bv[8 + gq]  = 0.5f * pB0[4 * gq + 3];
                    av[12 + gq] = pB1[4 * gq] + pB1[4 * gq + 1] + pB1[4 * gq + 2] + 0.5f * pB1[4 * gq + 3]; bv[12 + gq] = 0.5f * pB1[4 * gq + 3];
                }
                float* prow = part + ((size_t)hr * 64 + th * 32 + w.r32) * 33;
#pragma unroll
                for (int idx = 0; idx < 16; ++idx) {
                    const float bo = __shfl_xor(bv[idx], 32);
                    const float bprev = (idx > 0) ? __shfl_xor(bv[idx > 0 ? idx - 1 : 0], 32) : 0.f;
                    const float inc = w.hi ? bo : bprev;
                    prow[2 * idx + w.hi] = av[idx] + inc;
                }
            }
            if (type == 0) {
                bf16x8 pa0, pa1, pa2, pa3;
#pragma unroll
                for (int d = 0; d < 4; ++d) o[d] = f32x16{};
                pack_p(pA0, pA1, pa0, pa1, pa2, pa3); pv_tile<0>(o, w.vb0, pa0, pa1, pa2, pa3);
                pack_p(pB0, pB1, pa0, pa1, pa2, pa3); pv_tile<1>(o, w.vb0, pa0, pa1, pa2, pa3);
                if (w.hi == 0) wsf[w.r32] = 1.f;
                asm volatile("s_waitcnt lgkmcnt(0)" ::: "memory");
                store_o(w, o, wsf, ocmp + (size_t)tok0 * 1024 + h * HD);
            }
            __syncthreads();
#pragma unroll 1
            for (int ps2 = 0; ps2 < 4; ++ps2) {
                int ln = w.lane; asm volatile("" : "+v"(ln));
                const int j = ln & 31, hi2 = ln >> 5;
                const int tk = 8 * w.wid + 2 * ps2 + hi2, t = qb * 64 + tk, cur = qb;
                float imp = 0.f;
#pragma unroll
                for (int r = 0; r < 4; ++r) imp += part[((size_t)r * 64 + tk) * 33 + j];
                const bool ok = (64 * j <= t), forced = (j == 0) || (cur - j >= 0 && cur - j < 2);
                const float val = (ok && forced) ? 1.0e30f : (ok ? imp : -1.0e30f);
                vals[ln] = val;
                asm volatile("s_waitcnt lgkmcnt(0)" ::: "memory");
                int rank = 0;
#pragma unroll
                for (int jj = 0; jj < 32; ++jj) { const float o2 = vals[hi2 * 32 + jj]; rank += (o2 > val || (o2 == val && jj < j)) ? 1 : 0; }
                const unsigned long long bal = __ballot(rank < 16 && val >= 0.f);
                if (w.lane == 0) { selm[8 * w.wid + 2 * ps2] = (unsigned)bal; selm[8 * w.wid + 2 * ps2 + 1] = (unsigned)(bal >> 32); }
            }
            __syncthreads();
        }
#endif
#ifndef ATT_NO_SEL
        {
            WV_INIT();
            const unsigned sm = selm[th * 32 + w.r32];
            const int ntile = qb + 1, hsplit = (ntile + 1) >> 1;
            const int ja = (qb >= 16 && type == 1) ? hsplit : 0, jb = (qb >= 16 && type == 0) ? hsplit : ntile;
#pragma unroll
            for (int d0 = 0; d0 < 8; ++d0) qr[d0] = *(const bf16x8*)(qrp + qoff + d0 * 16);
#pragma unroll
            for (int d = 0; d < 4; ++d) o[d] = f32x16{};
            float m_reg = -1e30f, l_reg = 0.f;
            flash_pass<0>(w, kv + (size_t)2 * (4 * MB / 2) + kvoff, kv + (size_t)3 * (4 * MB / 2) + kvoff, ja, jb, qr, tpos, t0, sm, o, m_reg, l_reg);
            if (w.hi == 0) { wsf[w.r32] = l_reg > 0.f ? 1.f / l_reg : 0.f; float* mp = ml + (((size_t)type * NT + tok0 + w.r32) * NH + h) * 2; st_wt(mp, m_reg); st_wt(mp + 1, l_reg); }
            asm volatile("s_waitcnt lgkmcnt(0)" ::: "memory");
            store_o(w, o, wsf, osel + (size_t)type * NT * 1024 + (size_t)tok0 * 1024 + h * HD);
        }
#endif
    }
}

struct CvtTile { const float* src; const float* ksc; bf16_t* dst0; int sld, ldd, mode; };
__device__ __forceinline__ CvtTile cvt_decode(const Frame& F, int t) {
    CvtTile c; c.ksc = nullptr; c.mode = 0;
    if (t < 4096) { const int e = t >> 7, mat = (t >> 6) & 1, kt = (t >> 1) & 31, nt = t & 1;
        c.src = (mat ? F.in[I_WUP] : F.in[I_WGATE]) + ((size_t)e * DM + kt * 64) * FF + nt * 256; c.sld = FF; c.ksc = F.in[I_LNMOE] + kt * 64;
        c.dst0 = (bf16_t*)(F.ws + WS_W1T) + ((size_t)e * 1024 + nt * 512 + mat * 128) * DM + kt * 64; c.ldd = DM; c.mode = 1; return c; }
    t -= 4096;
    if (t < 2048) { const int e = t >> 6, kt = (t >> 3) & 7, nt = t & 7;
        c.src = F.in[I_WDOWN] + ((size_t)e * FF + kt * 64) * DM + nt * 256; c.sld = DM;
        c.dst0 = (bf16_t*)(F.ws + WS_W2T) + ((size_t)e * 2048 + nt * 256) * FF + kt * 64; c.ldd = FF; return c; }
    t -= 2048;
    if (t < 256) { const int kt = t >> 3, nt = t & 7;
        c.src = F.in[I_WOUT] + (size_t)kt * 64 * DM + nt * 256; c.sld = DM; c.dst0 = (bf16_t*)(F.ws + WS_WOUTT) + (size_t)nt * 256 * DM + kt * 64; c.ldd = DM; c.mode = 20; return c; }
    t -= 256;
    if (t < 480) { const int kt = t / 15, nt = t % 15;
        c.src = F.in[I_WIN] + (size_t)kt * 64 * INW; c.sld = INW; c.ksc = F.in[I_LNMIX] + kt * 64;
        c.dst0 = (bf16_t*)(F.ws + WS_WINT) + (size_t)nt * 256 * DM + kt * 64; c.ldd = DM; c.mode = 2 + nt; return c; }
    t -= 480;
    { const int kv = t >> 6, kt = t & 63;
      c.src = (kv ? F.in[I_WV1] : F.in[I_WK1]) + (size_t)kt * 64 * 256; c.sld = 256; c.dst0 = (bf16_t*)(F.ws + WS_CMPW) + (size_t)kv * 256 * 4096 + kt * 64; c.ldd = 4096; return c; }
}
constexpr int N_CVT_TILES = 4096 + 2048 + 256 + 480 + 128;
__device__ __forceinline__ void cvt_load(const CvtTile& c, int nq, int kq, float4 (&v)[8]) {
    const float* p = c.src + 4 * nq; bool valid = true;
    if (c.mode >= 2 && c.mode < 20) { const int n = (c.mode - 2) * 256 + 4 * nq; int sc = -1; if (n < 2560) sc = n; else if (n < 3584) sc = n + 24; else if (n < 3608) sc = n - 1024; valid = sc >= 0; p = c.src + (valid ? sc : 0); }
#pragma unroll
    for (int i = 0; i < 8; ++i) { pg8::f32x4 t_ = {0.f, 0.f, 0.f, 0.f}; if (valid) t_ = __builtin_nontemporal_load((const pg8::f32x4*)(p + (size_t)(kq * 8 + i) * c.sld)); v[i] = make_float4(t_[0], t_[1], t_[2], t_[3]); }
}

constexpr int CVT_RUN = 4;
struct CvtPre { int tA, tB; float4 vA[8], vB[8]; CvtTile cA, cB; };
__device__ __forceinline__ void cvt_prefetch(const Frame& F, int t_lo, int t_hi, CvtPre& P) {
    const int nq = F.tid & 63, kq = F.tid >> 6; P.tA = t_lo + F.bid; P.tB = P.tA + F.G;
    if (P.tA < t_hi) { P.cA = cvt_decode(F, P.tA); cvt_load(P.cA, nq, kq, P.vA); }
    if (P.tB < t_hi) { P.cB = cvt_decode(F, P.tB); cvt_load(P.cB, nq, kq, P.vB); }
}
template <bool PRE>
__device__ __forceinline__ void cvt_stream_t(const Frame& F, int t_lo, int t_hi, unsigned* queue, int sfirst, int sstride, CvtPre& pre) {
    if (sfirst < 0) { sfirst = F.bid; sstride = F.G; }
    float* T = F.lds;
    volatile int* nxtw = (volatile int*)(F.lds + 64 * 257);
    const int tid = F.tid, nq = tid & 63, kq = tid >> 6;
    int& tA = pre.tA; int& tB = pre.tB; float4 (&vA)[8] = pre.vA; float4 (&vB)[8] = pre.vB; CvtTile& cA = pre.cA; CvtTile& cB = pre.cB;
    if (!PRE) {
    if (queue) { __syncthreads(); if (tid == 0) { nxtw[0] = t_lo + CVT_RUN * (int)atomicAdd(queue, 1u); nxtw[1] = t_lo + CVT_RUN * (int)atomicAdd(queue, 1u); } __syncthreads(); tA = nxtw[0]; tB = nxtw[1]; }
    else { tA = t_lo + sfirst; tB = tA + sstride; }
    if (tA < t_hi) { cA = cvt_decode(F, tA); cvt_load(cA, nq, kq, vA); }
    if (tB < t_hi) { cB = cvt_decode(F, tB); cvt_load(cB, nq, kq, vB); } }
#define CVT_STEP(tX, cX, vX, slot) do {                                                                                                     \
        const bool pop = queue && (((tX) - t_lo) % CVT_RUN == CVT_RUN - 1);                 \
        int tn_reg = 0;                                                                                                                      \
        if (pop && tid == 0) tn_reg = t_lo + CVT_RUN * (int)atomicAdd(queue, 1u);                                                            \
        __syncthreads();                                                                                                                     \
        _Pragma("unroll") for (int i = 0; i < 8; ++i) { const float s = cX.ksc ? cX.ksc[kq * 8 + i] : 1.f; float* tp = T + (kq * 8 + i) * 257 + 4 * nq; \
            tp[0] = vX[i].x * s; tp[1] = vX[i].y * s; tp[2] = vX[i].z * s; tp[3] = vX[i].w * s; }                                           \
        if (pop && tid == 0) nxtw[slot] = tn_reg;                                                                                            \
        __syncthreads();                                                                                                                     \
        const CvtTile cc = cX; const int tn = queue ? (pop ? nxtw[slot] : tX + 1) : tX + 2 * sstride;                                            \
        if (tn < t_hi) { cX = cvt_decode(F, tn); cvt_load(cX, nq, kq, vX); }                                                                 \
        _Pragma("unroll") for (int j = 0; j < 4; ++j) { const int id = tid + 512 * j, n = id >> 3, kc = id & 7; const float* tp = T + (kc * 8) * 257 + n; \
            pg8::u32x4 w; w.x = pg8::cvt_pk_bf16(tp[0], tp[257]); w.y = pg8::cvt_pk_bf16(tp[2 * 257], tp[3 * 257]); w.z = pg8::cvt_pk_bf16(tp[4 * 257], tp[5 * 257]); w.w = pg8::cvt_pk_bf16(tp[6 * 257], tp[7 * 257]); \
              \
              \
            const int ct_ = cc.mode - 2; const bool wperm_ = cc.mode >= 2 && cc.mode < 16 && !(((ct_ < 4) || ct_ == 6 || ct_ == 8) && (n & 127) < 32);                          \
            const int rowi = (cc.mode == 1) ? ((n >> 7) * 256 + (n & 127)) : ((cc.mode == 20 || wperm_) ? ((n & ~31) | (((n >> 2) & 1) << 4) | (((n >> 3) & 3) << 2) | (n & 3)) : n);                    \
            *(pg8::u32x4*)(cc.dst0 + (size_t)rowi * cc.ldd + kc * 8) = w; }                                                                  \
        tX = tn; } while (0)
    while (tA < t_hi) {
        CVT_STEP(tA, cA, vA, 0);
        if (tB >= t_hi) { const int t2 = tA; tA = tB; tB = t2; const CvtTile c2 = cA; cA = cB; cB = c2;
#pragma unroll
            for (int i = 0; i < 8; ++i) { const float4 x = vA[i]; vA[i] = vB[i]; vB[i] = x; }
            continue; }
        CVT_STEP(tB, cB, vB, 1);
    }
    while (tB < t_hi) CVT_STEP(tB, cB, vB, 1);
#undef CVT_STEP
    __syncthreads();
}
__device__ __forceinline__ void cvt_stream(const Frame& F, int t_lo, int t_hi, unsigned* queue, int sfirst = -1, int sstride = 0) { CvtPre P; cvt_stream_t<false>(F, t_lo, t_hi, queue, sfirst, sstride, P); }

__device__ __forceinline__ void p0_tables(const Frame& F, int first, int stride) {
    {
        const float* wp = F.in[I_WPOOL]; const float* ps = F.in[I_PSCALE]; const float* bp = F.in[I_BPOOL]; bf16_t* wpt = (bf16_t*)(F.ws + WS_POOLW); float* pb = (float*)(F.ws + WS_POOLB);
        for (int idx = first * NTHREADS + F.tid; idx < 4 * 256 * 256; idx += stride * NTHREADS) { const int k = idx & 255, n = (idx >> 8) & 255, g = idx >> 16;
            wpt[idx] = f2bf(wp[((size_t)g * 256 + k) * 256 + n] * ps[g * 256 + n]); }
        for (int idx = first * NTHREADS + F.tid; idx < 1024; idx += stride * NTHREADS) pb[idx] = bp[idx] * ps[idx];
    }
    { const float* lnm = F.in[I_LNMOE]; const float* wre = F.in[I_WRE]; const float* wrg = F.in[I_WRG]; float* WRP = (float*)(F.ws + WS_WRP);
      for (int idx = first * NTHREADS + F.tid; idx < DM * 48; idx += stride * NTHREADS) { const int k = idx / 48, c = idx - k * 48;
          WRP[idx] = c < 32 ? lnm[k] * wre[((size_t)(c >> 3) * DM + k) * 8 + (c & 7)] : (c < 36 ? lnm[k] * wrg[k * 4 + (c - 32)] : 0.f); } }
    { const float* lnm = F.in[I_LNMOE]; const float* wre = F.in[I_WRE]; const float* wrg = F.in[I_WRG]; bf16_t* WQ = (bf16_t*)(F.ws + WS_WRPB);
      for (int idx = first * NTHREADS + F.tid; idx < 64 * 6 * 512; idx += stride * NTHREADS) {
          const int sl = idx & 7, ln = (idx >> 3) & 63, jp = (idx >> 9) % 6, cg = idx / (512 * 6), jblk = jp >> 1, part = jp & 1, fr = ln & 15, fq = ln >> 4;
          const int k = cg * 32 + 8 * fq + sl, c = jblk * 16 + fr;
          const float wv = c < 32 ? lnm[k] * wre[((size_t)(c >> 3) * DM + k) * 8 + (c & 7)] : (c < 36 ? lnm[k] * wrg[k * 4 + (c - 32)] : 0.f);
          const bf16_t hb = f2bf(wv); WQ[idx] = part ? f2bf(wv - bf2f(hb)) : hb; } }
    for (int it = first; it < 256; it += stride) {
        const int kv = it >> 7, jb = (it >> 5) & 3, mc = it & 31;
        const float* pe = (kv ? F.in[I_PEV] : F.in[I_PEK]); const float* w1 = (kv ? F.in[I_WV1] : F.in[I_WK1]);
        const int mg = F.tid >> 6, j = jb * 64 + (F.tid & 63);
        float a = 0.f;
#pragma unroll
        for (int q = 0; q < 16; ++q) { const int m = mc * 128 + mg + 8 * q; a += pe[m] * w1[(size_t)m * 256 + j]; }
        __syncthreads();
        F.lds[F.tid] = a;
        __syncthreads();
        if (F.tid < 64) { float s = 0.f; for (int q = 0; q < 8; ++q) s += F.lds[q * 64 + F.tid]; ((float*)(F.ws + WS_BIAS1))[(mc * 2 + kv) * 256 + j] = s; }
        __syncthreads();
    }
}
__device__ __forceinline__ void p0_prologue(const Frame& F) {
    const float* x = F.in[I_X];
    bf16_t* xb = (bf16_t*)(F.ws + WS_XB); float* rstd1 = (float*)(F.ws + WS_RSTD1);
    const int gw = F.bid * NWAVES + F.wave, nw = F.G * NWAVES, lane = F.lane;
    CvtPre cpre; cvt_prefetch(F, 6400, N_CVT_TILES, cpre);
    for (int r0 = gw; r0 < NT; r0 += 2 * nw) {
        float4 v[2][8]; float ss[2];
#pragma unroll
        for (int q = 0; q < 2; ++q) { const int r = r0 + q * nw;
#pragma unroll
            for (int i = 0; i < 8; ++i) { pg8::f32x4 t_ = {0.f, 0.f, 0.f, 0.f}; if (r < NT) t_ = __builtin_nontemporal_load((const pg8::f32x4*)(x + (size_t)r * DM + i * 256 + lane * 4)); v[q][i] = make_float4(t_[0], t_[1], t_[2], t_[3]); } }
#pragma unroll
        for (int q = 0; q < 2; ++q) { float a = 0.f;
#pragma unroll
            for (int i = 0; i < 8; ++i) a += v[q][i].x * v[q][i].x + v[q][i].y * v[q][i].y + v[q][i].z * v[q][i].z + v[q][i].w * v[q][i].w;
            ss[q] = wave_sum(a); }
#pragma unroll
        for (int q = 0; q < 2; ++q) { const int r = r0 + q * nw;
            if (r < NT) { if (lane == 0) rstd1[r] = rsqrtf(ss[q] * (1.f / DM) + EPS);
#pragma unroll
                for (int i = 0; i < 8; ++i) { uint2 w; w.x = pg8::cvt_pk_bf16(v[q][i].x, v[q][i].y); w.y = pg8::cvt_pk_bf16(v[q][i].z, v[q][i].w); *(uint2*)(xb + (size_t)r * DM + i * 256 + lane * 4) = w; } } }
    }
    cvt_stream_t<true>(F, 6400, N_CVT_TILES, nullptr, -1, 0, cpre);
    {
        const int* pos = (const int*)F.in[I_POS]; float* rc = (float*)(F.ws + WS_ROPEC); float* rs = (float*)(F.ws + WS_ROPES);
        for (int idx = F.bid * NTHREADS + F.tid; idx < NB * SEQ * 16; idx += F.G * NTHREADS) {
            const int i = idx & 15, bs = idx >> 4;
            const float inv = exp2f(-(float)i * (1.f / 16.f) * 18.931568569324174f);
            const float ang = (float)pos[bs] * inv;
            rc[idx] = cosf(ang); rs[idx] = sinf(ang);
        }
    }
}

struct EpiProj {
    static constexpr bool AFTER_DRAIN = false;
    const float* rstd1; const float* rc; const float* rs; bf16_t* qn; bf16_t* qr; bf16_t* kv; bf16_t* u; float* gates;
    __device__ __forceinline__ void operator()(const pg8::f32x4 (&acc)[2][2][4][2], const pg8::Unit& un, int wr, int wc, int fr, int fq) const {
        const int pn = un.pn;
#pragma unroll
        for (int ai = 0; ai < 2; ++ai)
#pragma unroll
            for (int m = 0; m < 4; ++m) {
                const int row = un.pm * 256 + ai * 128 + wr * 64 + m * 16 + fr; const float r1 = rstd1[row]; const int b = row >> 11, s = row & 2047;
                if (pn < 10) {
                    const bool ropeu = (pn < 4) || pn == 6 || pn == 8;
                    pg8::f32x4 c4 = {1.f, 1.f, 1.f, 1.f}, s4 = {0.f, 0.f, 0.f, 0.f};
                    if (ropeu && wc == 0) { c4 = *(const pg8::f32x4*)(rc + (size_t)row * 16 + 4 * fq); s4 = *(const pg8::f32x4*)(rs + (size_t)row * 16 + 4 * fq); }
#pragma unroll
                    for (int bj = 0; bj < 2; ++bj) {
                        const pg8::f32x4 v0 = acc[ai][bj][m][0] * r1, v1 = acc[ai][bj][m][1] * r1;
                        const bool rot = ropeu && wc == 0;
                        pg8::f32x4 o0 = v0, o1 = v1;
                        if (rot) { o0 = v0 * c4 - v1 * s4; o1 = v1 * c4 + v0 * s4; }
                        uint2 w0, w1; w0.x = pg8::cvt_pk_bf16(o0[0], o0[1]); w0.y = pg8::cvt_pk_bf16(o0[2], o0[3]); w1.x = pg8::cvt_pk_bf16(o1[0], o1[1]); w1.y = pg8::cvt_pk_bf16(o1[2], o1[3]);
                        const size_t hb = (pn < 4) ? (((size_t)b * NH + 2 * pn + bj) * SEQ + s) * HD : (size_t)(pn - 4) * (4 * MB / 2) + (((size_t)b * NG + bj) * SEQ + s) * HD;
                        bf16_t* dr = (pn < 4) ? qr : kv;
                        if (rot) {
                            const size_t o = hb + 4 * fq;
                            *(uint2*)(dr + o) = w0; *(uint2*)(dr + o + 16) = w1;
                            if (pn < 4) { uint2 n0, n1; n0.x = pg8::cvt_pk_bf16(v0[0], v0[1]); n0.y = pg8::cvt_pk_bf16(v0[2], v0[3]); n1.x = pg8::cvt_pk_bf16(v1[0], v1[1]); n1.y = pg8::cvt_pk_bf16(v1[2], v1[3]);
                                *(uint2*)(qn + o) = n0; *(uint2*)(qn + o + 16) = n1; }
                        } else {
                            const size_t o = hb + 32 * wc + 8 * fq; pg8::u32x4 ww; ww.x = w0.x; ww.y = w0.y; ww.z = w1.x; ww.w = w1.y;
                            *(pg8::u32x4*)(dr + o) = ww;
                            if (pn < 4) *(pg8::u32x4*)(qn + o) = ww;
                        }
                    }
                } else if (pn < 14) {
#pragma unroll
                    for (int bj = 0; bj < 2; ++bj) { const pg8::f32x4 v0 = acc[ai][bj][m][0] * r1, v1 = acc[ai][bj][m][1] * r1; pg8::u32x4 w_;
                        w_.x = pg8::cvt_pk_bf16(v0[0], v0[1]); w_.y = pg8::cvt_pk_bf16(v0[2], v0[3]); w_.z = pg8::cvt_pk_bf16(v1[0], v1[1]); w_.w = pg8::cvt_pk_bf16(v1[2], v1[3]);
                        *(pg8::u32x4*)(u + (size_t)row * 1024 + (pn - 10) * 256 + bj * 128 + wc * 32 + 8 * fq) = w_; }
                } else {
                    if (wc == 0) { *(pg8::f32x4*)(gates + (size_t)row * 24 + 4 * fq) = acc[ai][0][m][0] * r1; if (fq < 2) *(pg8::f32x4*)(gates + (size_t)row * 24 + 16 + 4 * fq) = acc[ai][0][m][1] * r1; }
                }
            }
    }
};

__device__ __forceinline__ void p1_proj(const Frame& F, LAS unsigned char* stage) {
    pg8::DenseOrder S; S.init(F.ws + WS_XB, F.ws + WS_WINT, DM, DM, NT, INWP, F.G, F.bid);
    EpiProj E{(const float*)(F.ws + WS_RSTD1), (const float*)(F.ws + WS_ROPEC), (const float*)(F.ws + WS_ROPES), (bf16_t*)(F.ws + WS_QN), (bf16_t*)(F.ws + WS_QR), (bf16_t*)(F.ws + WS_KV),
              (bf16_t*)(F.ws + WS_U), (float*)(F.ws + WS_GATES)};
    pg8::gemm_phase<EpiProj, pg8::DenseOrder, false>(stage, DM, DM, DM, S, E);
    if (F.G == 256) { if (F.bid >= 224) p0_tables(F, F.bid - 224, 32); } else p0_tables(F, F.bid, F.G);
}

__device__ __forceinline__ void p4_cmp2(const Frame& F, int first, int stride, bool gated) {
    const float* part = (const float*)(F.ws + WS_CPART); const float* bias1p = (const float*)(F.ws + WS_BIAS1); bf16_t* ckv = (bf16_t*)(F.ws + WS_CMPKV);
    float* H = F.lds;
    float* W2 = F.lds + 8 * 260;
    unsigned* ctl = (unsigned*)(F.ws + WS_CTL);
    int w2_of = -1;
    for (int it0 = first; it0 < 256; it0 += stride) {
        const int it = (stride == 128) ? (((first >> 6) << 7) | ((first & 63) << 1) | (it0 >= 128 ? 1 : 0)) : it0;
        const int kvi = it >> 7, r0 = (it & 127) * 8; const float* w2 = kvi ? F.in[I_WV2] : F.in[I_WK2];
        __syncthreads();
        if (gated && F.tid == 0) { unsigned* cw = ctl + CW_CMPR + 64 * (kvi * 4 + (r0 >> 8)); unsigned sp = 0;
            while (__hip_atomic_load(cw, __ATOMIC_RELAXED, __HIP_MEMORY_SCOPE_AGENT) < 8u) { __builtin_amdgcn_s_sleep(2);
                if ((++sp & 255u) == 0u) { if (xb_ld(&ctl[XB_TMO])) break; if (sp > XB_SPIN_CAP) { atomicAdd(&ctl[XB_TMO], 1u); break; } } }
            __builtin_amdgcn_fence(__ATOMIC_ACQUIRE, "agent"); asm volatile("s_waitcnt vmcnt(0)" ::: "memory"); }
        if (gated) __syncthreads();
        if (w2_of != kvi) {
#pragma unroll
            for (int j = 0; j < 16; ++j) { const int idx = F.tid + 512 * j; *(pg8::f32x4*)(W2 + idx * 4) = *(const pg8::f32x4*)(w2 + idx * 4); }
            w2_of = kvi;
        }
        { const int r = F.tid >> 6, c = (F.tid & 63) * 4;
            pg8::f32x4 s = {0.f, 0.f, 0.f, 0.f};
#pragma unroll
            for (int sp = 0; sp < 8; ++sp) s += *(const pg8::f32x4*)(part + (((size_t)sp * 2 + kvi) * 1024 + r0 + r) * 256 + c);
#pragma unroll
            for (int sp = 0; sp < 32; ++sp) s += *(const pg8::f32x4*)(bias1p + (sp * 2 + kvi) * 256 + c);
            H[r * 260 + c] = gelu_tanh(s[0]); H[r * 260 + c + 1] = gelu_tanh(s[1]); H[r * 260 + c + 2] = gelu_tanh(s[2]); H[r * 260 + c + 3] = gelu_tanh(s[3]); }
        __syncthreads();
        const int r = F.tid >> 6, c0 = (F.tid & 63) * 2;
        float a0 = 0.f, a1 = 0.f;
#pragma unroll 16
        for (int k = 0; k < 256; ++k) { const float hv = H[r * 260 + k]; const float2 wv = *(const float2*)(W2 + k * 128 + c0); a0 += hv * wv.x; a1 += hv * wv.y; }
        const int R = r0 + r; const bool pad = (R & 127) == 127;
        st_wt(ckv + ((size_t)kvi * 1024 + R) * 128 + c0, pad ? 0u : pg8::cvt_pk_bf16(a0, a1));
    }
}

struct CmpOrder {
    const char* kc; const char* w1t; int c;
    __device__ __forceinline__ bool next(int i, pg8::Unit& u) const { if (i > 0) return false; u.e = c >> 5; u.pm = (c >> 3) & 3; u.pn = c & 7; u.li = 0; return true; }
    __device__ __forceinline__ const char* a_base(const pg8::Unit& u) const { return kc + (size_t)u.e * 4 * MB + ((size_t)u.pm * 256 * 2048 + u.pn * 512) * 2; }
    __device__ __forceinline__ const char* b_base(const pg8::Unit& u) const { return w1t + ((size_t)u.e * 256 * 4096 + u.pn * 512) * 2; }
    __device__ __forceinline__ unsigned a_row_off(const pg8::Unit&, int r) const { return (unsigned)r * 4096u; }
};
struct EpiCmp {
    static constexpr bool AFTER_DRAIN = false;
    float* part;
    __device__ __forceinline__ void operator()(const pg8::f32x4 (&acc)[2][2][4][2], const pg8::Unit& un, int wr, int wc, int fr, int fq) const {
        float* base = part + (((size_t)un.pn * 2 + un.e) * 1024 + un.pm * 256) * 256;
#pragma unroll
        for (int ai = 0; ai < 2; ++ai)
#pragma unroll
            for (int m = 0; m < 4; ++m) { float* rowp = base + (size_t)(ai * 128 + wr * 64 + m * 16 + fr) * 256 + wc * 32 + 4 * fq;
#pragma unroll
                for (int bj = 0; bj < 2; ++bj)
#pragma unroll
                    for (int n = 0; n < 2; ++n) *(pg8::f32x4*)(rowp + bj * 128 + n * 16) = acc[ai][bj][m][n]; }
    }
};
struct PoolOrder {
    const char* d; const char* wpt; int c;
    __device__ __forceinline__ bool next(int i, pg8::Unit& u) const { if (i > 0) return false; u.pm = c >> 2; u.pn = 0; u.e = c & 3; u.li = 0; return true; }
    __device__ __forceinline__ const char* a_base(const pg8::Unit& u) const { return d + ((size_t)u.pm * 256 * 1024 + u.e * 256) * 2; }
    __device__ __forceinline__ const char* b_base(const pg8::Unit& u) const { return wpt + (size_t)u.e * 256 * 256 * 2; }
    __device__ __forceinline__ unsigned a_row_off(const pg8::Unit&, int r) const { return (unsigned)r * 2048u; }
};
struct EpiPool {
    static constexpr bool AFTER_DRAIN = false;
    bf16_t* z;
    __device__ __forceinline__ void operator()(const pg8::f32x4 (&acc)[2][2][4][2], const pg8::Unit& un, int wr, int wc, int fr, int fq) const {
#pragma unroll
        for (int ai = 0; ai < 2; ++ai)
#pragma unroll
            for (int m = 0; m < 4; ++m) { const int row = un.pm * 256 + ai * 128 + wr * 64 + m * 16 + fr;
#pragma unroll
                for (int bj = 0; bj < 2; ++bj)
#pragma unroll
                    for (int n = 0; n < 2; ++n) { const int c = un.e * 256 + bj * 128 + wc * 32 + n * 16 + 4 * fq;
                        const pg8::f32x4 v = acc[ai][bj][m][n]; uint2 w_; w_.x = pg8::cvt_pk_bf16(v[0], v[1]); w_.y = pg8::cvt_pk_bf16(v[2], v[3]);
                        *(uint2*)(z + (size_t)row * 1024 + c) = w_; } }
    }
};
__device__ __forceinline__ void p2a_mid(const Frame& F, LAS unsigned char* stage) {
    if (F.bid < 64) {
        CmpOrder S{(const char*)(F.ws + WS_KV), (const char*)(F.ws + WS_CMPW), F.bid};
        EpiCmp E{(float*)(F.ws + WS_CPART)};
        pg8::gemm_phase<EpiCmp, CmpOrder, false>(stage, 512, 2048, 4096, S, E);
    } else if (F.bid < 192) {
        PoolOrder S{(const char*)(F.ws + WS_U), (const char*)(F.ws + WS_POOLW), F.bid - 64};
        EpiPool E{(bf16_t*)(F.ws + WS_DBUF)};
        pg8::gemm_phase<EpiPool, PoolOrder, false>(stage, 256, 1024, 256, S, E);
    } else {
        cvt_stream(F, 6144, 6400, nullptr, F.bid - 192, F.G - 192);
    }
}
__device__ __forceinline__ void p2b_mid(const Frame& F, LAS unsigned char* stage) {
    (void)stage;
    if (F.bid < 128) {
        const bf16_t* z = (const bf16_t*)(F.ws + WS_DBUF); bf16_t* op = (bf16_t*)(F.ws + WS_OPOOL); const float* pbias = (const float*)(F.ws + WS_POOLB);
        const int col = 2 * F.tid, w = 2 << (col >> 8);
        const float b0 = pbias[col], b1 = pbias[col + 1];
#define WIN_LOAD(PR, ch) do { const int r0_ = (ch) * 16, s0_ = r0_ & 2047; _Pragma("unroll") for (int q = 0; q < 31; ++q) { PR[q] = 0u; if (s0_ - 15 + q >= 0) PR[q] = *(const unsigned*)(z + (size_t)(r0_ - 15 + q) * 1024 + col); } } while (0)
#define WIN_DONE(PR, ch) do { const int r0_ = (ch) * 16, s0_ = r0_ & 2047; float u0[31], u1[31]; \
            _Pragma("unroll") for (int q = 0; q < 31; ++q) { u0[q] = __uint_as_float(PR[q] << 16); u1[q] = __uint_as_float(PR[q] & 0xFFFF0000u); } \
            _Pragma("unroll") for (int i = 0; i < 16; ++i) { float sa = 0.f, sb = 0.f; \
                _Pragma("unroll") for (int q = 0; q < 16; ++q) if (q < w) { sa += u0[15 + i - q]; sb += u1[15 + i - q]; } \
                const int s = s0_ + i, cnt = (s + 1 < w) ? s + 1 : w; const float ic = 1.f / (float)cnt; \
                st_wt(op + (size_t)(r0_ + i) * 1024 + col, pg8::cvt_pk_bf16(sa * ic - u0[15 + i] + b0, sb * ic - u1[15 + i] + b1)); } } while (0)
        unsigned prA[31], prB[31];
        int ch = F.bid;
        if (ch < NT / 16) WIN_LOAD(prA, ch);
        for (; ch < NT / 16; ch += 256) {
            const int chn = ch + 128, chnn = ch + 256;
            if (chn < NT / 16) WIN_LOAD(prB, chn);
            WIN_DONE(prA, ch);
            if (chnn < NT / 16) WIN_LOAD(prA, chnn);
            if (chn < NT / 16) WIN_DONE(prB, chn);
        }
#undef WIN_LOAD
#undef WIN_DONE
    } else {
        p4_cmp2(F, F.bid - 128, F.G - 128, false);
    }
}

__device__ __forceinline__ void unpack8(const pg8::u32x4 w, float (&f)[8]) {
    f[0] = __uint_as_float(w.x << 16); f[1] = __uint_as_float(w.x & 0xFFFF0000u); f[2] = __uint_as_float(w.y << 16); f[3] = __uint_as_float(w.y & 0xFFFF0000u);
    f[4] = __uint_as_float(w.z << 16); f[5] = __uint_as_float(w.z & 0xFFFF0000u); f[6] = __uint_as_float(w.w << 16); f[7] = __uint_as_float(w.w & 0xFFFF0000u);
}
struct MixRow { pg8::u32x4 c[2], w[2], s[2], t[2], p[2]; float gq[2][3], m0[2], l0[2], m1[2], l1[2]; };
__device__ __forceinline__ void mix_load(const Frame& F, int r, int lane, bool split, MixRow& R) {
    const bf16_t* ocmp = (const bf16_t*)(F.ws + WS_OCMP); const bf16_t* owin = (const bf16_t*)(F.ws + WS_OWIN); const bf16_t* osel = (const bf16_t*)(F.ws + WS_OSEL);
    const float* ml = (const float*)(F.ws + WS_ML); const float* gates = (const float*)(F.ws + WS_GATES); const bf16_t* opool = (const bf16_t*)(F.ws + WS_OPOOL);
    const size_t o = (size_t)r * 1024 + lane * 8;
#pragma unroll
    for (int hf = 0; hf < 2; ++hf) { const int h = 4 * hf + (lane >> 4);
        R.c[hf] = __builtin_nontemporal_load((const pg8::u32x4*)(ocmp + o + hf * 512)); R.w[hf] = __builtin_nontemporal_load((const pg8::u32x4*)(owin + o + hf * 512)); R.s[hf] = __builtin_nontemporal_load((const pg8::u32x4*)(osel + o + hf * 512));
        R.t[hf] = split ? __builtin_nontemporal_load((const pg8::u32x4*)(osel + (size_t)NT * 1024 + o + hf * 512)) : R.s[hf]; R.p[hf] = __builtin_nontemporal_load((const pg8::u32x4*)(opool + o + hf * 512));
        const float* gq = gates + (size_t)r * 24 + h * 3; R.gq[hf][0] = gq[0]; R.gq[hf][1] = gq[1]; R.gq[hf][2] = gq[2];
        R.m0[hf] = 0.f; R.l0[hf] = 1.f; R.m1[hf] = 0.f; R.l1[hf] = 0.f;
        if (split) { const float* m0p = ml + ((size_t)r * NH + h) * 2; const float* m1p = ml + (((size_t)NT + r) * NH + h) * 2; R.m0[hf] = m0p[0]; R.l0[hf] = m0p[1]; R.m1[hf] = m1p[0]; R.l1[hf] = m1p[1]; } }
}
__device__ __forceinline__ void mix_finish(const Frame& F, int r, int lane, bool split, const MixRow& R, const float (&ga)[16], const float (&gb)[16]) {
    bf16_t* mix = (bf16_t*)(F.ws + WS_MIX);
    float a[16], p[16]; float sa = 0.f, sp = 0.f;
#pragma unroll
    for (int hf = 0; hf < 2; ++hf) {
        const float g0 = 1.f / (1.f + __expf(-R.gq[hf][0])), g1 = 1.f / (1.f + __expf(-R.gq[hf][1])), g2 = 1.f / (1.f + __expf(-R.gq[hf][2]));
        float w0 = 1.f, w1 = 0.f;
        if (split) { const float M = fmaxf(R.m0[hf], R.m1[hf]); const float a0 = R.l0[hf] * exp2f((R.m0[hf] - M) * att::C2), a1 = R.l1[hf] * exp2f((R.m1[hf] - M) * att::C2), inv = 1.f / (a0 + a1); w0 = a0 * inv; w1 = a1 * inv; }
        float c8[8], w8[8], s8[8], t8[8], p8[8];
        unpack8(R.c[hf], c8); unpack8(R.w[hf], w8); unpack8(R.s[hf], s8); unpack8(R.t[hf], t8); unpack8(R.p[hf], p8);
#pragma unroll
        for (int j = 0; j < 8; ++j) { const float os = split ? (w0 * s8[j] + w1 * t8[j]) : s8[j]; a[hf * 8 + j] = g0 * c8[j] + g1 * os + g2 * w8[j]; sa += a[hf * 8 + j] * a[hf * 8 + j];
            p[hf * 8 + j] = p8[j]; sp += p8[j] * p8[j]; }
    }
    sa = wave_sum(sa); sp = wave_sum(sp);
    const float ra = rsqrtf(sa * (1.f / 1024.f) + EPS), rp = rsqrtf(sp * (1.f / 1024.f) + EPS);
#pragma unroll
    for (int hf = 0; hf < 2; ++hf) { pg8::u32x4 wa, wb;
        wa.x = pg8::cvt_pk_bf16(a[hf * 8] * ra * ga[hf * 8], a[hf * 8 + 1] * ra * ga[hf * 8 + 1]); wa.y = pg8::cvt_pk_bf16(a[hf * 8 + 2] * ra * ga[hf * 8 + 2], a[hf * 8 + 3] * ra * ga[hf * 8 + 3]);
        wa.z = pg8::cvt_pk_bf16(a[hf * 8 + 4] * ra * ga[hf * 8 + 4], a[hf * 8 + 5] * ra * ga[hf * 8 + 5]); wa.w = pg8::cvt_pk_bf16(a[hf * 8 + 6] * ra * ga[hf * 8 + 6], a[hf * 8 + 7] * ra * ga[hf * 8 + 7]);
        wb.x = pg8::cvt_pk_bf16(p[hf * 8] * rp * gb[hf * 8], p[hf * 8 + 1] * rp * gb[hf * 8 + 1]); wb.y = pg8::cvt_pk_bf16(p[hf * 8 + 2] * rp * gb[hf * 8 + 2], p[hf * 8 + 3] * rp * gb[hf * 8 + 3]);
        wb.z = pg8::cvt_pk_bf16(p[hf * 8 + 4] * rp * gb[hf * 8 + 4], p[hf * 8 + 5] * rp * gb[hf * 8 + 5]); wb.w = pg8::cvt_pk_bf16(p[hf * 8 + 6] * rp * gb[hf * 8 + 6], p[hf * 8 + 7] * rp * gb[hf * 8 + 7]);
        *(pg8::u32x4*)(mix + (size_t)r * DM + hf * 512 + lane * 8) = wa; *(pg8::u32x4*)(mix + (size_t)r * DM + 1024 + hf * 512 + lane * 8) = wb; }
}
template <int NR>
__device__ __forceinline__ void mix_rows(const Frame& F, int r0, int lane) {
    const float* gn = F.in[I_GNNSA]; const float* gp = F.in[I_GNPOOL];
    float ga[16], gb[16];
#pragma unroll
    for (int q = 0; q < 4; ++q) { const pg8::f32x4 v = *(const pg8::f32x4*)(gn + (q >> 1) * 512 + lane * 8 + (q & 1) * 4), u = *(const pg8::f32x4*)(gp + (q >> 1) * 512 + lane * 8 + (q & 1) * 4);
        ga[q * 4] = v[0]; ga[q * 4 + 1] = v[1]; ga[q * 4 + 2] = v[2]; ga[q * 4 + 3] = v[3]; gb[q * 4] = u[0]; gb[q * 4 + 1] = u[1]; gb[q * 4 + 2] = u[2]; gb[q * 4 + 3] = u[3]; }
    const bool split = ((r0 & 2047) >> 6) >= 16;
    MixRow A, B;
    mix_load(F, r0, lane, split, A);
#pragma unroll 1
    for (int i = 0; i < NR; i += 2) {
        mix_load(F, r0 + i + 1, lane, split, B);
        mix_finish(F, r0 + i, lane, split, A, ga, gb);
        if (i + 2 < NR) mix_load(F, r0 + i + 2, lane, split, A);
        mix_finish(F, r0 + i + 1, lane, split, B, ga, gb);
    }
}

struct EpiOut {
    static constexpr bool AFTER_DRAIN = true;
    const float* x; float* out; bf16_t* x1b; const float* lnm; const bf16_t* wrpb; float* pl;
    __device__ __forceinline__ void fused(pg8::f32x4 (&acc)[2][2][4][2], const pg8::Unit& un, int wr, int wc, int fr, int fq, LAS unsigned char* lds) const {
        const unsigned long long te0_ = (PROBE_REPEAT == 37) ? (unsigned long long)__builtin_readcyclecounter() : 0ull;
#pragma unroll
        for (int ai = 0; ai < 2; ++ai)
#pragma unroll
            for (int m = 0; m < 4; ++m) {
                const int row = un.pm * 256 + ai * 128 + wr * 64 + m * 16 + fr;
#pragma unroll
                for (int bj = 0; bj < 2; ++bj) {
                    const int c0 = un.pn * 256 + bj * 128 + wc * 32 + 8 * fq; const size_t o = (size_t)row * DM + c0;
                    const pg8::f32x4 v0 = acc[ai][bj][m][0] + __builtin_nontemporal_load((const pg8::f32x4*)(x + o)), v1 = acc[ai][bj][m][1] + __builtin_nontemporal_load((const pg8::f32x4*)(x + o + 4));
                    acc[ai][bj][m][0] = v0; acc[ai][bj][m][1] = v1;
                    const pg8::f32x4 g0 = *(const pg8::f32x4*)(lnm + c0), g1 = *(const pg8::f32x4*)(lnm + c0 + 4);
                    pg8::u32x4 w; w.x = pg8::cvt_pk_bf16(v0[0] * g0[0], v0[1] * g0[1]); w.y = pg8::cvt_pk_bf16(v0[2] * g0[2], v0[3] * g0[3]);
                    w.z = pg8::cvt_pk_bf16(v1[0] * g1[0], v1[1] * g1[1]); w.w = pg8::cvt_pk_bf16(v1[2] * g1[2], v1[3] * g1[3]); *(pg8::u32x4*)(x1b + o) = w;
                }
            }
        const unsigned long long te1_ = (PROBE_REPEAT == 36) ? (unsigned long long)__builtin_readcyclecounter() : 0ull;
        float* red = (float*)((unsigned char*)lds);
        const int tid = threadIdx.x;
#pragma unroll 1
        for (int ai = 0; ai < 2; ++ai) {
#pragma unroll
            for (int m = 0; m < 4; ++m) {
                pg8::f32x4 D0 = {0.f, 0.f, 0.f, 0.f}, D1 = D0, D2 = D0; float s2 = 0.f;
#pragma unroll
                for (int bj = 0; bj < 2; ++bj) {
                    const pg8::f32x4 v0 = (ai == 0) ? acc[0][bj][m][0] : acc[1][bj][m][0], v1 = (ai == 0) ? acc[0][bj][m][1] : acc[1][bj][m][1];
                    s2 += v0[0] * v0[0] + v0[1] * v0[1] + v0[2] * v0[2] + v0[3] * v0[3] + v1[0] * v1[0] + v1[1] * v1[1] + v1[2] * v1[2] + v1[3] * v1[3];
                    pg8::u32x4 hq, lq;
                    hq.x = pg8::cvt_pk_bf16(v0[0], v0[1]); hq.y = pg8::cvt_pk_bf16(v0[2], v0[3]); hq.z = pg8::cvt_pk_bf16(v1[0], v1[1]); hq.w = pg8::cvt_pk_bf16(v1[2], v1[3]);
                    lq.x = pg8::cvt_pk_bf16(v0[0] - __uint_as_float(hq.x << 16), v0[1] - __uint_as_float(hq.x & 0xFFFF0000u)); lq.y = pg8::cvt_pk_bf16(v0[2] - __uint_as_float(hq.y << 16), v0[3] - __uint_as_float(hq.y & 0xFFFF0000u));
                    lq.z = pg8::cvt_pk_bf16(v1[0] - __uint_as_float(hq.z << 16), v1[1] - __uint_as_float(hq.z & 0xFFFF0000u)); lq.w = pg8::cvt_pk_bf16(v1[2] - __uint_as_float(hq.w << 16), v1[3] - __uint_as_float(hq.w & 0xFFFF0000u));
                    const pg8::bf16x8 xh = __builtin_bit_cast(pg8::bf16x8, hq), xl = __builtin_bit_cast(pg8::bf16x8, lq);
                    const bf16_t* wq = wrpb + (size_t)((un.pn * 256 + bj * 128 + wc * 32) >> 5) * (6 * 512) + (fq * 16 + fr) * 8;
                    const pg8::bf16x8 w0h = *(const pg8::bf16x8*)(wq), w0l = *(const pg8::bf16x8*)(wq + 512), w1h = *(const pg8::bf16x8*)(wq + 1024), w1l = *(const pg8::bf16x8*)(wq + 1536),
                                      w2h = *(const pg8::bf16x8*)(wq + 2048), w2l = *(const pg8::bf16x8*)(wq + 2560);
                    D0 = __builtin_amdgcn_mfma_f32_16x16x32_bf16(xh, w0h, D0, 0, 0, 0); D1 = __builtin_amdgcn_mfma_f32_16x16x32_bf16(xh, w1h, D1, 0, 0, 0); D2 = __builtin_amdgcn_mfma_f32_16x16x32_bf16(xh, w2h, D2, 0, 0, 0);
                    D0 = __builtin_amdgcn_mfma_f32_16x16x32_bf16(xh, w0l, D0, 0, 0, 0); D1 = __builtin_amdgcn_mfma_f32_16x16x32_bf16(xh, w1l, D1, 0, 0, 0); D2 = __builtin_amdgcn_mfma_f32_16x16x32_bf16(xh, w2l, D2, 0, 0, 0);
                    D0 = __builtin_amdgcn_mfma_f32_16x16x32_bf16(xl, w0h, D0, 0, 0, 0); D1 = __builtin_amdgcn_mfma_f32_16x16x32_bf16(xl, w1h, D1, 0, 0, 0); D2 = __builtin_amdgcn_mfma_f32_16x16x32_bf16(xl, w2h, D2, 0, 0, 0);
                }
                s2 += __shfl_xor(s2, 16); s2 += __shfl_xor(s2, 32);
                float* rr = red + ((size_t)wc * 128 + wr * 64 + m * 16) * 40;
#pragma unroll
                for (int r = 0; r < 4; ++r) { float* q = rr + (4 * fq + r) * 40; q[fr] = D0[r]; q[16 + fr] = D1[r]; if (fr < 8) q[32 + fr] = D2[r]; }
                if (fq == 0) rr[fr * 40 + 36] = s2;
            }
            __syncthreads();
            for (int idx = tid; idx < 128 * 40; idx += 512) { const int r = idx / 40, c = idx - r * 40;
                const float s = (red[idx] + red[128 * 40 + idx]) + (red[2 * 128 * 40 + idx] + red[3 * 128 * 40 + idx]);
                if (c < 37) st_wt(&pl[((size_t)un.pn * NT + un.pm * 256 + ai * 128 + r) * 40 + c], s); }
            __syncthreads();
        }
        if (PROBE_REPEAT == 36 && blockIdx.x == PROBE_WG && threadIdx.x == 0) *(volatile LAS unsigned long long*)(lds - 1024 + 512) = (unsigned long long)__builtin_readcyclecounter() - te1_;
        if (PROBE_REPEAT == 37 && blockIdx.x == PROBE_WG && threadIdx.x == 0) *(volatile LAS unsigned long long*)(lds - 1024 + 512) = (unsigned long long)__builtin_readcyclecounter() - te0_;
    }
};
template <bool AGG>
__device__ __forceinline__ void p8_router(const Frame& F, int dummy, int wv0 = -1, int wv1 = NT / 8, int wstep = 0, LAS unsigned* agg = nullptr) {
    const float* pl = (const float*)(F.ws + WS_PL); const float* brg = F.in[I_BRG]; const float* bre = F.in[I_BRE];
    float* rstd2 = (float*)(F.ws + WS_RSTD2); int* arow = (int*)(F.ws + WS_AROW); int* tokl = (int*)(F.ws + WS_TOKL); float* gatel = (float*)(F.ws + WS_GATEL);
    unsigned* cnt = (unsigned*)(F.ws + WS_CTL) + (dummy ? 10240 + 1024 : CW_CNT);
    const int gw = wv0 < 0 ? F.bid * NWAVES + F.wave : wv0 + F.wave, nw = wv0 < 0 ? F.G * NWAVES : wstep, lane = fresh_lane(), tl = lane >> 3, pn = lane & 7;
    bool has = false; int r_ = 0, ea_ = 0, eb_ = 0; float g0_ = 0.f, g1_ = 0.f; unsigned la_ = 0u, lb_ = 0u;
    if (AGG) { if (F.wave == 0) agg[lane] = 0u; __syncthreads(); }
    for (int wv = gw; wv < wv1; wv += nw) {
        const int r = wv * 8 + tl;
        const float* p = pl + ((size_t)pn * NT + r) * 40;
        float v[37];
#pragma unroll
        for (int q = 0; q < 9; ++q) { const pg8::f32x4 t = *(const pg8::f32x4*)(p + 4 * q); v[4 * q] = t[0]; v[4 * q + 1] = t[1]; v[4 * q + 2] = t[2]; v[4 * q + 3] = t[3]; }
        v[36] = p[36];
#pragma unroll
        for (int c = 0; c < 37; ++c) { v[c] += __shfl_xor(v[c], 1); v[c] += __shfl_xor(v[c], 2); v[c] += __shfl_xor(v[c], 4); }
        if (pn == 0) {
            const float rs = rsqrtf(v[36] * (1.f / DM) + EPS);
            float lg[4];
#pragma unroll
            for (int j = 0; j < 4; ++j) lg[j] = v[32 + j] * rs + brg[j];
            int gs = 0; float gm = lg[0];
#pragma unroll
            for (int j = 1; j < 4; ++j) if (lg[j] > gm) { gm = lg[j]; gs = j; }
            float den = 0.f;
#pragma unroll
            for (int j = 0; j < 4; ++j) den += __expf(lg[j] - gm);
            const float pg = 1.f / den;
            float le[8];
#pragma unroll
            for (int j = 0; j < 8; ++j) { const float s = (gs == 0) ? v[j] : (gs == 1) ? v[8 + j] : (gs == 2) ? v[16 + j] : v[24 + j]; le[j] = s * rs + bre[gs * 8 + j]; }
            int e0 = 0; float m0 = le[0];
#pragma unroll
            for (int j = 1; j < 8; ++j) if (le[j] > m0) { m0 = le[j]; e0 = j; }
            int e1 = -1; float m1 = -3.0e38f;
#pragma unroll
            for (int j = 0; j < 8; ++j) if (j != e0 && le[j] > m1) { m1 = le[j]; e1 = j; }
            const float p1 = __expf(m1 - m0);
            const float gate0 = pg / (1.f + p1), gate1 = pg * p1 / (1.f + p1);
            rstd2[r] = rs;
            const int ea = gs * 8 + e0, eb = gs * 8 + e1;
            if (AGG) { has = true; r_ = r; ea_ = ea; eb_ = eb; g0_ = gate0; g1_ = gate1;
                la_ = __hip_atomic_fetch_add(agg + ea, 1u, __ATOMIC_RELAXED, __HIP_MEMORY_SCOPE_WORKGROUP); lb_ = __hip_atomic_fetch_add(agg + eb, 1u, __ATOMIC_RELAXED, __HIP_MEMORY_SCOPE_WORKGROUP); }
            else {
            const unsigned sa = atomicAdd(&cnt[64 * ea], 1u), sb = atomicAdd(&cnt[64 * eb], 1u);
            tokl[ea * 8192 + sa] = r; gatel[ea * 8192 + sa] = gate0; tokl[eb * 8192 + sb] = r; gatel[eb * 8192 + sb] = gate1;
            arow[2 * r] = ea * 8192 + (int)sa; arow[2 * r + 1] = eb * 8192 + (int)sb; }
        }
    }
    if (AGG) {
        __syncthreads();
        if (F.wave == 0 && lane < 32) { const unsigned c = agg[lane]; agg[32 + lane] = c ? atomicAdd(&cnt[64 * lane], c) : 0u; }
        __syncthreads();
        if (has) { const unsigned sa = agg[32 + ea_] + la_, sb = agg[32 + eb_] + lb_;
            tokl[ea_ * 8192 + sa] = r_; gatel[ea_ * 8192 + sa] = g0_; tokl[eb_ * 8192 + sb] = r_; gatel[eb_ * 8192 + sb] = g1_;
            arow[2 * r_] = ea_ * 8192 + (int)sa; arow[2 * r_ + 1] = eb_ * 8192 + (int)sb; }
    }
}

constexpr int CW_PANEL = 12288 + 2048;
constexpr bool ROUTER_FUSED_OK = true;
__device__ __forceinline__ bool router_fused(const Frame& F) { return ROUTER_FUSED_OK && F.G == (NT / 256) * (DM / 256); }
__device__ __forceinline__ void p7_out(const Frame& F, LAS unsigned char* stage, unsigned char* lds_raw) {
    pg8::DenseOrder S; S.init(F.ws + WS_MIX, F.ws + WS_WOUTT, DM, DM, NT, DM, F.G, F.bid);
    EpiOut E{F.in[I_X], F.out, (bf16_t*)(F.ws + WS_X1B), F.in[I_LNMOE], (const bf16_t*)(F.ws + WS_WRPB), (float*)(F.ws + WS_PL)};
    const unsigned long long tp0_ = (PROBE_REPEAT == 38 || PROBE_REPEAT == 39) ? (unsigned long long)__builtin_readcyclecounter() : 0ull;
    pg8::gemm_phase<EpiOut, pg8::DenseOrder, false>(stage, DM, DM, DM, S, E);
    if (PROBE_REPEAT == 38 && blockIdx.x == PROBE_WG && threadIdx.x == 0) *(volatile unsigned long long*)(lds_raw + 512) = (unsigned long long)__builtin_readcyclecounter() - tp0_;
    if (router_fused(F)) {
        pg8::Unit u; (void)S.next(0, u);
        asm volatile("s_waitcnt vmcnt(0)" ::: "memory");
        __syncthreads();
        if (F.wave == 0 && fresh_lane() == 0) {
            unsigned* pc = (unsigned*)(F.ws + WS_CTL) + CW_PANEL + 64 * u.pm;
            (void)__hip_atomic_fetch_add(pc, 1u, __ATOMIC_RELAXED, __HIP_MEMORY_SCOPE_AGENT);
            unsigned sp = 0u; while (xb_ld(pc) < 8u) { __builtin_amdgcn_s_sleep(1); if (++sp > (1u << 22)) break; }
            __builtin_amdgcn_fence(__ATOMIC_ACQUIRE, "agent"); asm volatile("s_waitcnt vmcnt(0)" ::: "memory");
        }
        __syncthreads();
        p8_router<true>(F, 0, u.pm * 32 + u.pn * 4, u.pm * 32 + u.pn * 4 + 4, NWAVES, (LAS unsigned*)((LAS unsigned char*)lds_raw + 64));
    }
    if (PROBE_REPEAT == 39 && blockIdx.x == PROBE_WG && threadIdx.x == 0) *(volatile unsigned long long*)(lds_raw + 512) = (unsigned long long)__builtin_readcyclecounter() - tp0_;
}

__device__ __forceinline__ int scan32(int v, int ln) {
#pragma unroll
    for (int o = 1; o < 32; o <<= 1) { const int t = __shfl_up(v, o); if (ln >= o) v += t; }
    return v;
}
__device__ __forceinline__ void moe_counts(const Frame& F, int* cnts  , int* pst  ) {
    const unsigned* cnt = (const unsigned*)(F.ws + WS_CTL) + CW_CNT;
    __syncthreads();
    if (F.wave == 0) {
        const int ln = fresh_lane(); int c = 0; if (ln < 32) c = (int)__hip_atomic_load(&cnt[64 * ln], __ATOMIC_RELAXED, __HIP_MEMORY_SCOPE_AGENT);
        const int pad = (c + 255) & ~255, inc = scan32(pad, ln);
        if (ln < 32) { cnts[ln] = c; pst[ln] = inc - pad; } if (ln == 31) pst[32] = inc; }
    __syncthreads();
}

constexpr int MOE_TAB_OFF = 1024 + 131072;
struct MoeTabs { int* cnts; int* pst; int* ust; int* usth; int* rowtok; };
__device__ __forceinline__ MoeTabs moe_tabs(unsigned char* lds_raw) { MoeTabs T; T.cnts = (int*)(lds_raw + MOE_TAB_OFF); T.pst = T.cnts + 32; T.ust = T.pst + 40; T.usth = T.ust + 40; T.rowtok = T.usth + 40; return T; }
template <int NTN> __device__ __forceinline__ void moe_units(const Frame& F, const MoeTabs& T) {
    moe_counts(F, T.cnts, T.pst);
    if (F.wave == 0) { const int ln = fresh_lane(); const int c = ln < 32 ? T.cnts[ln] : 0, nmt = (c + 255) >> 8, hl = (nmt > 0 && c - 256 * (nmt - 1) <= 128) ? 1 : 0;
        const int fu = (nmt - hl) * NTN, hu = hl * NTN, fi = scan32(fu, ln), hi = scan32(hu, ln);
        if (ln < 32) { T.ust[ln] = fi - fu; T.usth[ln] = hi - hu; } if (ln == 31) { T.ust[32] = fi; T.usth[32] = hi; } }
    __syncthreads();
}
template <int NTN> struct MoeOrder2 {
    const int* cnts; const int* pst; const int* ust; const int* usth; const int* rowtok; const bf16_t* A; const float* W0; const float* W1; int G, c, lda, ldb, gather, narrow;
    __device__ __forceinline__ bool next(int i, g2::Unit& u) const {
        int L = i * G + c; u.li = i;
        if (L < ust[32]) {
            const int e = (int)__popcll(__ballot(ust[(fresh_lane() & 31) + 1] <= L) & 0xFFFFFFFFull);
            const int w = L - ust[e], c_ = cnts[e], nmt = (c_ + 255) >> 8, nf = nmt - ((c_ - 256 * (nmt - 1) <= 128) ? 1 : 0);
            u.e = e; u.pn = w / nf; u.pm = w - u.pn * nf; u.half = 0; return true; }
        L -= ust[32];
        const int Lh = narrow ? (L >> 1) : L; if (Lh >= usth[32]) return false;
        const int e = (int)__popcll(__ballot(usth[(fresh_lane() & 31) + 1] <= Lh) & 0xFFFFFFFFull);
        u.e = e; u.pn = Lh - usth[e]; u.pm = ((cnts[e] + 255) >> 8) - 1; u.half = narrow ? 2 + (L & 1) : 1; return true;
    }
    __device__ __forceinline__ int nvalid(const g2::Unit& u) const { const int v = cnts[u.e] - u.pm * 256; return v < 256 ? v : 256; }
    __device__ __forceinline__ unsigned a_off(const g2::Unit& u, int r) const {
        if (gather) { const int tk = rowtok[u.li * 256 + r]; return (unsigned)(tk < 0 ? 0 : tk) * (unsigned)lda * 2u; }
        return (unsigned)(pst[u.e] + u.pm * 256 + r) * (unsigned)lda * 2u;
    }
    __device__ __forceinline__ const float* b_col(const g2::Unit& u, int col) const {
        if (gather) { const int wcp = col >> 6, n = (col >> 4) & 3, i = col & 15; return ((n & 1) ? W1 : W0) + (size_t)u.e * DM * FF + u.pn * 64 + 32 * wcp + 16 * (n >> 1) + i; }
        { const int wcp = col >> 6, n = (col >> 4) & 3, j = col & 15;
          return W0 + (size_t)u.e * FF * DM + u.pn * 128 + 64 * wcp + 32 * (n >> 1) + 8 * (j >> 2) + 4 * (n & 1) + (j & 3); }
    }
};
struct EpiMoe1 {
    const int* pst; const int* rowtok; const float* rstd2; bf16_t* act;
    __device__ __forceinline__ void operator()(const pg8::f32x4 (&acc)[2][2][4], const g2::Unit& un, int wr, int wc, int fr, int fq) const {
        if (un.half >= 2 && wc != (un.half & 1)) return;
#pragma unroll
        for (int ai = 0; ai < 2; ++ai)
#pragma unroll
            for (int m = 0; m < 2; ++m) {
                const int r = ai * 128 + wr * 32 + m * 16 + fr; const int tk = rowtok[un.li * 256 + r];
                if (tk >= 0) {
                    const float rs = rstd2[tk];
#pragma unroll
                    for (int j = 0; j < 2; ++j) {
                        const pg8::f32x4 vg = acc[ai][m][2 * j] * rs, vu = acc[ai][m][2 * j + 1] * rs; float o[4];
#pragma unroll
                        for (int q = 0; q < 4; ++q) o[q] = vg[q] / (1.f + __expf(-vg[q])) * vu[q];
                        uint2 w; w.x = pg8::cvt_pk_bf16(o[0], o[1]); w.y = pg8::cvt_pk_bf16(o[2], o[3]);
                        *(uint2*)(act + (size_t)(pst[un.e] + un.pm * 256 + r) * FF + un.pn * 64 + wc * 32 + j * 16 + 4 * fq) = w; }
                }
            }
    }
};
struct EpiMoe2 {
    const int* cnts; const int* pst; const float* gatel; bf16_t* y;
    __device__ __forceinline__ void operator()(const pg8::f32x4 (&acc)[2][2][4], const g2::Unit& un, int wr, int wc, int fr, int fq) const {
#pragma unroll
        for (int ai = 0; ai < 2; ++ai)
#pragma unroll
            for (int m = 0; m < 2; ++m) {
                const int slot = un.pm * 256 + ai * 128 + wr * 32 + m * 16 + fr;
                if (slot < cnts[un.e]) {
                    const float gt = gatel[un.e * 8192 + slot];
                    bf16_t* dst = y + (size_t)(pst[un.e] + slot) * DM + un.pn * 128 + wc * 64 + 8 * fq;
#pragma unroll
                    for (int pq = 0; pq < 2; ++pq) { const pg8::f32x4 v0 = acc[ai][m][2 * pq] * gt, v1 = acc[ai][m][2 * pq + 1] * gt; pg8::u32x4 w;
                        w.x = pg8::cvt_pk_bf16(v0[0], v0[1]); w.y = pg8::cvt_pk_bf16(v0[2], v0[3]); w.z = pg8::cvt_pk_bf16(v1[0], v1[1]); w.w = pg8::cvt_pk_bf16(v1[2], v1[3]); *(pg8::u32x4*)(dst + pq * 32) = w; }
                }
            }
    }
};

__device__ __forceinline__ void p9_moe1(const Frame& F, unsigned char* lds_raw, LAS unsigned char* stage) {
    const MoeTabs T = moe_tabs(lds_raw);
    moe_units<8>(F, T);
    const int vc = (F.G % 8 == 0) ? (F.bid % 8) * (F.G / 8) + F.bid / 8 : F.bid;
    MoeOrder2<8> S{T.cnts, T.pst, T.ust, T.usth, T.rowtok, (const bf16_t*)(F.ws + WS_X1B), F.in[I_WGATE], F.in[I_WUP], F.G, vc, DM, FF, 1, 1};
    { const int* tokl = (const int*)(F.ws + WS_TOKL); g2::Unit u;
      for (int i = 0; i < 4 && S.next(i, u); ++i) { if (F.tid < 256) { const int slot = u.pm * 256 + F.tid; T.rowtok[i * 256 + F.tid] = slot < T.cnts[u.e] ? tokl[u.e * 8192 + slot] : -1; } } }
    asm volatile("s_waitcnt vmcnt(0) lgkmcnt(0)" ::: "memory");
    __syncthreads();
    EpiMoe1 E{T.pst, T.rowtok, (const float*)(F.ws + WS_RSTD2), (bf16_t*)(F.ws + WS_ACT)};
    g2::gemm<DM / 64, EpiMoe1, MoeOrder2<8>>(stage, S, E, F.wave, (PROBE_REPEAT >= 30 && PROBE_REPEAT <= 33) ? (unsigned long long*)(lds_raw + 512) : nullptr);
}

__device__ __forceinline__ void p10_moe2(const Frame& F, unsigned char* lds_raw, LAS unsigned char* stage) {
    const MoeTabs T = moe_tabs(lds_raw);
    moe_units<16>(F, T);
    const int vc = (F.G % 8 == 0) ? (F.bid % 8) * (F.G / 8) + F.bid / 8 : F.bid;
    MoeOrder2<16> S{T.cnts, T.pst, T.ust, T.usth, nullptr, (const bf16_t*)(F.ws + WS_ACT), F.in[I_WDOWN], nullptr, F.G, vc, FF, DM, 0, 0};
    EpiMoe2 E{T.cnts, T.pst, (const float*)(F.ws + WS_GATEL), (bf16_t*)(F.ws + WS_Y)};
    g2::gemm<FF / 64, EpiMoe2, MoeOrder2<16>>(stage, S, E, F.wave);
}

__device__ __forceinline__ void p11_final(const Frame& F, int dummy) {
    int* cnts = (int*)(F.lds + 3072); int* pst = cnts + 32;
    moe_counts(F, cnts, pst);
    const bf16_t* y = (const bf16_t*)(F.ws + WS_Y); const int* arow = (const int*)(F.ws + WS_AROW); const float* lnf = F.in[I_LNFINAL];
    const int gw = F.bid * NWAVES + F.wave, nw = F.G * NWAVES, lane = fresh_lane();
    const bf16_t* x1b = (const bf16_t*)(F.ws + WS_X1B); const float* lnm = F.in[I_LNMOE];
    float4 ig[8];
#pragma unroll
    for (int i = 0; i < 8; ++i) { const float4 g = *(const float4*)(lnm + i * 256 + lane * 4); ig[i].x = 1.f / g.x; ig[i].y = 1.f / g.y; ig[i].z = 1.f / g.z; ig[i].w = 1.f / g.w; }
    typedef unsigned u32x2_nt __attribute__((ext_vector_type(2)));
    float4 gf[8];
#pragma unroll
    for (int i = 0; i < 8; ++i) gf[i] = *(const float4*)(lnf + i * 256 + lane * 4);
#define FIN_LOAD(XQ, YA, YB, r) do { const int a0_ = arow[2 * (r)], a1_ = arow[2 * (r) + 1]; \
        const size_t r0_ = (size_t)(pst[a0_ >> 13] + (a0_ & 8191)), r1_ = (size_t)(pst[a1_ >> 13] + (a1_ & 8191)); \
        _Pragma("unroll") for (int i = 0; i < 8; ++i) { const int c = i * 256 + lane * 4; XQ[i] = __builtin_nontemporal_load((const u32x2_nt*)(x1b + (size_t)(r) * DM + c)); \
            YA[i] = __builtin_nontemporal_load((const u32x2_nt*)(y + r0_ * DM + c)); YB[i] = __builtin_nontemporal_load((const u32x2_nt*)(y + r1_ * DM + c)); } } while (0)
#define FIN_DONE(XQ, YA, YB, r) do { float v[32]; float ss = 0.f; \
        _Pragma("unroll") for (int i = 0; i < 8; ++i) { \
            v[4 * i]     = __uint_as_float(XQ[i].x << 16) * ig[i].x + __uint_as_float(YA[i].x << 16) + __uint_as_float(YB[i].x << 16); \
            v[4 * i + 1] = __uint_as_float(XQ[i].x & 0xFFFF0000u) * ig[i].y + __uint_as_float(YA[i].x & 0xFFFF0000u) + __uint_as_float(YB[i].x & 0xFFFF0000u); \
            v[4 * i + 2] = __uint_as_float(XQ[i].y << 16) * ig[i].z + __uint_as_float(YA[i].y << 16) + __uint_as_float(YB[i].y << 16); \
            v[4 * i + 3] = __uint_as_float(XQ[i].y & 0xFFFF0000u) * ig[i].w + __uint_as_float(YA[i].y & 0xFFFF0000u) + __uint_as_float(YB[i].y & 0xFFFF0000u); \
            ss += v[4 * i] * v[4 * i] + v[4 * i + 1] * v[4 * i + 1] + v[4 * i + 2] * v[4 * i + 2] + v[4 * i + 3] * v[4 * i + 3]; } \
        ss = wave_sum(ss); const float rs = rsqrtf(ss * (1.f / DM) + EPS); \
        _Pragma("unroll") for (int i = 0; i < 8; ++i) { const int c = i * 256 + lane * 4; \
            const pg8::f32x4 o_ = {v[4 * i] * rs * gf[i].x, v[4 * i + 1] * rs * gf[i].y, v[4 * i + 2] * rs * gf[i].z, v[4 * i + 3] * rs * gf[i].w}; \
            __builtin_nontemporal_store(o_, (pg8::f32x4*)((dummy ? (float*)(F.ws + WS_W1T) : F.out) + (size_t)(r) * DM + c)); } } while (0)
    u32x2_nt xA[8], yaA[8], ybA[8], xB[8], yaB[8], ybB[8];
    int r = gw;
    if (r < NT) FIN_LOAD(xA, yaA, ybA, r);
    for (; r < NT; r += 2 * nw) {
        const int rn = r + nw, rnn = r + 2 * nw;
        if (rn < NT) FIN_LOAD(xB, yaB, ybB, rn);
        FIN_DONE(xA, yaA, ybA, r);
        if (rnn < NT) FIN_LOAD(xA, yaA, ybA, rnn);
        if (rn < NT) FIN_DONE(xB, yaB, ybB, rn);
    }
#undef FIN_LOAD
#undef FIN_DONE
}

constexpr int NPHASE = 11;
__global__ void __launch_bounds__(NTHREADS, 2) fwd(Args args) {
    extern __shared__ __attribute__((aligned(16))) unsigned char lds_raw[];
    Frame F;
#pragma unroll
    for (int i = 0; i < N_IN; ++i) F.in[i] = args.in[i];
    F.out = args.out; F.ws = args.ws;
    F.lds = (float*)(lds_raw + 16);
    F.tid = threadIdx.x; F.lane = F.tid & 63; F.wave = __builtin_amdgcn_readfirstlane(F.tid >> 6); F.G = gridDim.x; F.bid = blockIdx.x;
    if (F.tid < 4) ((LAS unsigned*)lds_raw)[F.tid] = 0u;
    __syncthreads();
    XcdBarrier bar; bar.bar = (unsigned*)(F.ws + WS_CTL); bar.x = 0; bar.st = nullptr;
    if (N_LAUNCHES == 1) bar = xcd_barrier_post((unsigned*)(F.ws + WS_CTL), (volatile LAS unsigned*)lds_raw);
    bar.wave = F.wave;
    const int lo = args.ph_lo, hi = args.ph_hi;
#ifndef ONLY_PHASE
#define ONLY_PHASE -1
#endif
#define IN(k) (lo <= (k) && (k) < hi && (ONLY_PHASE < 0 || ONLY_PHASE == (k)))
#define SEAM(k) do { if (IN(k) && IN((k) + 1)) { const unsigned long long tb_ = (PROBE_REPEAT >= 40) ? (unsigned long long)__builtin_readcyclecounter() : 0ull; xcd_barrier(bar); if (PROBE_REPEAT == 12) xcd_barrier(bar); \
        if (PROBE_REPEAT == 40 || PROBE_REPEAT == 41 + (k)) tbar += (unsigned long long)__builtin_readcyclecounter() - tb_; if (PROBE_REPEAT == 60 + (k)) tbar = (unsigned long long)__builtin_readcyclecounter() - t_k0; } } while (0)
    unsigned long long tbar = 0ull; const unsigned long long t_k0 = (PROBE_REPEAT >= 60) ? (unsigned long long)__builtin_readcyclecounter() : 0ull;
    LAS unsigned char* stage = (LAS unsigned char*)lds_raw + 1024;
#define RUN(k, ...) do { if (IN(k)) { __VA_ARGS__; if (PROBE_REPEAT == (k)) { xcd_barrier(bar); __VA_ARGS__; } } } while (0)
    RUN(0, p0_prologue(F));
    if (PROBE_REPEAT == 11 && IN(0)) { xcd_barrier(bar); cvt_stream(F, 0, 6400, nullptr); }
    SEAM(0);
    RUN(1, p1_proj(F, stage));
    SEAM(1);
    RUN(2, p2a_mid(F, stage));
    SEAM(2);
    if (IN(3)) {
        p2b_mid(F, stage);
        asm volatile("s_waitcnt vmcnt(0)" ::: "memory");
        __syncthreads();
        if (F.wave == 0 && fresh_lane() == 0) (void)__hip_atomic_fetch_add((unsigned*)(F.ws + WS_CTL) + CW_MIDDONE, 1u, __ATOMIC_RELAXED, __HIP_MEMORY_SCOPE_AGENT);
    }
    if (IN(4)) {
#pragma unroll 1
        for (int rep = 0; rep < (PROBE_REPEAT == 4 ? 2 : 1); ++rep) { if (rep) xcd_barrier(bar); p_attn(F, lds_raw, rep); } }
    SEAM(5);
    RUN(6, p7_out(F, stage, lds_raw));
    if (!router_fused(F)) { SEAM(6);
        if (IN(7)) p8_router<false>(F, 0); }
    SEAM(7);
#define REFRESH_LANE() do { F.lane = fresh_lane(); F.tid = F.wave * 64 + F.lane; } while (0)
    REFRESH_LANE();
    if (IN(8)) {
#pragma unroll 1
        for (int rep = 0; rep < (PROBE_REPEAT == 8 ? 2 : 1); ++rep) { if (rep) xcd_barrier(bar); p9_moe1(F, lds_raw, stage); } }
    SEAM(8);
    REFRESH_LANE();
    if (IN(9)) {
#pragma unroll 1
        for (int rep = 0; rep < (PROBE_REPEAT == 9 ? 2 : 1); ++rep) { if (rep) xcd_barrier(bar); p10_moe2(F, lds_raw, stage); } }
    SEAM(9);
    REFRESH_LANE();
    if (IN(10)) { if (PROBE_REPEAT == 10) { p11_final(F, 1); xcd_barrier(bar); } const unsigned long long tf0 = (PROBE_REPEAT == 70) ? (unsigned long long)__builtin_readcyclecounter() : 0ull; p11_final(F, 0); if (PROBE_REPEAT == 70) tbar = (unsigned long long)__builtin_readcyclecounter() - tf0; }
#undef RUN
    if (PROBE_REPEAT >= 40 && blockIdx.x == PROBE_WG && threadIdx.x == 0) *(volatile unsigned long long*)(lds_raw + 512) = tbar;
    if (((PROBE_REPEAT >= 30 && PROBE_REPEAT <= 39) || PROBE_REPEAT >= 40) && blockIdx.x == PROBE_WG && threadIdx.x == 0) {
        const unsigned long long want = 4ull * *(volatile unsigned long long*)(lds_raw + 512), t0 = __builtin_readcyclecounter();
        while ((unsigned long long)__builtin_readcyclecounter() - t0 < want) __builtin_amdgcn_s_sleep(8);
    }
#undef IN
#undef SEAM
}

extern "C" void kernel_launch(void* const* d_in, const int* in_sizes, int n_in, void* d_out, int out_size, void* d_ws, size_t ws_size, hipStream_t stream) {
    static int grid = 0;
    if (grid == 0) {
        if (n_in != N_IN || out_size != NT * DM || ws_size < WS_END) { fprintf(stderr, "kernel_launch: unexpected shapes: n_in %d out %d ws %zu (need %zu)\n", n_in, out_size, ws_size, (size_t)WS_END); grid = -1; return; }
        int dev = 0, cus = 0, per_cu = 0;
        if (hipGetDevice(&dev) != hipSuccess || hipDeviceGetAttribute(&cus, hipDeviceAttributeMultiprocessorCount, dev) != hipSuccess) { grid = -1; return; }
        if (hipFuncSetAttribute((const void*)fwd, hipFuncAttributeMaxDynamicSharedMemorySize, LDS_BYTES) != hipSuccess) { fprintf(stderr, "kernel_launch: hipFuncSetAttribute failed\n"); grid = -1; return; }
        if (hipOccupancyMaxActiveBlocksPerMultiprocessor(&per_cu, (const void*)fwd, NTHREADS, LDS_BYTES) != hipSuccess || per_cu < 1) { fprintf(stderr, "kernel_launch: occupancy query says %d\n", per_cu); }
        (void)hipGetLastError();
        grid = cus;
    }
    if (grid < 0) return;
    (void)in_sizes;
    (void)hipMemsetAsync((char*)d_ws + WS_CTL, 0, CTL_ZERO_BYTES, stream);
    Args a{};
    for (int i = 0; i < N_IN; ++i) a.in[i] = (const float*)d_in[i];
    a.out = (float*)d_out; a.ws = (unsigned char*)d_ws;
    if (N_LAUNCHES == 1) { a.ph_lo = 0; a.ph_hi = NPHASE; hipLaunchKernelGGL(fwd, dim3(grid), dim3(NTHREADS), LDS_BYTES, stream, a); }
    else { for (int p = 0; p < NPHASE; ++p) { a.ph_lo = p; a.ph_hi = p + 1; hipLaunchKernelGGL(fwd, dim3(grid), dim3(NTHREADS), LDS_BYTES, stream, a); } }
}
```
